# Optimizing an MI355X kernel written in HIP

```python
import math
import jax, jax.numpy as jnp
from jax import lax
import numpy as np

D_MODEL = 2048
BATCH = 2
SEQ = 4096
DEPTH = 1

CHUNK = 64
N_META = 16
QB = 128
N_BUCKETS = 32
MAX_DISTANCE = 128

A_HEADS = 8
A_HEAD_DIM = 128
KV_RANK = 256
IDX_HEADS = 16
IDX_DIM = 64
TOPK_MAX = 256

B_HEADS = 8
B_QK_DIM = 64
B_V_DIM = 128

A_WIDTH = A_HEADS * A_HEAD_DIM
B_WIDTH = B_HEADS * B_V_DIM
IN_SIZES = (A_WIDTH, KV_RANK, A_WIDTH, IDX_HEADS * IDX_DIM, IDX_DIM, IDX_HEADS,
            2 * B_HEADS * B_QK_DIM, 2 * B_HEADS * B_QK_DIM, B_WIDTH, B_WIDTH,
            D_MODEL, D_MODEL)
IN_WIDTH = (3 * A_WIDTH + KV_RANK + IDX_HEADS * IDX_DIM + IDX_DIM + IDX_HEADS
            - A_WIDTH + 4 * B_HEADS * B_QK_DIM + 2 * B_WIDTH + 2 * D_MODEL)
EPS = 1e-6

kernel_name = "chunk_causal_dsa_diffattn_gated_hybrid"


def rms_norm(x, g):
    xf = x.astype(jnp.float32)
    y = xf * lax.rsqrt(jnp.mean(xf * xf, axis=-1, keepdims=True) + EPS)
    return (y * g.astype(jnp.float32)).astype(x.dtype)


def layer_norm(x, g, b):
    xf = x.astype(jnp.float32)
    mu = jnp.mean(xf, axis=-1, keepdims=True)
    var = jnp.mean(jnp.square(xf - mu), axis=-1, keepdims=True)
    y = (xf - mu) * lax.rsqrt(var + EPS)
    return (y * g.astype(jnp.float32) + b.astype(jnp.float32)).astype(x.dtype)


def chunk_id(pos):
    return jnp.where(pos < N_META, 0, 1 + (pos - N_META) // CHUNK)


def t5_bucket(rel):
    nb = N_BUCKETS // 2
    max_exact = nb // 2
    ret = jnp.where(rel > 0, nb, 0)
    n = jnp.abs(rel)
    nf = jnp.maximum(n, 1).astype(jnp.float32)
    large = max_exact + (jnp.log(nf / max_exact) / math.log(MAX_DISTANCE / max_exact)
                         * (nb - max_exact)).astype(jnp.int32)
    large = jnp.minimum(large, nb - 1)
    return ret + jnp.where(n < max_exact, n, large)


def hybrid_layer(h, layer, rel_bias, pre_w, w_in, kv_norm_w, w_uk, w_uv, ikn_w, ikn_b,
                 lam_p, subln_w, w_o_a, w_o_b, w_out, post_w):
    Bsz, T, _ = h.shape
    u = rms_norm(h, pre_w)
    proj = u @ w_in
    split_at = np.cumsum(np.array(IN_SIZES))[:-1].tolist()
    q_a, ckv, z_a, iq, ik, iw, q_b, k_b, v_b, z_b, g_a, g_b = jnp.split(proj, split_at, axis=-1)

    q_a = q_a.reshape(Bsz, T, A_HEADS, A_HEAD_DIM)
    ckv = rms_norm(ckv, kv_norm_w)
    iq = iq.reshape(Bsz, T, IDX_HEADS, IDX_DIM)
    ik = layer_norm(ik, ikn_w, ikn_b)
    iw = iw * (IDX_HEADS ** -0.5 * IDX_DIM ** -0.5)

    q_b = q_b.reshape(Bsz, T, B_HEADS, 2, B_QK_DIM)
    k_b = k_b.reshape(Bsz, T, B_HEADS, 2, B_QK_DIM)
    v_b = v_b.reshape(Bsz, T, B_HEADS, B_V_DIM)
    k1, k2 = k_b[..., 0, :], k_b[..., 1, :]
    lam_init = 0.8 - 0.6 * math.exp(-0.3 * layer)
    lp = lam_p.astype(jnp.float32)
    lam = jnp.exp(jnp.sum(lp[0] * lp[1])) - jnp.exp(jnp.sum(lp[2] * lp[3])) + lam_init

    bias_a = rel_bias[:, :A_HEADS]
    bias_b = rel_bias[:, A_HEADS:]

    kpos = jnp.arange(T)
    k_cid = chunk_id(kpos)
    n_blk = -(-T // QB)
    Tp = n_blk * QB
    q_pos = jnp.arange(Tp).reshape(n_blk, QB)
    topk = min(TOPK_MAX, T // 4)

    def to_blocks(a):
        a = jnp.pad(a, [(0, 0), (0, Tp - T)] + [(0, 0)] * (a.ndim - 2))
        return a.reshape((Bsz, n_blk, QB) + a.shape[2:]).swapaxes(0, 1)

    def from_blocks(a):
        return a.swapaxes(0, 1).reshape((Bsz, Tp) + a.shape[3:])[:, :T]

    a_scale = A_HEAD_DIM ** -0.5

    def dsa_block(args):
        q, bq, bw, qp = args
        qc = chunk_id(qp)
        s = jnp.einsum('bqhd,bsd->bqhs', bq, ik)
        score = jnp.einsum('bqhs,bqh->bqs', jax.nn.relu(s), bw).astype(jnp.float32)
        allowed = k_cid[None, :] <= qc[:, None]
        score = jnp.where(allowed[None], score, -jnp.inf)
        _, idx = lax.top_k(score, topk)
        valid = k_cid[idx] <= qc[None, :, None]
        sel = jax.vmap(lambda c, i: c[i])(ckv, idx)
        q_lat = jnp.einsum('bqhd,rhd->bqhr', q, w_uk)
        logits = jnp.einsum('bqhr,bqkr->bqhk', q_lat, sel).astype(jnp.float32) * a_scale
        bias = bias_a[t5_bucket(idx - qp[None, :, None])]
        logits = logits + jnp.swapaxes(bias, 2, 3).astype(jnp.float32)
        logits = jnp.where(valid[:, :, None, :], logits, -jnp.inf)
        p = jax.nn.softmax(logits, axis=-1).astype(sel.dtype)
        o_lat = jnp.einsum('bqhk,bqkr->bqhr', p, sel)
        o = jnp.einsum('bqhr,rhd->bqhd', o_lat, w_uv)
        return o.reshape(Bsz, QB, A_WIDTH)

    b_scale = B_QK_DIM ** -0.5

    def diff_block(args):
        q1, q2, qp = args
        qc = chunk_id(qp)
        allowed = (k_cid[None, :] <= qc[:, None])[None, None]
        bias = bias_b[t5_bucket(kpos[None, :] - qp[:, None])]
        bias = jnp.transpose(bias, (2, 0, 1))[None].astype(jnp.float32)

        def probs(q, k):
            l = jnp.einsum('bqhd,bshd->bhqs', q, k).astype(jnp.float32) * b_scale + bias
            return jax.nn.softmax(jnp.where(allowed, l, -jnp.inf), axis=-1)

        attn = probs(q1, k1) - lam * probs(q2, k2)
        return jnp.einsum('bhqs,bshd->bqhd', attn.astype(v_b.dtype), v_b)

    o_a = from_blocks(lax.map(dsa_block, (to_blocks(q_a), to_blocks(iq), to_blocks(iw), q_pos)))
    o_b = from_blocks(lax.map(diff_block, (to_blocks(q_b[..., 0, :]), to_blocks(q_b[..., 1, :]), q_pos)))
    o_b = (rms_norm(o_b, subln_w) * (1.0 - lam_init)).reshape(Bsz, T, B_WIDTH)

    y_a = (o_a * jax.nn.silu(z_a)) @ w_o_a
    y_b = (o_b * jax.nn.silu(z_b)) @ w_o_b
    mix = jax.nn.sigmoid(g_a) * y_a + jax.nn.sigmoid(g_b) * y_b
    out = mix @ w_out
    return h + rms_norm(out, post_w)


def setup_inputs(seed: int = 0) -> dict:
    key = jax.random.key(seed)
    ks = jax.random.split(key, 18)
    f32 = jnp.float32
    nrm = lambda k, shape, s: jax.random.normal(k, shape, f32) * s
    L = DEPTH
    return {
        "x": nrm(ks[0], (BATCH, SEQ, D_MODEL), 1.0),
        "meta_tokens": nrm(ks[1], (N_META, D_MODEL), 1.0),
        "rel_bias": nrm(ks[2], (N_BUCKETS, A_HEADS + B_HEADS), 0.5),
        "pre_norm_w": 1.0 + nrm(ks[3], (L, D_MODEL), 0.02),
        "w_in": nrm(ks[4], (L, D_MODEL, IN_WIDTH), D_MODEL ** -0.5),
        "kv_norm_w": 1.0 + nrm(ks[5], (L, KV_RANK), 0.02),
        "w_uk": nrm(ks[6], (L, KV_RANK, A_HEADS, A_HEAD_DIM), KV_RANK ** -0.5),
        "w_uv": nrm(ks[7], (L, KV_RANK, A_HEADS, A_HEAD_DIM), KV_RANK ** -0.5),
        "idx_k_norm_w": 1.0 + nrm(ks[8], (L, IDX_DIM), 0.02),
        "idx_k_norm_b": nrm(ks[9], (L, IDX_DIM), 0.02),
        "diff_lambda": nrm(ks[10], (L, 4, B_QK_DIM), 0.1),
        "diff_subln_w": 1.0 + nrm(ks[11], (L, B_V_DIM), 0.02),
        "w_o_a": nrm(ks[12], (L, A_WIDTH, D_MODEL), A_WIDTH ** -0.5),
        "w_o_b": nrm(ks[13], (L, B_WIDTH, D_MODEL), B_WIDTH ** -0.5),
        "w_out": nrm(ks[14], (L, D_MODEL, D_MODEL), D_MODEL ** -0.5),
        "post_norm_w": 1.0 + nrm(ks[15], (L, D_MODEL), 0.02),
    }


def reference(x, meta_tokens, rel_bias, pre_norm_w, w_in, kv_norm_w, w_uk, w_uv,
              idx_k_norm_w, idx_k_norm_b, diff_lambda, diff_subln_w, w_o_a, w_o_b,
              w_out, post_norm_w):
    Bsz = x.shape[0]
    meta = jnp.broadcast_to(meta_tokens[None].astype(x.dtype), (Bsz, N_META, x.shape[-1]))
    h = jnp.concatenate([meta, x], axis=1)
    for l in range(DEPTH):
        h = hybrid_layer(h, l, rel_bias, pre_norm_w[l], w_in[l], kv_norm_w[l], w_uk[l], w_uv[l],
                         idx_k_norm_w[l], idx_k_norm_b[l], diff_lambda[l], diff_subln_w[l],
                         w_o_a[l], w_o_b[l], w_out[l], post_norm_w[l])
    return h[:, N_META:]
```

```cpp
#include <hip/hip_runtime.h>
#include <cstdio>
#include <cstdint>
#include <cstring>

#define LAS __attribute__((address_space(3)))
#define GAS __attribute__((address_space(1)))
typedef unsigned short bf16_t;
typedef short bf16x8 __attribute__((ext_vector_type(8)));
typedef float f32x4 __attribute__((ext_vector_type(4)));
typedef unsigned u32x4 __attribute__((ext_vector_type(4)));
typedef unsigned u32x2 __attribute__((ext_vector_type(2)));

constexpr int DM = 2048, NB = 2, SEQ = 4096, NMETA = 16, TK = SEQ + NMETA  , MTOK = NB * SEQ  , MKEY = NB * TK  ;
constexpr int UROWS = 8448;
constexpr int NPAD = 11776;
constexpr float EPS = 1e-6f;
constexpr float LOG2E = 1.4426950408889634f;
constexpr size_t SC_PER_B = 8585216;

constexpr size_t MiB = 1u << 20;
constexpr size_t WS_CTL = 0, CTL_BYTES = 1 * MiB;
constexpr size_t WS_U = 1 * MiB;
constexpr size_t WS_WIN = 34 * MiB;
constexpr size_t WS_SC = 1 * MiB;
constexpr size_t WS_MIX = 1 * MiB;
constexpr size_t WS_WOA = 80 * MiB, WS_WOB = 84 * MiB, WS_WOUT = 88 * MiB, WS_WUK = 96 * MiB, WS_WUVT = 96 * MiB + 512 * 1024;
constexpr size_t WS_QA = 97 * MiB, WS_IQ = 113 * MiB, WS_QB = 129 * MiB, WS_ZA = 145 * MiB, WS_ZB = 161 * MiB, WS_GA = 177 * MiB, WS_GB = 209 * MiB;
constexpr size_t WS_OLAT = 97 * MiB;
constexpr size_t WS_OZA = 129 * MiB;
constexpr size_t WS_KB = 241 * MiB, WS_VB = 258 * MiB, WS_CKVRAW = 275 * MiB, WS_IKRAW = 284 * MiB, WS_IW = 287 * MiB, WS_CKV = 288 * MiB, WS_IK = 293 * MiB;
constexpr size_t WS_QLAT = 295 * MiB;
constexpr size_t WS_OUTPRE = 295 * MiB;
constexpr size_t WS_OZB = 327 * MiB, WS_SSQ = 343 * MiB, WS_END = 344 * MiB;

__device__ __forceinline__ float bf2f(unsigned short u) { return __uint_as_float(((unsigned)u) << 16); }
__device__ __forceinline__ unsigned f2bf(float f) { unsigned u = __float_as_uint(f); return (u + 0x7fffu + ((u >> 16) & 1u)) >> 16; }
__device__ __forceinline__ unsigned pk2(float lo, float hi) { return f2bf(lo) | (f2bf(hi) << 16); }
__device__ __forceinline__ float bflo(unsigned w) { return __uint_as_float(w << 16); }
__device__ __forceinline__ float bfhi(unsigned w) { return __uint_as_float(w & 0xffff0000u); }
__device__ __forceinline__ float wave_sum(float v) {
#pragma unroll
    for (int o = 1; o < 64; o <<= 1) v += __shfl_xor(v, o);
    return v;
}
__device__ __forceinline__ float silu_f(float x) { return x * __builtin_amdgcn_rcpf(1.f + __expf(-x)); }
__device__ __forceinline__ int t5_bucket(int rel) {
    const int n = rel < 0 ? -rel : rel; int f;
    if (n < 8) f = n; else if (n < 12) f = 8; else if (n < 16) f = 9; else if (n < 23) f = 10; else if (n < 32) f = 11; else if (n < 46) f = 12; else if (n < 64) f = 13; else if (n < 91) f = 14; else f = 15;
    return (rel > 0 ? 16 : 0) + f;
}
__device__ __forceinline__ size_t sc_off(int b, int j) {
    const int c = 1 + (j >> 6);
    return (size_t)b * SC_PER_B + (size_t)1024 * (c - 1) + (size_t)2048 * (c - 1) * c + (size_t)(j & 63) * (16 + 64 * c);
}

namespace pg8 {
constexpr int BM = 256, BK = 64, HALF = 128, HTB = HALF * BK * 2, STAGE_BYTES = 8 * HTB, NXCD = 8, WGM = 8;
__host__ __device__ __forceinline__ int lds_byte(int r, int c) { const int st = (r >> 4) * 2 + (c >> 5), rr = r & 15, cc = c & 31, ob = rr * 64 + cc * 2; return st * 1024 + (ob ^ (((ob >> 9) & 1) << 5)); }
__host__ __device__ __forceinline__ void stage_rc(int b, int& R, int& C) { const int st = b / 1024, sb = b % 1024, swz = sb ^ (((sb >> 9) & 1) << 5); R = (st >> 1) * 16 + swz / 64; C = (st & 1) * 32 + (swz % 64) / 2; }
__host__ __device__ __forceinline__ int perm32(int rho) { const int n = rho >> 4, i = rho & 15; return 8 * (i >> 2) + 4 * n + (i & 3); }

struct Unit { int pm, pn, sub; };
__device__ __forceinline__ unsigned cvt_pk_bf16(float lo, float hi) { unsigned r; asm volatile("v_cvt_pk_bf16_f32 %0, %1, %2" : "=v"(r) : "v"(lo), "v"(hi)); return r; }

__device__ __forceinline__ void tile_of(int L, int nM, int nN, int& pm, int& pn) {
    const int nwg = nM * nN; int wgid = L; { const int q = nwg / NXCD, r = nwg % NXCD, xcd = wgid % NXCD, off = wgid / NXCD; wgid = (xcd < r ? xcd * (q + 1) : r * (q + 1) + (xcd - r) * q) + off; }
    const int nig = WGM * nN, gid = wgid / nig, fm = gid * WGM, gsz = (nM - fm) < WGM ? (nM - fm) : WGM;
    pm = fm + ((wgid % nig) % gsz); pn = (wgid % nig) / gsz;
}

template <class Epi, class Sched, bool ALIGN_EPI = true, bool SP2 = true>
__device__ __forceinline__ void gemm_phase(LAS unsigned char* lds, const Sched& S, const Epi& E) {
    const int tid = threadIdx.x, wid = __builtin_amdgcn_readfirstlane(tid >> 6), lane = tid & 63, wr = wid >> 2, wc = wid & 3, fr = lane & 15, fq = lane >> 4;
    const int K = S.K, nt = K / BK;
    unsigned voffA[2], voffB[2];
#pragma unroll
    for (int i = 0; i < 2; ++i) { int R, C; stage_rc(tid * 16 + i * 8192, R, C); const int Rb = Epi::PERM ? ((R & ~31) + perm32(R & 31)) : R;
        voffA[i] = (unsigned)(R * K + C) * 2u; voffB[i] = (unsigned)(Rb * K + C) * 2u; }
    const size_t kstep = (size_t)(BK * 2);
    const size_t hstep = (size_t)HALF * K * 2;
    const unsigned ldsw = (unsigned)wid * 1024u;
    const int aoff = lds_byte(wr * 64 + fr, fq * 8), boff = lds_byte(wc * 32 + fr, fq * 8);
#define PG8_SA(b, h) (((b) * 2 + (h)) * HTB)
#define PG8_SB(b, h) ((4 + (b) * 2 + (h)) * HTB)
#define PG8_STAGE(bufoff, gbase, voff) do { _Pragma("unroll") for (int _i = 0; _i < 2; ++_i) \
        __builtin_amdgcn_global_load_lds((const unsigned*)((const char*)(gbase) + (voff)[_i]), (LAS unsigned*)(lds + (bufoff) + ldsw + _i * 8192), 16, 0, 0); } while (0)
#define PG8_LDA(dst, b, h) do { _Pragma("unroll") for (int m = 0; m < 4; ++m) _Pragma("unroll") for (int k = 0; k < 2; ++k) dst[m][k] = *(const LAS bf16x8*)(lds + PG8_SA(b, h) + aoff + m * 2048 + k * 1024); } while (0)
#define PG8_LDB(dst, b, h) do { _Pragma("unroll") for (int n = 0; n < 2; ++n) _Pragma("unroll") for (int k = 0; k < 2; ++k) dst[n][k] = *(const LAS bf16x8*)(lds + PG8_SB(b, h) + boff + n * 2048 + k * 1024); } while (0)
#define PG8_MMA(ai, bj, At, Bt) do { __builtin_amdgcn_s_setprio(1); _Pragma("unroll") for (int m = 0; m < 4; ++m) _Pragma("unroll") for (int n = 0; n < 2; ++n) _Pragma("unroll") for (int k = 0; k < 2; ++k) \
        acc[ai][bj][m][n] = __builtin_amdgcn_mfma_f32_16x16x32_bf16(Bt[n][k], At[m][k], acc[ai][bj][m][n], 0, 0, 0); __builtin_amdgcn_s_setprio(0); } while (0)
#define PG8_WAIT_V(n) asm volatile("s_waitcnt vmcnt(" #n ")" ::: "memory")
#define PG8_WAIT_L(n) asm volatile("s_waitcnt lgkmcnt(" #n ")" ::: "memory")
#define PG8_BAR __builtin_amdgcn_s_barrier()
#define PG8_SCHED __builtin_amdgcn_sched_barrier(0)
    Unit cur, nxt; int ui = 0;
    if (!S.next(0, cur)) return;
    f32x4 acc[2][2][4][2];
#pragma unroll
    for (int a = 0; a < 2; ++a)
#pragma unroll
        for (int b = 0; b < 2; ++b)
#pragma unroll
            for (int m = 0; m < 4; ++m)
#pragma unroll
                for (int n = 0; n < 2; ++n) acc[a][b][m][n] = (f32x4){0.f, 0.f, 0.f, 0.f};
    bf16x8 At[4][2], B0[2][2], B1[2][2];
    const char* cA = S.a_ptr(cur); const char* cB = S.b_ptr(cur);
    if constexpr (SP2) {
        PG8_STAGE(PG8_SB(0, 0), cB, voffB); PG8_STAGE(PG8_SB(0, 1), cB + hstep, voffB); PG8_STAGE(PG8_SA(0, 0), cA, voffA); PG8_STAGE(PG8_SA(0, 1), cA + hstep, voffA);
        if (wr == 1) PG8_BAR;
        PG8_WAIT_V(2); PG8_BAR;
        PG8_STAGE(PG8_SB(1, 0), cB + kstep, voffB); PG8_STAGE(PG8_SA(1, 0), cA + kstep, voffA); PG8_STAGE(PG8_SB(1, 1), cB + hstep + kstep, voffB);
        PG8_WAIT_V(6); PG8_BAR;
    } else {
        PG8_STAGE(PG8_SB(0, 0), cB, voffB); PG8_STAGE(PG8_SA(0, 0), cA, voffA); PG8_STAGE(PG8_SB(0, 1), cB + hstep, voffB); PG8_STAGE(PG8_SA(0, 1), cA + hstep, voffA);
        if (wr == 1) PG8_BAR;
        PG8_WAIT_V(4); PG8_BAR;
        PG8_STAGE(PG8_SB(1, 0), cB + kstep, voffB); PG8_STAGE(PG8_SA(1, 0), cA + kstep, voffA); PG8_STAGE(PG8_SB(1, 1), cB + hstep + kstep, voffB);
        PG8_WAIT_V(6); PG8_BAR;
    }
    for (;;) {
        const bool has_next = S.next(ui + 1, nxt);
        const char* nA = has_next ? S.a_ptr(nxt) : cA; const char* nB = has_next ? S.b_ptr(nxt) : cB;
        for (int t = 0; t < nt; t += 2) {
            const bool last = (t == nt - 2);
            const char* a1 = cA + (size_t)(t + 1) * kstep;
            const char* a2 = last ? nA : cA + (size_t)(t + 2) * kstep; const char* b2 = last ? nB : cB + (size_t)(t + 2) * kstep;
            const char* a3 = a2 + kstep; const char* b3 = b2 + kstep;
            if constexpr (SP2) {
            PG8_LDB(B0, 0, 0); PG8_LDB(B1, 0, 1); PG8_SCHED; PG8_LDA(At, 0, 0); PG8_STAGE(PG8_SA(1, 1), a1 + hstep, voffA);
            PG8_WAIT_V(8); PG8_WAIT_L(0); PG8_BAR; PG8_MMA(0, 0, At, B0); PG8_MMA(0, 1, At, B1); PG8_BAR; PG8_SCHED;
            PG8_LDA(At, 0, 1); PG8_STAGE(PG8_SB(0, 0), b2, voffB); PG8_STAGE(PG8_SB(0, 1), b2 + hstep, voffB); PG8_STAGE(PG8_SA(0, 0), a2, voffA);
            PG8_WAIT_V(8); PG8_WAIT_L(0); PG8_BAR; PG8_MMA(1, 0, At, B0); PG8_MMA(1, 1, At, B1); PG8_BAR; PG8_SCHED;
            PG8_LDB(B0, 1, 0); PG8_LDB(B1, 1, 1); PG8_SCHED; PG8_LDA(At, 1, 0); PG8_STAGE(PG8_SA(0, 1), a2 + hstep, voffA);
            PG8_WAIT_V(8); PG8_WAIT_L(0); PG8_BAR; PG8_MMA(0, 0, At, B0); PG8_MMA(0, 1, At, B1); PG8_BAR; PG8_SCHED;
            PG8_LDA(At, 1, 1); PG8_STAGE(PG8_SB(1, 0), b3, voffB); PG8_STAGE(PG8_SB(1, 1), b3 + hstep, voffB); PG8_STAGE(PG8_SA(1, 0), a3, voffA);
            PG8_WAIT_V(8); PG8_WAIT_L(0); PG8_BAR; PG8_MMA(1, 0, At, B0); PG8_MMA(1, 1, At, B1); PG8_BAR; PG8_SCHED;
            } else {
            PG8_LDB(B0, 0, 0); PG8_SCHED; PG8_LDA(At, 0, 0); PG8_STAGE(PG8_SA(1, 1), a1 + hstep, voffA);
            PG8_WAIT_L(8); PG8_BAR; PG8_WAIT_L(0); PG8_MMA(0, 0, At, B0); PG8_BAR; PG8_SCHED;
            PG8_LDB(B1, 0, 1); PG8_STAGE(PG8_SB(0, 0), b2, voffB);
            PG8_BAR; PG8_WAIT_L(0); PG8_MMA(0, 1, At, B1); PG8_BAR;
            PG8_LDA(At, 0, 1); PG8_STAGE(PG8_SA(0, 0), a2, voffA);
            PG8_BAR; PG8_WAIT_L(0); PG8_MMA(1, 0, At, B0); PG8_BAR; PG8_SCHED;
            PG8_STAGE(PG8_SB(0, 1), b2 + hstep, voffB);
            PG8_WAIT_V(6); PG8_BAR; PG8_MMA(1, 1, At, B1); PG8_BAR;
            PG8_LDB(B0, 1, 0); PG8_SCHED; PG8_LDA(At, 1, 0); PG8_STAGE(PG8_SA(0, 1), a2 + hstep, voffA);
            PG8_WAIT_L(8); PG8_BAR; PG8_WAIT_L(0); PG8_MMA(0, 0, At, B0); PG8_BAR; PG8_SCHED;
            PG8_LDB(B1, 1, 1); PG8_STAGE(PG8_SB(1, 0), b3, voffB);
            PG8_BAR; PG8_WAIT_L(0); PG8_MMA(0, 1, At, B1); PG8_BAR;
            PG8_LDA(At, 1, 1); PG8_STAGE(PG8_SA(1, 0), a3, voffA);
            PG8_BAR; PG8_WAIT_L(0); PG8_MMA(1, 0, At, B0); PG8_BAR; PG8_SCHED;
            PG8_STAGE(PG8_SB(1, 1), b3 + hstep, voffB);
            PG8_WAIT_V(6); PG8_BAR; PG8_MMA(1, 1, At, B1); PG8_BAR;
            }
        }
        if constexpr (ALIGN_EPI) { if (wr == 0) PG8_BAR; }
        E(acc, cur, wr, wc, fr, fq);
        if (!has_next) break;
        if (!E.keep_acc(cur)) {
#pragma unroll
        for (int a = 0; a < 2; ++a)
#pragma unroll
            for (int b = 0; b < 2; ++b)
#pragma unroll
                for (int m = 0; m < 4; ++m)
#pragma unroll
                    for (int n = 0; n < 2; ++n) acc[a][b][m][n] = (f32x4){0.f, 0.f, 0.f, 0.f};
        }
        cur = nxt; cA = nA; cB = nB; ++ui;
        if constexpr (ALIGN_EPI) { if (wr == 1) PG8_BAR; }
    }
    PG8_WAIT_V(0);
    if constexpr (!ALIGN_EPI) { if (wr == 0) PG8_BAR; }
    PG8_BAR;
#undef PG8_SA
#undef PG8_SB
#undef PG8_STAGE
#undef PG8_LDA
#undef PG8_LDB
#undef PG8_MMA
#undef PG8_WAIT_V
#undef PG8_WAIT_L
#undef PG8_BAR
#undef PG8_SCHED
}
}

struct SchedInproj {
    int K, G, c; const char* A; const char* B;
    __device__ __forceinline__ bool next(int i, pg8::Unit& u) const {
        const int L = i * G + c; u.sub = 0;
        if (L < 1472) { pg8::tile_of(L, 32, 46, u.pm, u.pn); return true; }
        if (L < 1482) { u.pm = 32; u.pn = 36 + (L - 1472); return true; }
        return false;
    }
    __device__ __forceinline__ const char* a_ptr(const pg8::Unit& u) const { return A + (size_t)u.pm * 256 * K * 2; }
    __device__ __forceinline__ const char* b_ptr(const pg8::Unit& u) const { return B + (size_t)u.pn * 256 * K * 2; }
};
struct EpiInproj {
    static constexpr bool PERM = true;
    bf16_t *QA, *ZA, *IQ, *QB, *ZB, *GA, *GB, *KB, *VB; float *CKVRAW, *IKRAW, *IW; float qb_scale;
    __device__ __forceinline__ bool keep_acc(const pg8::Unit&) const { return false; }
    __device__ __forceinline__ void operator()(f32x4 (&acc)[2][2][4][2], const pg8::Unit& u, int wr, int wc, int fr, int fq) const {
        const int pn = u.pn;
        if (pn < 44) {
            bf16_t* base; int ldc = 1024, ct, act = 0; bool kside = false;
            if (pn < 4) { base = QA; ct = pn; } else if (pn < 8) { base = ZA; ct = pn - 4; act = 1; } else if (pn < 12) { base = IQ; ct = pn - 8; }
            else if (pn < 16) { base = QB; ct = pn - 12; act = 2; } else if (pn < 20) { base = ZB; ct = pn - 16; act = 1; }
            else if (pn < 28) { base = GA; ct = pn - 20; ldc = 2048; } else if (pn < 36) { base = GB; ct = pn - 28; ldc = 2048; }
            else if (pn < 40) { base = KB; ct = pn - 36; kside = true; } else { base = VB; ct = pn - 40; kside = true; }
            const float sc = (act == 2) ? qb_scale : 1.f;
#pragma unroll
            for (int ai = 0; ai < 2; ++ai)
#pragma unroll
                for (int m = 0; m < 4; ++m) {
                    const int r = u.pm * 256 + ai * 128 + wr * 64 + m * 16 + fr;
                    long drow = r, drow2 = -1; bool ok = true;
                    if (kside) { if (r < MTOK) drow = (long)(r >> 12) * TK + NMETA + (r & 4095); else { const int i = r - MTOK; ok = i < NMETA; drow = i; drow2 = TK + i; } }
#pragma unroll
                    for (int bj = 0; bj < 2; ++bj) {
                        f32x4 v0 = acc[ai][bj][m][0], v1 = acc[ai][bj][m][1];
                        if (act == 1) {
#pragma unroll
                            for (int e = 0; e < 4; ++e) { v0[e] = silu_f(v0[e]); v1[e] = silu_f(v1[e]); }
                        }
                        v0 = v0 * sc; v1 = v1 * sc;
                        u32x4 w; w.x = pg8::cvt_pk_bf16(v0[0], v0[1]); w.y = pg8::cvt_pk_bf16(v0[2], v0[3]); w.z = pg8::cvt_pk_bf16(v1[0], v1[1]); w.w = pg8::cvt_pk_bf16(v1[2], v1[3]);
                        const int col = ct * 256 + bj * 128 + wc * 32 + 8 * fq;
                        if (ok) { *(u32x4*)(base + (size_t)drow * ldc + col) = w; if (drow2 >= 0) *(u32x4*)(base + (size_t)drow2 * ldc + col) = w; }
                    }
                }
        } else {
#pragma unroll
            for (int ai = 0; ai < 2; ++ai)
#pragma unroll
                for (int m = 0; m < 4; ++m) {
                    const int r = u.pm * 256 + ai * 128 + wr * 64 + m * 16 + fr;
                    long drow, drow2 = -1; bool ok = true;
                    if (r < MTOK) drow = (long)(r >> 12) * TK + NMETA + (r & 4095); else { const int i = r - MTOK; ok = i < NMETA; drow = i; drow2 = TK + i; }
#pragma unroll
                    for (int bj = 0; bj < 2; ++bj) {
                        const f32x4 v0 = acc[ai][bj][m][0], v1 = acc[ai][bj][m][1];
                        const int col = bj * 128 + wc * 32 + 8 * fq;
                        if (pn == 44) {
                            if (ok) { float* p = CKVRAW + (size_t)drow * 256 + col; *(f32x4*)p = v0; *(f32x4*)(p + 4) = v1;
                                      if (drow2 >= 0) { float* p2 = CKVRAW + (size_t)drow2 * 256 + col; *(f32x4*)p2 = v0; *(f32x4*)(p2 + 4) = v1; } }
                        } else {
                            if (col < 64) {
                                if (ok) { float* p = IKRAW + (size_t)drow * 64 + col; *(f32x4*)p = v0; *(f32x4*)(p + 4) = v1;
                                          if (drow2 >= 0) { float* p2 = IKRAW + (size_t)drow2 * 64 + col; *(f32x4*)p2 = v0; *(f32x4*)(p2 + 4) = v1; } }
                            } else if (col < 80) {
                                if (r < MTOK) { float* p = IW + (size_t)r * 16 + (col - 64); *(f32x4*)p = v0 * 0.03125f; *(f32x4*)(p + 4) = v1 * 0.03125f; }
                            }
                        }
                    }
                }
        }
    }
};
struct SchedMix {
    int K, G, c; const char *A0, *B0, *A1, *B1;
    __device__ __forceinline__ bool next(int i, pg8::Unit& u) const {
        const int L = (i >> 1) * G + c; if (L >= 256) return false;
        pg8::tile_of(L, 32, 8, u.pm, u.pn); u.sub = i & 1; return true;
    }
    __device__ __forceinline__ const char* a_ptr(const pg8::Unit& u) const { return (u.sub ? A1 : A0) + (size_t)u.pm * 256 * K * 2; }
    __device__ __forceinline__ const char* b_ptr(const pg8::Unit& u) const { return (u.sub ? B1 : B0) + (size_t)u.pn * 256 * K * 2; }
};
struct EpiMix {
    static constexpr bool PERM = true;
    const bf16_t *GA, *GB; bf16_t* MIX;
    __device__ __forceinline__ bool keep_acc(const pg8::Unit& u) const { return u.sub == 0; }
    __device__ __forceinline__ void operator()(f32x4 (&acc)[2][2][4][2], const pg8::Unit& u, int wr, int wc, int fr, int fq) const {
#pragma unroll
        for (int ai = 0; ai < 2; ++ai)
#pragma unroll
            for (int m = 0; m < 4; ++m) {
                const int r = u.pm * 256 + ai * 128 + wr * 64 + m * 16 + fr;
#pragma unroll
                for (int bj = 0; bj < 2; ++bj) {
                    const int col = u.pn * 256 + bj * 128 + wc * 32 + 8 * fq;
                    const u32x4 ga = *(const u32x4*)(GA + (size_t)r * DM + col), gb = *(const u32x4*)(GB + (size_t)r * DM + col);
                    float f[8];
#pragma unroll
                    for (int e = 0; e < 4; ++e) {
                        const unsigned wa = ga[e], wb = gb[e];
#pragma unroll
                        for (int hl = 0; hl < 2; ++hl) {
                            float a = hl ? bfhi(wa) : bflo(wa), b = hl ? bfhi(wb) : bflo(wb);
                            a = fminf(fmaxf(a, -30.f), 30.f); b = fminf(fmaxf(b, -30.f), 30.f);
                            const float ea = __expf(-a), eb = __expf(-b);
                            f[2 * e + hl] = (u.sub == 0) ? (1.f + eb) * __builtin_amdgcn_rcpf(1.f + ea) : __builtin_amdgcn_rcpf(1.f + eb);
                        }
                    }
                    f32x4 v0 = acc[ai][bj][m][0], v1 = acc[ai][bj][m][1];
#pragma unroll
                    for (int e = 0; e < 4; ++e) { v0[e] *= f[e]; v1[e] *= f[4 + e]; }
                    if (u.sub == 0) { acc[ai][bj][m][0] = v0; acc[ai][bj][m][1] = v1; }
                    else { u32x4 w; w.x = pg8::cvt_pk_bf16(v0[0], v0[1]); w.y = pg8::cvt_pk_bf16(v0[2], v0[3]); w.z = pg8::cvt_pk_bf16(v1[0], v1[1]); w.w = pg8::cvt_pk_bf16(v1[2], v1[3]);
                           *(u32x4*)(MIX + (size_t)r * DM + col) = w; }
                }
            }
    }
};
struct SchedOut {
    int K, G, c; const char *A, *B;
    __device__ __forceinline__ bool next(int i, pg8::Unit& u) const { const int L = i * G + c; if (L >= 256) return false; pg8::tile_of(L, 32, 8, u.pm, u.pn); u.sub = 0; return true; }
    __device__ __forceinline__ const char* a_ptr(const pg8::Unit& u) const { return A + (size_t)u.pm * 256 * K * 2; }
    __device__ __forceinline__ const char* b_ptr(const pg8::Unit& u) const { return B + (size_t)u.pn * 256 * K * 2; }
};
struct EpiOut {
    static constexpr bool PERM = true;
    bf16_t* OUTPRE; float* SSQ;
    __device__ __forceinline__ bool keep_acc(const pg8::Unit&) const { return false; }
    __device__ __forceinline__ void operator()(f32x4 (&acc)[2][2][4][2], const pg8::Unit& u, int wr, int wc, int fr, int fq) const {
#pragma unroll
        for (int ai = 0; ai < 2; ++ai)
#pragma unroll
            for (int m = 0; m < 4; ++m) {
                const int r = u.pm * 256 + ai * 128 + wr * 64 + m * 16 + fr; float ss = 0.f;
#pragma unroll
                for (int bj = 0; bj < 2; ++bj) {
                    const f32x4 v0 = acc[ai][bj][m][0], v1 = acc[ai][bj][m][1];
                    ss += (v0[0] * v0[0] + v0[1] * v0[1]) + (v0[2] * v0[2] + v0[3] * v0[3]) + (v1[0] * v1[0] + v1[1] * v1[1]) + (v1[2] * v1[2] + v1[3] * v1[3]);
                    u32x4 w; w.x = pg8::cvt_pk_bf16(v0[0], v0[1]); w.y = pg8::cvt_pk_bf16(v0[2], v0[3]); w.z = pg8::cvt_pk_bf16(v1[0], v1[1]); w.w = pg8::cvt_pk_bf16(v1[2], v1[3]);
                    *(u32x4*)(OUTPRE + (size_t)r * DM + u.pn * 256 + bj * 128 + wc * 32 + 8 * fq) = w;
                }
                ss += __shfl_xor(ss, 16); ss += __shfl_xor(ss, 32);
                if (fq == 0) SSQ[(size_t)r * 32 + u.pn * 4 + wc] = ss;
            }
    }
};

struct TJob { const float* src; bf16_t* dst; int K, N, col0, nblk, row0, item0; };
struct Params {
    const float *x, *meta, *rel_bias, *pre_w, *w_in, *kv_norm_w, *w_uk, *w_uv, *ikn_w, *ikn_b, *lam_p, *subln_w, *w_o_a, *w_o_b, *w_out, *post_w;
    float* out; unsigned char* ws;
    TJob jobs[16]; int njobs, nitems;
};
#define WSP(T, off) ((T*)(p.ws + (off)))

__device__ __forceinline__ void p0_transpose_item(const TJob& jb, LAS float* scr, int item, int lane) {
    const int kb = item / jb.nblk, nb = item % jb.nblk, k0 = 64 * kb, n0 = jb.col0 + 32 * nb;
#pragma unroll 8
    for (int i = 0; i < 32; ++i) { const int kk = 2 * i + (lane >> 5); scr[kk * 33 + (lane & 31)] = jb.src[(size_t)(k0 + kk) * jb.N + n0 + (lane & 31)]; }
    asm volatile("s_waitcnt lgkmcnt(0)" ::: "memory");
    const int c = lane & 7;
#pragma unroll
    for (int j = 0; j < 4; ++j) { const int n = (lane >> 3) + 8 * j; const LAS float* s = scr + (8 * c) * 33 + n;
        u32x4 o; o.x = pk2(s[0 * 33], s[1 * 33]); o.y = pk2(s[2 * 33], s[3 * 33]); o.z = pk2(s[4 * 33], s[5 * 33]); o.w = pk2(s[6 * 33], s[7 * 33]);
        *(u32x4*)(jb.dst + (size_t)(jb.row0 + 32 * nb + n) * jb.K + k0 + 8 * c) = o; }
    asm volatile("s_waitcnt lgkmcnt(0)" ::: "memory");
}
__device__ __forceinline__ void p0_norm_row(const float* xrow, const float* g, bf16_t* orow, int lane) {
    const f32x4* xr = (const f32x4*)xrow + lane; const f32x4* gr = (const f32x4*)g + lane;
    f32x4 v[8]; float s = 0.f;
#pragma unroll
    for (int j = 0; j < 8; ++j) { v[j] = xr[64 * j]; s += (v[j].x * v[j].x + v[j].y * v[j].y) + (v[j].z * v[j].z + v[j].w * v[j].w); }
    const float rstd = rsqrtf(wave_sum(s) * (1.f / DM) + EPS);
    u32x2* o8 = (u32x2*)orow + lane;
#pragma unroll
    for (int j = 0; j < 8; ++j) { const f32x4 gg = gr[64 * j]; u32x2 w; w.x = pk2(v[j].x * rstd * gg.x, v[j].y * rstd * gg.y); w.y = pk2(v[j].z * rstd * gg.z, v[j].w * rstd * gg.w); o8[64 * j] = w; }
}
__device__ __forceinline__ void phase0(const Params& p, LAS unsigned char* lds, int gw, int ngw, int wave, int lane) {
    LAS float* scr = (LAS float*)(lds + wave * 16384);
    for (int it = gw; it < p.nitems; it += ngw) {
        int jn = 0;
#pragma unroll
        for (int q = 1; q < 16; ++q) if (q < p.njobs && it >= p.jobs[q].item0) jn = q;
        p0_transpose_item(p.jobs[jn], scr, it - p.jobs[jn].item0, lane);
    }
    bf16_t* U = WSP(bf16_t, WS_U);
    for (int m = gw; m < UROWS; m += ngw) {
        if (m < MTOK) p0_norm_row(p.x + (size_t)m * DM, p.pre_w, U + (size_t)m * DM, lane);
        else if (m < MTOK + NMETA) p0_norm_row(p.meta + (size_t)(m - MTOK) * DM, p.pre_w, U + (size_t)m * DM, lane);
        else { u32x4* o = (u32x4*)(U + (size_t)m * DM) + lane;
#pragma unroll
            for (int j = 0; j < 4; ++j) o[64 * j] = (u32x4){0u, 0u, 0u, 0u}; }
    }
    bf16_t* WUK = WSP(bf16_t, WS_WUK);
    for (int i = gw * 64 + lane; i < 262144 / 4; i += ngw * 64) { const f32x4 v = ((const f32x4*)p.w_uk)[i]; u32x2 w; w.x = pk2(v.x, v.y); w.y = pk2(v.z, v.w); ((u32x2*)WUK)[i] = w; }
}

__device__ __forceinline__ void phase1b(const Params& p, int gw, int ngw, int lane) {
    const float* CKVRAW = WSP(const float, WS_CKVRAW); const float* IKRAW = WSP(const float, WS_IKRAW);
    bf16_t* CKV = WSP(bf16_t, WS_CKV); bf16_t* IK = WSP(bf16_t, WS_IK);
    for (int r = gw; r < MKEY; r += ngw) {
        const f32x4 v = ((const f32x4*)(CKVRAW + (size_t)r * 256))[lane];
        const float ss = wave_sum((v.x * v.x + v.y * v.y) + (v.z * v.z + v.w * v.w));
        const float rstd = rsqrtf(ss * (1.f / 256.f) + EPS);
        const f32x4 g = ((const f32x4*)p.kv_norm_w)[lane];
        u32x2 w; w.x = pk2(v.x * rstd * g.x, v.y * rstd * g.y); w.y = pk2(v.z * rstd * g.z, v.w * rstd * g.w);
        ((u32x2*)(CKV + (size_t)r * 256))[lane] = w;
        const float k = IKRAW[(size_t)r * 64 + lane];
        const float mu = wave_sum(k) * (1.f / 64.f); const float d = k - mu;
        const float var = wave_sum(d * d) * (1.f / 64.f);
        const float y = d * rsqrtf(var + EPS) * p.ikn_w[lane] + p.ikn_b[lane];
        IK[(size_t)r * 64 + lane] = (bf16_t)f2bf(y);
    }
}

__device__ __forceinline__ void phase7(const Params& p, int gw, int ngw, int lane) {
    const bf16_t* OUTPRE = WSP(const bf16_t, WS_OUTPRE); const float* SSQ = WSP(const float, WS_SSQ);
    for (int r = gw; r < MTOK; r += ngw) {
        float s = (lane < 32) ? SSQ[(size_t)r * 32 + lane] : 0.f; s = wave_sum(s);
        const float rstd = rsqrtf(s * (1.f / DM) + EPS);
        const u32x4* o = (const u32x4*)(OUTPRE + (size_t)r * DM); const f32x4* xr = (const f32x4*)(p.x + (size_t)r * DM); const f32x4* g = (const f32x4*)p.post_w; f32x4* out = (f32x4*)(p.out + (size_t)r * DM);
#pragma unroll
        for (int j = 0; j < 4; ++j) {
            const int ch = 64 * j + lane;
            const u32x4 w = o[ch]; const f32x4 x0 = xr[2 * ch], x1 = xr[2 * ch + 1], g0 = g[2 * ch], g1 = g[2 * ch + 1];
            f32x4 y0, y1;
            y0.x = x0.x + bflo(w.x) * rstd * g0.x; y0.y = x0.y + bfhi(w.x) * rstd * g0.y; y0.z = x0.z + bflo(w.y) * rstd * g0.z; y0.w = x0.w + bfhi(w.y) * rstd * g0.w;
            y1.x = x1.x + bflo(w.z) * rstd * g1.x; y1.y = x1.y + bfhi(w.z) * rstd * g1.y; y1.z = x1.z + bflo(w.w) * rstd * g1.z; y1.w = x1.w + bfhi(w.w) * rstd * g1.w;
            out[2 * ch] = y0; out[2 * ch + 1] = y1;
        }
    }
}

__global__ void __launch_bounds__(256) naive_scores(Params p) {
    const bf16_t* IQ = WSP(const bf16_t, WS_IQ); const bf16_t* IK = WSP(const bf16_t, WS_IK); const float* IW = WSP(const float, WS_IW); float* SC = WSP(float, WS_SC);
    const int t = blockIdx.x, b = t >> 12, j = t & 4095, c = 1 + (j >> 6), n = 16 + 64 * c, tid = threadIdx.x;
    __shared__ float q[1024]; __shared__ float w[16];
    for (int i = tid; i < 1024; i += 256) q[i] = bf2f(IQ[(size_t)t * 1024 + i]);
    if (tid < 16) w[tid] = IW[(size_t)t * 16 + tid];
    __syncthreads();
    float* row = SC + sc_off(b, j);
    for (int s = tid; s < n; s += 256) {
        const u32x4* kp = (const u32x4*)(IK + ((size_t)b * TK + s) * 64);
        float kf[64];
#pragma unroll
        for (int i = 0; i < 8; ++i) { const u32x4 v = kp[i]; kf[8 * i] = bflo(v.x); kf[8 * i + 1] = bfhi(v.x); kf[8 * i + 2] = bflo(v.y); kf[8 * i + 3] = bfhi(v.y); kf[8 * i + 4] = bflo(v.z); kf[8 * i + 5] = bfhi(v.z); kf[8 * i + 6] = bflo(v.w); kf[8 * i + 7] = bfhi(v.w); }
        float score = 0.f;
        for (int h = 0; h < 16; ++h) { float d = 0.f;
#pragma unroll
            for (int e = 0; e < 64; ++e) d += q[h * 64 + e] * kf[e];
            score += w[h] * fmaxf(d, 0.f); }
        row[s] = score;
    }
}

__device__ __forceinline__ float block_max256(float v, float* red) { const int tid = threadIdx.x;
#pragma unroll
    for (int o = 1; o < 64; o <<= 1) v = fmaxf(v, __shfl_xor(v, o));
    __syncthreads(); if ((tid & 63) == 0) red[tid >> 6] = v; __syncthreads(); return fmaxf(fmaxf(red[0], red[1]), fmaxf(red[2], red[3])); }
__device__ __forceinline__ float block_sum256(float v, float* red) { const int tid = threadIdx.x; v = wave_sum(v);
    __syncthreads(); if ((tid & 63) == 0) red[tid >> 6] = v; __syncthreads(); return (red[0] + red[1]) + (red[2] + red[3]); }

__global__ void __launch_bounds__(256) naive_diff(Params p) {
    const bf16_t* QB = WSP(const bf16_t, WS_QB); const bf16_t* KB = WSP(const bf16_t, WS_KB); const bf16_t* VB = WSP(const bf16_t, WS_VB); const bf16_t* ZB = WSP(const bf16_t, WS_ZB); bf16_t* OZB = WSP(bf16_t, WS_OZB);
    const int t = blockIdx.x >> 3, h = blockIdx.x & 7, b = t >> 12, j = t & 4095, c = 1 + (j >> 6), n = 16 + 64 * c, tid = threadIdx.x;
    __shared__ float q1[64], q2[64], s1[TK], s2[TK], red[4], ox[2][128], lam_s;
    if (tid < 64) q1[tid] = bf2f(QB[(size_t)t * 1024 + h * 128 + tid]); else if (tid < 128) q2[tid - 64] = bf2f(QB[(size_t)t * 1024 + h * 128 + tid]);
    if (tid == 0) { float a = 0.f, bb = 0.f; for (int i = 0; i < 64; ++i) { a += p.lam_p[i] * p.lam_p[64 + i]; bb += p.lam_p[128 + i] * p.lam_p[192 + i]; } lam_s = expf(a) - expf(bb) + 0.2f; }
    __syncthreads();
    float m1 = -INFINITY, m2 = -INFINITY;
    for (int s = tid; s < n; s += 256) {
        const u32x4* kp = (const u32x4*)(KB + ((size_t)b * TK + s) * 1024 + h * 128);
        float d1 = 0.f, d2 = 0.f;
#pragma unroll
        for (int i = 0; i < 8; ++i) { const u32x4 v = kp[i]; d1 += q1[8 * i] * bflo(v.x) + q1[8 * i + 1] * bfhi(v.x) + q1[8 * i + 2] * bflo(v.y) + q1[8 * i + 3] * bfhi(v.y) + q1[8 * i + 4] * bflo(v.z) + q1[8 * i + 5] * bfhi(v.z) + q1[8 * i + 6] * bflo(v.w) + q1[8 * i + 7] * bfhi(v.w); }
#pragma unroll
        for (int i = 0; i < 8; ++i) { const u32x4 v = kp[8 + i]; d2 += q2[8 * i] * bflo(v.x) + q2[8 * i + 1] * bfhi(v.x) + q2[8 * i + 2] * bflo(v.y) + q2[8 * i + 3] * bfhi(v.y) + q2[8 * i + 4] * bflo(v.z) + q2[8 * i + 5] * bfhi(v.z) + q2[8 * i + 6] * bflo(v.w) + q2[8 * i + 7] * bfhi(v.w); }
        const float bias = p.rel_bias[t5_bucket(s - (NMETA + j)) * 16 + 8 + h] * LOG2E;
        d1 += bias; d2 += bias; s1[s] = d1; s2[s] = d2; m1 = fmaxf(m1, d1); m2 = fmaxf(m2, d2);
    }
    m1 = block_max256(m1, red); m2 = block_max256(m2, red);
    float l1 = 0.f, l2 = 0.f;
    for (int s = tid; s < n; s += 256) { const float a = exp2f(s1[s] - m1), bb = exp2f(s2[s] - m2); s1[s] = a; s2[s] = bb; l1 += a; l2 += bb; }
    l1 = block_sum256(l1, red); l2 = block_sum256(l2, red);
    { const int xm = tid >> 7, d = tid & 127; const float* ps = xm ? s2 : s1; const bf16_t* vp = VB + (size_t)b * TK * 1024 + h * 128 + d; float a = 0.f;
      for (int s = 0; s < n; ++s) a += ps[s] * bf2f(vp[(size_t)s * 1024]);
      ox[xm][d] = a / (xm ? l2 : l1); }
    __syncthreads();
    float o = 0.f; if (tid < 128) o = ox[0][tid] - lam_s * ox[1][tid];
    const float ss = block_sum256(o * o, red);
    if (tid < 128) { const float y = o * rsqrtf(ss * (1.f / 128.f) + EPS) * p.subln_w[tid] * 0.8f * bf2f(ZB[(size_t)t * 1024 + h * 128 + tid]); OZB[(size_t)t * 1024 + h * 128 + tid] = (bf16_t)f2bf(y); }
}

__global__ void __launch_bounds__(256) naive_dsa(Params p) {
    const float* SC = WSP(const float, WS_SC); const bf16_t* QA = WSP(const bf16_t, WS_QA); const bf16_t* CKV = WSP(const bf16_t, WS_CKV); const bf16_t* WUK = WSP(const bf16_t, WS_WUK);
    const bf16_t* WUVT = WSP(const bf16_t, WS_WUVT); const bf16_t* ZA = WSP(const bf16_t, WS_ZA); bf16_t* OZA = WSP(bf16_t, WS_OZA);
    const int t = blockIdx.x, b = t >> 12, j = t & 4095, c = 1 + (j >> 6), n = 16 + 64 * c, tid = threadIdx.x, nsel = n < 256 ? n : 256;
    __shared__ float sc[TK]; __shared__ int sel[256]; __shared__ float qlat[2048], lg[2048], olat[2048], qa[1024];
    const float* row = SC + sc_off(b, j);
    for (int s = tid; s < n; s += 256) sc[s] = row[s];
    for (int i = tid; i < 1024; i += 256) qa[i] = bf2f(QA[(size_t)t * 1024 + i]);
    __syncthreads();
    for (int s = tid; s < n; s += 256) { const float v = sc[s]; int rank = 0;
        for (int s2 = 0; s2 < n; ++s2) { const float v2 = sc[s2]; rank += (v2 > v || (v2 == v && s2 < s)) ? 1 : 0; }
        if (rank < 256) sel[rank] = s; }
    for (int o = tid; o < 2048; o += 256) { const int h = o >> 8, r = o & 255; const bf16_t* wp = WUK + ((size_t)r * 8 + h) * 128; float a = 0.f;
        for (int d = 0; d < 128; ++d) a += qa[h * 128 + d] * bf2f(wp[d]);
        qlat[o] = a * 0.08838834764831845f; }
    __syncthreads();
    { const int k = tid; if (k < nsel) { const int s = sel[k]; const bf16_t* cp = CKV + ((size_t)b * TK + s) * 256; const int bk = t5_bucket(s - (NMETA + j));
        for (int h = 0; h < 8; ++h) { float a = 0.f; for (int r = 0; r < 256; ++r) a += qlat[h * 256 + r] * bf2f(cp[r]); lg[h * 256 + k] = a + p.rel_bias[bk * 16 + h]; } }
      else for (int h = 0; h < 8; ++h) lg[h * 256 + k] = -INFINITY; }
    __syncthreads();
    if (tid < 8) { const int h = tid; float m = -INFINITY; for (int k = 0; k < nsel; ++k) m = fmaxf(m, lg[h * 256 + k]); float l = 0.f; for (int k = 0; k < nsel; ++k) { const float e = __expf(lg[h * 256 + k] - m); lg[h * 256 + k] = e; l += e; }
                   const float il = 1.f / l; for (int k = 0; k < 256; ++k) lg[h * 256 + k] = (k < nsel) ? lg[h * 256 + k] * il : 0.f; }
    __syncthreads();
    { const int r = tid; float a[8];
#pragma unroll
      for (int h = 0; h < 8; ++h) a[h] = 0.f;
      for (int k = 0; k < nsel; ++k) { const float v = bf2f(CKV[((size_t)b * TK + sel[k]) * 256 + r]);
#pragma unroll
          for (int h = 0; h < 8; ++h) a[h] += lg[h * 256 + k] * v; }
#pragma unroll
      for (int h = 0; h < 8; ++h) olat[h * 256 + r] = a[h]; }
    __syncthreads();
    for (int o = tid; o < 1024; o += 256) { const int h = o >> 7; const bf16_t* wp = WUVT + (size_t)o * 256; float a = 0.f;
        for (int r = 0; r < 256; ++r) a += olat[h * 256 + r] * bf2f(wp[r]);
        OZA[(size_t)t * 1024 + o] = (bf16_t)f2bf(a * bf2f(ZA[(size_t)t * 1024 + o])); }
}

constexpr int LDS_BYTES = 147456;
__global__ void __launch_bounds__(512, 2) k_prologue(Params p) {
    extern __shared__ __attribute__((aligned(16))) unsigned char lds[];
    const int tid = threadIdx.x, lane = tid & 63, wave = __builtin_amdgcn_readfirstlane(tid >> 6);
    phase0(p, (LAS unsigned char*)lds, blockIdx.x * 8 + wave, gridDim.x * 8, wave, lane);
}
__global__ void __launch_bounds__(512, 2) k_inproj(Params p) {
    extern __shared__ __attribute__((aligned(16))) unsigned char lds[];
    SchedInproj S{DM, (int)gridDim.x, (int)blockIdx.x, (const char*)WSP(bf16_t, WS_U), (const char*)WSP(bf16_t, WS_WIN)};
    EpiInproj E{WSP(bf16_t, WS_QA), WSP(bf16_t, WS_ZA), WSP(bf16_t, WS_IQ), WSP(bf16_t, WS_QB), WSP(bf16_t, WS_ZB), WSP(bf16_t, WS_GA), WSP(bf16_t, WS_GB), WSP(bf16_t, WS_KB), WSP(bf16_t, WS_VB),
                WSP(float, WS_CKVRAW), WSP(float, WS_IKRAW), WSP(float, WS_IW), 0.125f * LOG2E};
    pg8::gemm_phase<EpiInproj, SchedInproj>((LAS unsigned char*)lds, S, E);
}
__global__ void __launch_bounds__(512, 2) k_norms(Params p) {
    const int tid = threadIdx.x, lane = tid & 63, wave = __builtin_amdgcn_readfirstlane(tid >> 6);
    phase1b(p, blockIdx.x * 8 + wave, gridDim.x * 8, lane);
}
__global__ void __launch_bounds__(512, 2) k_mix(Params p) {
    extern __shared__ __attribute__((aligned(16))) unsigned char lds[];
    SchedMix S{1024, (int)gridDim.x, (int)blockIdx.x, (const char*)WSP(bf16_t, WS_OZA), (const char*)WSP(bf16_t, WS_WOA), (const char*)WSP(bf16_t, WS_OZB), (const char*)WSP(bf16_t, WS_WOB)};
    EpiMix E{WSP(const bf16_t, WS_GA), WSP(const bf16_t, WS_GB), WSP(bf16_t, WS_MIX)};
    pg8::gemm_phase<EpiMix, SchedMix>((LAS unsigned char*)lds, S, E);
}
__global__ void __launch_bounds__(512, 2) k_out(Params p) {
    extern __shared__ __attribute__((aligned(16))) unsigned char lds[];
    SchedOut S{DM, (int)gridDim.x, (int)blockIdx.x, (const char*)WSP(bf16_t, WS_MIX), (const char*)WSP(bf16_t, WS_WOUT)};
    EpiOut E{WSP(bf16_t, WS_OUTPRE), WSP(float, WS_SSQ)};
    pg8::gemm_phase<EpiOut, SchedOut>((LAS unsigned char*)lds, S, E);
}
__global__ void __launch_bounds__(512, 2) k_final(Params p) {
    const int tid = threadIdx.x, lane = tid & 63, wave = __builtin_amdgcn_readfirstlane(tid >> 6);
    phase7(p, blockIdx.x * 8 + wave, gridDim.x * 8, lane);
}

static void add_job(Params& p, const float* src, bf16_t* dst, int K, int N, int col0, int ncols, int row0) {
    TJob& j = p.jobs[p.njobs++]; j.src = src; j.dst = dst; j.K = K; j.N = N; j.col0 = col0; j.nblk = (ncols + 31) / 32; j.row0 = row0; j.item0 = p.nitems; p.nitems += (K / 64) * j.nblk;
}
extern "C" void kernel_launch(void* const* d_in, const int* in_sizes, int n_in, void* d_out, int out_size, void* d_ws, size_t ws_size, hipStream_t stream) {
    if (n_in != 16 || ws_size < WS_END) { fprintf(stderr, "kernel_launch: unexpected arguments (n_in %d, ws %zu)\n", n_in, ws_size); return; }
    static bool attr_done = false;
    if (!attr_done) {
        (void)hipFuncSetAttribute((const void*)k_prologue, hipFuncAttributeMaxDynamicSharedMemorySize, LDS_BYTES);
        (void)hipFuncSetAttribute((const void*)k_inproj, hipFuncAttributeMaxDynamicSharedMemorySize, LDS_BYTES);
        (void)hipFuncSetAttribute((const void*)k_mix, hipFuncAttributeMaxDynamicSharedMemorySize, LDS_BYTES);
        (void)hipFuncSetAttribute((const void*)k_out, hipFuncAttributeMaxDynamicSharedMemorySize, LDS_BYTES);
        attr_done = true;
    }
    Params p; memset(&p, 0, sizeof(p));
    const float** in = (const float**)d_in;
    p.x = in[0]; p.meta = in[1]; p.rel_bias = in[2]; p.pre_w = in[3]; p.w_in = in[4]; p.kv_norm_w = in[5]; p.w_uk = in[6]; p.w_uv = in[7]; p.ikn_w = in[8]; p.ikn_b = in[9];
    p.lam_p = in[10]; p.subln_w = in[11]; p.w_o_a = in[12]; p.w_o_b = in[13]; p.w_out = in[14]; p.post_w = in[15];
    p.out = (float*)d_out; p.ws = (unsigned char*)d_ws;
    bf16_t* WIN = (bf16_t*)(p.ws + WS_WIN);
    const int NIN = 11600;
    add_job(p, p.w_in, WIN, DM, NIN, 0, 1024, 0);
    add_job(p, p.w_in, WIN, DM, NIN, 1280, 1024, 1024);
    add_job(p, p.w_in, WIN, DM, NIN, 2304, 1024, 2048);
    add_job(p, p.w_in, WIN, DM, NIN, 3408, 1024, 3072);
    add_job(p, p.w_in, WIN, DM, NIN, 6480, 1024, 4096);
    add_job(p, p.w_in, WIN, DM, NIN, 7504, 2048, 5120);
    add_job(p, p.w_in, WIN, DM, NIN, 9552, 2048, 7168);
    add_job(p, p.w_in, WIN, DM, NIN, 4432, 1024, 9216);
    add_job(p, p.w_in, WIN, DM, NIN, 5456, 1024, 10240);
    add_job(p, p.w_in, WIN, DM, NIN, 1024, 256, 11264);
    add_job(p, p.w_in, WIN, DM, NIN, 3328, 64, 11520);
    add_job(p, p.w_in, WIN, DM, NIN, 3392, 32, 11584);
    add_job(p, p.w_o_a, (bf16_t*)(p.ws + WS_WOA), 1024, DM, 0, DM, 0);
    add_job(p, p.w_o_b, (bf16_t*)(p.ws + WS_WOB), 1024, DM, 0, DM, 0);
    add_job(p, p.w_out, (bf16_t*)(p.ws + WS_WOUT), DM, DM, 0, DM, 0);
    add_job(p, p.w_uv, (bf16_t*)(p.ws + WS_WUVT), 256, 1024, 0, 1024, 0);
    hipLaunchKernelGGL(k_prologue, dim3(256), dim3(512), LDS_BYTES, stream, p);
    hipLaunchKernelGGL(k_inproj, dim3(256), dim3(512), LDS_BYTES, stream, p);
    hipLaunchKernelGGL(k_norms, dim3(256), dim3(512), 0, stream, p);
    hipLaunchKernelGGL(naive_scores, dim3(MTOK), dim3(256), 0, stream, p);
    hipLaunchKernelGGL(naive_diff, dim3(MTOK * 8), dim3(256), 0, stream, p);
    hipLaunchKernelGGL(naive_dsa, dim3(MTOK), dim3(256), 0, stream, p);
    hipLaunchKernelGGL(k_mix, dim3(256), dim3(512), LDS_BYTES, stream, p);
    hipLaunchKernelGGL(k_out, dim3(256), dim3(512), LDS_BYTES, stream, p);
    hipLaunchKernelGGL(k_final, dim3(256), dim3(512), 0, stream, p);
}
```

```cpp
#include <hip/hip_runtime.h>
#include <cstdio>
#include <cstdint>
#include <cstring>

#ifndef PROBE_REP
#define PROBE_REP (-1)
#endif
#define LAS __attribute__((address_space(3)))
#define GAS __attribute__((address_space(1)))
typedef unsigned short bf16_t;
typedef short bf16x8 __attribute__((ext_vector_type(8)));
typedef float f32x4 __attribute__((ext_vector_type(4)));
typedef unsigned u32x4 __attribute__((ext_vector_type(4)));
typedef unsigned u32x2 __attribute__((ext_vector_type(2)));

constexpr int DM = 2048, NB = 2, SEQ = 4096, NMETA = 16, TK = SEQ + NMETA  , MTOK = NB * SEQ  , MKEY = NB * TK  ;
constexpr int UROWS = 8448;
constexpr int NPAD = 11776;
constexpr float EPS = 1e-6f;
constexpr float LOG2E = 1.4426950408889634f;
constexpr size_t SC_PER_B = 8585216;

constexpr size_t MiB = 1u << 20;
constexpr size_t WS_CTL = 0, CTL_BYTES = 1 * MiB;
constexpr size_t WS_U = 1 * MiB;
constexpr size_t WS_WIN = 34 * MiB;
constexpr size_t WS_SC = 1 * MiB;
constexpr size_t WS_MIX = 1 * MiB;
constexpr size_t WS_WOA = 80 * MiB, WS_WOB = 84 * MiB, WS_WOUT = 88 * MiB, WS_WUK = 96 * MiB, WS_WUVT = 96 * MiB + 512 * 1024;
constexpr size_t WS_QA = 97 * MiB, WS_IQ = 113 * MiB, WS_QB = 129 * MiB, WS_ZA = 145 * MiB, WS_ZB = 161 * MiB, WS_GA = 177 * MiB, WS_GB = 209 * MiB;
constexpr size_t WS_OLAT = 241 * MiB;
constexpr size_t WS_OZA = 129 * MiB;
constexpr size_t WS_KB = 241 * MiB, WS_VB = 258 * MiB, WS_CKVRAW = 275 * MiB, WS_IKRAW = 284 * MiB, WS_IW = 287 * MiB, WS_CKV = 288 * MiB, WS_IK = 293 * MiB;
constexpr size_t WS_QLAT = 295 * MiB;
constexpr size_t WS_OUTPRE = 295 * MiB;
constexpr size_t WS_OZB = 327 * MiB, WS_SSQ = 343 * MiB, WS_END = 344 * MiB;

__device__ __forceinline__ int opaque_tid() { int t = threadIdx.x; asm volatile("" : "+v"(t)); return t; }
__device__ __forceinline__ float bf2f(unsigned short u) { return __uint_as_float(((unsigned)u) << 16); }
__device__ __forceinline__ unsigned f2bf(float f) { unsigned u = __float_as_uint(f); return (u + 0x7fffu + ((u >> 16) & 1u)) >> 16; }
__device__ __forceinline__ unsigned pk2(float lo, float hi) { return f2bf(lo) | (f2bf(hi) << 16); }
__device__ __forceinline__ float bflo(unsigned w) { return __uint_as_float(w << 16); }
__device__ __forceinline__ float bfhi(unsigned w) { return __uint_as_float(w & 0xffff0000u); }
__device__ __forceinline__ float wave_sum(float v) {
#pragma unroll
    for (int o = 1; o < 64; o <<= 1) v += __shfl_xor(v, o);
    return v;
}
__device__ __forceinline__ float silu_f(float x) { return x * __builtin_amdgcn_rcpf(1.f + __expf(-x)); }
__device__ __forceinline__ int t5_bucket(int rel) {
    const int n = rel < 0 ? -rel : rel; int f;
    if (n < 8) f = n; else if (n < 12) f = 8; else if (n < 16) f = 9; else if (n < 23) f = 10; else if (n < 32) f = 11; else if (n < 46) f = 12; else if (n < 64) f = 13; else if (n < 91) f = 14; else f = 15;
    return (rel > 0 ? 16 : 0) + f;
}
__device__ __forceinline__ size_t sc_off(int b, int j) {
    const int c = 1 + (j >> 6);
    return (size_t)b * SC_PER_B + (size_t)1024 * (c - 1) + (size_t)2048 * (c - 1) * c + (size_t)(j & 63) * (16 + 64 * c);
}

namespace pg8 {
constexpr int BM = 256, BK = 64, HALF = 128, HTB = HALF * BK * 2, STAGE_BYTES = 8 * HTB, NXCD = 8, WGM = 8;
__host__ __device__ __forceinline__ int lds_byte(int r, int c) { const int st = (r >> 4) * 2 + (c >> 5), rr = r & 15, cc = c & 31, ob = rr * 64 + cc * 2; return st * 1024 + (ob ^ (((ob >> 9) & 1) << 5)); }
__host__ __device__ __forceinline__ void stage_rc(int b, int& R, int& C) { const int st = b / 1024, sb = b % 1024, swz = sb ^ (((sb >> 9) & 1) << 5); R = (st >> 1) * 16 + swz / 64; C = (st & 1) * 32 + (swz % 64) / 2; }
__host__ __device__ __forceinline__ int perm32(int rho) { const int n = rho >> 4, i = rho & 15; return 8 * (i >> 2) + 4 * n + (i & 3); }

struct Unit { int pm, pn, sub; };
__device__ __forceinline__ unsigned cvt_pk_bf16(float lo, float hi) { unsigned r; asm volatile("v_cvt_pk_bf16_f32 %0, %1, %2" : "=v"(r) : "v"(lo), "v"(hi)); return r; }

__device__ __forceinline__ void tile_of(int L, int nM, int nN, int& pm, int& pn) {
    const int nwg = nM * nN; int wgid = L; { const int q = nwg / NXCD, r = nwg % NXCD, xcd = wgid % NXCD, off = wgid / NXCD; wgid = (xcd < r ? xcd * (q + 1) : r * (q + 1) + (xcd - r) * q) + off; }
    const int nig = WGM * nN, gid = wgid / nig, fm = gid * WGM, gsz = (nM - fm) < WGM ? (nM - fm) : WGM;
    pm = fm + ((wgid % nig) % gsz); pn = (wgid % nig) / gsz;
}

template <class Epi, class Sched, bool ALIGN_EPI = true, bool SP2 = true>
__device__ __forceinline__ void gemm_phase(LAS unsigned char* lds, const Sched& S, const Epi& E) {
    const int tid = opaque_tid(), wid = __builtin_amdgcn_readfirstlane(tid >> 6), lane = tid & 63, wr = wid >> 2, wc = wid & 3, fr = lane & 15, fq = lane >> 4;
    const int K = S.K, nt = K / BK;
    unsigned voffA[2], voffB[2];
#pragma unroll
    for (int i = 0; i < 2; ++i) { int R, C; stage_rc(tid * 16 + i * 8192, R, C); const int Rb = Epi::PERM ? ((R & ~31) + perm32(R & 31)) : R;
        voffA[i] = (unsigned)(R * K + C) * 2u; voffB[i] = (unsigned)(Rb * K + C) * 2u; }
    const size_t kstep = (size_t)(BK * 2);
    const size_t hstep = (size_t)HALF * K * 2;
    const unsigned ldsw = (unsigned)wid * 1024u;
    const int aoff = lds_byte(wr * 64 + fr, fq * 8), boff = lds_byte(wc * 32 + fr, fq * 8);
#define PG8_SA(b, h) (((b) * 2 + (h)) * HTB)
#define PG8_SB(b, h) ((4 + (b) * 2 + (h)) * HTB)
#define PG8_STAGE(bufoff, gbase, voff) do { _Pragma("unroll") for (int _i = 0; _i < 2; ++_i) \
        __builtin_amdgcn_global_load_lds((const unsigned*)((const char*)(gbase) + (voff)[_i]), (LAS unsigned*)(lds + (bufoff) + ldsw + _i * 8192), 16, 0, 0); } while (0)
#define PG8_LDA(dst, b, h) do { _Pragma("unroll") for (int m = 0; m < 4; ++m) _Pragma("unroll") for (int k = 0; k < 2; ++k) dst[m][k] = *(const LAS bf16x8*)(lds + PG8_SA(b, h) + aoff + m * 2048 + k * 1024); } while (0)
#define PG8_LDB(dst, b, h) do { _Pragma("unroll") for (int n = 0; n < 2; ++n) _Pragma("unroll") for (int k = 0; k < 2; ++k) dst[n][k] = *(const LAS bf16x8*)(lds + PG8_SB(b, h) + boff + n * 2048 + k * 1024); } while (0)
#define PG8_MMA(ai, bj, At, Bt) do { __builtin_amdgcn_s_setprio(1); _Pragma("unroll") for (int m = 0; m < 4; ++m) _Pragma("unroll") for (int n = 0; n < 2; ++n) _Pragma("unroll") for (int k = 0; k < 2; ++k) \
        acc[ai][bj][m][n] = __builtin_amdgcn_mfma_f32_16x16x32_bf16(Bt[n][k], At[m][k], acc[ai][bj][m][n], 0, 0, 0); __builtin_amdgcn_s_setprio(0); } while (0)
#define PG8_WAIT_V(n) asm volatile("s_waitcnt vmcnt(" #n ")" ::: "memory")
#define PG8_WAIT_L(n) asm volatile("s_waitcnt lgkmcnt(" #n ")" ::: "memory")
#define PG8_BAR __builtin_amdgcn_s_barrier()
#define PG8_SCHED __builtin_amdgcn_sched_barrier(0)
    Unit cur, nxt; int ui = 0;
    if (!S.next(0, cur)) return;
    f32x4 acc[2][2][4][2];
#pragma unroll
    for (int a = 0; a < 2; ++a)
#pragma unroll
        for (int b = 0; b < 2; ++b)
#pragma unroll
            for (int m = 0; m < 4; ++m)
#pragma unroll
                for (int n = 0; n < 2; ++n) acc[a][b][m][n] = (f32x4){0.f, 0.f, 0.f, 0.f};
    bf16x8 At[4][2], B0[2][2], B1[2][2];
    const char* cA = S.a_ptr(cur); const char* cB = S.b_ptr(cur);
    if constexpr (SP2) {
        PG8_STAGE(PG8_SB(0, 0), cB, voffB); PG8_STAGE(PG8_SB(0, 1), cB + hstep, voffB); PG8_STAGE(PG8_SA(0, 0), cA, voffA); PG8_STAGE(PG8_SA(0, 1), cA + hstep, voffA);
        if (wr == 1) PG8_BAR;
        PG8_WAIT_V(2); PG8_BAR;
        PG8_STAGE(PG8_SB(1, 0), cB + kstep, voffB); PG8_STAGE(PG8_SA(1, 0), cA + kstep, voffA); PG8_STAGE(PG8_SB(1, 1), cB + hstep + kstep, voffB);
        PG8_WAIT_V(6); PG8_BAR;
    } else {
        PG8_STAGE(PG8_SB(0, 0), cB, voffB); PG8_STAGE(PG8_SA(0, 0), cA, voffA); PG8_STAGE(PG8_SB(0, 1), cB + hstep, voffB); PG8_STAGE(PG8_SA(0, 1), cA + hstep, voffA);
        if (wr == 1) PG8_BAR;
        PG8_WAIT_V(4); PG8_BAR;
        PG8_STAGE(PG8_SB(1, 0), cB + kstep, voffB); PG8_STAGE(PG8_SA(1, 0), cA + kstep, voffA); PG8_STAGE(PG8_SB(1, 1), cB + hstep + kstep, voffB);
        PG8_WAIT_V(6); PG8_BAR;
    }
    for (;;) {
        const bool has_next = S.next(ui + 1, nxt);
        const char* nA = has_next ? S.a_ptr(nxt) : cA; const char* nB = has_next ? S.b_ptr(nxt) : cB;
        for (int t = 0; t < nt; t += 2) {
            const bool last = (t == nt - 2);
            const char* a1 = cA + (size_t)(t + 1) * kstep;
            const char* a2 = last ? nA : cA + (size_t)(t + 2) * kstep; const char* b2 = last ? nB : cB + (size_t)(t + 2) * kstep;
            const char* a3 = a2 + kstep; const char* b3 = b2 + kstep;
            if constexpr (SP2) {
            PG8_LDB(B0, 0, 0); PG8_LDB(B1, 0, 1); PG8_SCHED; PG8_LDA(At, 0, 0); PG8_STAGE(PG8_SA(1, 1), a1 + hstep, voffA);
            PG8_WAIT_V(8); PG8_WAIT_L(0); PG8_BAR; PG8_MMA(0, 0, At, B0); PG8_MMA(0, 1, At, B1); PG8_BAR; PG8_SCHED;
            PG8_LDA(At, 0, 1); PG8_STAGE(PG8_SB(0, 0), b2, voffB); PG8_STAGE(PG8_SB(0, 1), b2 + hstep, voffB); PG8_STAGE(PG8_SA(0, 0), a2, voffA);
            PG8_WAIT_V(8); PG8_WAIT_L(0); PG8_BAR; PG8_MMA(1, 0, At, B0); PG8_MMA(1, 1, At, B1); PG8_BAR; PG8_SCHED;
            PG8_LDB(B0, 1, 0); PG8_LDB(B1, 1, 1); PG8_SCHED; PG8_LDA(At, 1, 0); PG8_STAGE(PG8_SA(0, 1), a2 + hstep, voffA);
            PG8_WAIT_V(8); PG8_WAIT_L(0); PG8_BAR; PG8_MMA(0, 0, At, B0); PG8_MMA(0, 1, At, B1); PG8_BAR; PG8_SCHED;
            PG8_LDA(At, 1, 1); PG8_STAGE(PG8_SB(1, 0), b3, voffB); PG8_STAGE(PG8_SB(1, 1), b3 + hstep, voffB); PG8_STAGE(PG8_SA(1, 0), a3, voffA);
            PG8_WAIT_V(8); PG8_WAIT_L(0); PG8_BAR; PG8_MMA(1, 0, At, B0); PG8_MMA(1, 1, At, B1); PG8_BAR; PG8_SCHED;
            } else {
            PG8_LDB(B0, 0, 0); PG8_SCHED; PG8_LDA(At, 0, 0); PG8_STAGE(PG8_SA(1, 1), a1 + hstep, voffA);
            PG8_WAIT_L(8); PG8_BAR; PG8_WAIT_L(0); PG8_MMA(0, 0, At, B0); PG8_BAR; PG8_SCHED;
            PG8_LDB(B1, 0, 1); PG8_STAGE(PG8_SB(0, 0), b2, voffB);
            PG8_BAR; PG8_WAIT_L(0); PG8_MMA(0, 1, At, B1); PG8_BAR;
            PG8_LDA(At, 0, 1); PG8_STAGE(PG8_SA(0, 0), a2, voffA);
            PG8_BAR; PG8_WAIT_L(0); PG8_MMA(1, 0, At, B0); PG8_BAR; PG8_SCHED;
            PG8_STAGE(PG8_SB(0, 1), b2 + hstep, voffB);
            PG8_WAIT_V(6); PG8_BAR; PG8_MMA(1, 1, At, B1); PG8_BAR;
            PG8_LDB(B0, 1, 0); PG8_SCHED; PG8_LDA(At, 1, 0); PG8_STAGE(PG8_SA(0, 1), a2 + hstep, voffA);
            PG8_WAIT_L(8); PG8_BAR; PG8_WAIT_L(0); PG8_MMA(0, 0, At, B0); PG8_BAR; PG8_SCHED;
            PG8_LDB(B1, 1, 1); PG8_STAGE(PG8_SB(1, 0), b3, voffB);
            PG8_BAR; PG8_WAIT_L(0); PG8_MMA(0, 1, At, B1); PG8_BAR;
            PG8_LDA(At, 1, 1); PG8_STAGE(PG8_SA(1, 0), a3, voffA);
            PG8_BAR; PG8_WAIT_L(0); PG8_MMA(1, 0, At, B0); PG8_BAR; PG8_SCHED;
            PG8_STAGE(PG8_SB(1, 1), b3 + hstep, voffB);
            PG8_WAIT_V(6); PG8_BAR; PG8_MMA(1, 1, At, B1); PG8_BAR;
            }
        }
        if constexpr (ALIGN_EPI) { if (wr == 0) PG8_BAR; }
        E(acc, cur, wr, wc, fr, fq);
        if (!has_next) break;
        if (!E.keep_acc(cur)) {
#pragma unroll
        for (int a = 0; a < 2; ++a)
#pragma unroll
            for (int b = 0; b < 2; ++b)
#pragma unroll
                for (int m = 0; m < 4; ++m)
#pragma unroll
                    for (int n = 0; n < 2; ++n) acc[a][b][m][n] = (f32x4){0.f, 0.f, 0.f, 0.f};
        }
        cur = nxt; cA = nA; cB = nB; ++ui;
        if constexpr (ALIGN_EPI) { if (wr == 1) PG8_BAR; }
    }
    PG8_WAIT_V(0);
    if constexpr (!ALIGN_EPI) { if (wr == 0) PG8_BAR; }
    PG8_BAR;
#undef PG8_SA
#undef PG8_SB
#undef PG8_STAGE
#undef PG8_LDA
#undef PG8_LDB
#undef PG8_MMA
#undef PG8_WAIT_V
#undef PG8_WAIT_L
#undef PG8_BAR
#undef PG8_SCHED
}
}

struct SchedInproj {
    int K, G, c; const char* A; const char* B;
    __device__ __forceinline__ bool next(int i, pg8::Unit& u) const {
        const int L = i * G + c; u.sub = 0;
        if (L < 1472) { pg8::tile_of(L, 32, 46, u.pm, u.pn); return true; }
        if (L < 1482) { u.pm = 32; u.pn = 36 + (L - 1472); return true; }
        return false;
    }
    __device__ __forceinline__ const char* a_ptr(const pg8::Unit& u) const { return A + (size_t)u.pm * 256 * K * 2; }
    __device__ __forceinline__ const char* b_ptr(const pg8::Unit& u) const { return B + (size_t)u.pn * 256 * K * 2; }
};
struct EpiInproj {
    static constexpr bool PERM = true;
    bf16_t *QA, *ZA, *IQ, *QB, *ZB, *GA, *GB, *KB, *VB; float *CKVRAW; bf16_t* IKN; float* IW; float qb_scale; const float *ikn_w, *ikn_b;
    __device__ __forceinline__ bool keep_acc(const pg8::Unit&) const { return false; }
    __device__ __forceinline__ void operator()(f32x4 (&acc)[2][2][4][2], const pg8::Unit& u, int wr, int wc, int fr, int fq) const {
        const int pn = u.pn;
        if (pn < 44) {
            bf16_t* base; int ldc = 1024, ct, act = 0; bool kside = false;
            if (pn < 4) { base = QA; ct = pn; } else if (pn < 8) { base = ZA; ct = pn - 4; act = 1; } else if (pn < 12) { base = IQ; ct = pn - 8; }
            else if (pn < 16) { base = QB; ct = pn - 12; act = 2; } else if (pn < 20) { base = ZB; ct = pn - 16; act = 1; }
            else if (pn < 28) { base = GA; ct = pn - 20; ldc = 2048; } else if (pn < 36) { base = GB; ct = pn - 28; ldc = 2048; }
            else if (pn < 40) { base = KB; ct = pn - 36; kside = true; } else { base = VB; ct = pn - 40; kside = true; }
            const float sc = (act == 2) ? qb_scale : 1.f;
#pragma unroll
            for (int ai = 0; ai < 2; ++ai)
#pragma unroll
                for (int m = 0; m < 4; ++m) {
                    const int r = u.pm * 256 + ai * 128 + wr * 64 + m * 16 + fr;
                    long drow = r, drow2 = -1; bool ok = true;
                    if (kside) { if (r < MTOK) drow = (long)(r >> 12) * TK + NMETA + (r & 4095); else { const int i = r - MTOK; ok = i < NMETA; drow = i; drow2 = TK + i; } }
#pragma unroll
                    for (int bj = 0; bj < 2; ++bj) {
                        f32x4 v0 = acc[ai][bj][m][0], v1 = acc[ai][bj][m][1];
                        if (act == 1) {
#pragma unroll
                            for (int e = 0; e < 4; ++e) { v0[e] = silu_f(v0[e]); v1[e] = silu_f(v1[e]); }
                        }
                        v0 = v0 * sc; v1 = v1 * sc;
                        u32x4 w; w.x = pg8::cvt_pk_bf16(v0[0], v0[1]); w.y = pg8::cvt_pk_bf16(v0[2], v0[3]); w.z = pg8::cvt_pk_bf16(v1[0], v1[1]); w.w = pg8::cvt_pk_bf16(v1[2], v1[3]);
                        const int col = ct * 256 + bj * 128 + wc * 32 + 8 * fq;
                        if (ok) { *(u32x4*)(base + (size_t)drow * ldc + col) = w; if (drow2 >= 0) *(u32x4*)(base + (size_t)drow2 * ldc + col) = w; }
                    }
                }
        } else {
#pragma unroll
            for (int ai = 0; ai < 2; ++ai)
#pragma unroll
                for (int m = 0; m < 4; ++m) {
                    const int r = u.pm * 256 + ai * 128 + wr * 64 + m * 16 + fr;
                    long drow, drow2 = -1; bool ok = true;
                    if (r < MTOK) drow = (long)(r >> 12) * TK + NMETA + (r & 4095); else { const int i = r - MTOK; ok = i < NMETA; drow = i; drow2 = TK + i; }
                    if (pn == 44) {
#pragma unroll
                        for (int bj = 0; bj < 2; ++bj) {
                            const f32x4 v0 = acc[ai][bj][m][0], v1 = acc[ai][bj][m][1];
                            const int col = bj * 128 + wc * 32 + 8 * fq;
                            if (ok) { float* p = CKVRAW + (size_t)drow * 256 + col; *(f32x4*)p = v0; *(f32x4*)(p + 4) = v1;
                                      if (drow2 >= 0) { float* p2 = CKVRAW + (size_t)drow2 * 256 + col; *(f32x4*)p2 = v0; *(f32x4*)(p2 + 4) = v1; } }
                        }
                    } else if (wc == 0) {
                        const f32x4 a0 = acc[ai][0][m][0], a1 = acc[ai][0][m][1], b0 = acc[ai][1][m][0], b1 = acc[ai][1][m][1];
                        float s = ((a0[0] + a0[1]) + (a0[2] + a0[3])) + ((a1[0] + a1[1]) + (a1[2] + a1[3])) + ((b0[0] + b0[1]) + (b0[2] + b0[3])) + ((b1[0] + b1[1]) + (b1[2] + b1[3]));
                        s += __shfl_xor(s, 16); s += __shfl_xor(s, 32);
                        const float mu = s * (1.f / 64.f);
                        const f32x4 da0 = a0 - mu, da1 = a1 - mu, db0 = b0 - mu, db1 = b1 - mu;
                        float q = ((da0[0] * da0[0] + da0[1] * da0[1]) + (da0[2] * da0[2] + da0[3] * da0[3])) + ((da1[0] * da1[0] + da1[1] * da1[1]) + (da1[2] * da1[2] + da1[3] * da1[3]))
                                + ((db0[0] * db0[0] + db0[1] * db0[1]) + (db0[2] * db0[2] + db0[3] * db0[3])) + ((db1[0] * db1[0] + db1[1] * db1[1]) + (db1[2] * db1[2] + db1[3] * db1[3]));
                        q += __shfl_xor(q, 16); q += __shfl_xor(q, 32);
                        const float rs = rsqrtf(q * (1.f / 64.f) + EPS);
                        const f32x4 wa0 = *(const f32x4*)(ikn_w + 8 * fq), wa1 = *(const f32x4*)(ikn_w + 8 * fq + 4), wb0 = *(const f32x4*)(ikn_w + 32 + 8 * fq), wb1 = *(const f32x4*)(ikn_w + 36 + 8 * fq);
                        const f32x4 ba0 = *(const f32x4*)(ikn_b + 8 * fq), ba1 = *(const f32x4*)(ikn_b + 8 * fq + 4), bb0 = *(const f32x4*)(ikn_b + 32 + 8 * fq), bb1 = *(const f32x4*)(ikn_b + 36 + 8 * fq);
                        const f32x4 ya0 = da0 * rs * wa0 + ba0, ya1 = da1 * rs * wa1 + ba1, yb0 = db0 * rs * wb0 + bb0, yb1 = db1 * rs * wb1 + bb1;
                        u32x4 pa, pb;
                        pa.x = pg8::cvt_pk_bf16(ya0[0], ya0[1]); pa.y = pg8::cvt_pk_bf16(ya0[2], ya0[3]); pa.z = pg8::cvt_pk_bf16(ya1[0], ya1[1]); pa.w = pg8::cvt_pk_bf16(ya1[2], ya1[3]);
                        pb.x = pg8::cvt_pk_bf16(yb0[0], yb0[1]); pb.y = pg8::cvt_pk_bf16(yb0[2], yb0[3]); pb.z = pg8::cvt_pk_bf16(yb1[0], yb1[1]); pb.w = pg8::cvt_pk_bf16(yb1[2], yb1[3]);
                        if (ok) { *(u32x4*)(IKN + (size_t)drow * 64 + 8 * fq) = pa; *(u32x4*)(IKN + (size_t)drow * 64 + 32 + 8 * fq) = pb;
                                  if (drow2 >= 0) { *(u32x4*)(IKN + (size_t)drow2 * 64 + 8 * fq) = pa; *(u32x4*)(IKN + (size_t)drow2 * 64 + 32 + 8 * fq) = pb; } }
                    } else if (wc == 1) {
                        const f32x4 v0 = acc[ai][0][m][0], v1 = acc[ai][0][m][1];
                        if (fq < 2 && r < MTOK) { float* p = IW + (size_t)r * 16 + 8 * fq; *(f32x4*)p = v0 * 0.03125f; *(f32x4*)(p + 4) = v1 * 0.03125f; }
                    }
                }
        }
    }
};
struct SchedMix {
    int K, G, c; const char *A0, *B0, *A1, *B1;
    __device__ __forceinline__ bool next(int i, pg8::Unit& u) const {
        const int L = (i >> 1) * G + c; if (L >= 256) return false;
        pg8::tile_of(L, 32, 8, u.pm, u.pn); u.sub = i & 1; return true;
    }
    __device__ __forceinline__ const char* a_ptr(const pg8::Unit& u) const { return (u.sub ? A1 : A0) + (size_t)u.pm * 256 * K * 2; }
    __device__ __forceinline__ const char* b_ptr(const pg8::Unit& u) const { return (u.sub ? B1 : B0) + (size_t)u.pn * 256 * K * 2; }
};
struct EpiMix {
    static constexpr bool PERM = true;
    const bf16_t *GA, *GB; bf16_t* MIX;
    __device__ __forceinline__ bool keep_acc(const pg8::Unit& u) const { return u.sub == 0; }
    __device__ __forceinline__ void operator()(f32x4 (&acc)[2][2][4][2], const pg8::Unit& u, int wr, int wc, int fr, int fq) const {
#pragma unroll
        for (int ai = 0; ai < 2; ++ai)
#pragma unroll
            for (int m = 0; m < 4; ++m) {
                const int r = u.pm * 256 + ai * 128 + wr * 64 + m * 16 + fr;
#pragma unroll
                for (int bj = 0; bj < 2; ++bj) {
                    const int col = u.pn * 256 + bj * 128 + wc * 32 + 8 * fq;
                    const u32x4 ga = *(const u32x4*)(GA + (size_t)r * DM + col), gb = *(const u32x4*)(GB + (size_t)r * DM + col);
                    float f[8];
#pragma unroll
                    for (int e = 0; e < 4; ++e) {
                        const unsigned wa = ga[e], wb = gb[e];
#pragma unroll
                        for (int hl = 0; hl < 2; ++hl) {
                            float a = hl ? bfhi(wa) : bflo(wa), b = hl ? bfhi(wb) : bflo(wb);
                            a = fminf(fmaxf(a, -30.f), 30.f); b = fminf(fmaxf(b, -30.f), 30.f);
                            const float ea = __expf(-a), eb = __expf(-b);
                            f[2 * e + hl] = (u.sub == 0) ? (1.f + eb) * __builtin_amdgcn_rcpf(1.f + ea) : __builtin_amdgcn_rcpf(1.f + eb);
                        }
                    }
                    f32x4 v0 = acc[ai][bj][m][0], v1 = acc[ai][bj][m][1];
#pragma unroll
                    for (int e = 0; e < 4; ++e) { v0[e] *= f[e]; v1[e] *= f[4 + e]; }
                    if (u.sub == 0) { acc[ai][bj][m][0] = v0; acc[ai][bj][m][1] = v1; }
                    else { u32x4 w; w.x = pg8::cvt_pk_bf16(v0[0], v0[1]); w.y = pg8::cvt_pk_bf16(v0[2], v0[3]); w.z = pg8::cvt_pk_bf16(v1[0], v1[1]); w.w = pg8::cvt_pk_bf16(v1[2], v1[3]);
                           *(u32x4*)(MIX + (size_t)r * DM + col) = w; }
                }
            }
    }
};
struct SchedOut {
    int K, G, c; const char *A, *B;
    __device__ __forceinline__ bool next(int i, pg8::Unit& u) const { const int L = i * G + c; if (L >= 256) return false; pg8::tile_of(L, 32, 8, u.pm, u.pn); u.sub = 0; return true; }
    __device__ __forceinline__ const char* a_ptr(const pg8::Unit& u) const { return A + (size_t)u.pm * 256 * K * 2; }
    __device__ __forceinline__ const char* b_ptr(const pg8::Unit& u) const { return B + (size_t)u.pn * 256 * K * 2; }
};
struct EpiOut {
    static constexpr bool PERM = true;
    bf16_t* OUTPRE; float* SSQ;
    __device__ __forceinline__ bool keep_acc(const pg8::Unit&) const { return false; }
    __device__ __forceinline__ void operator()(f32x4 (&acc)[2][2][4][2], const pg8::Unit& u, int wr, int wc, int fr, int fq) const {
#pragma unroll
        for (int ai = 0; ai < 2; ++ai)
#pragma unroll
            for (int m = 0; m < 4; ++m) {
                const int r = u.pm * 256 + ai * 128 + wr * 64 + m * 16 + fr; float ss = 0.f;
#pragma unroll
                for (int bj = 0; bj < 2; ++bj) {
                    const f32x4 v0 = acc[ai][bj][m][0], v1 = acc[ai][bj][m][1];
                    ss += (v0[0] * v0[0] + v0[1] * v0[1]) + (v0[2] * v0[2] + v0[3] * v0[3]) + (v1[0] * v1[0] + v1[1] * v1[1]) + (v1[2] * v1[2] + v1[3] * v1[3]);
                    u32x4 w; w.x = pg8::cvt_pk_bf16(v0[0], v0[1]); w.y = pg8::cvt_pk_bf16(v0[2], v0[3]); w.z = pg8::cvt_pk_bf16(v1[0], v1[1]); w.w = pg8::cvt_pk_bf16(v1[2], v1[3]);
                    *(u32x4*)(OUTPRE + (size_t)r * DM + u.pn * 256 + bj * 128 + wc * 32 + 8 * fq) = w;
                }
                ss += __shfl_xor(ss, 16); ss += __shfl_xor(ss, 32);
                if (fq == 0) SSQ[(size_t)r * 32 + u.pn * 4 + wc] = ss;
            }
    }
};

struct TJob { const float* src; bf16_t* dst; int K, N, col0, nblk, row0, item0; };
struct Params {
    const float *x, *meta, *rel_bias, *pre_w, *w_in, *kv_norm_w, *w_uk, *w_uv, *ikn_w, *ikn_b, *lam_p, *subln_w, *w_o_a, *w_o_b, *w_out, *post_w;
    float* out; unsigned char* ws;
    TJob jobs[17]; int njobs, nitems;
};
#define WSP(T, off) ((T*)(p.ws + (off)))

__device__ __forceinline__ void p0_transpose_item(const TJob& jb, LAS float* scr, int item, int lane) {
    const int kb = item / jb.nblk, nb = item % jb.nblk, k0 = 64 * kb, n0 = jb.col0 + 32 * nb;
#pragma unroll 8
    for (int i = 0; i < 32; ++i) { const int kk = 2 * i + (lane >> 5); scr[kk * 33 + (lane & 31)] = jb.src[(size_t)(k0 + kk) * jb.N + n0 + (lane & 31)]; }
    asm volatile("s_waitcnt lgkmcnt(0)" ::: "memory");
    const int c = lane & 7;
#pragma unroll
    for (int j = 0; j < 4; ++j) { const int n = (lane >> 3) + 8 * j; const LAS float* s = scr + (8 * c) * 33 + n;
        u32x4 o; o.x = pk2(s[0 * 33], s[1 * 33]); o.y = pk2(s[2 * 33], s[3 * 33]); o.z = pk2(s[4 * 33], s[5 * 33]); o.w = pk2(s[6 * 33], s[7 * 33]);
        *(u32x4*)(jb.dst + (size_t)(jb.row0 + 32 * nb + n) * jb.K + k0 + 8 * c) = o; }
    asm volatile("s_waitcnt lgkmcnt(0)" ::: "memory");
}
__device__ __forceinline__ void p0_norm_row(const float* xrow, const float* g, bf16_t* orow, int lane) {
    const f32x4* xr = (const f32x4*)xrow + lane; const f32x4* gr = (const f32x4*)g + lane;
    f32x4 v[8]; float s = 0.f;
#pragma unroll
    for (int j = 0; j < 8; ++j) { v[j] = xr[64 * j]; s += (v[j].x * v[j].x + v[j].y * v[j].y) + (v[j].z * v[j].z + v[j].w * v[j].w); }
    const float rstd = rsqrtf(wave_sum(s) * (1.f / DM) + EPS);
    u32x2* o8 = (u32x2*)orow + lane;
#pragma unroll
    for (int j = 0; j < 8; ++j) { const f32x4 gg = gr[64 * j]; u32x2 w; w.x = pk2(v[j].x * rstd * gg.x, v[j].y * rstd * gg.y); w.y = pk2(v[j].z * rstd * gg.z, v[j].w * rstd * gg.w); o8[64 * j] = w; }
}
__device__ __forceinline__ void phase0(const Params& p, LAS unsigned char* lds, int gw, int ngw, int wave, int lane, int item_lo, int item_hi) {
    LAS float* scr = (LAS float*)(lds + wave * 16384);
    for (int it = gw + item_lo; it < item_hi; it += ngw) {
        int jn = 0;
#pragma unroll
        for (int q = 1; q < 17; ++q) if (q < p.njobs && it >= p.jobs[q].item0) jn = q;
        p0_transpose_item(p.jobs[jn], scr, it - p.jobs[jn].item0, lane);
    }
    if (item_lo != 0) return;
    bf16_t* U = WSP(bf16_t, WS_U);
    for (int m = gw; m < UROWS; m += ngw) {
        if (m < MTOK) p0_norm_row(p.x + (size_t)m * DM, p.pre_w, U + (size_t)m * DM, lane);
        else if (m < MTOK + NMETA) p0_norm_row(p.meta + (size_t)(m - MTOK) * DM, p.pre_w, U + (size_t)m * DM, lane);
        else { u32x4* o = (u32x4*)(U + (size_t)m * DM) + lane;
#pragma unroll
            for (int j = 0; j < 4; ++j) o[64 * j] = (u32x4){0u, 0u, 0u, 0u}; }
    }
    bf16_t* WUK = WSP(bf16_t, WS_WUK);
    for (int i = gw * 64 + lane; i < 262144 / 4; i += ngw * 64) { const f32x4 v = ((const f32x4*)p.w_uk)[i]; u32x2 w; w.x = pk2(v.x, v.y); w.y = pk2(v.z, v.w); ((u32x2*)WUK)[i] = w; }
}

__device__ __forceinline__ void phase_ckvnorm(const Params& p, int gw, int ngw, int lane) {
    const float* CKVRAW = WSP(const float, WS_CKVRAW); bf16_t* CKV = WSP(bf16_t, WS_CKV);
    for (int r = gw; r < MKEY; r += ngw) {
        const f32x4 v = ((const f32x4*)(CKVRAW + (size_t)r * 256))[lane];
        const float ss = wave_sum((v.x * v.x + v.y * v.y) + (v.z * v.z + v.w * v.w));
        const float rstd = rsqrtf(ss * (1.f / 256.f) + EPS);
        const f32x4 g = ((const f32x4*)p.kv_norm_w)[lane];
        int w = __builtin_amdgcn_cvt_pk_fp8_f32(v.x * rstd * g.x, v.y * rstd * g.y, 0, false); w = __builtin_amdgcn_cvt_pk_fp8_f32(v.z * rstd * g.z, v.w * rstd * g.w, w, true);
        ((unsigned*)((unsigned char*)CKV + (size_t)r * 256))[lane] = (unsigned)w;
    }
}

__device__ __forceinline__ void phase7(const Params& p, int gw, int ngw, int lane) {
    const bf16_t* OUTPRE = WSP(const bf16_t, WS_OUTPRE); const float* SSQ = WSP(const float, WS_SSQ);
    for (int r = gw; r < MTOK; r += ngw) {
        float s = (lane < 32) ? SSQ[(size_t)r * 32 + lane] : 0.f; s = wave_sum(s);
        const float rstd = rsqrtf(s * (1.f / DM) + EPS);
        const u32x4* o = (const u32x4*)(OUTPRE + (size_t)r * DM); const f32x4* xr = (const f32x4*)(p.x + (size_t)r * DM); const f32x4* g = (const f32x4*)p.post_w; f32x4* out = (f32x4*)(p.out + (size_t)r * DM);
#pragma unroll
        for (int j = 0; j < 4; ++j) {
            const int ch = 64 * j + lane;
            const u32x4 w = o[ch]; const f32x4 x0 = xr[2 * ch], x1 = xr[2 * ch + 1], g0 = g[2 * ch], g1 = g[2 * ch + 1];
            f32x4 y0, y1;
            y0.x = x0.x + bflo(w.x) * rstd * g0.x; y0.y = x0.y + bfhi(w.x) * rstd * g0.y; y0.z = x0.z + bflo(w.y) * rstd * g0.z; y0.w = x0.w + bfhi(w.y) * rstd * g0.w;
            y1.x = x1.x + bflo(w.z) * rstd * g1.x; y1.y = x1.y + bfhi(w.z) * rstd * g1.y; y1.z = x1.z + bflo(w.w) * rstd * g1.z; y1.w = x1.w + bfhi(w.w) * rstd * g1.w;
            out[2 * ch] = y0; out[2 * ch + 1] = y1;
        }
    }
}

typedef short v4i16_t __attribute__((ext_vector_type(4)));
typedef float f32x2_t __attribute__((ext_vector_type(2))); typedef __bf16 bf16x2_t __attribute__((ext_vector_type(2)));
__device__ __forceinline__ unsigned cvtpk_s(float lo, float hi) { const f32x2_t v = {lo, hi}; const bf16x2_t b = __builtin_convertvector(v, bf16x2_t); return __builtin_bit_cast(unsigned, b); }
__device__ __forceinline__ unsigned off_b(unsigned row, unsigned ch) { const unsigned f = ((row >> 3) & 1u) | ((((row >> 2) ^ (row >> 3)) & 1u) << 1) | (((row >> 1) & 1u) << 2) | ((row & 1u) << 3); return 256u * row + 16u * (ch ^ f); }
__device__ __forceinline__ bf16x8 tr_frag(LAS unsigned char* img, unsigned a0, unsigned a1) {
    const v4i16_t lo = __builtin_amdgcn_ds_read_tr16_b64_v4i16((LAS v4i16_t*)(img + a0));
    const v4i16_t hi = __builtin_amdgcn_ds_read_tr16_b64_v4i16((LAS v4i16_t*)(img + a1));
    return (bf16x8){lo[0], lo[1], lo[2], lo[3], hi[0], hi[1], hi[2], hi[3]};
}
__device__ __forceinline__ void glds16(const void* gsrc, unsigned lds_dst) {
    unsigned keep;
    asm volatile("s_mov_b32 %0, m0\n\ts_mov_b32 m0, %2\n\ts_nop 0\n\tglobal_load_lds_dwordx4 %1, off\n\ts_mov_b32 m0, %0" : "=&s"(keep) : "v"(gsrc), "s"(lds_dst) : "memory");
}
constexpr int DB_K = 0, DB_V = 49152, DB_LUT = 98304, DB_Q = 99328;
constexpr float DIFF_THR = 24.0f;
__device__ __forceinline__ void diff_unit(const Params& p, LAS unsigned char* lds, int b, int h, int qb, float lam) {
    const bf16_t* QB = WSP(const bf16_t, WS_QB); const bf16_t* KB = WSP(const bf16_t, WS_KB); const bf16_t* VB = WSP(const bf16_t, WS_VB); const bf16_t* ZB = WSP(const bf16_t, WS_ZB); bf16_t* OZB = WSP(bf16_t, WS_OZB);
    const int tid = opaque_tid(), lane = tid & 63, wave = __builtin_amdgcn_readfirstlane(tid >> 6), l15 = lane & 15, g = lane >> 4;
    const int jw = 128 * qb + 16 * wave, jq = jw + l15, cw = 2 * qb + 1 + (wave >> 2), ntiles = 2 * qb + 3;
    LAS float* LUT = (LAS float*)(lds + DB_LUT);
    __syncthreads();
    if (tid < 155) LUT[tid] = p.rel_bias[t5_bucket(tid - 91) * 16 + 8 + h] * LOG2E;
    LAS unsigned char* Qimg = lds + DB_Q + wave * 4096;
    { const bf16_t* qp = QB + (size_t)(b * SEQ + jq) * 1024 + h * 128 + 8 * g;
#pragma unroll
      for (int s = 0; s < 4; ++s) *(LAS bf16x8*)(Qimg + off_b((unsigned)l15, 4u * s + (unsigned)g)) = *(const bf16x8*)(qp + 32 * s); }
    size_t dsrc[2];
#pragma unroll
    for (int i = 0; i < 2; ++i) { const unsigned row = 8u * wave + 4u * i + (unsigned)(lane >> 4); const unsigned f = (off_b(row & 15u, 0u) >> 4) & 15u;
        dsrc[i] = (size_t)row * 1024 + h * 128 + (((unsigned)(lane & 15)) ^ f) * 8; }
    const unsigned ddst = 2048u * wave;
    const unsigned lds0 = (unsigned)(size_t)lds;
#define DF_ROW0(tt) ((size_t)b * TK + ((tt) == 0 ? 0 : 16 + 64 * ((tt) - 1)))
#define DF_DMAK(tt, slot) do { const bf16_t* g_ = KB + DF_ROW0(tt) * 1024; _Pragma("unroll") for (int i_ = 0; i_ < 2; ++i_) \
        glds16(g_ + dsrc[i_], (unsigned)__builtin_amdgcn_readfirstlane((int)(lds0 + DB_K + (slot) * 16384 + ddst + 1024 * i_))); } while (0)
#define DF_DMAV(tt, slot) do { const bf16_t* g_ = VB + DF_ROW0(tt) * 1024; _Pragma("unroll") for (int i_ = 0; i_ < 2; ++i_) \
        glds16(g_ + dsrc[i_], (unsigned)__builtin_amdgcn_readfirstlane((int)(lds0 + DB_V + (slot) * 16384 + ddst + 1024 * i_))); } while (0)
#define DF_WAITBAR(n) do { if ((n) >= 4) asm volatile("s_waitcnt vmcnt(4) lgkmcnt(0)" ::: "memory"); else if ((n) >= 2) asm volatile("s_waitcnt vmcnt(2) lgkmcnt(0)" ::: "memory"); \
        else asm volatile("s_waitcnt vmcnt(0) lgkmcnt(0)" ::: "memory"); __builtin_amdgcn_s_barrier(); asm volatile("" ::: "memory"); } while (0)
    const unsigned q4 = (unsigned)l15 >> 2, pp = (unsigned)l15 & 3u;
    unsigned kbase[2][2], vbase[8];
#pragma unroll
    for (int mp = 0; mp < 2; ++mp)
#pragma unroll
        for (int s = 0; s < 2; ++s) kbase[mp][s] = off_b((unsigned)l15, 8u * mp + 4u * s + (unsigned)g);
#pragma unroll
    for (int c = 0; c < 8; ++c) vbase[c] = off_b(4u * g + q4, 2u * c + (pp >> 1)) + 8u * (pp & 1u);

    float m1 = 0.f, m2 = 0.f;
    f32x4 O1[8], O2[8], OL1 = (f32x4){0.f, 0.f, 0.f, 0.f}, OL2 = (f32x4){0.f, 0.f, 0.f, 0.f};
    const short one_ = (l15 == 0) ? (short)0x3F80 : (short)0;
    const bf16x8 onesf = (bf16x8){one_, one_, one_, one_, one_, one_, one_, one_};
#pragma unroll
    for (int c = 0; c < 8; ++c) { O1[c] = (f32x4){0.f, 0.f, 0.f, 0.f}; O2[c] = (f32x4){0.f, 0.f, 0.f, 0.f}; }
    f32x4 S1[4], S2[4];
    bf16x8 pa1[2], pa2[2];
    float es1 = 1.f, es2 = 1.f; bool pending = false;
    f32x4 cn1 = (f32x4){0.f, 0.f, 0.f, 0.f}, cn2 = cn1, cf1 = cn1, cf2 = cn1;

#define DF_QK(tt, kbo_) do { LAS unsigned char* Kb_ = lds + DB_K + (kbo_); \
        const int dmin_ = ((tt) == 0) ? (jw + 1) : (jw - 64 * (tt) + 1); const bool near_ = dmin_ < 91; \
        const f32x4 ci1_ = near_ ? cn1 : cf1, ci2_ = near_ ? cn2 : cf2;        \
        _Pragma("unroll") for (int s = 0; s < 2; ++s) { const bf16x8 q1_ = *(const LAS bf16x8*)(Qimg + kbase[0][s]), q2_ = *(const LAS bf16x8*)(Qimg + kbase[1][s]); \
          bf16x8 ka1_[4], ka2_[4]; \
          _Pragma("unroll") for (int mb = 0; mb < 4; ++mb) { ka1_[mb] = *(const LAS bf16x8*)(Kb_ + kbase[0][s] + 4096 * mb); ka2_[mb] = *(const LAS bf16x8*)(Kb_ + kbase[1][s] + 4096 * mb); } \
          __builtin_amdgcn_sched_barrier(0); \
          _Pragma("unroll") for (int mb = 0; mb < 4; ++mb) { \
            S1[mb] = __builtin_amdgcn_mfma_f32_16x16x32_bf16(ka1_[mb], q1_, s == 0 ? ci1_ : S1[mb], 0, 0, 0); S2[mb] = __builtin_amdgcn_mfma_f32_16x16x32_bf16(ka2_[mb], q2_, s == 0 ? ci2_ : S2[mb], 0, 0, 0); } } \
        if (near_) { _Pragma("unroll") for (int mb = 0; mb < 4; ++mb) _Pragma("unroll") for (int i = 0; i < 4; ++i) { \
            const int kr_ = 16 * mb + 4 * g + i; const int kpos_ = ((tt) == 0) ? kr_ : 16 + 64 * ((tt) - 1) + kr_; \
            int rel_ = kpos_ - (NMETA + jq); rel_ = rel_ < -91 ? -91 : (rel_ > 63 ? 63 : rel_); const float bias_ = LUT[rel_ + 91]; S1[mb][i] += bias_; S2[mb][i] += bias_; } } \
        if ((tt) == 0) { _Pragma("unroll") for (int mb = 1; mb < 4; ++mb) { S1[mb] = (f32x4){-INFINITY, -INFINITY, -INFINITY, -INFINITY}; S2[mb] = S1[mb]; } } } while (0)
#define DF_LMAX(t1_, t2_) do { t1_ = fmaxf(fmaxf(S1[0][0], S1[0][1]), S1[0][2]); t2_ = fmaxf(fmaxf(S2[0][0], S2[0][1]), S2[0][2]); \
        t1_ = fmaxf(fmaxf(t1_, S1[0][3]), S1[1][0]); t2_ = fmaxf(fmaxf(t2_, S2[0][3]), S2[1][0]); \
        t1_ = fmaxf(fmaxf(t1_, S1[1][1]), S1[1][2]); t2_ = fmaxf(fmaxf(t2_, S2[1][1]), S2[1][2]); \
        t1_ = fmaxf(fmaxf(t1_, S1[1][3]), S1[2][0]); t2_ = fmaxf(fmaxf(t2_, S2[1][3]), S2[2][0]); \
        t1_ = fmaxf(fmaxf(t1_, S1[2][1]), S1[2][2]); t2_ = fmaxf(fmaxf(t2_, S2[2][1]), S2[2][2]); \
        t1_ = fmaxf(fmaxf(t1_, S1[2][3]), S1[3][0]); t2_ = fmaxf(fmaxf(t2_, S2[2][3]), S2[3][0]); \
        t1_ = fmaxf(fmaxf(t1_, S1[3][1]), S1[3][2]); t2_ = fmaxf(fmaxf(t2_, S2[3][1]), S2[3][2]); \
        t1_ = fmaxf(t1_, S1[3][3]); t2_ = fmaxf(t2_, S2[3][3]); } while (0)
#define DF_RESCALE(t1_, t2_, forced_) do { float r1_ = t1_, r2_ = t2_; r1_ = fmaxf(r1_, __shfl_xor(r1_, 16)); r1_ = fmaxf(r1_, __shfl_xor(r1_, 32)); r2_ = fmaxf(r2_, __shfl_xor(r2_, 16)); r2_ = fmaxf(r2_, __shfl_xor(r2_, 32)); \
        const float d1_ = (forced_) ? r1_ : fmaxf(r1_, 0.f), d2_ = (forced_) ? r2_ : fmaxf(r2_, 0.f); m1 += d1_; m2 += d2_; \
        es1 = __builtin_amdgcn_exp2f(-d1_); es2 = __builtin_amdgcn_exp2f(-d2_); \
        _Pragma("unroll") for (int mb = 0; mb < 4; ++mb) { S1[mb] = S1[mb] - d1_; S2[mb] = S2[mb] - d2_; } \
        cn1 = (f32x4){-m1, -m1, -m1, -m1}; cn2 = (f32x4){-m2, -m2, -m2, -m2}; { const float f1_ = bias_far - m1, f2_ = bias_far - m2; cf1 = (f32x4){f1_, f1_, f1_, f1_}; cf2 = (f32x4){f2_, f2_, f2_, f2_}; } } while (0)
#define DF_SCALE_O() do { _Pragma("unroll") for (int i = 0; i < 4; ++i) { const float x1_ = __shfl(es1, 4 * g + i), x2_ = __shfl(es2, 4 * g + i); OL1[i] *= x1_; OL2[i] *= x2_; \
            _Pragma("unroll") for (int c = 0; c < 8; ++c) { O1[c][i] *= x1_; O2[c][i] *= x2_; } } } while (0)
#define DF_EXP() do { _Pragma("unroll") for (int mb = 0; mb < 4; ++mb) _Pragma("unroll") for (int i = 0; i < 4; ++i) { S1[mb][i] = __builtin_amdgcn_exp2f(S1[mb][i]); S2[mb][i] = __builtin_amdgcn_exp2f(S2[mb][i]); } \
        _Pragma("unroll") for (int ks = 0; ks < 2; ++ks) { u32x4 w1_, w2_; \
            w1_.x = cvtpk_s(S1[2 * ks][0], S1[2 * ks][1]); w1_.y = cvtpk_s(S1[2 * ks][2], S1[2 * ks][3]); w1_.z = cvtpk_s(S1[2 * ks + 1][0], S1[2 * ks + 1][1]); w1_.w = cvtpk_s(S1[2 * ks + 1][2], S1[2 * ks + 1][3]); \
            w2_.x = cvtpk_s(S2[2 * ks][0], S2[2 * ks][1]); w2_.y = cvtpk_s(S2[2 * ks][2], S2[2 * ks][3]); w2_.z = cvtpk_s(S2[2 * ks + 1][0], S2[2 * ks + 1][1]); w2_.w = cvtpk_s(S2[2 * ks + 1][2], S2[2 * ks + 1][3]); \
            pa1[ks] = __builtin_bit_cast(bf16x8, w1_); pa2[ks] = __builtin_bit_cast(bf16x8, w2_); } } while (0)
#define DF_PV(vbo_, pq1_, pq2_) do { LAS unsigned char* Vb_ = lds + DB_V + (vbo_); \
        _Pragma("unroll") for (int ks = 0; ks < 2; ++ks) { OL1 = __builtin_amdgcn_mfma_f32_16x16x32_bf16(pq1_[ks], onesf, OL1, 0, 0, 0); OL2 = __builtin_amdgcn_mfma_f32_16x16x32_bf16(pq2_[ks], onesf, OL2, 0, 0, 0); } \
        _Pragma("unroll") for (int c2 = 0; c2 < 8; c2 += 2) { bf16x8 vf_[2][2]; \
            _Pragma("unroll") for (int cc = 0; cc < 2; ++cc) _Pragma("unroll") for (int ks = 0; ks < 2; ++ks) vf_[cc][ks] = tr_frag(Vb_ + vbase[c2 + cc], 8192u * ks, 8192u * ks + 4096u); \
            _Pragma("unroll") for (int cc = 0; cc < 2; ++cc) _Pragma("unroll") for (int ks = 0; ks < 2; ++ks) { \
                O1[c2 + cc] = __builtin_amdgcn_mfma_f32_16x16x32_bf16(pq1_[ks], vf_[cc][ks], O1[c2 + cc], 0, 0, 0); O2[c2 + cc] = __builtin_amdgcn_mfma_f32_16x16x32_bf16(pq2_[ks], vf_[cc][ks], O2[c2 + cc], 0, 0, 0); } } } while (0)

    DF_DMAK(0, 0); DF_DMAV(0, 0); DF_DMAK(1, 1); DF_DMAV(1, 1); DF_DMAK(2, 2);
    asm volatile("s_waitcnt vmcnt(0) lgkmcnt(0)" ::: "memory"); __builtin_amdgcn_s_barrier(); asm volatile("" ::: "memory");
    const float bias_far = LUT[0];
    cf1 = (f32x4){bias_far, bias_far, bias_far, bias_far}; cf2 = cf1;
    { DF_QK(0, 0u); float t1, t2; DF_LMAX(t1, t2); DF_RESCALE(t1, t2, true); DF_EXP(); }
    asm volatile("s_waitcnt lgkmcnt(0)" ::: "memory"); __builtin_amdgcn_s_barrier(); asm volatile("" ::: "memory");
    int sk = 1, sv = 0;
    for (int t = 0; t < ntiles; ++t) {
        if (__builtin_expect(pending, 0)) { DF_SCALE_O(); pending = false; }
        int nnew = 0;
        { const int s3 = (sk == 0) ? 2 : sk - 1;
          if (t + 3 < ntiles) { DF_DMAK(t + 3, s3); nnew += 2; }
          const int s2 = (sv == 0) ? 2 : sv - 1;
          if (t + 2 < ntiles) { DF_DMAV(t + 2, s2); nnew += 2; } }
        unsigned kbo = (unsigned)sk * 16384u, vbo = (unsigned)sv * 16384u; asm volatile("" : "+v"(kbo), "+v"(vbo));
        if (t + 1 <= cw) {
            DF_QK(t + 1, kbo);
            float t1, t2; DF_LMAX(t1, t2);
            if (__builtin_expect(__any((t1 > DIFF_THR) || (t2 > DIFF_THR)), 0)) { DF_RESCALE(t1, t2, false); pending = true; }
            DF_PV(vbo, pa1, pa2);
            DF_EXP();
        } else if (t <= cw) {
            DF_PV(vbo, pa1, pa2);
        }
        DF_WAITBAR(nnew);
        sk = (sk == 2) ? 0 : sk + 1; sv = (sv == 2) ? 0 : sv + 1;
    }
    asm volatile("s_waitcnt vmcnt(0)" ::: "memory");
#undef DF_ROW0
#undef DF_DMAK
#undef DF_DMAV
#undef DF_WAITBAR
#undef DF_QK
#undef DF_LMAX
#undef DF_RESCALE
#undef DF_SCALE_O
#undef DF_EXP
#undef DF_PV
#pragma unroll
    for (int i = 0; i < 4; ++i) {
        const float r1 = 1.f / __shfl(OL1[i], 16 * g), r2 = lam / __shfl(OL2[i], 16 * g);
        float o[8]; float ss = 0.f;
#pragma unroll
        for (int c = 0; c < 8; ++c) { o[c] = O1[c][i] * r1 - O2[c][i] * r2; ss += o[c] * o[c]; }
        ss += __shfl_xor(ss, 1); ss += __shfl_xor(ss, 2); ss += __shfl_xor(ss, 4); ss += __shfl_xor(ss, 8);
        const float rs = rsqrtf(ss * (1.f / 128.f) + EPS) * 0.8f;
        const size_t t = (size_t)b * SEQ + jw + 4 * g + i;
#pragma unroll
        for (int c = 0; c < 8; ++c) { const int d = 16 * c + l15; const float y = o[c] * rs * p.subln_w[d] * bf2f(ZB[t * 1024 + h * 128 + d]); OZB[t * 1024 + h * 128 + d] = (bf16_t)f2bf(y); }
    }
}
__device__ __forceinline__ void phase_diff(const Params& p, LAS unsigned char* lds) {
    const int lane = threadIdx.x & 63;
    float a = (lane < 64) ? p.lam_p[lane] * p.lam_p[64 + lane] : 0.f, bb = p.lam_p[128 + lane] * p.lam_p[192 + lane];
    a = wave_sum(a); bb = wave_sum(bb);
    const float lam = expf(a) - expf(bb) + 0.2f;
    for (int u = blockIdx.x; u < 512; u += gridDim.x) {
        const int v = u & 255;
        int bh = v >> 4, s = v & 15;
        if (gridDim.x == 256) { bh = (v & 7) + 8 * (v >> 7); s = (v >> 3) & 15; }
        const int qb = (u < 256) ? s : 31 - s;
        diff_unit(p, lds, bh >> 3, bh & 7, qb, lam);
    }
}

typedef float f32x16 __attribute__((ext_vector_type(16)));
__device__ __forceinline__ void scores_wg_unit(const Params& p, LAS unsigned char* lds, int c, int b, int half, int kh) {
    const bf16_t* IQ = WSP(const bf16_t, WS_IQ); const float* IW = WSP(const float, WS_IW); float* SC = WSP(float, WS_SC);
    const int tid = opaque_tid(), lane = tid & 63, wave = __builtin_amdgcn_readfirstlane(tid >> 6);
    const int j0 = (c - 1) * 64 + 32 * half + 4 * wave, m0 = b * SEQ + j0, n = 16 + 64 * c, nkb = 2 * c + 1, nkh = (nkb + 1) >> 1;
    const int kbA = kh ? nkh : 0, kbB = kh ? nkb : nkh, ntile = (kbB - kbA + 1) >> 1;
    const int r32 = lane & 31, hi = lane >> 5, tok = r32 >> 4, hh = r32 & 15;
    bf16x8 af[2][4]; float wv[2][16];
#pragma unroll
    for (int pr = 0; pr < 2; ++pr) {
#pragma unroll
        for (int s = 0; s < 4; ++s) af[pr][s] = *(const bf16x8*)(IQ + (size_t)(m0 + 2 * pr + tok) * 1024 + hh * 64 + 16 * s + 8 * hi);
#pragma unroll
        for (int r = 0; r < 16; ++r) wv[pr][r] = IW[(size_t)(m0 + 2 * pr + (r >> 3)) * 16 + (r & 3) + 8 * ((r >> 2) & 1) + 4 * hi];
    }
    float* rowbase = SC + sc_off(b, j0);
    const bf16_t* ikb = WSP(const bf16_t, WS_IK) + (size_t)b * TK * 64;
    const int pkey = tid >> 3, pch = tid & 7;
    const unsigned pdst = (unsigned)pkey * 128u + 16u * (unsigned)(pch ^ (pkey & 7));
    unsigned boff[4];
#pragma unroll
    for (int s = 0; s < 4; ++s) boff[s] = (unsigned)r32 * 128u + 16u * (unsigned)((2 * s + hi) ^ (r32 & 7));
    u32x4 kreg;
#define SCW_LOAD(t_) do { int key_ = 32 * (kbA + 2 * (t_)) + pkey; key_ = key_ < n ? key_ : n - 1; kreg = *(const u32x4*)(ikb + (size_t)key_ * 64 + pch * 8); } while (0)
#define SCW_WRITE(off_) do { *(LAS u32x4*)(lds + (off_) + pdst) = kreg; } while (0)
    __syncthreads();
    SCW_LOAD(0); SCW_WRITE(0u);
    __syncthreads();
    for (int t = 0; t < ntile; ++t) {
        if (t + 1 < ntile) SCW_LOAD(t + 1);
        unsigned bo = (unsigned)(t & 1) * 8192u; asm volatile("" : "+v"(bo));
#pragma unroll
        for (int q = 0; q < 2; ++q) {
            const int kb = kbA + 2 * t + q, key = 32 * kb + r32;
            bf16x8 bfr[4];
#pragma unroll
            for (int s = 0; s < 4; ++s) bfr[s] = *(const LAS bf16x8*)(lds + bo + boff[s] + 4096 * q);
#pragma unroll
            for (int pr = 0; pr < 2; ++pr) {
                f32x16 acc;
#pragma unroll
                for (int r = 0; r < 16; ++r) acc[r] = 0.f;
#pragma unroll
                for (int s = 0; s < 4; ++s) acc = __builtin_amdgcn_mfma_f32_32x32x16_bf16(af[pr][s], bfr[s], acc, 0, 0, 0);
                float p0 = 0.f, p1 = 0.f;
#pragma unroll
                for (int r = 0; r < 8; ++r) { p0 += wv[pr][r] * fmaxf(acc[r], 0.f); p1 += wv[pr][8 + r] * fmaxf(acc[8 + r], 0.f); }
                const auto sw = __builtin_amdgcn_permlane32_swap(__float_as_uint(p0), __float_as_uint(p1), false, false);
                const float tot = __uint_as_float(sw[0]) + __uint_as_float(sw[1]);
                if (kb < kbB && key < n) rowbase[(size_t)(2 * pr + hi) * n + key] = tot;
            }
        }
        if (t + 1 < ntile) SCW_WRITE((unsigned)((t + 1) & 1) * 8192u);
        __syncthreads();
    }
#undef SCW_LOAD
#undef SCW_WRITE
}
__device__ __forceinline__ void phase_scores(const Params& p, LAS unsigned char* lds) {
    for (int P = (int)blockIdx.x; P < 256; P += (int)gridDim.x) {
        const int cl = 1 + (P >> 3), sub = P & 7;
        scores_wg_unit(p, lds, 65 - cl, sub >> 2, (sub >> 1) & 1, sub & 1);
        scores_wg_unit(p, lds, cl, sub >> 2, (sub >> 1) & 1, sub & 1);
    }
}
__device__ __forceinline__ void phase_qlat(const Params& p, LAS unsigned char* lds) {
    const bf16_t* QA = WSP(const bf16_t, WS_QA); const bf16_t* WUK = WSP(const bf16_t, WS_WUK); bf16_t* QLAT = WSP(bf16_t, WS_QLAT);
    const int tid = opaque_tid(), lane = tid & 63, w = __builtin_amdgcn_readfirstlane(tid >> 6), l15 = lane & 15, g = lane >> 4;
    const float sc = 0.08838834764831845f * LOG2E * 16.f;
    const int G = (int)gridDim.x;
    int hcur = -1;
    const unsigned kb0 = off_b((unsigned)l15, (unsigned)g);
    for (int u0 = (int)blockIdx.x; u0 < 4096; u0 += 8 * G) {
        const int h = u0 & 7;
        if (h != hcur || (G & 7)) { hcur = h; __syncthreads();
#pragma unroll
            for (int i = 0; i < 8; ++i) { const int idx = tid + 512 * i, row = idx >> 4, ch = idx & 15;
                *(LAS u32x4*)(lds + off_b((unsigned)row, (unsigned)ch)) = *(const u32x4*)(WUK + ((size_t)row * 8 + h) * 128 + ch * 8); }
            __syncthreads(); }
        const int u = u0 + w * G;
        if (u < 4096 && (u & 7) == h) {
            const int m0 = (u >> 3) * 16;
            bf16x8 bq[4];
#pragma unroll
            for (int s = 0; s < 4; ++s) bq[s] = *(const bf16x8*)(QA + (size_t)(m0 + l15) * 1024 + h * 128 + 32 * s + 8 * g);
#pragma unroll 4
            for (int nb = 0; nb < 16; ++nb) {
                bf16x8 af[4];
#pragma unroll
                for (int s = 0; s < 4; ++s) af[s] = *(const LAS bf16x8*)(lds + 4096 * nb + (kb0 ^ (64u * s)));
                f32x4 acc = (f32x4){0.f, 0.f, 0.f, 0.f};
#pragma unroll
                for (int s = 0; s < 4; ++s) acc = __builtin_amdgcn_mfma_f32_16x16x32_bf16(af[s], bq[s], acc, 0, 0, 0);
                int wv = __builtin_amdgcn_cvt_pk_fp8_f32(acc[0] * sc, acc[1] * sc, 0, false); wv = __builtin_amdgcn_cvt_pk_fp8_f32(acc[2] * sc, acc[3] * sc, wv, true);
                *(unsigned*)((unsigned char*)QLAT + ((size_t)(m0 + l15) * 8 + h) * 256 + 16 * nb + 4 * g) = (unsigned)wv;
            }
        }
    }
}
__device__ __forceinline__ void phase_oproj(const Params& p, LAS unsigned char* lds) {
    const bf16_t* OLAT = WSP(const bf16_t, WS_OLAT); const bf16_t* WUVT = WSP(const bf16_t, WS_WUVT); const bf16_t* ZA = WSP(const bf16_t, WS_ZA); bf16_t* OZA = WSP(bf16_t, WS_OZA);
    const int tid = opaque_tid(), lane = tid & 63, w = __builtin_amdgcn_readfirstlane(tid >> 6), l15 = lane & 15, g = lane >> 4;
    const int G = (int)gridDim.x;
    int hcur = -1;
    const unsigned kb0 = off_b((unsigned)l15, (unsigned)g);
    for (int u0 = (int)blockIdx.x; u0 < 4096; u0 += 8 * G) {
        const int h = u0 & 7;
        if (h != hcur || (G & 7)) { hcur = h; __syncthreads();
#pragma unroll
            for (int i = 0; i < 8; ++i) { const int idx = tid + 512 * i, row = idx >> 5, c32 = idx & 31;
                *(LAS u32x4*)(lds + (c32 >> 4) * 32768 + off_b((unsigned)row, (unsigned)(c32 & 15))) = *(const u32x4*)(WUVT + (size_t)(h * 128 + row) * 256 + c32 * 8); }
            __syncthreads(); }
        const int u = u0 + w * G;
        if (u < 4096 && (u & 7) == h) {
            const int m0 = (u >> 3) * 16;
            bf16x8 bq[8];
#pragma unroll
            for (int s = 0; s < 8; ++s) bq[s] = *(const bf16x8*)(OLAT + ((size_t)(m0 + l15) * 8 + h) * 256 + 32 * s + 8 * g);
#pragma unroll 2
            for (int nb = 0; nb < 8; ++nb) {
                bf16x8 af[8];
#pragma unroll
                for (int s = 0; s < 8; ++s) af[s] = *(const LAS bf16x8*)(lds + (s >> 2) * 32768 + 4096 * nb + (kb0 ^ (64u * (s & 3))));
                f32x4 acc = (f32x4){0.f, 0.f, 0.f, 0.f};
#pragma unroll
                for (int s = 0; s < 8; ++s) acc = __builtin_amdgcn_mfma_f32_16x16x32_bf16(af[s], bq[s], acc, 0, 0, 0);
                const size_t o = (size_t)(m0 + l15) * 1024 + h * 128 + 16 * nb + 4 * g;
                const u32x2 z = *(const u32x2*)(ZA + o);
                u32x2 wv; wv.x = pg8::cvt_pk_bf16(acc[0] * bflo(z.x), acc[1] * bfhi(z.x)); wv.y = pg8::cvt_pk_bf16(acc[2] * bflo(z.y), acc[3] * bfhi(z.y));
                *(u32x2*)(OZA + o) = wv;
            }
        }
    }
}
typedef int v2i32_t __attribute__((ext_vector_type(2)));
constexpr int DSA_WAVE_LDS = 17408, DSA_LUT = 8 * DSA_WAVE_LDS;
__device__ __forceinline__ int lpos(int s) { return (s & ~31) | ((s & 3) << 3) | ((s & 31) >> 2); }
__device__ __forceinline__ unsigned ord_key(float f) { const unsigned u = __float_as_uint(f); return (u & 0x80000000u) ? ~u : (u | 0x80000000u); }
template <int KN>
__device__ __forceinline__ void dsa_select(const float* row, int n, int nsel, LAS int* list, int lane) {
    const __amdgpu_buffer_rsrc_t rs = __builtin_amdgcn_make_buffer_rsrc((void*)row, 0, n * 4, 0x00020000);
    unsigned key[KN];
#pragma unroll
    for (int k = 0; k < KN; ++k) key[k] = (unsigned)__builtin_amdgcn_raw_buffer_load_b32(rs, lane * 4, 256 * k, 2);
    { int idx0 = lane;
#pragma unroll
      for (int k = 0; k < KN; ++k) { const unsigned u = key[k]; const unsigned o = (u & 0x80000000u) ? ~u : (u | 0x80000000u); key[k] = (idx0 < n) ? o : 0u; idx0 += 64; asm volatile("" : "+v"(idx0)); } }
    unsigned thr = 0u;
    if (n > 256) {
        for (int bit = 31; bit >= 0; --bit) {
            const unsigned cand = thr | (1u << bit);
            int c = 0;
#pragma unroll
            for (int k = 0; k < KN; ++k) c += (key[k] >= cand) ? 1 : 0;
            int cnt = 0;
#pragma unroll
            for (int b7 = 0; b7 < 7; ++b7) cnt += __popcll(__ballot((c >> b7) & 1)) << b7;
            if (cnt >= 256) thr = cand;
            if (cnt == 256) break;
        }
    }
    int pos = 0; int idx = lane;
#pragma unroll
    for (int k = 0; k < KN; ++k) { const bool mine = key[k] > thr; const unsigned long long msk = __ballot(mine);
        const int my = __builtin_amdgcn_mbcnt_hi((unsigned)(msk >> 32), __builtin_amdgcn_mbcnt_lo((unsigned)msk, 0u));
        if (mine) list[lpos(pos + my)] = idx; pos += __popcll(msk); idx += 64; asm volatile("" : "+v"(idx)); }
    if (pos < nsel) {
        idx = lane;
#pragma unroll
        for (int k = 0; k < KN; ++k) { const bool mine = (key[k] == thr) && (idx < n); const unsigned long long msk = __ballot(mine);
            const int my = __builtin_amdgcn_mbcnt_hi((unsigned)(msk >> 32), __builtin_amdgcn_mbcnt_lo((unsigned)msk, 0u));
            if (mine && pos + my < nsel) list[lpos(pos + my)] = idx; pos += __popcll(msk); idx += 64; asm volatile("" : "+v"(idx)); }
    }
}
__device__ __forceinline__ void dsa_unit(const Params& p, LAS unsigned char* lds, int qi, int wave, int lane, int probe) {
    const float* SC = WSP(const float, WS_SC); bf16_t* OLAT = WSP(bf16_t, WS_OLAT);
    const int c = qi >> 8, b = (qi >> 6) & 1, j = (c - 1) * 64 + (qi & 63), t = b * SEQ + j, n = 16 + 64 * c, nsel = n < 256 ? n : 256, qpos = NMETA + j;
    LAS unsigned char* img = lds + wave * DSA_WAVE_LDS; LAS int* list = (LAS int*)(img + 16384); const LAS float* LUTA = (const LAS float*)(lds + DSA_LUT);
    const int l15 = lane & 15, g = lane >> 4;
    const float* row = SC + sc_off(b, j);
#pragma unroll
    for (int rs_ = (PROBE_REP == 41) ? 2 : 1; rs_ > 0; --rs_) {
    if (n <= 64 * 17) dsa_select<17>(row, n, nsel, list, lane);
    else if (n <= 64 * 33) dsa_select<33>(row, n, nsel, list, lane);
    else if (n <= 64 * 49) dsa_select<49>(row, n, nsel, list, lane);
    else dsa_select<65>(row, n, nsel, list, lane);
    }
#pragma unroll
    for (int ra_ = (PROBE_REP == 42) ? 2 : 1; ra_ > 0; --ra_) {
    const unsigned char* CKV8 = WSP(const unsigned char, WS_CKV); const unsigned char* qlp = WSP(const unsigned char, WS_QLAT) + ((size_t)t * 8 + (l15 & 7)) * 256 + 8 * g;
    const bool qreal = l15 < 8;
    unsigned rdb[2];
    rdb[0] = 256u * (unsigned)l15 + 8u * ((unsigned)g ^ (2u * (unsigned)l15));
    rdb[1] = 256u * (unsigned)(l15 + 16) + 8u * ((unsigned)g ^ (2u * ((unsigned)l15 ^ 8u)));
    const unsigned tq = (unsigned)l15 >> 1, tp = (unsigned)l15 & 1u;
    const unsigned trow = (tq < 4u) ? 4u * g + tq : 16u + 4u * g + (tq - 4u);
    const unsigned trb = 256u * trow + 8u * (tp ^ (2u * ((trow & 15u) ^ ((trow >> 4) << 3))));
    float m = -INFINITY, l = 0.f;
    f32x4 O[16];
#pragma unroll
    for (int rb = 0; rb < 16; ++rb) O[rb] = (f32x4){0.f, 0.f, 0.f, 0.f};
    const int nch = (nsel + 31) >> 5;
    const int hcol = l15 & 7;
    u32x4 gr[8];
    const unsigned gwr = 256u * (unsigned)(lane >> 4) + 16u * (unsigned)(lane & 15);
#define DSA_GATHER(chn) do { int ki_[8]; { const LAS int* lp_ = list + 32 * (chn) + 8 * (lane >> 4); \
        _Pragma("unroll") for (int v_ = 0; v_ < 2; ++v_) { const u32x4 t_ = *(const LAS u32x4*)(lp_ + 4 * v_); ki_[4 * v_] = (int)t_.x; ki_[4 * v_ + 1] = (int)t_.y; ki_[4 * v_ + 2] = (int)t_.z; ki_[4 * v_ + 3] = (int)t_.w; } } \
        _Pragma("unroll") for (int i = 0; i < 8; ++i) { const int slot = 32 * (chn) + 4 * i + (lane >> 4); const int kidx = slot < nsel ? ki_[i] : 0; \
        gr[i] = *(const u32x4*)(CKV8 + ((size_t)b * TK + kidx) * 256 + (lane & 15) * 16); } } while (0)
    DSA_GATHER(0);
    for (int ch = 0; ch < nch; ++ch) {
#pragma unroll
        for (int i = 0; i < 8; ++i) { const unsigned row = 4u * i + (unsigned)(lane >> 4); const unsigned rc = (row & 15u) ^ ((row >> 4) << 3);
            *(LAS u32x4*)(img + 256u * row + 16u * (((unsigned)lane & 15u) ^ rc)) = gr[i]; }
        long qf[8];
#pragma unroll
        for (int s = 0; s < 8; ++s) qf[s] = *(const long*)(qlp + 32 * s);
        asm volatile("" ::: "memory");
        DSA_GATHER(ch + 1);
        asm volatile("" ::: "memory");
#pragma unroll
        for (int s = 0; s < 8; ++s) qf[s] = qreal ? qf[s] : 0l;
        unsigned io = 0u; asm volatile("" : "+v"(io));
        LAS unsigned char* im = img + io;
        f32x4 S[2];
        S[0] = (f32x4){0.f, 0.f, 0.f, 0.f}; S[1] = S[0];
#pragma unroll
        for (int s4 = 0; s4 < 8; s4 += 4) {
            long af_[4][2];
#pragma unroll
            for (int s = 0; s < 4; ++s)
#pragma unroll
                for (int mb = 0; mb < 2; ++mb) af_[s][mb] = *(const LAS long*)(im + (rdb[mb] ^ (32u * (s4 + s))));
            __builtin_amdgcn_sched_barrier(0);
#pragma unroll
            for (int s = 0; s < 4; ++s)
#pragma unroll
                for (int mb = 0; mb < 2; ++mb) S[mb] = __builtin_amdgcn_mfma_f32_16x16x32_fp8_fp8(af_[s][mb], qf[s4 + s], S[mb], 0, 0, 0);
        }
        float cm = -INFINITY;
#pragma unroll
        for (int mb = 0; mb < 2; ++mb)
#pragma unroll
            for (int i = 0; i < 4; ++i) { const int slot = 32 * ch + 16 * mb + 4 * g + i; const int kidx = list[lpos(slot & 255)];
                int rel = kidx - qpos; rel = rel < -91 ? -91 : (rel > 63 ? 63 : rel);
                float v = S[mb][i] * 0.0625f + LUTA[(rel + 91) * 8 + hcol]; v = slot < nsel ? v : -INFINITY; S[mb][i] = v; cm = fmaxf(cm, v); }
        cm = fmaxf(cm, __shfl_xor(cm, 16)); cm = fmaxf(cm, __shfl_xor(cm, 32));
        const float mn = fmaxf(m, cm), alpha = __builtin_amdgcn_exp2f(m - mn); m = mn;
        float ps = 0.f;
#pragma unroll
        for (int mb = 0; mb < 2; ++mb)
#pragma unroll
            for (int i = 0; i < 4; ++i) { S[mb][i] = __builtin_amdgcn_exp2f(S[mb][i] - mn); ps += S[mb][i]; }
        l = l * alpha + ps;
        if (__any(alpha != 1.f)) {
#pragma unroll
            for (int rb = 0; rb < 16; ++rb) O[rb] = O[rb] * alpha;
        }
        int w0 = __builtin_amdgcn_cvt_pk_fp8_f32(S[0][0], S[0][1], 0, false); w0 = __builtin_amdgcn_cvt_pk_fp8_f32(S[0][2], S[0][3], w0, true);
        int w1 = __builtin_amdgcn_cvt_pk_fp8_f32(S[1][0], S[1][1], 0, false); w1 = __builtin_amdgcn_cvt_pk_fp8_f32(S[1][2], S[1][3], w1, true);
        const long pb = (long)(((unsigned long long)(unsigned)w1 << 32) | (unsigned long long)(unsigned)w0);
#pragma unroll
        for (int rb4 = 0; rb4 < 16; rb4 += 4) {
            long tf_[4];
#pragma unroll
            for (int r_ = 0; r_ < 4; ++r_) { const v2i32_t tv = __builtin_amdgcn_ds_read_tr8_b64_v2i32((LAS v2i32_t*)(im + (trb ^ (16u * (rb4 + r_))))); tf_[r_] = __builtin_bit_cast(long, tv); }
            __builtin_amdgcn_sched_barrier(0);
#pragma unroll
            for (int r_ = 0; r_ < 4; ++r_) O[rb4 + r_] = __builtin_amdgcn_mfma_f32_16x16x32_fp8_fp8(tf_[r_], pb, O[rb4 + r_], 0, 0, 0);
        }
    }
    l += __shfl_xor(l, 16); l += __shfl_xor(l, 32);
    const float il = 1.f / l;
    if (l15 < 8) {
#pragma unroll
        for (int rb = 0; rb < 16; ++rb) { u32x2 w; w.x = pg8::cvt_pk_bf16(O[rb][0] * il, O[rb][1] * il); w.y = pg8::cvt_pk_bf16(O[rb][2] * il, O[rb][3] * il);
            *(u32x2*)(OLAT + ((size_t)t * 8 + l15) * 256 + 16 * rb + 4 * g) = w; }
    }
    }
}
#undef DSA_GATHER
__device__ __forceinline__ int lds_take(LAS unsigned* ctr, int lane) {
    int u = 0; if (lane == 0) u = (int)__hip_atomic_fetch_add(ctr, 1u, __ATOMIC_RELAXED, __HIP_MEMORY_SCOPE_WORKGROUP);
    return __builtin_amdgcn_readfirstlane(u);
}
__device__ __forceinline__ int dsa_query_of(int u, int G) {
    const int k = u >> 3, r = u & 7;
    int cl, bb, grp;
    if (G == 256) { const int idx = ((int)blockIdx.x >> 1) + 128 * k; cl = 1 + (idx >> 4); grp = idx & 15; bb = (int)blockIdx.x & 1; }
    else { const int P = (int)blockIdx.x + k * G; cl = 1 + (P >> 5); bb = (P >> 4) & 1; grp = P & 15; }
    const int c = (r < 4) ? 65 - cl : cl;
    return (c << 8) | (bb << 6) | (4 * grp + (r & 3));
}
__device__ __forceinline__ int dsa_token_of(int qi) { return ((qi >> 6) & 1) * SEQ + ((qi >> 8) - 1) * 64 + (qi & 63); }
__device__ __forceinline__ void phase_dsa(const Params& p, LAS unsigned char* lds, int wave, int lane, int probe) {
    LAS float* LUTA = (LAS float*)(lds + DSA_LUT); LAS unsigned* ctr = (LAS unsigned*)(lds + DSA_LUT + 155 * 8 * 4);
    const int G = (int)gridDim.x, l15 = lane & 15, g = lane >> 4;
    __syncthreads();
    for (int i = threadIdx.x; i < 155 * 8; i += 512) LUTA[i] = p.rel_bias[t5_bucket((i >> 3) - 91) * 16 + (i & 7)] * LOG2E;
    if (threadIdx.x == 0) ctr[0] = 0u;
    const int npi = (1024 - (int)blockIdx.x + G - 1) / G;
    const int nun = npi * 8;
    __syncthreads();
    for (;;) {
        const int u = lds_take(ctr, lane); if (u >= nun) break;
        dsa_unit(p, lds, dsa_query_of(u, G), wave, lane, probe);
    }
}

#define XB_TMO      128
#define XB_XCNT(j)  (256  + 64 * (j))
#define XB_XSUB(j)  (1280 + 64 * (j))
#define XB_XGEN(j)  (2304 + 64 * (j))
#define XB_TOP      3328
#define XB_TOPGEN   3392
#define XCD_BAR_WORDS 3456
#define XB_SPIN_CAP (1u << 24)
__device__ __forceinline__ unsigned xb_ld(unsigned* p)              { return __hip_atomic_load(p, __ATOMIC_RELAXED, __HIP_MEMORY_SCOPE_AGENT); }
__device__ __forceinline__ unsigned xb_add(unsigned* p, unsigned v) { return __hip_atomic_fetch_add(p, v, __ATOMIC_RELAXED, __HIP_MEMORY_SCOPE_AGENT); }
__device__ __forceinline__ unsigned xb_xcc_id() { return (unsigned)__builtin_amdgcn_s_getreg((3 << 11) | 20) & 0xFu; }
#define XB_SPIN(cond, bar) do { unsigned _sp = 0; while (cond) { __builtin_amdgcn_s_sleep(1); \
    if ((++_sp & 255u) == 0u) { if (xb_ld(&(bar)[XB_TMO])) break; if (_sp > XB_SPIN_CAP) { atomicAdd(&(bar)[XB_TMO], 1u); break; } } } } while (0)
struct XcdBarrier { unsigned* bar; unsigned x; volatile LAS unsigned* st; };
__device__ __forceinline__ XcdBarrier xcd_barrier_post(unsigned* bar, volatile LAS unsigned* st) {
    XcdBarrier b; b.bar = bar; b.x = xb_xcc_id(); b.st = st;
    if (threadIdx.x == 0) (void)xb_add(&bar[XB_XCNT(b.x)], 1u);
    return b;
}
__device__ __forceinline__ void xcd_barrier_complete(unsigned* bar, unsigned x, unsigned& nloc, unsigned& nx) {
    const unsigned G = gridDim.x * gridDim.y * gridDim.z;
    unsigned sum, cnt, mine, sp = 0u;
    for (;;) {
        sum = 0u; cnt = 0u; mine = 0u;
#pragma unroll
        for (unsigned j = 0; j < 16; ++j) { const unsigned c = xb_ld(&bar[XB_XCNT(j)]); sum += c; cnt += (c > 0u) ? 1u : 0u; mine = (j == x) ? c : mine; }
        if (sum == G) break;
        __builtin_amdgcn_s_sleep(1);
        if ((++sp & 255u) == 0u) { if (xb_ld(&bar[XB_TMO])) break; if (sp > XB_SPIN_CAP) { atomicAdd(&bar[XB_TMO], 1u); break; } }
    }
    nloc = mine > 0u ? mine : 1u; nx = cnt > 0u ? cnt : 1u;
}
__device__ __forceinline__ void xcd_barrier(const XcdBarrier& b) {
    asm volatile("s_waitcnt vmcnt(0)" ::: "memory");
    __syncthreads();
    if (threadIdx.x == 0) {
        unsigned* bar = b.bar;
        __builtin_amdgcn_s_waitcnt(0);
        unsigned nloc = b.st[0], nx = b.st[1];
        if (nloc == 0u) { xcd_barrier_complete(bar, b.x, nloc, nx); b.st[0] = nloc; b.st[1] = nx; }
        const unsigned old = xb_add(&bar[XB_XSUB(b.x)], 1u);
        const unsigned gen = old / nloc;
        if (old + 1u == (gen + 1u) * nloc) {
            __builtin_amdgcn_fence(__ATOMIC_RELEASE, "agent");
            asm volatile("s_waitcnt vmcnt(0)" ::: "memory");
            const unsigned og = xb_add(&bar[XB_TOP], 1u);
            const unsigned tg = og / nx;
            if (og + 1u == (tg + 1u) * nx) xb_add(&bar[XB_TOPGEN], 1u);
            else XB_SPIN(xb_ld(&bar[XB_TOPGEN]) == tg, bar);
            __builtin_amdgcn_fence(__ATOMIC_ACQUIRE, "agent");
            xb_add(&bar[XB_XGEN(b.x)], 1u);
            asm volatile("s_waitcnt vmcnt(0)" ::: "memory");
        } else {
            XB_SPIN(xb_ld(&bar[XB_XGEN(b.x)]) == gen, bar);
            __builtin_amdgcn_fence(__ATOMIC_ACQUIRE, "agent");
            asm volatile("s_waitcnt vmcnt(0)" ::: "memory");
        }
    }
    __syncthreads();
}

constexpr int LDS_BYTES = 147456, MISC_OFF = 147456 - 256;
constexpr int NPHASE = 8;
#ifndef ONE_LAUNCH
#define ONE_LAUNCH 1
#endif

struct KArgs { Params p; int ph_lo, ph_hi, probe, pad; };
__global__ void __launch_bounds__(512, 2) k_fwd(KArgs a) {
    extern __shared__ __attribute__((aligned(16))) unsigned char lds_raw[];
    LAS unsigned char* lds = (LAS unsigned char*)lds_raw;
    const Params& p = a.p;
    const int tid = threadIdx.x, lane = tid & 63, wave = __builtin_amdgcn_readfirstlane(tid >> 6);
    const int gw = blockIdx.x * 8 + wave, ngw = gridDim.x * 8;
    volatile LAS unsigned* misc = (volatile LAS unsigned*)(lds + MISC_OFF);
    if (tid < 64) misc[tid] = 0u;
    __syncthreads();
    XcdBarrier bar; bar.bar = WSP(unsigned, WS_CTL) + 4096; bar.x = 0; bar.st = misc;
    if (ONE_LAUNCH) bar = xcd_barrier_post(WSP(unsigned, WS_CTL) + 4096, misc);
#define IN(k) (a.ph_lo <= 0 && 0 < a.ph_hi)
#define SEAM(k) do { xcd_barrier(bar); } while (0)
#define RUNPH(k, ...) do { if (IN(k)) { constexpr int nrep_ = (PROBE_REP == (k)) ? 2 : 1; _Pragma("unroll") for (int rep = 0; rep < nrep_; ++rep) { if (rep) xcd_barrier(bar); __VA_ARGS__ } } } while (0)
    RUNPH(0, const int lane_ = opaque_tid() & 63; phase0(p, lds, gw, ngw, wave, lane_, 0, (gridDim.x == 256) ? p.jobs[13].item0 : p.nitems););
    SEAM(0);
    RUNPH(1,
        SchedInproj S{DM, (int)gridDim.x, (int)blockIdx.x, (const char*)WSP(bf16_t, WS_U), (const char*)WSP(bf16_t, WS_WIN)};
        EpiInproj E{WSP(bf16_t, WS_QA), WSP(bf16_t, WS_ZA), WSP(bf16_t, WS_IQ), WSP(bf16_t, WS_QB), WSP(bf16_t, WS_ZB), WSP(bf16_t, WS_GA), WSP(bf16_t, WS_GB), WSP(bf16_t, WS_KB), WSP(bf16_t, WS_VB),
                    WSP(float, WS_CKVRAW), WSP(bf16_t, WS_IK), WSP(float, WS_IW), 0.125f * LOG2E, p.ikn_w, p.ikn_b};
        pg8::gemm_phase<EpiInproj, SchedInproj>(lds, S, E);
        if (gridDim.x == 256 && blockIdx.x >= 202) { const int lane_ = opaque_tid() & 63; phase0(p, lds, ((int)blockIdx.x - 202) * 8 + wave, 54 * 8, wave, lane_, p.jobs[13].item0, p.nitems); });
    SEAM(1);
    RUNPH(33, const int lane_ = opaque_tid() & 63; phase_ckvnorm(p, gw, ngw, lane_););
    RUNPH(32, phase_qlat(p, lds););
    RUNPH(30, phase_diff(p, lds););
    RUNPH(31, phase_scores(p, lds););
    SEAM(3);
    RUNPH(4, const int lane_ = opaque_tid() & 63; phase_dsa(p, lds, wave, lane_, a.probe););
    SEAM(4);
    RUNPH(8, phase_oproj(p, lds););
    SEAM(8);
    RUNPH(5,
        SchedMix S{1024, (int)gridDim.x, (int)blockIdx.x, (const char*)WSP(bf16_t, WS_OZA), (const char*)WSP(bf16_t, WS_WOA), (const char*)WSP(bf16_t, WS_OZB), (const char*)WSP(bf16_t, WS_WOB)};
        EpiMix E{WSP(const bf16_t, WS_GA), WSP(const bf16_t, WS_GB), WSP(bf16_t, WS_MIX)};
        pg8::gemm_phase<EpiMix, SchedMix>(lds, S, E););
    SEAM(5);
    RUNPH(6,
        SchedOut S{DM, (int)gridDim.x, (int)blockIdx.x, (const char*)WSP(bf16_t, WS_MIX), (const char*)WSP(bf16_t, WS_WOUT)};
        EpiOut E{WSP(bf16_t, WS_OUTPRE), WSP(float, WS_SSQ)};
        pg8::gemm_phase<EpiOut, SchedOut>(lds, S, E););
    SEAM(6);
    RUNPH(7, const int lane_ = opaque_tid() & 63; phase7(p, gw, ngw, lane_););
#undef RUNPH
#undef IN
#undef SEAM
}

static void add_job(Params& p, const float* src, bf16_t* dst, int K, int N, int col0, int ncols, int row0) {
    TJob& j = p.jobs[p.njobs++]; j.src = src; j.dst = dst; j.K = K; j.N = N; j.col0 = col0; j.nblk = (ncols + 31) / 32; j.row0 = row0; j.item0 = p.nitems; p.nitems += (K / 64) * j.nblk;
}
extern "C" void kernel_launch(void* const* d_in, const int* in_sizes, int n_in, void* d_out, int out_size, void* d_ws, size_t ws_size, hipStream_t stream) {
    if (n_in != 16 || ws_size < WS_END) { fprintf(stderr, "kernel_launch: unexpected arguments (n_in %d, ws %zu)\n", n_in, ws_size); return; }
    static int grid = 0;
    if (!grid) {
        int dev = 0, cus = 0, per_cu = 0;
        (void)hipGetDevice(&dev); (void)hipDeviceGetAttribute(&cus, hipDeviceAttributeMultiprocessorCount, dev);
        (void)hipFuncSetAttribute((const void*)k_fwd, hipFuncAttributeMaxDynamicSharedMemorySize, LDS_BYTES);
        (void)hipOccupancyMaxActiveBlocksPerMultiprocessor(&per_cu, (const void*)k_fwd, 512, LDS_BYTES);
        (void)hipGetLastError();
        grid = cus > 0 ? cus : 256;
        if (per_cu < 1) fprintf(stderr, "kernel_launch: occupancy query reports %d blocks per CU\n", per_cu);
    }
    KArgs a; memset(&a, 0, sizeof(a));
    Params& p = a.p;
    const float** in = (const float**)d_in;
    p.x = in[0]; p.meta = in[1]; p.rel_bias = in[2]; p.pre_w = in[3]; p.w_in = in[4]; p.kv_norm_w = in[5]; p.w_uk = in[6]; p.w_uv = in[7]; p.ikn_w = in[8]; p.ikn_b = in[9];
    p.lam_p = in[10]; p.subln_w = in[11]; p.w_o_a = in[12]; p.w_o_b = in[13]; p.w_out = in[14]; p.post_w = in[15];
    p.out = (float*)d_out; p.ws = (unsigned char*)d_ws;
    bf16_t* WIN = (bf16_t*)(p.ws + WS_WIN);
    const int NIN = 11600;
    add_job(p, p.w_in, WIN, DM, NIN, 0, 1024, 0);
    add_job(p, p.w_in, WIN, DM, NIN, 1280, 1024, 1024);
    add_job(p, p.w_in, WIN, DM, NIN, 2304, 1024, 2048);
    add_job(p, p.w_in, WIN, DM, NIN, 3408, 1024, 3072);
    add_job(p, p.w_in, WIN, DM, NIN, 6480, 1024, 4096);
    add_job(p, p.w_in, WIN, DM, NIN, 7504, 2048, 5120);
    add_job(p, p.w_in, WIN, DM, NIN, 9552, 2048, 7168);
    add_job(p, p.w_in, WIN, DM, NIN, 4432, 1024, 9216);
    add_job(p, p.w_in, WIN, DM, NIN, 5456, 1024, 10240);
    add_job(p, p.w_in, WIN, DM, NIN, 1024, 256, 11264);
    add_job(p, p.w_in, WIN, DM, NIN, 3328, 32, 11520);
    add_job(p, p.w_in, WIN, DM, NIN, 3392, 32, 11520 + 32);
    add_job(p, p.w_in, WIN, DM, NIN, 3360, 32, 11520 + 128);
    add_job(p, p.w_o_a, (bf16_t*)(p.ws + WS_WOA), 1024, DM, 0, DM, 0);
    add_job(p, p.w_o_b, (bf16_t*)(p.ws + WS_WOB), 1024, DM, 0, DM, 0);
    add_job(p, p.w_out, (bf16_t*)(p.ws + WS_WOUT), DM, DM, 0, DM, 0);
    add_job(p, p.w_uv, (bf16_t*)(p.ws + WS_WUVT), 256, 1024, 0, 1024, 0);
    (void)hipMemsetAsync((char*)d_ws + WS_CTL, 0, CTL_BYTES, stream);
#if ONE_LAUNCH
    a.ph_lo = 0; a.ph_hi = NPHASE; a.probe = PROBE_REP;
    hipLaunchKernelGGL(k_fwd, dim3(grid), dim3(512), LDS_BYTES, stream, a);
#else
    for (int ph = 0; ph < NPHASE; ++ph) { a.ph_lo = ph; a.ph_hi = ph + 1; hipLaunchKernelGGL(k_fwd, dim3(grid), dim3(512), LDS_BYTES, stream, a); }
#endif
}
```

```cpp
#include <hip/hip_runtime.h>
#include <cstdio>
#include <cstdint>
#include <cstring>

#ifndef PROBE_REP
#define PROBE_REP (-1)
#endif
#define LAS __attribute__((address_space(3)))
#define GAS __attribute__((address_space(1)))
typedef unsigned short bf16_t;
typedef short bf16x8 __attribute__((ext_vector_type(8)));
typedef float f32x4 __attribute__((ext_vector_type(4)));
typedef unsigned u32x4 __attribute__((ext_vector_type(4)));
typedef unsigned u32x2 __attribute__((ext_vector_type(2)));

constexpr int DM = 2048, NB = 2, SEQ = 4096, NMETA = 16, TK = SEQ + NMETA  , MTOK = NB * SEQ  , MKEY = NB * TK  ;
constexpr int UROWS = 8448;
constexpr int NPAD = 11776;
constexpr float EPS = 1e-6f;
constexpr float LOG2E = 1.4426950408889634f;
constexpr size_t SC_PER_B = 8585216;

constexpr size_t MiB = 1u << 20;
constexpr size_t WS_CTL = 0, CTL_BYTES = 1 * MiB;
constexpr size_t WS_U = 1 * MiB;
constexpr size_t WS_WIN = 34 * MiB;
constexpr size_t WS_SC = 1 * MiB;
constexpr size_t WS_MIX = 1 * MiB;
constexpr size_t WS_WOA = 80 * MiB, WS_WOB = 84 * MiB, WS_WOUT = 88 * MiB, WS_WUK = 96 * MiB, WS_WUVT = 96 * MiB + 512 * 1024;
constexpr size_t WS_QA = 97 * MiB, WS_IQ = 113 * MiB, WS_QB = 129 * MiB, WS_ZA = 145 * MiB, WS_ZB = 161 * MiB, WS_GA = 177 * MiB, WS_GB = 209 * MiB;
constexpr size_t WS_OLAT = 241 * MiB;
constexpr size_t WS_OZA = 129 * MiB;
constexpr size_t WS_KB = 241 * MiB, WS_VB = 258 * MiB, WS_CKVRAW = 275 * MiB, WS_IKRAW = 284 * MiB, WS_IW = 287 * MiB, WS_CKV = 288 * MiB, WS_IK = 293 * MiB;
constexpr size_t WS_QLAT = 295 * MiB;
constexpr size_t WS_OUTPRE = 295 * MiB;
constexpr size_t WS_OZB = 327 * MiB, WS_SSQ = 343 * MiB, WS_END = 344 * MiB;

__device__ __forceinline__ int opaque_tid() { int t = threadIdx.x; asm volatile("" : "+v"(t)); return t; }
__device__ __forceinline__ float bf2f(unsigned short u) { return __uint_as_float(((unsigned)u) << 16); }
__device__ __forceinline__ unsigned f2bf(float f) { unsigned u = __float_as_uint(f); return (u + 0x7fffu + ((u >> 16) & 1u)) >> 16; }
__device__ __forceinline__ unsigned pk2(float lo, float hi) { return f2bf(lo) | (f2bf(hi) << 16); }
__device__ __forceinline__ float bflo(unsigned w) { return __uint_as_float(w << 16); }
__device__ __forceinline__ float bfhi(unsigned w) { return __uint_as_float(w & 0xffff0000u); }
__device__ __forceinline__ float wave_sum(float v) {
#pragma unroll
    for (int o = 1; o < 64; o <<= 1) v += __shfl_xor(v, o);
    return v;
}
__device__ __forceinline__ float silu_f(float x) { return x * __builtin_amdgcn_rcpf(1.f + __expf(-x)); }
__device__ __forceinline__ int t5_bucket(int rel) {
    const int n = rel < 0 ? -rel : rel; int f;
    if (n < 8) f = n; else if (n < 12) f = 8; else if (n < 16) f = 9; else if (n < 23) f = 10; else if (n < 32) f = 11; else if (n < 46) f = 12; else if (n < 64) f = 13; else if (n < 91) f = 14; else f = 15;
    return (rel > 0 ? 16 : 0) + f;
}
__device__ __forceinline__ size_t sc_off(int b, int j) {
    const int c = 1 + (j >> 6);
    return (size_t)b * SC_PER_B + (size_t)1024 * (c - 1) + (size_t)2048 * (c - 1) * c + (size_t)(j & 63) * (16 + 64 * c);
}

namespace pg8 {
constexpr int BM = 256, BK = 64, HALF = 128, HTB = HALF * BK * 2, STAGE_BYTES = 8 * HTB, NXCD = 8, WGM = 8;
__host__ __device__ __forceinline__ int lds_byte(int r, int c) { const int st = (r >> 4) * 2 + (c >> 5), rr = r & 15, cc = c & 31, ob = rr * 64 + cc * 2; return st * 1024 + (ob ^ (((ob >> 9) & 1) << 5)); }
__host__ __device__ __forceinline__ void stage_rc(int b, int& R, int& C) { const int st = b / 1024, sb = b % 1024, swz = sb ^ (((sb >> 9) & 1) << 5); R = (st >> 1) * 16 + swz / 64; C = (st & 1) * 32 + (swz % 64) / 2; }
__host__ __device__ __forceinline__ int perm32(int rho) { const int n = rho >> 4, i = rho & 15; return 8 * (i >> 2) + 4 * n + (i & 3); }

struct Unit { int pm, pn, sub; };
__device__ __forceinline__ unsigned cvt_pk_bf16(float lo, float hi) { unsigned r; asm volatile("v_cvt_pk_bf16_f32 %0, %1, %2" : "=v"(r) : "v"(lo), "v"(hi)); return r; }

__device__ __forceinline__ void tile_of(int L, int nM, int nN, int& pm, int& pn) {
    const int nwg = nM * nN; int wgid = L; { const int q = nwg / NXCD, r = nwg % NXCD, xcd = wgid % NXCD, off = wgid / NXCD; wgid = (xcd < r ? xcd * (q + 1) : r * (q + 1) + (xcd - r) * q) + off; }
    const int nig = WGM * nN, gid = wgid / nig, fm = gid * WGM, gsz = (nM - fm) < WGM ? (nM - fm) : WGM;
    pm = fm + ((wgid % nig) % gsz); pn = (wgid % nig) / gsz;
}

template <class Epi, class Sched, bool ALIGN_EPI = true, bool SP2 = true>
__device__ __forceinline__ void gemm_phase(LAS unsigned char* lds, const Sched& S, const Epi& E) {
    const int tid = opaque_tid(), wid = __builtin_amdgcn_readfirstlane(tid >> 6), lane = tid & 63, wr = wid >> 2, wc = wid & 3, fr = lane & 15, fq = lane >> 4;
    const int K = S.K, nt = K / BK;
    unsigned voffA[2], voffB[2];
#pragma unroll
    for (int i = 0; i < 2; ++i) { int R, C; stage_rc(tid * 16 + i * 8192, R, C); const int Rb = Epi::PERM ? ((R & ~31) + perm32(R & 31)) : R;
        voffA[i] = (unsigned)(R * K + C) * 2u; voffB[i] = (unsigned)(Rb * K + C) * 2u; }
    const size_t kstep = (size_t)(BK * 2);
    const size_t hstep = (size_t)HALF * K * 2;
    const unsigned ldsw = (unsigned)wid * 1024u;
    const int aoff = lds_byte(wr * 64 + fr, fq * 8), boff = lds_byte(wc * 32 + fr, fq * 8);
#define PG8_SA(b, h) (((b) * 2 + (h)) * HTB)
#define PG8_SB(b, h) ((4 + (b) * 2 + (h)) * HTB)
#define PG8_STAGE(bufoff, gbase, voff) do { _Pragma("unroll") for (int _i = 0; _i < 2; ++_i) \
        __builtin_amdgcn_global_load_lds((const unsigned*)((const char*)(gbase) + (voff)[_i]), (LAS unsigned*)(lds + (bufoff) + ldsw + _i * 8192), 16, 0, 0); } while (0)
#define PG8_LDA(dst, b, h) do { _Pragma("unroll") for (int m = 0; m < 4; ++m) _Pragma("unroll") for (int k = 0; k < 2; ++k) dst[m][k] = *(const LAS bf16x8*)(lds + PG8_SA(b, h) + aoff + m * 2048 + k * 1024); } while (0)
#define PG8_LDB(dst, b, h) do { _Pragma("unroll") for (int n = 0; n < 2; ++n) _Pragma("unroll") for (int k = 0; k < 2; ++k) dst[n][k] = *(const LAS bf16x8*)(lds + PG8_SB(b, h) + boff + n * 2048 + k * 1024); } while (0)
#define PG8_MMA(ai, bj, At, Bt) do { __builtin_amdgcn_s_setprio(1); _Pragma("unroll") for (int m = 0; m < 4; ++m) _Pragma("unroll") for (int n = 0; n < 2; ++n) _Pragma("unroll") for (int k = 0; k < 2; ++k) \
        acc[ai][bj][m][n] = __builtin_amdgcn_mfma_f32_16x16x32_bf16(Bt[n][k], At[m][k], acc[ai][bj][m][n], 0, 0, 0); __builtin_amdgcn_s_setprio(0); } while (0)
#define PG8_WAIT_V(n) asm volatile("s_waitcnt vmcnt(" #n ")" ::: "memory")
#define PG8_WAIT_L(n) asm volatile("s_waitcnt lgkmcnt(" #n ")" ::: "memory")
#define PG8_BAR __builtin_amdgcn_s_barrier()
#define PG8_SCHED __builtin_amdgcn_sched_barrier(0)
    Unit cur, nxt; int ui = 0;
    if (!S.next(0, cur)) return;
    f32x4 acc[2][2][4][2];
#pragma unroll
    for (int a = 0; a < 2; ++a)
#pragma unroll
        for (int b = 0; b < 2; ++b)
#pragma unroll
            for (int m = 0; m < 4; ++m)
#pragma unroll
                for (int n = 0; n < 2; ++n) acc[a][b][m][n] = (f32x4){0.f, 0.f, 0.f, 0.f};
    bf16x8 At[4][2], B0[2][2], B1[2][2];
    const char* cA = S.a_ptr(cur); const char* cB = S.b_ptr(cur);
    if constexpr (SP2) {
        PG8_STAGE(PG8_SB(0, 0), cB, voffB); PG8_STAGE(PG8_SB(0, 1), cB + hstep, voffB); PG8_STAGE(PG8_SA(0, 0), cA, voffA); PG8_STAGE(PG8_SA(0, 1), cA + hstep, voffA);
        if (wr == 1) PG8_BAR;
        PG8_WAIT_V(2); PG8_BAR;
        PG8_STAGE(PG8_SB(1, 0), cB + kstep, voffB); PG8_STAGE(PG8_SA(1, 0), cA + kstep, voffA); PG8_STAGE(PG8_SB(1, 1), cB + hstep + kstep, voffB);
        PG8_WAIT_V(6); PG8_BAR;
    } else {
        PG8_STAGE(PG8_SB(0, 0), cB, voffB); PG8_STAGE(PG8_SA(0, 0), cA, voffA); PG8_STAGE(PG8_SB(0, 1), cB + hstep, voffB); PG8_STAGE(PG8_SA(0, 1), cA + hstep, voffA);
        if (wr == 1) PG8_BAR;
        PG8_WAIT_V(4); PG8_BAR;
        PG8_STAGE(PG8_SB(1, 0), cB + kstep, voffB); PG8_STAGE(PG8_SA(1, 0), cA + kstep, voffA); PG8_STAGE(PG8_SB(1, 1), cB + hstep + kstep, voffB);
        PG8_WAIT_V(6); PG8_BAR;
    }
    for (;;) {
        const bool has_next = S.next(ui + 1, nxt);
        const char* nA = has_next ? S.a_ptr(nxt) : cA; const char* nB = has_next ? S.b_ptr(nxt) : cB;
        for (int t = 0; t < nt; t += 2) {
            const bool last = (t == nt - 2);
            const char* a1 = cA + (size_t)(t + 1) * kstep;
            const char* a2 = last ? nA : cA + (size_t)(t + 2) * kstep; const char* b2 = last ? nB : cB + (size_t)(t + 2) * kstep;
            const char* a3 = a2 + kstep; const char* b3 = b2 + kstep;
            if constexpr (SP2) {
            PG8_LDB(B0, 0, 0); PG8_LDB(B1, 0, 1); PG8_SCHED; PG8_LDA(At, 0, 0); PG8_STAGE(PG8_SA(1, 1), a1 + hstep, voffA);
            PG8_WAIT_V(8); PG8_WAIT_L(0); PG8_BAR; PG8_MMA(0, 0, At, B0); PG8_MMA(0, 1, At, B1); PG8_BAR; PG8_SCHED;
            PG8_LDA(At, 0, 1); PG8_STAGE(PG8_SB(0, 0), b2, voffB); PG8_STAGE(PG8_SB(0, 1), b2 + hstep, voffB); PG8_STAGE(PG8_SA(0, 0), a2, voffA);
            PG8_WAIT_V(8); PG8_WAIT_L(0); PG8_BAR; PG8_MMA(1, 0, At, B0); PG8_MMA(1, 1, At, B1); PG8_BAR; PG8_SCHED;
            PG8_LDB(B0, 1, 0); PG8_LDB(B1, 1, 1); PG8_SCHED; PG8_LDA(At, 1, 0); PG8_STAGE(PG8_SA(0, 1), a2 + hstep, voffA);
            PG8_WAIT_V(8); PG8_WAIT_L(0); PG8_BAR; PG8_MMA(0, 0, At, B0); PG8_MMA(0, 1, At, B1); PG8_BAR; PG8_SCHED;
            PG8_LDA(At, 1, 1); PG8_STAGE(PG8_SB(1, 0), b3, voffB); PG8_STAGE(PG8_SB(1, 1), b3 + hstep, voffB); PG8_STAGE(PG8_SA(1, 0), a3, voffA);
            PG8_WAIT_V(8); PG8_WAIT_L(0); PG8_BAR; PG8_MMA(1, 0, At, B0); PG8_MMA(1, 1, At, B1); PG8_BAR; PG8_SCHED;
            } else {
            PG8_LDB(B0, 0, 0); PG8_SCHED; PG8_LDA(At, 0, 0); PG8_STAGE(PG8_SA(1, 1), a1 + hstep, voffA);
            PG8_WAIT_L(8); PG8_BAR; PG8_WAIT_L(0); PG8_MMA(0, 0, At, B0); PG8_BAR; PG8_SCHED;
            PG8_LDB(B1, 0, 1); PG8_STAGE(PG8_SB(0, 0), b2, voffB);
            PG8_BAR; PG8_WAIT_L(0); PG8_MMA(0, 1, At, B1); PG8_BAR;
            PG8_LDA(At, 0, 1); PG8_STAGE(PG8_SA(0, 0), a2, voffA);
            PG8_BAR; PG8_WAIT_L(0); PG8_MMA(1, 0, At, B0); PG8_BAR; PG8_SCHED;
            PG8_STAGE(PG8_SB(0, 1), b2 + hstep, voffB);
            PG8_WAIT_V(6); PG8_BAR; PG8_MMA(1, 1, At, B1); PG8_BAR;
            PG8_LDB(B0, 1, 0); PG8_SCHED; PG8_LDA(At, 1, 0); PG8_STAGE(PG8_SA(0, 1), a2 + hstep, voffA);
            PG8_WAIT_L(8); PG8_BAR; PG8_WAIT_L(0); PG8_MMA(0, 0, At, B0); PG8_BAR; PG8_SCHED;
            PG8_LDB(B1, 1, 1); PG8_STAGE(PG8_SB(1, 0), b3, voffB);
            PG8_BAR; PG8_WAIT_L(0); PG8_MMA(0, 1, At, B1); PG8_BAR;
            PG8_LDA(At, 1, 1); PG8_STAGE(PG8_SA(1, 0), a3, voffA);
            PG8_BAR; PG8_WAIT_L(0); PG8_MMA(1, 0, At, B0); PG8_BAR; PG8_SCHED;
            PG8_STAGE(PG8_SB(1, 1), b3 + hstep, voffB);
            PG8_WAIT_V(6); PG8_BAR; PG8_MMA(1, 1, At, B1); PG8_BAR;
            }
        }
        if constexpr (ALIGN_EPI) { if (wr == 0) PG8_BAR; }
        E(acc, cur, wr, wc, fr, fq);
        if (!has_next) break;
        if (!E.keep_acc(cur)) {
#pragma unroll
        for (int a = 0; a < 2; ++a)
#pragma unroll
            for (int b = 0; b < 2; ++b)
#pragma unroll
                for (int m = 0; m < 4; ++m)
#pragma unroll
                    for (int n = 0; n < 2; ++n) acc[a][b][m][n] = (f32x4){0.f, 0.f, 0.f, 0.f};
        }
        cur = nxt; cA = nA; cB = nB; ++ui;
        if constexpr (ALIGN_EPI) { if (wr == 1) PG8_BAR; }
    }
    PG8_WAIT_V(0);
    if constexpr (!ALIGN_EPI) { if (wr == 0) PG8_BAR; }
    PG8_BAR;
#undef PG8_SA
#undef PG8_SB
#undef PG8_STAGE
#undef PG8_LDA
#undef PG8_LDB
#undef PG8_MMA
#undef PG8_WAIT_V
#undef PG8_WAIT_L
#undef PG8_BAR
#undef PG8_SCHED
}
}

struct SchedInproj {
    int K, G, c; const char* A; const char* B;
    __device__ __forceinline__ bool next(int i, pg8::Unit& u) const {
        const int L = i * G + c; u.sub = 0;
        if (L < 1472) { pg8::tile_of(L, 32, 46, u.pm, u.pn); return true; }
        if (L < 1482) { u.pm = 32; u.pn = 36 + (L - 1472); return true; }
        return false;
    }
    __device__ __forceinline__ const char* a_ptr(const pg8::Unit& u) const { return A + (size_t)u.pm * 256 * K * 2; }
    __device__ __forceinline__ const char* b_ptr(const pg8::Unit& u) const { return B + (size_t)u.pn * 256 * K * 2; }
};
struct EpiInproj {
    static constexpr bool PERM = true;
    bf16_t *QA, *ZA, *IQ, *QB, *ZB, *GA, *GB, *KB, *VB; float *CKVRAW; bf16_t* IKN; float* IW; float qb_scale; const float *ikn_w, *ikn_b;
    __device__ __forceinline__ bool keep_acc(const pg8::Unit&) const { return false; }
    __device__ __forceinline__ void operator()(f32x4 (&acc)[2][2][4][2], const pg8::Unit& u, int wr, int wc, int fr, int fq) const {
        const int pn = u.pn;
        if (pn < 44) {
            bf16_t* base; int ldc = 1024, ct, act = 0; bool kside = false;
            if (pn < 4) { base = QA; ct = pn; } else if (pn < 8) { base = ZA; ct = pn - 4; act = 1; } else if (pn < 12) { base = IQ; ct = pn - 8; }
            else if (pn < 16) { base = QB; ct = pn - 12; act = 2; } else if (pn < 20) { base = ZB; ct = pn - 16; act = 1; }
            else if (pn < 28) { base = GA; ct = pn - 20; ldc = 2048; } else if (pn < 36) { base = GB; ct = pn - 28; ldc = 2048; }
            else if (pn < 40) { base = KB; ct = pn - 36; kside = true; } else { base = VB; ct = pn - 40; kside = true; }
            const float sc = (act == 2) ? qb_scale : 1.f;
#pragma unroll
            for (int ai = 0; ai < 2; ++ai)
#pragma unroll
                for (int m = 0; m < 4; ++m) {
                    const int r = u.pm * 256 + ai * 128 + wr * 64 + m * 16 + fr;
                    long drow = r, drow2 = -1; bool ok = true;
                    if (kside) { if (r < MTOK) drow = (long)(r >> 12) * TK + NMETA + (r & 4095); else { const int i = r - MTOK; ok = i < NMETA; drow = i; drow2 = TK + i; } }
#pragma unroll
                    for (int bj = 0; bj < 2; ++bj) {
                        f32x4 v0 = acc[ai][bj][m][0], v1 = acc[ai][bj][m][1];
                        if (act == 1) {
#pragma unroll
                            for (int e = 0; e < 4; ++e) { v0[e] = silu_f(v0[e]); v1[e] = silu_f(v1[e]); }
                        }
                        v0 = v0 * sc; v1 = v1 * sc;
                        u32x4 w; w.x = pg8::cvt_pk_bf16(v0[0], v0[1]); w.y = pg8::cvt_pk_bf16(v0[2], v0[3]); w.z = pg8::cvt_pk_bf16(v1[0], v1[1]); w.w = pg8::cvt_pk_bf16(v1[2], v1[3]);
                        const int col = ct * 256 + bj * 128 + wc * 32 + 8 * fq;
                        if (ok) { *(u32x4*)(base + (size_t)drow * ldc + col) = w; if (drow2 >= 0) *(u32x4*)(base + (size_t)drow2 * ldc + col) = w; }
                    }
                }
        } else {
#pragma unroll
            for (int ai = 0; ai < 2; ++ai)
#pragma unroll
                for (int m = 0; m < 4; ++m) {
                    const int r = u.pm * 256 + ai * 128 + wr * 64 + m * 16 + fr;
                    long drow, drow2 = -1; bool ok = true;
                    if (r < MTOK) drow = (long)(r >> 12) * TK + NMETA + (r & 4095); else { const int i = r - MTOK; ok = i < NMETA; drow = i; drow2 = TK + i; }
                    if (pn == 44) {
#pragma unroll
                        for (int bj = 0; bj < 2; ++bj) {
                            const f32x4 v0 = acc[ai][bj][m][0], v1 = acc[ai][bj][m][1];
                            const int col = bj * 128 + wc * 32 + 8 * fq;
                            if (ok) { float* p = CKVRAW + (size_t)drow * 256 + col; *(f32x4*)p = v0; *(f32x4*)(p + 4) = v1;
                                      if (drow2 >= 0) { float* p2 = CKVRAW + (size_t)drow2 * 256 + col; *(f32x4*)p2 = v0; *(f32x4*)(p2 + 4) = v1; } }
                        }
                    } else if (wc == 0) {
                        const f32x4 a0 = acc[ai][0][m][0], a1 = acc[ai][0][m][1], b0 = acc[ai][1][m][0], b1 = acc[ai][1][m][1];
                        float s = ((a0[0] + a0[1]) + (a0[2] + a0[3])) + ((a1[0] + a1[1]) + (a1[2] + a1[3])) + ((b0[0] + b0[1]) + (b0[2] + b0[3])) + ((b1[0] + b1[1]) + (b1[2] + b1[3]));
                        s += __shfl_xor(s, 16); s += __shfl_xor(s, 32);
                        const float mu = s * (1.f / 64.f);
                        const f32x4 da0 = a0 - mu, da1 = a1 - mu, db0 = b0 - mu, db1 = b1 - mu;
                        float q = ((da0[0] * da0[0] + da0[1] * da0[1]) + (da0[2] * da0[2] + da0[3] * da0[3])) + ((da1[0] * da1[0] + da1[1] * da1[1]) + (da1[2] * da1[2] + da1[3] * da1[3]))
                                + ((db0[0] * db0[0] + db0[1] * db0[1]) + (db0[2] * db0[2] + db0[3] * db0[3])) + ((db1[0] * db1[0] + db1[1] * db1[1]) + (db1[2] * db1[2] + db1[3] * db1[3]));
                        q += __shfl_xor(q, 16); q += __shfl_xor(q, 32);
                        const float rs = rsqrtf(q * (1.f / 64.f) + EPS);
                        const f32x4 wa0 = *(const f32x4*)(ikn_w + 8 * fq), wa1 = *(const f32x4*)(ikn_w + 8 * fq + 4), wb0 = *(const f32x4*)(ikn_w + 32 + 8 * fq), wb1 = *(const f32x4*)(ikn_w + 36 + 8 * fq);
                        const f32x4 ba0 = *(const f32x4*)(ikn_b + 8 * fq), ba1 = *(const f32x4*)(ikn_b + 8 * fq + 4), bb0 = *(const f32x4*)(ikn_b + 32 + 8 * fq), bb1 = *(const f32x4*)(ikn_b + 36 + 8 * fq);
                        const f32x4 ya0 = da0 * rs * wa0 + ba0, ya1 = da1 * rs * wa1 + ba1, yb0 = db0 * rs * wb0 + bb0, yb1 = db1 * rs * wb1 + bb1;
                        u32x4 pa, pb;
                        pa.x = pg8::cvt_pk_bf16(ya0[0], ya0[1]); pa.y = pg8::cvt_pk_bf16(ya0[2], ya0[3]); pa.z = pg8::cvt_pk_bf16(ya1[0], ya1[1]); pa.w = pg8::cvt_pk_bf16(ya1[2], ya1[3]);
                        pb.x = pg8::cvt_pk_bf16(yb0[0], yb0[1]); pb.y = pg8::cvt_pk_bf16(yb0[2], yb0[3]); pb.z = pg8::cvt_pk_bf16(yb1[0], yb1[1]); pb.w = pg8::cvt_pk_bf16(yb1[2], yb1[3]);
                        if (ok) { *(u32x4*)(IKN + (size_t)drow * 64 + 8 * fq) = pa; *(u32x4*)(IKN + (size_t)drow * 64 + 32 + 8 * fq) = pb;
                                  if (drow2 >= 0) { *(u32x4*)(IKN + (size_t)drow2 * 64 + 8 * fq) = pa; *(u32x4*)(IKN + (size_t)drow2 * 64 + 32 + 8 * fq) = pb; } }
                    } else if (wc == 1) {
                        const f32x4 v0 = acc[ai][0][m][0], v1 = acc[ai][0][m][1];
                        if (fq < 2 && r < MTOK) { float* p = IW + (size_t)r * 16 + 8 * fq; *(f32x4*)p = v0 * 0.03125f; *(f32x4*)(p + 4) = v1 * 0.03125f; }
                    }
                }
        }
    }
};
struct SchedMix {
    int K, G, c; const char *A0, *B0, *A1, *B1;
    __device__ __forceinline__ bool next(int i, pg8::Unit& u) const {
        const int L = (i >> 1) * G + c; if (L >= 256) return false;
        pg8::tile_of(L, 32, 8, u.pm, u.pn); u.sub = i & 1; return true;
    }
    __device__ __forceinline__ const char* a_ptr(const pg8::Unit& u) const { return (u.sub ? A1 : A0) + (size_t)u.pm * 256 * K * 2; }
    __device__ __forceinline__ const char* b_ptr(const pg8::Unit& u) const { return (u.sub ? B1 : B0) + (size_t)u.pn * 256 * K * 2; }
};
struct EpiMix {
    static constexpr bool PERM = true;
    const bf16_t *GA, *GB; bf16_t* MIX;
    __device__ __forceinline__ bool keep_acc(const pg8::Unit& u) const { return u.sub == 0; }
    __device__ __forceinline__ void operator()(f32x4 (&acc)[2][2][4][2], const pg8::Unit& u, int wr, int wc, int fr, int fq) const {
#pragma unroll
        for (int ai = 0; ai < 2; ++ai)
#pragma unroll
            for (int m = 0; m < 4; ++m) {
                const int r = u.pm * 256 + ai * 128 + wr * 64 + m * 16 + fr;
#pragma unroll
                for (int bj = 0; bj < 2; ++bj) {
                    const int col = u.pn * 256 + bj * 128 + wc * 32 + 8 * fq;
                    const u32x4 ga = *(const u32x4*)(GA + (size_t)r * DM + col), gb = *(const u32x4*)(GB + (size_t)r * DM + col);
                    float f[8];
#pragma unroll
                    for (int e = 0; e < 4; ++e) {
                        const unsigned wa = ga[e], wb = gb[e];
#pragma unroll
                        for (int hl = 0; hl < 2; ++hl) {
                            float a = hl ? bfhi(wa) : bflo(wa), b = hl ? bfhi(wb) : bflo(wb);
                            a = fminf(fmaxf(a, -30.f), 30.f); b = fminf(fmaxf(b, -30.f), 30.f);
                            const float ea = __expf(-a), eb = __expf(-b);
                            f[2 * e + hl] = (u.sub == 0) ? (1.f + eb) * __builtin_amdgcn_rcpf(1.f + ea) : __builtin_amdgcn_rcpf(1.f + eb);
                        }
                    }
                    f32x4 v0 = acc[ai][bj][m][0], v1 = acc[ai][bj][m][1];
#pragma unroll
                    for (int e = 0; e < 4; ++e) { v0[e] *= f[e]; v1[e] *= f[4 + e]; }
                    if (u.sub == 0) { acc[ai][bj][m][0] = v0; acc[ai][bj][m][1] = v1; }
                    else { u32x4 w; w.x = pg8::cvt_pk_bf16(v0[0], v0[1]); w.y = pg8::cvt_pk_bf16(v0[2], v0[3]); w.z = pg8::cvt_pk_bf16(v1[0], v1[1]); w.w = pg8::cvt_pk_bf16(v1[2], v1[3]);
                           *(u32x4*)(MIX + (size_t)r * DM + col) = w; }
                }
            }
    }
};
struct SchedOut {
    int K, G, c; const char *A, *B;
    __device__ __forceinline__ bool next(int i, pg8::Unit& u) const { const int L = i * G + c; if (L >= 256) return false; pg8::tile_of(L, 32, 8, u.pm, u.pn); u.sub = 0; return true; }
    __device__ __forceinline__ const char* a_ptr(const pg8::Unit& u) const { return A + (size_t)u.pm * 256 * K * 2; }
    __device__ __forceinline__ const char* b_ptr(const pg8::Unit& u) const { return B + (size_t)u.pn * 256 * K * 2; }
};
struct EpiOut {
    static constexpr bool PERM = true;
    bf16_t* OUTPRE; float* SSQ;
    __device__ __forceinline__ bool keep_acc(const pg8::Unit&) const { return false; }
    __device__ __forceinline__ void operator()(f32x4 (&acc)[2][2][4][2], const pg8::Unit& u, int wr, int wc, int fr, int fq) const {
#pragma unroll
        for (int ai = 0; ai < 2; ++ai)
#pragma unroll
            for (int m = 0; m < 4; ++m) {
                const int r = u.pm * 256 + ai * 128 + wr * 64 + m * 16 + fr; float ss = 0.f;
#pragma unroll
                for (int bj = 0; bj < 2; ++bj) {
                    const f32x4 v0 = acc[ai][bj][m][0], v1 = acc[ai][bj][m][1];
                    ss += (v0[0] * v0[0] + v0[1] * v0[1]) + (v0[2] * v0[2] + v0[3] * v0[3]) + (v1[0] * v1[0] + v1[1] * v1[1]) + (v1[2] * v1[2] + v1[3] * v1[3]);
                    u32x4 w; w.x = pg8::cvt_pk_bf16(v0[0], v0[1]); w.y = pg8::cvt_pk_bf16(v0[2], v0[3]); w.z = pg8::cvt_pk_bf16(v1[0], v1[1]); w.w = pg8::cvt_pk_bf16(v1[2], v1[3]);
                    *(u32x4*)(OUTPRE + (size_t)r * DM + u.pn * 256 + bj * 128 + wc * 32 + 8 * fq) = w;
                }
                ss += __shfl_xor(ss, 16); ss += __shfl_xor(ss, 32);
                if (fq == 0) SSQ[(size_t)r * 32 + u.pn * 4 + wc] = ss;
            }
    }
};

struct TJob { const float* src; bf16_t* dst; int K, N, col0, nblk, row0, item0; };
struct Params {
    const float *x, *meta, *rel_bias, *pre_w, *w_in, *kv_norm_w, *w_uk, *w_uv, *ikn_w, *ikn_b, *lam_p, *subln_w, *w_o_a, *w_o_b, *w_out, *post_w;
    float* out; unsigned char* ws;
    TJob jobs[17]; int njobs, nitems;
};
#define WSP(T, off) ((T*)(p.ws + (off)))

__device__ __forceinline__ void p0_transpose_item(const TJob& jb, LAS float* scr, int item, int lane) {
    const int kb = item / jb.nblk, nb = item % jb.nblk, k0 = 64 * kb, n0 = jb.col0 + 32 * nb;
#pragma unroll 8
    for (int i = 0; i < 32; ++i) { const int kk = 2 * i + (lane >> 5); scr[kk * 33 + (lane & 31)] = __builtin_nontemporal_load(jb.src + (size_t)(k0 + kk) * jb.N + n0 + (lane & 31)); }
    asm volatile("s_waitcnt lgkmcnt(0)" ::: "memory");
    const int c = lane & 7;
#pragma unroll
    for (int j = 0; j < 4; ++j) { const int n = (lane >> 3) + 8 * j; const LAS float* s = scr + (8 * c) * 33 + n;
        u32x4 o; o.x = pk2(s[0 * 33], s[1 * 33]); o.y = pk2(s[2 * 33], s[3 * 33]); o.z = pk2(s[4 * 33], s[5 * 33]); o.w = pk2(s[6 * 33], s[7 * 33]);
        *(u32x4*)(jb.dst + (size_t)(jb.row0 + 32 * nb + n) * jb.K + k0 + 8 * c) = o; }
    asm volatile("s_waitcnt lgkmcnt(0)" ::: "memory");
}
__device__ __forceinline__ void p0_norm_row(const float* xrow, const float* g, bf16_t* orow, int lane) {
    const f32x4* xr = (const f32x4*)xrow + lane; const f32x4* gr = (const f32x4*)g + lane;
    f32x4 v[8]; float s = 0.f;
#pragma unroll
    for (int j = 0; j < 8; ++j) { v[j] = __builtin_nontemporal_load(xr + 64 * j); s += (v[j].x * v[j].x + v[j].y * v[j].y) + (v[j].z * v[j].z + v[j].w * v[j].w); }
    const float rstd = rsqrtf(wave_sum(s) * (1.f / DM) + EPS);
    u32x2* o8 = (u32x2*)orow + lane;
#pragma unroll
    for (int j = 0; j < 8; ++j) { const f32x4 gg = gr[64 * j]; u32x2 w; w.x = pk2(v[j].x * rstd * gg.x, v[j].y * rstd * gg.y); w.y = pk2(v[j].z * rstd * gg.z, v[j].w * rstd * gg.w); o8[64 * j] = w; }
}
__device__ __forceinline__ void phase0(const Params& p, LAS unsigned char* lds, int gw, int ngw, int wave, int lane, int item_lo, int item_hi) {
    LAS float* scr = (LAS float*)(lds + wave * 16384);
    for (int it = gw + item_lo; it < item_hi; it += ngw) {
        int jn = 0;
#pragma unroll
        for (int q = 1; q < 17; ++q) if (q < p.njobs && it >= p.jobs[q].item0) jn = q;
        p0_transpose_item(p.jobs[jn], scr, it - p.jobs[jn].item0, lane);
    }
    if (item_lo != 0) return;
    bf16_t* U = WSP(bf16_t, WS_U);
    for (int m = gw; m < UROWS; m += ngw) {
        if (m < MTOK) p0_norm_row(p.x + (size_t)m * DM, p.pre_w, U + (size_t)m * DM, lane);
        else if (m < MTOK + NMETA) p0_norm_row(p.meta + (size_t)(m - MTOK) * DM, p.pre_w, U + (size_t)m * DM, lane);
        else { u32x4* o = (u32x4*)(U + (size_t)m * DM) + lane;
#pragma unroll
            for (int j = 0; j < 4; ++j) o[64 * j] = (u32x4){0u, 0u, 0u, 0u}; }
    }
    bf16_t* WUK = WSP(bf16_t, WS_WUK);
    for (int i = gw * 64 + lane; i < 262144 / 4; i += ngw * 64) { const f32x4 v = ((const f32x4*)p.w_uk)[i]; u32x2 w; w.x = pk2(v.x, v.y); w.y = pk2(v.z, v.w); ((u32x2*)WUK)[i] = w; }
}

__device__ __forceinline__ void phase_ckvnorm(const Params& p, int gw, int ngw, int lane) {
    const float* CKVRAW = WSP(const float, WS_CKVRAW); bf16_t* CKV = WSP(bf16_t, WS_CKV);
    for (int r = gw; r < MKEY; r += ngw) {
        const f32x4 v = ((const f32x4*)(CKVRAW + (size_t)r * 256))[lane];
        const float ss = wave_sum((v.x * v.x + v.y * v.y) + (v.z * v.z + v.w * v.w));
        const float rstd = rsqrtf(ss * (1.f / 256.f) + EPS);
        const f32x4 g = ((const f32x4*)p.kv_norm_w)[lane];
        int w = __builtin_amdgcn_cvt_pk_fp8_f32(v.x * rstd * g.x, v.y * rstd * g.y, 0, false); w = __builtin_amdgcn_cvt_pk_fp8_f32(v.z * rstd * g.z, v.w * rstd * g.w, w, true);
        ((unsigned*)((unsigned char*)CKV + (size_t)r * 256))[lane] = (unsigned)w;
    }
}

__device__ __forceinline__ void phase7(const Params& p, int gw, int ngw, int lane) {
    const bf16_t* OUTPRE = WSP(const bf16_t, WS_OUTPRE); const float* SSQ = WSP(const float, WS_SSQ);
    for (int r = gw; r < MTOK; r += ngw) {
        float s = (lane < 32) ? SSQ[(size_t)r * 32 + lane] : 0.f; s = wave_sum(s);
        const float rstd = rsqrtf(s * (1.f / DM) + EPS);
        const u32x4* o = (const u32x4*)(OUTPRE + (size_t)r * DM); const f32x4* xr = (const f32x4*)(p.x + (size_t)r * DM); const f32x4* g = (const f32x4*)p.post_w; f32x4* out = (f32x4*)(p.out + (size_t)r * DM);
#pragma unroll
        for (int j = 0; j < 4; ++j) {
            const int ch = 64 * j + lane;
            const u32x4 w = o[ch]; const f32x4 x0 = __builtin_nontemporal_load(xr + 2 * ch), x1 = __builtin_nontemporal_load(xr + 2 * ch + 1), g0 = g[2 * ch], g1 = g[2 * ch + 1];
            f32x4 y0, y1;
            y0.x = x0.x + bflo(w.x) * rstd * g0.x; y0.y = x0.y + bfhi(w.x) * rstd * g0.y; y0.z = x0.z + bflo(w.y) * rstd * g0.z; y0.w = x0.w + bfhi(w.y) * rstd * g0.w;
            y1.x = x1.x + bflo(w.z) * rstd * g1.x; y1.y = x1.y + bfhi(w.z) * rstd * g1.y; y1.z = x1.z + bflo(w.w) * rstd * g1.z; y1.w = x1.w + bfhi(w.w) * rstd * g1.w;
            out[2 * ch] = y0; out[2 * ch + 1] = y1;
        }
    }
}

typedef short v4i16_t __attribute__((ext_vector_type(4)));
typedef float f32x2_t __attribute__((ext_vector_type(2))); typedef __bf16 bf16x2_t __attribute__((ext_vector_type(2)));
__device__ __forceinline__ unsigned cvtpk_s(float lo, float hi) { const f32x2_t v = {lo, hi}; const bf16x2_t b = __builtin_convertvector(v, bf16x2_t); return __builtin_bit_cast(unsigned, b); }
__device__ __forceinline__ unsigned off_b(unsigned row, unsigned ch) { const unsigned f = ((row >> 3) & 1u) | ((((row >> 2) ^ (row >> 3)) & 1u) << 1) | (((row >> 1) & 1u) << 2) | ((row & 1u) << 3); return 256u * row + 16u * (ch ^ f); }
__device__ __forceinline__ bf16x8 tr_frag(LAS unsigned char* img, unsigned a0, unsigned a1) {
    const v4i16_t lo = __builtin_amdgcn_ds_read_tr16_b64_v4i16((LAS v4i16_t*)(img + a0));
    const v4i16_t hi = __builtin_amdgcn_ds_read_tr16_b64_v4i16((LAS v4i16_t*)(img + a1));
    return (bf16x8){lo[0], lo[1], lo[2], lo[3], hi[0], hi[1], hi[2], hi[3]};
}
__device__ __forceinline__ void glds16(const void* gsrc, unsigned lds_dst) {
    unsigned keep;
    asm volatile("s_mov_b32 %0, m0\n\ts_mov_b32 m0, %2\n\ts_nop 0\n\tglobal_load_lds_dwordx4 %1, off\n\ts_mov_b32 m0, %0" : "=&s"(keep) : "v"(gsrc), "s"(lds_dst) : "memory");
}
constexpr int DB_K = 0, DB_V = 49152, DB_LUT = 98304, DB_Q = 99328;
constexpr float DIFF_THR = 24.0f;
__device__ __forceinline__ void diff_unit(const Params& p, LAS unsigned char* lds, int b, int h, int qb, float lam) {
    const bf16_t* QB = WSP(const bf16_t, WS_QB); const bf16_t* KB = WSP(const bf16_t, WS_KB); const bf16_t* VB = WSP(const bf16_t, WS_VB); const bf16_t* ZB = WSP(const bf16_t, WS_ZB); bf16_t* OZB = WSP(bf16_t, WS_OZB);
    const int tid = opaque_tid(), lane = tid & 63, wave = __builtin_amdgcn_readfirstlane(tid >> 6), l15 = lane & 15, g = lane >> 4;
    const int jw = 128 * qb + 16 * wave, jq = jw + l15, cw = 2 * qb + 1 + (wave >> 2), ntiles = 2 * qb + 3;
    LAS float* LUT = (LAS float*)(lds + DB_LUT);
    __syncthreads();
    if (tid < 155) LUT[tid] = p.rel_bias[t5_bucket(tid - 91) * 16 + 8 + h] * LOG2E;
    LAS unsigned char* Qimg = lds + DB_Q + wave * 4096;
    { const bf16_t* qp = QB + (size_t)(b * SEQ + jq) * 1024 + h * 128 + 8 * g;
#pragma unroll
      for (int s = 0; s < 4; ++s) *(LAS bf16x8*)(Qimg + off_b((unsigned)l15, 4u * s + (unsigned)g)) = *(const bf16x8*)(qp + 32 * s); }
    size_t dsrc[2];
#pragma unroll
    for (int i = 0; i < 2; ++i) { const unsigned row = 8u * wave + 4u * i + (unsigned)(lane >> 4); const unsigned f = (off_b(row & 15u, 0u) >> 4) & 15u;
        dsrc[i] = (size_t)row * 1024 + h * 128 + (((unsigned)(lane & 15)) ^ f) * 8; }
    const unsigned ddst = 2048u * wave;
    const unsigned lds0 = (unsigned)(size_t)lds;
#define DF_ROW0(tt) ((size_t)b * TK + ((tt) == 0 ? 0 : 16 + 64 * ((tt) - 1)))
#define DF_DMAK(tt, slot) do { const bf16_t* g_ = KB + DF_ROW0(tt) * 1024; _Pragma("unroll") for (int i_ = 0; i_ < 2; ++i_) \
        glds16(g_ + dsrc[i_], (unsigned)__builtin_amdgcn_readfirstlane((int)(lds0 + DB_K + (slot) * 16384 + ddst + 1024 * i_))); } while (0)
#define DF_DMAV(tt, slot) do { const bf16_t* g_ = VB + DF_ROW0(tt) * 1024; _Pragma("unroll") for (int i_ = 0; i_ < 2; ++i_) \
        glds16(g_ + dsrc[i_], (unsigned)__builtin_amdgcn_readfirstlane((int)(lds0 + DB_V + (slot) * 16384 + ddst + 1024 * i_))); } while (0)
#define DF_WAITBAR(n) do { if ((n) >= 4) asm volatile("s_waitcnt vmcnt(4) lgkmcnt(0)" ::: "memory"); else if ((n) >= 2) asm volatile("s_waitcnt vmcnt(2) lgkmcnt(0)" ::: "memory"); \
        else asm volatile("s_waitcnt vmcnt(0) lgkmcnt(0)" ::: "memory"); __builtin_amdgcn_s_barrier(); asm volatile("" ::: "memory"); } while (0)
    const unsigned q4 = (unsigned)l15 >> 2, pp = (unsigned)l15 & 3u;
    unsigned kbase[2][2], vbase[8];
#pragma unroll
    for (int mp = 0; mp < 2; ++mp)
#pragma unroll
        for (int s = 0; s < 2; ++s) kbase[mp][s] = off_b((unsigned)l15, 8u * mp + 4u * s + (unsigned)g);
#pragma unroll
    for (int c = 0; c < 8; ++c) vbase[c] = off_b(4u * g + q4, 2u * c + (pp >> 1)) + 8u * (pp & 1u);

    float m1 = 0.f, m2 = 0.f;
    f32x4 O1[8], O2[8], OL1 = (f32x4){0.f, 0.f, 0.f, 0.f}, OL2 = (f32x4){0.f, 0.f, 0.f, 0.f};
    const short one_ = (l15 == 0) ? (short)0x3F80 : (short)0;
    const bf16x8 onesf = (bf16x8){one_, one_, one_, one_, one_, one_, one_, one_};
#pragma unroll
    for (int c = 0; c < 8; ++c) { O1[c] = (f32x4){0.f, 0.f, 0.f, 0.f}; O2[c] = (f32x4){0.f, 0.f, 0.f, 0.f}; }
    f32x4 S1[4], S2[4];
    bf16x8 pa1[2], pa2[2];
    float es1 = 1.f, es2 = 1.f; bool pending = false;
    f32x4 cn1 = (f32x4){0.f, 0.f, 0.f, 0.f}, cn2 = cn1, cf1 = cn1, cf2 = cn1;

#define DF_QK(tt, kbo_) do { LAS unsigned char* Kb_ = lds + DB_K + (kbo_); \
        const int dmin_ = ((tt) == 0) ? (jw + 1) : (jw - 64 * (tt) + 1); const bool near_ = dmin_ < 91; \
        const f32x4 ci1_ = near_ ? cn1 : cf1, ci2_ = near_ ? cn2 : cf2;        \
        _Pragma("unroll") for (int s = 0; s < 2; ++s) { const bf16x8 q1_ = *(const LAS bf16x8*)(Qimg + kbase[0][s]), q2_ = *(const LAS bf16x8*)(Qimg + kbase[1][s]); \
          bf16x8 ka1_[4], ka2_[4]; \
          _Pragma("unroll") for (int mb = 0; mb < 4; ++mb) { ka1_[mb] = *(const LAS bf16x8*)(Kb_ + kbase[0][s] + 4096 * mb); ka2_[mb] = *(const LAS bf16x8*)(Kb_ + kbase[1][s] + 4096 * mb); } \
          __builtin_amdgcn_sched_barrier(0); \
          _Pragma("unroll") for (int mb = 0; mb < 4; ++mb) { \
            S1[mb] = __builtin_amdgcn_mfma_f32_16x16x32_bf16(ka1_[mb], q1_, s == 0 ? ci1_ : S1[mb], 0, 0, 0); S2[mb] = __builtin_amdgcn_mfma_f32_16x16x32_bf16(ka2_[mb], q2_, s == 0 ? ci2_ : S2[mb], 0, 0, 0); } } \
        if (near_) { _Pragma("unroll") for (int mb = 0; mb < 4; ++mb) _Pragma("unroll") for (int i = 0; i < 4; ++i) { \
            const int kr_ = 16 * mb + 4 * g + i; const int kpos_ = ((tt) == 0) ? kr_ : 16 + 64 * ((tt) - 1) + kr_; \
            int rel_ = kpos_ - (NMETA + jq); rel_ = rel_ < -91 ? -91 : (rel_ > 63 ? 63 : rel_); const float bias_ = LUT[rel_ + 91]; S1[mb][i] += bias_; S2[mb][i] += bias_; } } \
        if ((tt) == 0) { _Pragma("unroll") for (int mb = 1; mb < 4; ++mb) { S1[mb] = (f32x4){-INFINITY, -INFINITY, -INFINITY, -INFINITY}; S2[mb] = S1[mb]; } } } while (0)
#define DF_LMAX(t1_, t2_) do { t1_ = fmaxf(fmaxf(S1[0][0], S1[0][1]), S1[0][2]); t2_ = fmaxf(fmaxf(S2[0][0], S2[0][1]), S2[0][2]); \
        t1_ = fmaxf(fmaxf(t1_, S1[0][3]), S1[1][0]); t2_ = fmaxf(fmaxf(t2_, S2[0][3]), S2[1][0]); \
        t1_ = fmaxf(fmaxf(t1_, S1[1][1]), S1[1][2]); t2_ = fmaxf(fmaxf(t2_, S2[1][1]), S2[1][2]); \
        t1_ = fmaxf(fmaxf(t1_, S1[1][3]), S1[2][0]); t2_ = fmaxf(fmaxf(t2_, S2[1][3]), S2[2][0]); \
        t1_ = fmaxf(fmaxf(t1_, S1[2][1]), S1[2][2]); t2_ = fmaxf(fmaxf(t2_, S2[2][1]), S2[2][2]); \
        t1_ = fmaxf(fmaxf(t1_, S1[2][3]), S1[3][0]); t2_ = fmaxf(fmaxf(t2_, S2[2][3]), S2[3][0]); \
        t1_ = fmaxf(fmaxf(t1_, S1[3][1]), S1[3][2]); t2_ = fmaxf(fmaxf(t2_, S2[3][1]), S2[3][2]); \
        t1_ = fmaxf(t1_, S1[3][3]); t2_ = fmaxf(t2_, S2[3][3]); } while (0)
#define DF_RESCALE(t1_, t2_, forced_) do { float r1_ = t1_, r2_ = t2_; r1_ = fmaxf(r1_, __shfl_xor(r1_, 16)); r1_ = fmaxf(r1_, __shfl_xor(r1_, 32)); r2_ = fmaxf(r2_, __shfl_xor(r2_, 16)); r2_ = fmaxf(r2_, __shfl_xor(r2_, 32)); \
        const float d1_ = (forced_) ? r1_ : fmaxf(r1_, 0.f), d2_ = (forced_) ? r2_ : fmaxf(r2_, 0.f); m1 += d1_; m2 += d2_; \
        es1 = __builtin_amdgcn_exp2f(-d1_); es2 = __builtin_amdgcn_exp2f(-d2_); \
        _Pragma("unroll") for (int mb = 0; mb < 4; ++mb) { S1[mb] = S1[mb] - d1_; S2[mb] = S2[mb] - d2_; } \
        cn1 = (f32x4){-m1, -m1, -m1, -m1}; cn2 = (f32x4){-m2, -m2, -m2, -m2}; { const float f1_ = bias_far - m1, f2_ = bias_far - m2; cf1 = (f32x4){f1_, f1_, f1_, f1_}; cf2 = (f32x4){f2_, f2_, f2_, f2_}; } } while (0)
#define DF_SCALE_O() do { _Pragma("unroll") for (int i = 0; i < 4; ++i) { const float x1_ = __shfl(es1, 4 * g + i), x2_ = __shfl(es2, 4 * g + i); OL1[i] *= x1_; OL2[i] *= x2_; \
            _Pragma("unroll") for (int c = 0; c < 8; ++c) { O1[c][i] *= x1_; O2[c][i] *= x2_; } } } while (0)
#define DF_EXP() do { _Pragma("unroll") for (int mb = 0; mb < 4; ++mb) _Pragma("unroll") for (int i = 0; i < 4; ++i) { S1[mb][i] = __builtin_amdgcn_exp2f(S1[mb][i]); S2[mb][i] = __builtin_amdgcn_exp2f(S2[mb][i]); } \
        _Pragma("unroll") for (int ks = 0; ks < 2; ++ks) { u32x4 w1_, w2_; \
            w1_.x = cvtpk_s(S1[2 * ks][0], S1[2 * ks][1]); w1_.y = cvtpk_s(S1[2 * ks][2], S1[2 * ks][3]); w1_.z = cvtpk_s(S1[2 * ks + 1][0], S1[2 * ks + 1][1]); w1_.w = cvtpk_s(S1[2 * ks + 1][2], S1[2 * ks + 1][3]); \
            w2_.x = cvtpk_s(S2[2 * ks][0], S2[2 * ks][1]); w2_.y = cvtpk_s(S2[2 * ks][2], S2[2 * ks][3]); w2_.z = cvtpk_s(S2[2 * ks + 1][0], S2[2 * ks + 1][1]); w2_.w = cvtpk_s(S2[2 * ks + 1][2], S2[2 * ks + 1][3]); \
            pa1[ks] = __builtin_bit_cast(bf16x8, w1_); pa2[ks] = __builtin_bit_cast(bf16x8, w2_); } } while (0)
#define DF_PV(vbo_, pq1_, pq2_) do { LAS unsigned char* Vb_ = lds + DB_V + (vbo_); \
        _Pragma("unroll") for (int ks = 0; ks < 2; ++ks) { OL1 = __builtin_amdgcn_mfma_f32_16x16x32_bf16(pq1_[ks], onesf, OL1, 0, 0, 0); OL2 = __builtin_amdgcn_mfma_f32_16x16x32_bf16(pq2_[ks], onesf, OL2, 0, 0, 0); } \
        _Pragma("unroll") for (int c2 = 0; c2 < 8; c2 += 2) { bf16x8 vf_[2][2]; \
            _Pragma("unroll") for (int cc = 0; cc < 2; ++cc) _Pragma("unroll") for (int ks = 0; ks < 2; ++ks) vf_[cc][ks] = tr_frag(Vb_ + vbase[c2 + cc], 8192u * ks, 8192u * ks + 4096u); \
            _Pragma("unroll") for (int cc = 0; cc < 2; ++cc) _Pragma("unroll") for (int ks = 0; ks < 2; ++ks) { \
                O1[c2 + cc] = __builtin_amdgcn_mfma_f32_16x16x32_bf16(pq1_[ks], vf_[cc][ks], O1[c2 + cc], 0, 0, 0); O2[c2 + cc] = __builtin_amdgcn_mfma_f32_16x16x32_bf16(pq2_[ks], vf_[cc][ks], O2[c2 + cc], 0, 0, 0); } } } while (0)

    DF_DMAK(0, 0); DF_DMAV(0, 0); DF_DMAK(1, 1); DF_DMAV(1, 1); DF_DMAK(2, 2);
    asm volatile("s_waitcnt vmcnt(0) lgkmcnt(0)" ::: "memory"); __builtin_amdgcn_s_barrier(); asm volatile("" ::: "memory");
    const float bias_far = LUT[0];
    cf1 = (f32x4){bias_far, bias_far, bias_far, bias_far}; cf2 = cf1;
    { DF_QK(0, 0u); float t1, t2; DF_LMAX(t1, t2); DF_RESCALE(t1, t2, true); DF_EXP(); }
    asm volatile("s_waitcnt lgkmcnt(0)" ::: "memory"); __builtin_amdgcn_s_barrier(); asm volatile("" ::: "memory");
    int sk = 1, sv = 0;
    for (int t = 0; t < ntiles; ++t) {
        if (__builtin_expect(pending, 0)) { DF_SCALE_O(); pending = false; }
        int nnew = 0;
        { const int s3 = (sk == 0) ? 2 : sk - 1;
          if (t + 3 < ntiles) { DF_DMAK(t + 3, s3); nnew += 2; }
          const int s2 = (sv == 0) ? 2 : sv - 1;
          if (t + 2 < ntiles) { DF_DMAV(t + 2, s2); nnew += 2; } }
        unsigned kbo = (unsigned)sk * 16384u, vbo = (unsigned)sv * 16384u; asm volatile("" : "+v"(kbo), "+v"(vbo));
        if (t + 1 <= cw) {
            DF_QK(t + 1, kbo);
            float t1, t2; DF_LMAX(t1, t2);
            if (__builtin_expect(__any((t1 > DIFF_THR) || (t2 > DIFF_THR)), 0)) { DF_RESCALE(t1, t2, false); pending = true; }
            DF_PV(vbo, pa1, pa2);
            DF_EXP();
        } else if (t <= cw) {
            DF_PV(vbo, pa1, pa2);
        }
        DF_WAITBAR(nnew);
        sk = (sk == 2) ? 0 : sk + 1; sv = (sv == 2) ? 0 : sv + 1;
    }
    asm volatile("s_waitcnt vmcnt(0)" ::: "memory");
#undef DF_ROW0
#undef DF_DMAK
#undef DF_DMAV
#undef DF_WAITBAR
#undef DF_QK
#undef DF_LMAX
#undef DF_RESCALE
#undef DF_SCALE_O
#undef DF_EXP
#undef DF_PV
#pragma unroll
    for (int i = 0; i < 4; ++i) {
        const float r1 = 1.f / __shfl(OL1[i], 16 * g), r2 = lam / __shfl(OL2[i], 16 * g);
        float o[8]; float ss = 0.f;
#pragma unroll
        for (int c = 0; c < 8; ++c) { o[c] = O1[c][i] * r1 - O2[c][i] * r2; ss += o[c] * o[c]; }
        ss += __shfl_xor(ss, 1); ss += __shfl_xor(ss, 2); ss += __shfl_xor(ss, 4); ss += __shfl_xor(ss, 8);
        const float rs = rsqrtf(ss * (1.f / 128.f) + EPS) * 0.8f;
        const size_t t = (size_t)b * SEQ + jw + 4 * g + i;
#pragma unroll
        for (int c = 0; c < 8; ++c) { const int d = 16 * c + l15; const float y = o[c] * rs * p.subln_w[d] * bf2f(ZB[t * 1024 + h * 128 + d]); OZB[t * 1024 + h * 128 + d] = (bf16_t)f2bf(y); }
    }
}
__device__ __forceinline__ void phase_diff(const Params& p, LAS unsigned char* lds) {
    const int lane = threadIdx.x & 63;
    float a = (lane < 64) ? p.lam_p[lane] * p.lam_p[64 + lane] : 0.f, bb = p.lam_p[128 + lane] * p.lam_p[192 + lane];
    a = wave_sum(a); bb = wave_sum(bb);
    const float lam = expf(a) - expf(bb) + 0.2f;
    for (int u = blockIdx.x; u < 512; u += gridDim.x) {
        const int v = u & 255;
        int bh = v >> 4, s = v & 15;
        if (gridDim.x == 256) { bh = (v & 7) + 8 * (v >> 7); s = (v >> 3) & 15; }
        const int qb = (u < 256) ? s : 31 - s;
        diff_unit(p, lds, bh >> 3, bh & 7, qb, lam);
    }
}

typedef float f32x16 __attribute__((ext_vector_type(16)));
__device__ __forceinline__ void scores_wg_unit(const Params& p, LAS unsigned char* lds, int c, int b, int half, int kh) {
    const bf16_t* IQ = WSP(const bf16_t, WS_IQ); const float* IW = WSP(const float, WS_IW); float* SC = WSP(float, WS_SC);
    const int tid = opaque_tid(), lane = tid & 63, wave = __builtin_amdgcn_readfirstlane(tid >> 6);
    const int j0 = (c - 1) * 64 + 32 * half + 4 * wave, m0 = b * SEQ + j0, n = 16 + 64 * c, nkb = 2 * c + 1, nkh = (nkb + 1) >> 1;
    const int kbA = kh ? nkh : 0, kbB = kh ? nkb : nkh, ntile = (kbB - kbA + 1) >> 1;
    const int r32 = lane & 31, hi = lane >> 5, tok = r32 >> 4, hh = r32 & 15;
    bf16x8 af[2][4]; float wv[2][16];
#pragma unroll
    for (int pr = 0; pr < 2; ++pr) {
#pragma unroll
        for (int s = 0; s < 4; ++s) af[pr][s] = *(const bf16x8*)(IQ + (size_t)(m0 + 2 * pr + tok) * 1024 + hh * 64 + 16 * s + 8 * hi);
#pragma unroll
        for (int r = 0; r < 16; ++r) wv[pr][r] = IW[(size_t)(m0 + 2 * pr + (r >> 3)) * 16 + (r & 3) + 8 * ((r >> 2) & 1) + 4 * hi];
    }
    float* rowbase = SC + sc_off(b, j0);
    const bf16_t* ikb = WSP(const bf16_t, WS_IK) + (size_t)b * TK * 64;
    const int pkey = tid >> 3, pch = tid & 7;
    const unsigned pdst = (unsigned)pkey * 128u + 16u * (unsigned)(pch ^ (pkey & 7));
    unsigned boff[4];
#pragma unroll
    for (int s = 0; s < 4; ++s) boff[s] = (unsigned)r32 * 128u + 16u * (unsigned)((2 * s + hi) ^ (r32 & 7));
    u32x4 kreg;
#define SCW_LOAD(t_) do { int key_ = 32 * (kbA + 2 * (t_)) + pkey; key_ = key_ < n ? key_ : n - 1; kreg = *(const u32x4*)(ikb + (size_t)key_ * 64 + pch * 8); } while (0)
#define SCW_WRITE(off_) do { *(LAS u32x4*)(lds + (off_) + pdst) = kreg; } while (0)
    __syncthreads();
    SCW_LOAD(0); SCW_WRITE(0u);
    __syncthreads();
    for (int t = 0; t < ntile; ++t) {
        if (t + 1 < ntile) SCW_LOAD(t + 1);
        unsigned bo = (unsigned)(t & 1) * 8192u; asm volatile("" : "+v"(bo));
#pragma unroll
        for (int q = 0; q < 2; ++q) {
            const int kb = kbA + 2 * t + q, key = 32 * kb + r32;
            bf16x8 bfr[4];
#pragma unroll
            for (int s = 0; s < 4; ++s) bfr[s] = *(const LAS bf16x8*)(lds + bo + boff[s] + 4096 * q);
#pragma unroll
            for (int pr = 0; pr < 2; ++pr) {
                f32x16 acc;
#pragma unroll
                for (int r = 0; r < 16; ++r) acc[r] = 0.f;
#pragma unroll
                for (int s = 0; s < 4; ++s) acc = __builtin_amdgcn_mfma_f32_32x32x16_bf16(af[pr][s], bfr[s], acc, 0, 0, 0);
                float p0 = 0.f, p1 = 0.f;
#pragma unroll
                for (int r = 0; r < 8; ++r) { p0 += wv[pr][r] * fmaxf(acc[r], 0.f); p1 += wv[pr][8 + r] * fmaxf(acc[8 + r], 0.f); }
                const auto sw = __builtin_amdgcn_permlane32_swap(__float_as_uint(p0), __float_as_uint(p1), false, false);
                const float tot = __uint_as_float(sw[0]) + __uint_as_float(sw[1]);
                if (kb < kbB && key < n) rowbase[(size_t)(2 * pr + hi) * n + key] = tot;
            }
        }
        if (t + 1 < ntile) SCW_WRITE((unsigned)((t + 1) & 1) * 8192u);
        __syncthreads();
    }
#undef SCW_LOAD
#undef SCW_WRITE
}
__device__ __forceinline__ void phase_scores(const Params& p, LAS unsigned char* lds) {
    for (int P = (int)blockIdx.x; P < 256; P += (int)gridDim.x) {
        const int cl = 1 + (P >> 3), sub = P & 7;
        scores_wg_unit(p, lds, 65 - cl, sub >> 2, (sub >> 1) & 1, sub & 1);
        scores_wg_unit(p, lds, cl, sub >> 2, (sub >> 1) & 1, sub & 1);
    }
}
__device__ __forceinline__ void phase_qlat(const Params& p, LAS unsigned char* lds) {
    const bf16_t* QA = WSP(const bf16_t, WS_QA); const bf16_t* WUK = WSP(const bf16_t, WS_WUK); bf16_t* QLAT = WSP(bf16_t, WS_QLAT);
    const int tid = opaque_tid(), lane = tid & 63, w = __builtin_amdgcn_readfirstlane(tid >> 6), l15 = lane & 15, g = lane >> 4;
    const float sc = 0.08838834764831845f * LOG2E * 16.f;
    const int G = (int)gridDim.x;
    int hcur = -1;
    const unsigned kb0 = off_b((unsigned)l15, (unsigned)g);
    for (int u0 = (int)blockIdx.x; u0 < 4096; u0 += 8 * G) {
        const int h = u0 & 7;
        if (h != hcur || (G & 7)) { hcur = h; __syncthreads();
#pragma unroll
            for (int i = 0; i < 8; ++i) { const int idx = tid + 512 * i, row = idx >> 4, ch = idx & 15;
                *(LAS u32x4*)(lds + off_b((unsigned)row, (unsigned)ch)) = *(const u32x4*)(WUK + ((size_t)row * 8 + h) * 128 + ch * 8); }
            __syncthreads(); }
        const int u = u0 + w * G;
        if (u < 4096 && (u & 7) == h) {
            const int m0 = (u >> 3) * 16;
            bf16x8 bq[4];
#pragma unroll
            for (int s = 0; s < 4; ++s) bq[s] = *(const bf16x8*)(QA + (size_t)(m0 + l15) * 1024 + h * 128 + 32 * s + 8 * g);
#pragma unroll 4
            for (int nb = 0; nb < 16; ++nb) {
                bf16x8 af[4];
#pragma unroll
                for (int s = 0; s < 4; ++s) af[s] = *(const LAS bf16x8*)(lds + 4096 * nb + (kb0 ^ (64u * s)));
                f32x4 acc = (f32x4){0.f, 0.f, 0.f, 0.f};
#pragma unroll
                for (int s = 0; s < 4; ++s) acc = __builtin_amdgcn_mfma_f32_16x16x32_bf16(af[s], bq[s], acc, 0, 0, 0);
                int wv = __builtin_amdgcn_cvt_pk_fp8_f32(acc[0] * sc, acc[1] * sc, 0, false); wv = __builtin_amdgcn_cvt_pk_fp8_f32(acc[2] * sc, acc[3] * sc, wv, true);
                *(unsigned*)((unsigned char*)QLAT + ((size_t)(m0 + l15) * 8 + h) * 256 + 16 * nb + 4 * g) = (unsigned)wv;
            }
        }
    }
}
__device__ __forceinline__ void phase_oproj(const Params& p, LAS unsigned char* lds) {
    const bf16_t* OLAT = WSP(const bf16_t, WS_OLAT); const bf16_t* WUVT = WSP(const bf16_t, WS_WUVT); const bf16_t* ZA = WSP(const bf16_t, WS_ZA); bf16_t* OZA = WSP(bf16_t, WS_OZA);
    const int tid = opaque_tid(), lane = tid & 63, w = __builtin_amdgcn_readfirstlane(tid >> 6), l15 = lane & 15, g = lane >> 4;
    const int G = (int)gridDim.x;
    int hcur = -1;
    const unsigned kb0 = off_b((unsigned)l15, (unsigned)g);
    for (int u0 = (int)blockIdx.x; u0 < 4096; u0 += 8 * G) {
        const int h = u0 & 7;
        if (h != hcur || (G & 7)) { hcur = h; __syncthreads();
#pragma unroll
            for (int i = 0; i < 8; ++i) { const int idx = tid + 512 * i, row = idx >> 5, c32 = idx & 31;
                *(LAS u32x4*)(lds + (c32 >> 4) * 32768 + off_b((unsigned)row, (unsigned)(c32 & 15))) = *(const u32x4*)(WUVT + (size_t)(h * 128 + row) * 256 + c32 * 8); }
            __syncthreads(); }
        const int u = u0 + w * G;
        if (u < 4096 && (u & 7) == h) {
            const int m0 = (u >> 3) * 16;
            bf16x8 bq[8];
#pragma unroll
            for (int s = 0; s < 8; ++s) bq[s] = *(const bf16x8*)(OLAT + ((size_t)(m0 + l15) * 8 + h) * 256 + 32 * s + 8 * g);
#pragma unroll 2
            for (int nb = 0; nb < 8; ++nb) {
                bf16x8 af[8];
#pragma unroll
                for (int s = 0; s < 8; ++s) af[s] = *(const LAS bf16x8*)(lds + (s >> 2) * 32768 + 4096 * nb + (kb0 ^ (64u * (s & 3))));
                f32x4 acc = (f32x4){0.f, 0.f, 0.f, 0.f};
#pragma unroll
                for (int s = 0; s < 8; ++s) acc = __builtin_amdgcn_mfma_f32_16x16x32_bf16(af[s], bq[s], acc, 0, 0, 0);
                const size_t o = (size_t)(m0 + l15) * 1024 + h * 128 + 16 * nb + 4 * g;
                const u32x2 z = *(const u32x2*)(ZA + o);
                u32x2 wv; wv.x = pg8::cvt_pk_bf16(acc[0] * bflo(z.x), acc[1] * bfhi(z.x)); wv.y = pg8::cvt_pk_bf16(acc[2] * bflo(z.y), acc[3] * bfhi(z.y));
                *(u32x2*)(OZA + o) = wv;
            }
        }
    }
}
typedef int v2i32_t __attribute__((ext_vector_type(2)));
constexpr int DSA_WAVE_LDS = 17408, DSA_LUT = 8 * DSA_WAVE_LDS;
__device__ __forceinline__ int lpos(int s) { return (s & ~31) | ((s & 3) << 3) | ((s & 31) >> 2); }
__device__ __forceinline__ unsigned ord_key(float f) { const unsigned u = __float_as_uint(f); return (u & 0x80000000u) ? ~u : (u | 0x80000000u); }
template <int KN>
__device__ __forceinline__ void dsa_select(const float* row, int n, int nsel, LAS int* list, int lane) {
    const __amdgpu_buffer_rsrc_t rs = __builtin_amdgcn_make_buffer_rsrc((void*)row, 0, n * 4, 0x00020000);
    unsigned key[KN];
#pragma unroll
    for (int k = 0; k < KN; ++k) key[k] = (unsigned)__builtin_amdgcn_raw_buffer_load_b32(rs, lane * 4, 256 * k, 2);
    { int idx0 = lane;
#pragma unroll
      for (int k = 0; k < KN; ++k) { const unsigned u = key[k]; const unsigned o = (u & 0x80000000u) ? ~u : (u | 0x80000000u); key[k] = (idx0 < n) ? o : 0u; idx0 += 64; asm volatile("" : "+v"(idx0)); } }
    unsigned thr = 0u;
    if (n > 256) {
        for (int bit = 31; bit >= 0; --bit) {
            const unsigned cand = thr | (1u << bit);
            int c = 0;
#pragma unroll
            for (int k = 0; k < KN; ++k) c += (key[k] >= cand) ? 1 : 0;
            int cnt = 0;
#pragma unroll
            for (int b7 = 0; b7 < 7; ++b7) cnt += __popcll(__ballot((c >> b7) & 1)) << b7;
            if (cnt >= 256) thr = cand;
            if (cnt == 256) break;
        }
    }
    int pos = 0; int idx = lane;
#pragma unroll
    for (int k = 0; k < KN; ++k) { const bool mine = key[k] > thr; const unsigned long long msk = __ballot(mine);
        const int my = __builtin_amdgcn_mbcnt_hi((unsigned)(msk >> 32), __builtin_amdgcn_mbcnt_lo((unsigned)msk, 0u));
        if (mine) list[lpos(pos + my)] = idx; pos += __popcll(msk); idx += 64; asm volatile("" : "+v"(idx)); }
    if (pos < nsel) {
        idx = lane;
#pragma unroll
        for (int k = 0; k < KN; ++k) { const bool mine = (key[k] == thr) && (idx < n); const unsigned long long msk = __ballot(mine);
            const int my = __builtin_amdgcn_mbcnt_hi((unsigned)(msk >> 32), __builtin_amdgcn_mbcnt_lo((unsigned)msk, 0u));
            if (mine && pos + my < nsel) list[lpos(pos + my)] = idx; pos += __popcll(msk); idx += 64; asm volatile("" : "+v"(idx)); }
    }
}
__device__ __forceinline__ void dsa_unit(const Params& p, LAS unsigned char* lds, int qi, int wave, int lane, int probe) {
    const float* SC = WSP(const float, WS_SC); bf16_t* OLAT = WSP(bf16_t, WS_OLAT);
    const int c = qi >> 8, b = (qi >> 6) & 1, j = (c - 1) * 64 + (qi & 63), t = b * SEQ + j, n = 16 + 64 * c, nsel = n < 256 ? n : 256, qpos = NMETA + j;
    LAS unsigned char* img = lds + wave * DSA_WAVE_LDS; LAS int* list = (LAS int*)(img + 16384); const LAS float* LUTA = (const LAS float*)(lds + DSA_LUT);
    const int l15 = lane & 15, g = lane >> 4;
    const float* row = SC + sc_off(b, j);
#pragma unroll
    for (int rs_ = (PROBE_REP == 41) ? 2 : 1; rs_ > 0; --rs_) {
    if (n <= 64 * 17) dsa_select<17>(row, n, nsel, list, lane);
    else if (n <= 64 * 33) dsa_select<33>(row, n, nsel, list, lane);
    else if (n <= 64 * 49) dsa_select<49>(row, n, nsel, list, lane);
    else dsa_select<65>(row, n, nsel, list, lane);
    }
#pragma unroll
    for (int ra_ = (PROBE_REP == 42) ? 2 : 1; ra_ > 0; --ra_) {
    const unsigned char* CKV8 = WSP(const unsigned char, WS_CKV); const unsigned char* qlp = WSP(const unsigned char, WS_QLAT) + ((size_t)t * 8 + (l15 & 7)) * 256 + 8 * g;
    const bool qreal = l15 < 8;
    unsigned rdb[2];
    rdb[0] = 256u * (unsigned)l15 + 8u * ((unsigned)g ^ (2u * (unsigned)l15));
    rdb[1] = 256u * (unsigned)(l15 + 16) + 8u * ((unsigned)g ^ (2u * ((unsigned)l15 ^ 8u)));
    const unsigned tq = (unsigned)l15 >> 1, tp = (unsigned)l15 & 1u;
    const unsigned trow = (tq < 4u) ? 4u * g + tq : 16u + 4u * g + (tq - 4u);
    const unsigned trb = 256u * trow + 8u * (tp ^ (2u * ((trow & 15u) ^ ((trow >> 4) << 3))));
    float m = -INFINITY, l = 0.f;
    f32x4 O[16];
#pragma unroll
    for (int rb = 0; rb < 16; ++rb) O[rb] = (f32x4){0.f, 0.f, 0.f, 0.f};
    const int nch = (nsel + 31) >> 5;
    const int hcol = l15 & 7;
    u32x4 gr[8];
    const unsigned gwr = 256u * (unsigned)(lane >> 4) + 16u * (unsigned)(lane & 15);
#define DSA_GATHER(chn) do { int ki_[8]; { const LAS int* lp_ = list + 32 * (chn) + 8 * (lane >> 4); \
        _Pragma("unroll") for (int v_ = 0; v_ < 2; ++v_) { const u32x4 t_ = *(const LAS u32x4*)(lp_ + 4 * v_); ki_[4 * v_] = (int)t_.x; ki_[4 * v_ + 1] = (int)t_.y; ki_[4 * v_ + 2] = (int)t_.z; ki_[4 * v_ + 3] = (int)t_.w; } } \
        _Pragma("unroll") for (int i = 0; i < 8; ++i) { const int slot = 32 * (chn) + 4 * i + (lane >> 4); const int kidx = slot < nsel ? ki_[i] : 0; \
        gr[i] = *(const u32x4*)(CKV8 + ((size_t)b * TK + kidx) * 256 + (lane & 15) * 16); } } while (0)
    DSA_GATHER(0);
    for (int ch = 0; ch < nch; ++ch) {
#pragma unroll
        for (int i = 0; i < 8; ++i) { const unsigned row = 4u * i + (unsigned)(lane >> 4); const unsigned rc = (row & 15u) ^ ((row >> 4) << 3);
            *(LAS u32x4*)(img + 256u * row + 16u * (((unsigned)lane & 15u) ^ rc)) = gr[i]; }
        long qf[8];
#pragma unroll
        for (int s = 0; s < 8; ++s) qf[s] = *(const long*)(qlp + 32 * s);
        asm volatile("" ::: "memory");
        DSA_GATHER(ch + 1);
        asm volatile("" ::: "memory");
#pragma unroll
        for (int s = 0; s < 8; ++s) qf[s] = qreal ? qf[s] : 0l;
        unsigned io = 0u; asm volatile("" : "+v"(io));
        LAS unsigned char* im = img + io;
        f32x4 S[2];
        S[0] = (f32x4){0.f, 0.f, 0.f, 0.f}; S[1] = S[0];
#pragma unroll
        for (int s4 = 0; s4 < 8; s4 += 4) {
            long af_[4][2];
#pragma unroll
            for (int s = 0; s < 4; ++s)
#pragma unroll
                for (int mb = 0; mb < 2; ++mb) af_[s][mb] = *(const LAS long*)(im + (rdb[mb] ^ (32u * (s4 + s))));
            __builtin_amdgcn_sched_barrier(0);
#pragma unroll
            for (int s = 0; s < 4; ++s)
#pragma unroll
                for (int mb = 0; mb < 2; ++mb) S[mb] = __builtin_amdgcn_mfma_f32_16x16x32_fp8_fp8(af_[s][mb], qf[s4 + s], S[mb], 0, 0, 0);
        }
        float cm = -INFINITY;
#pragma unroll
        for (int mb = 0; mb < 2; ++mb)
#pragma unroll
            for (int i = 0; i < 4; ++i) { const int slot = 32 * ch + 16 * mb + 4 * g + i; const int kidx = list[lpos(slot & 255)];
                int rel = kidx - qpos; rel = rel < -91 ? -91 : (rel > 63 ? 63 : rel);
                float v = S[mb][i] * 0.0625f + LUTA[(rel + 91) * 8 + hcol]; v = slot < nsel ? v : -INFINITY; S[mb][i] = v; cm = fmaxf(cm, v); }
        cm = fmaxf(cm, __shfl_xor(cm, 16)); cm = fmaxf(cm, __shfl_xor(cm, 32));
        const float mn = fmaxf(m, cm), alpha = __builtin_amdgcn_exp2f(m - mn); m = mn;
        float ps = 0.f;
#pragma unroll
        for (int mb = 0; mb < 2; ++mb)
#pragma unroll
            for (int i = 0; i < 4; ++i) { S[mb][i] = __builtin_amdgcn_exp2f(S[mb][i] - mn); ps += S[mb][i]; }
        l = l * alpha + ps;
        if (__any(alpha != 1.f)) {
#pragma unroll
            for (int rb = 0; rb < 16; ++rb) O[rb] = O[rb] * alpha;
        }
        int w0 = __builtin_amdgcn_cvt_pk_fp8_f32(S[0][0], S[0][1], 0, false); w0 = __builtin_amdgcn_cvt_pk_fp8_f32(S[0][2], S[0][3], w0, true);
        int w1 = __builtin_amdgcn_cvt_pk_fp8_f32(S[1][0], S[1][1], 0, false); w1 = __builtin_amdgcn_cvt_pk_fp8_f32(S[1][2], S[1][3], w1, true);
        const long pb = (long)(((unsigned long long)(unsigned)w1 << 32) | (unsigned long long)(unsigned)w0);
#pragma unroll
        for (int rb4 = 0; rb4 < 16; rb4 += 4) {
            long tf_[4];
#pragma unroll
            for (int r_ = 0; r_ < 4; ++r_) { const v2i32_t tv = __builtin_amdgcn_ds_read_tr8_b64_v2i32((LAS v2i32_t*)(im + (trb ^ (16u * (rb4 + r_))))); tf_[r_] = __builtin_bit_cast(long, tv); }
            __builtin_amdgcn_sched_barrier(0);
#pragma unroll
            for (int r_ = 0; r_ < 4; ++r_) O[rb4 + r_] = __builtin_amdgcn_mfma_f32_16x16x32_fp8_fp8(tf_[r_], pb, O[rb4 + r_], 0, 0, 0);
        }
    }
    l += __shfl_xor(l, 16); l += __shfl_xor(l, 32);
    const float il = 1.f / l;
    if (l15 < 8) {
#pragma unroll
        for (int rb = 0; rb < 16; ++rb) { u32x2 w; w.x = pg8::cvt_pk_bf16(O[rb][0] * il, O[rb][1] * il); w.y = pg8::cvt_pk_bf16(O[rb][2] * il, O[rb][3] * il);
            *(u32x2*)(OLAT + ((size_t)t * 8 + l15) * 256 + 16 * rb + 4 * g) = w; }
    }
    }
}
#undef DSA_GATHER
__device__ __forceinline__ int lds_take(LAS unsigned* ctr, int lane) {
    int u = 0; if (lane == 0) u = (int)__hip_atomic_fetch_add(ctr, 1u, __ATOMIC_RELAXED, __HIP_MEMORY_SCOPE_WORKGROUP);
    return __builtin_amdgcn_readfirstlane(u);
}
__device__ __forceinline__ int dsa_query_of(int u, int G) {
    const int k = u >> 3, r = u & 7;
    int cl, bb, grp;
    if (G == 256) { const int idx = ((int)blockIdx.x >> 1) + 128 * k; cl = 1 + (idx >> 4); grp = idx & 15; bb = (int)blockIdx.x & 1; }
    else { const int P = (int)blockIdx.x + k * G; cl = 1 + (P >> 5); bb = (P >> 4) & 1; grp = P & 15; }
    const int c = (r < 4) ? 65 - cl : cl;
    return (c << 8) | (bb << 6) | (4 * grp + (r & 3));
}
__device__ __forceinline__ int dsa_token_of(int qi) { return ((qi >> 6) & 1) * SEQ + ((qi >> 8) - 1) * 64 + (qi & 63); }
__device__ __forceinline__ void phase_dsa(const Params& p, LAS unsigned char* lds, int wave, int lane, int probe) {
    LAS float* LUTA = (LAS float*)(lds + DSA_LUT); LAS unsigned* ctr = (LAS unsigned*)(lds + DSA_LUT + 155 * 8 * 4);
    const int G = (int)gridDim.x, l15 = lane & 15, g = lane >> 4;
    __syncthreads();
    for (int i = threadIdx.x; i < 155 * 8; i += 512) LUTA[i] = p.rel_bias[t5_bucket((i >> 3) - 91) * 16 + (i & 7)] * LOG2E;
    if (threadIdx.x == 0) ctr[0] = 0u;
    const int npi = (1024 - (int)blockIdx.x + G - 1) / G;
    const int nun = npi * 8;
    __syncthreads();
    for (;;) {
        const int u = lds_take(ctr, lane); if (u >= nun) break;
        dsa_unit(p, lds, dsa_query_of(u, G), wave, lane, probe);
    }
}

#define XB_TMO      128
#define XB_XCNT(j)  (256  + 64 * (j))
#define XB_XSUB(j)  (1280 + 64 * (j))
#define XB_XGEN(j)  (2304 + 64 * (j))
#define XB_TOP      3328
#define XB_TOPGEN   3392
#define XCD_BAR_WORDS 3456
#define XB_SPIN_CAP (1u << 24)
__device__ __forceinline__ unsigned xb_ld(unsigned* p)              { return __hip_atomic_load(p, __ATOMIC_RELAXED, __HIP_MEMORY_SCOPE_AGENT); }
__device__ __forceinline__ unsigned xb_add(unsigned* p, unsigned v) { return __hip_atomic_fetch_add(p, v, __ATOMIC_RELAXED, __HIP_MEMORY_SCOPE_AGENT); }
__device__ __forceinline__ unsigned xb_xcc_id() { return (unsigned)__builtin_amdgcn_s_getreg((3 << 11) | 20) & 0xFu; }
#define XB_SPIN(cond, bar) do { unsigned _sp = 0; while (cond) { __builtin_amdgcn_s_sleep(1); \
    if ((++_sp & 255u) == 0u) { if (xb_ld(&(bar)[XB_TMO])) break; if (_sp > XB_SPIN_CAP) { atomicAdd(&(bar)[XB_TMO], 1u); break; } } } } while (0)
struct XcdBarrier { unsigned* bar; unsigned x; volatile LAS unsigned* st; };
__device__ __forceinline__ XcdBarrier xcd_barrier_post(unsigned* bar, volatile LAS unsigned* st) {
    XcdBarrier b; b.bar = bar; b.x = xb_xcc_id(); b.st = st;
    if (threadIdx.x == 0) (void)xb_add(&bar[XB_XCNT(b.x)], 1u);
    return b;
}
__device__ __forceinline__ void xcd_barrier_complete(unsigned* bar, unsigned x, unsigned& nloc, unsigned& nx) {
    const unsigned G = gridDim.x * gridDim.y * gridDim.z;
    unsigned sum, cnt, mine, sp = 0u;
    for (;;) {
        sum = 0u; cnt = 0u; mine = 0u;
#pragma unroll
        for (unsigned j = 0; j < 16; ++j) { const unsigned c = xb_ld(&bar[XB_XCNT(j)]); sum += c; cnt += (c > 0u) ? 1u : 0u; mine = (j == x) ? c : mine; }
        if (sum == G) break;
        __builtin_amdgcn_s_sleep(1);
        if ((++sp & 255u) == 0u) { if (xb_ld(&bar[XB_TMO])) break; if (sp > XB_SPIN_CAP) { atomicAdd(&bar[XB_TMO], 1u); break; } }
    }
    nloc = mine > 0u ? mine : 1u; nx = cnt > 0u ? cnt : 1u;
}
__device__ __forceinline__ void xcd_barrier(const XcdBarrier& b) {
    asm volatile("s_waitcnt vmcnt(0)" ::: "memory");
    __syncthreads();
    if (threadIdx.x == 0) {
        unsigned* bar = b.bar;
        __builtin_amdgcn_s_waitcnt(0);
        unsigned nloc = b.st[0], nx = b.st[1];
        if (nloc == 0u) { xcd_barrier_complete(bar, b.x, nloc, nx); b.st[0] = nloc; b.st[1] = nx; }
        const unsigned old = xb_add(&bar[XB_XSUB(b.x)], 1u);
        const unsigned gen = old / nloc;
        if (old + 1u == (gen + 1u) * nloc) {
            __builtin_amdgcn_fence(__ATOMIC_RELEASE, "agent");
            asm volatile("s_waitcnt vmcnt(0)" ::: "memory");
            const unsigned og = xb_add(&bar[XB_TOP], 1u);
            const unsigned tg = og / nx;
            if (og + 1u == (tg + 1u) * nx) xb_add(&bar[XB_TOPGEN], 1u);
            else XB_SPIN(xb_ld(&bar[XB_TOPGEN]) == tg, bar);
            __builtin_amdgcn_fence(__ATOMIC_ACQUIRE, "agent");
            xb_add(&bar[XB_XGEN(b.x)], 1u);
            asm volatile("s_waitcnt vmcnt(0)" ::: "memory");
        } else {
            XB_SPIN(xb_ld(&bar[XB_XGEN(b.x)]) == gen, bar);
            __builtin_amdgcn_fence(__ATOMIC_ACQUIRE, "agent");
            asm volatile("s_waitcnt vmcnt(0)" ::: "memory");
        }
    }
    __syncthreads();
}

constexpr int LDS_BYTES = 147456, MISC_OFF = 147456 - 256;
constexpr int NPHASE = 8;
#ifndef ONE_LAUNCH
#define ONE_LAUNCH 1
#endif

struct KArgs { Params p; int ph_lo, ph_hi, probe, pad; };
__global__ void __launch_bounds__(512, 2) k_fwd(KArgs a) {
    extern __shared__ __attribute__((aligned(16))) unsigned char lds_raw[];
    LAS unsigned char* lds = (LAS unsigned char*)lds_raw;
    const Params& p = a.p;
    const int tid = threadIdx.x, lane = tid & 63, wave = __builtin_amdgcn_readfirstlane(tid >> 6);
    const int gw = blockIdx.x * 8 + wave, ngw = gridDim.x * 8;
    volatile LAS unsigned* misc = (volatile LAS unsigned*)(lds + MISC_OFF);
    if (tid < 64) misc[tid] = 0u;
    __syncthreads();
    XcdBarrier bar; bar.bar = WSP(unsigned, WS_CTL) + 4096; bar.x = 0; bar.st = misc;
    if (ONE_LAUNCH) bar = xcd_barrier_post(WSP(unsigned, WS_CTL) + 4096, misc);
#define IN(k) (a.ph_lo <= 0 && 0 < a.ph_hi)
#define SEAM(k) do { xcd_barrier(bar); } while (0)
#define RUNPH(k, ...) do { if (IN(k)) { constexpr int nrep_ = (PROBE_REP == (k)) ? 2 : 1; _Pragma("unroll") for (int rep = 0; rep < nrep_; ++rep) { if (rep) xcd_barrier(bar); __VA_ARGS__ } } } while (0)
    RUNPH(0, const int lane_ = opaque_tid() & 63; phase0(p, lds, gw, ngw, wave, lane_, 0, (gridDim.x == 256) ? p.jobs[13].item0 : p.nitems););
    SEAM(0);
    RUNPH(1,
        SchedInproj S{DM, (int)gridDim.x, (int)blockIdx.x, (const char*)WSP(bf16_t, WS_U), (const char*)WSP(bf16_t, WS_WIN)};
        EpiInproj E{WSP(bf16_t, WS_QA), WSP(bf16_t, WS_ZA), WSP(bf16_t, WS_IQ), WSP(bf16_t, WS_QB), WSP(bf16_t, WS_ZB), WSP(bf16_t, WS_GA), WSP(bf16_t, WS_GB), WSP(bf16_t, WS_KB), WSP(bf16_t, WS_VB),
                    WSP(float, WS_CKVRAW), WSP(bf16_t, WS_IK), WSP(float, WS_IW), 0.125f * LOG2E, p.ikn_w, p.ikn_b};
        pg8::gemm_phase<EpiInproj, SchedInproj>(lds, S, E);
        if (gridDim.x == 256 && blockIdx.x >= 202) { const int lane_ = opaque_tid() & 63; phase0(p, lds, ((int)blockIdx.x - 202) * 8 + wave, 54 * 8, wave, lane_, p.jobs[13].item0, p.nitems); });
    SEAM(1);
    RUNPH(33, const int lane_ = opaque_tid() & 63; phase_ckvnorm(p, gw, ngw, lane_););
    RUNPH(32, phase_qlat(p, lds););
    RUNPH(30, phase_diff(p, lds););
    RUNPH(31, phase_scores(p, lds););
    SEAM(3);
    RUNPH(4, const int lane_ = opaque_tid() & 63; phase_dsa(p, lds, wave, lane_, a.probe););
    SEAM(4);
    RUNPH(8, phase_oproj(p, lds););
    SEAM(8);
    RUNPH(5,
        SchedMix S{1024, (int)gridDim.x, (int)blockIdx.x, (const char*)WSP(bf16_t, WS_OZA), (const char*)WSP(bf16_t, WS_WOA), (const char*)WSP(bf16_t, WS_OZB), (const char*)WSP(bf16_t, WS_WOB)};
        EpiMix E{WSP(const bf16_t, WS_GA), WSP(const bf16_t, WS_GB), WSP(bf16_t, WS_MIX)};
        pg8::gemm_phase<EpiMix, SchedMix>(lds, S, E););
    SEAM(5);
    RUNPH(6,
        SchedOut S{DM, (int)gridDim.x, (int)blockIdx.x, (const char*)WSP(bf16_t, WS_MIX), (const char*)WSP(bf16_t, WS_WOUT)};
        EpiOut E{WSP(bf16_t, WS_OUTPRE), WSP(float, WS_SSQ)};
        pg8::gemm_phase<EpiOut, SchedOut>(lds, S, E););
    SEAM(6);
    RUNPH(7, const int lane_ = opaque_tid() & 63; phase7(p, gw, ngw, lane_););
#undef RUNPH
#undef IN
#undef SEAM
}

static void add_job(Params& p, const float* src, bf16_t* dst, int K, int N, int col0, int ncols, int row0) {
    TJob& j = p.jobs[p.njobs++]; j.src = src; j.dst = dst; j.K = K; j.N = N; j.col0 = col0; j.nblk = (ncols + 31) / 32; j.row0 = row0; j.item0 = p.nitems; p.nitems += (K / 64) * j.nblk;
}
extern "C" void kernel_launch(void* const* d_in, const int* in_sizes, int n_in, void* d_out, int out_size, void* d_ws, size_t ws_size, hipStream_t stream) {
    if (n_in != 16 || ws_size < WS_END) { fprintf(stderr, "kernel_launch: unexpected arguments (n_in %d, ws %zu)\n", n_in, ws_size); return; }
    static int grid = 0;
    if (!grid) {
        int dev = 0, cus = 0, per_cu = 0;
        (void)hipGetDevice(&dev); (void)hipDeviceGetAttribute(&cus, hipDeviceAttributeMultiprocessorCount, dev);
        (void)hipFuncSetAttribute((const void*)k_fwd, hipFuncAttributeMaxDynamicSharedMemorySize, LDS_BYTES);
        (void)hipOccupancyMaxActiveBlocksPerMultiprocessor(&per_cu, (const void*)k_fwd, 512, LDS_BYTES);
        (void)hipGetLastError();
        grid = cus > 0 ? cus : 256;
        if (per_cu < 1) fprintf(stderr, "kernel_launch: occupancy query reports %d blocks per CU\n", per_cu);
    }
    KArgs a; memset(&a, 0, sizeof(a));
    Params& p = a.p;
    const float** in = (const float**)d_in;
    p.x = in[0]; p.meta = in[1]; p.rel_bias = in[2]; p.pre_w = in[3]; p.w_in = in[4]; p.kv_norm_w = in[5]; p.w_uk = in[6]; p.w_uv = in[7]; p.ikn_w = in[8]; p.ikn_b = in[9];
    p.lam_p = in[10]; p.subln_w = in[11]; p.w_o_a = in[12]; p.w_o_b = in[13]; p.w_out = in[14]; p.post_w = in[15];
    p.out = (float*)d_out; p.ws = (unsigned char*)d_ws;
    bf16_t* WIN = (bf16_t*)(p.ws + WS_WIN);
    const int NIN = 11600;
    add_job(p, p.w_in, WIN, DM, NIN, 0, 1024, 0);
    add_job(p, p.w_in, WIN, DM, NIN, 1280, 1024, 1024);
    add_job(p, p.w_in, WIN, DM, NIN, 2304, 1024, 2048);
    add_job(p, p.w_in, WIN, DM, NIN, 3408, 1024, 3072);
    add_job(p, p.w_in, WIN, DM, NIN, 6480, 1024, 4096);
    add_job(p, p.w_in, WIN, DM, NIN, 7504, 2048, 5120);
    add_job(p, p.w_in, WIN, DM, NIN, 9552, 2048, 7168);
    add_job(p, p.w_in, WIN, DM, NIN, 4432, 1024, 9216);
    add_job(p, p.w_in, WIN, DM, NIN, 5456, 1024, 10240);
    add_job(p, p.w_in, WIN, DM, NIN, 1024, 256, 11264);
    add_job(p, p.w_in, WIN, DM, NIN, 3328, 32, 11520);
    add_job(p, p.w_in, WIN, DM, NIN, 3392, 32, 11520 + 32);
    add_job(p, p.w_in, WIN, DM, NIN, 3360, 32, 11520 + 128);
    add_job(p, p.w_o_a, (bf16_t*)(p.ws + WS_WOA), 1024, DM, 0, DM, 0);
    add_job(p, p.w_o_b, (bf16_t*)(p.ws + WS_WOB), 1024, DM, 0, DM, 0);
    add_job(p, p.w_out, (bf16_t*)(p.ws + WS_WOUT), DM, DM, 0, DM, 0);
    add_job(p, p.w_uv, (bf16_t*)(p.ws + WS_WUVT), 256, 1024, 0, 1024, 0);
    (void)hipMemsetAsync((char*)d_ws + WS_CTL, 0, CTL_BYTES, stream);
#if ONE_LAUNCH
    a.ph_lo = 0; a.ph_hi = NPHASE; a.probe = PROBE_REP;
    hipLaunchKernelGGL(k_fwd, dim3(grid), dim3(512), LDS_BYTES, stream, a);
#else
    for (int ph = 0; ph < NPHASE; ++ph) { a.ph_lo = ph; a.ph_hi = ph + 1; hipLaunchKernelGGL(k_fwd, dim3(grid), dim3(512), LDS_BYTES, stream, a); }
#endif
}
```

```cpp
#include <hip/hip_runtime.h>
#include <cstdio>
#include <cstdint>
#include <cstring>

#ifndef PROBE_REP
#define PROBE_REP (-1)
#endif
#define LAS __attribute__((address_space(3)))
#define GAS __attribute__((address_space(1)))
typedef unsigned short bf16_t;
typedef short bf16x8 __attribute__((ext_vector_type(8)));
typedef float f32x4 __attribute__((ext_vector_type(4)));
typedef unsigned u32x4 __attribute__((ext_vector_type(4)));
typedef unsigned u32x2 __attribute__((ext_vector_type(2)));

constexpr int DM = 2048, NB = 2, SEQ = 4096, NMETA = 16, TK = SEQ + NMETA  , MTOK = NB * SEQ  , MKEY = NB * TK  ;
constexpr int UROWS = 8448;
constexpr int NPAD = 11776;
constexpr float EPS = 1e-6f;
constexpr float LOG2E = 1.4426950408889634f;
constexpr size_t SC_PER_B = 8585216;

constexpr size_t MiB = 1u << 20;
constexpr size_t WS_CTL = 0, CTL_BYTES = 1 * MiB;
constexpr size_t WS_U = 1 * MiB;
constexpr size_t WS_WIN = 34 * MiB;
constexpr size_t WS_SC = 1 * MiB;
constexpr size_t WS_MIX = 1 * MiB;
constexpr size_t WS_WOA = 80 * MiB, WS_WOB = 84 * MiB, WS_WOUT = 88 * MiB, WS_WUK = 96 * MiB, WS_WUVT = 96 * MiB + 512 * 1024;
constexpr size_t WS_QA = 97 * MiB, WS_IQ = 113 * MiB, WS_QB = 129 * MiB, WS_ZA = 145 * MiB, WS_ZB = 161 * MiB, WS_GA = 177 * MiB, WS_GB = 209 * MiB;
constexpr size_t WS_OLAT = 241 * MiB;
constexpr size_t WS_OZA = 129 * MiB;
constexpr size_t WS_KB = 241 * MiB, WS_VB = 258 * MiB, WS_CKVRAW = 275 * MiB, WS_IKRAW = 284 * MiB, WS_IW = 287 * MiB, WS_CKV = 288 * MiB, WS_IK = 293 * MiB;
constexpr size_t WS_QLAT = 295 * MiB;
constexpr size_t WS_OUTPRE = 295 * MiB;
constexpr size_t WS_OZB = 327 * MiB, WS_SSQ = 343 * MiB, WS_END = 344 * MiB;

__device__ __forceinline__ int opaque_tid() { int t = threadIdx.x; asm volatile("" : "+v"(t)); return t; }
__device__ __forceinline__ float bf2f(unsigned short u) { return __uint_as_float(((unsigned)u) << 16); }
__device__ __forceinline__ unsigned f2bf(float f) { unsigned u = __float_as_uint(f); return (u + 0x7fffu + ((u >> 16) & 1u)) >> 16; }
__device__ __forceinline__ unsigned pk2(float lo, float hi) { return f2bf(lo) | (f2bf(hi) << 16); }
__device__ __forceinline__ float bflo(unsigned w) { return __uint_as_float(w << 16); }
__device__ __forceinline__ float bfhi(unsigned w) { return __uint_as_float(w & 0xffff0000u); }
__device__ __forceinline__ float wave_sum(float v) {
#pragma unroll
    for (int o = 1; o < 64; o <<= 1) v += __shfl_xor(v, o);
    return v;
}
__device__ __forceinline__ float silu_f(float x) { return x * __builtin_amdgcn_rcpf(1.f + __expf(-x)); }
__device__ __forceinline__ int t5_bucket(int rel) {
    const int n = rel < 0 ? -rel : rel; int f;
    if (n < 8) f = n; else if (n < 12) f = 8; else if (n < 16) f = 9; else if (n < 23) f = 10; else if (n < 32) f = 11; else if (n < 46) f = 12; else if (n < 64) f = 13; else if (n < 91) f = 14; else f = 15;
    return (rel > 0 ? 16 : 0) + f;
}
__device__ __forceinline__ size_t sc_off(int b, int j) {
    const int c = 1 + (j >> 6);
    return (size_t)b * SC_PER_B + (size_t)1024 * (c - 1) + (size_t)2048 * (c - 1) * c + (size_t)(j & 63) * (16 + 64 * c);
}

namespace pg8 {
constexpr int BM = 256, BK = 64, HALF = 128, HTB = HALF * BK * 2, STAGE_BYTES = 8 * HTB, NXCD = 8, WGM = 8;
__host__ __device__ __forceinline__ int lds_byte(int r, int c) { const int st = (r >> 4) * 2 + (c >> 5), rr = r & 15, cc = c & 31, ob = rr * 64 + cc * 2; return st * 1024 + (ob ^ (((ob >> 9) & 1) << 5)); }
__host__ __device__ __forceinline__ void stage_rc(int b, int& R, int& C) { const int st = b / 1024, sb = b % 1024, swz = sb ^ (((sb >> 9) & 1) << 5); R = (st >> 1) * 16 + swz / 64; C = (st & 1) * 32 + (swz % 64) / 2; }
__host__ __device__ __forceinline__ int perm32(int rho) { const int n = rho >> 4, i = rho & 15; return 8 * (i >> 2) + 4 * n + (i & 3); }

struct Unit { int pm, pn, sub; };
__device__ __forceinline__ unsigned cvt_pk_bf16(float lo, float hi) { unsigned r; asm volatile("v_cvt_pk_bf16_f32 %0, %1, %2" : "=v"(r) : "v"(lo), "v"(hi)); return r; }

__device__ __forceinline__ void tile_of(int L, int nM, int nN, int& pm, int& pn) {
    const int nwg = nM * nN; int wgid = L; { const int q = nwg / NXCD, r = nwg % NXCD, xcd = wgid % NXCD, off = wgid / NXCD; wgid = (xcd < r ? xcd * (q + 1) : r * (q + 1) + (xcd - r) * q) + off; }
    const int nig = WGM * nN, gid = wgid / nig, fm = gid * WGM, gsz = (nM - fm) < WGM ? (nM - fm) : WGM;
    pm = fm + ((wgid % nig) % gsz); pn = (wgid % nig) / gsz;
}

template <class Epi, class Sched, bool ALIGN_EPI = true, bool SP2 = true>
__device__ __forceinline__ void gemm_phase(LAS unsigned char* lds, const Sched& S, const Epi& E) {
    const int tid = opaque_tid(), wid = __builtin_amdgcn_readfirstlane(tid >> 6), lane = tid & 63, wr = wid >> 2, wc = wid & 3, fr = lane & 15, fq = lane >> 4;
    const int K = S.K, nt = K / BK;
    unsigned voffA[2], voffB[2];
#pragma unroll
    for (int i = 0; i < 2; ++i) { int R, C; stage_rc(tid * 16 + i * 8192, R, C); const int Rb = Epi::PERM ? ((R & ~31) + perm32(R & 31)) : R;
        voffA[i] = (unsigned)(R * K + C) * 2u; voffB[i] = (unsigned)(Rb * K + C) * 2u; }
    const size_t kstep = (size_t)(BK * 2);
    const size_t hstep = (size_t)HALF * K * 2;
    const unsigned ldsw = (unsigned)wid * 1024u;
    const int aoff = lds_byte(wr * 64 + fr, fq * 8), boff = lds_byte(wc * 32 + fr, fq * 8);
#define PG8_SA(b, h) (((b) * 2 + (h)) * HTB)
#define PG8_SB(b, h) ((4 + (b) * 2 + (h)) * HTB)
#define PG8_STAGE(bufoff, gbase, voff) do { _Pragma("unroll") for (int _i = 0; _i < 2; ++_i) \
        __builtin_amdgcn_global_load_lds((const unsigned*)((const char*)(gbase) + (voff)[_i]), (LAS unsigned*)(lds + (bufoff) + ldsw + _i * 8192), 16, 0, 0); } while (0)
#define PG8_LDA(dst, b, h) do { _Pragma("unroll") for (int m = 0; m < 4; ++m) _Pragma("unroll") for (int k = 0; k < 2; ++k) dst[m][k] = *(const LAS bf16x8*)(lds + PG8_SA(b, h) + aoff + m * 2048 + k * 1024); } while (0)
#define PG8_LDB(dst, b, h) do { _Pragma("unroll") for (int n = 0; n < 2; ++n) _Pragma("unroll") for (int k = 0; k < 2; ++k) dst[n][k] = *(const LAS bf16x8*)(lds + PG8_SB(b, h) + boff + n * 2048 + k * 1024); } while (0)
#define PG8_MMA(ai, bj, At, Bt) do { __builtin_amdgcn_s_setprio(1); _Pragma("unroll") for (int m = 0; m < 4; ++m) _Pragma("unroll") for (int n = 0; n < 2; ++n) _Pragma("unroll") for (int k = 0; k < 2; ++k) \
        acc[ai][bj][m][n] = __builtin_amdgcn_mfma_f32_16x16x32_bf16(Bt[n][k], At[m][k], acc[ai][bj][m][n], 0, 0, 0); __builtin_amdgcn_s_setprio(0); } while (0)
#define PG8_WAIT_V(n) asm volatile("s_waitcnt vmcnt(" #n ")" ::: "memory")
#define PG8_WAIT_L(n) asm volatile("s_waitcnt lgkmcnt(" #n ")" ::: "memory")
#define PG8_BAR __builtin_amdgcn_s_barrier()
#define PG8_SCHED __builtin_amdgcn_sched_barrier(0)
    Unit cur, nxt; int ui = 0;
    if (!S.next(0, cur)) return;
    f32x4 acc[2][2][4][2];
#pragma unroll
    for (int a = 0; a < 2; ++a)
#pragma unroll
        for (int b = 0; b < 2; ++b)
#pragma unroll
            for (int m = 0; m < 4; ++m)
#pragma unroll
                for (int n = 0; n < 2; ++n) acc[a][b][m][n] = (f32x4){0.f, 0.f, 0.f, 0.f};
    bf16x8 At[4][2], B0[2][2], B1[2][2];
    const char* cA = S.a_ptr(cur); const char* cB = S.b_ptr(cur);
    if constexpr (SP2) {
        PG8_STAGE(PG8_SB(0, 0), cB, voffB); PG8_STAGE(PG8_SB(0, 1), cB + hstep, voffB); PG8_STAGE(PG8_SA(0, 0), cA, voffA); PG8_STAGE(PG8_SA(0, 1), cA + hstep, voffA);
        if (wr == 1) PG8_BAR;
        PG8_WAIT_V(2); PG8_BAR;
        PG8_STAGE(PG8_SB(1, 0), cB + kstep, voffB); PG8_STAGE(PG8_SA(1, 0), cA + kstep, voffA); PG8_STAGE(PG8_SB(1, 1), cB + hstep + kstep, voffB);
        PG8_WAIT_V(6); PG8_BAR;
    } else {
        PG8_STAGE(PG8_SB(0, 0), cB, voffB); PG8_STAGE(PG8_SA(0, 0), cA, voffA); PG8_STAGE(PG8_SB(0, 1), cB + hstep, voffB); PG8_STAGE(PG8_SA(0, 1), cA + hstep, voffA);
        if (wr == 1) PG8_BAR;
        PG8_WAIT_V(4); PG8_BAR;
        PG8_STAGE(PG8_SB(1, 0), cB + kstep, voffB); PG8_STAGE(PG8_SA(1, 0), cA + kstep, voffA); PG8_STAGE(PG8_SB(1, 1), cB + hstep + kstep, voffB);
        PG8_WAIT_V(6); PG8_BAR;
    }
    for (;;) {
        const bool has_next = S.next(ui + 1, nxt);
        const char* nA = has_next ? S.a_ptr(nxt) : cA; const char* nB = has_next ? S.b_ptr(nxt) : cB;
        for (int t = 0; t < nt; t += 2) {
            const bool last = (t == nt - 2);
            const char* a1 = cA + (size_t)(t + 1) * kstep;
            const char* a2 = last ? nA : cA + (size_t)(t + 2) * kstep; const char* b2 = last ? nB : cB + (size_t)(t + 2) * kstep;
            const char* a3 = a2 + kstep; const char* b3 = b2 + kstep;
            if constexpr (SP2) {
            PG8_LDB(B0, 0, 0); PG8_LDB(B1, 0, 1); PG8_SCHED; PG8_LDA(At, 0, 0); PG8_STAGE(PG8_SA(1, 1), a1 + hstep, voffA);
            PG8_WAIT_V(8); PG8_WAIT_L(0); PG8_BAR; PG8_MMA(0, 0, At, B0); PG8_MMA(0, 1, At, B1); PG8_BAR; PG8_SCHED;
            PG8_LDA(At, 0, 1); PG8_STAGE(PG8_SB(0, 0), b2, voffB); PG8_STAGE(PG8_SB(0, 1), b2 + hstep, voffB); PG8_STAGE(PG8_SA(0, 0), a2, voffA);
            PG8_WAIT_V(8); PG8_WAIT_L(0); PG8_BAR; PG8_MMA(1, 0, At, B0); PG8_MMA(1, 1, At, B1); PG8_BAR; PG8_SCHED;
            PG8_LDB(B0, 1, 0); PG8_LDB(B1, 1, 1); PG8_SCHED; PG8_LDA(At, 1, 0); PG8_STAGE(PG8_SA(0, 1), a2 + hstep, voffA);
            PG8_WAIT_V(8); PG8_WAIT_L(0); PG8_BAR; PG8_MMA(0, 0, At, B0); PG8_MMA(0, 1, At, B1); PG8_BAR; PG8_SCHED;
            PG8_LDA(At, 1, 1); PG8_STAGE(PG8_SB(1, 0), b3, voffB); PG8_STAGE(PG8_SB(1, 1), b3 + hstep, voffB); PG8_STAGE(PG8_SA(1, 0), a3, voffA);
            PG8_WAIT_V(8); PG8_WAIT_L(0); PG8_BAR; PG8_MMA(1, 0, At, B0); PG8_MMA(1, 1, At, B1); PG8_BAR; PG8_SCHED;
            } else {
            PG8_LDB(B0, 0, 0); PG8_SCHED; PG8_LDA(At, 0, 0); PG8_STAGE(PG8_SA(1, 1), a1 + hstep, voffA);
            PG8_WAIT_L(8); PG8_BAR; PG8_WAIT_L(0); PG8_MMA(0, 0, At, B0); PG8_BAR; PG8_SCHED;
            PG8_LDB(B1, 0, 1); PG8_STAGE(PG8_SB(0, 0), b2, voffB);
            PG8_BAR; PG8_WAIT_L(0); PG8_MMA(0, 1, At, B1); PG8_BAR;
            PG8_LDA(At, 0, 1); PG8_STAGE(PG8_SA(0, 0), a2, voffA);
            PG8_BAR; PG8_WAIT_L(0); PG8_MMA(1, 0, At, B0); PG8_BAR; PG8_SCHED;
            PG8_STAGE(PG8_SB(0, 1), b2 + hstep, voffB);
            PG8_WAIT_V(6); PG8_BAR; PG8_MMA(1, 1, At, B1); PG8_BAR;
            PG8_LDB(B0, 1, 0); PG8_SCHED; PG8_LDA(At, 1, 0); PG8_STAGE(PG8_SA(0, 1), a2 + hstep, voffA);
            PG8_WAIT_L(8); PG8_BAR; PG8_WAIT_L(0); PG8_MMA(0, 0, At, B0); PG8_BAR; PG8_SCHED;
            PG8_LDB(B1, 1, 1); PG8_STAGE(PG8_SB(1, 0), b3, voffB);
            PG8_BAR; PG8_WAIT_L(0); PG8_MMA(0, 1, At, B1); PG8_BAR;
            PG8_LDA(At, 1, 1); PG8_STAGE(PG8_SA(1, 0), a3, voffA);
            PG8_BAR; PG8_WAIT_L(0); PG8_MMA(1, 0, At, B0); PG8_BAR; PG8_SCHED;
            PG8_STAGE(PG8_SB(1, 1), b3 + hstep, voffB);
            PG8_WAIT_V(6); PG8_BAR; PG8_MMA(1, 1, At, B1); PG8_BAR;
            }
        }
        if constexpr (ALIGN_EPI) { if (wr == 0) PG8_BAR; }
        E(acc, cur, wr, wc, fr, fq);
        if (!has_next) break;
        if (!E.keep_acc(cur)) {
#pragma unroll
        for (int a = 0; a < 2; ++a)
#pragma unroll
            for (int b = 0; b < 2; ++b)
#pragma unroll
                for (int m = 0; m < 4; ++m)
#pragma unroll
                    for (int n = 0; n < 2; ++n) acc[a][b][m][n] = (f32x4){0.f, 0.f, 0.f, 0.f};
        }
        cur = nxt; cA = nA; cB = nB; ++ui;
        if constexpr (ALIGN_EPI) { if (wr == 1) PG8_BAR; }
    }
    PG8_WAIT_V(0);
    if constexpr (!ALIGN_EPI) { if (wr == 0) PG8_BAR; }
    PG8_BAR;
#undef PG8_SA
#undef PG8_SB
#undef PG8_STAGE
#undef PG8_LDA
#undef PG8_LDB
#undef PG8_MMA
#undef PG8_WAIT_V
#undef PG8_WAIT_L
#undef PG8_BAR
#undef PG8_SCHED
}
}

struct SchedInproj {
    int K, G, c; const char* A; const char* B;
    __device__ __forceinline__ bool next(int i, pg8::Unit& u) const {
        const int L = i * G + c; u.sub = 0;
        if (L < 1472) { pg8::tile_of(L, 32, 46, u.pm, u.pn); return true; }
        if (L < 1482) { u.pm = 32; u.pn = 36 + (L - 1472); return true; }
        return false;
    }
    __device__ __forceinline__ const char* a_ptr(const pg8::Unit& u) const { return A + (size_t)u.pm * 256 * K * 2; }
    __device__ __forceinline__ const char* b_ptr(const pg8::Unit& u) const { return B + (size_t)u.pn * 256 * K * 2; }
};
struct EpiInproj {
    static constexpr bool PERM = true;
    bf16_t *QA, *ZA, *IQ, *QB, *ZB, *GA, *GB, *KB, *VB; float *CKVRAW; bf16_t* IKN; float* IW; float qb_scale; const float *ikn_w, *ikn_b;
    __device__ __forceinline__ bool keep_acc(const pg8::Unit&) const { return false; }
    __device__ __forceinline__ void operator()(f32x4 (&acc)[2][2][4][2], const pg8::Unit& u, int wr, int wc, int fr, int fq) const {
        const int pn = u.pn;
        if (pn < 44) {
            bf16_t* base; int ldc = 1024, ct, act = 0; bool kside = false;
            if (pn < 4) { base = QA; ct = pn; } else if (pn < 8) { base = ZA; ct = pn - 4; act = 1; } else if (pn < 12) { base = IQ; ct = pn - 8; }
            else if (pn < 16) { base = QB; ct = pn - 12; act = 2; } else if (pn < 20) { base = ZB; ct = pn - 16; act = 1; }
            else if (pn < 28) { base = GA; ct = pn - 20; ldc = 2048; } else if (pn < 36) { base = GB; ct = pn - 28; ldc = 2048; }
            else if (pn < 40) { base = KB; ct = pn - 36; kside = true; } else { base = VB; ct = pn - 40; kside = true; }
            const float sc = (act == 2) ? qb_scale : 1.f;
#pragma unroll
            for (int ai = 0; ai < 2; ++ai)
#pragma unroll
                for (int m = 0; m < 4; ++m) {
                    const int r = u.pm * 256 + ai * 128 + wr * 64 + m * 16 + fr;
                    long drow = r, drow2 = -1; bool ok = true;
                    if (kside) { if (r < MTOK) drow = (long)(r >> 12) * TK + NMETA + (r & 4095); else { const int i = r - MTOK; ok = i < NMETA; drow = i; drow2 = TK + i; } }
#pragma unroll
                    for (int bj = 0; bj < 2; ++bj) {
                        f32x4 v0 = acc[ai][bj][m][0], v1 = acc[ai][bj][m][1];
                        if (act == 1) {
#pragma unroll
                            for (int e = 0; e < 4; ++e) { v0[e] = silu_f(v0[e]); v1[e] = silu_f(v1[e]); }
                        }
                        v0 = v0 * sc; v1 = v1 * sc;
                        u32x4 w; w.x = pg8::cvt_pk_bf16(v0[0], v0[1]); w.y = pg8::cvt_pk_bf16(v0[2], v0[3]); w.z = pg8::cvt_pk_bf16(v1[0], v1[1]); w.w = pg8::cvt_pk_bf16(v1[2], v1[3]);
                        const int col = ct * 256 + bj * 128 + wc * 32 + 8 * fq;
                        if (ok) { *(u32x4*)(base + (size_t)drow * ldc + col) = w; if (drow2 >= 0) *(u32x4*)(base + (size_t)drow2 * ldc + col) = w; }
                    }
                }
        } else {
#pragma unroll
            for (int ai = 0; ai < 2; ++ai)
#pragma unroll
                for (int m = 0; m < 4; ++m) {
                    const int r = u.pm * 256 + ai * 128 + wr * 64 + m * 16 + fr;
                    long drow, drow2 = -1; bool ok = true;
                    if (r < MTOK) drow = (long)(r >> 12) * TK + NMETA + (r & 4095); else { const int i = r - MTOK; ok = i < NMETA; drow = i; drow2 = TK + i; }
                    if (pn == 44) {
#pragma unroll
                        for (int bj = 0; bj < 2; ++bj) {
                            const f32x4 v0 = acc[ai][bj][m][0], v1 = acc[ai][bj][m][1];
                            const int col = bj * 128 + wc * 32 + 8 * fq;
                            if (ok) { float* p = CKVRAW + (size_t)drow * 256 + col; *(f32x4*)p = v0; *(f32x4*)(p + 4) = v1;
                                      if (drow2 >= 0) { float* p2 = CKVRAW + (size_t)drow2 * 256 + col; *(f32x4*)p2 = v0; *(f32x4*)(p2 + 4) = v1; } }
                        }
                    } else if (wc == 0) {
                        const f32x4 a0 = acc[ai][0][m][0], a1 = acc[ai][0][m][1], b0 = acc[ai][1][m][0], b1 = acc[ai][1][m][1];
                        float s = ((a0[0] + a0[1]) + (a0[2] + a0[3])) + ((a1[0] + a1[1]) + (a1[2] + a1[3])) + ((b0[0] + b0[1]) + (b0[2] + b0[3])) + ((b1[0] + b1[1]) + (b1[2] + b1[3]));
                        s += __shfl_xor(s, 16); s += __shfl_xor(s, 32);
                        const float mu = s * (1.f / 64.f);
                        const f32x4 da0 = a0 - mu, da1 = a1 - mu, db0 = b0 - mu, db1 = b1 - mu;
                        float q = ((da0[0] * da0[0] + da0[1] * da0[1]) + (da0[2] * da0[2] + da0[3] * da0[3])) + ((da1[0] * da1[0] + da1[1] * da1[1]) + (da1[2] * da1[2] + da1[3] * da1[3]))
                                + ((db0[0] * db0[0] + db0[1] * db0[1]) + (db0[2] * db0[2] + db0[3] * db0[3])) + ((db1[0] * db1[0] + db1[1] * db1[1]) + (db1[2] * db1[2] + db1[3] * db1[3]));
                        q += __shfl_xor(q, 16); q += __shfl_xor(q, 32);
                        const float rs = rsqrtf(q * (1.f / 64.f) + EPS);
                        const f32x4 wa0 = *(const f32x4*)(ikn_w + 8 * fq), wa1 = *(const f32x4*)(ikn_w + 8 * fq + 4), wb0 = *(const f32x4*)(ikn_w + 32 + 8 * fq), wb1 = *(const f32x4*)(ikn_w + 36 + 8 * fq);
                        const f32x4 ba0 = *(const f32x4*)(ikn_b + 8 * fq), ba1 = *(const f32x4*)(ikn_b + 8 * fq + 4), bb0 = *(const f32x4*)(ikn_b + 32 + 8 * fq), bb1 = *(const f32x4*)(ikn_b + 36 + 8 * fq);
                        const f32x4 ya0 = da0 * rs * wa0 + ba0, ya1 = da1 * rs * wa1 + ba1, yb0 = db0 * rs * wb0 + bb0, yb1 = db1 * rs * wb1 + bb1;
                        u32x4 pa, pb;
                        pa.x = pg8::cvt_pk_bf16(ya0[0], ya0[1]); pa.y = pg8::cvt_pk_bf16(ya0[2], ya0[3]); pa.z = pg8::cvt_pk_bf16(ya1[0], ya1[1]); pa.w = pg8::cvt_pk_bf16(ya1[2], ya1[3]);
                        pb.x = pg8::cvt_pk_bf16(yb0[0], yb0[1]); pb.y = pg8::cvt_pk_bf16(yb0[2], yb0[3]); pb.z = pg8::cvt_pk_bf16(yb1[0], yb1[1]); pb.w = pg8::cvt_pk_bf16(yb1[2], yb1[3]);
                        if (ok) { *(u32x4*)(IKN + (size_t)drow * 64 + 8 * fq) = pa; *(u32x4*)(IKN + (size_t)drow * 64 + 32 + 8 * fq) = pb;
                                  if (drow2 >= 0) { *(u32x4*)(IKN + (size_t)drow2 * 64 + 8 * fq) = pa; *(u32x4*)(IKN + (size_t)drow2 * 64 + 32 + 8 * fq) = pb; } }
                    } else if (wc == 1) {
                        const f32x4 v0 = acc[ai][0][m][0], v1 = acc[ai][0][m][1];
                        if (fq < 2 && r < MTOK) { float* p = IW + (size_t)r * 16 + 8 * fq; *(f32x4*)p = v0 * 0.03125f; *(f32x4*)(p + 4) = v1 * 0.03125f; }
                    }
                }
        }
    }
};
struct SchedMix {
    int K, G, c; const char *A0, *B0, *A1, *B1;
    __device__ __forceinline__ bool next(int i, pg8::Unit& u) const {
        const int L = (i >> 1) * G + c; if (L >= 256) return false;
        pg8::tile_of(L, 32, 8, u.pm, u.pn); u.sub = i & 1; return true;
    }
    __device__ __forceinline__ const char* a_ptr(const pg8::Unit& u) const { return (u.sub ? A1 : A0) + (size_t)u.pm * 256 * K * 2; }
    __device__ __forceinline__ const char* b_ptr(const pg8::Unit& u) const { return (u.sub ? B1 : B0) + (size_t)u.pn * 256 * K * 2; }
};
struct EpiMix {
    static constexpr bool PERM = true;
    const bf16_t *GA, *GB; bf16_t* MIX;
    __device__ __forceinline__ bool keep_acc(const pg8::Unit& u) const { return u.sub == 0; }
    __device__ __forceinline__ void operator()(f32x4 (&acc)[2][2][4][2], const pg8::Unit& u, int wr, int wc, int fr, int fq) const {
#pragma unroll
        for (int ai = 0; ai < 2; ++ai)
#pragma unroll
            for (int m = 0; m < 4; ++m) {
                const int r = u.pm * 256 + ai * 128 + wr * 64 + m * 16 + fr;
#pragma unroll
                for (int bj = 0; bj < 2; ++bj) {
                    const int col = u.pn * 256 + bj * 128 + wc * 32 + 8 * fq;
                    const u32x4 ga = *(const u32x4*)(GA + (size_t)r * DM + col), gb = *(const u32x4*)(GB + (size_t)r * DM + col);
                    float f[8];
#pragma unroll
                    for (int e = 0; e < 4; ++e) {
                        const unsigned wa = ga[e], wb = gb[e];
#pragma unroll
                        for (int hl = 0; hl < 2; ++hl) {
                            float a = hl ? bfhi(wa) : bflo(wa), b = hl ? bfhi(wb) : bflo(wb);
                            a = fminf(fmaxf(a, -30.f), 30.f); b = fminf(fmaxf(b, -30.f), 30.f);
                            const float ea = __expf(-a), eb = __expf(-b);
                            f[2 * e + hl] = (u.sub == 0) ? (1.f + eb) * __builtin_amdgcn_rcpf(1.f + ea) : __builtin_amdgcn_rcpf(1.f + eb);
                        }
                    }
                    f32x4 v0 = acc[ai][bj][m][0], v1 = acc[ai][bj][m][1];
#pragma unroll
                    for (int e = 0; e < 4; ++e) { v0[e] *= f[e]; v1[e] *= f[4 + e]; }
                    if (u.sub == 0) { acc[ai][bj][m][0] = v0; acc[ai][bj][m][1] = v1; }
                    else { u32x4 w; w.x = pg8::cvt_pk_bf16(v0[0], v0[1]); w.y = pg8::cvt_pk_bf16(v0[2], v0[3]); w.z = pg8::cvt_pk_bf16(v1[0], v1[1]); w.w = pg8::cvt_pk_bf16(v1[2], v1[3]);
                           *(u32x4*)(MIX + (size_t)r * DM + col) = w; }
                }
            }
    }
};
struct SchedOut {
    int K, G, c; const char *A, *B;
    __device__ __forceinline__ bool next(int i, pg8::Unit& u) const { const int L = i * G + c; if (L >= 256) return false; pg8::tile_of(L, 32, 8, u.pm, u.pn); u.sub = 0; return true; }
    __device__ __forceinline__ const char* a_ptr(const pg8::Unit& u) const { return A + (size_t)u.pm * 256 * K * 2; }
    __device__ __forceinline__ const char* b_ptr(const pg8::Unit& u) const { return B + (size_t)u.pn * 256 * K * 2; }
};
struct EpiOut {
    static constexpr bool PERM = true;
    bf16_t* OUTPRE; float* SSQ;
    __device__ __forceinline__ bool keep_acc(const pg8::Unit&) const { return false; }
    __device__ __forceinline__ void operator()(f32x4 (&acc)[2][2][4][2], const pg8::Unit& u, int wr, int wc, int fr, int fq) const {
#pragma unroll
        for (int ai = 0; ai < 2; ++ai)
#pragma unroll
            for (int m = 0; m < 4; ++m) {
                const int r = u.pm * 256 + ai * 128 + wr * 64 + m * 16 + fr; float ss = 0.f;
#pragma unroll
                for (int bj = 0; bj < 2; ++bj) {
                    const f32x4 v0 = acc[ai][bj][m][0], v1 = acc[ai][bj][m][1];
                    ss += (v0[0] * v0[0] + v0[1] * v0[1]) + (v0[2] * v0[2] + v0[3] * v0[3]) + (v1[0] * v1[0] + v1[1] * v1[1]) + (v1[2] * v1[2] + v1[3] * v1[3]);
                    u32x4 w; w.x = pg8::cvt_pk_bf16(v0[0], v0[1]); w.y = pg8::cvt_pk_bf16(v0[2], v0[3]); w.z = pg8::cvt_pk_bf16(v1[0], v1[1]); w.w = pg8::cvt_pk_bf16(v1[2], v1[3]);
                    *(u32x4*)(OUTPRE + (size_t)r * DM + u.pn * 256 + bj * 128 + wc * 32 + 8 * fq) = w;
                }
                ss += __shfl_xor(ss, 16); ss += __shfl_xor(ss, 32);
                if (fq == 0) SSQ[(size_t)r * 32 + u.pn * 4 + wc] = ss;
            }
    }
};

struct EpiOutFused {
    static constexpr bool PERM = false;
    const float* x; const float* post_w; float* out; float* SSQ; unsigned* cnt; LAS unsigned char* lds;
    __device__ __forceinline__ bool keep_acc(const pg8::Unit&) const { return false; }
    __device__ __forceinline__ void operator()(f32x4 (&acc)[2][2][4][2], const pg8::Unit& u, int wr, int wc, int fr, int fq) const {
        const int tid = opaque_tid(), wid = __builtin_amdgcn_readfirstlane(tid >> 6), lane = tid & 63;
        LAS float* S = (LAS float*)(lds + 131072);
#pragma unroll
        for (int ai = 0; ai < 2; ++ai)
#pragma unroll
            for (int m = 0; m < 4; ++m) {
                float ss = 0.f;
#pragma unroll
                for (int bj = 0; bj < 2; ++bj)
#pragma unroll
                    for (int n = 0; n < 2; ++n) { const f32x4 v = acc[ai][bj][m][n]; ss += (v[0] * v[0] + v[1] * v[1]) + (v[2] * v[2] + v[3] * v[3]); }
                ss += __shfl_xor(ss, 16); ss += __shfl_xor(ss, 32);
                if (fq == 0) __hip_atomic_store(SSQ + (size_t)(u.pm * 256 + ai * 128 + wr * 64 + m * 16 + fr) * 32 + u.pn * 4 + wc, ss, __ATOMIC_RELAXED, __HIP_MEMORY_SCOPE_AGENT);
            }
        asm volatile("s_waitcnt vmcnt(0)" ::: "memory");
        if (lane == 0) __hip_atomic_fetch_add(cnt + 64 * u.pm, 1u, __ATOMIC_RELAXED, __HIP_MEMORY_SCOPE_AGENT);
        if (wid == 0) {
            for (unsigned it = 0; it < (1u << 22); ++it) {
                if ((unsigned)__builtin_amdgcn_readfirstlane(__hip_atomic_load(cnt + 64 * u.pm, __ATOMIC_RELAXED, __HIP_MEMORY_SCOPE_AGENT)) >= 64u) break;
                __builtin_amdgcn_s_sleep(2);
            }
            __builtin_amdgcn_fence(__ATOMIC_ACQUIRE, "agent");
        }
        asm volatile("s_waitcnt vmcnt(0) lgkmcnt(0)" ::: "memory"); __builtin_amdgcn_s_barrier(); asm volatile("" ::: "memory");
        if (tid < 256) {
            const unsigned long long* slot = (const unsigned long long*)(SSQ + (size_t)(u.pm * 256 + tid) * 32); float s = 0.f;
#pragma unroll
            for (int t = 0; t < 16; ++t) { const unsigned long long w = __hip_atomic_load(slot + t, __ATOMIC_RELAXED, __HIP_MEMORY_SCOPE_AGENT); s += __uint_as_float((unsigned)w) + __uint_as_float((unsigned)(w >> 32)); }
            S[tid] = rsqrtf(s * (1.f / DM) + EPS);
        }
        asm volatile("s_waitcnt lgkmcnt(0)" ::: "memory"); __builtin_amdgcn_s_barrier(); asm volatile("" ::: "memory");
        const f32x4 g = *(const f32x4*)(post_w + u.pn * 256 + 4 * lane);
        const int lr0 = 4 * wid;
        const size_t gbase = (size_t)(u.pm * 256 + (lr0 >> 4) * 64 + (lr0 & 15)) * DM + u.pn * 256 + 4 * lane;
        const unsigned woff = (unsigned)((wr * 16 + fr) * 1040 + (wc * 32 + 4 * fq) * 4), roff = (unsigned)(lr0 * 1040 + lane * 16);
        f32x4 xv[4], xn[4];
#pragma unroll
        for (int q = 0; q < 4; ++q) xv[q] = __builtin_nontemporal_load((const f32x4*)(x + gbase + (size_t)q * DM));
#pragma unroll
        for (int s = 0; s < 8; ++s) {
            const int ai = s >> 2, m = s & 3; LAS unsigned char* T = lds + (s & 1) * 33280;
            const float rs = S[ai * 128 + wr * 64 + m * 16 + fr];
#pragma unroll
            for (int bj = 0; bj < 2; ++bj)
#pragma unroll
                for (int n = 0; n < 2; ++n) *(LAS f32x4*)(T + woff + bj * 512 + n * 64) = acc[ai][bj][m][n] * rs;
            if (s < 7) {
                const size_t o2 = (size_t)(((s + 1) >> 2) * 128 + ((s + 1) & 3) * 16) * DM;
#pragma unroll
                for (int q = 0; q < 4; ++q) xn[q] = __builtin_nontemporal_load((const f32x4*)(x + gbase + o2 + (size_t)q * DM));
            }
            asm volatile("s_waitcnt lgkmcnt(0)" ::: "memory"); __builtin_amdgcn_s_barrier(); asm volatile("" ::: "memory");
            const size_t o1 = (size_t)(ai * 128 + m * 16) * DM;
#pragma unroll
            for (int q = 0; q < 4; ++q) { const f32x4 v = *(const LAS f32x4*)(T + roff + q * 1040); *(f32x4*)(out + gbase + o1 + (size_t)q * DM) = xv[q] + v * g; }
#pragma unroll
            for (int q = 0; q < 4; ++q) xv[q] = xn[q];
        }
    }
};

struct TJob { const float* src; bf16_t* dst; int K, N, col0, nblk, row0, item0; };
struct Params {
    const float *x, *meta, *rel_bias, *pre_w, *w_in, *kv_norm_w, *w_uk, *w_uv, *ikn_w, *ikn_b, *lam_p, *subln_w, *w_o_a, *w_o_b, *w_out, *post_w;
    float* out; unsigned char* ws;
    TJob jobs[17]; int njobs, nitems;
};
#define WSP(T, off) ((T*)(p.ws + (off)))

__device__ __forceinline__ void p0_transpose_item(const TJob& jb, LAS float* scr, int item, int lane) {
    const int kb = item / jb.nblk, nb = item % jb.nblk, k0 = 64 * kb, n0 = jb.col0 + 32 * nb;
#pragma unroll 8
    for (int i = 0; i < 32; ++i) { const int kk = 2 * i + (lane >> 5); scr[kk * 33 + (lane & 31)] = __builtin_nontemporal_load(jb.src + (size_t)(k0 + kk) * jb.N + n0 + (lane & 31)); }
    asm volatile("s_waitcnt lgkmcnt(0)" ::: "memory");
    const int c = lane & 7;
#pragma unroll
    for (int j = 0; j < 4; ++j) { const int n = (lane >> 3) + 8 * j; const LAS float* s = scr + (8 * c) * 33 + n;
        u32x4 o; o.x = pk2(s[0 * 33], s[1 * 33]); o.y = pk2(s[2 * 33], s[3 * 33]); o.z = pk2(s[4 * 33], s[5 * 33]); o.w = pk2(s[6 * 33], s[7 * 33]);
        *(u32x4*)(jb.dst + (size_t)(jb.row0 + 32 * nb + n) * jb.K + k0 + 8 * c) = o; }
    asm volatile("s_waitcnt lgkmcnt(0)" ::: "memory");
}
__device__ __forceinline__ void p0_norm_row(const float* xrow, const float* g, bf16_t* orow, int lane) {
    const f32x4* xr = (const f32x4*)xrow + lane; const f32x4* gr = (const f32x4*)g + lane;
    f32x4 v[8]; float s = 0.f;
#pragma unroll
    for (int j = 0; j < 8; ++j) { v[j] = __builtin_nontemporal_load(xr + 64 * j); s += (v[j].x * v[j].x + v[j].y * v[j].y) + (v[j].z * v[j].z + v[j].w * v[j].w); }
    const float rstd = rsqrtf(wave_sum(s) * (1.f / DM) + EPS);
    u32x2* o8 = (u32x2*)orow + lane;
#pragma unroll
    for (int j = 0; j < 8; ++j) { const f32x4 gg = gr[64 * j]; u32x2 w; w.x = pk2(v[j].x * rstd * gg.x, v[j].y * rstd * gg.y); w.y = pk2(v[j].z * rstd * gg.z, v[j].w * rstd * gg.w); o8[64 * j] = w; }
}
__device__ __forceinline__ void phase0(const Params& p, LAS unsigned char* lds, int gw, int ngw, int wave, int lane, int item_lo, int item_hi) {
    LAS float* scr = (LAS float*)(lds + wave * 16384);
    for (int it = gw + item_lo; it < item_hi; it += ngw) {
        int jn = 0;
#pragma unroll
        for (int q = 1; q < 17; ++q) if (q < p.njobs && it >= p.jobs[q].item0) jn = q;
        p0_transpose_item(p.jobs[jn], scr, it - p.jobs[jn].item0, lane);
    }
    if (item_lo != 0) return;
    bf16_t* U = WSP(bf16_t, WS_U);
    for (int m = gw; m < UROWS; m += ngw) {
        if (m < MTOK) p0_norm_row(p.x + (size_t)m * DM, p.pre_w, U + (size_t)m * DM, lane);
        else if (m < MTOK + NMETA) p0_norm_row(p.meta + (size_t)(m - MTOK) * DM, p.pre_w, U + (size_t)m * DM, lane);
        else { u32x4* o = (u32x4*)(U + (size_t)m * DM) + lane;
#pragma unroll
            for (int j = 0; j < 4; ++j) o[64 * j] = (u32x4){0u, 0u, 0u, 0u}; }
    }
    bf16_t* WUK = WSP(bf16_t, WS_WUK);
    for (int i = gw * 64 + lane; i < 262144 / 4; i += ngw * 64) { const f32x4 v = ((const f32x4*)p.w_uk)[i]; u32x2 w; w.x = pk2(v.x, v.y); w.y = pk2(v.z, v.w); ((u32x2*)WUK)[i] = w; }
}

__device__ __forceinline__ void phase_ckvnorm(const Params& p, int gw, int ngw, int lane) {
    const float* CKVRAW = WSP(const float, WS_CKVRAW); bf16_t* CKV = WSP(bf16_t, WS_CKV);
    for (int r = gw; r < MKEY; r += ngw) {
        const f32x4 v = ((const f32x4*)(CKVRAW + (size_t)r * 256))[lane];
        const float ss = wave_sum((v.x * v.x + v.y * v.y) + (v.z * v.z + v.w * v.w));
        const float rstd = rsqrtf(ss * (1.f / 256.f) + EPS);
        const f32x4 g = ((const f32x4*)p.kv_norm_w)[lane];
        int w = __builtin_amdgcn_cvt_pk_fp8_f32(v.x * rstd * g.x, v.y * rstd * g.y, 0, false); w = __builtin_amdgcn_cvt_pk_fp8_f32(v.z * rstd * g.z, v.w * rstd * g.w, w, true);
        ((unsigned*)((unsigned char*)CKV + (size_t)r * 256))[lane] = (unsigned)w;
    }
}

__device__ __forceinline__ void phase7(const Params& p, int gw, int ngw, int lane) {
    const bf16_t* OUTPRE = WSP(const bf16_t, WS_OUTPRE); const float* SSQ = WSP(const float, WS_SSQ);
    for (int r = gw; r < MTOK; r += ngw) {
        float s = (lane < 32) ? SSQ[(size_t)r * 32 + lane] : 0.f; s = wave_sum(s);
        const float rstd = rsqrtf(s * (1.f / DM) + EPS);
        const u32x4* o = (const u32x4*)(OUTPRE + (size_t)r * DM); const f32x4* xr = (const f32x4*)(p.x + (size_t)r * DM); const f32x4* g = (const f32x4*)p.post_w; f32x4* out = (f32x4*)(p.out + (size_t)r * DM);
#pragma unroll
        for (int j = 0; j < 4; ++j) {
            const int ch = 64 * j + lane;
            const u32x4 w = o[ch]; const f32x4 x0 = __builtin_nontemporal_load(xr + 2 * ch), x1 = __builtin_nontemporal_load(xr + 2 * ch + 1), g0 = g[2 * ch], g1 = g[2 * ch + 1];
            f32x4 y0, y1;
            y0.x = x0.x + bflo(w.x) * rstd * g0.x; y0.y = x0.y + bfhi(w.x) * rstd * g0.y; y0.z = x0.z + bflo(w.y) * rstd * g0.z; y0.w = x0.w + bfhi(w.y) * rstd * g0.w;
            y1.x = x1.x + bflo(w.z) * rstd * g1.x; y1.y = x1.y + bfhi(w.z) * rstd * g1.y; y1.z = x1.z + bflo(w.w) * rstd * g1.z; y1.w = x1.w + bfhi(w.w) * rstd * g1.w;
            out[2 * ch] = y0; out[2 * ch + 1] = y1;
        }
    }
}

typedef short v4i16_t __attribute__((ext_vector_type(4)));
typedef float f32x2_t __attribute__((ext_vector_type(2))); typedef __bf16 bf16x2_t __attribute__((ext_vector_type(2)));
__device__ __forceinline__ unsigned cvtpk_s(float lo, float hi) { const f32x2_t v = {lo, hi}; const bf16x2_t b = __builtin_convertvector(v, bf16x2_t); return __builtin_bit_cast(unsigned, b); }
__device__ __forceinline__ unsigned off_b(unsigned row, unsigned ch) { const unsigned f = ((row >> 3) & 1u) | ((((row >> 2) ^ (row >> 3)) & 1u) << 1) | (((row >> 1) & 1u) << 2) | ((row & 1u) << 3); return 256u * row + 16u * (ch ^ f); }
__device__ __forceinline__ bf16x8 tr_frag(LAS unsigned char* img, unsigned a0, unsigned a1) {
    const v4i16_t lo = __builtin_amdgcn_ds_read_tr16_b64_v4i16((LAS v4i16_t*)(img + a0));
    const v4i16_t hi = __builtin_amdgcn_ds_read_tr16_b64_v4i16((LAS v4i16_t*)(img + a1));
    return (bf16x8){lo[0], lo[1], lo[2], lo[3], hi[0], hi[1], hi[2], hi[3]};
}
__device__ __forceinline__ void glds16(const void* gsrc, unsigned lds_dst) {
    unsigned keep;
    asm volatile("s_mov_b32 %0, m0\n\ts_mov_b32 m0, %2\n\ts_nop 0\n\tglobal_load_lds_dwordx4 %1, off\n\ts_mov_b32 m0, %0" : "=&s"(keep) : "v"(gsrc), "s"(lds_dst) : "memory");
}
constexpr int DB_K = 0, DB_V = 49152, DB_LUT = 98304, DB_Q = 99328;
constexpr float DIFF_THR = 24.0f;
__device__ __forceinline__ void diff_unit(const Params& p, LAS unsigned char* lds, int b, int h, int qb, float lam) {
    const bf16_t* QB = WSP(const bf16_t, WS_QB); const bf16_t* KB = WSP(const bf16_t, WS_KB); const bf16_t* VB = WSP(const bf16_t, WS_VB); const bf16_t* ZB = WSP(const bf16_t, WS_ZB); bf16_t* OZB = WSP(bf16_t, WS_OZB);
    const int tid = opaque_tid(), lane = tid & 63, wave = __builtin_amdgcn_readfirstlane(tid >> 6), l15 = lane & 15, g = lane >> 4;
    const int jw = 128 * qb + 16 * wave, jq = jw + l15, cw = 2 * qb + 1 + (wave >> 2), ntiles = 2 * qb + 3;
    LAS float* LUT = (LAS float*)(lds + DB_LUT);
    __syncthreads();
    if (tid < 155) LUT[tid] = p.rel_bias[t5_bucket(tid - 91) * 16 + 8 + h] * LOG2E;
    LAS unsigned char* Qimg = lds + DB_Q + wave * 4096;
    { const bf16_t* qp = QB + (size_t)(b * SEQ + jq) * 1024 + h * 128 + 8 * g;
#pragma unroll
      for (int s = 0; s < 4; ++s) *(LAS bf16x8*)(Qimg + off_b((unsigned)l15, 4u * s + (unsigned)g)) = *(const bf16x8*)(qp + 32 * s); }
    size_t dsrc[2];
#pragma unroll
    for (int i = 0; i < 2; ++i) { const unsigned row = 8u * wave + 4u * i + (unsigned)(lane >> 4); const unsigned f = (off_b(row & 15u, 0u) >> 4) & 15u;
        dsrc[i] = (size_t)row * 1024 + h * 128 + (((unsigned)(lane & 15)) ^ f) * 8; }
    const unsigned ddst = 2048u * wave;
    const unsigned lds0 = (unsigned)(size_t)lds;
#define DF_ROW0(tt) ((size_t)b * TK + ((tt) == 0 ? 0 : 16 + 64 * ((tt) - 1)))
#define DF_DMAK(tt, slot) do { const bf16_t* g_ = KB + DF_ROW0(tt) * 1024; _Pragma("unroll") for (int i_ = 0; i_ < 2; ++i_) \
        glds16(g_ + dsrc[i_], (unsigned)__builtin_amdgcn_readfirstlane((int)(lds0 + DB_K + (slot) * 16384 + ddst + 1024 * i_))); } while (0)
#define DF_DMAV(tt, slot) do { const bf16_t* g_ = VB + DF_ROW0(tt) * 1024; _Pragma("unroll") for (int i_ = 0; i_ < 2; ++i_) \
        glds16(g_ + dsrc[i_], (unsigned)__builtin_amdgcn_readfirstlane((int)(lds0 + DB_V + (slot) * 16384 + ddst + 1024 * i_))); } while (0)
#define DF_WAITBAR(n) do { if ((n) >= 4) asm volatile("s_waitcnt vmcnt(4) lgkmcnt(0)" ::: "memory"); else if ((n) >= 2) asm volatile("s_waitcnt vmcnt(2) lgkmcnt(0)" ::: "memory"); \
        else asm volatile("s_waitcnt vmcnt(0) lgkmcnt(0)" ::: "memory"); __builtin_amdgcn_s_barrier(); asm volatile("" ::: "memory"); } while (0)
    const unsigned q4 = (unsigned)l15 >> 2, pp = (unsigned)l15 & 3u;
    unsigned kbase[2][2], vbase[8];
#pragma unroll
    for (int mp = 0; mp < 2; ++mp)
#pragma unroll
        for (int s = 0; s < 2; ++s) kbase[mp][s] = off_b((unsigned)l15, 8u * mp + 4u * s + (unsigned)g);
#pragma unroll
    for (int c = 0; c < 8; ++c) vbase[c] = off_b(4u * g + q4, 2u * c + (pp >> 1)) + 8u * (pp & 1u);

    float m1 = 0.f, m2 = 0.f;
    f32x4 O1[8], O2[8], OL1 = (f32x4){0.f, 0.f, 0.f, 0.f}, OL2 = (f32x4){0.f, 0.f, 0.f, 0.f};
    const short one_ = (l15 == 0) ? (short)0x3F80 : (short)0;
    const bf16x8 onesf = (bf16x8){one_, one_, one_, one_, one_, one_, one_, one_};
#pragma unroll
    for (int c = 0; c < 8; ++c) { O1[c] = (f32x4){0.f, 0.f, 0.f, 0.f}; O2[c] = (f32x4){0.f, 0.f, 0.f, 0.f}; }
    f32x4 S1[4], S2[4];
    bf16x8 pa1[2], pa2[2];
    float es1 = 1.f, es2 = 1.f; bool pending = false;
    f32x4 cn1 = (f32x4){0.f, 0.f, 0.f, 0.f}, cn2 = cn1, cf1 = cn1, cf2 = cn1;

#define DF_QK(tt, kbo_) do { LAS unsigned char* Kb_ = lds + DB_K + (kbo_); \
        const int dmin_ = ((tt) == 0) ? (jw + 1) : (jw - 64 * (tt) + 1); const bool near_ = dmin_ < 91; \
        const f32x4 ci1_ = near_ ? cn1 : cf1, ci2_ = near_ ? cn2 : cf2;        \
        _Pragma("unroll") for (int s = 0; s < 2; ++s) { const bf16x8 q1_ = *(const LAS bf16x8*)(Qimg + kbase[0][s]), q2_ = *(const LAS bf16x8*)(Qimg + kbase[1][s]); \
          bf16x8 ka1_[4], ka2_[4]; \
          _Pragma("unroll") for (int mb = 0; mb < 4; ++mb) { ka1_[mb] = *(const LAS bf16x8*)(Kb_ + kbase[0][s] + 4096 * mb); ka2_[mb] = *(const LAS bf16x8*)(Kb_ + kbase[1][s] + 4096 * mb); } \
          __builtin_amdgcn_sched_barrier(0); \
          _Pragma("unroll") for (int mb = 0; mb < 4; ++mb) { \
            S1[mb] = __builtin_amdgcn_mfma_f32_16x16x32_bf16(ka1_[mb], q1_, s == 0 ? ci1_ : S1[mb], 0, 0, 0); S2[mb] = __builtin_amdgcn_mfma_f32_16x16x32_bf16(ka2_[mb], q2_, s == 0 ? ci2_ : S2[mb], 0, 0, 0); } } \
        if (near_) { _Pragma("unroll") for (int mb = 0; mb < 4; ++mb) _Pragma("unroll") for (int i = 0; i < 4; ++i) { \
            const int kr_ = 16 * mb + 4 * g + i; const int kpos_ = ((tt) == 0) ? kr_ : 16 + 64 * ((tt) - 1) + kr_; \
            int rel_ = kpos_ - (NMETA + jq); rel_ = rel_ < -91 ? -91 : (rel_ > 63 ? 63 : rel_); const float bias_ = LUT[rel_ + 91]; S1[mb][i] += bias_; S2[mb][i] += bias_; } } \
        if ((tt) == 0) { _Pragma("unroll") for (int mb = 1; mb < 4; ++mb) { S1[mb] = (f32x4){-INFINITY, -INFINITY, -INFINITY, -INFINITY}; S2[mb] = S1[mb]; } } } while (0)
#define DF_LMAX(t1_, t2_) do { t1_ = fmaxf(fmaxf(S1[0][0], S1[0][1]), S1[0][2]); t2_ = fmaxf(fmaxf(S2[0][0], S2[0][1]), S2[0][2]); \
        t1_ = fmaxf(fmaxf(t1_, S1[0][3]), S1[1][0]); t2_ = fmaxf(fmaxf(t2_, S2[0][3]), S2[1][0]); \
        t1_ = fmaxf(fmaxf(t1_, S1[1][1]), S1[1][2]); t2_ = fmaxf(fmaxf(t2_, S2[1][1]), S2[1][2]); \
        t1_ = fmaxf(fmaxf(t1_, S1[1][3]), S1[2][0]); t2_ = fmaxf(fmaxf(t2_, S2[1][3]), S2[2][0]); \
        t1_ = fmaxf(fmaxf(t1_, S1[2][1]), S1[2][2]); t2_ = fmaxf(fmaxf(t2_, S2[2][1]), S2[2][2]); \
        t1_ = fmaxf(fmaxf(t1_, S1[2][3]), S1[3][0]); t2_ = fmaxf(fmaxf(t2_, S2[2][3]), S2[3][0]); \
        t1_ = fmaxf(fmaxf(t1_, S1[3][1]), S1[3][2]); t2_ = fmaxf(fmaxf(t2_, S2[3][1]), S2[3][2]); \
        t1_ = fmaxf(t1_, S1[3][3]); t2_ = fmaxf(t2_, S2[3][3]); } while (0)
#define DF_RESCALE(t1_, t2_, forced_) do { float r1_ = t1_, r2_ = t2_; r1_ = fmaxf(r1_, __shfl_xor(r1_, 16)); r1_ = fmaxf(r1_, __shfl_xor(r1_, 32)); r2_ = fmaxf(r2_, __shfl_xor(r2_, 16)); r2_ = fmaxf(r2_, __shfl_xor(r2_, 32)); \
        const float d1_ = (forced_) ? r1_ : fmaxf(r1_, 0.f), d2_ = (forced_) ? r2_ : fmaxf(r2_, 0.f); m1 += d1_; m2 += d2_; \
        es1 = __builtin_amdgcn_exp2f(-d1_); es2 = __builtin_amdgcn_exp2f(-d2_); \
        _Pragma("unroll") for (int mb = 0; mb < 4; ++mb) { S1[mb] = S1[mb] - d1_; S2[mb] = S2[mb] - d2_; } \
        cn1 = (f32x4){-m1, -m1, -m1, -m1}; cn2 = (f32x4){-m2, -m2, -m2, -m2}; { const float f1_ = bias_far - m1, f2_ = bias_far - m2; cf1 = (f32x4){f1_, f1_, f1_, f1_}; cf2 = (f32x4){f2_, f2_, f2_, f2_}; } } while (0)
#define DF_SCALE_O() do { _Pragma("unroll") for (int i = 0; i < 4; ++i) { const float x1_ = __shfl(es1, 4 * g + i), x2_ = __shfl(es2, 4 * g + i); OL1[i] *= x1_; OL2[i] *= x2_; \
            _Pragma("unroll") for (int c = 0; c < 8; ++c) { O1[c][i] *= x1_; O2[c][i] *= x2_; } } } while (0)
#define DF_EXP() do { _Pragma("unroll") for (int mb = 0; mb < 4; ++mb) _Pragma("unroll") for (int i = 0; i < 4; ++i) { S1[mb][i] = __builtin_amdgcn_exp2f(S1[mb][i]); S2[mb][i] = __builtin_amdgcn_exp2f(S2[mb][i]); } \
        _Pragma("unroll") for (int ks = 0; ks < 2; ++ks) { u32x4 w1_, w2_; \
            w1_.x = cvtpk_s(S1[2 * ks][0], S1[2 * ks][1]); w1_.y = cvtpk_s(S1[2 * ks][2], S1[2 * ks][3]); w1_.z = cvtpk_s(S1[2 * ks + 1][0], S1[2 * ks + 1][1]); w1_.w = cvtpk_s(S1[2 * ks + 1][2], S1[2 * ks + 1][3]); \
            w2_.x = cvtpk_s(S2[2 * ks][0], S2[2 * ks][1]); w2_.y = cvtpk_s(S2[2 * ks][2], S2[2 * ks][3]); w2_.z = cvtpk_s(S2[2 * ks + 1][0], S2[2 * ks + 1][1]); w2_.w = cvtpk_s(S2[2 * ks + 1][2], S2[2 * ks + 1][3]); \
            pa1[ks] = __builtin_bit_cast(bf16x8, w1_); pa2[ks] = __builtin_bit_cast(bf16x8, w2_); } } while (0)
#define DF_PV(vbo_, pq1_, pq2_) do { LAS unsigned char* Vb_ = lds + DB_V + (vbo_); \
        _Pragma("unroll") for (int ks = 0; ks < 2; ++ks) { OL1 = __builtin_amdgcn_mfma_f32_16x16x32_bf16(pq1_[ks], onesf, OL1, 0, 0, 0); OL2 = __builtin_amdgcn_mfma_f32_16x16x32_bf16(pq2_[ks], onesf, OL2, 0, 0, 0); } \
        _Pragma("unroll") for (int c2 = 0; c2 < 8; c2 += 2) { bf16x8 vf_[2][2]; \
            _Pragma("unroll") for (int cc = 0; cc < 2; ++cc) _Pragma("unroll") for (int ks = 0; ks < 2; ++ks) vf_[cc][ks] = tr_frag(Vb_ + vbase[c2 + cc], 8192u * ks, 8192u * ks + 4096u); \
            _Pragma("unroll") for (int cc = 0; cc < 2; ++cc) _Pragma("unroll") for (int ks = 0; ks < 2; ++ks) { \
                O1[c2 + cc] = __builtin_amdgcn_mfma_f32_16x16x32_bf16(pq1_[ks], vf_[cc][ks], O1[c2 + cc], 0, 0, 0); O2[c2 + cc] = __builtin_amdgcn_mfma_f32_16x16x32_bf16(pq2_[ks], vf_[cc][ks], O2[c2 + cc], 0, 0, 0); } } } while (0)

    DF_DMAK(0, 0); DF_DMAV(0, 0); DF_DMAK(1, 1); DF_DMAV(1, 1); DF_DMAK(2, 2);
    asm volatile("s_waitcnt vmcnt(0) lgkmcnt(0)" ::: "memory"); __builtin_amdgcn_s_barrier(); asm volatile("" ::: "memory");
    const float bias_far = LUT[0];
    cf1 = (f32x4){bias_far, bias_far, bias_far, bias_far}; cf2 = cf1;
    { DF_QK(0, 0u); float t1, t2; DF_LMAX(t1, t2); DF_RESCALE(t1, t2, true); DF_EXP(); }
    asm volatile("s_waitcnt lgkmcnt(0)" ::: "memory"); __builtin_amdgcn_s_barrier(); asm volatile("" ::: "memory");
    int sk = 1, sv = 0;
    for (int t = 0; t < ntiles; ++t) {
        if (__builtin_expect(pending, 0)) { DF_SCALE_O(); pending = false; }
        int nnew = 0;
        { const int s3 = (sk == 0) ? 2 : sk - 1;
          if (t + 3 < ntiles) { DF_DMAK(t + 3, s3); nnew += 2; }
          const int s2 = (sv == 0) ? 2 : sv - 1;
          if (t + 2 < ntiles) { DF_DMAV(t + 2, s2); nnew += 2; } }
        unsigned kbo = (unsigned)sk * 16384u, vbo = (unsigned)sv * 16384u; asm volatile("" : "+v"(kbo), "+v"(vbo));
        if (t + 1 <= cw) {
            DF_QK(t + 1, kbo);
            float t1, t2; DF_LMAX(t1, t2);
            if (__builtin_expect(__any((t1 > DIFF_THR) || (t2 > DIFF_THR)), 0)) { DF_RESCALE(t1, t2, false); pending = true; }
            DF_PV(vbo, pa1, pa2);
            DF_EXP();
        } else if (t <= cw) {
            DF_PV(vbo, pa1, pa2);
        }
        DF_WAITBAR(nnew);
        sk = (sk == 2) ? 0 : sk + 1; sv = (sv == 2) ? 0 : sv + 1;
    }
    asm volatile("s_waitcnt vmcnt(0)" ::: "memory");
#undef DF_ROW0
#undef DF_DMAK
#undef DF_DMAV
#undef DF_WAITBAR
#undef DF_QK
#undef DF_LMAX
#undef DF_RESCALE
#undef DF_SCALE_O
#undef DF_EXP
#undef DF_PV
#pragma unroll
    for (int i = 0; i < 4; ++i) {
        const float r1 = 1.f / __shfl(OL1[i], 16 * g), r2 = lam / __shfl(OL2[i], 16 * g);
        float o[8]; float ss = 0.f;
#pragma unroll
        for (int c = 0; c < 8; ++c) { o[c] = O1[c][i] * r1 - O2[c][i] * r2; ss += o[c] * o[c]; }
        ss += __shfl_xor(ss, 1); ss += __shfl_xor(ss, 2); ss += __shfl_xor(ss, 4); ss += __shfl_xor(ss, 8);
        const float rs = rsqrtf(ss * (1.f / 128.f) + EPS) * 0.8f;
        const size_t t = (size_t)b * SEQ + jw + 4 * g + i;
#pragma unroll
        for (int c = 0; c < 8; ++c) { const int d = 16 * c + l15; const float y = o[c] * rs * p.subln_w[d] * bf2f(ZB[t * 1024 + h * 128 + d]); OZB[t * 1024 + h * 128 + d] = (bf16_t)f2bf(y); }
    }
}
__device__ __forceinline__ void phase_diff(const Params& p, LAS unsigned char* lds) {
    const int lane = threadIdx.x & 63;
    float a = (lane < 64) ? p.lam_p[lane] * p.lam_p[64 + lane] : 0.f, bb = p.lam_p[128 + lane] * p.lam_p[192 + lane];
    a = wave_sum(a); bb = wave_sum(bb);
    const float lam = expf(a) - expf(bb) + 0.2f;
    for (int u = blockIdx.x; u < 512; u += gridDim.x) {
        const int v = u & 255;
        int bh = v >> 4, s = v & 15;
        if (gridDim.x == 256) { bh = (v & 7) + 8 * (v >> 7); s = (v >> 3) & 15; }
        const int qb = (u < 256) ? s : 31 - s;
        diff_unit(p, lds, bh >> 3, bh & 7, qb, lam);
    }
}

typedef float f32x16 __attribute__((ext_vector_type(16)));
__device__ __forceinline__ void scores_wg_unit(const Params& p, LAS unsigned char* lds, int c, int b, int half, int kh) {
    const bf16_t* IQ = WSP(const bf16_t, WS_IQ); const float* IW = WSP(const float, WS_IW); float* SC = WSP(float, WS_SC);
    const int tid = opaque_tid(), lane = tid & 63, wave = __builtin_amdgcn_readfirstlane(tid >> 6);
    const int j0 = (c - 1) * 64 + 32 * half + 4 * wave, m0 = b * SEQ + j0, n = 16 + 64 * c, nkb = 2 * c + 1, nkh = (nkb + 1) >> 1;
    const int kbA = kh ? nkh : 0, kbB = kh ? nkb : nkh, ntile = (kbB - kbA + 1) >> 1;
    const int r32 = lane & 31, hi = lane >> 5, tok = r32 >> 4, hh = r32 & 15;
    bf16x8 af[2][4]; float wv[2][16];
#pragma unroll
    for (int pr = 0; pr < 2; ++pr) {
#pragma unroll
        for (int s = 0; s < 4; ++s) af[pr][s] = *(const bf16x8*)(IQ + (size_t)(m0 + 2 * pr + tok) * 1024 + hh * 64 + 16 * s + 8 * hi);
#pragma unroll
        for (int r = 0; r < 16; ++r) wv[pr][r] = IW[(size_t)(m0 + 2 * pr + (r >> 3)) * 16 + (r & 3) + 8 * ((r >> 2) & 1) + 4 * hi];
    }
    float* rowbase = SC + sc_off(b, j0);
    const bf16_t* ikb = WSP(const bf16_t, WS_IK) + (size_t)b * TK * 64;
    const int pkey = tid >> 3, pch = tid & 7;
    const unsigned pdst = (unsigned)pkey * 128u + 16u * (unsigned)(pch ^ (pkey & 7));
    unsigned boff[4];
#pragma unroll
    for (int s = 0; s < 4; ++s) boff[s] = (unsigned)r32 * 128u + 16u * (unsigned)((2 * s + hi) ^ (r32 & 7));
    u32x4 kreg;
#define SCW_LOAD(t_) do { int key_ = 32 * (kbA + 2 * (t_)) + pkey; key_ = key_ < n ? key_ : n - 1; kreg = *(const u32x4*)(ikb + (size_t)key_ * 64 + pch * 8); } while (0)
#define SCW_WRITE(off_) do { *(LAS u32x4*)(lds + (off_) + pdst) = kreg; } while (0)
    __syncthreads();
    SCW_LOAD(0); SCW_WRITE(0u);
    __syncthreads();
    for (int t = 0; t < ntile; ++t) {
        if (t + 1 < ntile) SCW_LOAD(t + 1);
        unsigned bo = (unsigned)(t & 1) * 8192u; asm volatile("" : "+v"(bo));
#pragma unroll
        for (int q = 0; q < 2; ++q) {
            const int kb = kbA + 2 * t + q, key = 32 * kb + r32;
            bf16x8 bfr[4];
#pragma unroll
            for (int s = 0; s < 4; ++s) bfr[s] = *(const LAS bf16x8*)(lds + bo + boff[s] + 4096 * q);
#pragma unroll
            for (int pr = 0; pr < 2; ++pr) {
                f32x16 acc;
#pragma unroll
                for (int r = 0; r < 16; ++r) acc[r] = 0.f;
#pragma unroll
                for (int s = 0; s < 4; ++s) acc = __builtin_amdgcn_mfma_f32_32x32x16_bf16(af[pr][s], bfr[s], acc, 0, 0, 0);
                float p0 = 0.f, p1 = 0.f;
#pragma unroll
                for (int r = 0; r < 8; ++r) { p0 += wv[pr][r] * fmaxf(acc[r], 0.f); p1 += wv[pr][8 + r] * fmaxf(acc[8 + r], 0.f); }
                const auto sw = __builtin_amdgcn_permlane32_swap(__float_as_uint(p0), __float_as_uint(p1), false, false);
                const float tot = __uint_as_float(sw[0]) + __uint_as_float(sw[1]);
                if (kb < kbB && key < n) rowbase[(size_t)(2 * pr + hi) * n + key] = tot;
            }
        }
        if (t + 1 < ntile) SCW_WRITE((unsigned)((t + 1) & 1) * 8192u);
        __syncthreads();
    }
#undef SCW_LOAD
#undef SCW_WRITE
}
__device__ __forceinline__ void phase_scores(const Params& p, LAS unsigned char* lds) {
    for (int P = (int)blockIdx.x; P < 256; P += (int)gridDim.x) {
        const int cl = 1 + (P >> 3), sub = P & 7;
        scores_wg_unit(p, lds, 65 - cl, sub >> 2, (sub >> 1) & 1, sub & 1);
        scores_wg_unit(p, lds, cl, sub >> 2, (sub >> 1) & 1, sub & 1);
    }
}
__device__ __forceinline__ void phase_qlat(const Params& p, LAS unsigned char* lds) {
    const bf16_t* QA = WSP(const bf16_t, WS_QA); const bf16_t* WUK = WSP(const bf16_t, WS_WUK); bf16_t* QLAT = WSP(bf16_t, WS_QLAT);
    const int tid = opaque_tid(), lane = tid & 63, w = __builtin_amdgcn_readfirstlane(tid >> 6), l15 = lane & 15, g = lane >> 4;
    const float sc = 0.08838834764831845f * LOG2E * 16.f;
    const int G = (int)gridDim.x;
    int hcur = -1;
    const unsigned kb0 = off_b((unsigned)l15, (unsigned)g);
    for (int u0 = (int)blockIdx.x; u0 < 4096; u0 += 8 * G) {
        const int h = u0 & 7;
        if (h != hcur || (G & 7)) { hcur = h; __syncthreads();
#pragma unroll
            for (int i = 0; i < 8; ++i) { const int idx = tid + 512 * i, row = idx >> 4, ch = idx & 15;
                *(LAS u32x4*)(lds + off_b((unsigned)row, (unsigned)ch)) = *(const u32x4*)(WUK + ((size_t)row * 8 + h) * 128 + ch * 8); }
            __syncthreads(); }
        const int u = u0 + w * G;
        if (u < 4096 && (u & 7) == h) {
            const int m0 = (u >> 3) * 16;
            bf16x8 bq[4];
#pragma unroll
            for (int s = 0; s < 4; ++s) bq[s] = *(const bf16x8*)(QA + (size_t)(m0 + l15) * 1024 + h * 128 + 32 * s + 8 * g);
#pragma unroll 4
            for (int nb = 0; nb < 16; ++nb) {
                bf16x8 af[4];
#pragma unroll
                for (int s = 0; s < 4; ++s) af[s] = *(const LAS bf16x8*)(lds + 4096 * nb + (kb0 ^ (64u * s)));
                f32x4 acc = (f32x4){0.f, 0.f, 0.f, 0.f};
#pragma unroll
                for (int s = 0; s < 4; ++s) acc = __builtin_amdgcn_mfma_f32_16x16x32_bf16(af[s], bq[s], acc, 0, 0, 0);
                int wv = __builtin_amdgcn_cvt_pk_fp8_f32(acc[0] * sc, acc[1] * sc, 0, false); wv = __builtin_amdgcn_cvt_pk_fp8_f32(acc[2] * sc, acc[3] * sc, wv, true);
                *(unsigned*)((unsigned char*)QLAT + ((size_t)(m0 + l15) * 8 + h) * 256 + 16 * nb + 4 * g) = (unsigned)wv;
            }
        }
    }
}
__device__ __forceinline__ void phase_oproj(const Params& p, LAS unsigned char* lds) {
    const bf16_t* OLAT = WSP(const bf16_t, WS_OLAT); const bf16_t* WUVT = WSP(const bf16_t, WS_WUVT); const bf16_t* ZA = WSP(const bf16_t, WS_ZA); bf16_t* OZA = WSP(bf16_t, WS_OZA);
    const int tid = opaque_tid(), lane = tid & 63, w = __builtin_amdgcn_readfirstlane(tid >> 6), l15 = lane & 15, g = lane >> 4;
    const int G = (int)gridDim.x;
    int hcur = -1;
    const unsigned kb0 = off_b((unsigned)l15, (unsigned)g);
    for (int u0 = (int)blockIdx.x; u0 < 4096; u0 += 8 * G) {
        const int h = u0 & 7;
        if (h != hcur || (G & 7)) { hcur = h; __syncthreads();
#pragma unroll
            for (int i = 0; i < 8; ++i) { const int idx = tid + 512 * i, row = idx >> 5, c32 = idx & 31;
                *(LAS u32x4*)(lds + (c32 >> 4) * 32768 + off_b((unsigned)row, (unsigned)(c32 & 15))) = *(const u32x4*)(WUVT + (size_t)(h * 128 + row) * 256 + c32 * 8); }
            __syncthreads(); }
        const int u = u0 + w * G;
        if (u < 4096 && (u & 7) == h) {
            const int m0 = (u >> 3) * 16;
            bf16x8 bq[8];
#pragma unroll
            for (int s = 0; s < 8; ++s) bq[s] = *(const bf16x8*)(OLAT + ((size_t)(m0 + l15) * 8 + h) * 256 + 32 * s + 8 * g);
#pragma unroll 2
            for (int nb = 0; nb < 8; ++nb) {
                bf16x8 af[8];
#pragma unroll
                for (int s = 0; s < 8; ++s) af[s] = *(const LAS bf16x8*)(lds + (s >> 2) * 32768 + 4096 * nb + (kb0 ^ (64u * (s & 3))));
                f32x4 acc = (f32x4){0.f, 0.f, 0.f, 0.f};
#pragma unroll
                for (int s = 0; s < 8; ++s) acc = __builtin_amdgcn_mfma_f32_16x16x32_bf16(af[s], bq[s], acc, 0, 0, 0);
                const size_t o = (size_t)(m0 + l15) * 1024 + h * 128 + 16 * nb + 4 * g;
                const u32x2 z = *(const u32x2*)(ZA + o);
                u32x2 wv; wv.x = pg8::cvt_pk_bf16(acc[0] * bflo(z.x), acc[1] * bfhi(z.x)); wv.y = pg8::cvt_pk_bf16(acc[2] * bflo(z.y), acc[3] * bfhi(z.y));
                *(u32x2*)(OZA + o) = wv;
            }
        }
    }
}
typedef int v2i32_t __attribute__((ext_vector_type(2)));
constexpr int DSA_WAVE_LDS = 17408, DSA_LUT = 8 * DSA_WAVE_LDS;
__device__ __forceinline__ int lpos(int s) { return (s & ~31) | ((s & 3) << 3) | ((s & 31) >> 2); }
__device__ __forceinline__ unsigned ord_key(float f) { const unsigned u = __float_as_uint(f); return (u & 0x80000000u) ? ~u : (u | 0x80000000u); }
template <int KN>
__device__ __forceinline__ void dsa_select(const float* row, int n, int nsel, LAS int* list, int lane) {
    const __amdgpu_buffer_rsrc_t rs = __builtin_amdgcn_make_buffer_rsrc((void*)row, 0, n * 4, 0x00020000);
    unsigned key[KN];
#pragma unroll
    for (int k = 0; k < KN; ++k) key[k] = (unsigned)__builtin_amdgcn_raw_buffer_load_b32(rs, lane * 4, 256 * k, 2);
    { int idx0 = lane;
#pragma unroll
      for (int k = 0; k < KN; ++k) { const unsigned u = key[k]; const unsigned o = (u & 0x80000000u) ? ~u : (u | 0x80000000u); key[k] = (idx0 < n) ? o : 0u; idx0 += 64; asm volatile("" : "+v"(idx0)); } }
    unsigned thr = 0u;
    if (n > 256) {
        for (int bit = 31; bit >= 0; --bit) {
            const unsigned cand = thr | (1u << bit);
            int c = 0;
#pragma unroll
            for (int k = 0; k < KN; ++k) c += (key[k] >= cand) ? 1 : 0;
            int cnt = 0;
#pragma unroll
            for (int b7 = 0; b7 < 7; ++b7) cnt += __popcll(__ballot((c >> b7) & 1)) << b7;
            if (cnt >= 256) thr = cand;
            if (cnt == 256) break;
        }
    }
    int pos = 0; int idx = lane;
#pragma unroll
    for (int k = 0; k < KN; ++k) { const bool mine = key[k] > thr; const unsigned long long msk = __ballot(mine);
        const int my = __builtin_amdgcn_mbcnt_hi((unsigned)(msk >> 32), __builtin_amdgcn_mbcnt_lo((unsigned)msk, 0u));
        if (mine) list[lpos(pos + my)] = idx; pos += __popcll(msk); idx += 64; asm volatile("" : "+v"(idx)); }
    if (pos < nsel) {
        idx = lane;
#pragma unroll
        for (int k = 0; k < KN; ++k) { const bool mine = (key[k] == thr) && (idx < n); const unsigned long long msk = __ballot(mine);
            const int my = __builtin_amdgcn_mbcnt_hi((unsigned)(msk >> 32), __builtin_amdgcn_mbcnt_lo((unsigned)msk, 0u));
            if (mine && pos + my < nsel) list[lpos(pos + my)] = idx; pos += __popcll(msk); idx += 64; asm volatile("" : "+v"(idx)); }
    }
}
__device__ __forceinline__ void dsa_unit(const Params& p, LAS unsigned char* lds, int qi, int wave, int lane, int probe) {
    const float* SC = WSP(const float, WS_SC); bf16_t* OLAT = WSP(bf16_t, WS_OLAT);
    const int c = qi >> 8, b = (qi >> 6) & 1, j = (c - 1) * 64 + (qi & 63), t = b * SEQ + j, n = 16 + 64 * c, nsel = n < 256 ? n : 256, qpos = NMETA + j;
    LAS unsigned char* img = lds + wave * DSA_WAVE_LDS; LAS int* list = (LAS int*)(img + 16384); const LAS float* LUTA = (const LAS float*)(lds + DSA_LUT);
    const int l15 = lane & 15, g = lane >> 4;
    const float* row = SC + sc_off(b, j);
#pragma unroll
    for (int rs_ = (PROBE_REP == 41) ? 2 : 1; rs_ > 0; --rs_) {
    if (n <= 64 * 17) dsa_select<17>(row, n, nsel, list, lane);
    else if (n <= 64 * 33) dsa_select<33>(row, n, nsel, list, lane);
    else if (n <= 64 * 49) dsa_select<49>(row, n, nsel, list, lane);
    else dsa_select<65>(row, n, nsel, list, lane);
    }
#pragma unroll
    for (int ra_ = (PROBE_REP == 42) ? 2 : 1; ra_ > 0; --ra_) {
    const unsigned char* CKV8 = WSP(const unsigned char, WS_CKV); const unsigned char* qlp = WSP(const unsigned char, WS_QLAT) + ((size_t)t * 8 + (l15 & 7)) * 256 + 8 * g;
    const bool qreal = l15 < 8;
    unsigned rdb[2];
    rdb[0] = 256u * (unsigned)l15 + 8u * ((unsigned)g ^ (2u * (unsigned)l15));
    rdb[1] = 256u * (unsigned)(l15 + 16) + 8u * ((unsigned)g ^ (2u * ((unsigned)l15 ^ 8u)));
    const unsigned tq = (unsigned)l15 >> 1, tp = (unsigned)l15 & 1u;
    const unsigned trow = (tq < 4u) ? 4u * g + tq : 16u + 4u * g + (tq - 4u);
    const unsigned trb = 256u * trow + 8u * (tp ^ (2u * ((trow & 15u) ^ ((trow >> 4) << 3))));
    float m = -INFINITY, l = 0.f;
    f32x4 O[16];
#pragma unroll
    for (int rb = 0; rb < 16; ++rb) O[rb] = (f32x4){0.f, 0.f, 0.f, 0.f};
    const int nch = (nsel + 31) >> 5;
    const int hcol = l15 & 7;
    u32x4 gr[8];
    const unsigned gwr = 256u * (unsigned)(lane >> 4) + 16u * (unsigned)(lane & 15);
#define DSA_GATHER(chn) do { int ki_[8]; { const LAS int* lp_ = list + 32 * (chn) + 8 * (lane >> 4); \
        _Pragma("unroll") for (int v_ = 0; v_ < 2; ++v_) { const u32x4 t_ = *(const LAS u32x4*)(lp_ + 4 * v_); ki_[4 * v_] = (int)t_.x; ki_[4 * v_ + 1] = (int)t_.y; ki_[4 * v_ + 2] = (int)t_.z; ki_[4 * v_ + 3] = (int)t_.w; } } \
        _Pragma("unroll") for (int i = 0; i < 8; ++i) { const int slot = 32 * (chn) + 4 * i + (lane >> 4); const int kidx = slot < nsel ? ki_[i] : 0; \
        gr[i] = *(const u32x4*)(CKV8 + ((size_t)b * TK + kidx) * 256 + (lane & 15) * 16); } } while (0)
    DSA_GATHER(0);
    for (int ch = 0; ch < nch; ++ch) {
#pragma unroll
        for (int i = 0; i < 8; ++i) { const unsigned row = 4u * i + (unsigned)(lane >> 4); const unsigned rc = (row & 15u) ^ ((row >> 4) << 3);
            *(LAS u32x4*)(img + 256u * row + 16u * (((unsigned)lane & 15u) ^ rc)) = gr[i]; }
        long qf[8];
#pragma unroll
        for (int s = 0; s < 8; ++s) qf[s] = *(const long*)(qlp + 32 * s);
        asm volatile("" ::: "memory");
        DSA_GATHER(ch + 1);
        asm volatile("" ::: "memory");
#pragma unroll
        for (int s = 0; s < 8; ++s) qf[s] = qreal ? qf[s] : 0l;
        unsigned io = 0u; asm volatile("" : "+v"(io));
        LAS unsigned char* im = img + io;
        f32x4 S[2];
        S[0] = (f32x4){0.f, 0.f, 0.f, 0.f}; S[1] = S[0];
#pragma unroll
        for (int s4 = 0; s4 < 8; s4 += 4) {
            long af_[4][2];
#pragma unroll
            for (int s = 0; s < 4; ++s)
#pragma unroll
                for (int mb = 0; mb < 2; ++mb) af_[s][mb] = *(const LAS long*)(im + (rdb[mb] ^ (32u * (s4 + s))));
            __builtin_amdgcn_sched_barrier(0);
#pragma unroll
            for (int s = 0; s < 4; ++s)
#pragma unroll
                for (int mb = 0; mb < 2; ++mb) S[mb] = __builtin_amdgcn_mfma_f32_16x16x32_fp8_fp8(af_[s][mb], qf[s4 + s], S[mb], 0, 0, 0);
        }
        float cm = -INFINITY;
#pragma unroll
        for (int mb = 0; mb < 2; ++mb)
#pragma unroll
            for (int i = 0; i < 4; ++i) { const int slot = 32 * ch + 16 * mb + 4 * g + i; const int kidx = list[lpos(slot & 255)];
                int rel = kidx - qpos; rel = rel < -91 ? -91 : (rel > 63 ? 63 : rel);
                float v = S[mb][i] * 0.0625f + LUTA[(rel + 91) * 8 + hcol]; v = slot < nsel ? v : -INFINITY; S[mb][i] = v; cm = fmaxf(cm, v); }
        cm = fmaxf(cm, __shfl_xor(cm, 16)); cm = fmaxf(cm, __shfl_xor(cm, 32));
        const float mn = fmaxf(m, cm), alpha = __builtin_amdgcn_exp2f(m - mn); m = mn;
        float ps = 0.f;
#pragma unroll
        for (int mb = 0; mb < 2; ++mb)
#pragma unroll
            for (int i = 0; i < 4; ++i) { S[mb][i] = __builtin_amdgcn_exp2f(S[mb][i] - mn); ps += S[mb][i]; }
        l = l * alpha + ps;
        if (__any(alpha != 1.f)) {
#pragma unroll
            for (int rb = 0; rb < 16; ++rb) O[rb] = O[rb] * alpha;
        }
        int w0 = __builtin_amdgcn_cvt_pk_fp8_f32(S[0][0], S[0][1], 0, false); w0 = __builtin_amdgcn_cvt_pk_fp8_f32(S[0][2], S[0][3], w0, true);
        int w1 = __builtin_amdgcn_cvt_pk_fp8_f32(S[1][0], S[1][1], 0, false); w1 = __builtin_amdgcn_cvt_pk_fp8_f32(S[1][2], S[1][3], w1, true);
        const long pb = (long)(((unsigned long long)(unsigned)w1 << 32) | (unsigned long long)(unsigned)w0);
#pragma unroll
        for (int rb4 = 0; rb4 < 16; rb4 += 4) {
            long tf_[4];
#pragma unroll
            for (int r_ = 0; r_ < 4; ++r_) { const v2i32_t tv = __builtin_amdgcn_ds_read_tr8_b64_v2i32((LAS v2i32_t*)(im + (trb ^ (16u * (rb4 + r_))))); tf_[r_] = __builtin_bit_cast(long, tv); }
            __builtin_amdgcn_sched_barrier(0);
#pragma unroll
            for (int r_ = 0; r_ < 4; ++r_) O[rb4 + r_] = __builtin_amdgcn_mfma_f32_16x16x32_fp8_fp8(tf_[r_], pb, O[rb4 + r_], 0, 0, 0);
        }
    }
    l += __shfl_xor(l, 16); l += __shfl_xor(l, 32);
    const float il = 1.f / l;
    if (l15 < 8) {
#pragma unroll
        for (int rb = 0; rb < 16; ++rb) { u32x2 w; w.x = pg8::cvt_pk_bf16(O[rb][0] * il, O[rb][1] * il); w.y = pg8::cvt_pk_bf16(O[rb][2] * il, O[rb][3] * il);
            *(u32x2*)(OLAT + ((size_t)t * 8 + l15) * 256 + 16 * rb + 4 * g) = w; }
    }
    }
}
#undef DSA_GATHER
__device__ __forceinline__ int lds_take(LAS unsigned* ctr, int lane) {
    int u = 0; if (lane == 0) u = (int)__hip_atomic_fetch_add(ctr, 1u, __ATOMIC_RELAXED, __HIP_MEMORY_SCOPE_WORKGROUP);
    return __builtin_amdgcn_readfirstlane(u);
}
__device__ __forceinline__ int dsa_query_of(int u, int G) {
    const int k = u >> 3, r = u & 7;
    int cl, bb, grp;
    if (G == 256) { const int idx = ((int)blockIdx.x >> 1) + 128 * k; cl = 1 + (idx >> 4); grp = idx & 15; bb = (int)blockIdx.x & 1; }
    else { const int P = (int)blockIdx.x + k * G; cl = 1 + (P >> 5); bb = (P >> 4) & 1; grp = P & 15; }
    const int c = (r < 4) ? 65 - cl : cl;
    return (c << 8) | (bb << 6) | (4 * grp + (r & 3));
}
__device__ __forceinline__ int dsa_token_of(int qi) { return ((qi >> 6) & 1) * SEQ + ((qi >> 8) - 1) * 64 + (qi & 63); }
__device__ __forceinline__ void phase_dsa(const Params& p, LAS unsigned char* lds, int wave, int lane, int probe) {
    LAS float* LUTA = (LAS float*)(lds + DSA_LUT); LAS unsigned* ctr = (LAS unsigned*)(lds + DSA_LUT + 155 * 8 * 4);
    const int G = (int)gridDim.x, l15 = lane & 15, g = lane >> 4;
    __syncthreads();
    for (int i = threadIdx.x; i < 155 * 8; i += 512) LUTA[i] = p.rel_bias[t5_bucket((i >> 3) - 91) * 16 + (i & 7)] * LOG2E;
    if (threadIdx.x == 0) ctr[0] = 0u;
    const int npi = (1024 - (int)blockIdx.x + G - 1) / G;
    const int nun = npi * 8;
    __syncthreads();
    for (;;) {
        const int u = lds_take(ctr, lane); if (u >= nun) break;
        dsa_unit(p, lds, dsa_query_of(u, G), wave, lane, probe);
    }
}

#define XB_TMO      128
#define XB_XCNT(j)  (256  + 64 * (j))
#define XB_XSUB(j)  (1280 + 64 * (j))
#define XB_XGEN(j)  (2304 + 64 * (j))
#define XB_TOP      3328
#define XB_TOPGEN   3392
#define XCD_BAR_WORDS 3456
#define XB_SPIN_CAP (1u << 24)
__device__ __forceinline__ unsigned xb_ld(unsigned* p)              { return __hip_atomic_load(p, __ATOMIC_RELAXED, __HIP_MEMORY_SCOPE_AGENT); }
__device__ __forceinline__ unsigned xb_add(unsigned* p, unsigned v) { return __hip_atomic_fetch_add(p, v, __ATOMIC_RELAXED, __HIP_MEMORY_SCOPE_AGENT); }
__device__ __forceinline__ unsigned xb_xcc_id() { return (unsigned)__builtin_amdgcn_s_getreg((3 << 11) | 20) & 0xFu; }
#define XB_SPIN(cond, bar) do { unsigned _sp = 0; while (cond) { __builtin_amdgcn_s_sleep(1); \
    if ((++_sp & 255u) == 0u) { if (xb_ld(&(bar)[XB_TMO])) break; if (_sp > XB_SPIN_CAP) { atomicAdd(&(bar)[XB_TMO], 1u); break; } } } } while (0)
struct XcdBarrier { unsigned* bar; unsigned x; volatile LAS unsigned* st; };
__device__ __forceinline__ XcdBarrier xcd_barrier_post(unsigned* bar, volatile LAS unsigned* st) {
    XcdBarrier b; b.bar = bar; b.x = xb_xcc_id(); b.st = st;
    if (threadIdx.x == 0) (void)xb_add(&bar[XB_XCNT(b.x)], 1u);
    return b;
}
__device__ __forceinline__ void xcd_barrier_complete(unsigned* bar, unsigned x, unsigned& nloc, unsigned& nx) {
    const unsigned G = gridDim.x * gridDim.y * gridDim.z;
    unsigned sum, cnt, mine, sp = 0u;
    for (;;) {
        sum = 0u; cnt = 0u; mine = 0u;
#pragma unroll
        for (unsigned j = 0; j < 16; ++j) { const unsigned c = xb_ld(&bar[XB_XCNT(j)]); sum += c; cnt += (c > 0u) ? 1u : 0u; mine = (j == x) ? c : mine; }
        if (sum == G) break;
        __builtin_amdgcn_s_sleep(1);
        if ((++sp & 255u) == 0u) { if (xb_ld(&bar[XB_TMO])) break; if (sp > XB_SPIN_CAP) { atomicAdd(&bar[XB_TMO], 1u); break; } }
    }
    nloc = mine > 0u ? mine : 1u; nx = cnt > 0u ? cnt : 1u;
}
__device__ __forceinline__ void xcd_barrier(const XcdBarrier& b) {
    asm volatile("s_waitcnt vmcnt(0)" ::: "memory");
    __syncthreads();
    if (threadIdx.x == 0) {
        unsigned* bar = b.bar;
        __builtin_amdgcn_s_waitcnt(0);
        unsigned nloc = b.st[0], nx = b.st[1];
        if (nloc == 0u) { xcd_barrier_complete(bar, b.x, nloc, nx); b.st[0] = nloc; b.st[1] = nx; }
        const unsigned old = xb_add(&bar[XB_XSUB(b.x)], 1u);
        const unsigned gen = old / nloc;
        if (old + 1u == (gen + 1u) * nloc) {
            __builtin_amdgcn_fence(__ATOMIC_RELEASE, "agent");
            asm volatile("s_waitcnt vmcnt(0)" ::: "memory");
            const unsigned og = xb_add(&bar[XB_TOP], 1u);
            const unsigned tg = og / nx;
            if (og + 1u == (tg + 1u) * nx) xb_add(&bar[XB_TOPGEN], 1u);
            else XB_SPIN(xb_ld(&bar[XB_TOPGEN]) == tg, bar);
            __builtin_amdgcn_fence(__ATOMIC_ACQUIRE, "agent");
            xb_add(&bar[XB_XGEN(b.x)], 1u);
            asm volatile("s_waitcnt vmcnt(0)" ::: "memory");
        } else {
            XB_SPIN(xb_ld(&bar[XB_XGEN(b.x)]) == gen, bar);
            __builtin_amdgcn_fence(__ATOMIC_ACQUIRE, "agent");
            asm volatile("s_waitcnt vmcnt(0)" ::: "memory");
        }
    }
    __syncthreads();
}

constexpr int LDS_BYTES = 147456, MISC_OFF = 147456 - 256;
constexpr int NPHASE = 8;
#ifndef ONE_LAUNCH
#define ONE_LAUNCH 1
#endif

struct KArgs { Params p; int ph_lo, ph_hi, probe, pad; };
__global__ void __launch_bounds__(512, 2) k_fwd(KArgs a) {
    extern __shared__ __attribute__((aligned(16))) unsigned char lds_raw[];
    LAS unsigned char* lds = (LAS unsigned char*)lds_raw;
    const Params& p = a.p;
    const int tid = threadIdx.x, lane = tid & 63, wave = __builtin_amdgcn_readfirstlane(tid >> 6);
    const int gw = blockIdx.x * 8 + wave, ngw = gridDim.x * 8;
    volatile LAS unsigned* misc = (volatile LAS unsigned*)(lds + MISC_OFF);
    if (tid < 64) misc[tid] = 0u;
    __syncthreads();
    XcdBarrier bar; bar.bar = WSP(unsigned, WS_CTL) + 4096; bar.x = 0; bar.st = misc;
    if (ONE_LAUNCH) bar = xcd_barrier_post(WSP(unsigned, WS_CTL) + 4096, misc);
#define IN(k) (a.ph_lo <= 0 && 0 < a.ph_hi)
#define SEAM(k) do { xcd_barrier(bar); } while (0)
#define RUNPH(k, ...) do { if (IN(k)) { constexpr int nrep_ = (PROBE_REP == (k)) ? 2 : 1; _Pragma("unroll") for (int rep = 0; rep < nrep_; ++rep) { if (rep) xcd_barrier(bar); __VA_ARGS__ } } } while (0)
    RUNPH(0, const int lane_ = opaque_tid() & 63; phase0(p, lds, gw, ngw, wave, lane_, 0, (gridDim.x == 256) ? p.jobs[13].item0 : p.nitems););
    SEAM(0);
    RUNPH(1,
        SchedInproj S{DM, (int)gridDim.x, (int)blockIdx.x, (const char*)WSP(bf16_t, WS_U), (const char*)WSP(bf16_t, WS_WIN)};
        EpiInproj E{WSP(bf16_t, WS_QA), WSP(bf16_t, WS_ZA), WSP(bf16_t, WS_IQ), WSP(bf16_t, WS_QB), WSP(bf16_t, WS_ZB), WSP(bf16_t, WS_GA), WSP(bf16_t, WS_GB), WSP(bf16_t, WS_KB), WSP(bf16_t, WS_VB),
                    WSP(float, WS_CKVRAW), WSP(bf16_t, WS_IK), WSP(float, WS_IW), 0.125f * LOG2E, p.ikn_w, p.ikn_b};
        pg8::gemm_phase<EpiInproj, SchedInproj>(lds, S, E);
        if (gridDim.x == 256 && blockIdx.x >= 202) { const int lane_ = opaque_tid() & 63; phase0(p, lds, ((int)blockIdx.x - 202) * 8 + wave, 54 * 8, wave, lane_, p.jobs[13].item0, p.nitems); });
    SEAM(1);
    RUNPH(33, const int lane_ = opaque_tid() & 63; phase_ckvnorm(p, gw, ngw, lane_););
    RUNPH(32, phase_qlat(p, lds););
    RUNPH(30, phase_diff(p, lds););
    RUNPH(31, phase_scores(p, lds););
    SEAM(3);
    RUNPH(4, const int lane_ = opaque_tid() & 63; phase_dsa(p, lds, wave, lane_, a.probe););
    SEAM(4);
    RUNPH(8, phase_oproj(p, lds););
    SEAM(8);
    RUNPH(5,
        SchedMix S{1024, (int)gridDim.x, (int)blockIdx.x, (const char*)WSP(bf16_t, WS_OZA), (const char*)WSP(bf16_t, WS_WOA), (const char*)WSP(bf16_t, WS_OZB), (const char*)WSP(bf16_t, WS_WOB)};
        EpiMix E{WSP(const bf16_t, WS_GA), WSP(const bf16_t, WS_GB), WSP(bf16_t, WS_MIX)};
        pg8::gemm_phase<EpiMix, SchedMix>(lds, S, E););
    SEAM(5);
    if (gridDim.x == 256) {
        RUNPH(6,
            SchedOut S{DM, (int)gridDim.x, (int)blockIdx.x, (const char*)WSP(bf16_t, WS_MIX), (const char*)WSP(bf16_t, WS_WOUT)};
            EpiOutFused E{p.x, p.post_w, p.out, WSP(float, WS_SSQ), WSP(unsigned, WS_CTL) + 8192, lds};
            pg8::gemm_phase<EpiOutFused, SchedOut>(lds, S, E););
    } else {
        RUNPH(6,
            SchedOut S{DM, (int)gridDim.x, (int)blockIdx.x, (const char*)WSP(bf16_t, WS_MIX), (const char*)WSP(bf16_t, WS_WOUT)};
            EpiOut E{WSP(bf16_t, WS_OUTPRE), WSP(float, WS_SSQ)};
            pg8::gemm_phase<EpiOut, SchedOut>(lds, S, E););
        SEAM(6);
        RUNPH(7, const int lane_ = opaque_tid() & 63; phase7(p, gw, ngw, lane_););
    }
#undef RUNPH
#undef IN
#undef SEAM
}

static void add_job(Params& p, const float* src, bf16_t* dst, int K, int N, int col0, int ncols, int row0) {
    TJob& j = p.jobs[p.njobs++]; j.src = src; j.dst = dst; j.K = K; j.N = N; j.col0 = col0; j.nblk = (ncols + 31) / 32; j.row0 = row0; j.item0 = p.nitems; p.nitems += (K / 64) * j.nblk;
}
extern "C" void kernel_launch(void* const* d_in, const int* in_sizes, int n_in, void* d_out, int out_size, void* d_ws, size_t ws_size, hipStream_t stream) {
    if (n_in != 16 || ws_size < WS_END) { fprintf(stderr, "kernel_launch: unexpected arguments (n_in %d, ws %zu)\n", n_in, ws_size); return; }
    static int grid = 0;
    if (!grid) {
        int dev = 0, cus = 0, per_cu = 0;
        (void)hipGetDevice(&dev); (void)hipDeviceGetAttribute(&cus, hipDeviceAttributeMultiprocessorCount, dev);
        (void)hipFuncSetAttribute((const void*)k_fwd, hipFuncAttributeMaxDynamicSharedMemorySize, LDS_BYTES);
        (void)hipOccupancyMaxActiveBlocksPerMultiprocessor(&per_cu, (const void*)k_fwd, 512, LDS_BYTES);
        (void)hipGetLastError();
        grid = cus > 0 ? cus : 256;
        if (per_cu < 1) fprintf(stderr, "kernel_launch: occupancy query reports %d blocks per CU\n", per_cu);
    }
    KArgs a; memset(&a, 0, sizeof(a));
    Params& p = a.p;
    const float** in = (const float**)d_in;
    p.x = in[0]; p.meta = in[1]; p.rel_bias = in[2]; p.pre_w = in[3]; p.w_in = in[4]; p.kv_norm_w = in[5]; p.w_uk = in[6]; p.w_uv = in[7]; p.ikn_w = in[8]; p.ikn_b = in[9];
    p.lam_p = in[10]; p.subln_w = in[11]; p.w_o_a = in[12]; p.w_o_b = in[13]; p.w_out = in[14]; p.post_w = in[15];
    p.out = (float*)d_out; p.ws = (unsigned char*)d_ws;
    bf16_t* WIN = (bf16_t*)(p.ws + WS_WIN);
    const int NIN = 11600;
    add_job(p, p.w_in, WIN, DM, NIN, 0, 1024, 0);
    add_job(p, p.w_in, WIN, DM, NIN, 1280, 1024, 1024);
    add_job(p, p.w_in, WIN, DM, NIN, 2304, 1024, 2048);
    add_job(p, p.w_in, WIN, DM, NIN, 3408, 1024, 3072);
    add_job(p, p.w_in, WIN, DM, NIN, 6480, 1024, 4096);
    add_job(p, p.w_in, WIN, DM, NIN, 7504, 2048, 5120);
    add_job(p, p.w_in, WIN, DM, NIN, 9552, 2048, 7168);
    add_job(p, p.w_in, WIN, DM, NIN, 4432, 1024, 9216);
    add_job(p, p.w_in, WIN, DM, NIN, 5456, 1024, 10240);
    add_job(p, p.w_in, WIN, DM, NIN, 1024, 256, 11264);
    add_job(p, p.w_in, WIN, DM, NIN, 3328, 32, 11520);
    add_job(p, p.w_in, WIN, DM, NIN, 3392, 32, 11520 + 32);
    add_job(p, p.w_in, WIN, DM, NIN, 3360, 32, 11520 + 128);
    add_job(p, p.w_o_a, (bf16_t*)(p.ws + WS_WOA), 1024, DM, 0, DM, 0);
    add_job(p, p.w_o_b, (bf16_t*)(p.ws + WS_WOB), 1024, DM, 0, DM, 0);
    add_job(p, p.w_out, (bf16_t*)(p.ws + WS_WOUT), DM, DM, 0, DM, 0);
    add_job(p, p.w_uv, (bf16_t*)(p.ws + WS_WUVT), 256, 1024, 0, 1024, 0);
    (void)hipMemsetAsync((char*)d_ws + WS_CTL, 0, CTL_BYTES, stream);
#if ONE_LAUNCH
    a.ph_lo = 0; a.ph_hi = NPHASE; a.probe = PROBE_REP;
    hipLaunchKernelGGL(k_fwd, dim3(grid), dim3(512), LDS_BYTES, stream, a);
#else
    for (int ph = 0; ph < NPHASE; ++ph) { a.ph_lo = ph; a.ph_hi = ph + 1; hipLaunchKernelGGL(k_fwd, dim3(grid), dim3(512), LDS_BYTES, stream, a); }
#endif
}
```

```cpp
#include <hip/hip_runtime.h>
#include <cstdio>
#include <cstdint>
#include <cstring>

#ifndef PROBE_REP
#define PROBE_REP (-1)
#endif
#define LAS __attribute__((address_space(3)))
#define GAS __attribute__((address_space(1)))
typedef unsigned short bf16_t;
typedef short bf16x8 __attribute__((ext_vector_type(8)));
typedef float f32x4 __attribute__((ext_vector_type(4)));
typedef unsigned u32x4 __attribute__((ext_vector_type(4)));
typedef unsigned u32x2 __attribute__((ext_vector_type(2)));

constexpr int DM = 2048, NB = 2, SEQ = 4096, NMETA = 16, TK = SEQ + NMETA  , MTOK = NB * SEQ  , MKEY = NB * TK  ;
constexpr int UROWS = 8448;
constexpr int NPAD = 11776;
constexpr float EPS = 1e-6f;
constexpr float LOG2E = 1.4426950408889634f;
constexpr size_t SC_PER_B = 8585216;

constexpr size_t MiB = 1u << 20;
constexpr size_t WS_CTL = 0, CTL_BYTES = 1 * MiB;
constexpr size_t WS_U = 1 * MiB;
constexpr size_t WS_WIN = 34 * MiB;
constexpr size_t WS_SC = 1 * MiB;
constexpr size_t WS_MIX = 1 * MiB;
constexpr size_t WS_WOA = 80 * MiB, WS_WOB = 84 * MiB, WS_WOUT = 88 * MiB, WS_WUK = 96 * MiB, WS_WUVT = 96 * MiB + 512 * 1024;
constexpr size_t WS_QA = 97 * MiB, WS_IQ = 113 * MiB, WS_QB = 129 * MiB, WS_ZA = 145 * MiB, WS_ZB = 161 * MiB, WS_GA = 177 * MiB, WS_GB = 209 * MiB;
constexpr size_t WS_OLAT = 241 * MiB;
constexpr size_t WS_OZA = 129 * MiB;
constexpr size_t WS_KB = 241 * MiB, WS_VB = 258 * MiB, WS_CKVRAW = 275 * MiB, WS_IKRAW = 284 * MiB, WS_IW = 287 * MiB, WS_CKV = 288 * MiB, WS_IK = 293 * MiB;
constexpr size_t WS_QLAT = 295 * MiB;
constexpr size_t WS_OUTPRE = 295 * MiB;
constexpr size_t WS_OZB = 327 * MiB, WS_SSQ = 343 * MiB, WS_END = 344 * MiB;

__device__ __forceinline__ int opaque_tid() { int t = threadIdx.x; asm volatile("" : "+v"(t)); return t; }
__device__ __forceinline__ float bf2f(unsigned short u) { return __uint_as_float(((unsigned)u) << 16); }
__device__ __forceinline__ unsigned f2bf(float f) { unsigned u = __float_as_uint(f); return (u + 0x7fffu + ((u >> 16) & 1u)) >> 16; }
__device__ __forceinline__ unsigned pk2(float lo, float hi) { return f2bf(lo) | (f2bf(hi) << 16); }
__device__ __forceinline__ float bflo(unsigned w) { return __uint_as_float(w << 16); }
__device__ __forceinline__ float bfhi(unsigned w) { return __uint_as_float(w & 0xffff0000u); }
__device__ __forceinline__ float wave_sum(float v) {
#pragma unroll
    for (int o = 1; o < 64; o <<= 1) v += __shfl_xor(v, o);
    return v;
}
__device__ __forceinline__ float silu_f(float x) { return x * __builtin_amdgcn_rcpf(1.f + __expf(-x)); }
__device__ __forceinline__ int t5_bucket(int rel) {
    const int n = rel < 0 ? -rel : rel; int f;
    if (n < 8) f = n; else if (n < 12) f = 8; else if (n < 16) f = 9; else if (n < 23) f = 10; else if (n < 32) f = 11; else if (n < 46) f = 12; else if (n < 64) f = 13; else if (n < 91) f = 14; else f = 15;
    return (rel > 0 ? 16 : 0) + f;
}
__device__ __forceinline__ size_t sc_off(int b, int j) {
    const int c = 1 + (j >> 6);
    return (size_t)b * SC_PER_B + (size_t)1024 * (c - 1) + (size_t)2048 * (c - 1) * c + (size_t)(j & 63) * (16 + 64 * c);
}

namespace pg8 {
constexpr int BM = 256, BK = 64, HALF = 128, HTB = HALF * BK * 2, STAGE_BYTES = 8 * HTB, NXCD = 8, WGM = 8;
__host__ __device__ __forceinline__ int lds_byte(int r, int c) { const int st = (r >> 4) * 2 + (c >> 5), rr = r & 15, cc = c & 31, ob = rr * 64 + cc * 2; return st * 1024 + (ob ^ (((ob >> 9) & 1) << 5)); }
__host__ __device__ __forceinline__ void stage_rc(int b, int& R, int& C) { const int st = b / 1024, sb = b % 1024, swz = sb ^ (((sb >> 9) & 1) << 5); R = (st >> 1) * 16 + swz / 64; C = (st & 1) * 32 + (swz % 64) / 2; }
__host__ __device__ __forceinline__ int perm32(int rho) { const int n = rho >> 4, i = rho & 15; return 8 * (i >> 2) + 4 * n + (i & 3); }

struct Unit { int pm, pn, sub; };
__device__ __forceinline__ unsigned cvt_pk_bf16(float lo, float hi) { unsigned r; asm volatile("v_cvt_pk_bf16_f32 %0, %1, %2" : "=v"(r) : "v"(lo), "v"(hi)); return r; }

__device__ __forceinline__ void tile_of(int L, int nM, int nN, int& pm, int& pn) {
    const int nwg = nM * nN; int wgid = L; { const int q = nwg / NXCD, r = nwg % NXCD, xcd = wgid % NXCD, off = wgid / NXCD; wgid = (xcd < r ? xcd * (q + 1) : r * (q + 1) + (xcd - r) * q) + off; }
    const int nig = WGM * nN, gid = wgid / nig, fm = gid * WGM, gsz = (nM - fm) < WGM ? (nM - fm) : WGM;
    pm = fm + ((wgid % nig) % gsz); pn = (wgid % nig) / gsz;
}

template <class Epi, class Sched, bool ALIGN_EPI = true, bool SP2 = true>
__device__ __forceinline__ void gemm_phase(LAS unsigned char* lds, const Sched& S, const Epi& E) {
    const int tid = opaque_tid(), wid = __builtin_amdgcn_readfirstlane(tid >> 6), lane = tid & 63, wr = wid >> 2, wc = wid & 3, fr = lane & 15, fq = lane >> 4;
    const int K = S.K, nt = K / BK;
    unsigned voffA[2], voffB[2];
#pragma unroll
    for (int i = 0; i < 2; ++i) { int R, C; stage_rc(tid * 16 + i * 8192, R, C); const int Rb = Epi::PERM ? ((R & ~31) + perm32(R & 31)) : R;
        voffA[i] = (unsigned)(R * K + C) * 2u; voffB[i] = (unsigned)(Rb * K + C) * 2u; }
    const size_t kstep = (size_t)(BK * 2);
    const size_t hstep = (size_t)HALF * K * 2;
    const unsigned ldsw = (unsigned)wid * 1024u;
    const int aoff = lds_byte(wr * 64 + fr, fq * 8), boff = lds_byte(wc * 32 + fr, fq * 8);
#define PG8_SA(b, h) (((b) * 2 + (h)) * HTB)
#define PG8_SB(b, h) ((4 + (b) * 2 + (h)) * HTB)
#define PG8_STAGE(bufoff, gbase, voff) do { _Pragma("unroll") for (int _i = 0; _i < 2; ++_i) \
        __builtin_amdgcn_global_load_lds((const unsigned*)((const char*)(gbase) + (voff)[_i]), (LAS unsigned*)(lds + (bufoff) + ldsw + _i * 8192), 16, 0, 0); } while (0)
#define PG8_LDA(dst, b, h) do { _Pragma("unroll") for (int m = 0; m < 4; ++m) _Pragma("unroll") for (int k = 0; k < 2; ++k) dst[m][k] = *(const LAS bf16x8*)(lds + PG8_SA(b, h) + aoff + m * 2048 + k * 1024); } while (0)
#define PG8_LDB(dst, b, h) do { _Pragma("unroll") for (int n = 0; n < 2; ++n) _Pragma("unroll") for (int k = 0; k < 2; ++k) dst[n][k] = *(const LAS bf16x8*)(lds + PG8_SB(b, h) + boff + n * 2048 + k * 1024); } while (0)
#define PG8_MMA(ai, bj, At, Bt) do { __builtin_amdgcn_s_setprio(1); _Pragma("unroll") for (int m = 0; m < 4; ++m) _Pragma("unroll") for (int n = 0; n < 2; ++n) _Pragma("unroll") for (int k = 0; k < 2; ++k) \
        acc[ai][bj][m][n] = __builtin_amdgcn_mfma_f32_16x16x32_bf16(Bt[n][k], At[m][k], acc[ai][bj][m][n], 0, 0, 0); __builtin_amdgcn_s_setprio(0); } while (0)
#define PG8_WAIT_V(n) asm volatile("s_waitcnt vmcnt(" #n ")" ::: "memory")
#define PG8_WAIT_L(n) asm volatile("s_waitcnt lgkmcnt(" #n ")" ::: "memory")
#define PG8_BAR __builtin_amdgcn_s_barrier()
#define PG8_SCHED __builtin_amdgcn_sched_barrier(0)
    Unit cur, nxt; int ui = 0;
    if (!S.next(0, cur)) return;
    f32x4 acc[2][2][4][2];
#pragma unroll
    for (int a = 0; a < 2; ++a)
#pragma unroll
        for (int b = 0; b < 2; ++b)
#pragma unroll
            for (int m = 0; m < 4; ++m)
#pragma unroll
                for (int n = 0; n < 2; ++n) acc[a][b][m][n] = (f32x4){0.f, 0.f, 0.f, 0.f};
    bf16x8 At[4][2], B0[2][2], B1[2][2];
    const char* cA = S.a_ptr(cur); const char* cB = S.b_ptr(cur);
    if constexpr (SP2) {
        PG8_STAGE(PG8_SB(0, 0), cB, voffB); PG8_STAGE(PG8_SB(0, 1), cB + hstep, voffB); PG8_STAGE(PG8_SA(0, 0), cA, voffA); PG8_STAGE(PG8_SA(0, 1), cA + hstep, voffA);
        if (wr == 1) PG8_BAR;
        PG8_WAIT_V(2); PG8_BAR;
        PG8_STAGE(PG8_SB(1, 0), cB + kstep, voffB); PG8_STAGE(PG8_SA(1, 0), cA + kstep, voffA); PG8_STAGE(PG8_SB(1, 1), cB + hstep + kstep, voffB);
        PG8_WAIT_V(6); PG8_BAR;
    } else {
        PG8_STAGE(PG8_SB(0, 0), cB, voffB); PG8_STAGE(PG8_SA(0, 0), cA, voffA); PG8_STAGE(PG8_SB(0, 1), cB + hstep, voffB); PG8_STAGE(PG8_SA(0, 1), cA + hstep, voffA);
        if (wr == 1) PG8_BAR;
        PG8_WAIT_V(4); PG8_BAR;
        PG8_STAGE(PG8_SB(1, 0), cB + kstep, voffB); PG8_STAGE(PG8_SA(1, 0), cA + kstep, voffA); PG8_STAGE(PG8_SB(1, 1), cB + hstep + kstep, voffB);
        PG8_WAIT_V(6); PG8_BAR;
    }
    for (;;) {
        const bool has_next = S.next(ui + 1, nxt);
        const char* nA = has_next ? S.a_ptr(nxt) : cA; const char* nB = has_next ? S.b_ptr(nxt) : cB;
        for (int t = 0; t < nt; t += 2) {
            const bool last = (t == nt - 2);
            const char* a1 = cA + (size_t)(t + 1) * kstep;
            const char* a2 = last ? nA : cA + (size_t)(t + 2) * kstep; const char* b2 = last ? nB : cB + (size_t)(t + 2) * kstep;
            const char* a3 = a2 + kstep; const char* b3 = b2 + kstep;
            if constexpr (SP2) {
            PG8_LDB(B0, 0, 0); PG8_LDB(B1, 0, 1); PG8_SCHED; PG8_LDA(At, 0, 0); PG8_STAGE(PG8_SA(1, 1), a1 + hstep, voffA);
            PG8_WAIT_V(8); PG8_WAIT_L(0); PG8_BAR; PG8_MMA(0, 0, At, B0); PG8_MMA(0, 1, At, B1); PG8_BAR; PG8_SCHED;
            PG8_LDA(At, 0, 1); PG8_STAGE(PG8_SB(0, 0), b2, voffB); PG8_STAGE(PG8_SB(0, 1), b2 + hstep, voffB); PG8_STAGE(PG8_SA(0, 0), a2, voffA);
            PG8_WAIT_V(8); PG8_WAIT_L(0); PG8_BAR; PG8_MMA(1, 0, At, B0); PG8_MMA(1, 1, At, B1); PG8_BAR; PG8_SCHED;
            PG8_LDB(B0, 1, 0); PG8_LDB(B1, 1, 1); PG8_SCHED; PG8_LDA(At, 1, 0); PG8_STAGE(PG8_SA(0, 1), a2 + hstep, voffA);
            PG8_WAIT_V(8); PG8_WAIT_L(0); PG8_BAR; PG8_MMA(0, 0, At, B0); PG8_MMA(0, 1, At, B1); PG8_BAR; PG8_SCHED;
            PG8_LDA(At, 1, 1); PG8_STAGE(PG8_SB(1, 0), b3, voffB); PG8_STAGE(PG8_SB(1, 1), b3 + hstep, voffB); PG8_STAGE(PG8_SA(1, 0), a3, voffA);
            PG8_WAIT_V(8); PG8_WAIT_L(0); PG8_BAR; PG8_MMA(1, 0, At, B0); PG8_MMA(1, 1, At, B1); PG8_BAR; PG8_SCHED;
            } else {
            PG8_LDB(B0, 0, 0); PG8_SCHED; PG8_LDA(At, 0, 0); PG8_STAGE(PG8_SA(1, 1), a1 + hstep, voffA);
            PG8_WAIT_L(8); PG8_BAR; PG8_WAIT_L(0); PG8_MMA(0, 0, At, B0); PG8_BAR; PG8_SCHED;
            PG8_LDB(B1, 0, 1); PG8_STAGE(PG8_SB(0, 0), b2, voffB);
            PG8_BAR; PG8_WAIT_L(0); PG8_MMA(0, 1, At, B1); PG8_BAR;
            PG8_LDA(At, 0, 1); PG8_STAGE(PG8_SA(0, 0), a2, voffA);
            PG8_BAR; PG8_WAIT_L(0); PG8_MMA(1, 0, At, B0); PG8_BAR; PG8_SCHED;
            PG8_STAGE(PG8_SB(0, 1), b2 + hstep, voffB);
            PG8_WAIT_V(6); PG8_BAR; PG8_MMA(1, 1, At, B1); PG8_BAR;
            PG8_LDB(B0, 1, 0); PG8_SCHED; PG8_LDA(At, 1, 0); PG8_STAGE(PG8_SA(0, 1), a2 + hstep, voffA);
            PG8_WAIT_L(8); PG8_BAR; PG8_WAIT_L(0); PG8_MMA(0, 0, At, B0); PG8_BAR; PG8_SCHED;
            PG8_LDB(B1, 1, 1); PG8_STAGE(PG8_SB(1, 0), b3, voffB);
            PG8_BAR; PG8_WAIT_L(0); PG8_MMA(0, 1, At, B1); PG8_BAR;
            PG8_LDA(At, 1, 1); PG8_STAGE(PG8_SA(1, 0), a3, voffA);
            PG8_BAR; PG8_WAIT_L(0); PG8_MMA(1, 0, At, B0); PG8_BAR; PG8_SCHED;
            PG8_STAGE(PG8_SB(1, 1), b3 + hstep, voffB);
            PG8_WAIT_V(6); PG8_BAR; PG8_MMA(1, 1, At, B1); PG8_BAR;
            }
        }
        if constexpr (ALIGN_EPI) { if (wr == 0) PG8_BAR; }
        E(acc, cur, wr, wc, fr, fq);
        if (!has_next) break;
        if (!E.keep_acc(cur)) {
#pragma unroll
        for (int a = 0; a < 2; ++a)
#pragma unroll
            for (int b = 0; b < 2; ++b)
#pragma unroll
                for (int m = 0; m < 4; ++m)
#pragma unroll
                    for (int n = 0; n < 2; ++n) acc[a][b][m][n] = (f32x4){0.f, 0.f, 0.f, 0.f};
        }
        cur = nxt; cA = nA; cB = nB; ++ui;
        if constexpr (ALIGN_EPI) { if (wr == 1) PG8_BAR; }
    }
    PG8_WAIT_V(0);
    if constexpr (!ALIGN_EPI) { if (wr == 0) PG8_BAR; }
    PG8_BAR;
#undef PG8_SA
#undef PG8_SB
#undef PG8_STAGE
#undef PG8_LDA
#undef PG8_LDB
#undef PG8_MMA
#undef PG8_WAIT_V
#undef PG8_WAIT_L
#undef PG8_BAR
#undef PG8_SCHED
}
}

struct SchedInproj {
    int K, G, c; const char* A; const char* B;
    __device__ __forceinline__ bool next(int i, pg8::Unit& u) const {
        const int L = i * G + c; u.sub = 0;
        if (L < 1472) { pg8::tile_of(L, 32, 46, u.pm, u.pn); return true; }
        if (L < 1482) { u.pm = 32; u.pn = 36 + (L - 1472); return true; }
        return false;
    }
    __device__ __forceinline__ const char* a_ptr(const pg8::Unit& u) const { return A + (size_t)u.pm * 256 * K * 2; }
    __device__ __forceinline__ const char* b_ptr(const pg8::Unit& u) const { return B + (size_t)u.pn * 256 * K * 2; }
};
struct EpiInproj {
    static constexpr bool PERM = true;
    bf16_t *QA, *ZA, *IQ, *QB, *ZB, *GA, *GB, *KB, *VB; float *CKVRAW; bf16_t* IKN; float* IW; float qb_scale; const float *ikn_w, *ikn_b;
    __device__ __forceinline__ bool keep_acc(const pg8::Unit&) const { return false; }
    __device__ __forceinline__ void operator()(f32x4 (&acc)[2][2][4][2], const pg8::Unit& u, int wr, int wc, int fr, int fq) const {
        const int pn = u.pn;
        if (pn < 44) {
            bf16_t* base; int ldc = 1024, ct, act = 0; bool kside = false;
            if (pn < 4) { base = QA; ct = pn; } else if (pn < 8) { base = ZA; ct = pn - 4; act = 1; } else if (pn < 12) { base = IQ; ct = pn - 8; }
            else if (pn < 16) { base = QB; ct = pn - 12; act = 2; } else if (pn < 20) { base = ZB; ct = pn - 16; act = 1; }
            else if (pn < 28) { base = GA; ct = pn - 20; ldc = 2048; } else if (pn < 36) { base = GB; ct = pn - 28; ldc = 2048; }
            else if (pn < 40) { base = KB; ct = pn - 36; kside = true; } else { base = VB; ct = pn - 40; kside = true; }
            const float sc = (act == 2) ? qb_scale : 1.f;
#pragma unroll
            for (int ai = 0; ai < 2; ++ai)
#pragma unroll
                for (int m = 0; m < 4; ++m) {
                    const int r = u.pm * 256 + ai * 128 + wr * 64 + m * 16 + fr;
                    long drow = r, drow2 = -1; bool ok = true;
                    if (kside) { if (r < MTOK) drow = (long)(r >> 12) * TK + NMETA + (r & 4095); else { const int i = r - MTOK; ok = i < NMETA; drow = i; drow2 = TK + i; } }
#pragma unroll
                    for (int bj = 0; bj < 2; ++bj) {
                        f32x4 v0 = acc[ai][bj][m][0], v1 = acc[ai][bj][m][1];
                        if (act == 1) {
#pragma unroll
                            for (int e = 0; e < 4; ++e) { v0[e] = silu_f(v0[e]); v1[e] = silu_f(v1[e]); }
                        }
                        v0 = v0 * sc; v1 = v1 * sc;
                        u32x4 w; w.x = pg8::cvt_pk_bf16(v0[0], v0[1]); w.y = pg8::cvt_pk_bf16(v0[2], v0[3]); w.z = pg8::cvt_pk_bf16(v1[0], v1[1]); w.w = pg8::cvt_pk_bf16(v1[2], v1[3]);
                        const int col = ct * 256 + bj * 128 + wc * 32 + 8 * fq;
                        if (ok) { *(u32x4*)(base + (size_t)drow * ldc + col) = w; if (drow2 >= 0) *(u32x4*)(base + (size_t)drow2 * ldc + col) = w; }
                    }
                }
        } else {
#pragma unroll
            for (int ai = 0; ai < 2; ++ai)
#pragma unroll
                for (int m = 0; m < 4; ++m) {
                    const int r = u.pm * 256 + ai * 128 + wr * 64 + m * 16 + fr;
                    long drow, drow2 = -1; bool ok = true;
                    if (r < MTOK) drow = (long)(r >> 12) * TK + NMETA + (r & 4095); else { const int i = r - MTOK; ok = i < NMETA; drow = i; drow2 = TK + i; }
                    if (pn == 44) {
#pragma unroll
                        for (int bj = 0; bj < 2; ++bj) {
                            const f32x4 v0 = acc[ai][bj][m][0], v1 = acc[ai][bj][m][1];
                            const int col = bj * 128 + wc * 32 + 8 * fq;
                            if (ok) { float* p = CKVRAW + (size_t)drow * 256 + col; *(f32x4*)p = v0; *(f32x4*)(p + 4) = v1;
                                      if (drow2 >= 0) { float* p2 = CKVRAW + (size_t)drow2 * 256 + col; *(f32x4*)p2 = v0; *(f32x4*)(p2 + 4) = v1; } }
                        }
                    } else if (wc == 0) {
                        const f32x4 a0 = acc[ai][0][m][0], a1 = acc[ai][0][m][1], b0 = acc[ai][1][m][0], b1 = acc[ai][1][m][1];
                        float s = ((a0[0] + a0[1]) + (a0[2] + a0[3])) + ((a1[0] + a1[1]) + (a1[2] + a1[3])) + ((b0[0] + b0[1]) + (b0[2] + b0[3])) + ((b1[0] + b1[1]) + (b1[2] + b1[3]));
                        s += __shfl_xor(s, 16); s += __shfl_xor(s, 32);
                        const float mu = s * (1.f / 64.f);
                        const f32x4 da0 = a0 - mu, da1 = a1 - mu, db0 = b0 - mu, db1 = b1 - mu;
                        float q = ((da0[0] * da0[0] + da0[1] * da0[1]) + (da0[2] * da0[2] + da0[3] * da0[3])) + ((da1[0] * da1[0] + da1[1] * da1[1]) + (da1[2] * da1[2] + da1[3] * da1[3]))
                                + ((db0[0] * db0[0] + db0[1] * db0[1]) + (db0[2] * db0[2] + db0[3] * db0[3])) + ((db1[0] * db1[0] + db1[1] * db1[1]) + (db1[2] * db1[2] + db1[3] * db1[3]));
                        q += __shfl_xor(q, 16); q += __shfl_xor(q, 32);
                        const float rs = rsqrtf(q * (1.f / 64.f) + EPS);
                        const f32x4 wa0 = *(const f32x4*)(ikn_w + 8 * fq), wa1 = *(const f32x4*)(ikn_w + 8 * fq + 4), wb0 = *(const f32x4*)(ikn_w + 32 + 8 * fq), wb1 = *(const f32x4*)(ikn_w + 36 + 8 * fq);
                        const f32x4 ba0 = *(const f32x4*)(ikn_b + 8 * fq), ba1 = *(const f32x4*)(ikn_b + 8 * fq + 4), bb0 = *(const f32x4*)(ikn_b + 32 + 8 * fq), bb1 = *(const f32x4*)(ikn_b + 36 + 8 * fq);
                        const f32x4 ya0 = da0 * rs * wa0 + ba0, ya1 = da1 * rs * wa1 + ba1, yb0 = db0 * rs * wb0 + bb0, yb1 = db1 * rs * wb1 + bb1;
                        u32x4 pa, pb;
                        pa.x = pg8::cvt_pk_bf16(ya0[0], ya0[1]); pa.y = pg8::cvt_pk_bf16(ya0[2], ya0[3]); pa.z = pg8::cvt_pk_bf16(ya1[0], ya1[1]); pa.w = pg8::cvt_pk_bf16(ya1[2], ya1[3]);
                        pb.x = pg8::cvt_pk_bf16(yb0[0], yb0[1]); pb.y = pg8::cvt_pk_bf16(yb0[2], yb0[3]); pb.z = pg8::cvt_pk_bf16(yb1[0], yb1[1]); pb.w = pg8::cvt_pk_bf16(yb1[2], yb1[3]);
                        if (ok) { *(u32x4*)(IKN + (size_t)drow * 64 + 8 * fq) = pa; *(u32x4*)(IKN + (size_t)drow * 64 + 32 + 8 * fq) = pb;
                                  if (drow2 >= 0) { *(u32x4*)(IKN + (size_t)drow2 * 64 + 8 * fq) = pa; *(u32x4*)(IKN + (size_t)drow2 * 64 + 32 + 8 * fq) = pb; } }
                    } else if (wc == 1) {
                        const f32x4 v0 = acc[ai][0][m][0], v1 = acc[ai][0][m][1];
                        if (fq < 2 && r < MTOK) { float* p = IW + (size_t)r * 16 + 8 * fq; *(f32x4*)p = v0 * 0.03125f; *(f32x4*)(p + 4) = v1 * 0.03125f; }
                    }
                }
        }
    }
};
struct SchedMix {
    int K, G, c; const char *A0, *B0, *A1, *B1;
    __device__ __forceinline__ bool next(int i, pg8::Unit& u) const {
        const int L = (i >> 1) * G + c; if (L >= 256) return false;
        pg8::tile_of(L, 32, 8, u.pm, u.pn); u.sub = i & 1; return true;
    }
    __device__ __forceinline__ const char* a_ptr(const pg8::Unit& u) const { return (u.sub ? A1 : A0) + (size_t)u.pm * 256 * K * 2; }
    __device__ __forceinline__ const char* b_ptr(const pg8::Unit& u) const { return (u.sub ? B1 : B0) + (size_t)u.pn * 256 * K * 2; }
};
struct EpiMix {
    static constexpr bool PERM = true;
    const bf16_t *GA, *GB; bf16_t* MIX;
    __device__ __forceinline__ bool keep_acc(const pg8::Unit& u) const { return u.sub == 0; }
    static __device__ __forceinline__ float sg_e(float a) { return __expf(-fminf(fmaxf(a, -30.f), 30.f)); }
    __device__ __forceinline__ void operator()(f32x4 (&acc)[2][2][4][2], const pg8::Unit& u, int wr, int wc, int fr, int fq) const {
        const size_t base = (size_t)(u.pm * 256 + wr * 64 + fr) * DM + u.pn * 256 + wc * 32 + 8 * fq;
        if (u.sub == 0) {
#pragma unroll
            for (int ai = 0; ai < 2; ++ai) {
                u32x4 ga[4][2], gb[4][2];
#pragma unroll
                for (int m = 0; m < 4; ++m)
#pragma unroll
                    for (int bj = 0; bj < 2; ++bj) { const size_t o = base + (size_t)(ai * 128 + m * 16) * DM + bj * 128; ga[m][bj] = *(const u32x4*)(GA + o); gb[m][bj] = *(const u32x4*)(GB + o); }
#pragma unroll
                for (int m = 0; m < 4; ++m)
#pragma unroll
                    for (int bj = 0; bj < 2; ++bj)
#pragma unroll
                        for (int e = 0; e < 4; ++e) {
                            const unsigned wa = ga[m][bj][e], wb = gb[m][bj][e];
                            const float f0 = (1.f + sg_e(bflo(wb))) * __builtin_amdgcn_rcpf(1.f + sg_e(bflo(wa))), f1 = (1.f + sg_e(bfhi(wb))) * __builtin_amdgcn_rcpf(1.f + sg_e(bfhi(wa)));
                            const int n = e >> 1, j = (e & 1) * 2;
                            acc[ai][bj][m][n][j] *= f0; acc[ai][bj][m][n][j + 1] *= f1;
                        }
            }
        } else {
            u32x4 gb[2][4][2];
#pragma unroll
            for (int m = 0; m < 4; ++m)
#pragma unroll
                for (int bj = 0; bj < 2; ++bj) gb[0][m][bj] = *(const u32x4*)(GB + base + (size_t)(m * 16) * DM + bj * 128);
#pragma unroll
            for (int ai = 0; ai < 2; ++ai) {
                if (ai == 0) {
#pragma unroll
                    for (int m = 0; m < 4; ++m)
#pragma unroll
                        for (int bj = 0; bj < 2; ++bj) gb[1][m][bj] = *(const u32x4*)(GB + base + (size_t)(128 + m * 16) * DM + bj * 128);
                }
#pragma unroll
                for (int m = 0; m < 4; ++m)
#pragma unroll
                    for (int bj = 0; bj < 2; ++bj) {
                        float v[8];
#pragma unroll
                        for (int e = 0; e < 4; ++e) {
                            const unsigned wb = gb[ai][m][bj][e]; const int n = e >> 1, j = (e & 1) * 2;
                            v[2 * e] = acc[ai][bj][m][n][j] * __builtin_amdgcn_rcpf(1.f + sg_e(bflo(wb))); v[2 * e + 1] = acc[ai][bj][m][n][j + 1] * __builtin_amdgcn_rcpf(1.f + sg_e(bfhi(wb)));
                        }
                        u32x4 w; w.x = pg8::cvt_pk_bf16(v[0], v[1]); w.y = pg8::cvt_pk_bf16(v[2], v[3]); w.z = pg8::cvt_pk_bf16(v[4], v[5]); w.w = pg8::cvt_pk_bf16(v[6], v[7]);
                        *(u32x4*)(MIX + base + (size_t)(ai * 128 + m * 16) * DM + bj * 128) = w;
                    }
            }
        }
    }
};
struct SchedOut {
    int K, G, c; const char *A, *B;
    __device__ __forceinline__ bool next(int i, pg8::Unit& u) const { const int L = i * G + c; if (L >= 256) return false; pg8::tile_of(L, 32, 8, u.pm, u.pn); u.sub = 0; return true; }
    __device__ __forceinline__ const char* a_ptr(const pg8::Unit& u) const { return A + (size_t)u.pm * 256 * K * 2; }
    __device__ __forceinline__ const char* b_ptr(const pg8::Unit& u) const { return B + (size_t)u.pn * 256 * K * 2; }
};
struct EpiOut {
    static constexpr bool PERM = true;
    bf16_t* OUTPRE; float* SSQ;
    __device__ __forceinline__ bool keep_acc(const pg8::Unit&) const { return false; }
    __device__ __forceinline__ void operator()(f32x4 (&acc)[2][2][4][2], const pg8::Unit& u, int wr, int wc, int fr, int fq) const {
#pragma unroll
        for (int ai = 0; ai < 2; ++ai)
#pragma unroll
            for (int m = 0; m < 4; ++m) {
                const int r = u.pm * 256 + ai * 128 + wr * 64 + m * 16 + fr; float ss = 0.f;
#pragma unroll
                for (int bj = 0; bj < 2; ++bj) {
                    const f32x4 v0 = acc[ai][bj][m][0], v1 = acc[ai][bj][m][1];
                    ss += (v0[0] * v0[0] + v0[1] * v0[1]) + (v0[2] * v0[2] + v0[3] * v0[3]) + (v1[0] * v1[0] + v1[1] * v1[1]) + (v1[2] * v1[2] + v1[3] * v1[3]);
                    u32x4 w; w.x = pg8::cvt_pk_bf16(v0[0], v0[1]); w.y = pg8::cvt_pk_bf16(v0[2], v0[3]); w.z = pg8::cvt_pk_bf16(v1[0], v1[1]); w.w = pg8::cvt_pk_bf16(v1[2], v1[3]);
                    *(u32x4*)(OUTPRE + (size_t)r * DM + u.pn * 256 + bj * 128 + wc * 32 + 8 * fq) = w;
                }
                ss += __shfl_xor(ss, 16); ss += __shfl_xor(ss, 32);
                if (fq == 0) SSQ[(size_t)r * 32 + u.pn * 4 + wc] = ss;
            }
    }
};

struct EpiOutFused {
    static constexpr bool PERM = false;
    const float* x; const float* post_w; float* out; float* SSQ; unsigned* cnt; LAS unsigned char* lds;
    __device__ __forceinline__ bool keep_acc(const pg8::Unit&) const { return false; }
    __device__ __forceinline__ void operator()(f32x4 (&acc)[2][2][4][2], const pg8::Unit& u, int wr, int wc, int fr, int fq) const {
        const int tid = opaque_tid(), wid = __builtin_amdgcn_readfirstlane(tid >> 6), lane = tid & 63;
        LAS float* S = (LAS float*)(lds + 131072);
#pragma unroll
        for (int ai = 0; ai < 2; ++ai)
#pragma unroll
            for (int m = 0; m < 4; ++m) {
                float ss = 0.f;
#pragma unroll
                for (int bj = 0; bj < 2; ++bj)
#pragma unroll
                    for (int n = 0; n < 2; ++n) { const f32x4 v = acc[ai][bj][m][n]; ss += (v[0] * v[0] + v[1] * v[1]) + (v[2] * v[2] + v[3] * v[3]); }
                ss += __shfl_xor(ss, 16); ss += __shfl_xor(ss, 32);
                if (fq == 0) __hip_atomic_store(SSQ + (size_t)(u.pm * 256 + ai * 128 + wr * 64 + m * 16 + fr) * 32 + u.pn * 4 + wc, ss, __ATOMIC_RELAXED, __HIP_MEMORY_SCOPE_AGENT);
            }
        asm volatile("s_waitcnt vmcnt(0)" ::: "memory");
        if (lane == 0) __hip_atomic_fetch_add(cnt + 64 * u.pm, 1u, __ATOMIC_RELAXED, __HIP_MEMORY_SCOPE_AGENT);
        if (wid == 0) {
            for (unsigned it = 0; it < (1u << 22); ++it) {
                if ((unsigned)__builtin_amdgcn_readfirstlane(__hip_atomic_load(cnt + 64 * u.pm, __ATOMIC_RELAXED, __HIP_MEMORY_SCOPE_AGENT)) >= 64u) break;
                __builtin_amdgcn_s_sleep(2);
            }
            __builtin_amdgcn_fence(__ATOMIC_ACQUIRE, "agent");
        }
        asm volatile("s_waitcnt vmcnt(0) lgkmcnt(0)" ::: "memory"); __builtin_amdgcn_s_barrier(); asm volatile("" ::: "memory");
        if (tid < 256) {
            const unsigned long long* slot = (const unsigned long long*)(SSQ + (size_t)(u.pm * 256 + tid) * 32); float s = 0.f;
#pragma unroll
            for (int t = 0; t < 16; ++t) { const unsigned long long w = __hip_atomic_load(slot + t, __ATOMIC_RELAXED, __HIP_MEMORY_SCOPE_AGENT); s += __uint_as_float((unsigned)w) + __uint_as_float((unsigned)(w >> 32)); }
            S[tid] = rsqrtf(s * (1.f / DM) + EPS);
        }
        asm volatile("s_waitcnt lgkmcnt(0)" ::: "memory"); __builtin_amdgcn_s_barrier(); asm volatile("" ::: "memory");
        const f32x4 g = *(const f32x4*)(post_w + u.pn * 256 + 4 * lane);
        const int lr0 = 4 * wid;
        const size_t gbase = (size_t)(u.pm * 256 + (lr0 >> 4) * 64 + (lr0 & 15)) * DM + u.pn * 256 + 4 * lane;
        const unsigned woff = (unsigned)((wr * 16 + fr) * 1040 + (wc * 32 + 4 * fq) * 4), roff = (unsigned)(lr0 * 1040 + lane * 16);
        f32x4 xv[4], xn[4];
#pragma unroll
        for (int q = 0; q < 4; ++q) xv[q] = __builtin_nontemporal_load((const f32x4*)(x + gbase + (size_t)q * DM));
#pragma unroll
        for (int s = 0; s < 8; ++s) {
            const int ai = s >> 2, m = s & 3; LAS unsigned char* T = lds + (s & 1) * 33280;
            const float rs = S[ai * 128 + wr * 64 + m * 16 + fr];
#pragma unroll
            for (int bj = 0; bj < 2; ++bj)
#pragma unroll
                for (int n = 0; n < 2; ++n) *(LAS f32x4*)(T + woff + bj * 512 + n * 64) = acc[ai][bj][m][n] * rs;
            if (s < 7) {
                const size_t o2 = (size_t)(((s + 1) >> 2) * 128 + ((s + 1) & 3) * 16) * DM;
#pragma unroll
                for (int q = 0; q < 4; ++q) xn[q] = __builtin_nontemporal_load((const f32x4*)(x + gbase + o2 + (size_t)q * DM));
            }
            asm volatile("s_waitcnt lgkmcnt(0)" ::: "memory"); __builtin_amdgcn_s_barrier(); asm volatile("" ::: "memory");
            const size_t o1 = (size_t)(ai * 128 + m * 16) * DM;
#pragma unroll
            for (int q = 0; q < 4; ++q) { const f32x4 v = *(const LAS f32x4*)(T + roff + q * 1040); __builtin_nontemporal_store(xv[q] + v * g, (f32x4*)(out + gbase + o1 + (size_t)q * DM)); }
#pragma unroll
            for (int q = 0; q < 4; ++q) xv[q] = xn[q];
        }
    }
};

struct TJob { const float* src; bf16_t* dst; int K, N, col0, nblk, row0, item0; };
struct Params {
    const float *x, *meta, *rel_bias, *pre_w, *w_in, *kv_norm_w, *w_uk, *w_uv, *ikn_w, *ikn_b, *lam_p, *subln_w, *w_o_a, *w_o_b, *w_out, *post_w;
    float* out; unsigned char* ws;
    TJob jobs[17]; int njobs, nitems;
};
#define WSP(T, off) ((T*)(p.ws + (off)))

__device__ __forceinline__ void p0_transpose_item(const TJob& jb, LAS float* scr, int item, int lane) {
    const int kb = item / jb.nblk, nb = item % jb.nblk, k0 = 64 * kb, n0 = jb.col0 + 32 * nb;
#pragma unroll 8
    for (int i = 0; i < 32; ++i) { const int kk = 2 * i + (lane >> 5); scr[kk * 33 + (lane & 31)] = __builtin_nontemporal_load(jb.src + (size_t)(k0 + kk) * jb.N + n0 + (lane & 31)); }
    asm volatile("s_waitcnt lgkmcnt(0)" ::: "memory");
    const int c = lane & 7;
#pragma unroll
    for (int j = 0; j < 4; ++j) { const int n = (lane >> 3) + 8 * j; const LAS float* s = scr + (8 * c) * 33 + n;
        u32x4 o; o.x = pk2(s[0 * 33], s[1 * 33]); o.y = pk2(s[2 * 33], s[3 * 33]); o.z = pk2(s[4 * 33], s[5 * 33]); o.w = pk2(s[6 * 33], s[7 * 33]);
        *(u32x4*)(jb.dst + (size_t)(jb.row0 + 32 * nb + n) * jb.K + k0 + 8 * c) = o; }
    asm volatile("s_waitcnt lgkmcnt(0)" ::: "memory");
}
__device__ __forceinline__ void p0_norm_row(const float* xrow, const float* g, bf16_t* orow, int lane) {
    const f32x4* xr = (const f32x4*)xrow + lane; const f32x4* gr = (const f32x4*)g + lane;
    f32x4 v[8]; float s = 0.f;
#pragma unroll
    for (int j = 0; j < 8; ++j) { v[j] = __builtin_nontemporal_load(xr + 64 * j); s += (v[j].x * v[j].x + v[j].y * v[j].y) + (v[j].z * v[j].z + v[j].w * v[j].w); }
    const float rstd = rsqrtf(wave_sum(s) * (1.f / DM) + EPS);
    u32x2* o8 = (u32x2*)orow + lane;
#pragma unroll
    for (int j = 0; j < 8; ++j) { const f32x4 gg = gr[64 * j]; u32x2 w; w.x = pk2(v[j].x * rstd * gg.x, v[j].y * rstd * gg.y); w.y = pk2(v[j].z * rstd * gg.z, v[j].w * rstd * gg.w); o8[64 * j] = w; }
}
__device__ __forceinline__ void phase0(const Params& p, LAS unsigned char* lds, int gw, int ngw, int wave, int lane, int item_lo, int item_hi) {
    LAS float* scr = (LAS float*)(lds + wave * 16384);
    for (int it = gw + item_lo; it < item_hi; it += ngw) {
        int jn = 0;
#pragma unroll
        for (int q = 1; q < 17; ++q) if (q < p.njobs && it >= p.jobs[q].item0) jn = q;
        p0_transpose_item(p.jobs[jn], scr, it - p.jobs[jn].item0, lane);
    }
    if (item_lo != 0) return;
    bf16_t* U = WSP(bf16_t, WS_U);
    for (int m = gw; m < UROWS; m += ngw) {
        if (m < MTOK) p0_norm_row(p.x + (size_t)m * DM, p.pre_w, U + (size_t)m * DM, lane);
        else if (m < MTOK + NMETA) p0_norm_row(p.meta + (size_t)(m - MTOK) * DM, p.pre_w, U + (size_t)m * DM, lane);
        else { u32x4* o = (u32x4*)(U + (size_t)m * DM) + lane;
#pragma unroll
            for (int j = 0; j < 4; ++j) o[64 * j] = (u32x4){0u, 0u, 0u, 0u}; }
    }
    bf16_t* WUK = WSP(bf16_t, WS_WUK);
    for (int i = gw * 64 + lane; i < 262144 / 4; i += ngw * 64) { const f32x4 v = ((const f32x4*)p.w_uk)[i]; u32x2 w; w.x = pk2(v.x, v.y); w.y = pk2(v.z, v.w); ((u32x2*)WUK)[i] = w; }
}

__device__ __forceinline__ void phase_ckvnorm(const Params& p, int gw, int ngw, int lane) {
    const float* CKVRAW = WSP(const float, WS_CKVRAW); bf16_t* CKV = WSP(bf16_t, WS_CKV);
    for (int r = gw; r < MKEY; r += ngw) {
        const f32x4 v = ((const f32x4*)(CKVRAW + (size_t)r * 256))[lane];
        const float ss = wave_sum((v.x * v.x + v.y * v.y) + (v.z * v.z + v.w * v.w));
        const float rstd = rsqrtf(ss * (1.f / 256.f) + EPS);
        const f32x4 g = ((const f32x4*)p.kv_norm_w)[lane];
        int w = __builtin_amdgcn_cvt_pk_fp8_f32(v.x * rstd * g.x, v.y * rstd * g.y, 0, false); w = __builtin_amdgcn_cvt_pk_fp8_f32(v.z * rstd * g.z, v.w * rstd * g.w, w, true);
        ((unsigned*)((unsigned char*)CKV + (size_t)r * 256))[lane] = (unsigned)w;
    }
}

__device__ __forceinline__ void phase7(const Params& p, int gw, int ngw, int lane) {
    const bf16_t* OUTPRE = WSP(const bf16_t, WS_OUTPRE); const float* SSQ = WSP(const float, WS_SSQ);
    for (int r = gw; r < MTOK; r += ngw) {
        float s = (lane < 32) ? SSQ[(size_t)r * 32 + lane] : 0.f; s = wave_sum(s);
        const float rstd = rsqrtf(s * (1.f / DM) + EPS);
        const u32x4* o = (const u32x4*)(OUTPRE + (size_t)r * DM); const f32x4* xr = (const f32x4*)(p.x + (size_t)r * DM); const f32x4* g = (const f32x4*)p.post_w; f32x4* out = (f32x4*)(p.out + (size_t)r * DM);
#pragma unroll
        for (int j = 0; j < 4; ++j) {
            const int ch = 64 * j + lane;
            const u32x4 w = o[ch]; const f32x4 x0 = __builtin_nontemporal_load(xr + 2 * ch), x1 = __builtin_nontemporal_load(xr + 2 * ch + 1), g0 = g[2 * ch], g1 = g[2 * ch + 1];
            f32x4 y0, y1;
            y0.x = x0.x + bflo(w.x) * rstd * g0.x; y0.y = x0.y + bfhi(w.x) * rstd * g0.y; y0.z = x0.z + bflo(w.y) * rstd * g0.z; y0.w = x0.w + bfhi(w.y) * rstd * g0.w;
            y1.x = x1.x + bflo(w.z) * rstd * g1.x; y1.y = x1.y + bfhi(w.z) * rstd * g1.y; y1.z = x1.z + bflo(w.w) * rstd * g1.z; y1.w = x1.w + bfhi(w.w) * rstd * g1.w;
            out[2 * ch] = y0; out[2 * ch + 1] = y1;
        }
    }
}

typedef short v4i16_t __attribute__((ext_vector_type(4)));
typedef float f32x2_t __attribute__((ext_vector_type(2))); typedef __bf16 bf16x2_t __attribute__((ext_vector_type(2)));
__device__ __forceinline__ unsigned cvtpk_s(float lo, float hi) { const f32x2_t v = {lo, hi}; const bf16x2_t b = __builtin_convertvector(v, bf16x2_t); return __builtin_bit_cast(unsigned, b); }
__device__ __forceinline__ unsigned off_b(unsigned row, unsigned ch) { const unsigned f = ((row >> 3) & 1u) | ((((row >> 2) ^ (row >> 3)) & 1u) << 1) | (((row >> 1) & 1u) << 2) | ((row & 1u) << 3); return 256u * row + 16u * (ch ^ f); }
__device__ __forceinline__ bf16x8 tr_frag(LAS unsigned char* img, unsigned a0, unsigned a1) {
    const v4i16_t lo = __builtin_amdgcn_ds_read_tr16_b64_v4i16((LAS v4i16_t*)(img + a0));
    const v4i16_t hi = __builtin_amdgcn_ds_read_tr16_b64_v4i16((LAS v4i16_t*)(img + a1));
    return (bf16x8){lo[0], lo[1], lo[2], lo[3], hi[0], hi[1], hi[2], hi[3]};
}
__device__ __forceinline__ void glds16(const void* gsrc, unsigned lds_dst) {
    unsigned keep;
    asm volatile("s_mov_b32 %0, m0\n\ts_mov_b32 m0, %2\n\ts_nop 0\n\tglobal_load_lds_dwordx4 %1, off\n\ts_mov_b32 m0, %0" : "=&s"(keep) : "v"(gsrc), "s"(lds_dst) : "memory");
}
constexpr int DB_K = 0, DB_V = 49152, DB_LUT = 98304, DB_Q = 99328;
constexpr float DIFF_THR = 24.0f;
__device__ __forceinline__ void diff_unit(const Params& p, LAS unsigned char* lds, int b, int h, int qb, float lam) {
    const bf16_t* QB = WSP(const bf16_t, WS_QB); const bf16_t* KB = WSP(const bf16_t, WS_KB); const bf16_t* VB = WSP(const bf16_t, WS_VB); const bf16_t* ZB = WSP(const bf16_t, WS_ZB); bf16_t* OZB = WSP(bf16_t, WS_OZB);
    const int tid = opaque_tid(), lane = tid & 63, wave = __builtin_amdgcn_readfirstlane(tid >> 6), l15 = lane & 15, g = lane >> 4;
    const int jw = 128 * qb + 16 * wave, jq = jw + l15, cw = 2 * qb + 1 + (wave >> 2), ntiles = 2 * qb + 3;
    LAS float* LUT = (LAS float*)(lds + DB_LUT);
    __syncthreads();
    if (tid < 155) LUT[tid] = p.rel_bias[t5_bucket(tid - 91) * 16 + 8 + h] * LOG2E;
    LAS unsigned char* Qimg = lds + DB_Q + wave * 4096;
    { const bf16_t* qp = QB + (size_t)(b * SEQ + jq) * 1024 + h * 128 + 8 * g;
#pragma unroll
      for (int s = 0; s < 4; ++s) *(LAS bf16x8*)(Qimg + off_b((unsigned)l15, 4u * s + (unsigned)g)) = *(const bf16x8*)(qp + 32 * s); }
    size_t dsrc[2];
#pragma unroll
    for (int i = 0; i < 2; ++i) { const unsigned row = 8u * wave + 4u * i + (unsigned)(lane >> 4); const unsigned f = (off_b(row & 15u, 0u) >> 4) & 15u;
        dsrc[i] = (size_t)row * 1024 + h * 128 + (((unsigned)(lane & 15)) ^ f) * 8; }
    const unsigned ddst = 2048u * wave;
    const unsigned lds0 = (unsigned)(size_t)lds;
#define DF_ROW0(tt) ((size_t)b * TK + ((tt) == 0 ? 0 : 16 + 64 * ((tt) - 1)))
#define DF_DMAK(tt, slot) do { const bf16_t* g_ = KB + DF_ROW0(tt) * 1024; _Pragma("unroll") for (int i_ = 0; i_ < 2; ++i_) \
        glds16(g_ + dsrc[i_], (unsigned)__builtin_amdgcn_readfirstlane((int)(lds0 + DB_K + (slot) * 16384 + ddst + 1024 * i_))); } while (0)
#define DF_DMAV(tt, slot) do { const bf16_t* g_ = VB + DF_ROW0(tt) * 1024; _Pragma("unroll") for (int i_ = 0; i_ < 2; ++i_) \
        glds16(g_ + dsrc[i_], (unsigned)__builtin_amdgcn_readfirstlane((int)(lds0 + DB_V + (slot) * 16384 + ddst + 1024 * i_))); } while (0)
#define DF_WAITBAR(n) do { if ((n) >= 4) asm volatile("s_waitcnt vmcnt(4) lgkmcnt(0)" ::: "memory"); else if ((n) >= 2) asm volatile("s_waitcnt vmcnt(2) lgkmcnt(0)" ::: "memory"); \
        else asm volatile("s_waitcnt vmcnt(0) lgkmcnt(0)" ::: "memory"); __builtin_amdgcn_s_barrier(); asm volatile("" ::: "memory"); } while (0)
    const unsigned q4 = (unsigned)l15 >> 2, pp = (unsigned)l15 & 3u;
    unsigned kbase[2][2], vbase[8];
#pragma unroll
    for (int mp = 0; mp < 2; ++mp)
#pragma unroll
        for (int s = 0; s < 2; ++s) kbase[mp][s] = off_b((unsigned)l15, 8u * mp + 4u * s + (unsigned)g);
#pragma unroll
    for (int c = 0; c < 8; ++c) vbase[c] = off_b(4u * g + q4, 2u * c + (pp >> 1)) + 8u * (pp & 1u);

    float m1 = 0.f, m2 = 0.f;
    f32x4 O1[8], O2[8], OL1 = (f32x4){0.f, 0.f, 0.f, 0.f}, OL2 = (f32x4){0.f, 0.f, 0.f, 0.f};
    const short one_ = (l15 == 0) ? (short)0x3F80 : (short)0;
    const bf16x8 onesf = (bf16x8){one_, one_, one_, one_, one_, one_, one_, one_};
#pragma unroll
    for (int c = 0; c < 8; ++c) { O1[c] = (f32x4){0.f, 0.f, 0.f, 0.f}; O2[c] = (f32x4){0.f, 0.f, 0.f, 0.f}; }
    f32x4 S1[4], S2[4];
    bf16x8 pa1[2], pa2[2];
    float es1 = 1.f, es2 = 1.f; bool pending = false;
    f32x4 cn1 = (f32x4){0.f, 0.f, 0.f, 0.f}, cn2 = cn1, cf1 = cn1, cf2 = cn1;

#define DF_QK(tt, kbo_) do { LAS unsigned char* Kb_ = lds + DB_K + (kbo_); \
        const int dmin_ = ((tt) == 0) ? (jw + 1) : (jw - 64 * (tt) + 1); const bool near_ = dmin_ < 91; \
        const f32x4 ci1_ = near_ ? cn1 : cf1, ci2_ = near_ ? cn2 : cf2;        \
        _Pragma("unroll") for (int s = 0; s < 2; ++s) { const bf16x8 q1_ = *(const LAS bf16x8*)(Qimg + kbase[0][s]), q2_ = *(const LAS bf16x8*)(Qimg + kbase[1][s]); \
          bf16x8 ka1_[4], ka2_[4]; \
          _Pragma("unroll") for (int mb = 0; mb < 4; ++mb) { ka1_[mb] = *(const LAS bf16x8*)(Kb_ + kbase[0][s] + 4096 * mb); ka2_[mb] = *(const LAS bf16x8*)(Kb_ + kbase[1][s] + 4096 * mb); } \
          __builtin_amdgcn_sched_barrier(0); \
          _Pragma("unroll") for (int mb = 0; mb < 4; ++mb) { \
            S1[mb] = __builtin_amdgcn_mfma_f32_16x16x32_bf16(ka1_[mb], q1_, s == 0 ? ci1_ : S1[mb], 0, 0, 0); S2[mb] = __builtin_amdgcn_mfma_f32_16x16x32_bf16(ka2_[mb], q2_, s == 0 ? ci2_ : S2[mb], 0, 0, 0); } } \
        if (near_) { _Pragma("unroll") for (int mb = 0; mb < 4; ++mb) _Pragma("unroll") for (int i = 0; i < 4; ++i) { \
            const int kr_ = 16 * mb + 4 * g + i; const int kpos_ = ((tt) == 0) ? kr_ : 16 + 64 * ((tt) - 1) + kr_; \
            int rel_ = kpos_ - (NMETA + jq); rel_ = rel_ < -91 ? -91 : (rel_ > 63 ? 63 : rel_); const float bias_ = LUT[rel_ + 91]; S1[mb][i] += bias_; S2[mb][i] += bias_; } } \
        if ((tt) == 0) { _Pragma("unroll") for (int mb = 1; mb < 4; ++mb) { S1[mb] = (f32x4){-INFINITY, -INFINITY, -INFINITY, -INFINITY}; S2[mb] = S1[mb]; } } } while (0)
#define DF_LMAX(t1_, t2_) do { t1_ = fmaxf(fmaxf(S1[0][0], S1[0][1]), S1[0][2]); t2_ = fmaxf(fmaxf(S2[0][0], S2[0][1]), S2[0][2]); \
        t1_ = fmaxf(fmaxf(t1_, S1[0][3]), S1[1][0]); t2_ = fmaxf(fmaxf(t2_, S2[0][3]), S2[1][0]); \
        t1_ = fmaxf(fmaxf(t1_, S1[1][1]), S1[1][2]); t2_ = fmaxf(fmaxf(t2_, S2[1][1]), S2[1][2]); \
        t1_ = fmaxf(fmaxf(t1_, S1[1][3]), S1[2][0]); t2_ = fmaxf(fmaxf(t2_, S2[1][3]), S2[2][0]); \
        t1_ = fmaxf(fmaxf(t1_, S1[2][1]), S1[2][2]); t2_ = fmaxf(fmaxf(t2_, S2[2][1]), S2[2][2]); \
        t1_ = fmaxf(fmaxf(t1_, S1[2][3]), S1[3][0]); t2_ = fmaxf(fmaxf(t2_, S2[2][3]), S2[3][0]); \
        t1_ = fmaxf(fmaxf(t1_, S1[3][1]), S1[3][2]); t2_ = fmaxf(fmaxf(t2_, S2[3][1]), S2[3][2]); \
        t1_ = fmaxf(t1_, S1[3][3]); t2_ = fmaxf(t2_, S2[3][3]); } while (0)
#define DF_RESCALE(t1_, t2_, forced_) do { float r1_ = t1_, r2_ = t2_; r1_ = fmaxf(r1_, __shfl_xor(r1_, 16)); r1_ = fmaxf(r1_, __shfl_xor(r1_, 32)); r2_ = fmaxf(r2_, __shfl_xor(r2_, 16)); r2_ = fmaxf(r2_, __shfl_xor(r2_, 32)); \
        const float d1_ = (forced_) ? r1_ : fmaxf(r1_, 0.f), d2_ = (forced_) ? r2_ : fmaxf(r2_, 0.f); m1 += d1_; m2 += d2_; \
        es1 = __builtin_amdgcn_exp2f(-d1_); es2 = __builtin_amdgcn_exp2f(-d2_); \
        _Pragma("unroll") for (int mb = 0; mb < 4; ++mb) { S1[mb] = S1[mb] - d1_; S2[mb] = S2[mb] - d2_; } \
        cn1 = (f32x4){-m1, -m1, -m1, -m1}; cn2 = (f32x4){-m2, -m2, -m2, -m2}; { const float f1_ = bias_far - m1, f2_ = bias_far - m2; cf1 = (f32x4){f1_, f1_, f1_, f1_}; cf2 = (f32x4){f2_, f2_, f2_, f2_}; } } while (0)
#define DF_SCALE_O() do { _Pragma("unroll") for (int i = 0; i < 4; ++i) { const float x1_ = __shfl(es1, 4 * g + i), x2_ = __shfl(es2, 4 * g + i); OL1[i] *= x1_; OL2[i] *= x2_; \
            _Pragma("unroll") for (int c = 0; c < 8; ++c) { O1[c][i] *= x1_; O2[c][i] *= x2_; } } } while (0)
#define DF_EXP() do { _Pragma("unroll") for (int mb = 0; mb < 4; ++mb) _Pragma("unroll") for (int i = 0; i < 4; ++i) { S1[mb][i] = __builtin_amdgcn_exp2f(S1[mb][i]); S2[mb][i] = __builtin_amdgcn_exp2f(S2[mb][i]); } \
        _Pragma("unroll") for (int ks = 0; ks < 2; ++ks) { u32x4 w1_, w2_; \
            w1_.x = cvtpk_s(S1[2 * ks][0], S1[2 * ks][1]); w1_.y = cvtpk_s(S1[2 * ks][2], S1[2 * ks][3]); w1_.z = cvtpk_s(S1[2 * ks + 1][0], S1[2 * ks + 1][1]); w1_.w = cvtpk_s(S1[2 * ks + 1][2], S1[2 * ks + 1][3]); \
            w2_.x = cvtpk_s(S2[2 * ks][0], S2[2 * ks][1]); w2_.y = cvtpk_s(S2[2 * ks][2], S2[2 * ks][3]); w2_.z = cvtpk_s(S2[2 * ks + 1][0], S2[2 * ks + 1][1]); w2_.w = cvtpk_s(S2[2 * ks + 1][2], S2[2 * ks + 1][3]); \
            pa1[ks] = __builtin_bit_cast(bf16x8, w1_); pa2[ks] = __builtin_bit_cast(bf16x8, w2_); } } while (0)
#define DF_PV(vbo_, pq1_, pq2_) do { LAS unsigned char* Vb_ = lds + DB_V + (vbo_); \
        _Pragma("unroll") for (int ks = 0; ks < 2; ++ks) { OL1 = __builtin_amdgcn_mfma_f32_16x16x32_bf16(pq1_[ks], onesf, OL1, 0, 0, 0); OL2 = __builtin_amdgcn_mfma_f32_16x16x32_bf16(pq2_[ks], onesf, OL2, 0, 0, 0); } \
        _Pragma("unroll") for (int c2 = 0; c2 < 8; c2 += 2) { bf16x8 vf_[2][2]; \
            _Pragma("unroll") for (int cc = 0; cc < 2; ++cc) _Pragma("unroll") for (int ks = 0; ks < 2; ++ks) vf_[cc][ks] = tr_frag(Vb_ + vbase[c2 + cc], 8192u * ks, 8192u * ks + 4096u); \
            _Pragma("unroll") for (int cc = 0; cc < 2; ++cc) _Pragma("unroll") for (int ks = 0; ks < 2; ++ks) { \
                O1[c2 + cc] = __builtin_amdgcn_mfma_f32_16x16x32_bf16(pq1_[ks], vf_[cc][ks], O1[c2 + cc], 0, 0, 0); O2[c2 + cc] = __builtin_amdgcn_mfma_f32_16x16x32_bf16(pq2_[ks], vf_[cc][ks], O2[c2 + cc], 0, 0, 0); } } } while (0)

    DF_DMAK(0, 0); DF_DMAV(0, 0); DF_DMAK(1, 1); DF_DMAV(1, 1); DF_DMAK(2, 2);
    asm volatile("s_waitcnt vmcnt(0) lgkmcnt(0)" ::: "memory"); __builtin_amdgcn_s_barrier(); asm volatile("" ::: "memory");
    const float bias_far = LUT[0];
    cf1 = (f32x4){bias_far, bias_far, bias_far, bias_far}; cf2 = cf1;
    { DF_QK(0, 0u); float t1, t2; DF_LMAX(t1, t2); DF_RESCALE(t1, t2, true); DF_EXP(); }
    asm volatile("s_waitcnt lgkmcnt(0)" ::: "memory"); __builtin_amdgcn_s_barrier(); asm volatile("" ::: "memory");
    int sk = 1, sv = 0;
    for (int t = 0; t < ntiles; ++t) {
        if (__builtin_expect(pending, 0)) { DF_SCALE_O(); pending = false; }
        int nnew = 0;
        { const int s3 = (sk == 0) ? 2 : sk - 1;
          if (t + 3 < ntiles) { DF_DMAK(t + 3, s3); nnew += 2; }
          const int s2 = (sv == 0) ? 2 : sv - 1;
          if (t + 2 < ntiles) { DF_DMAV(t + 2, s2); nnew += 2; } }
        unsigned kbo = (unsigned)sk * 16384u, vbo = (unsigned)sv * 16384u; asm volatile("" : "+v"(kbo), "+v"(vbo));
        if (t + 1 <= cw) {
            DF_QK(t + 1, kbo);
            float t1, t2; DF_LMAX(t1, t2);
            if (__builtin_expect(__any((t1 > DIFF_THR) || (t2 > DIFF_THR)), 0)) { DF_RESCALE(t1, t2, false); pending = true; }
            DF_PV(vbo, pa1, pa2);
            DF_EXP();
        } else if (t <= cw) {
            DF_PV(vbo, pa1, pa2);
        }
        DF_WAITBAR(nnew);
        sk = (sk == 2) ? 0 : sk + 1; sv = (sv == 2) ? 0 : sv + 1;
    }
    asm volatile("s_waitcnt vmcnt(0)" ::: "memory");
#undef DF_ROW0
#undef DF_DMAK
#undef DF_DMAV
#undef DF_WAITBAR
#undef DF_QK
#undef DF_LMAX
#undef DF_RESCALE
#undef DF_SCALE_O
#undef DF_EXP
#undef DF_PV
#pragma unroll
    for (int i = 0; i < 4; ++i) {
        const float r1 = 1.f / __shfl(OL1[i], 16 * g), r2 = lam / __shfl(OL2[i], 16 * g);
        float o[8]; float ss = 0.f;
#pragma unroll
        for (int c = 0; c < 8; ++c) { o[c] = O1[c][i] * r1 - O2[c][i] * r2; ss += o[c] * o[c]; }
        ss += __shfl_xor(ss, 1); ss += __shfl_xor(ss, 2); ss += __shfl_xor(ss, 4); ss += __shfl_xor(ss, 8);
        const float rs = rsqrtf(ss * (1.f / 128.f) + EPS) * 0.8f;
        const size_t t = (size_t)b * SEQ + jw + 4 * g + i;
#pragma unroll
        for (int c = 0; c < 8; ++c) { const int d = 16 * c + l15; const float y = o[c] * rs * p.subln_w[d] * bf2f(ZB[t * 1024 + h * 128 + d]); OZB[t * 1024 + h * 128 + d] = (bf16_t)f2bf(y); }
    }
}
__device__ __forceinline__ void phase_diff(const Params& p, LAS unsigned char* lds) {
    const int lane = threadIdx.x & 63;
    float a = (lane < 64) ? p.lam_p[lane] * p.lam_p[64 + lane] : 0.f, bb = p.lam_p[128 + lane] * p.lam_p[192 + lane];
    a = wave_sum(a); bb = wave_sum(bb);
    const float lam = expf(a) - expf(bb) + 0.2f;
    for (int u = blockIdx.x; u < 512; u += gridDim.x) {
        const int v = u & 255;
        int bh = v >> 4, s = v & 15;
        if (gridDim.x == 256) { bh = (v & 7) + 8 * (v >> 7); s = (v >> 3) & 15; }
        const int qb = (u < 256) ? s : 31 - s;
        diff_unit(p, lds, bh >> 3, bh & 7, qb, lam);
    }
}

typedef float f32x16 __attribute__((ext_vector_type(16)));
__device__ __forceinline__ void scores_wg_unit(const Params& p, LAS unsigned char* lds, int c, int b, int half, int kh) {
    const bf16_t* IQ = WSP(const bf16_t, WS_IQ); const float* IW = WSP(const float, WS_IW); float* SC = WSP(float, WS_SC);
    const int tid = opaque_tid(), lane = tid & 63, wave = __builtin_amdgcn_readfirstlane(tid >> 6);
    const int j0 = (c - 1) * 64 + 32 * half + 4 * wave, m0 = b * SEQ + j0, n = 16 + 64 * c, nkb = 2 * c + 1, nkh = (nkb + 1) >> 1;
    const int kbA = kh ? nkh : 0, kbB = kh ? nkb : nkh, ntile = (kbB - kbA + 1) >> 1;
    const int r32 = lane & 31, hi = lane >> 5, tok = r32 >> 4, hh = r32 & 15;
    bf16x8 af[2][4]; float wv[2][16];
#pragma unroll
    for (int pr = 0; pr < 2; ++pr) {
#pragma unroll
        for (int s = 0; s < 4; ++s) af[pr][s] = *(const bf16x8*)(IQ + (size_t)(m0 + 2 * pr + tok) * 1024 + hh * 64 + 16 * s + 8 * hi);
#pragma unroll
        for (int r = 0; r < 16; ++r) wv[pr][r] = IW[(size_t)(m0 + 2 * pr + (r >> 3)) * 16 + (r & 3) + 8 * ((r >> 2) & 1) + 4 * hi];
    }
    float* rowbase = SC + sc_off(b, j0);
    const bf16_t* ikb = WSP(const bf16_t, WS_IK) + (size_t)b * TK * 64;
    const int pkey = tid >> 3, pch = tid & 7;
    const unsigned pdst = (unsigned)pkey * 128u + 16u * (unsigned)(pch ^ (pkey & 7));
    unsigned boff[4];
#pragma unroll
    for (int s = 0; s < 4; ++s) boff[s] = (unsigned)r32 * 128u + 16u * (unsigned)((2 * s + hi) ^ (r32 & 7));
    u32x4 kreg;
#define SCW_LOAD(t_) do { int key_ = 32 * (kbA + 2 * (t_)) + pkey; key_ = key_ < n ? key_ : n - 1; kreg = *(const u32x4*)(ikb + (size_t)key_ * 64 + pch * 8); } while (0)
#define SCW_WRITE(off_) do { *(LAS u32x4*)(lds + (off_) + pdst) = kreg; } while (0)
    __syncthreads();
    SCW_LOAD(0); SCW_WRITE(0u);
    __syncthreads();
    for (int t = 0; t < ntile; ++t) {
        if (t + 1 < ntile) SCW_LOAD(t + 1);
        unsigned bo = (unsigned)(t & 1) * 8192u; asm volatile("" : "+v"(bo));
#pragma unroll
        for (int q = 0; q < 2; ++q) {
            const int kb = kbA + 2 * t + q, key = 32 * kb + r32;
            bf16x8 bfr[4];
#pragma unroll
            for (int s = 0; s < 4; ++s) bfr[s] = *(const LAS bf16x8*)(lds + bo + boff[s] + 4096 * q);
#pragma unroll
            for (int pr = 0; pr < 2; ++pr) {
                f32x16 acc;
#pragma unroll
                for (int r = 0; r < 16; ++r) acc[r] = 0.f;
#pragma unroll
                for (int s = 0; s < 4; ++s) acc = __builtin_amdgcn_mfma_f32_32x32x16_bf16(af[pr][s], bfr[s], acc, 0, 0, 0);
                float p0 = 0.f, p1 = 0.f;
#pragma unroll
                for (int r = 0; r < 8; ++r) { p0 += wv[pr][r] * fmaxf(acc[r], 0.f); p1 += wv[pr][8 + r] * fmaxf(acc[8 + r], 0.f); }
                const auto sw = __builtin_amdgcn_permlane32_swap(__float_as_uint(p0), __float_as_uint(p1), false, false);
                const float tot = __uint_as_float(sw[0]) + __uint_as_float(sw[1]);
                if (kb < kbB && key < n) rowbase[(size_t)(2 * pr + hi) * n + key] = tot;
            }
        }
        if (t + 1 < ntile) SCW_WRITE((unsigned)((t + 1) & 1) * 8192u);
        __syncthreads();
    }
#undef SCW_LOAD
#undef SCW_WRITE
}
__device__ __forceinline__ void phase_scores(const Params& p, LAS unsigned char* lds) {
    for (int P = (int)blockIdx.x; P < 256; P += (int)gridDim.x) {
        const int cl = 1 + (P >> 3), sub = P & 7;
        scores_wg_unit(p, lds, 65 - cl, sub >> 2, (sub >> 1) & 1, sub & 1);
        scores_wg_unit(p, lds, cl, sub >> 2, (sub >> 1) & 1, sub & 1);
    }
}
__device__ __forceinline__ void phase_qlat(const Params& p, LAS unsigned char* lds) {
    const bf16_t* QA = WSP(const bf16_t, WS_QA); const bf16_t* WUK = WSP(const bf16_t, WS_WUK); bf16_t* QLAT = WSP(bf16_t, WS_QLAT);
    const int tid = opaque_tid(), lane = tid & 63, w = __builtin_amdgcn_readfirstlane(tid >> 6), l15 = lane & 15, g = lane >> 4;
    const float sc = 0.08838834764831845f * LOG2E * 16.f;
    const int G = (int)gridDim.x;
    int hcur = -1;
    const unsigned kb0 = off_b((unsigned)l15, (unsigned)g);
    for (int u0 = (int)blockIdx.x; u0 < 4096; u0 += 8 * G) {
        const int h = u0 & 7;
        if (h != hcur || (G & 7)) { hcur = h; __syncthreads();
#pragma unroll
            for (int i = 0; i < 8; ++i) { const int idx = tid + 512 * i, row = idx >> 4, ch = idx & 15;
                *(LAS u32x4*)(lds + off_b((unsigned)row, (unsigned)ch)) = *(const u32x4*)(WUK + ((size_t)row * 8 + h) * 128 + ch * 8); }
            __syncthreads(); }
        const int u = u0 + w * G;
        if (u < 4096 && (u & 7) == h) {
            const int m0 = (u >> 3) * 16;
            bf16x8 bq[4];
#pragma unroll
            for (int s = 0; s < 4; ++s) bq[s] = *(const bf16x8*)(QA + (size_t)(m0 + l15) * 1024 + h * 128 + 32 * s + 8 * g);
#pragma unroll 4
            for (int nb = 0; nb < 16; ++nb) {
                bf16x8 af[4];
#pragma unroll
                for (int s = 0; s < 4; ++s) af[s] = *(const LAS bf16x8*)(lds + 4096 * nb + (kb0 ^ (64u * s)));
                f32x4 acc = (f32x4){0.f, 0.f, 0.f, 0.f};
#pragma unroll
                for (int s = 0; s < 4; ++s) acc = __builtin_amdgcn_mfma_f32_16x16x32_bf16(af[s], bq[s], acc, 0, 0, 0);
                int wv = __builtin_amdgcn_cvt_pk_fp8_f32(acc[0] * sc, acc[1] * sc, 0, false); wv = __builtin_amdgcn_cvt_pk_fp8_f32(acc[2] * sc, acc[3] * sc, wv, true);
                *(unsigned*)((unsigned char*)QLAT + ((size_t)(m0 + l15) * 8 + h) * 256 + 16 * nb + 4 * g) = (unsigned)wv;
            }
        }
    }
}
__device__ __forceinline__ void phase_oproj(const Params& p, LAS unsigned char* lds) {
    const bf16_t* OLAT = WSP(const bf16_t, WS_OLAT); const bf16_t* WUVT = WSP(const bf16_t, WS_WUVT); const bf16_t* ZA = WSP(const bf16_t, WS_ZA); bf16_t* OZA = WSP(bf16_t, WS_OZA);
    const int tid = opaque_tid(), lane = tid & 63, w = __builtin_amdgcn_readfirstlane(tid >> 6), l15 = lane & 15, g = lane >> 4;
    const int G = (int)gridDim.x;
    int hcur = -1;
    const unsigned kb0 = off_b((unsigned)l15, (unsigned)g);
    for (int u0 = (int)blockIdx.x; u0 < 4096; u0 += 8 * G) {
        const int h = u0 & 7;
        if (h != hcur || (G & 7)) { hcur = h; __syncthreads();
#pragma unroll
            for (int i = 0; i < 8; ++i) { const int idx = tid + 512 * i, row = idx >> 5, c32 = idx & 31;
                *(LAS u32x4*)(lds + (c32 >> 4) * 32768 + off_b((unsigned)row, (unsigned)(c32 & 15))) = *(const u32x4*)(WUVT + (size_t)(h * 128 + row) * 256 + c32 * 8); }
            __syncthreads(); }
        const int u = u0 + w * G;
        if (u < 4096 && (u & 7) == h) {
            const int m0 = (u >> 3) * 16;
            bf16x8 bq[8];
#pragma unroll
            for (int s = 0; s < 8; ++s) bq[s] = *(const bf16x8*)(OLAT + ((size_t)(m0 + l15) * 8 + h) * 256 + 32 * s + 8 * g);
#pragma unroll 2
            for (int nb = 0; nb < 8; ++nb) {
                bf16x8 af[8];
#pragma unroll
                for (int s = 0; s < 8; ++s) af[s] = *(const LAS bf16x8*)(lds + (s >> 2) * 32768 + 4096 * nb + (kb0 ^ (64u * (s & 3))));
                f32x4 acc = (f32x4){0.f, 0.f, 0.f, 0.f};
#pragma unroll
                for (int s = 0; s < 8; ++s) acc = __builtin_amdgcn_mfma_f32_16x16x32_bf16(af[s], bq[s], acc, 0, 0, 0);
                const size_t o = (size_t)(m0 + l15) * 1024 + h * 128 + 16 * nb + 4 * g;
                const u32x2 z = *(const u32x2*)(ZA + o);
                u32x2 wv; wv.x = pg8::cvt_pk_bf16(acc[0] * bflo(z.x), acc[1] * bfhi(z.x)); wv.y = pg8::cvt_pk_bf16(acc[2] * bflo(z.y), acc[3] * bfhi(z.y));
                *(u32x2*)(OZA + o) = wv;
            }
        }
    }
}
typedef int v2i32_t __attribute__((ext_vector_type(2)));
constexpr int DSA_WAVE_LDS = 17408, DSA_LUT = 8 * DSA_WAVE_LDS;
__device__ __forceinline__ int lpos(int s) { return (s & ~31) | ((s & 3) << 3) | ((s & 31) >> 2); }
__device__ __forceinline__ unsigned ord_key(float f) { const unsigned u = __float_as_uint(f); return (u & 0x80000000u) ? ~u : (u | 0x80000000u); }
template <int KN>
__device__ __forceinline__ void dsa_select(const float* row, int n, int nsel, LAS int* list, int lane) {
    const __amdgpu_buffer_rsrc_t rs = __builtin_amdgcn_make_buffer_rsrc((void*)row, 0, n * 4, 0x00020000);
    unsigned key[KN];
#pragma unroll
    for (int k = 0; k < KN; ++k) key[k] = (unsigned)__builtin_amdgcn_raw_buffer_load_b32(rs, lane * 4, 256 * k, 2);
    { int idx0 = lane;
#pragma unroll
      for (int k = 0; k < KN; ++k) { const unsigned u = key[k]; const unsigned o = (u & 0x80000000u) ? ~u : (u | 0x80000000u); key[k] = (idx0 < n) ? o : 0u; idx0 += 64; asm volatile("" : "+v"(idx0)); } }
    unsigned thr = 0u;
    if (n > 256) {
        for (int bit = 31; bit >= 0; --bit) {
            const unsigned cand = thr | (1u << bit);
            int c = 0;
#pragma unroll
            for (int k = 0; k < KN; ++k) c += (key[k] >= cand) ? 1 : 0;
            int cnt = 0;
#pragma unroll
            for (int b7 = 0; b7 < 7; ++b7) cnt += __popcll(__ballot((c >> b7) & 1)) << b7;
            if (cnt >= 256) thr = cand;
            if (cnt == 256) break;
        }
    }
    int pos = 0; int idx = lane;
#pragma unroll
    for (int k = 0; k < KN; ++k) { const bool mine = key[k] > thr; const unsigned long long msk = __ballot(mine);
        const int my = __builtin_amdgcn_mbcnt_hi((unsigned)(msk >> 32), __builtin_amdgcn_mbcnt_lo((unsigned)msk, 0u));
        if (mine) list[lpos(pos + my)] = idx; pos += __popcll(msk); idx += 64; asm volatile("" : "+v"(idx)); }
    if (pos < nsel) {
        idx = lane;
#pragma unroll
        for (int k = 0; k < KN; ++k) { const bool mine = (key[k] == thr) && (idx < n); const unsigned long long msk = __ballot(mine);
            const int my = __builtin_amdgcn_mbcnt_hi((unsigned)(msk >> 32), __builtin_amdgcn_mbcnt_lo((unsigned)msk, 0u));
            if (mine && pos + my < nsel) list[lpos(pos + my)] = idx; pos += __popcll(msk); idx += 64; asm volatile("" : "+v"(idx)); }
    }
}
__device__ __forceinline__ void dsa_unit(const Params& p, LAS unsigned char* lds, int qi, int wave, int lane, int probe) {
    const float* SC = WSP(const float, WS_SC); bf16_t* OLAT = WSP(bf16_t, WS_OLAT);
    const int c = qi >> 8, b = (qi >> 6) & 1, j = (c - 1) * 64 + (qi & 63), t = b * SEQ + j, n = 16 + 64 * c, nsel = n < 256 ? n : 256, qpos = NMETA + j;
    LAS unsigned char* img = lds + wave * DSA_WAVE_LDS; LAS int* list = (LAS int*)(img + 16384); const LAS float* LUTA = (const LAS float*)(lds + DSA_LUT);
    const int l15 = lane & 15, g = lane >> 4;
    const float* row = SC + sc_off(b, j);
#pragma unroll
    for (int rs_ = (PROBE_REP == 41) ? 2 : 1; rs_ > 0; --rs_) {
    if (n <= 64 * 17) dsa_select<17>(row, n, nsel, list, lane);
    else if (n <= 64 * 33) dsa_select<33>(row, n, nsel, list, lane);
    else if (n <= 64 * 49) dsa_select<49>(row, n, nsel, list, lane);
    else dsa_select<65>(row, n, nsel, list, lane);
    }
#pragma unroll
    for (int ra_ = (PROBE_REP == 42) ? 2 : 1; ra_ > 0; --ra_) {
    const unsigned char* CKV8 = WSP(const unsigned char, WS_CKV); const unsigned char* qlp = WSP(const unsigned char, WS_QLAT) + ((size_t)t * 8 + (l15 & 7)) * 256 + 8 * g;
    const bool qreal = l15 < 8;
    unsigned rdb[2];
    rdb[0] = 256u * (unsigned)l15 + 8u * ((unsigned)g ^ (2u * (unsigned)l15));
    rdb[1] = 256u * (unsigned)(l15 + 16) + 8u * ((unsigned)g ^ (2u * ((unsigned)l15 ^ 8u)));
    const unsigned tq = (unsigned)l15 >> 1, tp = (unsigned)l15 & 1u;
    const unsigned trow = (tq < 4u) ? 4u * g + tq : 16u + 4u * g + (tq - 4u);
    const unsigned trb = 256u * trow + 8u * (tp ^ (2u * ((trow & 15u) ^ ((trow >> 4) << 3))));
    float m = -INFINITY, l = 0.f;
    f32x4 O[16];
#pragma unroll
    for (int rb = 0; rb < 16; ++rb) O[rb] = (f32x4){0.f, 0.f, 0.f, 0.f};
    const int nch = (nsel + 31) >> 5;
    const int hcol = l15 & 7;
    u32x4 gr[8];
    const unsigned gwr = 256u * (unsigned)(lane >> 4) + 16u * (unsigned)(lane & 15);
#define DSA_GATHER(chn) do { int ki_[8]; { const LAS int* lp_ = list + 32 * (chn) + 8 * (lane >> 4); \
        _Pragma("unroll") for (int v_ = 0; v_ < 2; ++v_) { const u32x4 t_ = *(const LAS u32x4*)(lp_ + 4 * v_); ki_[4 * v_] = (int)t_.x; ki_[4 * v_ + 1] = (int)t_.y; ki_[4 * v_ + 2] = (int)t_.z; ki_[4 * v_ + 3] = (int)t_.w; } } \
        _Pragma("unroll") for (int i = 0; i < 8; ++i) { const int slot = 32 * (chn) + 4 * i + (lane >> 4); const int kidx = slot < nsel ? ki_[i] : 0; \
        gr[i] = *(const u32x4*)(CKV8 + ((size_t)b * TK + kidx) * 256 + (lane & 15) * 16); } } while (0)
    DSA_GATHER(0);
    for (int ch = 0; ch < nch; ++ch) {
#pragma unroll
        for (int i = 0; i < 8; ++i) { const unsigned row = 4u * i + (unsigned)(lane >> 4); const unsigned rc = (row & 15u) ^ ((row >> 4) << 3);
            *(LAS u32x4*)(img + 256u * row + 16u * (((unsigned)lane & 15u) ^ rc)) = gr[i]; }
        long qf[8];
#pragma unroll
        for (int s = 0; s < 8; ++s) qf[s] = *(const long*)(qlp + 32 * s);
        asm volatile("" ::: "memory");
        DSA_GATHER(ch + 1);
        asm volatile("" ::: "memory");
#pragma unroll
        for (int s = 0; s < 8; ++s) qf[s] = qreal ? qf[s] : 0l;
        unsigned io = 0u; asm volatile("" : "+v"(io));
        LAS unsigned char* im = img + io;
        f32x4 S[2];
        S[0] = (f32x4){0.f, 0.f, 0.f, 0.f}; S[1] = S[0];
#pragma unroll
        for (int s4 = 0; s4 < 8; s4 += 4) {
            long af_[4][2];
#pragma unroll
            for (int s = 0; s < 4; ++s)
#pragma unroll
                for (int mb = 0; mb < 2; ++mb) af_[s][mb] = *(const LAS long*)(im + (rdb[mb] ^ (32u * (s4 + s))));
            __builtin_amdgcn_sched_barrier(0);
#pragma unroll
            for (int s = 0; s < 4; ++s)
#pragma unroll
                for (int mb = 0; mb < 2; ++mb) S[mb] = __builtin_amdgcn_mfma_f32_16x16x32_fp8_fp8(af_[s][mb], qf[s4 + s], S[mb], 0, 0, 0);
        }
        float cm = -INFINITY;
#pragma unroll
        for (int mb = 0; mb < 2; ++mb)
#pragma unroll
            for (int i = 0; i < 4; ++i) { const int slot = 32 * ch + 16 * mb + 4 * g + i; const int kidx = list[lpos(slot & 255)];
                int rel = kidx - qpos; rel = rel < -91 ? -91 : (rel > 63 ? 63 : rel);
                float v = S[mb][i] * 0.0625f + LUTA[(rel + 91) * 8 + hcol]; v = slot < nsel ? v : -INFINITY; S[mb][i] = v; cm = fmaxf(cm, v); }
        cm = fmaxf(cm, __shfl_xor(cm, 16)); cm = fmaxf(cm, __shfl_xor(cm, 32));
        const float mn = fmaxf(m, cm), alpha = __builtin_amdgcn_exp2f(m - mn); m = mn;
        float ps = 0.f;
#pragma unroll
        for (int mb = 0; mb < 2; ++mb)
#pragma unroll
            for (int i = 0; i < 4; ++i) { S[mb][i] = __builtin_amdgcn_exp2f(S[mb][i] - mn); ps += S[mb][i]; }
        l = l * alpha + ps;
        if (__any(alpha != 1.f)) {
#pragma unroll
            for (int rb = 0; rb < 16; ++rb) O[rb] = O[rb] * alpha;
        }
        int w0 = __builtin_amdgcn_cvt_pk_fp8_f32(S[0][0], S[0][1], 0, false); w0 = __builtin_amdgcn_cvt_pk_fp8_f32(S[0][2], S[0][3], w0, true);
        int w1 = __builtin_amdgcn_cvt_pk_fp8_f32(S[1][0], S[1][1], 0, false); w1 = __builtin_amdgcn_cvt_pk_fp8_f32(S[1][2], S[1][3], w1, true);
        const long pb = (long)(((unsigned long long)(unsigned)w1 << 32) | (unsigned long long)(unsigned)w0);
#pragma unroll
        for (int rb4 = 0; rb4 < 16; rb4 += 4) {
            long tf_[4];
#pragma unroll
            for (int r_ = 0; r_ < 4; ++r_) { const v2i32_t tv = __builtin_amdgcn_ds_read_tr8_b64_v2i32((LAS v2i32_t*)(im + (trb ^ (16u * (rb4 + r_))))); tf_[r_] = __builtin_bit_cast(long, tv); }
            __builtin_amdgcn_sched_barrier(0);
#pragma unroll
            for (int r_ = 0; r_ < 4; ++r_) O[rb4 + r_] = __builtin_amdgcn_mfma_f32_16x16x32_fp8_fp8(tf_[r_], pb, O[rb4 + r_], 0, 0, 0);
        }
    }
    l += __shfl_xor(l, 16); l += __shfl_xor(l, 32);
    const float il = 1.f / l;
    if (l15 < 8) {
#pragma unroll
        for (int rb = 0; rb < 16; ++rb) { u32x2 w; w.x = pg8::cvt_pk_bf16(O[rb][0] * il, O[rb][1] * il); w.y = pg8::cvt_pk_bf16(O[rb][2] * il, O[rb][3] * il);
            *(u32x2*)(OLAT + ((size_t)t * 8 + l15) * 256 + 16 * rb + 4 * g) = w; }
    }
    }
}
#undef DSA_GATHER
__device__ __forceinline__ int lds_take(LAS unsigned* ctr, int lane) {
    int u = 0; if (lane == 0) u = (int)__hip_atomic_fetch_add(ctr, 1u, __ATOMIC_RELAXED, __HIP_MEMORY_SCOPE_WORKGROUP);
    return __builtin_amdgcn_readfirstlane(u);
}
__device__ __forceinline__ int dsa_query_of(int u, int G) {
    const int k = u >> 3, r = u & 7;
    int cl, bb, grp;
    if (G == 256) { const int idx = ((int)blockIdx.x >> 1) + 128 * k; cl = 1 + (idx >> 4); grp = idx & 15; bb = (int)blockIdx.x & 1; }
    else { const int P = (int)blockIdx.x + k * G; cl = 1 + (P >> 5); bb = (P >> 4) & 1; grp = P & 15; }
    const int c = (r < 4) ? 65 - cl : cl;
    return (c << 8) | (bb << 6) | (4 * grp + (r & 3));
}
__device__ __forceinline__ int dsa_token_of(int qi) { return ((qi >> 6) & 1) * SEQ + ((qi >> 8) - 1) * 64 + (qi & 63); }
__device__ __forceinline__ void phase_dsa(const Params& p, LAS unsigned char* lds, int wave, int lane, int probe) {
    LAS float* LUTA = (LAS float*)(lds + DSA_LUT); LAS unsigned* ctr = (LAS unsigned*)(lds + DSA_LUT + 155 * 8 * 4);
    const int G = (int)gridDim.x, l15 = lane & 15, g = lane >> 4;
    __syncthreads();
    for (int i = threadIdx.x; i < 155 * 8; i += 512) LUTA[i] = p.rel_bias[t5_bucket((i >> 3) - 91) * 16 + (i & 7)] * LOG2E;
    if (threadIdx.x == 0) ctr[0] = 0u;
    const int npi = (1024 - (int)blockIdx.x + G - 1) / G;
    const int nun = npi * 8;
    __syncthreads();
    for (;;) {
        const int u = lds_take(ctr, lane); if (u >= nun) break;
        dsa_unit(p, lds, dsa_query_of(u, G), wave, lane, probe);
    }
}

#define XB_TMO      128
#define XB_XCNT(j)  (256  + 64 * (j))
#define XB_XSUB(j)  (1280 + 64 * (j))
#define XB_XGEN(j)  (2304 + 64 * (j))
#define XB_TOP      3328
#define XB_TOPGEN   3392
#define XCD_BAR_WORDS 3456
#define XB_SPIN_CAP (1u << 24)
__device__ __forceinline__ unsigned xb_ld(unsigned* p)              { return __hip_atomic_load(p, __ATOMIC_RELAXED, __HIP_MEMORY_SCOPE_AGENT); }
__device__ __forceinline__ unsigned xb_add(unsigned* p, unsigned v) { return __hip_atomic_fetch_add(p, v, __ATOMIC_RELAXED, __HIP_MEMORY_SCOPE_AGENT); }
__device__ __forceinline__ unsigned xb_xcc_id() { return (unsigned)__builtin_amdgcn_s_getreg((3 << 11) | 20) & 0xFu; }
#define XB_SPIN(cond, bar) do { unsigned _sp = 0; while (cond) { __builtin_amdgcn_s_sleep(1); \
    if ((++_sp & 255u) == 0u) { if (xb_ld(&(bar)[XB_TMO])) break; if (_sp > XB_SPIN_CAP) { atomicAdd(&(bar)[XB_TMO], 1u); break; } } } } while (0)
struct XcdBarrier { unsigned* bar; unsigned x; volatile LAS unsigned* st; };
__device__ __forceinline__ XcdBarrier xcd_barrier_post(unsigned* bar, volatile LAS unsigned* st) {
    XcdBarrier b; b.bar = bar; b.x = xb_xcc_id(); b.st = st;
    if (threadIdx.x == 0) (void)xb_add(&bar[XB_XCNT(b.x)], 1u);
    return b;
}
__device__ __forceinline__ void xcd_barrier_complete(unsigned* bar, unsigned x, unsigned& nloc, unsigned& nx) {
    const unsigned G = gridDim.x * gridDim.y * gridDim.z;
    unsigned sum, cnt, mine, sp = 0u;
    for (;;) {
        sum = 0u; cnt = 0u; mine = 0u;
#pragma unroll
        for (unsigned j = 0; j < 16; ++j) { const unsigned c = xb_ld(&bar[XB_XCNT(j)]); sum += c; cnt += (c > 0u) ? 1u : 0u; mine = (j == x) ? c : mine; }
        if (sum == G) break;
        __builtin_amdgcn_s_sleep(1);
        if ((++sp & 255u) == 0u) { if (xb_ld(&bar[XB_TMO])) break; if (sp > XB_SPIN_CAP) { atomicAdd(&bar[XB_TMO], 1u); break; } }
    }
    nloc = mine > 0u ? mine : 1u; nx = cnt > 0u ? cnt : 1u;
}
__device__ __forceinline__ void xcd_barrier(const XcdBarrier& b) {
    asm volatile("s_waitcnt vmcnt(0)" ::: "memory");
    __syncthreads();
    if (threadIdx.x == 0) {
        unsigned* bar = b.bar;
        __builtin_amdgcn_s_waitcnt(0);
        unsigned nloc = b.st[0], nx = b.st[1];
        if (nloc == 0u) { xcd_barrier_complete(bar, b.x, nloc, nx); b.st[0] = nloc; b.st[1] = nx; }
        const unsigned old = xb_add(&bar[XB_XSUB(b.x)], 1u);
        const unsigned gen = old / nloc;
        if (old + 1u == (gen + 1u) * nloc) {
            __builtin_amdgcn_fence(__ATOMIC_RELEASE, "agent");
            asm volatile("s_waitcnt vmcnt(0)" ::: "memory");
            const unsigned og = xb_add(&bar[XB_TOP], 1u);
            const unsigned tg = og / nx;
            if (og + 1u == (tg + 1u) * nx) xb_add(&bar[XB_TOPGEN], 1u);
            else XB_SPIN(xb_ld(&bar[XB_TOPGEN]) == tg, bar);
            __builtin_amdgcn_fence(__ATOMIC_ACQUIRE, "agent");
            xb_add(&bar[XB_XGEN(b.x)], 1u);
            asm volatile("s_waitcnt vmcnt(0)" ::: "memory");
        } else {
            XB_SPIN(xb_ld(&bar[XB_XGEN(b.x)]) == gen, bar);
            __builtin_amdgcn_fence(__ATOMIC_ACQUIRE, "agent");
            asm volatile("s_waitcnt vmcnt(0)" ::: "memory");
        }
    }
    __syncthreads();
}

constexpr int LDS_BYTES = 147456, MISC_OFF = 147456 - 256;
constexpr int NPHASE = 8;
#ifndef ONE_LAUNCH
#define ONE_LAUNCH 1
#endif

struct KArgs { Params p; int ph_lo, ph_hi, probe, pad; };
__global__ void __launch_bounds__(512, 2) k_fwd(KArgs a) {
    extern __shared__ __attribute__((aligned(16))) unsigned char lds_raw[];
    LAS unsigned char* lds = (LAS unsigned char*)lds_raw;
    const Params& p = a.p;
    const int tid = threadIdx.x, lane = tid & 63, wave = __builtin_amdgcn_readfirstlane(tid >> 6);
    const int gw = blockIdx.x * 8 + wave, ngw = gridDim.x * 8;
    volatile LAS unsigned* misc = (volatile LAS unsigned*)(lds + MISC_OFF);
    if (tid < 64) misc[tid] = 0u;
    __syncthreads();
    XcdBarrier bar; bar.bar = WSP(unsigned, WS_CTL) + 4096; bar.x = 0; bar.st = misc;
    if (ONE_LAUNCH) bar = xcd_barrier_post(WSP(unsigned, WS_CTL) + 4096, misc);
#define IN(k) (a.ph_lo <= 0 && 0 < a.ph_hi)
#define SEAM(k) do { xcd_barrier(bar); } while (0)
#define RUNPH(k, ...) do { if (IN(k)) { constexpr int nrep_ = (PROBE_REP == (k)) ? 2 : 1; _Pragma("unroll") for (int rep = 0; rep < nrep_; ++rep) { if (rep) xcd_barrier(bar); __VA_ARGS__ } } } while (0)
    RUNPH(0, const int lane_ = opaque_tid() & 63; phase0(p, lds, gw, ngw, wave, lane_, 0, (gridDim.x == 256) ? p.jobs[13].item0 : p.nitems););
    SEAM(0);
    RUNPH(1,
        SchedInproj S{DM, (int)gridDim.x, (int)blockIdx.x, (const char*)WSP(bf16_t, WS_U), (const char*)WSP(bf16_t, WS_WIN)};
        EpiInproj E{WSP(bf16_t, WS_QA), WSP(bf16_t, WS_ZA), WSP(bf16_t, WS_IQ), WSP(bf16_t, WS_QB), WSP(bf16_t, WS_ZB), WSP(bf16_t, WS_GA), WSP(bf16_t, WS_GB), WSP(bf16_t, WS_KB), WSP(bf16_t, WS_VB),
                    WSP(float, WS_CKVRAW), WSP(bf16_t, WS_IK), WSP(float, WS_IW), 0.125f * LOG2E, p.ikn_w, p.ikn_b};
        pg8::gemm_phase<EpiInproj, SchedInproj>(lds, S, E);
        if (gridDim.x == 256 && blockIdx.x >= 202) { const int lane_ = opaque_tid() & 63; phase0(p, lds, ((int)blockIdx.x - 202) * 8 + wave, 54 * 8, wave, lane_, p.jobs[13].item0, p.nitems); });
    SEAM(1);
    RUNPH(33, const int lane_ = opaque_tid() & 63; phase_ckvnorm(p, gw, ngw, lane_););
    RUNPH(32, phase_qlat(p, lds););
    RUNPH(30, phase_diff(p, lds););
    RUNPH(31, phase_scores(p, lds););
    SEAM(3);
    RUNPH(4, const int lane_ = opaque_tid() & 63; phase_dsa(p, lds, wave, lane_, a.probe););
    SEAM(4);
    RUNPH(8, phase_oproj(p, lds););
    SEAM(8);
    RUNPH(5,
        SchedMix S{1024, (int)gridDim.x, (int)blockIdx.x, (const char*)WSP(bf16_t, WS_OZA), (const char*)WSP(bf16_t, WS_WOA), (const char*)WSP(bf16_t, WS_OZB), (const char*)WSP(bf16_t, WS_WOB)};
        EpiMix E{WSP(const bf16_t, WS_GA), WSP(const bf16_t, WS_GB), WSP(bf16_t, WS_MIX)};
        pg8::gemm_phase<EpiMix, SchedMix>(lds, S, E););
    SEAM(5);
    if (gridDim.x == 256) {
        RUNPH(6,
            SchedOut S{DM, (int)gridDim.x, (int)blockIdx.x, (const char*)WSP(bf16_t, WS_MIX), (const char*)WSP(bf16_t, WS_WOUT)};
            EpiOutFused E{p.x, p.post_w, p.out, WSP(float, WS_SSQ), WSP(unsigned, WS_CTL) + 8192, lds};
            pg8::gemm_phase<EpiOutFused, SchedOut>(lds, S, E););
    } else {
        RUNPH(6,
            SchedOut S{DM, (int)gridDim.x, (int)blockIdx.x, (const char*)WSP(bf16_t, WS_MIX), (const char*)WSP(bf16_t, WS_WOUT)};
            EpiOut E{WSP(bf16_t, WS_OUTPRE), WSP(float, WS_SSQ)};
            pg8::gemm_phase<EpiOut, SchedOut>(lds, S, E););
        SEAM(6);
        RUNPH(7, const int lane_ = opaque_tid() & 63; phase7(p, gw, ngw, lane_););
    }
#undef RUNPH
#undef IN
#undef SEAM
}

static void add_job(Params& p, const float* src, bf16_t* dst, int K, int N, int col0, int ncols, int row0) {
    TJob& j = p.jobs[p.njobs++]; j.src = src; j.dst = dst; j.K = K; j.N = N; j.col0 = col0; j.nblk = (ncols + 31) / 32; j.row0 = row0; j.item0 = p.nitems; p.nitems += (K / 64) * j.nblk;
}
extern "C" void kernel_launch(void* const* d_in, const int* in_sizes, int n_in, void* d_out, int out_size, void* d_ws, size_t ws_size, hipStream_t stream) {
    if (n_in != 16 || ws_size < WS_END) { fprintf(stderr, "kernel_launch: unexpected arguments (n_in %d, ws %zu)\n", n_in, ws_size); return; }
    static int grid = 0;
    if (!grid) {
        int dev = 0, cus = 0, per_cu = 0;
        (void)hipGetDevice(&dev); (void)hipDeviceGetAttribute(&cus, hipDeviceAttributeMultiprocessorCount, dev);
        (void)hipFuncSetAttribute((const void*)k_fwd, hipFuncAttributeMaxDynamicSharedMemorySize, LDS_BYTES);
        (void)hipOccupancyMaxActiveBlocksPerMultiprocessor(&per_cu, (const void*)k_fwd, 512, LDS_BYTES);
        (void)hipGetLastError();
        grid = cus > 0 ? cus : 256;
        if (per_cu < 1) fprintf(stderr, "kernel_launch: occupancy query reports %d blocks per CU\n", per_cu);
    }
    KArgs a; memset(&a, 0, sizeof(a));
    Params& p = a.p;
    const float** in = (const float**)d_in;
    p.x = in[0]; p.meta = in[1]; p.rel_bias = in[2]; p.pre_w = in[3]; p.w_in = in[4]; p.kv_norm_w = in[5]; p.w_uk = in[6]; p.w_uv = in[7]; p.ikn_w = in[8]; p.ikn_b = in[9];
    p.lam_p = in[10]; p.subln_w = in[11]; p.w_o_a = in[12]; p.w_o_b = in[13]; p.w_out = in[14]; p.post_w = in[15];
    p.out = (float*)d_out; p.ws = (unsigned char*)d_ws;
    bf16_t* WIN = (bf16_t*)(p.ws + WS_WIN);
    const int NIN = 11600;
    add_job(p, p.w_in, WIN, DM, NIN, 0, 1024, 0);
    add_job(p, p.w_in, WIN, DM, NIN, 1280, 1024, 1024);
    add_job(p, p.w_in, WIN, DM, NIN, 2304, 1024, 2048);
    add_job(p, p.w_in, WIN, DM, NIN, 3408, 1024, 3072);
    add_job(p, p.w_in, WIN, DM, NIN, 6480, 1024, 4096);
    add_job(p, p.w_in, WIN, DM, NIN, 7504, 2048, 5120);
    add_job(p, p.w_in, WIN, DM, NIN, 9552, 2048, 7168);
    add_job(p, p.w_in, WIN, DM, NIN, 4432, 1024, 9216);
    add_job(p, p.w_in, WIN, DM, NIN, 5456, 1024, 10240);
    add_job(p, p.w_in, WIN, DM, NIN, 1024, 256, 11264);
    add_job(p, p.w_in, WIN, DM, NIN, 3328, 32, 11520);
    add_job(p, p.w_in, WIN, DM, NIN, 3392, 32, 11520 + 32);
    add_job(p, p.w_in, WIN, DM, NIN, 3360, 32, 11520 + 128);
    add_job(p, p.w_o_a, (bf16_t*)(p.ws + WS_WOA), 1024, DM, 0, DM, 0);
    add_job(p, p.w_o_b, (bf16_t*)(p.ws + WS_WOB), 1024, DM, 0, DM, 0);
    add_job(p, p.w_out, (bf16_t*)(p.ws + WS_WOUT), DM, DM, 0, DM, 0);
    add_job(p, p.w_uv, (bf16_t*)(p.ws + WS_WUVT), 256, 1024, 0, 1024, 0);
    (void)hipMemsetAsync((char*)d_ws + WS_CTL, 0, CTL_BYTES, stream);
#if ONE_LAUNCH
    a.ph_lo = 0; a.ph_hi = NPHASE; a.probe = PROBE_REP;
    hipLaunchKernelGGL(k_fwd, dim3(grid), dim3(512), LDS_BYTES, stream, a);
#else
    for (int ph = 0; ph < NPHASE; ++ph) { a.ph_lo = ph; a.ph_hi = ph + 1; hipLaunchKernelGGL(k_fwd, dim3(grid), dim3(512), LDS_BYTES, stream, a); }
#endif
}
```

```cpp
#include <hip/hip_runtime.h>
#include <cstdio>
#include <cstdint>
#include <cstring>

#ifndef PROBE_REP
#define PROBE_REP (-1)
#endif
#define LAS __attribute__((address_space(3)))
#define GAS __attribute__((address_space(1)))
typedef unsigned short bf16_t;
typedef short bf16x8 __attribute__((ext_vector_type(8)));
typedef float f32x4 __attribute__((ext_vector_type(4)));
typedef unsigned u32x4 __attribute__((ext_vector_type(4)));
typedef unsigned u32x2 __attribute__((ext_vector_type(2)));

constexpr int DM = 2048, NB = 2, SEQ = 4096, NMETA = 16, TK = SEQ + NMETA  , MTOK = NB * SEQ  , MKEY = NB * TK  ;
constexpr int UROWS = 8448;
constexpr int NPAD = 11776;
constexpr float EPS = 1e-6f;
constexpr float LOG2E = 1.4426950408889634f;
constexpr size_t SC_PER_B = 8585216;

constexpr size_t MiB = 1u << 20;
constexpr size_t WS_CTL = 0, CTL_BYTES = 1 * MiB;
constexpr size_t WS_U = 1 * MiB;
constexpr size_t WS_WIN = 34 * MiB;
constexpr size_t WS_SC = 1 * MiB;
constexpr size_t WS_MIX = 1 * MiB;
constexpr size_t WS_WOA = 80 * MiB, WS_WOB = 84 * MiB, WS_WOUT = 88 * MiB, WS_WUK = 96 * MiB, WS_WUVT = 96 * MiB + 512 * 1024;
constexpr size_t WS_QA = 97 * MiB, WS_IQ = 113 * MiB, WS_QB = 129 * MiB, WS_ZA = 145 * MiB, WS_ZB = 161 * MiB, WS_GA = 177 * MiB, WS_GB = 209 * MiB;
constexpr size_t WS_OLAT = 241 * MiB;
constexpr size_t WS_OZA = 129 * MiB;
constexpr size_t WS_KB = 241 * MiB, WS_VB = 258 * MiB, WS_CKVRAW = 275 * MiB, WS_IKRAW = 284 * MiB, WS_IW = 287 * MiB, WS_CKV = 288 * MiB, WS_IK = 293 * MiB;
constexpr size_t WS_QLAT = 295 * MiB;
constexpr size_t WS_OUTPRE = 295 * MiB;
constexpr size_t WS_OZB = 327 * MiB, WS_SSQ = 343 * MiB, WS_END = 344 * MiB;

__device__ __forceinline__ int opaque_tid() { int t = threadIdx.x; asm volatile("" : "+v"(t)); return t; }
__device__ __forceinline__ float bf2f(unsigned short u) { return __uint_as_float(((unsigned)u) << 16); }
__device__ __forceinline__ unsigned f2bf(float f) { unsigned u = __float_as_uint(f); return (u + 0x7fffu + ((u >> 16) & 1u)) >> 16; }
__device__ __forceinline__ unsigned pk2(float lo, float hi) { return f2bf(lo) | (f2bf(hi) << 16); }
__device__ __forceinline__ float bflo(unsigned w) { return __uint_as_float(w << 16); }
__device__ __forceinline__ float bfhi(unsigned w) { return __uint_as_float(w & 0xffff0000u); }
__device__ __forceinline__ float wave_sum(float v) {
#pragma unroll
    for (int o = 1; o < 64; o <<= 1) v += __shfl_xor(v, o);
    return v;
}
__device__ __forceinline__ float silu_f(float x) { return x * __builtin_amdgcn_rcpf(1.f + __expf(-x)); }
__device__ __forceinline__ int t5_bucket(int rel) {
    const int n = rel < 0 ? -rel : rel; int f;
    if (n < 8) f = n; else if (n < 12) f = 8; else if (n < 16) f = 9; else if (n < 23) f = 10; else if (n < 32) f = 11; else if (n < 46) f = 12; else if (n < 64) f = 13; else if (n < 91) f = 14; else f = 15;
    return (rel > 0 ? 16 : 0) + f;
}
__device__ __forceinline__ size_t sc_off(int b, int j) {
    const int c = 1 + (j >> 6);
    return (size_t)b * SC_PER_B + (size_t)1024 * (c - 1) + (size_t)2048 * (c - 1) * c + (size_t)(j & 63) * (16 + 64 * c);
}

namespace pg8 {
constexpr int BM = 256, BK = 64, HALF = 128, HTB = HALF * BK * 2, STAGE_BYTES = 8 * HTB, NXCD = 8, WGM = 8;
__host__ __device__ __forceinline__ int lds_byte(int r, int c) { const int st = (r >> 4) * 2 + (c >> 5), rr = r & 15, cc = c & 31, ob = rr * 64 + cc * 2; return st * 1024 + (ob ^ (((ob >> 9) & 1) << 5)); }
__host__ __device__ __forceinline__ void stage_rc(int b, int& R, int& C) { const int st = b / 1024, sb = b % 1024, swz = sb ^ (((sb >> 9) & 1) << 5); R = (st >> 1) * 16 + swz / 64; C = (st & 1) * 32 + (swz % 64) / 2; }
__host__ __device__ __forceinline__ int perm32(int rho) { const int n = rho >> 4, i = rho & 15; return 8 * (i >> 2) + 4 * n + (i & 3); }

struct Unit { int pm, pn, sub; };
__device__ __forceinline__ unsigned cvt_pk_bf16(float lo, float hi) { unsigned r; asm volatile("v_cvt_pk_bf16_f32 %0, %1, %2" : "=v"(r) : "v"(lo), "v"(hi)); return r; }

__device__ __forceinline__ void tile_of(int L, int nM, int nN, int& pm, int& pn) {
    const int nwg = nM * nN; int wgid = L; { const int q = nwg / NXCD, r = nwg % NXCD, xcd = wgid % NXCD, off = wgid / NXCD; wgid = (xcd < r ? xcd * (q + 1) : r * (q + 1) + (xcd - r) * q) + off; }
    const int nig = WGM * nN, gid = wgid / nig, fm = gid * WGM, gsz = (nM - fm) < WGM ? (nM - fm) : WGM;
    pm = fm + ((wgid % nig) % gsz); pn = (wgid % nig) / gsz;
}

template <class Epi, class Sched, bool ALIGN_EPI = true, bool SP2 = true>
__device__ __forceinline__ void gemm_phase(LAS unsigned char* lds, const Sched& S, const Epi& E) {
    const int tid = opaque_tid(), wid = __builtin_amdgcn_readfirstlane(tid >> 6), lane = tid & 63, wr = wid >> 2, wc = wid & 3, fr = lane & 15, fq = lane >> 4;
    const int K = S.K, nt = K / BK;
    unsigned voffA[2], voffB[2];
#pragma unroll
    for (int i = 0; i < 2; ++i) { int R, C; stage_rc(tid * 16 + i * 8192, R, C); const int Rb = Epi::PERM ? ((R & ~31) + perm32(R & 31)) : R;
        voffA[i] = (unsigned)(R * K + C) * 2u; voffB[i] = (unsigned)(Rb * K + C) * 2u; }
    const size_t kstep = (size_t)(BK * 2);
    const size_t hstep = (size_t)HALF * K * 2;
    const unsigned ldsw = (unsigned)wid * 1024u;
    const int aoff = lds_byte(wr * 64 + fr, fq * 8), boff = lds_byte(wc * 32 + fr, fq * 8);
#define PG8_SA(b, h) (((b) * 2 + (h)) * HTB)
#define PG8_SB(b, h) ((4 + (b) * 2 + (h)) * HTB)
#define PG8_STAGE(bufoff, gbase, voff) do { _Pragma("unroll") for (int _i = 0; _i < 2; ++_i) \
        __builtin_amdgcn_global_load_lds((const unsigned*)((const char*)(gbase) + (voff)[_i]), (LAS unsigned*)(lds + (bufoff) + ldsw + _i * 8192), 16, 0, 0); } while (0)
#define PG8_LDA(dst, b, h) do { _Pragma("unroll") for (int m = 0; m < 4; ++m) _Pragma("unroll") for (int k = 0; k < 2; ++k) dst[m][k] = *(const LAS bf16x8*)(lds + PG8_SA(b, h) + aoff + m * 2048 + k * 1024); } while (0)
#define PG8_LDB(dst, b, h) do { _Pragma("unroll") for (int n = 0; n < 2; ++n) _Pragma("unroll") for (int k = 0; k < 2; ++k) dst[n][k] = *(const LAS bf16x8*)(lds + PG8_SB(b, h) + boff + n * 2048 + k * 1024); } while (0)
#define PG8_MMA(ai, bj, At, Bt) do { __builtin_amdgcn_s_setprio(1); _Pragma("unroll") for (int m = 0; m < 4; ++m) _Pragma("unroll") for (int n = 0; n < 2; ++n) _Pragma("unroll") for (int k = 0; k < 2; ++k) \
        acc[ai][bj][m][n] = __builtin_amdgcn_mfma_f32_16x16x32_bf16(Bt[n][k], At[m][k], acc[ai][bj][m][n], 0, 0, 0); __builtin_amdgcn_s_setprio(0); } while (0)
#define PG8_WAIT_V(n) asm volatile("s_waitcnt vmcnt(" #n ")" ::: "memory")
#define PG8_WAIT_L(n) asm volatile("s_waitcnt lgkmcnt(" #n ")" ::: "memory")
#define PG8_BAR __builtin_amdgcn_s_barrier()
#define PG8_SCHED __builtin_amdgcn_sched_barrier(0)
    Unit cur, nxt; int ui = 0;
    if (!S.next(0, cur)) return;
    f32x4 acc[2][2][4][2];
#pragma unroll
    for (int a = 0; a < 2; ++a)
#pragma unroll
        for (int b = 0; b < 2; ++b)
#pragma unroll
            for (int m = 0; m < 4; ++m)
#pragma unroll
                for (int n = 0; n < 2; ++n) acc[a][b][m][n] = (f32x4){0.f, 0.f, 0.f, 0.f};
    bf16x8 At[4][2], B0[2][2], B1[2][2];
    const char* cA = S.a_ptr(cur); const char* cB = S.b_ptr(cur);
    if constexpr (SP2) {
        PG8_STAGE(PG8_SB(0, 0), cB, voffB); PG8_STAGE(PG8_SB(0, 1), cB + hstep, voffB); PG8_STAGE(PG8_SA(0, 0), cA, voffA); PG8_STAGE(PG8_SA(0, 1), cA + hstep, voffA);
        if (wr == 1) PG8_BAR;
        PG8_WAIT_V(2); PG8_BAR;
        PG8_STAGE(PG8_SB(1, 0), cB + kstep, voffB); PG8_STAGE(PG8_SA(1, 0), cA + kstep, voffA); PG8_STAGE(PG8_SB(1, 1), cB + hstep + kstep, voffB);
        PG8_WAIT_V(6); PG8_BAR;
    } else {
        PG8_STAGE(PG8_SB(0, 0), cB, voffB); PG8_STAGE(PG8_SA(0, 0), cA, voffA); PG8_STAGE(PG8_SB(0, 1), cB + hstep, voffB); PG8_STAGE(PG8_SA(0, 1), cA + hstep, voffA);
        if (wr == 1) PG8_BAR;
        PG8_WAIT_V(4); PG8_BAR;
        PG8_STAGE(PG8_SB(1, 0), cB + kstep, voffB); PG8_STAGE(PG8_SA(1, 0), cA + kstep, voffA); PG8_STAGE(PG8_SB(1, 1), cB + hstep + kstep, voffB);
        PG8_WAIT_V(6); PG8_BAR;
    }
    for (;;) {
        const bool has_next = S.next(ui + 1, nxt);
        const char* nA = has_next ? S.a_ptr(nxt) : cA; const char* nB = has_next ? S.b_ptr(nxt) : cB;
        for (int t = 0; t < nt; t += 2) {
            const bool last = (t == nt - 2);
            const char* a1 = cA + (size_t)(t + 1) * kstep;
            const char* a2 = last ? nA : cA + (size_t)(t + 2) * kstep; const char* b2 = last ? nB : cB + (size_t)(t + 2) * kstep;
            const char* a3 = a2 + kstep; const char* b3 = b2 + kstep;
            if constexpr (SP2) {
            PG8_LDB(B0, 0, 0); PG8_LDB(B1, 0, 1); PG8_SCHED; PG8_LDA(At, 0, 0); PG8_STAGE(PG8_SA(1, 1), a1 + hstep, voffA);
            PG8_WAIT_V(8); PG8_WAIT_L(0); PG8_BAR; PG8_MMA(0, 0, At, B0); PG8_MMA(0, 1, At, B1); PG8_BAR; PG8_SCHED;
            PG8_LDA(At, 0, 1); PG8_STAGE(PG8_SB(0, 0), b2, voffB); PG8_STAGE(PG8_SB(0, 1), b2 + hstep, voffB); PG8_STAGE(PG8_SA(0, 0), a2, voffA);
            PG8_WAIT_V(8); PG8_WAIT_L(0); PG8_BAR; PG8_MMA(1, 0, At, B0); PG8_MMA(1, 1, At, B1); PG8_BAR; PG8_SCHED;
            PG8_LDB(B0, 1, 0); PG8_LDB(B1, 1, 1); PG8_SCHED; PG8_LDA(At, 1, 0); PG8_STAGE(PG8_SA(0, 1), a2 + hstep, voffA);
            PG8_WAIT_V(8); PG8_WAIT_L(0); PG8_BAR; PG8_MMA(0, 0, At, B0); PG8_MMA(0, 1, At, B1); PG8_BAR; PG8_SCHED;
            PG8_LDA(At, 1, 1); PG8_STAGE(PG8_SB(1, 0), b3, voffB); PG8_STAGE(PG8_SB(1, 1), b3 + hstep, voffB); PG8_STAGE(PG8_SA(1, 0), a3, voffA);
            PG8_WAIT_V(8); PG8_WAIT_L(0); PG8_BAR; PG8_MMA(1, 0, At, B0); PG8_MMA(1, 1, At, B1); PG8_BAR; PG8_SCHED;
            } else {
            PG8_LDB(B0, 0, 0); PG8_SCHED; PG8_LDA(At, 0, 0); PG8_STAGE(PG8_SA(1, 1), a1 + hstep, voffA);
            PG8_WAIT_L(8); PG8_BAR; PG8_WAIT_L(0); PG8_MMA(0, 0, At, B0); PG8_BAR; PG8_SCHED;
            PG8_LDB(B1, 0, 1); PG8_STAGE(PG8_SB(0, 0), b2, voffB);
            PG8_BAR; PG8_WAIT_L(0); PG8_MMA(0, 1, At, B1); PG8_BAR;
            PG8_LDA(At, 0, 1); PG8_STAGE(PG8_SA(0, 0), a2, voffA);
            PG8_BAR; PG8_WAIT_L(0); PG8_MMA(1, 0, At, B0); PG8_BAR; PG8_SCHED;
            PG8_STAGE(PG8_SB(0, 1), b2 + hstep, voffB);
            PG8_WAIT_V(6); PG8_BAR; PG8_MMA(1, 1, At, B1); PG8_BAR;
            PG8_LDB(B0, 1, 0); PG8_SCHED; PG8_LDA(At, 1, 0); PG8_STAGE(PG8_SA(0, 1), a2 + hstep, voffA);
            PG8_WAIT_L(8); PG8_BAR; PG8_WAIT_L(0); PG8_MMA(0, 0, At, B0); PG8_BAR; PG8_SCHED;
            PG8_LDB(B1, 1, 1); PG8_STAGE(PG8_SB(1, 0), b3, voffB);
            PG8_BAR; PG8_WAIT_L(0); PG8_MMA(0, 1, At, B1); PG8_BAR;
            PG8_LDA(At, 1, 1); PG8_STAGE(PG8_SA(1, 0), a3, voffA);
            PG8_BAR; PG8_WAIT_L(0); PG8_MMA(1, 0, At, B0); PG8_BAR; PG8_SCHED;
            PG8_STAGE(PG8_SB(1, 1), b3 + hstep, voffB);
            PG8_WAIT_V(6); PG8_BAR; PG8_MMA(1, 1, At, B1); PG8_BAR;
            }
        }
        if constexpr (ALIGN_EPI) { if (wr == 0) PG8_BAR; }
        E(acc, cur, wr, wc, fr, fq);
        if (!has_next) break;
        if (!E.keep_acc(cur)) {
#pragma unroll
        for (int a = 0; a < 2; ++a)
#pragma unroll
            for (int b = 0; b < 2; ++b)
#pragma unroll
                for (int m = 0; m < 4; ++m)
#pragma unroll
                    for (int n = 0; n < 2; ++n) acc[a][b][m][n] = (f32x4){0.f, 0.f, 0.f, 0.f};
        }
        cur = nxt; cA = nA; cB = nB; ++ui;
        if constexpr (ALIGN_EPI) { if (wr == 1) PG8_BAR; }
    }
    PG8_WAIT_V(0);
    if constexpr (!ALIGN_EPI) { if (wr == 0) PG8_BAR; }
    PG8_BAR;
#undef PG8_SA
#undef PG8_SB
#undef PG8_STAGE
#undef PG8_LDA
#undef PG8_LDB
#undef PG8_MMA
#undef PG8_WAIT_V
#undef PG8_WAIT_L
#undef PG8_BAR
#undef PG8_SCHED
}
}

struct SchedInproj {
    int K, G, c; const char* A; const char* B;
    __device__ __forceinline__ bool next(int i, pg8::Unit& u) const {
        const int L = i * G + c; u.sub = 0;
        if (L < 1472) { pg8::tile_of(L, 32, 46, u.pm, u.pn); return true; }
        if (L < 1482) { u.pm = 32; u.pn = 36 + (L - 1472); return true; }
        return false;
    }
    __device__ __forceinline__ const char* a_ptr(const pg8::Unit& u) const { return A + (size_t)u.pm * 256 * K * 2; }
    __device__ __forceinline__ const char* b_ptr(const pg8::Unit& u) const { return B + (size_t)u.pn * 256 * K * 2; }
};
struct EpiInproj {
    static constexpr bool PERM = true;
    bf16_t *QA, *ZA, *IQ, *QB, *ZB, *GA, *GB, *KB, *VB; float *CKVRAW; bf16_t* IKN; float* IW; float qb_scale; const float *ikn_w, *ikn_b;
    __device__ __forceinline__ bool keep_acc(const pg8::Unit&) const { return false; }
    __device__ __forceinline__ void operator()(f32x4 (&acc)[2][2][4][2], const pg8::Unit& u, int wr, int wc, int fr, int fq) const {
        const int pn = u.pn;
        if (pn < 44) {
            bf16_t* base; int ldc = 1024, ct, act = 0; bool kside = false;
            if (pn < 4) { base = QA; ct = pn; } else if (pn < 8) { base = ZA; ct = pn - 4; act = 1; } else if (pn < 12) { base = IQ; ct = pn - 8; }
            else if (pn < 16) { base = QB; ct = pn - 12; act = 2; } else if (pn < 20) { base = ZB; ct = pn - 16; act = 1; }
            else if (pn < 28) { base = GA; ct = pn - 20; ldc = 2048; } else if (pn < 36) { base = GB; ct = pn - 28; ldc = 2048; }
            else if (pn < 40) { base = KB; ct = pn - 36; kside = true; } else { base = VB; ct = pn - 40; kside = true; }
            const float sc = (act == 2) ? qb_scale : 1.f;
#pragma unroll
            for (int ai = 0; ai < 2; ++ai)
#pragma unroll
                for (int m = 0; m < 4; ++m) {
                    const int r = u.pm * 256 + ai * 128 + wr * 64 + m * 16 + fr;
                    long drow = r, drow2 = -1; bool ok = true;
                    if (kside) { if (r < MTOK) drow = (long)(r >> 12) * TK + NMETA + (r & 4095); else { const int i = r - MTOK; ok = i < NMETA; drow = i; drow2 = TK + i; } }
#pragma unroll
                    for (int bj = 0; bj < 2; ++bj) {
                        f32x4 v0 = acc[ai][bj][m][0], v1 = acc[ai][bj][m][1];
                        if (act == 1) {
#pragma unroll
                            for (int e = 0; e < 4; ++e) { v0[e] = silu_f(v0[e]); v1[e] = silu_f(v1[e]); }
                        }
                        v0 = v0 * sc; v1 = v1 * sc;
                        u32x4 w; w.x = pg8::cvt_pk_bf16(v0[0], v0[1]); w.y = pg8::cvt_pk_bf16(v0[2], v0[3]); w.z = pg8::cvt_pk_bf16(v1[0], v1[1]); w.w = pg8::cvt_pk_bf16(v1[2], v1[3]);
                        const int col = ct * 256 + bj * 128 + wc * 32 + 8 * fq;
                        if (ok) { *(u32x4*)(base + (size_t)drow * ldc + col) = w; if (drow2 >= 0) *(u32x4*)(base + (size_t)drow2 * ldc + col) = w; }
                    }
                }
        } else {
#pragma unroll
            for (int ai = 0; ai < 2; ++ai)
#pragma unroll
                for (int m = 0; m < 4; ++m) {
                    const int r = u.pm * 256 + ai * 128 + wr * 64 + m * 16 + fr;
                    long drow, drow2 = -1; bool ok = true;
                    if (r < MTOK) drow = (long)(r >> 12) * TK + NMETA + (r & 4095); else { const int i = r - MTOK; ok = i < NMETA; drow = i; drow2 = TK + i; }
                    if (pn == 44) {
#pragma unroll
                        for (int bj = 0; bj < 2; ++bj) {
                            const f32x4 v0 = acc[ai][bj][m][0], v1 = acc[ai][bj][m][1];
                            const int col = bj * 128 + wc * 32 + 8 * fq;
                            if (ok) { float* p = CKVRAW + (size_t)drow * 256 + col; *(f32x4*)p = v0; *(f32x4*)(p + 4) = v1;
                                      if (drow2 >= 0) { float* p2 = CKVRAW + (size_t)drow2 * 256 + col; *(f32x4*)p2 = v0; *(f32x4*)(p2 + 4) = v1; } }
                        }
                    } else if (wc == 0) {
                        const f32x4 a0 = acc[ai][0][m][0], a1 = acc[ai][0][m][1], b0 = acc[ai][1][m][0], b1 = acc[ai][1][m][1];
                        float s = ((a0[0] + a0[1]) + (a0[2] + a0[3])) + ((a1[0] + a1[1]) + (a1[2] + a1[3])) + ((b0[0] + b0[1]) + (b0[2] + b0[3])) + ((b1[0] + b1[1]) + (b1[2] + b1[3]));
                        s += __shfl_xor(s, 16); s += __shfl_xor(s, 32);
                        const float mu = s * (1.f / 64.f);
                        const f32x4 da0 = a0 - mu, da1 = a1 - mu, db0 = b0 - mu, db1 = b1 - mu;
                        float q = ((da0[0] * da0[0] + da0[1] * da0[1]) + (da0[2] * da0[2] + da0[3] * da0[3])) + ((da1[0] * da1[0] + da1[1] * da1[1]) + (da1[2] * da1[2] + da1[3] * da1[3]))
                                + ((db0[0] * db0[0] + db0[1] * db0[1]) + (db0[2] * db0[2] + db0[3] * db0[3])) + ((db1[0] * db1[0] + db1[1] * db1[1]) + (db1[2] * db1[2] + db1[3] * db1[3]));
                        q += __shfl_xor(q, 16); q += __shfl_xor(q, 32);
                        const float rs = rsqrtf(q * (1.f / 64.f) + EPS);
                        const f32x4 wa0 = *(const f32x4*)(ikn_w + 8 * fq), wa1 = *(const f32x4*)(ikn_w + 8 * fq + 4), wb0 = *(const f32x4*)(ikn_w + 32 + 8 * fq), wb1 = *(const f32x4*)(ikn_w + 36 + 8 * fq);
                        const f32x4 ba0 = *(const f32x4*)(ikn_b + 8 * fq), ba1 = *(const f32x4*)(ikn_b + 8 * fq + 4), bb0 = *(const f32x4*)(ikn_b + 32 + 8 * fq), bb1 = *(const f32x4*)(ikn_b + 36 + 8 * fq);
                        const f32x4 ya0 = da0 * rs * wa0 + ba0, ya1 = da1 * rs * wa1 + ba1, yb0 = db0 * rs * wb0 + bb0, yb1 = db1 * rs * wb1 + bb1;
                        u32x4 pa, pb;
                        pa.x = pg8::cvt_pk_bf16(ya0[0], ya0[1]); pa.y = pg8::cvt_pk_bf16(ya0[2], ya0[3]); pa.z = pg8::cvt_pk_bf16(ya1[0], ya1[1]); pa.w = pg8::cvt_pk_bf16(ya1[2], ya1[3]);
                        pb.x = pg8::cvt_pk_bf16(yb0[0], yb0[1]); pb.y = pg8::cvt_pk_bf16(yb0[2], yb0[3]); pb.z = pg8::cvt_pk_bf16(yb1[0], yb1[1]); pb.w = pg8::cvt_pk_bf16(yb1[2], yb1[3]);
                        if (ok) { *(u32x4*)(IKN + (size_t)drow * 64 + 8 * fq) = pa; *(u32x4*)(IKN + (size_t)drow * 64 + 32 + 8 * fq) = pb;
                                  if (drow2 >= 0) { *(u32x4*)(IKN + (size_t)drow2 * 64 + 8 * fq) = pa; *(u32x4*)(IKN + (size_t)drow2 * 64 + 32 + 8 * fq) = pb; } }
                    } else if (wc == 1) {
                        const f32x4 v0 = acc[ai][0][m][0], v1 = acc[ai][0][m][1];
                        if (fq < 2 && r < MTOK) { float* p = IW + (size_t)r * 16 + 8 * fq; *(f32x4*)p = v0 * 0.03125f; *(f32x4*)(p + 4) = v1 * 0.03125f; }
                    }
                }
        }
    }
};
struct SchedMix {
    int K, G, c; const char *A0, *B0, *A1, *B1;
    __device__ __forceinline__ bool next(int i, pg8::Unit& u) const {
        const int L = (i >> 1) * G + c; if (L >= 256) return false;
        pg8::tile_of(L, 32, 8, u.pm, u.pn); u.sub = i & 1; return true;
    }
    __device__ __forceinline__ const char* a_ptr(const pg8::Unit& u) const { return (u.sub ? A1 : A0) + (size_t)u.pm * 256 * K * 2; }
    __device__ __forceinline__ const char* b_ptr(const pg8::Unit& u) const { return (u.sub ? B1 : B0) + (size_t)u.pn * 256 * K * 2; }
};
struct EpiMix {
    static constexpr bool PERM = true;
    const bf16_t *GA, *GB; bf16_t* MIX;
    __device__ __forceinline__ bool keep_acc(const pg8::Unit& u) const { return u.sub == 0; }
    static __device__ __forceinline__ float sg_e(float a) { return __expf(-fminf(fmaxf(a, -30.f), 30.f)); }
    __device__ __forceinline__ void operator()(f32x4 (&acc)[2][2][4][2], const pg8::Unit& u, int wr, int wc, int fr, int fq) const {
        const size_t base = (size_t)(u.pm * 256 + wr * 64 + fr) * DM + u.pn * 256 + wc * 32 + 8 * fq;
        if (u.sub == 0) {
#pragma unroll
            for (int ai = 0; ai < 2; ++ai) {
                u32x4 ga[4][2], gb[4][2];
#pragma unroll
                for (int m = 0; m < 4; ++m)
#pragma unroll
                    for (int bj = 0; bj < 2; ++bj) { const size_t o = base + (size_t)(ai * 128 + m * 16) * DM + bj * 128; ga[m][bj] = *(const u32x4*)(GA + o); gb[m][bj] = *(const u32x4*)(GB + o); }
#pragma unroll
                for (int m = 0; m < 4; ++m)
#pragma unroll
                    for (int bj = 0; bj < 2; ++bj)
#pragma unroll
                        for (int e = 0; e < 4; ++e) {
                            const unsigned wa = ga[m][bj][e], wb = gb[m][bj][e];
                            const float f0 = (1.f + sg_e(bflo(wb))) * __builtin_amdgcn_rcpf(1.f + sg_e(bflo(wa))), f1 = (1.f + sg_e(bfhi(wb))) * __builtin_amdgcn_rcpf(1.f + sg_e(bfhi(wa)));
                            const int n = e >> 1, j = (e & 1) * 2;
                            acc[ai][bj][m][n][j] *= f0; acc[ai][bj][m][n][j + 1] *= f1;
                        }
            }
        } else {
            u32x4 gb[2][4][2];
#pragma unroll
            for (int m = 0; m < 4; ++m)
#pragma unroll
                for (int bj = 0; bj < 2; ++bj) gb[0][m][bj] = *(const u32x4*)(GB + base + (size_t)(m * 16) * DM + bj * 128);
#pragma unroll
            for (int ai = 0; ai < 2; ++ai) {
                if (ai == 0) {
#pragma unroll
                    for (int m = 0; m < 4; ++m)
#pragma unroll
                        for (int bj = 0; bj < 2; ++bj) gb[1][m][bj] = *(const u32x4*)(GB + base + (size_t)(128 + m * 16) * DM + bj * 128);
                }
#pragma unroll
                for (int m = 0; m < 4; ++m)
#pragma unroll
                    for (int bj = 0; bj < 2; ++bj) {
                        float v[8];
#pragma unroll
                        for (int e = 0; e < 4; ++e) {
                            const unsigned wb = gb[ai][m][bj][e]; const int n = e >> 1, j = (e & 1) * 2;
                            v[2 * e] = acc[ai][bj][m][n][j] * __builtin_amdgcn_rcpf(1.f + sg_e(bflo(wb))); v[2 * e + 1] = acc[ai][bj][m][n][j + 1] * __builtin_amdgcn_rcpf(1.f + sg_e(bfhi(wb)));
                        }
                        u32x4 w; w.x = pg8::cvt_pk_bf16(v[0], v[1]); w.y = pg8::cvt_pk_bf16(v[2], v[3]); w.z = pg8::cvt_pk_bf16(v[4], v[5]); w.w = pg8::cvt_pk_bf16(v[6], v[7]);
                        *(u32x4*)(MIX + base + (size_t)(ai * 128 + m * 16) * DM + bj * 128) = w;
                    }
            }
        }
    }
};
struct SchedOut {
    int K, G, c; const char *A, *B;
    __device__ __forceinline__ bool next(int i, pg8::Unit& u) const { const int L = i * G + c; if (L >= 256) return false; pg8::tile_of(L, 32, 8, u.pm, u.pn); u.sub = 0; return true; }
    __device__ __forceinline__ const char* a_ptr(const pg8::Unit& u) const { return A + (size_t)u.pm * 256 * K * 2; }
    __device__ __forceinline__ const char* b_ptr(const pg8::Unit& u) const { return B + (size_t)u.pn * 256 * K * 2; }
};
struct EpiOut {
    static constexpr bool PERM = true;
    bf16_t* OUTPRE; float* SSQ;
    __device__ __forceinline__ bool keep_acc(const pg8::Unit&) const { return false; }
    __device__ __forceinline__ void operator()(f32x4 (&acc)[2][2][4][2], const pg8::Unit& u, int wr, int wc, int fr, int fq) const {
#pragma unroll
        for (int ai = 0; ai < 2; ++ai)
#pragma unroll
            for (int m = 0; m < 4; ++m) {
                const int r = u.pm * 256 + ai * 128 + wr * 64 + m * 16 + fr; float ss = 0.f;
#pragma unroll
                for (int bj = 0; bj < 2; ++bj) {
                    const f32x4 v0 = acc[ai][bj][m][0], v1 = acc[ai][bj][m][1];
                    ss += (v0[0] * v0[0] + v0[1] * v0[1]) + (v0[2] * v0[2] + v0[3] * v0[3]) + (v1[0] * v1[0] + v1[1] * v1[1]) + (v1[2] * v1[2] + v1[3] * v1[3]);
                    u32x4 w; w.x = pg8::cvt_pk_bf16(v0[0], v0[1]); w.y = pg8::cvt_pk_bf16(v0[2], v0[3]); w.z = pg8::cvt_pk_bf16(v1[0], v1[1]); w.w = pg8::cvt_pk_bf16(v1[2], v1[3]);
                    *(u32x4*)(OUTPRE + (size_t)r * DM + u.pn * 256 + bj * 128 + wc * 32 + 8 * fq) = w;
                }
                ss += __shfl_xor(ss, 16); ss += __shfl_xor(ss, 32);
                if (fq == 0) SSQ[(size_t)r * 32 + u.pn * 4 + wc] = ss;
            }
    }
};

struct EpiOutFused {
    static constexpr bool PERM = false;
    const float* x; const float* post_w; float* out; float* SSQ; unsigned* cnt; LAS unsigned char* lds;
    __device__ __forceinline__ bool keep_acc(const pg8::Unit&) const { return false; }
    __device__ __forceinline__ void operator()(f32x4 (&acc)[2][2][4][2], const pg8::Unit& u, int wr, int wc, int fr, int fq) const {
        const int tid = opaque_tid(), wid = __builtin_amdgcn_readfirstlane(tid >> 6), lane = tid & 63;
        LAS float* S = (LAS float*)(lds + 131072);
#pragma unroll
        for (int ai = 0; ai < 2; ++ai)
#pragma unroll
            for (int m = 0; m < 4; ++m) {
                float ss = 0.f;
#pragma unroll
                for (int bj = 0; bj < 2; ++bj)
#pragma unroll
                    for (int n = 0; n < 2; ++n) { const f32x4 v = acc[ai][bj][m][n]; ss += (v[0] * v[0] + v[1] * v[1]) + (v[2] * v[2] + v[3] * v[3]); }
                ss += __shfl_xor(ss, 16); ss += __shfl_xor(ss, 32);
                if (fq == 0) __hip_atomic_store(SSQ + (size_t)(u.pm * 256 + ai * 128 + wr * 64 + m * 16 + fr) * 32 + u.pn * 4 + wc, ss, __ATOMIC_RELAXED, __HIP_MEMORY_SCOPE_AGENT);
            }
        asm volatile("s_waitcnt vmcnt(0)" ::: "memory");
        if (lane == 0) __hip_atomic_fetch_add(cnt + 64 * u.pm, 1u, __ATOMIC_RELAXED, __HIP_MEMORY_SCOPE_AGENT);
        if (wid == 0) {
            for (unsigned it = 0; it < (1u << 22); ++it) {
                if ((unsigned)__builtin_amdgcn_readfirstlane(__hip_atomic_load(cnt + 64 * u.pm, __ATOMIC_RELAXED, __HIP_MEMORY_SCOPE_AGENT)) >= 64u) break;
                __builtin_amdgcn_s_sleep(2);
            }
            __builtin_amdgcn_fence(__ATOMIC_ACQUIRE, "agent");
        }
        asm volatile("s_waitcnt vmcnt(0) lgkmcnt(0)" ::: "memory"); __builtin_amdgcn_s_barrier(); asm volatile("" ::: "memory");
        if (tid < 256) {
            const unsigned long long* slot = (const unsigned long long*)(SSQ + (size_t)(u.pm * 256 + tid) * 32); float s = 0.f;
#pragma unroll
            for (int t = 0; t < 16; ++t) { const unsigned long long w = __hip_atomic_load(slot + t, __ATOMIC_RELAXED, __HIP_MEMORY_SCOPE_AGENT); s += __uint_as_float((unsigned)w) + __uint_as_float((unsigned)(w >> 32)); }
            S[tid] = rsqrtf(s * (1.f / DM) + EPS);
        }
        asm volatile("s_waitcnt lgkmcnt(0)" ::: "memory"); __builtin_amdgcn_s_barrier(); asm volatile("" ::: "memory");
        const f32x4 g = *(const f32x4*)(post_w + u.pn * 256 + 4 * lane);
        const int lr0 = 4 * wid;
        const size_t gbase = (size_t)(u.pm * 256 + (lr0 >> 4) * 64 + (lr0 & 15)) * DM + u.pn * 256 + 4 * lane;
        const unsigned woff = (unsigned)((wr * 16 + fr) * 1040 + (wc * 32 + 4 * fq) * 4), roff = (unsigned)(lr0 * 1040 + lane * 16);
        f32x4 xv[4], xn[4];
#pragma unroll
        for (int q = 0; q < 4; ++q) xv[q] = __builtin_nontemporal_load((const f32x4*)(x + gbase + (size_t)q * DM));
#pragma unroll
        for (int s = 0; s < 8; ++s) {
            const int ai = s >> 2, m = s & 3; LAS unsigned char* T = lds + (s & 1) * 33280;
            const float rs = S[ai * 128 + wr * 64 + m * 16 + fr];
#pragma unroll
            for (int bj = 0; bj < 2; ++bj)
#pragma unroll
                for (int n = 0; n < 2; ++n) *(LAS f32x4*)(T + woff + bj * 512 + n * 64) = acc[ai][bj][m][n] * rs;
            if (s < 7) {
                const size_t o2 = (size_t)(((s + 1) >> 2) * 128 + ((s + 1) & 3) * 16) * DM;
#pragma unroll
                for (int q = 0; q < 4; ++q) xn[q] = __builtin_nontemporal_load((const f32x4*)(x + gbase + o2 + (size_t)q * DM));
            }
            asm volatile("s_waitcnt lgkmcnt(0)" ::: "memory"); __builtin_amdgcn_s_barrier(); asm volatile("" ::: "memory");
            const size_t o1 = (size_t)(ai * 128 + m * 16) * DM;
#pragma unroll
            for (int q = 0; q < 4; ++q) { const f32x4 v = *(const LAS f32x4*)(T + roff + q * 1040); __builtin_nontemporal_store(xv[q] + v * g, (f32x4*)(out + gbase + o1 + (size_t)q * DM)); }
#pragma unroll
            for (int q = 0; q < 4; ++q) xv[q] = xn[q];
        }
    }
};

struct TJob { const float* src; bf16_t* dst; int K, N, col0, nblk, row0, item0; };
struct Params {
    const float *x, *meta, *rel_bias, *pre_w, *w_in, *kv_norm_w, *w_uk, *w_uv, *ikn_w, *ikn_b, *lam_p, *subln_w, *w_o_a, *w_o_b, *w_out, *post_w;
    float* out; unsigned char* ws;
    TJob jobs[17]; int njobs, nitems;
};
#define WSP(T, off) ((T*)(p.ws + (off)))

__device__ __forceinline__ void p0_transpose_item(const TJob& jb, LAS float* scr, int item, int lane) {
    const int kb = item / jb.nblk, nb = item % jb.nblk, k0 = 64 * kb, n0 = jb.col0 + 32 * nb;
#pragma unroll 8
    for (int i = 0; i < 32; ++i) { const int kk = 2 * i + (lane >> 5); scr[kk * 33 + (lane & 31)] = __builtin_nontemporal_load(jb.src + (size_t)(k0 + kk) * jb.N + n0 + (lane & 31)); }
    asm volatile("s_waitcnt lgkmcnt(0)" ::: "memory");
    const int c = lane & 7;
#pragma unroll
    for (int j = 0; j < 4; ++j) { const int n = (lane >> 3) + 8 * j; const LAS float* s = scr + (8 * c) * 33 + n;
        u32x4 o; o.x = pk2(s[0 * 33], s[1 * 33]); o.y = pk2(s[2 * 33], s[3 * 33]); o.z = pk2(s[4 * 33], s[5 * 33]); o.w = pk2(s[6 * 33], s[7 * 33]);
        *(u32x4*)(jb.dst + (size_t)(jb.row0 + 32 * nb + n) * jb.K + k0 + 8 * c) = o; }
    asm volatile("s_waitcnt lgkmcnt(0)" ::: "memory");
}
__device__ __forceinline__ void p0_norm_row(const float* xrow, const float* g, bf16_t* orow, int lane) {
    const f32x4* xr = (const f32x4*)xrow + lane; const f32x4* gr = (const f32x4*)g + lane;
    f32x4 v[8]; float s = 0.f;
#pragma unroll
    for (int j = 0; j < 8; ++j) { v[j] = __builtin_nontemporal_load(xr + 64 * j); s += (v[j].x * v[j].x + v[j].y * v[j].y) + (v[j].z * v[j].z + v[j].w * v[j].w); }
    const float rstd = rsqrtf(wave_sum(s) * (1.f / DM) + EPS);
    u32x2* o8 = (u32x2*)orow + lane;
#pragma unroll
    for (int j = 0; j < 8; ++j) { const f32x4 gg = gr[64 * j]; u32x2 w; w.x = pk2(v[j].x * rstd * gg.x, v[j].y * rstd * gg.y); w.y = pk2(v[j].z * rstd * gg.z, v[j].w * rstd * gg.w); o8[64 * j] = w; }
}
__device__ __forceinline__ void phase0(const Params& p, LAS unsigned char* lds, int gw, int ngw, int wave, int lane, int item_lo, int item_hi) {
    LAS float* scr = (LAS float*)(lds + wave * 16384);
    for (int it = gw + item_lo; it < item_hi; it += ngw) {
        int jn = 0;
#pragma unroll
        for (int q = 1; q < 17; ++q) if (q < p.njobs && it >= p.jobs[q].item0) jn = q;
        p0_transpose_item(p.jobs[jn], scr, it - p.jobs[jn].item0, lane);
    }
    if (item_lo != 0) return;
    bf16_t* U = WSP(bf16_t, WS_U);
    for (int m = gw; m < UROWS; m += ngw) {
        if (m < MTOK) p0_norm_row(p.x + (size_t)m * DM, p.pre_w, U + (size_t)m * DM, lane);
        else if (m < MTOK + NMETA) p0_norm_row(p.meta + (size_t)(m - MTOK) * DM, p.pre_w, U + (size_t)m * DM, lane);
        else { u32x4* o = (u32x4*)(U + (size_t)m * DM) + lane;
#pragma unroll
            for (int j = 0; j < 4; ++j) o[64 * j] = (u32x4){0u, 0u, 0u, 0u}; }
    }
    bf16_t* WUK = WSP(bf16_t, WS_WUK);
    for (int i = gw * 64 + lane; i < 262144 / 4; i += ngw * 64) { const f32x4 v = ((const f32x4*)p.w_uk)[i]; u32x2 w; w.x = pk2(v.x, v.y); w.y = pk2(v.z, v.w); ((u32x2*)WUK)[i] = w; }
}

__device__ __forceinline__ void phase_ckvnorm(const Params& p, int gw, int ngw, int lane) {
    const float* CKVRAW = WSP(const float, WS_CKVRAW); bf16_t* CKV = WSP(bf16_t, WS_CKV);
    for (int r = gw; r < MKEY; r += ngw) {
        const f32x4 v = ((const f32x4*)(CKVRAW + (size_t)r * 256))[lane];
        const float ss = wave_sum((v.x * v.x + v.y * v.y) + (v.z * v.z + v.w * v.w));
        const float rstd = rsqrtf(ss * (1.f / 256.f) + EPS);
        const f32x4 g = ((const f32x4*)p.kv_norm_w)[lane];
        int w = __builtin_amdgcn_cvt_pk_fp8_f32(v.x * rstd * g.x, v.y * rstd * g.y, 0, false); w = __builtin_amdgcn_cvt_pk_fp8_f32(v.z * rstd * g.z, v.w * rstd * g.w, w, true);
        ((unsigned*)((unsigned char*)CKV + (size_t)r * 256))[lane] = (unsigned)w;
    }
}

__device__ __forceinline__ void phase7(const Params& p, int gw, int ngw, int lane) {
    const bf16_t* OUTPRE = WSP(const bf16_t, WS_OUTPRE); const float* SSQ = WSP(const float, WS_SSQ);
    for (int r = gw; r < MTOK; r += ngw) {
        float s = (lane < 32) ? SSQ[(size_t)r * 32 + lane] : 0.f; s = wave_sum(s);
        const float rstd = rsqrtf(s * (1.f / DM) + EPS);
        const u32x4* o = (const u32x4*)(OUTPRE + (size_t)r * DM); const f32x4* xr = (const f32x4*)(p.x + (size_t)r * DM); const f32x4* g = (const f32x4*)p.post_w; f32x4* out = (f32x4*)(p.out + (size_t)r * DM);
#pragma unroll
        for (int j = 0; j < 4; ++j) {
            const int ch = 64 * j + lane;
            const u32x4 w = o[ch]; const f32x4 x0 = __builtin_nontemporal_load(xr + 2 * ch), x1 = __builtin_nontemporal_load(xr + 2 * ch + 1), g0 = g[2 * ch], g1 = g[2 * ch + 1];
            f32x4 y0, y1;
            y0.x = x0.x + bflo(w.x) * rstd * g0.x; y0.y = x0.y + bfhi(w.x) * rstd * g0.y; y0.z = x0.z + bflo(w.y) * rstd * g0.z; y0.w = x0.w + bfhi(w.y) * rstd * g0.w;
            y1.x = x1.x + bflo(w.z) * rstd * g1.x; y1.y = x1.y + bfhi(w.z) * rstd * g1.y; y1.z = x1.z + bflo(w.w) * rstd * g1.z; y1.w = x1.w + bfhi(w.w) * rstd * g1.w;
            out[2 * ch] = y0; out[2 * ch + 1] = y1;
        }
    }
}

typedef short v4i16_t __attribute__((ext_vector_type(4)));
typedef float f32x2_t __attribute__((ext_vector_type(2))); typedef __bf16 bf16x2_t __attribute__((ext_vector_type(2)));
__device__ __forceinline__ unsigned cvtpk_s(float lo, float hi) { const f32x2_t v = {lo, hi}; const bf16x2_t b = __builtin_convertvector(v, bf16x2_t); return __builtin_bit_cast(unsigned, b); }
__device__ __forceinline__ unsigned off_b(unsigned row, unsigned ch) { const unsigned f = ((row >> 3) & 1u) | ((((row >> 2) ^ (row >> 3)) & 1u) << 1) | (((row >> 1) & 1u) << 2) | ((row & 1u) << 3); return 256u * row + 16u * (ch ^ f); }
__device__ __forceinline__ bf16x8 tr_frag(LAS unsigned char* img, unsigned a0, unsigned a1) {
    const v4i16_t lo = __builtin_amdgcn_ds_read_tr16_b64_v4i16((LAS v4i16_t*)(img + a0));
    const v4i16_t hi = __builtin_amdgcn_ds_read_tr16_b64_v4i16((LAS v4i16_t*)(img + a1));
    return (bf16x8){lo[0], lo[1], lo[2], lo[3], hi[0], hi[1], hi[2], hi[3]};
}
__device__ __forceinline__ void glds16(const void* gsrc, unsigned lds_dst) {
    unsigned keep;
    asm volatile("s_mov_b32 %0, m0\n\ts_mov_b32 m0, %2\n\ts_nop 0\n\tglobal_load_lds_dwordx4 %1, off\n\ts_mov_b32 m0, %0" : "=&s"(keep) : "v"(gsrc), "s"(lds_dst) : "memory");
}
constexpr int DB_K = 0, DB_V = 49152, DB_LUT = 98304, DB_Q = 99328;
constexpr float DIFF_THR = 24.0f;
__device__ __forceinline__ void diff_unit(const Params& p, LAS unsigned char* lds, int b, int h, int qb, float lam) {
    const bf16_t* QB = WSP(const bf16_t, WS_QB); const bf16_t* KB = WSP(const bf16_t, WS_KB); const bf16_t* VB = WSP(const bf16_t, WS_VB); const bf16_t* ZB = WSP(const bf16_t, WS_ZB); bf16_t* OZB = WSP(bf16_t, WS_OZB);
    const int tid = opaque_tid(), lane = tid & 63, wave = __builtin_amdgcn_readfirstlane(tid >> 6), l15 = lane & 15, g = lane >> 4;
    const int jw = 128 * qb + 16 * wave, jq = jw + l15, cw = 2 * qb + 1 + (wave >> 2), ntiles = 2 * qb + 3;
    LAS float* LUT = (LAS float*)(lds + DB_LUT);
    __syncthreads();
    if (tid < 155) LUT[tid] = p.rel_bias[t5_bucket(tid - 91) * 16 + 8 + h] * LOG2E;
    LAS unsigned char* Qimg = lds + DB_Q + wave * 4096;
    { const bf16_t* qp = QB + (size_t)(b * SEQ + jq) * 1024 + h * 128 + 8 * g;
#pragma unroll
      for (int s = 0; s < 4; ++s) *(LAS bf16x8*)(Qimg + off_b((unsigned)l15, 4u * s + (unsigned)g)) = *(const bf16x8*)(qp + 32 * s); }
    size_t dsrc[2];
#pragma unroll
    for (int i = 0; i < 2; ++i) { const unsigned row = 8u * wave + 4u * i + (unsigned)(lane >> 4); const unsigned f = (off_b(row & 15u, 0u) >> 4) & 15u;
        dsrc[i] = (size_t)row * 1024 + h * 128 + (((unsigned)(lane & 15)) ^ f) * 8; }
    const unsigned ddst = 2048u * wave;
    const unsigned lds0 = (unsigned)(size_t)lds;
#define DF_ROW0(tt) ((size_t)b * TK + ((tt) == 0 ? 0 : 16 + 64 * ((tt) - 1)))
#define DF_DMAK(tt, slot) do { const bf16_t* g_ = KB + DF_ROW0(tt) * 1024; _Pragma("unroll") for (int i_ = 0; i_ < 2; ++i_) \
        glds16(g_ + dsrc[i_], (unsigned)__builtin_amdgcn_readfirstlane((int)(lds0 + DB_K + (slot) * 16384 + ddst + 1024 * i_))); } while (0)
#define DF_DMAV(tt, slot) do { const bf16_t* g_ = VB + DF_ROW0(tt) * 1024; _Pragma("unroll") for (int i_ = 0; i_ < 2; ++i_) \
        glds16(g_ + dsrc[i_], (unsigned)__builtin_amdgcn_readfirstlane((int)(lds0 + DB_V + (slot) * 16384 + ddst + 1024 * i_))); } while (0)
#define DF_WAITBAR(n) do { if ((n) >= 4) asm volatile("s_waitcnt vmcnt(4) lgkmcnt(0)" ::: "memory"); else if ((n) >= 2) asm volatile("s_waitcnt vmcnt(2) lgkmcnt(0)" ::: "memory"); \
        else asm volatile("s_waitcnt vmcnt(0) lgkmcnt(0)" ::: "memory"); __builtin_amdgcn_s_barrier(); asm volatile("" ::: "memory"); } while (0)
    const unsigned q4 = (unsigned)l15 >> 2, pp = (unsigned)l15 & 3u;
    unsigned kbase[2][2], vbase[8];
#pragma unroll
    for (int mp = 0; mp < 2; ++mp)
#pragma unroll
        for (int s = 0; s < 2; ++s) kbase[mp][s] = off_b((unsigned)l15, 8u * mp + 4u * s + (unsigned)g);
#pragma unroll
    for (int c = 0; c < 8; ++c) vbase[c] = off_b(4u * g + q4, 2u * c + (pp >> 1)) + 8u * (pp & 1u);

    float m1 = 0.f, m2 = 0.f;
    f32x4 O1[8], O2[8], OL1 = (f32x4){0.f, 0.f, 0.f, 0.f}, OL2 = (f32x4){0.f, 0.f, 0.f, 0.f};
    const short one_ = (l15 == 0) ? (short)0x3F80 : (short)0;
    const bf16x8 onesf = (bf16x8){one_, one_, one_, one_, one_, one_, one_, one_};
#pragma unroll
    for (int c = 0; c < 8; ++c) { O1[c] = (f32x4){0.f, 0.f, 0.f, 0.f}; O2[c] = (f32x4){0.f, 0.f, 0.f, 0.f}; }
    f32x4 S1[4], S2[4];
    bf16x8 pa1[2], pa2[2];
    float es1 = 1.f, es2 = 1.f; bool pending = false;
    f32x4 cn1 = (f32x4){0.f, 0.f, 0.f, 0.f}, cn2 = cn1, cf1 = cn1, cf2 = cn1;

#define DF_QK(tt, kbo_) do { LAS unsigned char* Kb_ = lds + DB_K + (kbo_); \
        const int dmin_ = ((tt) == 0) ? (jw + 1) : (jw - 64 * (tt) + 1); const bool near_ = dmin_ < 91; \
        const f32x4 ci1_ = near_ ? cn1 : cf1, ci2_ = near_ ? cn2 : cf2;        \
        _Pragma("unroll") for (int s = 0; s < 2; ++s) { const bf16x8 q1_ = *(const LAS bf16x8*)(Qimg + kbase[0][s]), q2_ = *(const LAS bf16x8*)(Qimg + kbase[1][s]); \
          bf16x8 ka1_[4], ka2_[4]; \
          _Pragma("unroll") for (int mb = 0; mb < 4; ++mb) { ka1_[mb] = *(const LAS bf16x8*)(Kb_ + kbase[0][s] + 4096 * mb); ka2_[mb] = *(const LAS bf16x8*)(Kb_ + kbase[1][s] + 4096 * mb); } \
          __builtin_amdgcn_sched_barrier(0); \
          _Pragma("unroll") for (int mb = 0; mb < 4; ++mb) { \
            S1[mb] = __builtin_amdgcn_mfma_f32_16x16x32_bf16(ka1_[mb], q1_, s == 0 ? ci1_ : S1[mb], 0, 0, 0); S2[mb] = __builtin_amdgcn_mfma_f32_16x16x32_bf16(ka2_[mb], q2_, s == 0 ? ci2_ : S2[mb], 0, 0, 0); } } \
        if (near_) { _Pragma("unroll") for (int mb = 0; mb < 4; ++mb) _Pragma("unroll") for (int i = 0; i < 4; ++i) { \
            const int kr_ = 16 * mb + 4 * g + i; const int kpos_ = ((tt) == 0) ? kr_ : 16 + 64 * ((tt) - 1) + kr_; \
            int rel_ = kpos_ - (NMETA + jq); rel_ = rel_ < -91 ? -91 : (rel_ > 63 ? 63 : rel_); const float bias_ = LUT[rel_ + 91]; S1[mb][i] += bias_; S2[mb][i] += bias_; } } \
        if ((tt) == 0) { _Pragma("unroll") for (int mb = 1; mb < 4; ++mb) { S1[mb] = (f32x4){-INFINITY, -INFINITY, -INFINITY, -INFINITY}; S2[mb] = S1[mb]; } } } while (0)
#define DF_LMAX(t1_, t2_) do { t1_ = fmaxf(fmaxf(S1[0][0], S1[0][1]), S1[0][2]); t2_ = fmaxf(fmaxf(S2[0][0], S2[0][1]), S2[0][2]); \
        t1_ = fmaxf(fmaxf(t1_, S1[0][3]), S1[1][0]); t2_ = fmaxf(fmaxf(t2_, S2[0][3]), S2[1][0]); \
        t1_ = fmaxf(fmaxf(t1_, S1[1][1]), S1[1][2]); t2_ = fmaxf(fmaxf(t2_, S2[1][1]), S2[1][2]); \
        t1_ = fmaxf(fmaxf(t1_, S1[1][3]), S1[2][0]); t2_ = fmaxf(fmaxf(t2_, S2[1][3]), S2[2][0]); \
        t1_ = fmaxf(fmaxf(t1_, S1[2][1]), S1[2][2]); t2_ = fmaxf(fmaxf(t2_, S2[2][1]), S2[2][2]); \
        t1_ = fmaxf(fmaxf(t1_, S1[2][3]), S1[3][0]); t2_ = fmaxf(fmaxf(t2_, S2[2][3]), S2[3][0]); \
        t1_ = fmaxf(fmaxf(t1_, S1[3][1]), S1[3][2]); t2_ = fmaxf(fmaxf(t2_, S2[3][1]), S2[3][2]); \
        t1_ = fmaxf(t1_, S1[3][3]); t2_ = fmaxf(t2_, S2[3][3]); } while (0)
#define DF_RESCALE(t1_, t2_, forced_) do { float r1_ = t1_, r2_ = t2_; r1_ = fmaxf(r1_, __shfl_xor(r1_, 16)); r1_ = fmaxf(r1_, __shfl_xor(r1_, 32)); r2_ = fmaxf(r2_, __shfl_xor(r2_, 16)); r2_ = fmaxf(r2_, __shfl_xor(r2_, 32)); \
        const float d1_ = (forced_) ? r1_ : fmaxf(r1_, 0.f), d2_ = (forced_) ? r2_ : fmaxf(r2_, 0.f); m1 += d1_; m2 += d2_; \
        es1 = __builtin_amdgcn_exp2f(-d1_); es2 = __builtin_amdgcn_exp2f(-d2_); \
        _Pragma("unroll") for (int mb = 0; mb < 4; ++mb) { S1[mb] = S1[mb] - d1_; S2[mb] = S2[mb] - d2_; } \
        cn1 = (f32x4){-m1, -m1, -m1, -m1}; cn2 = (f32x4){-m2, -m2, -m2, -m2}; { const float f1_ = bias_far - m1, f2_ = bias_far - m2; cf1 = (f32x4){f1_, f1_, f1_, f1_}; cf2 = (f32x4){f2_, f2_, f2_, f2_}; } } while (0)
#define DF_SCALE_O() do { _Pragma("unroll") for (int i = 0; i < 4; ++i) { const float x1_ = __shfl(es1, 4 * g + i), x2_ = __shfl(es2, 4 * g + i); OL1[i] *= x1_; OL2[i] *= x2_; \
            _Pragma("unroll") for (int c = 0; c < 8; ++c) { O1[c][i] *= x1_; O2[c][i] *= x2_; } } } while (0)
#define DF_EXP() do { _Pragma("unroll") for (int mb = 0; mb < 4; ++mb) _Pragma("unroll") for (int i = 0; i < 4; ++i) { S1[mb][i] = __builtin_amdgcn_exp2f(S1[mb][i]); S2[mb][i] = __builtin_amdgcn_exp2f(S2[mb][i]); } \
        _Pragma("unroll") for (int ks = 0; ks < 2; ++ks) { u32x4 w1_, w2_; \
            w1_.x = cvtpk_s(S1[2 * ks][0], S1[2 * ks][1]); w1_.y = cvtpk_s(S1[2 * ks][2], S1[2 * ks][3]); w1_.z = cvtpk_s(S1[2 * ks + 1][0], S1[2 * ks + 1][1]); w1_.w = cvtpk_s(S1[2 * ks + 1][2], S1[2 * ks + 1][3]); \
            w2_.x = cvtpk_s(S2[2 * ks][0], S2[2 * ks][1]); w2_.y = cvtpk_s(S2[2 * ks][2], S2[2 * ks][3]); w2_.z = cvtpk_s(S2[2 * ks + 1][0], S2[2 * ks + 1][1]); w2_.w = cvtpk_s(S2[2 * ks + 1][2], S2[2 * ks + 1][3]); \
            pa1[ks] = __builtin_bit_cast(bf16x8, w1_); pa2[ks] = __builtin_bit_cast(bf16x8, w2_); } } while (0)
#define DF_PV(vbo_, pq1_, pq2_) do { LAS unsigned char* Vb_ = lds + DB_V + (vbo_); \
        _Pragma("unroll") for (int ks = 0; ks < 2; ++ks) { OL1 = __builtin_amdgcn_mfma_f32_16x16x32_bf16(pq1_[ks], onesf, OL1, 0, 0, 0); OL2 = __builtin_amdgcn_mfma_f32_16x16x32_bf16(pq2_[ks], onesf, OL2, 0, 0, 0); } \
        _Pragma("unroll") for (int c2 = 0; c2 < 8; c2 += 2) { bf16x8 vf_[2][2]; \
            _Pragma("unroll") for (int cc = 0; cc < 2; ++cc) _Pragma("unroll") for (int ks = 0; ks < 2; ++ks) vf_[cc][ks] = tr_frag(Vb_ + vbase[c2 + cc], 8192u * ks, 8192u * ks + 4096u); \
            _Pragma("unroll") for (int cc = 0; cc < 2; ++cc) _Pragma("unroll") for (int ks = 0; ks < 2; ++ks) { \
                O1[c2 + cc] = __builtin_amdgcn_mfma_f32_16x16x32_bf16(pq1_[ks], vf_[cc][ks], O1[c2 + cc], 0, 0, 0); O2[c2 + cc] = __builtin_amdgcn_mfma_f32_16x16x32_bf16(pq2_[ks], vf_[cc][ks], O2[c2 + cc], 0, 0, 0); } } } while (0)

    DF_DMAK(0, 0); DF_DMAV(0, 0); DF_DMAK(1, 1); DF_DMAV(1, 1); DF_DMAK(2, 2);
    asm volatile("s_waitcnt vmcnt(0) lgkmcnt(0)" ::: "memory"); __builtin_amdgcn_s_barrier(); asm volatile("" ::: "memory");
    const float bias_far = LUT[0];
    cf1 = (f32x4){bias_far, bias_far, bias_far, bias_far}; cf2 = cf1;
    { DF_QK(0, 0u); float t1, t2; DF_LMAX(t1, t2); DF_RESCALE(t1, t2, true); DF_EXP(); }
    asm volatile("s_waitcnt lgkmcnt(0)" ::: "memory"); __builtin_amdgcn_s_barrier(); asm volatile("" ::: "memory");
    int sk = 1, sv = 0;
    for (int t = 0; t < ntiles; ++t) {
        if (__builtin_expect(pending, 0)) { DF_SCALE_O(); pending = false; }
        int nnew = 0;
        { const int s3 = (sk == 0) ? 2 : sk - 1;
          if (t + 3 < ntiles) { DF_DMAK(t + 3, s3); nnew += 2; }
          const int s2 = (sv == 0) ? 2 : sv - 1;
          if (t + 2 < ntiles) { DF_DMAV(t + 2, s2); nnew += 2; } }
        unsigned kbo = (unsigned)sk * 16384u, vbo = (unsigned)sv * 16384u; asm volatile("" : "+v"(kbo), "+v"(vbo));
        if (t + 1 <= cw) {
            DF_QK(t + 1, kbo);
            float t1, t2; DF_LMAX(t1, t2);
            if (__builtin_expect(__any((t1 > DIFF_THR) || (t2 > DIFF_THR)), 0)) { DF_RESCALE(t1, t2, false); pending = true; }
            DF_PV(vbo, pa1, pa2);
            DF_EXP();
        } else if (t <= cw) {
            DF_PV(vbo, pa1, pa2);
        }
        DF_WAITBAR(nnew);
        sk = (sk == 2) ? 0 : sk + 1; sv = (sv == 2) ? 0 : sv + 1;
    }
    asm volatile("s_waitcnt vmcnt(0)" ::: "memory");
#undef DF_ROW0
#undef DF_DMAK
#undef DF_DMAV
#undef DF_WAITBAR
#undef DF_QK
#undef DF_LMAX
#undef DF_RESCALE
#undef DF_SCALE_O
#undef DF_EXP
#undef DF_PV
#pragma unroll
    for (int i = 0; i < 4; ++i) {
        const float r1 = 1.f / __shfl(OL1[i], 16 * g), r2 = lam / __shfl(OL2[i], 16 * g);
        float o[8]; float ss = 0.f;
#pragma unroll
        for (int c = 0; c < 8; ++c) { o[c] = O1[c][i] * r1 - O2[c][i] * r2; ss += o[c] * o[c]; }
        ss += __shfl_xor(ss, 1); ss += __shfl_xor(ss, 2); ss += __shfl_xor(ss, 4); ss += __shfl_xor(ss, 8);
        const float rs = rsqrtf(ss * (1.f / 128.f) + EPS) * 0.8f;
        const size_t t = (size_t)b * SEQ + jw + 4 * g + i;
#pragma unroll
        for (int c = 0; c < 8; ++c) { const int d = 16 * c + l15; const float y = o[c] * rs * p.subln_w[d] * bf2f(ZB[t * 1024 + h * 128 + d]); OZB[t * 1024 + h * 128 + d] = (bf16_t)f2bf(y); }
    }
}
__device__ __forceinline__ void phase_diff(const Params& p, LAS unsigned char* lds) {
    const int lane = threadIdx.x & 63;
    float a = (lane < 64) ? p.lam_p[lane] * p.lam_p[64 + lane] : 0.f, bb = p.lam_p[128 + lane] * p.lam_p[192 + lane];
    a = wave_sum(a); bb = wave_sum(bb);
    const float lam = expf(a) - expf(bb) + 0.2f;
    for (int u = blockIdx.x; u < 512; u += gridDim.x) {
        const int v = u & 255;
        int bh = v >> 4, s = v & 15;
        if (gridDim.x == 256) { bh = (v & 7) + 8 * (v >> 7); s = (v >> 3) & 15; }
        const int qb = (u < 256) ? s : 31 - s;
        diff_unit(p, lds, bh >> 3, bh & 7, qb, lam);
    }
}

typedef float f32x16 __attribute__((ext_vector_type(16)));
__device__ __forceinline__ void scores_wg_unit(const Params& p, LAS unsigned char* lds, int c, int b, int half, int kh) {
    const bf16_t* IQ = WSP(const bf16_t, WS_IQ); const float* IW = WSP(const float, WS_IW); float* SC = WSP(float, WS_SC);
    const int tid = opaque_tid(), lane = tid & 63, wave = __builtin_amdgcn_readfirstlane(tid >> 6);
    const int j0 = (c - 1) * 64 + 32 * half + 4 * wave, m0 = b * SEQ + j0, n = 16 + 64 * c, nkb = 2 * c + 1, nkh = (nkb + 1) >> 1;
    const int kbA = kh ? nkh : 0, kbB = kh ? nkb : nkh, ntile = (kbB - kbA + 1) >> 1;
    const int r32 = lane & 31, hi = lane >> 5, tok = r32 >> 4, hh = r32 & 15;
    bf16x8 af[2][4]; float wv[2][16];
#pragma unroll
    for (int pr = 0; pr < 2; ++pr) {
#pragma unroll
        for (int s = 0; s < 4; ++s) af[pr][s] = *(const bf16x8*)(IQ + (size_t)(m0 + 2 * pr + tok) * 1024 + hh * 64 + 16 * s + 8 * hi);
#pragma unroll
        for (int r = 0; r < 16; ++r) wv[pr][r] = IW[(size_t)(m0 + 2 * pr + (r >> 3)) * 16 + (r & 3) + 8 * ((r >> 2) & 1) + 4 * hi];
    }
    float* rowbase = SC + sc_off(b, j0);
    const bf16_t* ikb = WSP(const bf16_t, WS_IK) + (size_t)b * TK * 64;
    const int pkey = tid >> 3, pch = tid & 7;
    const unsigned pdst = (unsigned)pkey * 128u + 16u * (unsigned)(pch ^ (((pkey >> 1) & 1) | (((pkey >> 3) & 1) << 1) | (((pkey >> 4) & 1) << 2)));
    unsigned boff[4];
#pragma unroll
    for (int s = 0; s < 4; ++s) boff[s] = (unsigned)r32 * 128u + 16u * (unsigned)((2 * s + hi) ^ (((r32 >> 1) & 1) | (((r32 >> 3) & 1) << 1) | (((r32 >> 4) & 1) << 2)));
    u32x4 kreg[4];
#define SCW_LOAD(T_) do { _Pragma("unroll") for (int i_ = 0; i_ < 4; ++i_) { int key_ = 32 * (kbA + 8 * (T_)) + 64 * i_ + pkey; key_ = key_ < n ? key_ : n - 1; kreg[i_] = *(const u32x4*)(ikb + (size_t)key_ * 64 + pch * 8); } } while (0)
#define SCW_WRITE(off_) do { _Pragma("unroll") for (int i_ = 0; i_ < 4; ++i_) *(LAS u32x4*)(lds + (off_) + i_ * 8192 + pdst) = kreg[i_]; } while (0)
#define SCW_CHAIN(acc_, pr_, bf_) do { _Pragma("unroll") for (int r_ = 0; r_ < 16; ++r_) acc_[r_] = 0.f; \
        _Pragma("unroll") for (int s_ = 0; s_ < 4; ++s_) acc_ = __builtin_amdgcn_mfma_f32_32x32x16_bf16(af[pr_][s_], bf_[s_], acc_, 0, 0, 0); } while (0)
#define SCW_SUM(acc_, pr_, kb_, en_) do { f32x2_t s0_ = {0.f, 0.f}, s1_ = {0.f, 0.f}; \
        _Pragma("unroll") for (int r_ = 0; r_ < 8; r_ += 2) { \
            const f32x2_t x0_ = {__builtin_amdgcn_fmed3f(acc_[r_], 0.f, pinf), __builtin_amdgcn_fmed3f(acc_[r_ + 1], 0.f, pinf)}; \
            const f32x2_t x1_ = {__builtin_amdgcn_fmed3f(acc_[8 + r_], 0.f, pinf), __builtin_amdgcn_fmed3f(acc_[9 + r_], 0.f, pinf)}; \
            s0_ = __builtin_elementwise_fma((f32x2_t){wv[pr_][r_], wv[pr_][r_ + 1]}, x0_, s0_); s1_ = __builtin_elementwise_fma((f32x2_t){wv[pr_][8 + r_], wv[pr_][9 + r_]}, x1_, s1_); } \
        const float p0_ = s0_.x + s0_.y, p1_ = s1_.x + s1_.y; \
        const auto sw_ = __builtin_amdgcn_permlane32_swap(__float_as_uint(p0_), __float_as_uint(p1_), false, false); \
        const float tot_ = __uint_as_float(sw_[0]) + __uint_as_float(sw_[1]); const int key_ = 32 * (kb_) + r32; \
        if ((en_) && (kb_) < kbB && key_ < n) rowbase[(size_t)(2 * (pr_) + hi) * n + key_] = tot_; } while (0)
#define SCW_MIX() do { _Pragma("unroll") for (int g_ = 0; g_ < 4; ++g_) { __builtin_amdgcn_sched_group_barrier(0x008, 1, 0); __builtin_amdgcn_sched_group_barrier(0x002, 6, 0); } } while (0)
    __syncthreads();
    SCW_LOAD(0); SCW_WRITE(0u);
    __syncthreads();
    f32x16 accA, accB;
    float pinf = __builtin_inff(); asm volatile("" : "+v"(pinf));
#pragma unroll
    for (int r = 0; r < 16; ++r) accB[r] = 0.f;
    const int nsup = (ntile + 3) >> 2;
    for (int T = 0; T < nsup; ++T) {
        if (T + 1 < nsup) SCW_LOAD(T + 1);
        const int tend = (4 * T + 4 < ntile) ? 4 * T + 4 : ntile;
        for (int t = 4 * T; t < tend; ++t) {
            unsigned bo = (unsigned)(T & 1) * 32768u + (unsigned)(t & 3) * 8192u; asm volatile("" : "+v"(bo));
            const int kb0 = kbA + 2 * t;
            bf16x8 bf0[4], bf1[4];
#pragma unroll
            for (int s = 0; s < 4; ++s) bf0[s] = *(const LAS bf16x8*)(lds + bo + boff[s]);
#pragma unroll
            for (int s = 0; s < 4; ++s) bf1[s] = *(const LAS bf16x8*)(lds + bo + boff[s] + 4096);
            SCW_CHAIN(accA, 0, bf0); SCW_SUM(accB, 1, kb0 - 1, t > 0); SCW_MIX();
            SCW_CHAIN(accB, 1, bf0); SCW_SUM(accA, 0, kb0, true); SCW_MIX();
            SCW_CHAIN(accA, 0, bf1); SCW_SUM(accB, 1, kb0, true); SCW_MIX();
            SCW_CHAIN(accB, 1, bf1); SCW_SUM(accA, 0, kb0 + 1, true); SCW_MIX();
        }
        if (T + 1 < nsup) SCW_WRITE((unsigned)((T + 1) & 1) * 32768u);
        __syncthreads();
    }
    SCW_SUM(accB, 1, kbA + 2 * ntile - 1, true);
#undef SCW_CHAIN
#undef SCW_SUM
#undef SCW_MIX
#undef SCW_LOAD
#undef SCW_WRITE
}
__device__ __forceinline__ void phase_scores(const Params& p, LAS unsigned char* lds) {
    for (int P = (int)blockIdx.x; P < 256; P += (int)gridDim.x) {
        const int cl = 1 + (P >> 3), sub = P & 7;
        scores_wg_unit(p, lds, 65 - cl, sub >> 2, (sub >> 1) & 1, sub & 1);
        scores_wg_unit(p, lds, cl, sub >> 2, (sub >> 1) & 1, sub & 1);
    }
}
__device__ __forceinline__ void phase_qlat(const Params& p, LAS unsigned char* lds) {
    const bf16_t* QA = WSP(const bf16_t, WS_QA); const bf16_t* WUK = WSP(const bf16_t, WS_WUK); bf16_t* QLAT = WSP(bf16_t, WS_QLAT);
    const int tid = opaque_tid(), lane = tid & 63, w = __builtin_amdgcn_readfirstlane(tid >> 6), l15 = lane & 15, g = lane >> 4;
    const float sc = 0.08838834764831845f * LOG2E * 16.f;
    const int G = (int)gridDim.x;
    int hcur = -1;
    const unsigned kb0 = off_b((unsigned)l15, (unsigned)g);
    for (int u0 = (int)blockIdx.x; u0 < 4096; u0 += 8 * G) {
        const int h = u0 & 7;
        if (h != hcur || (G & 7)) { hcur = h; __syncthreads();
#pragma unroll
            for (int i = 0; i < 8; ++i) { const int idx = tid + 512 * i, row = idx >> 4, ch = idx & 15;
                *(LAS u32x4*)(lds + off_b((unsigned)row, (unsigned)ch)) = *(const u32x4*)(WUK + ((size_t)row * 8 + h) * 128 + ch * 8); }
            __syncthreads(); }
        const int u = u0 + w * G;
        if (u < 4096 && (u & 7) == h) {
            const int m0 = (u >> 3) * 16;
            bf16x8 bq[4];
#pragma unroll
            for (int s = 0; s < 4; ++s) bq[s] = *(const bf16x8*)(QA + (size_t)(m0 + l15) * 1024 + h * 128 + 32 * s + 8 * g);
#pragma unroll 4
            for (int nb = 0; nb < 16; ++nb) {
                bf16x8 af[4];
#pragma unroll
                for (int s = 0; s < 4; ++s) af[s] = *(const LAS bf16x8*)(lds + 4096 * nb + (kb0 ^ (64u * s)));
                f32x4 acc = (f32x4){0.f, 0.f, 0.f, 0.f};
#pragma unroll
                for (int s = 0; s < 4; ++s) acc = __builtin_amdgcn_mfma_f32_16x16x32_bf16(af[s], bq[s], acc, 0, 0, 0);
                int wv = __builtin_amdgcn_cvt_pk_fp8_f32(acc[0] * sc, acc[1] * sc, 0, false); wv = __builtin_amdgcn_cvt_pk_fp8_f32(acc[2] * sc, acc[3] * sc, wv, true);
                *(unsigned*)((unsigned char*)QLAT + ((size_t)(m0 + l15) * 8 + h) * 256 + 16 * nb + 4 * g) = (unsigned)wv;
            }
        }
    }
}
__device__ __forceinline__ void phase_oproj(const Params& p, LAS unsigned char* lds) {
    const bf16_t* OLAT = WSP(const bf16_t, WS_OLAT); const bf16_t* WUVT = WSP(const bf16_t, WS_WUVT); const bf16_t* ZA = WSP(const bf16_t, WS_ZA); bf16_t* OZA = WSP(bf16_t, WS_OZA);
    const int tid = opaque_tid(), lane = tid & 63, w = __builtin_amdgcn_readfirstlane(tid >> 6), l15 = lane & 15, g = lane >> 4;
    const int G = (int)gridDim.x;
    int hcur = -1;
    const unsigned kb0 = off_b((unsigned)l15, (unsigned)g);
    for (int u0 = (int)blockIdx.x; u0 < 4096; u0 += 8 * G) {
        const int h = u0 & 7;
        if (h != hcur || (G & 7)) { hcur = h; __syncthreads();
#pragma unroll
            for (int i = 0; i < 8; ++i) { const int idx = tid + 512 * i, row = idx >> 5, c32 = idx & 31;
                *(LAS u32x4*)(lds + (c32 >> 4) * 32768 + off_b((unsigned)row, (unsigned)(c32 & 15))) = *(const u32x4*)(WUVT + (size_t)(h * 128 + row) * 256 + c32 * 8); }
            __syncthreads(); }
        const int u = u0 + w * G;
        if (u < 4096 && (u & 7) == h) {
            const int m0 = (u >> 3) * 16;
            bf16x8 bq[8];
#pragma unroll
            for (int s = 0; s < 8; ++s) bq[s] = *(const bf16x8*)(OLAT + ((size_t)(m0 + l15) * 8 + h) * 256 + 32 * s + 8 * g);
#pragma unroll 2
            for (int nb = 0; nb < 8; ++nb) {
                bf16x8 af[8];
#pragma unroll
                for (int s = 0; s < 8; ++s) af[s] = *(const LAS bf16x8*)(lds + (s >> 2) * 32768 + 4096 * nb + (kb0 ^ (64u * (s & 3))));
                f32x4 acc = (f32x4){0.f, 0.f, 0.f, 0.f};
#pragma unroll
                for (int s = 0; s < 8; ++s) acc = __builtin_amdgcn_mfma_f32_16x16x32_bf16(af[s], bq[s], acc, 0, 0, 0);
                const size_t o = (size_t)(m0 + l15) * 1024 + h * 128 + 16 * nb + 4 * g;
                const u32x2 z = *(const u32x2*)(ZA + o);
                u32x2 wv; wv.x = pg8::cvt_pk_bf16(acc[0] * bflo(z.x), acc[1] * bfhi(z.x)); wv.y = pg8::cvt_pk_bf16(acc[2] * bflo(z.y), acc[3] * bfhi(z.y));
                *(u32x2*)(OZA + o) = wv;
            }
        }
    }
}
typedef int v2i32_t __attribute__((ext_vector_type(2)));
constexpr int DSA_WAVE_LDS = 17408, DSA_LUT = 8 * DSA_WAVE_LDS;
__device__ __forceinline__ int lpos(int s) { return (s & ~31) | ((s & 3) << 3) | ((s & 31) >> 2); }
__device__ __forceinline__ unsigned ord_key(float f) { const unsigned u = __float_as_uint(f); return (u & 0x80000000u) ? ~u : (u | 0x80000000u); }
template <int KN>
__device__ __forceinline__ void dsa_select(const float* row, int n, int nsel, LAS int* list, int lane) {
    const __amdgpu_buffer_rsrc_t rs = __builtin_amdgcn_make_buffer_rsrc((void*)row, 0, n * 4, 0x00020000);
    unsigned key[KN];
#pragma unroll
    for (int k = 0; k < KN; ++k) key[k] = (unsigned)__builtin_amdgcn_raw_buffer_load_b32(rs, lane * 4, 256 * k, 2);
    { int idx0 = lane;
#pragma unroll
      for (int k = 0; k < KN; ++k) { const unsigned u = key[k]; const unsigned o = (u & 0x80000000u) ? ~u : (u | 0x80000000u); key[k] = (idx0 < n) ? o : 0u; idx0 += 64; asm volatile("" : "+v"(idx0)); } }
    unsigned thr = 0u;
    if (n > 256) {
        for (int bit = 31; bit >= 0; --bit) {
            const unsigned cand = thr | (1u << bit);
            int c = 0;
#pragma unroll
            for (int k = 0; k < KN; ++k) c += (key[k] >= cand) ? 1 : 0;
            int cnt = 0;
#pragma unroll
            for (int b7 = 0; b7 < 7; ++b7) cnt += __popcll(__ballot((c >> b7) & 1)) << b7;
            if (cnt >= 256) thr = cand;
            if (cnt == 256) break;
        }
    }
    int pos = 0; int idx = lane;
#pragma unroll
    for (int k = 0; k < KN; ++k) { const bool mine = key[k] > thr; const unsigned long long msk = __ballot(mine);
        const int my = __builtin_amdgcn_mbcnt_hi((unsigned)(msk >> 32), __builtin_amdgcn_mbcnt_lo((unsigned)msk, 0u));
        if (mine) list[lpos(pos + my)] = idx; pos += __popcll(msk); idx += 64; asm volatile("" : "+v"(idx)); }
    if (pos < nsel) {
        idx = lane;
#pragma unroll
        for (int k = 0; k < KN; ++k) { const bool mine = (key[k] == thr) && (idx < n); const unsigned long long msk = __ballot(mine);
            const int my = __builtin_amdgcn_mbcnt_hi((unsigned)(msk >> 32), __builtin_amdgcn_mbcnt_lo((unsigned)msk, 0u));
            if (mine && pos + my < nsel) list[lpos(pos + my)] = idx; pos += __popcll(msk); idx += 64; asm volatile("" : "+v"(idx)); }
    }
}
__device__ __forceinline__ void dsa_unit(const Params& p, LAS unsigned char* lds, int qi, int wave, int lane, int probe) {
    const float* SC = WSP(const float, WS_SC); bf16_t* OLAT = WSP(bf16_t, WS_OLAT);
    const int c = qi >> 8, b = (qi >> 6) & 1, j = (c - 1) * 64 + (qi & 63), t = b * SEQ + j, n = 16 + 64 * c, nsel = n < 256 ? n : 256, qpos = NMETA + j;
    LAS unsigned char* img = lds + wave * DSA_WAVE_LDS; LAS int* list = (LAS int*)(img + 16384); const LAS float* LUTA = (const LAS float*)(lds + DSA_LUT);
    const int l15 = lane & 15, g = lane >> 4;
    const float* row = SC + sc_off(b, j);
#pragma unroll
    for (int rs_ = (PROBE_REP == 41) ? 2 : 1; rs_ > 0; --rs_) {
    if (n <= 64 * 17) dsa_select<17>(row, n, nsel, list, lane);
    else if (n <= 64 * 33) dsa_select<33>(row, n, nsel, list, lane);
    else if (n <= 64 * 49) dsa_select<49>(row, n, nsel, list, lane);
    else dsa_select<65>(row, n, nsel, list, lane);
    }
#pragma unroll
    for (int ra_ = (PROBE_REP == 42) ? 2 : 1; ra_ > 0; --ra_) {
    const unsigned char* CKV8 = WSP(const unsigned char, WS_CKV); const unsigned char* qlp = WSP(const unsigned char, WS_QLAT) + ((size_t)t * 8 + (l15 & 7)) * 256 + 8 * g;
    const bool qreal = l15 < 8;
    unsigned rdb[2];
    rdb[0] = 256u * (unsigned)l15 + 8u * ((unsigned)g ^ (2u * (unsigned)l15));
    rdb[1] = 256u * (unsigned)(l15 + 16) + 8u * ((unsigned)g ^ (2u * ((unsigned)l15 ^ 8u)));
    const unsigned tq = (unsigned)l15 >> 1, tp = (unsigned)l15 & 1u;
    const unsigned trow = (tq < 4u) ? 4u * g + tq : 16u + 4u * g + (tq - 4u);
    const unsigned trb = 256u * trow + 8u * (tp ^ (2u * ((trow & 15u) ^ ((trow >> 4) << 3))));
    float m = -INFINITY, l = 0.f;
    f32x4 O[16];
#pragma unroll
    for (int rb = 0; rb < 16; ++rb) O[rb] = (f32x4){0.f, 0.f, 0.f, 0.f};
    const int nch = (nsel + 31) >> 5;
    const int hcol = l15 & 7;
    u32x4 gr[8];
    const unsigned gwr = 256u * (unsigned)(lane >> 4) + 16u * (unsigned)(lane & 15);
#define DSA_GATHER(chn) do { int ki_[8]; { const LAS int* lp_ = list + 32 * (chn) + 8 * (lane >> 4); \
        _Pragma("unroll") for (int v_ = 0; v_ < 2; ++v_) { const u32x4 t_ = *(const LAS u32x4*)(lp_ + 4 * v_); ki_[4 * v_] = (int)t_.x; ki_[4 * v_ + 1] = (int)t_.y; ki_[4 * v_ + 2] = (int)t_.z; ki_[4 * v_ + 3] = (int)t_.w; } } \
        _Pragma("unroll") for (int i = 0; i < 8; ++i) { const int slot = 32 * (chn) + 4 * i + (lane >> 4); const int kidx = slot < nsel ? ki_[i] : 0; \
        gr[i] = *(const u32x4*)(CKV8 + ((size_t)b * TK + kidx) * 256 + (lane & 15) * 16); } } while (0)
    DSA_GATHER(0);
    for (int ch = 0; ch < nch; ++ch) {
#pragma unroll
        for (int i = 0; i < 8; ++i) { const unsigned row = 4u * i + (unsigned)(lane >> 4); const unsigned rc = (row & 15u) ^ ((row >> 4) << 3);
            *(LAS u32x4*)(img + 256u * row + 16u * (((unsigned)lane & 15u) ^ rc)) = gr[i]; }
        long qf[8];
#pragma unroll
        for (int s = 0; s < 8; ++s) qf[s] = *(const long*)(qlp + 32 * s);
        asm volatile("" ::: "memory");
        DSA_GATHER(ch + 1);
        asm volatile("" ::: "memory");
#pragma unroll
        for (int s = 0; s < 8; ++s) qf[s] = qreal ? qf[s] : 0l;
        unsigned io = 0u; asm volatile("" : "+v"(io));
        LAS unsigned char* im = img + io;
        f32x4 S[2];
        S[0] = (f32x4){0.f, 0.f, 0.f, 0.f}; S[1] = S[0];
#pragma unroll
        for (int s4 = 0; s4 < 8; s4 += 4) {
            long af_[4][2];
#pragma unroll
            for (int s = 0; s < 4; ++s)
#pragma unroll
                for (int mb = 0; mb < 2; ++mb) af_[s][mb] = *(const LAS long*)(im + (rdb[mb] ^ (32u * (s4 + s))));
            __builtin_amdgcn_sched_barrier(0);
#pragma unroll
            for (int s = 0; s < 4; ++s)
#pragma unroll
                for (int mb = 0; mb < 2; ++mb) S[mb] = __builtin_amdgcn_mfma_f32_16x16x32_fp8_fp8(af_[s][mb], qf[s4 + s], S[mb], 0, 0, 0);
        }
        float cm = -INFINITY;
#pragma unroll
        for (int mb = 0; mb < 2; ++mb)
#pragma unroll
            for (int i = 0; i < 4; ++i) { const int slot = 32 * ch + 16 * mb + 4 * g + i; const int kidx = list[lpos(slot & 255)];
                int rel = kidx - qpos; rel = rel < -91 ? -91 : (rel > 63 ? 63 : rel);
                float v = S[mb][i] * 0.0625f + LUTA[(rel + 91) * 8 + hcol]; v = slot < nsel ? v : -INFINITY; S[mb][i] = v; cm = fmaxf(cm, v); }
        cm = fmaxf(cm, __shfl_xor(cm, 16)); cm = fmaxf(cm, __shfl_xor(cm, 32));
        const float mn = fmaxf(m, cm), alpha = __builtin_amdgcn_exp2f(m - mn); m = mn;
        float ps = 0.f;
#pragma unroll
        for (int mb = 0; mb < 2; ++mb)
#pragma unroll
            for (int i = 0; i < 4; ++i) { S[mb][i] = __builtin_amdgcn_exp2f(S[mb][i] - mn); ps += S[mb][i]; }
        l = l * alpha + ps;
        if (__any(alpha != 1.f)) {
#pragma unroll
            for (int rb = 0; rb < 16; ++rb) O[rb] = O[rb] * alpha;
        }
        int w0 = __builtin_amdgcn_cvt_pk_fp8_f32(S[0][0], S[0][1], 0, false); w0 = __builtin_amdgcn_cvt_pk_fp8_f32(S[0][2], S[0][3], w0, true);
        int w1 = __builtin_amdgcn_cvt_pk_fp8_f32(S[1][0], S[1][1], 0, false); w1 = __builtin_amdgcn_cvt_pk_fp8_f32(S[1][2], S[1][3], w1, true);
        const long pb = (long)(((unsigned long long)(unsigned)w1 << 32) | (unsigned long long)(unsigned)w0);
#pragma unroll
        for (int rb4 = 0; rb4 < 16; rb4 += 4) {
            long tf_[4];
#pragma unroll
            for (int r_ = 0; r_ < 4; ++r_) { const v2i32_t tv = __builtin_amdgcn_ds_read_tr8_b64_v2i32((LAS v2i32_t*)(im + (trb ^ (16u * (rb4 + r_))))); tf_[r_] = __builtin_bit_cast(long, tv); }
            __builtin_amdgcn_sched_barrier(0);
#pragma unroll
            for (int r_ = 0; r_ < 4; ++r_) O[rb4 + r_] = __builtin_amdgcn_mfma_f32_16x16x32_fp8_fp8(tf_[r_], pb, O[rb4 + r_], 0, 0, 0);
        }
    }
    l += __shfl_xor(l, 16); l += __shfl_xor(l, 32);
    const float il = 1.f / l;
    if (l15 < 8) {
#pragma unroll
        for (int rb = 0; rb < 16; ++rb) { u32x2 w; w.x = pg8::cvt_pk_bf16(O[rb][0] * il, O[rb][1] * il); w.y = pg8::cvt_pk_bf16(O[rb][2] * il, O[rb][3] * il);
            *(u32x2*)(OLAT + ((size_t)t * 8 + l15) * 256 + 16 * rb + 4 * g) = w; }
    }
    }
}
#undef DSA_GATHER
__device__ __forceinline__ int lds_take(LAS unsigned* ctr, int lane) {
    int u = 0; if (lane == 0) u = (int)__hip_atomic_fetch_add(ctr, 1u, __ATOMIC_RELAXED, __HIP_MEMORY_SCOPE_WORKGROUP);
    return __builtin_amdgcn_readfirstlane(u);
}
__device__ __forceinline__ int dsa_query_of(int u, int G) {
    const int k = u >> 3, r = u & 7;
    int cl, bb, grp;
    if (G == 256) { const int idx = ((int)blockIdx.x >> 1) + 128 * k; cl = 1 + (idx >> 4); grp = idx & 15; bb = (int)blockIdx.x & 1; }
    else { const int P = (int)blockIdx.x + k * G; cl = 1 + (P >> 5); bb = (P >> 4) & 1; grp = P & 15; }
    const int c = (r < 4) ? 65 - cl : cl;
    return (c << 8) | (bb << 6) | (4 * grp + (r & 3));
}
__device__ __forceinline__ int dsa_token_of(int qi) { return ((qi >> 6) & 1) * SEQ + ((qi >> 8) - 1) * 64 + (qi & 63); }
__device__ __forceinline__ void phase_dsa(const Params& p, LAS unsigned char* lds, int wave, int lane, int probe) {
    LAS float* LUTA = (LAS float*)(lds + DSA_LUT); LAS unsigned* ctr = (LAS unsigned*)(lds + DSA_LUT + 155 * 8 * 4);
    const int G = (int)gridDim.x, l15 = lane & 15, g = lane >> 4;
    __syncthreads();
    for (int i = threadIdx.x; i < 155 * 8; i += 512) LUTA[i] = p.rel_bias[t5_bucket((i >> 3) - 91) * 16 + (i & 7)] * LOG2E;
    if (threadIdx.x == 0) ctr[0] = 0u;
    const int npi = (1024 - (int)blockIdx.x + G - 1) / G;
    const int nun = npi * 8;
    __syncthreads();
    for (;;) {
        const int u = lds_take(ctr, lane); if (u >= nun) break;
        dsa_unit(p, lds, dsa_query_of(u, G), wave, lane, probe);
    }
}

#define XB_TMO      128
#define XB_XCNT(j)  (256  + 64 * (j))
#define XB_XSUB(j)  (1280 + 64 * (j))
#define XB_XGEN(j)  (2304 + 64 * (j))
#define XB_TOP      3328
#define XB_TOPGEN   3392
#define XCD_BAR_WORDS 3456
#define XB_SPIN_CAP (1u << 24)
__device__ __forceinline__ unsigned xb_ld(unsigned* p)              { return __hip_atomic_load(p, __ATOMIC_RELAXED, __HIP_MEMORY_SCOPE_AGENT); }
__device__ __forceinline__ unsigned xb_add(unsigned* p, unsigned v) { return __hip_atomic_fetch_add(p, v, __ATOMIC_RELAXED, __HIP_MEMORY_SCOPE_AGENT); }
__device__ __forceinline__ unsigned xb_xcc_id() { return (unsigned)__builtin_amdgcn_s_getreg((3 << 11) | 20) & 0xFu; }
#define XB_SPIN(cond, bar) do { unsigned _sp = 0; while (cond) { __builtin_amdgcn_s_sleep(1); \
    if ((++_sp & 255u) == 0u) { if (xb_ld(&(bar)[XB_TMO])) break; if (_sp > XB_SPIN_CAP) { atomicAdd(&(bar)[XB_TMO], 1u); break; } } } } while (0)
struct XcdBarrier { unsigned* bar; unsigned x; volatile LAS unsigned* st; };
__device__ __forceinline__ XcdBarrier xcd_barrier_post(unsigned* bar, volatile LAS unsigned* st) {
    XcdBarrier b; b.bar = bar; b.x = xb_xcc_id(); b.st = st;
    if (threadIdx.x == 0) (void)xb_add(&bar[XB_XCNT(b.x)], 1u);
    return b;
}
__device__ __forceinline__ void xcd_barrier_complete(unsigned* bar, unsigned x, unsigned& nloc, unsigned& nx) {
    const unsigned G = gridDim.x * gridDim.y * gridDim.z;
    unsigned sum, cnt, mine, sp = 0u;
    for (;;) {
        sum = 0u; cnt = 0u; mine = 0u;
#pragma unroll
        for (unsigned j = 0; j < 16; ++j) { const unsigned c = xb_ld(&bar[XB_XCNT(j)]); sum += c; cnt += (c > 0u) ? 1u : 0u; mine = (j == x) ? c : mine; }
        if (sum == G) break;
        __builtin_amdgcn_s_sleep(1);
        if ((++sp & 255u) == 0u) { if (xb_ld(&bar[XB_TMO])) break; if (sp > XB_SPIN_CAP) { atomicAdd(&bar[XB_TMO], 1u); break; } }
    }
    nloc = mine > 0u ? mine : 1u; nx = cnt > 0u ? cnt : 1u;
}
__device__ __forceinline__ void xcd_barrier(const XcdBarrier& b) {
    asm volatile("s_waitcnt vmcnt(0)" ::: "memory");
    __syncthreads();
    if (threadIdx.x == 0) {
        unsigned* bar = b.bar;
        __builtin_amdgcn_s_waitcnt(0);
        unsigned nloc = b.st[0], nx = b.st[1];
        if (nloc == 0u) { xcd_barrier_complete(bar, b.x, nloc, nx); b.st[0] = nloc; b.st[1] = nx; }
        const unsigned old = xb_add(&bar[XB_XSUB(b.x)], 1u);
        const unsigned gen = old / nloc;
        if (old + 1u == (gen + 1u) * nloc) {
            __builtin_amdgcn_fence(__ATOMIC_RELEASE, "agent");
            asm volatile("s_waitcnt vmcnt(0)" ::: "memory");
            const unsigned og = xb_add(&bar[XB_TOP], 1u);
            const unsigned tg = og / nx;
            if (og + 1u == (tg + 1u) * nx) xb_add(&bar[XB_TOPGEN], 1u);
            else XB_SPIN(xb_ld(&bar[XB_TOPGEN]) == tg, bar);
            __builtin_amdgcn_fence(__ATOMIC_ACQUIRE, "agent");
            xb_add(&bar[XB_XGEN(b.x)], 1u);
            asm volatile("s_waitcnt vmcnt(0)" ::: "memory");
        } else {
            XB_SPIN(xb_ld(&bar[XB_XGEN(b.x)]) == gen, bar);
            __builtin_amdgcn_fence(__ATOMIC_ACQUIRE, "agent");
            asm volatile("s_waitcnt vmcnt(0)" ::: "memory");
        }
    }
    __syncthreads();
}

constexpr int LDS_BYTES = 147456, MISC_OFF = 147456 - 256;
constexpr int NPHASE = 8;
#ifndef ONE_LAUNCH
#define ONE_LAUNCH 1
#endif

struct KArgs { Params p; int ph_lo, ph_hi, probe, pad; };
__global__ void __launch_bounds__(512, 2) k_fwd(KArgs a) {
    extern __shared__ __attribute__((aligned(16))) unsigned char lds_raw[];
    LAS unsigned char* lds = (LAS unsigned char*)lds_raw;
    const Params& p = a.p;
    const int tid = threadIdx.x, lane = tid & 63, wave = __builtin_amdgcn_readfirstlane(tid >> 6);
    const int gw = blockIdx.x * 8 + wave, ngw = gridDim.x * 8;
    volatile LAS unsigned* misc = (volatile LAS unsigned*)(lds + MISC_OFF);
    if (tid < 64) misc[tid] = 0u;
    __syncthreads();
    XcdBarrier bar; bar.bar = WSP(unsigned, WS_CTL) + 4096; bar.x = 0; bar.st = misc;
    if (ONE_LAUNCH) bar = xcd_barrier_post(WSP(unsigned, WS_CTL) + 4096, misc);
#define IN(k) (a.ph_lo <= 0 && 0 < a.ph_hi)
#define SEAM(k) do { xcd_barrier(bar); } while (0)
#define RUNPH(k, ...) do { if (IN(k)) { constexpr int nrep_ = (PROBE_REP == (k)) ? 2 : 1; _Pragma("unroll") for (int rep = 0; rep < nrep_; ++rep) { if (rep) xcd_barrier(bar); __VA_ARGS__ } } } while (0)
    RUNPH(0, const int lane_ = opaque_tid() & 63; phase0(p, lds, gw, ngw, wave, lane_, 0, (gridDim.x == 256) ? p.jobs[13].item0 : p.nitems););
    SEAM(0);
    RUNPH(1,
        SchedInproj S{DM, (int)gridDim.x, (int)blockIdx.x, (const char*)WSP(bf16_t, WS_U), (const char*)WSP(bf16_t, WS_WIN)};
        EpiInproj E{WSP(bf16_t, WS_QA), WSP(bf16_t, WS_ZA), WSP(bf16_t, WS_IQ), WSP(bf16_t, WS_QB), WSP(bf16_t, WS_ZB), WSP(bf16_t, WS_GA), WSP(bf16_t, WS_GB), WSP(bf16_t, WS_KB), WSP(bf16_t, WS_VB),
                    WSP(float, WS_CKVRAW), WSP(bf16_t, WS_IK), WSP(float, WS_IW), 0.125f * LOG2E, p.ikn_w, p.ikn_b};
        pg8::gemm_phase<EpiInproj, SchedInproj>(lds, S, E);
        if (gridDim.x == 256 && blockIdx.x >= 202) { const int lane_ = opaque_tid() & 63; phase0(p, lds, ((int)blockIdx.x - 202) * 8 + wave, 54 * 8, wave, lane_, p.jobs[13].item0, p.nitems); });
    SEAM(1);
    RUNPH(33, const int lane_ = opaque_tid() & 63; phase_ckvnorm(p, gw, ngw, lane_););
    RUNPH(32, phase_qlat(p, lds););
    RUNPH(30, phase_diff(p, lds););
    RUNPH(31, phase_scores(p, lds););
    SEAM(3);
    RUNPH(4, const int lane_ = opaque_tid() & 63; phase_dsa(p, lds, wave, lane_, a.probe););
    SEAM(4);
    RUNPH(8, phase_oproj(p, lds););
    SEAM(8);
    RUNPH(5,
        SchedMix S{1024, (int)gridDim.x, (int)blockIdx.x, (const char*)WSP(bf16_t, WS_OZA), (const char*)WSP(bf16_t, WS_WOA), (const char*)WSP(bf16_t, WS_OZB), (const char*)WSP(bf16_t, WS_WOB)};
        EpiMix E{WSP(const bf16_t, WS_GA), WSP(const bf16_t, WS_GB), WSP(bf16_t, WS_MIX)};
        pg8::gemm_phase<EpiMix, SchedMix>(lds, S, E););
    SEAM(5);
    if (gridDim.x == 256) {
        RUNPH(6,
            SchedOut S{DM, (int)gridDim.x, (int)blockIdx.x, (const char*)WSP(bf16_t, WS_MIX), (const char*)WSP(bf16_t, WS_WOUT)};
            EpiOutFused E{p.x, p.post_w, p.out, WSP(float, WS_SSQ), WSP(unsigned, WS_CTL) + 8192, lds};
            pg8::gemm_phase<EpiOutFused, SchedOut>(lds, S, E););
    } else {
        RUNPH(6,
            SchedOut S{DM, (int)gridDim.x, (int)blockIdx.x, (const char*)WSP(bf16_t, WS_MIX), (const char*)WSP(bf16_t, WS_WOUT)};
            EpiOut E{WSP(bf16_t, WS_OUTPRE), WSP(float, WS_SSQ)};
            pg8::gemm_phase<EpiOut, SchedOut>(lds, S, E););
        SEAM(6);
        RUNPH(7, const int lane_ = opaque_tid() & 63; phase7(p, gw, ngw, lane_););
    }
#undef RUNPH
#undef IN
#undef SEAM
}

static void add_job(Params& p, const float* src, bf16_t* dst, int K, int N, int col0, int ncols, int row0) {
    TJob& j = p.jobs[p.njobs++]; j.src = src; j.dst = dst; j.K = K; j.N = N; j.col0 = col0; j.nblk = (ncols + 31) / 32; j.row0 = row0; j.item0 = p.nitems; p.nitems += (K / 64) * j.nblk;
}
extern "C" void kernel_launch(void* const* d_in, const int* in_sizes, int n_in, void* d_out, int out_size, void* d_ws, size_t ws_size, hipStream_t stream) {
    if (n_in != 16 || ws_size < WS_END) { fprintf(stderr, "kernel_launch: unexpected arguments (n_in %d, ws %zu)\n", n_in, ws_size); return; }
    static int grid = 0;
    if (!grid) {
        int dev = 0, cus = 0, per_cu = 0;
        (void)hipGetDevice(&dev); (void)hipDeviceGetAttribute(&cus, hipDeviceAttributeMultiprocessorCount, dev);
        (void)hipFuncSetAttribute((const void*)k_fwd, hipFuncAttributeMaxDynamicSharedMemorySize, LDS_BYTES);
        (void)hipOccupancyMaxActiveBlocksPerMultiprocessor(&per_cu, (const void*)k_fwd, 512, LDS_BYTES);
        (void)hipGetLastError();
        grid = cus > 0 ? cus : 256;
        if (per_cu < 1) fprintf(stderr, "kernel_launch: occupancy query reports %d blocks per CU\n", per_cu);
    }
    KArgs a; memset(&a, 0, sizeof(a));
    Params& p = a.p;
    const float** in = (const float**)d_in;
    p.x = in[0]; p.meta = in[1]; p.rel_bias = in[2]; p.pre_w = in[3]; p.w_in = in[4]; p.kv_norm_w = in[5]; p.w_uk = in[6]; p.w_uv = in[7]; p.ikn_w = in[8]; p.ikn_b = in[9];
    p.lam_p = in[10]; p.subln_w = in[11]; p.w_o_a = in[12]; p.w_o_b = in[13]; p.w_out = in[14]; p.post_w = in[15];
    p.out = (float*)d_out; p.ws = (unsigned char*)d_ws;
    bf16_t* WIN = (bf16_t*)(p.ws + WS_WIN);
    const int NIN = 11600;
    add_job(p, p.w_in, WIN, DM, NIN, 0, 1024, 0);
    add_job(p, p.w_in, WIN, DM, NIN, 1280, 1024, 1024);
    add_job(p, p.w_in, WIN, DM, NIN, 2304, 1024, 2048);
    add_job(p, p.w_in, WIN, DM, NIN, 3408, 1024, 3072);
    add_job(p, p.w_in, WIN, DM, NIN, 6480, 1024, 4096);
    add_job(p, p.w_in, WIN, DM, NIN, 7504, 2048, 5120);
    add_job(p, p.w_in, WIN, DM, NIN, 9552, 2048, 7168);
    add_job(p, p.w_in, WIN, DM, NIN, 4432, 1024, 9216);
    add_job(p, p.w_in, WIN, DM, NIN, 5456, 1024, 10240);
    add_job(p, p.w_in, WIN, DM, NIN, 1024, 256, 11264);
    add_job(p, p.w_in, WIN, DM, NIN, 3328, 32, 11520);
    add_job(p, p.w_in, WIN, DM, NIN, 3392, 32, 11520 + 32);
    add_job(p, p.w_in, WIN, DM, NIN, 3360, 32, 11520 + 128);
    add_job(p, p.w_o_a, (bf16_t*)(p.ws + WS_WOA), 1024, DM, 0, DM, 0);
    add_job(p, p.w_o_b, (bf16_t*)(p.ws + WS_WOB), 1024, DM, 0, DM, 0);
    add_job(p, p.w_out, (bf16_t*)(p.ws + WS_WOUT), DM, DM, 0, DM, 0);
    add_job(p, p.w_uv, (bf16_t*)(p.ws + WS_WUVT), 256, 1024, 0, 1024, 0);
    (void)hipMemsetAsync((char*)d_ws + WS_CTL, 0, CTL_BYTES, stream);
#if ONE_LAUNCH
    a.ph_lo = 0; a.ph_hi = NPHASE; a.probe = PROBE_REP;
    hipLaunchKernelGGL(k_fwd, dim3(grid), dim3(512), LDS_BYTES, stream, a);
#else
    for (int ph = 0; ph < NPHASE; ++ph) { a.ph_lo = ph; a.ph_hi = ph + 1; hipLaunchKernelGGL(k_fwd, dim3(grid), dim3(512), LDS_BYTES, stream, a); }
#endif
}
```

```cpp
#include <hip/hip_runtime.h>
#include <cstdio>
#include <cstdint>
#include <cstring>

#ifndef PROBE_REP
#define PROBE_REP (-1)
#endif
#define LAS __attribute__((address_space(3)))
#define GAS __attribute__((address_space(1)))
typedef unsigned short bf16_t;
typedef short bf16x8 __attribute__((ext_vector_type(8)));
typedef float f32x4 __attribute__((ext_vector_type(4)));
typedef unsigned u32x4 __attribute__((ext_vector_type(4)));
typedef unsigned u32x2 __attribute__((ext_vector_type(2)));
typedef int v8i32 __attribute__((ext_vector_type(8)));
typedef int v4i32 __attribute__((ext_vector_type(4)));

constexpr int DM = 2048, NB = 2, SEQ = 4096, NMETA = 16, TK = SEQ + NMETA  , MTOK = NB * SEQ  , MKEY = NB * TK  ;
constexpr int UROWS = 8448;
constexpr int NPAD = 11776;
constexpr float EPS = 1e-6f;
constexpr float LOG2E = 1.4426950408889634f;
constexpr size_t SC_PER_B = 8585216;

constexpr size_t MiB = 1u << 20;
constexpr size_t WS_CTL = 0, CTL_BYTES = 1 * MiB;
constexpr size_t WS_U = 1 * MiB;
constexpr size_t WS_WIN = 34 * MiB;
constexpr size_t WS_SC = 1 * MiB;
constexpr size_t WS_MIX = 1 * MiB;
constexpr size_t WS_WOA = 80 * MiB, WS_WOB = 84 * MiB, WS_WOUT = 88 * MiB, WS_WUK = 96 * MiB, WS_WUVT = 96 * MiB + 512 * 1024;
constexpr size_t WS_QA = 97 * MiB, WS_IQ = 113 * MiB, WS_QB = 129 * MiB, WS_ZA = 145 * MiB, WS_ZB = 161 * MiB, WS_GA = 177 * MiB, WS_GB = 209 * MiB;
constexpr size_t WS_OLAT = 241 * MiB;
constexpr size_t WS_OZA = 129 * MiB;
constexpr size_t WS_KB = 241 * MiB, WS_VB = 258 * MiB, WS_CKVRAW = 275 * MiB, WS_IKRAW = 284 * MiB, WS_IW = 287 * MiB, WS_CKV = 288 * MiB, WS_IK = 293 * MiB;
constexpr size_t WS_QLAT = 295 * MiB;
constexpr size_t WS_OUTPRE = 295 * MiB;
constexpr size_t WS_OZB = 327 * MiB, WS_SSQ = 343 * MiB, WS_U8 = 344 * MiB, WS_END = 360 * MiB;
constexpr size_t WS_W8 = WS_WIN + (size_t)5120 * 2048 * 2;

__device__ __forceinline__ int opaque_tid() { int t = threadIdx.x; asm volatile("" : "+v"(t)); return t; }
__device__ __forceinline__ float bf2f(unsigned short u) { return __uint_as_float(((unsigned)u) << 16); }
__device__ __forceinline__ unsigned f2bf(float f) { unsigned u = __float_as_uint(f); return (u + 0x7fffu + ((u >> 16) & 1u)) >> 16; }
__device__ __forceinline__ unsigned pk2(float lo, float hi) { return f2bf(lo) | (f2bf(hi) << 16); }
__device__ __forceinline__ float bflo(unsigned w) { return __uint_as_float(w << 16); }
__device__ __forceinline__ float bfhi(unsigned w) { return __uint_as_float(w & 0xffff0000u); }
__device__ __forceinline__ float wave_sum(float v) {
#pragma unroll
    for (int o = 1; o < 64; o <<= 1) v += __shfl_xor(v, o);
    return v;
}
__device__ __forceinline__ float silu_f(float x) { return x * __builtin_amdgcn_rcpf(1.f + __expf(-x)); }
__device__ __forceinline__ int t5_bucket(int rel) {
    const int n = rel < 0 ? -rel : rel; int f;
    if (n < 8) f = n; else if (n < 12) f = 8; else if (n < 16) f = 9; else if (n < 23) f = 10; else if (n < 32) f = 11; else if (n < 46) f = 12; else if (n < 64) f = 13; else if (n < 91) f = 14; else f = 15;
    return (rel > 0 ? 16 : 0) + f;
}
__device__ __forceinline__ size_t sc_off(int b, int j) {
    const int c = 1 + (j >> 6);
    return (size_t)b * SC_PER_B + (size_t)1024 * (c - 1) + (size_t)2048 * (c - 1) * c + (size_t)(j & 63) * (16 + 64 * c);
}

namespace pg8 {
constexpr int BM = 256, BK = 64, HALF = 128, HTB = HALF * BK * 2, STAGE_BYTES = 8 * HTB, NXCD = 8, WGM = 8;
__host__ __device__ __forceinline__ int lds_byte(int r, int c) { const int st = (r >> 4) * 2 + (c >> 5), rr = r & 15, cc = c & 31, ob = rr * 64 + cc * 2; return st * 1024 + (ob ^ (((ob >> 9) & 1) << 5)); }
__host__ __device__ __forceinline__ void stage_rc(int b, int& R, int& C) { const int st = b / 1024, sb = b % 1024, swz = sb ^ (((sb >> 9) & 1) << 5); R = (st >> 1) * 16 + swz / 64; C = (st & 1) * 32 + (swz % 64) / 2; }
__host__ __device__ __forceinline__ int perm32(int rho) { const int n = rho >> 4, i = rho & 15; return 8 * (i >> 2) + 4 * n + (i & 3); }

struct Unit { int pm, pn, sub; };
__device__ __forceinline__ unsigned cvt_pk_bf16(float lo, float hi) { unsigned r; asm volatile("v_cvt_pk_bf16_f32 %0, %1, %2" : "=v"(r) : "v"(lo), "v"(hi)); return r; }

__device__ __forceinline__ void tile_of(int L, int nM, int nN, int& pm, int& pn) {
    const int nwg = nM * nN; int wgid = L; { const int q = nwg / NXCD, r = nwg % NXCD, xcd = wgid % NXCD, off = wgid / NXCD; wgid = (xcd < r ? xcd * (q + 1) : r * (q + 1) + (xcd - r) * q) + off; }
    const int nig = WGM * nN, gid = wgid / nig, fm = gid * WGM, gsz = (nM - fm) < WGM ? (nM - fm) : WGM;
    pm = fm + ((wgid % nig) % gsz); pn = (wgid % nig) / gsz;
}

template <class Epi, class Sched, bool ALIGN_EPI = true, bool SP2 = true, bool FP8 = false>
__device__ __forceinline__ void gemm_phase(LAS unsigned char* lds, const Sched& S, const Epi& E) {
    const int tid = opaque_tid(), wid = __builtin_amdgcn_readfirstlane(tid >> 6), lane = tid & 63, wr = wid >> 2, wc = wid & 3, fr = lane & 15, fq = lane >> 4;
    const int K = FP8 ? S.K / 2 : S.K, nt = K / BK;
    unsigned voffA[2], voffB[2];
#pragma unroll
    for (int i = 0; i < 2; ++i) { int R, C; stage_rc(tid * 16 + i * 8192, R, C); const int Rb = Epi::PERM ? ((R & ~31) + perm32(R & 31)) : R;
        voffA[i] = (unsigned)(R * K + C) * 2u; voffB[i] = (unsigned)(Rb * K + C) * 2u; }
    const size_t kstep = (size_t)(BK * 2);
    const size_t hstep = (size_t)HALF * K * 2;
    const unsigned ldsw = (unsigned)wid * 1024u, lds0 = (unsigned)(size_t)lds;
    const int aoff = lds_byte(wr * 64 + fr, fq * 8), boff = lds_byte(wc * 32 + fr, fq * 8);
#define PG8_SA(b, h) (((b) * 2 + (h)) * HTB)
#define PG8_SB(b, h) ((4 + (b) * 2 + (h)) * HTB)
#define PG8_STAGE(bufoff, gbase, voff) do { _Pragma("unroll") for (int _i = 0; _i < 2; ++_i) { \
        if constexpr (FP8) { unsigned keep_; asm volatile("s_mov_b32 %0, m0\n\ts_mov_b32 m0, %3\n\ts_nop 0\n\tglobal_load_lds_dwordx4 %1, %2\n\ts_mov_b32 m0, %0" \
                : "=&s"(keep_) : "v"((voff)[_i]), "s"((const char*)(gbase)), "s"(lds0 + (unsigned)(bufoff) + ldsw + (unsigned)(_i * 8192)) : "memory"); } \
        else __builtin_amdgcn_global_load_lds((const unsigned*)((const char*)(gbase) + (voff)[_i]), (LAS unsigned*)(lds + (bufoff) + ldsw + _i * 8192), 16, 0, 0); } } while (0)
#define PG8_LD8(dst, addr) do { const v4i32 lo_ = *(const LAS v4i32*)(addr), hi_ = *(const LAS v4i32*)((addr) + 1024); dst = __builtin_shufflevector(lo_, hi_, 0, 1, 2, 3, 4, 5, 6, 7); } while (0)
#define PG8_LDA(dst, b, h) do { if constexpr (FP8) { _Pragma("unroll") for (int m = 0; m < 4; ++m) PG8_LD8(dst##8[m], lds + PG8_SA(b, h) + aoff + m * 2048); } else { \
        _Pragma("unroll") for (int m = 0; m < 4; ++m) _Pragma("unroll") for (int k = 0; k < 2; ++k) dst[m][k] = *(const LAS bf16x8*)(lds + PG8_SA(b, h) + aoff + m * 2048 + k * 1024); } } while (0)
#define PG8_LDB(dst, b, h) do { if constexpr (FP8) { _Pragma("unroll") for (int n = 0; n < 2; ++n) PG8_LD8(dst##8[n], lds + PG8_SB(b, h) + boff + n * 2048); } else { \
        _Pragma("unroll") for (int n = 0; n < 2; ++n) _Pragma("unroll") for (int k = 0; k < 2; ++k) dst[n][k] = *(const LAS bf16x8*)(lds + PG8_SB(b, h) + boff + n * 2048 + k * 1024); } } while (0)
#define PG8_MMA(ai, bj, At, Bt) do { __builtin_amdgcn_s_setprio(1); _Pragma("unroll") for (int m = 0; m < 4; ++m) _Pragma("unroll") for (int n = 0; n < 2; ++n) _Pragma("unroll") for (int k = 0; k < 2; ++k) \
        acc[ai][bj][m][n] = __builtin_amdgcn_mfma_f32_16x16x32_bf16(Bt[n][k], At[m][k], acc[ai][bj][m][n], 0, 0, 0); __builtin_amdgcn_s_setprio(0); } while (0)
#define PG8_MMA8(ai, bj, At, Bt) do { __builtin_amdgcn_s_setprio(1); _Pragma("unroll") for (int m = 0; m < 4; ++m) _Pragma("unroll") for (int n = 0; n < 2; ++n) \
        acc[ai][bj][m][n] = __builtin_amdgcn_mfma_scale_f32_16x16x128_f8f6f4(Bt##8[n], At##8[m], acc[ai][bj][m][n], 0, 0, 0, 0x7f7f7f7f, 0, 0x7f7f7f7f); __builtin_amdgcn_s_setprio(0); } while (0)
#define PG8_MM(ai, bj, At, Bt) do { if constexpr (FP8) PG8_MMA8(ai, bj, At, Bt); else PG8_MMA(ai, bj, At, Bt); } while (0)
#define PG8_WAIT_V(n) asm volatile("s_waitcnt vmcnt(" #n ")" ::: "memory")
#define PG8_WAIT_L(n) asm volatile("s_waitcnt lgkmcnt(" #n ")" ::: "memory")
#define PG8_BAR __builtin_amdgcn_s_barrier()
#define PG8_SCHED __builtin_amdgcn_sched_barrier(0)
    Unit cur, nxt; int ui = 0;
    if (!S.next(0, cur)) return;
    f32x4 acc[2][2][4][2];
#pragma unroll
    for (int a = 0; a < 2; ++a)
#pragma unroll
        for (int b = 0; b < 2; ++b)
#pragma unroll
            for (int m = 0; m < 4; ++m)
#pragma unroll
                for (int n = 0; n < 2; ++n) acc[a][b][m][n] = (f32x4){0.f, 0.f, 0.f, 0.f};
    bf16x8 At[4][2], B0[2][2], B1[2][2];
    v8i32 At8[4], B08[2], B18[2];
    const char* cA = S.a_ptr(cur); const char* cB = S.b_ptr(cur);
    if constexpr (SP2) {
        PG8_STAGE(PG8_SB(0, 0), cB, voffB); PG8_STAGE(PG8_SB(0, 1), cB + hstep, voffB); PG8_STAGE(PG8_SA(0, 0), cA, voffA); PG8_STAGE(PG8_SA(0, 1), cA + hstep, voffA);
        if (wr == 1) PG8_BAR;
        PG8_WAIT_V(2); PG8_BAR;
        PG8_STAGE(PG8_SB(1, 0), cB + kstep, voffB); PG8_STAGE(PG8_SA(1, 0), cA + kstep, voffA); PG8_STAGE(PG8_SB(1, 1), cB + hstep + kstep, voffB);
        PG8_WAIT_V(6); PG8_BAR;
    } else {
        PG8_STAGE(PG8_SB(0, 0), cB, voffB); PG8_STAGE(PG8_SA(0, 0), cA, voffA); PG8_STAGE(PG8_SB(0, 1), cB + hstep, voffB); PG8_STAGE(PG8_SA(0, 1), cA + hstep, voffA);
        if (wr == 1) PG8_BAR;
        PG8_WAIT_V(4); PG8_BAR;
        PG8_STAGE(PG8_SB(1, 0), cB + kstep, voffB); PG8_STAGE(PG8_SA(1, 0), cA + kstep, voffA); PG8_STAGE(PG8_SB(1, 1), cB + hstep + kstep, voffB);
        PG8_WAIT_V(6); PG8_BAR;
    }
    for (;;) {
        const bool has_next = S.next(ui + 1, nxt);
        const char* nA = has_next ? S.a_ptr(nxt) : cA; const char* nB = has_next ? S.b_ptr(nxt) : cB;
        for (int t = 0; t < nt; t += 2) {
            const bool last = (t == nt - 2);
            const char* a1 = cA + (size_t)(t + 1) * kstep;
            const char* a2 = last ? nA : cA + (size_t)(t + 2) * kstep; const char* b2 = last ? nB : cB + (size_t)(t + 2) * kstep;
            const char* a3 = a2 + kstep; const char* b3 = b2 + kstep;
            if constexpr (SP2) {
            PG8_LDB(B0, 0, 0); PG8_LDB(B1, 0, 1); PG8_SCHED; PG8_LDA(At, 0, 0); PG8_STAGE(PG8_SA(1, 1), a1 + hstep, voffA);
            PG8_WAIT_V(8); PG8_WAIT_L(0); PG8_BAR; PG8_MM(0, 0, At, B0); PG8_MM(0, 1, At, B1); PG8_BAR; PG8_SCHED;
            PG8_LDA(At, 0, 1); PG8_STAGE(PG8_SB(0, 0), b2, voffB); PG8_STAGE(PG8_SB(0, 1), b2 + hstep, voffB); PG8_STAGE(PG8_SA(0, 0), a2, voffA);
            PG8_WAIT_V(8); PG8_WAIT_L(0); PG8_BAR; PG8_MM(1, 0, At, B0); PG8_MM(1, 1, At, B1); PG8_BAR; PG8_SCHED;
            PG8_LDB(B0, 1, 0); PG8_LDB(B1, 1, 1); PG8_SCHED; PG8_LDA(At, 1, 0); PG8_STAGE(PG8_SA(0, 1), a2 + hstep, voffA);
            PG8_WAIT_V(8); PG8_WAIT_L(0); PG8_BAR; PG8_MM(0, 0, At, B0); PG8_MM(0, 1, At, B1); PG8_BAR; PG8_SCHED;
            PG8_LDA(At, 1, 1); PG8_STAGE(PG8_SB(1, 0), b3, voffB); PG8_STAGE(PG8_SB(1, 1), b3 + hstep, voffB); PG8_STAGE(PG8_SA(1, 0), a3, voffA);
            PG8_WAIT_V(8); PG8_WAIT_L(0); PG8_BAR; PG8_MM(1, 0, At, B0); PG8_MM(1, 1, At, B1); PG8_BAR; PG8_SCHED;
            } else {
            PG8_LDB(B0, 0, 0); PG8_SCHED; PG8_LDA(At, 0, 0); PG8_STAGE(PG8_SA(1, 1), a1 + hstep, voffA);
            PG8_WAIT_L(8); PG8_BAR; PG8_WAIT_L(0); PG8_MM(0, 0, At, B0); PG8_BAR; PG8_SCHED;
            PG8_LDB(B1, 0, 1); PG8_STAGE(PG8_SB(0, 0), b2, voffB);
            PG8_BAR; PG8_WAIT_L(0); PG8_MM(0, 1, At, B1); PG8_BAR;
            PG8_LDA(At, 0, 1); PG8_STAGE(PG8_SA(0, 0), a2, voffA);
            PG8_BAR; PG8_WAIT_L(0); PG8_MM(1, 0, At, B0); PG8_BAR; PG8_SCHED;
            PG8_STAGE(PG8_SB(0, 1), b2 + hstep, voffB);
            PG8_WAIT_V(6); PG8_BAR; PG8_MM(1, 1, At, B1); PG8_BAR;
            PG8_LDB(B0, 1, 0); PG8_SCHED; PG8_LDA(At, 1, 0); PG8_STAGE(PG8_SA(0, 1), a2 + hstep, voffA);
            PG8_WAIT_L(8); PG8_BAR; PG8_WAIT_L(0); PG8_MM(0, 0, At, B0); PG8_BAR; PG8_SCHED;
            PG8_LDB(B1, 1, 1); PG8_STAGE(PG8_SB(1, 0), b3, voffB);
            PG8_BAR; PG8_WAIT_L(0); PG8_MM(0, 1, At, B1); PG8_BAR;
            PG8_LDA(At, 1, 1); PG8_STAGE(PG8_SA(1, 0), a3, voffA);
            PG8_BAR; PG8_WAIT_L(0); PG8_MM(1, 0, At, B0); PG8_BAR; PG8_SCHED;
            PG8_STAGE(PG8_SB(1, 1), b3 + hstep, voffB);
            PG8_WAIT_V(6); PG8_BAR; PG8_MM(1, 1, At, B1); PG8_BAR;
            }
        }
        if constexpr (ALIGN_EPI) { if (wr == 0) PG8_BAR; }
        E(acc, cur, wr, wc, fr, fq);
        if (!has_next) break;
        if (!E.keep_acc(cur)) {
#pragma unroll
        for (int a = 0; a < 2; ++a)
#pragma unroll
            for (int b = 0; b < 2; ++b)
#pragma unroll
                for (int m = 0; m < 4; ++m)
#pragma unroll
                    for (int n = 0; n < 2; ++n) acc[a][b][m][n] = (f32x4){0.f, 0.f, 0.f, 0.f};
        }
        cur = nxt; cA = nA; cB = nB; ++ui;
        if constexpr (ALIGN_EPI) { if (wr == 1) PG8_BAR; }
    }
    PG8_WAIT_V(0);
    if constexpr (!ALIGN_EPI) { if (wr == 0) PG8_BAR; }
    PG8_BAR;
#undef PG8_SA
#undef PG8_SB
#undef PG8_STAGE
#undef PG8_LDA
#undef PG8_LDB
#undef PG8_MMA
#undef PG8_MMA8
#undef PG8_LD8
#undef PG8_MM
#undef PG8_WAIT_V
#undef PG8_WAIT_L
#undef PG8_BAR
#undef PG8_SCHED
}
}

struct SchedInproj {
    int K, G, c; const char* A; const char* B;
    __device__ __forceinline__ bool next(int i, pg8::Unit& u) const {
        const int L = i * G + c; u.sub = 0;
        if (L < 960) { int pn; pg8::tile_of(L, 32, 30, u.pm, pn); u.pn = pn < 20 ? pn : pn + 16; return true; }
        if (L < 970) { u.pm = 32; u.pn = 36 + (L - 960); return true; }
        return false;
    }
    __device__ __forceinline__ const char* a_ptr(const pg8::Unit& u) const { return A + (size_t)u.pm * 256 * K * 2; }
    __device__ __forceinline__ const char* b_ptr(const pg8::Unit& u) const { return B + (size_t)u.pn * 256 * K * 2; }
};
struct SchedGate {
    int K, G, c; const char* A; const char* B;
    __device__ __forceinline__ bool next(int i, pg8::Unit& u) const {
        const int L = i * G + c; u.sub = 0; if (L >= 512) return false;
        int pn; pg8::tile_of(L, 32, 16, u.pm, pn); u.pn = 20 + pn; return true;
    }
    __device__ __forceinline__ const char* a_ptr(const pg8::Unit& u) const { return A + (size_t)u.pm * 256 * K; }
    __device__ __forceinline__ const char* b_ptr(const pg8::Unit& u) const { return B + (size_t)(u.pn - 20) * 256 * K; }
};
struct EpiInproj {
    static constexpr bool PERM = true;
    bf16_t *QA, *ZA, *IQ, *QB, *ZB, *GA, *GB, *KB, *VB; float *CKVRAW; bf16_t* IKN; float* IW; float qb_scale; const float *ikn_w, *ikn_b; float gscale;
    __device__ __forceinline__ bool keep_acc(const pg8::Unit&) const { return false; }
    __device__ __forceinline__ void operator()(f32x4 (&acc)[2][2][4][2], const pg8::Unit& u, int wr, int wc, int fr, int fq) const {
        const int pn = u.pn;
        if (pn < 44) {
            bf16_t* base; int ldc = 1024, ct, act = 0; bool kside = false;
            if (pn < 4) { base = QA; ct = pn; } else if (pn < 8) { base = ZA; ct = pn - 4; act = 1; } else if (pn < 12) { base = IQ; ct = pn - 8; }
            else if (pn < 16) { base = QB; ct = pn - 12; act = 2; } else if (pn < 20) { base = ZB; ct = pn - 16; act = 1; }
            else if (pn < 28) { base = GA; ct = pn - 20; ldc = 2048; act = 3; } else if (pn < 36) { base = GB; ct = pn - 28; ldc = 2048; act = 3; }
            else if (pn < 40) { base = KB; ct = pn - 36; kside = true; } else { base = VB; ct = pn - 40; kside = true; }
            const float sc = (act == 2) ? qb_scale : (act == 3) ? gscale : 1.f;
#pragma unroll
            for (int ai = 0; ai < 2; ++ai)
#pragma unroll
                for (int m = 0; m < 4; ++m) {
                    const int r = u.pm * 256 + ai * 128 + wr * 64 + m * 16 + fr;
                    long drow = r, drow2 = -1; bool ok = true;
                    if (kside) { if (r < MTOK) drow = (long)(r >> 12) * TK + NMETA + (r & 4095); else { const int i = r - MTOK; ok = i < NMETA; drow = i; drow2 = TK + i; } }
#pragma unroll
                    for (int bj = 0; bj < 2; ++bj) {
                        f32x4 v0 = acc[ai][bj][m][0], v1 = acc[ai][bj][m][1];
                        if (act == 1) {
#pragma unroll
                            for (int e = 0; e < 4; ++e) { v0[e] = silu_f(v0[e]); v1[e] = silu_f(v1[e]); }
                        }
                        v0 = v0 * sc; v1 = v1 * sc;
                        u32x4 w; w.x = pg8::cvt_pk_bf16(v0[0], v0[1]); w.y = pg8::cvt_pk_bf16(v0[2], v0[3]); w.z = pg8::cvt_pk_bf16(v1[0], v1[1]); w.w = pg8::cvt_pk_bf16(v1[2], v1[3]);
                        const int col = ct * 256 + bj * 128 + wc * 32 + 8 * fq;
                        if (ok) { *(u32x4*)(base + (size_t)drow * ldc + col) = w; if (drow2 >= 0) *(u32x4*)(base + (size_t)drow2 * ldc + col) = w; }
                    }
                }
        } else {
#pragma unroll
            for (int ai = 0; ai < 2; ++ai)
#pragma unroll
                for (int m = 0; m < 4; ++m) {
                    const int r = u.pm * 256 + ai * 128 + wr * 64 + m * 16 + fr;
                    long drow, drow2 = -1; bool ok = true;
                    if (r < MTOK) drow = (long)(r >> 12) * TK + NMETA + (r & 4095); else { const int i = r - MTOK; ok = i < NMETA; drow = i; drow2 = TK + i; }
                    if (pn == 44) {
#pragma unroll
                        for (int bj = 0; bj < 2; ++bj) {
                            const f32x4 v0 = acc[ai][bj][m][0], v1 = acc[ai][bj][m][1];
                            const int col = bj * 128 + wc * 32 + 8 * fq;
                            if (ok) { float* p = CKVRAW + (size_t)drow * 256 + col; *(f32x4*)p = v0; *(f32x4*)(p + 4) = v1;
                                      if (drow2 >= 0) { float* p2 = CKVRAW + (size_t)drow2 * 256 + col; *(f32x4*)p2 = v0; *(f32x4*)(p2 + 4) = v1; } }
                        }
                    } else if (wc == 0) {
                        const f32x4 a0 = acc[ai][0][m][0], a1 = acc[ai][0][m][1], b0 = acc[ai][1][m][0], b1 = acc[ai][1][m][1];
                        float s = ((a0[0] + a0[1]) + (a0[2] + a0[3])) + ((a1[0] + a1[1]) + (a1[2] + a1[3])) + ((b0[0] + b0[1]) + (b0[2] + b0[3])) + ((b1[0] + b1[1]) + (b1[2] + b1[3]));
                        s += __shfl_xor(s, 16); s += __shfl_xor(s, 32);
                        const float mu = s * (1.f / 64.f);
                        const f32x4 da0 = a0 - mu, da1 = a1 - mu, db0 = b0 - mu, db1 = b1 - mu;
                        float q = ((da0[0] * da0[0] + da0[1] * da0[1]) + (da0[2] * da0[2] + da0[3] * da0[3])) + ((da1[0] * da1[0] + da1[1] * da1[1]) + (da1[2] * da1[2] + da1[3] * da1[3]))
                                + ((db0[0] * db0[0] + db0[1] * db0[1]) + (db0[2] * db0[2] + db0[3] * db0[3])) + ((db1[0] * db1[0] + db1[1] * db1[1]) + (db1[2] * db1[2] + db1[3] * db1[3]));
                        q += __shfl_xor(q, 16); q += __shfl_xor(q, 32);
                        const float rs = rsqrtf(q * (1.f / 64.f) + EPS);
                        const f32x4 wa0 = *(const f32x4*)(ikn_w + 8 * fq), wa1 = *(const f32x4*)(ikn_w + 8 * fq + 4), wb0 = *(const f32x4*)(ikn_w + 32 + 8 * fq), wb1 = *(const f32x4*)(ikn_w + 36 + 8 * fq);
                        const f32x4 ba0 = *(const f32x4*)(ikn_b + 8 * fq), ba1 = *(const f32x4*)(ikn_b + 8 * fq + 4), bb0 = *(const f32x4*)(ikn_b + 32 + 8 * fq), bb1 = *(const f32x4*)(ikn_b + 36 + 8 * fq);
                        const f32x4 ya0 = da0 * rs * wa0 + ba0, ya1 = da1 * rs * wa1 + ba1, yb0 = db0 * rs * wb0 + bb0, yb1 = db1 * rs * wb1 + bb1;
                        u32x4 pa, pb;
                        pa.x = pg8::cvt_pk_bf16(ya0[0], ya0[1]); pa.y = pg8::cvt_pk_bf16(ya0[2], ya0[3]); pa.z = pg8::cvt_pk_bf16(ya1[0], ya1[1]); pa.w = pg8::cvt_pk_bf16(ya1[2], ya1[3]);
                        pb.x = pg8::cvt_pk_bf16(yb0[0], yb0[1]); pb.y = pg8::cvt_pk_bf16(yb0[2], yb0[3]); pb.z = pg8::cvt_pk_bf16(yb1[0], yb1[1]); pb.w = pg8::cvt_pk_bf16(yb1[2], yb1[3]);
                        if (ok) { *(u32x4*)(IKN + (size_t)drow * 64 + 8 * fq) = pa; *(u32x4*)(IKN + (size_t)drow * 64 + 32 + 8 * fq) = pb;
                                  if (drow2 >= 0) { *(u32x4*)(IKN + (size_t)drow2 * 64 + 8 * fq) = pa; *(u32x4*)(IKN + (size_t)drow2 * 64 + 32 + 8 * fq) = pb; } }
                    } else if (wc == 1) {
                        const f32x4 v0 = acc[ai][0][m][0], v1 = acc[ai][0][m][1];
                        if (fq < 2 && r < MTOK) { float* p = IW + (size_t)r * 16 + 8 * fq; *(f32x4*)p = v0 * 0.03125f; *(f32x4*)(p + 4) = v1 * 0.03125f; }
                    }
                }
        }
    }
};
struct EpiGate {
    static constexpr bool PERM = true;
    bf16_t *GA, *GB;
    __device__ __forceinline__ bool keep_acc(const pg8::Unit&) const { return false; }
    __device__ __forceinline__ void operator()(f32x4 (&acc)[2][2][4][2], const pg8::Unit& u, int wr, int wc, int fr, int fq) const {
        bf16_t* base = (u.pn < 28 ? GA + (u.pn - 20) * 256 : GB + (u.pn - 28) * 256) + (size_t)(u.pm * 256 + wr * 64 + fr) * DM + wc * 32 + 8 * fq;
#pragma unroll
        for (int ai = 0; ai < 2; ++ai)
#pragma unroll
            for (int m = 0; m < 4; ++m)
#pragma unroll
                for (int bj = 0; bj < 2; ++bj) {
                    const f32x4 v0 = acc[ai][bj][m][0] * 0.015625f, v1 = acc[ai][bj][m][1] * 0.015625f;
                    u32x4 w; w.x = pg8::cvt_pk_bf16(v0[0], v0[1]); w.y = pg8::cvt_pk_bf16(v0[2], v0[3]); w.z = pg8::cvt_pk_bf16(v1[0], v1[1]); w.w = pg8::cvt_pk_bf16(v1[2], v1[3]);
                    *(u32x4*)(base + (size_t)(ai * 128 + m * 16) * DM + bj * 128) = w;
                }
    }
};
struct SchedMix {
    int K, G, c; const char *A0, *B0, *A1, *B1;
    __device__ __forceinline__ bool next(int i, pg8::Unit& u) const {
        const int L = (i >> 1) * G + c; if (L >= 256) return false;
        pg8::tile_of(L, 32, 8, u.pm, u.pn); u.sub = i & 1; return true;
    }
    __device__ __forceinline__ const char* a_ptr(const pg8::Unit& u) const { return (u.sub ? A1 : A0) + (size_t)u.pm * 256 * K * 2; }
    __device__ __forceinline__ const char* b_ptr(const pg8::Unit& u) const { return (u.sub ? B1 : B0) + (size_t)u.pn * 256 * K * 2; }
};
struct EpiMix {
    static constexpr bool PERM = true;
    const bf16_t *GA, *GB; bf16_t* MIX;
    __device__ __forceinline__ bool keep_acc(const pg8::Unit& u) const { return u.sub == 0; }
    static __device__ __forceinline__ float sg_e(float a) { return __expf(-fminf(fmaxf(a, -30.f), 30.f)); }
    __device__ __forceinline__ void operator()(f32x4 (&acc)[2][2][4][2], const pg8::Unit& u, int wr, int wc, int fr, int fq) const {
        const size_t base = (size_t)(u.pm * 256 + wr * 64 + fr) * DM + u.pn * 256 + wc * 32 + 8 * fq;
        if (u.sub == 0) {
#pragma unroll
            for (int ai = 0; ai < 2; ++ai) {
                u32x4 ga[4][2], gb[4][2];
#pragma unroll
                for (int m = 0; m < 4; ++m)
#pragma unroll
                    for (int bj = 0; bj < 2; ++bj) { const size_t o = base + (size_t)(ai * 128 + m * 16) * DM + bj * 128; ga[m][bj] = *(const u32x4*)(GA + o); gb[m][bj] = *(const u32x4*)(GB + o); }
#pragma unroll
                for (int m = 0; m < 4; ++m)
#pragma unroll
                    for (int bj = 0; bj < 2; ++bj)
#pragma unroll
                        for (int e = 0; e < 4; ++e) {
                            const unsigned wa = ga[m][bj][e], wb = gb[m][bj][e];
                            const float f0 = (1.f + sg_e(bflo(wb))) * __builtin_amdgcn_rcpf(1.f + sg_e(bflo(wa))), f1 = (1.f + sg_e(bfhi(wb))) * __builtin_amdgcn_rcpf(1.f + sg_e(bfhi(wa)));
                            const int n = e >> 1, j = (e & 1) * 2;
                            acc[ai][bj][m][n][j] *= f0; acc[ai][bj][m][n][j + 1] *= f1;
                        }
            }
        } else {
            u32x4 gb[2][4][2];
#pragma unroll
            for (int m = 0; m < 4; ++m)
#pragma unroll
                for (int bj = 0; bj < 2; ++bj) gb[0][m][bj] = *(const u32x4*)(GB + base + (size_t)(m * 16) * DM + bj * 128);
#pragma unroll
            for (int ai = 0; ai < 2; ++ai) {
                if (ai == 0) {
#pragma unroll
                    for (int m = 0; m < 4; ++m)
#pragma unroll
                        for (int bj = 0; bj < 2; ++bj) gb[1][m][bj] = *(const u32x4*)(GB + base + (size_t)(128 + m * 16) * DM + bj * 128);
                }
#pragma unroll
                for (int m = 0; m < 4; ++m)
#pragma unroll
                    for (int bj = 0; bj < 2; ++bj) {
                        float v[8];
#pragma unroll
                        for (int e = 0; e < 4; ++e) {
                            const unsigned wb = gb[ai][m][bj][e]; const int n = e >> 1, j = (e & 1) * 2;
                            v[2 * e] = acc[ai][bj][m][n][j] * __builtin_amdgcn_rcpf(1.f + sg_e(bflo(wb))); v[2 * e + 1] = acc[ai][bj][m][n][j + 1] * __builtin_amdgcn_rcpf(1.f + sg_e(bfhi(wb)));
                        }
                        u32x4 w; w.x = pg8::cvt_pk_bf16(v[0], v[1]); w.y = pg8::cvt_pk_bf16(v[2], v[3]); w.z = pg8::cvt_pk_bf16(v[4], v[5]); w.w = pg8::cvt_pk_bf16(v[6], v[7]);
                        *(u32x4*)(MIX + base + (size_t)(ai * 128 + m * 16) * DM + bj * 128) = w;
                    }
            }
        }
    }
};
struct SchedOut {
    int K, G, c; const char *A, *B;
    __device__ __forceinline__ bool next(int i, pg8::Unit& u) const { const int L = i * G + c; if (L >= 256) return false; pg8::tile_of(L, 32, 8, u.pm, u.pn); u.sub = 0; return true; }
    __device__ __forceinline__ const char* a_ptr(const pg8::Unit& u) const { return A + (size_t)u.pm * 256 * K * 2; }
    __device__ __forceinline__ const char* b_ptr(const pg8::Unit& u) const { return B + (size_t)u.pn * 256 * K * 2; }
};
struct EpiOut {
    static constexpr bool PERM = true;
    bf16_t* OUTPRE; float* SSQ;
    __device__ __forceinline__ bool keep_acc(const pg8::Unit&) const { return false; }
    __device__ __forceinline__ void operator()(f32x4 (&acc)[2][2][4][2], const pg8::Unit& u, int wr, int wc, int fr, int fq) const {
#pragma unroll
        for (int ai = 0; ai < 2; ++ai)
#pragma unroll
            for (int m = 0; m < 4; ++m) {
                const int r = u.pm * 256 + ai * 128 + wr * 64 + m * 16 + fr; float ss = 0.f;
#pragma unroll
                for (int bj = 0; bj < 2; ++bj) {
                    const f32x4 v0 = acc[ai][bj][m][0], v1 = acc[ai][bj][m][1];
                    ss += (v0[0] * v0[0] + v0[1] * v0[1]) + (v0[2] * v0[2] + v0[3] * v0[3]) + (v1[0] * v1[0] + v1[1] * v1[1]) + (v1[2] * v1[2] + v1[3] * v1[3]);
                    u32x4 w; w.x = pg8::cvt_pk_bf16(v0[0], v0[1]); w.y = pg8::cvt_pk_bf16(v0[2], v0[3]); w.z = pg8::cvt_pk_bf16(v1[0], v1[1]); w.w = pg8::cvt_pk_bf16(v1[2], v1[3]);
                    *(u32x4*)(OUTPRE + (size_t)r * DM + u.pn * 256 + bj * 128 + wc * 32 + 8 * fq) = w;
                }
                ss += __shfl_xor(ss, 16); ss += __shfl_xor(ss, 32);
                if (fq == 0) SSQ[(size_t)r * 32 + u.pn * 4 + wc] = ss;
            }
    }
};

struct EpiOutFused {
    static constexpr bool PERM = false;
    const float* x; const float* post_w; float* out; float* SSQ; unsigned* cnt; LAS unsigned char* lds;
    __device__ __forceinline__ bool keep_acc(const pg8::Unit&) const { return false; }
    __device__ __forceinline__ void operator()(f32x4 (&acc)[2][2][4][2], const pg8::Unit& u, int wr, int wc, int fr, int fq) const {
        const int tid = opaque_tid(), wid = __builtin_amdgcn_readfirstlane(tid >> 6), lane = tid & 63;
        LAS float* S = (LAS float*)(lds + 131072);
#pragma unroll
        for (int ai = 0; ai < 2; ++ai)
#pragma unroll
            for (int m = 0; m < 4; ++m) {
                float ss = 0.f;
#pragma unroll
                for (int bj = 0; bj < 2; ++bj)
#pragma unroll
                    for (int n = 0; n < 2; ++n) { const f32x4 v = acc[ai][bj][m][n]; ss += (v[0] * v[0] + v[1] * v[1]) + (v[2] * v[2] + v[3] * v[3]); }
                ss += __shfl_xor(ss, 16); ss += __shfl_xor(ss, 32);
                if (fq == 0) __hip_atomic_store(SSQ + (size_t)(u.pm * 256 + ai * 128 + wr * 64 + m * 16 + fr) * 32 + u.pn * 4 + wc, ss, __ATOMIC_RELAXED, __HIP_MEMORY_SCOPE_AGENT);
            }
        asm volatile("s_waitcnt vmcnt(0)" ::: "memory");
        if (lane == 0) __hip_atomic_fetch_add(cnt + 64 * u.pm, 1u, __ATOMIC_RELAXED, __HIP_MEMORY_SCOPE_AGENT);
        if (wid == 0) {
            for (unsigned it = 0; it < (1u << 22); ++it) {
                if ((unsigned)__builtin_amdgcn_readfirstlane(__hip_atomic_load(cnt + 64 * u.pm, __ATOMIC_RELAXED, __HIP_MEMORY_SCOPE_AGENT)) >= 64u) break;
                __builtin_amdgcn_s_sleep(2);
            }
            __builtin_amdgcn_fence(__ATOMIC_ACQUIRE, "agent");
        }
        asm volatile("s_waitcnt vmcnt(0) lgkmcnt(0)" ::: "memory"); __builtin_amdgcn_s_barrier(); asm volatile("" ::: "memory");
        if (tid < 256) {
            const unsigned long long* slot = (const unsigned long long*)(SSQ + (size_t)(u.pm * 256 + tid) * 32); float s = 0.f;
#pragma unroll
            for (int t = 0; t < 16; ++t) { const unsigned long long w = __hip_atomic_load(slot + t, __ATOMIC_RELAXED, __HIP_MEMORY_SCOPE_AGENT); s += __uint_as_float((unsigned)w) + __uint_as_float((unsigned)(w >> 32)); }
            S[tid] = rsqrtf(s * (1.f / DM) + EPS);
        }
        asm volatile("s_waitcnt lgkmcnt(0)" ::: "memory"); __builtin_amdgcn_s_barrier(); asm volatile("" ::: "memory");
        const f32x4 g = *(const f32x4*)(post_w + u.pn * 256 + 4 * lane);
        const int lr0 = 4 * wid;
        const size_t gbase = (size_t)(u.pm * 256 + (lr0 >> 4) * 64 + (lr0 & 15)) * DM + u.pn * 256 + 4 * lane;
        const unsigned woff = (unsigned)((wr * 16 + fr) * 1040 + (wc * 32 + 4 * fq) * 4), roff = (unsigned)(lr0 * 1040 + lane * 16);
        f32x4 xv[4], xn[4];
#pragma unroll
        for (int q = 0; q < 4; ++q) xv[q] = __builtin_nontemporal_load((const f32x4*)(x + gbase + (size_t)q * DM));
#pragma unroll
        for (int s = 0; s < 8; ++s) {
            const int ai = s >> 2, m = s & 3; LAS unsigned char* T = lds + (s & 1) * 33280;
            const float rs = S[ai * 128 + wr * 64 + m * 16 + fr];
#pragma unroll
            for (int bj = 0; bj < 2; ++bj)
#pragma unroll
                for (int n = 0; n < 2; ++n) *(LAS f32x4*)(T + woff + bj * 512 + n * 64) = acc[ai][bj][m][n] * rs;
            if (s < 7) {
                const size_t o2 = (size_t)(((s + 1) >> 2) * 128 + ((s + 1) & 3) * 16) * DM;
#pragma unroll
                for (int q = 0; q < 4; ++q) xn[q] = __builtin_nontemporal_load((const f32x4*)(x + gbase + o2 + (size_t)q * DM));
            }
            asm volatile("s_waitcnt lgkmcnt(0)" ::: "memory"); __builtin_amdgcn_s_barrier(); asm volatile("" ::: "memory");
            const size_t o1 = (size_t)(ai * 128 + m * 16) * DM;
#pragma unroll
            for (int q = 0; q < 4; ++q) { const f32x4 v = *(const LAS f32x4*)(T + roff + q * 1040); __builtin_nontemporal_store(xv[q] + v * g, (f32x4*)(out + gbase + o1 + (size_t)q * DM)); }
#pragma unroll
            for (int q = 0; q < 4; ++q) xv[q] = xn[q];
        }
    }
};

struct TJob { const float* src; bf16_t* dst; int K, N, col0, nblk, row0, item0, fp8, pad_; };
struct Params {
    const float *x, *meta, *rel_bias, *pre_w, *w_in, *kv_norm_w, *w_uk, *w_uv, *ikn_w, *ikn_b, *lam_p, *subln_w, *w_o_a, *w_o_b, *w_out, *post_w;
    float* out; unsigned char* ws;
    TJob jobs[17]; int njobs, nitems;
};
#define WSP(T, off) ((T*)(p.ws + (off)))

__device__ __forceinline__ void p0_transpose_item(const TJob& jb, LAS float* scr, int item, int lane) {
    const int kb = item / jb.nblk, nb = item % jb.nblk, k0 = 64 * kb, n0 = jb.col0 + 32 * nb;
#pragma unroll 8
    for (int i = 0; i < 32; ++i) { const int kk = 2 * i + (lane >> 5); scr[kk * 33 + (lane & 31)] = __builtin_nontemporal_load(jb.src + (size_t)(k0 + kk) * jb.N + n0 + (lane & 31)); }
    asm volatile("s_waitcnt lgkmcnt(0)" ::: "memory");
    const int c = lane & 7;
#pragma unroll
    for (int j = 0; j < 4; ++j) { const int n = (lane >> 3) + 8 * j; const LAS float* s = scr + (8 * c) * 33 + n;
        u32x4 o; o.x = pk2(s[0 * 33], s[1 * 33]); o.y = pk2(s[2 * 33], s[3 * 33]); o.z = pk2(s[4 * 33], s[5 * 33]); o.w = pk2(s[6 * 33], s[7 * 33]);
        if (!jb.fp8) *(u32x4*)(jb.dst + (size_t)(jb.row0 + 32 * nb + n) * jb.K + k0 + 8 * c) = o;
        else { int w0 = __builtin_amdgcn_cvt_pk_fp8_f32(s[0 * 33] * 64.f, s[1 * 33] * 64.f, 0, false); w0 = __builtin_amdgcn_cvt_pk_fp8_f32(s[2 * 33] * 64.f, s[3 * 33] * 64.f, w0, true);
               int w1 = __builtin_amdgcn_cvt_pk_fp8_f32(s[4 * 33] * 64.f, s[5 * 33] * 64.f, 0, false); w1 = __builtin_amdgcn_cvt_pk_fp8_f32(s[6 * 33] * 64.f, s[7 * 33] * 64.f, w1, true);
               u32x2 o8; o8.x = (unsigned)w0; o8.y = (unsigned)w1; *(u32x2*)((unsigned char*)jb.dst + (size_t)(jb.row0 + 32 * nb + n) * jb.K + k0 + 8 * c) = o8; } }
    asm volatile("s_waitcnt lgkmcnt(0)" ::: "memory");
}
__device__ __forceinline__ void p0_norm_row(const float* xrow, const float* g, bf16_t* orow, unsigned char* o8row, int lane) {
    const f32x4* xr = (const f32x4*)xrow + lane; const f32x4* gr = (const f32x4*)g + lane;
    f32x4 v[8]; float s = 0.f;
#pragma unroll
    for (int j = 0; j < 8; ++j) { v[j] = __builtin_nontemporal_load(xr + 64 * j); s += (v[j].x * v[j].x + v[j].y * v[j].y) + (v[j].z * v[j].z + v[j].w * v[j].w); }
    const float rstd = rsqrtf(wave_sum(s) * (1.f / DM) + EPS);
    u32x2* o8 = (u32x2*)orow + lane;
#pragma unroll
    for (int j = 0; j < 8; ++j) { const f32x4 gg = gr[64 * j]; const float y0 = v[j].x * rstd * gg.x, y1 = v[j].y * rstd * gg.y, y2 = v[j].z * rstd * gg.z, y3 = v[j].w * rstd * gg.w;
        u32x2 w; w.x = pk2(y0, y1); w.y = pk2(y2, y3); o8[64 * j] = w;
        if (o8row) { int q = __builtin_amdgcn_cvt_pk_fp8_f32(y0, y1, 0, false); q = __builtin_amdgcn_cvt_pk_fp8_f32(y2, y3, q, true); ((unsigned*)o8row)[64 * j + lane] = (unsigned)q; } }
}
__device__ __forceinline__ void phase0(const Params& p, LAS unsigned char* lds, int gw, int ngw, int wave, int lane, int item_lo, int item_hi) {
    LAS float* scr = (LAS float*)(lds + wave * 16384);
    for (int it = gw + item_lo; it < item_hi; it += ngw) {
        int jn = 0;
#pragma unroll
        for (int q = 1; q < 17; ++q) if (q < p.njobs && it >= p.jobs[q].item0) jn = q;
        p0_transpose_item(p.jobs[jn], scr, it - p.jobs[jn].item0, lane);
    }
    if (item_lo != 0) return;
    bf16_t* U = WSP(bf16_t, WS_U);
    for (int m = gw; m < UROWS; m += ngw) {
        if (m < MTOK) p0_norm_row(p.x + (size_t)m * DM, p.pre_w, U + (size_t)m * DM, WSP(unsigned char, WS_U8) + (size_t)m * DM, lane);
        else if (m < MTOK + NMETA) p0_norm_row(p.meta + (size_t)(m - MTOK) * DM, p.pre_w, U + (size_t)m * DM, nullptr, lane);
        else { u32x4* o = (u32x4*)(U + (size_t)m * DM) + lane;
#pragma unroll
            for (int j = 0; j < 4; ++j) o[64 * j] = (u32x4){0u, 0u, 0u, 0u}; }
    }
    bf16_t* WUK = WSP(bf16_t, WS_WUK);
    for (int i = gw * 64 + lane; i < 262144 / 4; i += ngw * 64) { const f32x4 v = ((const f32x4*)p.w_uk)[i]; u32x2 w; w.x = pk2(v.x, v.y); w.y = pk2(v.z, v.w); ((u32x2*)WUK)[i] = w; }
}

__device__ __forceinline__ void phase_ckvnorm(const Params& p, int gw, int ngw, int lane) {
    const float* CKVRAW = WSP(const float, WS_CKVRAW); bf16_t* CKV = WSP(bf16_t, WS_CKV);
    for (int r = gw; r < MKEY; r += ngw) {
        const f32x4 v = ((const f32x4*)(CKVRAW + (size_t)r * 256))[lane];
        const float ss = wave_sum((v.x * v.x + v.y * v.y) + (v.z * v.z + v.w * v.w));
        const float rstd = rsqrtf(ss * (1.f / 256.f) + EPS);
        const f32x4 g = ((const f32x4*)p.kv_norm_w)[lane];
        int w = __builtin_amdgcn_cvt_pk_fp8_f32(v.x * rstd * g.x, v.y * rstd * g.y, 0, false); w = __builtin_amdgcn_cvt_pk_fp8_f32(v.z * rstd * g.z, v.w * rstd * g.w, w, true);
        ((unsigned*)((unsigned char*)CKV + (size_t)r * 256))[lane] = (unsigned)w;
    }
}

__device__ __forceinline__ void phase7(const Params& p, int gw, int ngw, int lane) {
    const bf16_t* OUTPRE = WSP(const bf16_t, WS_OUTPRE); const float* SSQ = WSP(const float, WS_SSQ);
    for (int r = gw; r < MTOK; r += ngw) {
        float s = (lane < 32) ? SSQ[(size_t)r * 32 + lane] : 0.f; s = wave_sum(s);
        const float rstd = rsqrtf(s * (1.f / DM) + EPS);
        const u32x4* o = (const u32x4*)(OUTPRE + (size_t)r * DM); const f32x4* xr = (const f32x4*)(p.x + (size_t)r * DM); const f32x4* g = (const f32x4*)p.post_w; f32x4* out = (f32x4*)(p.out + (size_t)r * DM);
#pragma unroll
        for (int j = 0; j < 4; ++j) {
            const int ch = 64 * j + lane;
            const u32x4 w = o[ch]; const f32x4 x0 = __builtin_nontemporal_load(xr + 2 * ch), x1 = __builtin_nontemporal_load(xr + 2 * ch + 1), g0 = g[2 * ch], g1 = g[2 * ch + 1];
            f32x4 y0, y1;
            y0.x = x0.x + bflo(w.x) * rstd * g0.x; y0.y = x0.y + bfhi(w.x) * rstd * g0.y; y0.z = x0.z + bflo(w.y) * rstd * g0.z; y0.w = x0.w + bfhi(w.y) * rstd * g0.w;
            y1.x = x1.x + bflo(w.z) * rstd * g1.x; y1.y = x1.y + bfhi(w.z) * rstd * g1.y; y1.z = x1.z + bflo(w.w) * rstd * g1.z; y1.w = x1.w + bfhi(w.w) * rstd * g1.w;
            out[2 * ch] = y0; out[2 * ch + 1] = y1;
        }
    }
}

typedef short v4i16_t __attribute__((ext_vector_type(4)));
typedef float f32x2_t __attribute__((ext_vector_type(2))); typedef __bf16 bf16x2_t __attribute__((ext_vector_type(2)));
__device__ __forceinline__ unsigned cvtpk_s(float lo, float hi) { const f32x2_t v = {lo, hi}; const bf16x2_t b = __builtin_convertvector(v, bf16x2_t); return __builtin_bit_cast(unsigned, b); }
__device__ __forceinline__ unsigned off_b(unsigned row, unsigned ch) { const unsigned f = ((row >> 3) & 1u) | ((((row >> 2) ^ (row >> 3)) & 1u) << 1) | (((row >> 1) & 1u) << 2) | ((row & 1u) << 3); return 256u * row + 16u * (ch ^ f); }
__device__ __forceinline__ bf16x8 tr_frag(LAS unsigned char* img, unsigned a0, unsigned a1) {
    const v4i16_t lo = __builtin_amdgcn_ds_read_tr16_b64_v4i16((LAS v4i16_t*)(img + a0));
    const v4i16_t hi = __builtin_amdgcn_ds_read_tr16_b64_v4i16((LAS v4i16_t*)(img + a1));
    return (bf16x8){lo[0], lo[1], lo[2], lo[3], hi[0], hi[1], hi[2], hi[3]};
}
__device__ __forceinline__ void glds16(const void* gsrc, unsigned lds_dst) {
    unsigned keep;
    asm volatile("s_mov_b32 %0, m0\n\ts_mov_b32 m0, %2\n\ts_nop 0\n\tglobal_load_lds_dwordx4 %1, off\n\ts_mov_b32 m0, %0" : "=&s"(keep) : "v"(gsrc), "s"(lds_dst) : "memory");
}
constexpr int DB_K = 0, DB_V = 49152, DB_LUT = 98304, DB_Q = 99328;
constexpr float DIFF_THR = 24.0f;
__device__ __forceinline__ void diff_unit(const Params& p, LAS unsigned char* lds, int b, int h, int qb, float lam) {
    const bf16_t* QB = WSP(const bf16_t, WS_QB); const bf16_t* KB = WSP(const bf16_t, WS_KB); const bf16_t* VB = WSP(const bf16_t, WS_VB); const bf16_t* ZB = WSP(const bf16_t, WS_ZB); bf16_t* OZB = WSP(bf16_t, WS_OZB);
    const int tid = opaque_tid(), lane = tid & 63, wave = __builtin_amdgcn_readfirstlane(tid >> 6), l15 = lane & 15, g = lane >> 4;
    const int jw = 128 * qb + 16 * wave, jq = jw + l15, cw = 2 * qb + 1 + (wave >> 2), ntiles = 2 * qb + 3;
    LAS float* LUT = (LAS float*)(lds + DB_LUT);
    __syncthreads();
    if (tid < 155) LUT[tid] = p.rel_bias[t5_bucket(tid - 91) * 16 + 8 + h] * LOG2E;
    LAS unsigned char* Qimg = lds + DB_Q + wave * 4096;
    { const bf16_t* qp = QB + (size_t)(b * SEQ + jq) * 1024 + h * 128 + 8 * g;
#pragma unroll
      for (int s = 0; s < 4; ++s) *(LAS bf16x8*)(Qimg + off_b((unsigned)l15, 4u * s + (unsigned)g)) = *(const bf16x8*)(qp + 32 * s); }
    size_t dsrc[2];
#pragma unroll
    for (int i = 0; i < 2; ++i) { const unsigned row = 8u * wave + 4u * i + (unsigned)(lane >> 4); const unsigned f = (off_b(row & 15u, 0u) >> 4) & 15u;
        dsrc[i] = (size_t)row * 1024 + h * 128 + (((unsigned)(lane & 15)) ^ f) * 8; }
    const unsigned ddst = 2048u * wave;
    const unsigned lds0 = (unsigned)(size_t)lds;
#define DF_ROW0(tt) ((size_t)b * TK + ((tt) == 0 ? 0 : 16 + 64 * ((tt) - 1)))
#define DF_DMAK(tt, slot) do { const bf16_t* g_ = KB + DF_ROW0(tt) * 1024; _Pragma("unroll") for (int i_ = 0; i_ < 2; ++i_) \
        glds16(g_ + dsrc[i_], (unsigned)__builtin_amdgcn_readfirstlane((int)(lds0 + DB_K + (slot) * 16384 + ddst + 1024 * i_))); } while (0)
#define DF_DMAV(tt, slot) do { const bf16_t* g_ = VB + DF_ROW0(tt) * 1024; _Pragma("unroll") for (int i_ = 0; i_ < 2; ++i_) \
        glds16(g_ + dsrc[i_], (unsigned)__builtin_amdgcn_readfirstlane((int)(lds0 + DB_V + (slot) * 16384 + ddst + 1024 * i_))); } while (0)
#define DF_WAITBAR(n) do { if ((n) >= 4) asm volatile("s_waitcnt vmcnt(4) lgkmcnt(0)" ::: "memory"); else if ((n) >= 2) asm volatile("s_waitcnt vmcnt(2) lgkmcnt(0)" ::: "memory"); \
        else asm volatile("s_waitcnt vmcnt(0) lgkmcnt(0)" ::: "memory"); __builtin_amdgcn_s_barrier(); asm volatile("" ::: "memory"); } while (0)
    const unsigned q4 = (unsigned)l15 >> 2, pp = (unsigned)l15 & 3u;
    unsigned kbase[2][2], vbase[8];
#pragma unroll
    for (int mp = 0; mp < 2; ++mp)
#pragma unroll
        for (int s = 0; s < 2; ++s) kbase[mp][s] = off_b((unsigned)l15, 8u * mp + 4u * s + (unsigned)g);
#pragma unroll
    for (int c = 0; c < 8; ++c) vbase[c] = off_b(4u * g + q4, 2u * c + (pp >> 1)) + 8u * (pp & 1u);

    float m1 = 0.f, m2 = 0.f;
    f32x4 O1[8], O2[8], OL1 = (f32x4){0.f, 0.f, 0.f, 0.f}, OL2 = (f32x4){0.f, 0.f, 0.f, 0.f};
    const short one_ = (l15 == 0) ? (short)0x3F80 : (short)0;
    const bf16x8 onesf = (bf16x8){one_, one_, one_, one_, one_, one_, one_, one_};
#pragma unroll
    for (int c = 0; c < 8; ++c) { O1[c] = (f32x4){0.f, 0.f, 0.f, 0.f}; O2[c] = (f32x4){0.f, 0.f, 0.f, 0.f}; }
    f32x4 S1[4], S2[4];
    bf16x8 pa1[2], pa2[2];
    float es1 = 1.f, es2 = 1.f; bool pending = false;
    f32x4 cn1 = (f32x4){0.f, 0.f, 0.f, 0.f}, cn2 = cn1, cf1 = cn1, cf2 = cn1;

#define DF_QK(tt, kbo_) do { LAS unsigned char* Kb_ = lds + DB_K + (kbo_); \
        const int dmin_ = ((tt) == 0) ? (jw + 1) : (jw - 64 * (tt) + 1); const bool near_ = dmin_ < 91; \
        const f32x4 ci1_ = near_ ? cn1 : cf1, ci2_ = near_ ? cn2 : cf2;        \
        _Pragma("unroll") for (int s = 0; s < 2; ++s) { const bf16x8 q1_ = *(const LAS bf16x8*)(Qimg + kbase[0][s]), q2_ = *(const LAS bf16x8*)(Qimg + kbase[1][s]); \
          bf16x8 ka1_[4], ka2_[4]; \
          _Pragma("unroll") for (int mb = 0; mb < 4; ++mb) { ka1_[mb] = *(const LAS bf16x8*)(Kb_ + kbase[0][s] + 4096 * mb); ka2_[mb] = *(const LAS bf16x8*)(Kb_ + kbase[1][s] + 4096 * mb); } \
          __builtin_amdgcn_sched_barrier(0); \
          _Pragma("unroll") for (int mb = 0; mb < 4; ++mb) { \
            S1[mb] = __builtin_amdgcn_mfma_f32_16x16x32_bf16(ka1_[mb], q1_, s == 0 ? ci1_ : S1[mb], 0, 0, 0); S2[mb] = __builtin_amdgcn_mfma_f32_16x16x32_bf16(ka2_[mb], q2_, s == 0 ? ci2_ : S2[mb], 0, 0, 0); } } \
        if (near_) { _Pragma("unroll") for (int mb = 0; mb < 4; ++mb) _Pragma("unroll") for (int i = 0; i < 4; ++i) { \
            const int kr_ = 16 * mb + 4 * g + i; const int kpos_ = ((tt) == 0) ? kr_ : 16 + 64 * ((tt) - 1) + kr_; \
            int rel_ = kpos_ - (NMETA + jq); rel_ = rel_ < -91 ? -91 : (rel_ > 63 ? 63 : rel_); const float bias_ = LUT[rel_ + 91]; S1[mb][i] += bias_; S2[mb][i] += bias_; } } \
        if ((tt) == 0) { _Pragma("unroll") for (int mb = 1; mb < 4; ++mb) { S1[mb] = (f32x4){-INFINITY, -INFINITY, -INFINITY, -INFINITY}; S2[mb] = S1[mb]; } } } while (0)
#define DF_LMAX(t1_, t2_) do { t1_ = fmaxf(fmaxf(S1[0][0], S1[0][1]), S1[0][2]); t2_ = fmaxf(fmaxf(S2[0][0], S2[0][1]), S2[0][2]); \
        t1_ = fmaxf(fmaxf(t1_, S1[0][3]), S1[1][0]); t2_ = fmaxf(fmaxf(t2_, S2[0][3]), S2[1][0]); \
        t1_ = fmaxf(fmaxf(t1_, S1[1][1]), S1[1][2]); t2_ = fmaxf(fmaxf(t2_, S2[1][1]), S2[1][2]); \
        t1_ = fmaxf(fmaxf(t1_, S1[1][3]), S1[2][0]); t2_ = fmaxf(fmaxf(t2_, S2[1][3]), S2[2][0]); \
        t1_ = fmaxf(fmaxf(t1_, S1[2][1]), S1[2][2]); t2_ = fmaxf(fmaxf(t2_, S2[2][1]), S2[2][2]); \
        t1_ = fmaxf(fmaxf(t1_, S1[2][3]), S1[3][0]); t2_ = fmaxf(fmaxf(t2_, S2[2][3]), S2[3][0]); \
        t1_ = fmaxf(fmaxf(t1_, S1[3][1]), S1[3][2]); t2_ = fmaxf(fmaxf(t2_, S2[3][1]), S2[3][2]); \
        t1_ = fmaxf(t1_, S1[3][3]); t2_ = fmaxf(t2_, S2[3][3]); } while (0)
#define DF_RESCALE(t1_, t2_, forced_) do { float r1_ = t1_, r2_ = t2_; r1_ = fmaxf(r1_, __shfl_xor(r1_, 16)); r1_ = fmaxf(r1_, __shfl_xor(r1_, 32)); r2_ = fmaxf(r2_, __shfl_xor(r2_, 16)); r2_ = fmaxf(r2_, __shfl_xor(r2_, 32)); \
        const float d1_ = (forced_) ? r1_ : fmaxf(r1_, 0.f), d2_ = (forced_) ? r2_ : fmaxf(r2_, 0.f); m1 += d1_; m2 += d2_; \
        es1 = __builtin_amdgcn_exp2f(-d1_); es2 = __builtin_amdgcn_exp2f(-d2_); \
        _Pragma("unroll") for (int mb = 0; mb < 4; ++mb) { S1[mb] = S1[mb] - d1_; S2[mb] = S2[mb] - d2_; } \
        cn1 = (f32x4){-m1, -m1, -m1, -m1}; cn2 = (f32x4){-m2, -m2, -m2, -m2}; { const float f1_ = bias_far - m1, f2_ = bias_far - m2; cf1 = (f32x4){f1_, f1_, f1_, f1_}; cf2 = (f32x4){f2_, f2_, f2_, f2_}; } } while (0)
#define DF_SCALE_O() do { _Pragma("unroll") for (int i = 0; i < 4; ++i) { const float x1_ = __shfl(es1, 4 * g + i), x2_ = __shfl(es2, 4 * g + i); OL1[i] *= x1_; OL2[i] *= x2_; \
            _Pragma("unroll") for (int c = 0; c < 8; ++c) { O1[c][i] *= x1_; O2[c][i] *= x2_; } } } while (0)
#define DF_EXP() do { _Pragma("unroll") for (int mb = 0; mb < 4; ++mb) _Pragma("unroll") for (int i = 0; i < 4; ++i) { S1[mb][i] = __builtin_amdgcn_exp2f(S1[mb][i]); S2[mb][i] = __builtin_amdgcn_exp2f(S2[mb][i]); } \
        _Pragma("unroll") for (int ks = 0; ks < 2; ++ks) { u32x4 w1_, w2_; \
            w1_.x = cvtpk_s(S1[2 * ks][0], S1[2 * ks][1]); w1_.y = cvtpk_s(S1[2 * ks][2], S1[2 * ks][3]); w1_.z = cvtpk_s(S1[2 * ks + 1][0], S1[2 * ks + 1][1]); w1_.w = cvtpk_s(S1[2 * ks + 1][2], S1[2 * ks + 1][3]); \
            w2_.x = cvtpk_s(S2[2 * ks][0], S2[2 * ks][1]); w2_.y = cvtpk_s(S2[2 * ks][2], S2[2 * ks][3]); w2_.z = cvtpk_s(S2[2 * ks + 1][0], S2[2 * ks + 1][1]); w2_.w = cvtpk_s(S2[2 * ks + 1][2], S2[2 * ks + 1][3]); \
            pa1[ks] = __builtin_bit_cast(bf16x8, w1_); pa2[ks] = __builtin_bit_cast(bf16x8, w2_); } } while (0)
#define DF_PV(vbo_, pq1_, pq2_) do { LAS unsigned char* Vb_ = lds + DB_V + (vbo_); \
        _Pragma("unroll") for (int ks = 0; ks < 2; ++ks) { OL1 = __builtin_amdgcn_mfma_f32_16x16x32_bf16(pq1_[ks], onesf, OL1, 0, 0, 0); OL2 = __builtin_amdgcn_mfma_f32_16x16x32_bf16(pq2_[ks], onesf, OL2, 0, 0, 0); } \
        _Pragma("unroll") for (int c2 = 0; c2 < 8; c2 += 2) { bf16x8 vf_[2][2]; \
            _Pragma("unroll") for (int cc = 0; cc < 2; ++cc) _Pragma("unroll") for (int ks = 0; ks < 2; ++ks) vf_[cc][ks] = tr_frag(Vb_ + vbase[c2 + cc], 8192u * ks, 8192u * ks + 4096u); \
            _Pragma("unroll") for (int cc = 0; cc < 2; ++cc) _Pragma("unroll") for (int ks = 0; ks < 2; ++ks) { \
                O1[c2 + cc] = __builtin_amdgcn_mfma_f32_16x16x32_bf16(pq1_[ks], vf_[cc][ks], O1[c2 + cc], 0, 0, 0); O2[c2 + cc] = __builtin_amdgcn_mfma_f32_16x16x32_bf16(pq2_[ks], vf_[cc][ks], O2[c2 + cc], 0, 0, 0); } } } while (0)

    DF_DMAK(0, 0); DF_DMAV(0, 0); DF_DMAK(1, 1); DF_DMAV(1, 1); DF_DMAK(2, 2);
    asm volatile("s_waitcnt vmcnt(0) lgkmcnt(0)" ::: "memory"); __builtin_amdgcn_s_barrier(); asm volatile("" ::: "memory");
    const float bias_far = LUT[0];
    cf1 = (f32x4){bias_far, bias_far, bias_far, bias_far}; cf2 = cf1;
    { DF_QK(0, 0u); float t1, t2; DF_LMAX(t1, t2); DF_RESCALE(t1, t2, true); DF_EXP(); }
    asm volatile("s_waitcnt lgkmcnt(0)" ::: "memory"); __builtin_amdgcn_s_barrier(); asm volatile("" ::: "memory");
    int sk = 1, sv = 0;
    for (int t = 0; t < ntiles; ++t) {
        if (__builtin_expect(pending, 0)) { DF_SCALE_O(); pending = false; }
        int nnew = 0;
        { const int s3 = (sk == 0) ? 2 : sk - 1;
          if (t + 3 < ntiles) { DF_DMAK(t + 3, s3); nnew += 2; }
          const int s2 = (sv == 0) ? 2 : sv - 1;
          if (t + 2 < ntiles) { DF_DMAV(t + 2, s2); nnew += 2; } }
        unsigned kbo = (unsigned)sk * 16384u, vbo = (unsigned)sv * 16384u; asm volatile("" : "+v"(kbo), "+v"(vbo));
        if (t + 1 <= cw) {
            DF_QK(t + 1, kbo);
            float t1, t2; DF_LMAX(t1, t2);
            if (__builtin_expect(__any((t1 > DIFF_THR) || (t2 > DIFF_THR)), 0)) { DF_RESCALE(t1, t2, false); pending = true; }
            DF_PV(vbo, pa1, pa2);
            DF_EXP();
        } else if (t <= cw) {
            DF_PV(vbo, pa1, pa2);
        }
        DF_WAITBAR(nnew);
        sk = (sk == 2) ? 0 : sk + 1; sv = (sv == 2) ? 0 : sv + 1;
    }
    asm volatile("s_waitcnt vmcnt(0)" ::: "memory");
#undef DF_ROW0
#undef DF_DMAK
#undef DF_DMAV
#undef DF_WAITBAR
#undef DF_QK
#undef DF_LMAX
#undef DF_RESCALE
#undef DF_SCALE_O
#undef DF_EXP
#undef DF_PV
#pragma unroll
    for (int i = 0; i < 4; ++i) {
        const float r1 = 1.f / __shfl(OL1[i], 16 * g), r2 = lam / __shfl(OL2[i], 16 * g);
        float o[8]; float ss = 0.f;
#pragma unroll
        for (int c = 0; c < 8; ++c) { o[c] = O1[c][i] * r1 - O2[c][i] * r2; ss += o[c] * o[c]; }
        ss += __shfl_xor(ss, 1); ss += __shfl_xor(ss, 2); ss += __shfl_xor(ss, 4); ss += __shfl_xor(ss, 8);
        const float rs = rsqrtf(ss * (1.f / 128.f) + EPS) * 0.8f;
        const size_t t = (size_t)b * SEQ + jw + 4 * g + i;
#pragma unroll
        for (int c = 0; c < 8; ++c) { const int d = 16 * c + l15; const float y = o[c] * rs * p.subln_w[d] * bf2f(ZB[t * 1024 + h * 128 + d]); OZB[t * 1024 + h * 128 + d] = (bf16_t)f2bf(y); }
    }
}
__device__ __forceinline__ void phase_diff(const Params& p, LAS unsigned char* lds) {
    const int lane = threadIdx.x & 63;
    float a = (lane < 64) ? p.lam_p[lane] * p.lam_p[64 + lane] : 0.f, bb = p.lam_p[128 + lane] * p.lam_p[192 + lane];
    a = wave_sum(a); bb = wave_sum(bb);
    const float lam = expf(a) - expf(bb) + 0.2f;
    for (int u = blockIdx.x; u < 512; u += gridDim.x) {
        const int v = u & 255;
        int bh = v >> 4, s = v & 15;
        if (gridDim.x == 256) { bh = (v & 7) + 8 * (v >> 7); s = (v >> 3) & 15; }
        const int qb = (u < 256) ? s : 31 - s;
        diff_unit(p, lds, bh >> 3, bh & 7, qb, lam);
    }
}

typedef float f32x16 __attribute__((ext_vector_type(16)));
__device__ __forceinline__ void scores_wg_unit(const Params& p, LAS unsigned char* lds, int c, int b, int half, int kh) {
    const bf16_t* IQ = WSP(const bf16_t, WS_IQ); const float* IW = WSP(const float, WS_IW); float* SC = WSP(float, WS_SC);
    const int tid = opaque_tid(), lane = tid & 63, wave = __builtin_amdgcn_readfirstlane(tid >> 6);
    const int j0 = (c - 1) * 64 + 32 * half + 4 * wave, m0 = b * SEQ + j0, n = 16 + 64 * c, nkb = 2 * c + 1, nkh = (nkb + 1) >> 1;
    const int kbA = kh ? nkh : 0, kbB = kh ? nkb : nkh, ntile = (kbB - kbA + 1) >> 1;
    const int r32 = lane & 31, hi = lane >> 5, tok = r32 >> 4, hh = r32 & 15;
    bf16x8 af[2][4]; float wv[2][16];
#pragma unroll
    for (int pr = 0; pr < 2; ++pr) {
#pragma unroll
        for (int s = 0; s < 4; ++s) af[pr][s] = *(const bf16x8*)(IQ + (size_t)(m0 + 2 * pr + tok) * 1024 + hh * 64 + 16 * s + 8 * hi);
#pragma unroll
        for (int r = 0; r < 16; ++r) wv[pr][r] = IW[(size_t)(m0 + 2 * pr + (r >> 3)) * 16 + (r & 3) + 8 * ((r >> 2) & 1) + 4 * hi];
    }
    float* rowbase = SC + sc_off(b, j0);
    const bf16_t* ikb = WSP(const bf16_t, WS_IK) + (size_t)b * TK * 64;
    const int pkey = tid >> 3, pch = tid & 7;
    const unsigned pdst = (unsigned)pkey * 128u + 16u * (unsigned)(pch ^ (((pkey >> 1) & 1) | (((pkey >> 3) & 1) << 1) | (((pkey >> 4) & 1) << 2)));
    unsigned boff[4];
#pragma unroll
    for (int s = 0; s < 4; ++s) boff[s] = (unsigned)r32 * 128u + 16u * (unsigned)((2 * s + hi) ^ (((r32 >> 1) & 1) | (((r32 >> 3) & 1) << 1) | (((r32 >> 4) & 1) << 2)));
    u32x4 kreg[4];
#define SCW_LOAD(T_) do { _Pragma("unroll") for (int i_ = 0; i_ < 4; ++i_) { int key_ = 32 * (kbA + 8 * (T_)) + 64 * i_ + pkey; key_ = key_ < n ? key_ : n - 1; kreg[i_] = *(const u32x4*)(ikb + (size_t)key_ * 64 + pch * 8); } } while (0)
#define SCW_WRITE(off_) do { _Pragma("unroll") for (int i_ = 0; i_ < 4; ++i_) *(LAS u32x4*)(lds + (off_) + i_ * 8192 + pdst) = kreg[i_]; } while (0)
#define SCW_CHAIN(acc_, pr_, bf_) do { _Pragma("unroll") for (int r_ = 0; r_ < 16; ++r_) acc_[r_] = 0.f; \
        _Pragma("unroll") for (int s_ = 0; s_ < 4; ++s_) acc_ = __builtin_amdgcn_mfma_f32_32x32x16_bf16(af[pr_][s_], bf_[s_], acc_, 0, 0, 0); } while (0)
#define SCW_SUM(acc_, pr_, kb_, en_) do { f32x2_t s0_ = {0.f, 0.f}, s1_ = {0.f, 0.f}; \
        _Pragma("unroll") for (int r_ = 0; r_ < 8; r_ += 2) { \
            const f32x2_t x0_ = {__builtin_amdgcn_fmed3f(acc_[r_], 0.f, pinf), __builtin_amdgcn_fmed3f(acc_[r_ + 1], 0.f, pinf)}; \
            const f32x2_t x1_ = {__builtin_amdgcn_fmed3f(acc_[8 + r_], 0.f, pinf), __builtin_amdgcn_fmed3f(acc_[9 + r_], 0.f, pinf)}; \
            s0_ = __builtin_elementwise_fma((f32x2_t){wv[pr_][r_], wv[pr_][r_ + 1]}, x0_, s0_); s1_ = __builtin_elementwise_fma((f32x2_t){wv[pr_][8 + r_], wv[pr_][9 + r_]}, x1_, s1_); } \
        const float p0_ = s0_.x + s0_.y, p1_ = s1_.x + s1_.y; \
        const auto sw_ = __builtin_amdgcn_permlane32_swap(__float_as_uint(p0_), __float_as_uint(p1_), false, false); \
        const float tot_ = __uint_as_float(sw_[0]) + __uint_as_float(sw_[1]); const int key_ = 32 * (kb_) + r32; \
        if ((en_) && (kb_) < kbB && key_ < n) rowbase[(size_t)(2 * (pr_) + hi) * n + key_] = tot_; } while (0)
#define SCW_MIX() do { _Pragma("unroll") for (int g_ = 0; g_ < 4; ++g_) { __builtin_amdgcn_sched_group_barrier(0x008, 1, 0); __builtin_amdgcn_sched_group_barrier(0x002, 6, 0); } } while (0)
    __syncthreads();
    SCW_LOAD(0); SCW_WRITE(0u);
    __syncthreads();
    f32x16 accA, accB;
    float pinf = __builtin_inff(); asm volatile("" : "+v"(pinf));
#pragma unroll
    for (int r = 0; r < 16; ++r) accB[r] = 0.f;
    const int nsup = (ntile + 3) >> 2;
    for (int T = 0; T < nsup; ++T) {
        if (T + 1 < nsup) SCW_LOAD(T + 1);
        const int tend = (4 * T + 4 < ntile) ? 4 * T + 4 : ntile;
        for (int t = 4 * T; t < tend; ++t) {
            unsigned bo = (unsigned)(T & 1) * 32768u + (unsigned)(t & 3) * 8192u; asm volatile("" : "+v"(bo));
            const int kb0 = kbA + 2 * t;
            bf16x8 bf0[4], bf1[4];
#pragma unroll
            for (int s = 0; s < 4; ++s) bf0[s] = *(const LAS bf16x8*)(lds + bo + boff[s]);
#pragma unroll
            for (int s = 0; s < 4; ++s) bf1[s] = *(const LAS bf16x8*)(lds + bo + boff[s] + 4096);
            SCW_CHAIN(accA, 0, bf0); SCW_SUM(accB, 1, kb0 - 1, t > 0); SCW_MIX();
            SCW_CHAIN(accB, 1, bf0); SCW_SUM(accA, 0, kb0, true); SCW_MIX();
            SCW_CHAIN(accA, 0, bf1); SCW_SUM(accB, 1, kb0, true); SCW_MIX();
            SCW_CHAIN(accB, 1, bf1); SCW_SUM(accA, 0, kb0 + 1, true); SCW_MIX();
        }
        if (T + 1 < nsup) SCW_WRITE((unsigned)((T + 1) & 1) * 32768u);
        __syncthreads();
    }
    SCW_SUM(accB, 1, kbA + 2 * ntile - 1, true);
#undef SCW_CHAIN
#undef SCW_SUM
#undef SCW_MIX
#undef SCW_LOAD
#undef SCW_WRITE
}
__device__ __forceinline__ void phase_scores(const Params& p, LAS unsigned char* lds) {
    for (int P = (int)blockIdx.x; P < 256; P += (int)gridDim.x) {
        const int cl = 1 + (P >> 3), sub = P & 7;
        scores_wg_unit(p, lds, 65 - cl, sub >> 2, (sub >> 1) & 1, sub & 1);
        scores_wg_unit(p, lds, cl, sub >> 2, (sub >> 1) & 1, sub & 1);
    }
}
__device__ __forceinline__ void phase_qlat(const Params& p, LAS unsigned char* lds) {
    const bf16_t* QA = WSP(const bf16_t, WS_QA); const bf16_t* WUK = WSP(const bf16_t, WS_WUK); bf16_t* QLAT = WSP(bf16_t, WS_QLAT);
    const int tid = opaque_tid(), lane = tid & 63, w = __builtin_amdgcn_readfirstlane(tid >> 6), l15 = lane & 15, g = lane >> 4;
    const float sc = 0.08838834764831845f * LOG2E * 16.f;
    const int G = (int)gridDim.x;
    int hcur = -1;
    const unsigned kb0 = off_b((unsigned)l15, (unsigned)g);
    for (int u0 = (int)blockIdx.x; u0 < 4096; u0 += 8 * G) {
        const int h = u0 & 7;
        if (h != hcur || (G & 7)) { hcur = h; __syncthreads();
#pragma unroll
            for (int i = 0; i < 8; ++i) { const int idx = tid + 512 * i, row = idx >> 4, ch = idx & 15;
                *(LAS u32x4*)(lds + off_b((unsigned)row, (unsigned)ch)) = *(const u32x4*)(WUK + ((size_t)row * 8 + h) * 128 + ch * 8); }
            __syncthreads(); }
        const int u = u0 + w * G;
        if (u < 4096 && (u & 7) == h) {
            const int m0 = (u >> 3) * 16;
            bf16x8 bq[4];
#pragma unroll
            for (int s = 0; s < 4; ++s) bq[s] = *(const bf16x8*)(QA + (size_t)(m0 + l15) * 1024 + h * 128 + 32 * s + 8 * g);
#pragma unroll 4
            for (int nb = 0; nb < 16; ++nb) {
                bf16x8 af[4];
#pragma unroll
                for (int s = 0; s < 4; ++s) af[s] = *(const LAS bf16x8*)(lds + 4096 * nb + (kb0 ^ (64u * s)));
                f32x4 acc = (f32x4){0.f, 0.f, 0.f, 0.f};
#pragma unroll
                for (int s = 0; s < 4; ++s) acc = __builtin_amdgcn_mfma_f32_16x16x32_bf16(af[s], bq[s], acc, 0, 0, 0);
                int wv = __builtin_amdgcn_cvt_pk_fp8_f32(acc[0] * sc, acc[1] * sc, 0, false); wv = __builtin_amdgcn_cvt_pk_fp8_f32(acc[2] * sc, acc[3] * sc, wv, true);
                *(unsigned*)((unsigned char*)QLAT + ((size_t)(m0 + l15) * 8 + h) * 256 + 16 * nb + 4 * g) = (unsigned)wv;
            }
        }
    }
}
__device__ __forceinline__ void phase_oproj(const Params& p, LAS unsigned char* lds) {
    const bf16_t* OLAT = WSP(const bf16_t, WS_OLAT); const bf16_t* WUVT = WSP(const bf16_t, WS_WUVT); const bf16_t* ZA = WSP(const bf16_t, WS_ZA); bf16_t* OZA = WSP(bf16_t, WS_OZA);
    const int tid = opaque_tid(), lane = tid & 63, w = __builtin_amdgcn_readfirstlane(tid >> 6), l15 = lane & 15, g = lane >> 4;
    const int G = (int)gridDim.x;
    int hcur = -1;
    const unsigned kb0 = off_b((unsigned)l15, (unsigned)g);
    for (int u0 = (int)blockIdx.x; u0 < 4096; u0 += 8 * G) {
        const int h = u0 & 7;
        if (h != hcur || (G & 7)) { hcur = h; __syncthreads();
#pragma unroll
            for (int i = 0; i < 8; ++i) { const int idx = tid + 512 * i, row = idx >> 5, c32 = idx & 31;
                *(LAS u32x4*)(lds + (c32 >> 4) * 32768 + off_b((unsigned)row, (unsigned)(c32 & 15))) = *(const u32x4*)(WUVT + (size_t)(h * 128 + row) * 256 + c32 * 8); }
            __syncthreads(); }
        const int u = u0 + w * G;
        if (u < 4096 && (u & 7) == h) {
            const int m0 = (u >> 3) * 16;
            bf16x8 bq[8];
#pragma unroll
            for (int s = 0; s < 8; ++s) bq[s] = *(const bf16x8*)(OLAT + ((size_t)(m0 + l15) * 8 + h) * 256 + 32 * s + 8 * g);
#pragma unroll 2
            for (int nb = 0; nb < 8; ++nb) {
                bf16x8 af[8];
#pragma unroll
                for (int s = 0; s < 8; ++s) af[s] = *(const LAS bf16x8*)(lds + (s >> 2) * 32768 + 4096 * nb + (kb0 ^ (64u * (s & 3))));
                f32x4 acc = (f32x4){0.f, 0.f, 0.f, 0.f};
#pragma unroll
                for (int s = 0; s < 8; ++s) acc = __builtin_amdgcn_mfma_f32_16x16x32_bf16(af[s], bq[s], acc, 0, 0, 0);
                const size_t o = (size_t)(m0 + l15) * 1024 + h * 128 + 16 * nb + 4 * g;
                const u32x2 z = *(const u32x2*)(ZA + o);
                u32x2 wv; wv.x = pg8::cvt_pk_bf16(acc[0] * bflo(z.x), acc[1] * bfhi(z.x)); wv.y = pg8::cvt_pk_bf16(acc[2] * bflo(z.y), acc[3] * bfhi(z.y));
                *(u32x2*)(OZA + o) = wv;
            }
        }
    }
}
typedef int v2i32_t __attribute__((ext_vector_type(2)));
constexpr int DSA_WAVE_LDS = 17408, DSA_LUT = 8 * DSA_WAVE_LDS;
__device__ __forceinline__ int lpos(int s) { return (s & ~31) | ((s & 3) << 3) | ((s & 31) >> 2); }
__device__ __forceinline__ unsigned ord_key(float f) { const unsigned u = __float_as_uint(f); return (u & 0x80000000u) ? ~u : (u | 0x80000000u); }
template <int KN>
__device__ __forceinline__ void dsa_select(const float* row, int n, int nsel, LAS int* list, int lane) {
    const __amdgpu_buffer_rsrc_t rs = __builtin_amdgcn_make_buffer_rsrc((void*)row, 0, n * 4, 0x00020000);
    unsigned key[KN];
#pragma unroll
    for (int k = 0; k < KN; ++k) key[k] = (unsigned)__builtin_amdgcn_raw_buffer_load_b32(rs, lane * 4, 256 * k, 2);
    { int idx0 = lane;
#pragma unroll
      for (int k = 0; k < KN; ++k) { const unsigned u = key[k]; const unsigned o = (u & 0x80000000u) ? ~u : (u | 0x80000000u); key[k] = (idx0 < n) ? o : 0u; idx0 += 64; asm volatile("" : "+v"(idx0)); } }
    unsigned thr = 0u;
    if (n > 256) {
        for (int bit = 31; bit >= 0; --bit) {
            const unsigned cand = thr | (1u << bit);
            int c = 0;
#pragma unroll
            for (int k = 0; k < KN; ++k) c += (key[k] >= cand) ? 1 : 0;
            int cnt = 0;
#pragma unroll
            for (int b7 = 0; b7 < 7; ++b7) cnt += __popcll(__ballot((c >> b7) & 1)) << b7;
            if (cnt >= 256) thr = cand;
            if (cnt == 256) break;
        }
    }
    int pos = 0; int idx = lane;
#pragma unroll
    for (int k = 0; k < KN; ++k) { const bool mine = key[k] > thr; const unsigned long long msk = __ballot(mine);
        const int my = __builtin_amdgcn_mbcnt_hi((unsigned)(msk >> 32), __builtin_amdgcn_mbcnt_lo((unsigned)msk, 0u));
        if (mine) list[lpos(pos + my)] = idx; pos += __popcll(msk); idx += 64; asm volatile("" : "+v"(idx)); }
    if (pos < nsel) {
        idx = lane;
#pragma unroll
        for (int k = 0; k < KN; ++k) { const bool mine = (key[k] == thr) && (idx < n); const unsigned long long msk = __ballot(mine);
            const int my = __builtin_amdgcn_mbcnt_hi((unsigned)(msk >> 32), __builtin_amdgcn_mbcnt_lo((unsigned)msk, 0u));
            if (mine && pos + my < nsel) list[lpos(pos + my)] = idx; pos += __popcll(msk); idx += 64; asm volatile("" : "+v"(idx)); }
    }
}
__device__ __forceinline__ void dsa_unit(const Params& p, LAS unsigned char* lds, int qi, int wave, int lane, int probe) {
    const float* SC = WSP(const float, WS_SC); bf16_t* OLAT = WSP(bf16_t, WS_OLAT);
    const int c = qi >> 8, b = (qi >> 6) & 1, j = (c - 1) * 64 + (qi & 63), t = b * SEQ + j, n = 16 + 64 * c, nsel = n < 256 ? n : 256, qpos = NMETA + j;
    LAS unsigned char* img = lds + wave * DSA_WAVE_LDS; LAS int* list = (LAS int*)(img + 16384); const LAS float* LUTA = (const LAS float*)(lds + DSA_LUT);
    const int l15 = lane & 15, g = lane >> 4;
    const float* row = SC + sc_off(b, j);
#pragma unroll
    for (int rs_ = (PROBE_REP == 41) ? 2 : 1; rs_ > 0; --rs_) {
    if (n <= 64 * 17) dsa_select<17>(row, n, nsel, list, lane);
    else if (n <= 64 * 33) dsa_select<33>(row, n, nsel, list, lane);
    else if (n <= 64 * 49) dsa_select<49>(row, n, nsel, list, lane);
    else dsa_select<65>(row, n, nsel, list, lane);
    }
#pragma unroll
    for (int ra_ = (PROBE_REP == 42) ? 2 : 1; ra_ > 0; --ra_) {
    const unsigned char* CKV8 = WSP(const unsigned char, WS_CKV); const unsigned char* qlp = WSP(const unsigned char, WS_QLAT) + ((size_t)t * 8 + (l15 & 7)) * 256 + 8 * g;
    const bool qreal = l15 < 8;
    unsigned rdb[2];
    rdb[0] = 256u * (unsigned)l15 + 8u * ((unsigned)g ^ (2u * (unsigned)l15));
    rdb[1] = 256u * (unsigned)(l15 + 16) + 8u * ((unsigned)g ^ (2u * ((unsigned)l15 ^ 8u)));
    const unsigned tq = (unsigned)l15 >> 1, tp = (unsigned)l15 & 1u;
    const unsigned trow = (tq < 4u) ? 4u * g + tq : 16u + 4u * g + (tq - 4u);
    const unsigned trb = 256u * trow + 8u * (tp ^ (2u * ((trow & 15u) ^ ((trow >> 4) << 3))));
    float m = -INFINITY, l = 0.f;
    f32x4 O[16];
#pragma unroll
    for (int rb = 0; rb < 16; ++rb) O[rb] = (f32x4){0.f, 0.f, 0.f, 0.f};
    const int nch = (nsel + 31) >> 5;
    const int hcol = l15 & 7;
    u32x4 gr[8];
    const unsigned gwr = 256u * (unsigned)(lane >> 4) + 16u * (unsigned)(lane & 15);
#define DSA_GATHER(chn) do { int ki_[8]; { const LAS int* lp_ = list + 32 * (chn) + 8 * (lane >> 4); \
        _Pragma("unroll") for (int v_ = 0; v_ < 2; ++v_) { const u32x4 t_ = *(const LAS u32x4*)(lp_ + 4 * v_); ki_[4 * v_] = (int)t_.x; ki_[4 * v_ + 1] = (int)t_.y; ki_[4 * v_ + 2] = (int)t_.z; ki_[4 * v_ + 3] = (int)t_.w; } } \
        _Pragma("unroll") for (int i = 0; i < 8; ++i) { const int slot = 32 * (chn) + 4 * i + (lane >> 4); const int kidx = slot < nsel ? ki_[i] : 0; \
        gr[i] = *(const u32x4*)(CKV8 + ((size_t)b * TK + kidx) * 256 + (lane & 15) * 16); } } while (0)
    DSA_GATHER(0);
    for (int ch = 0; ch < nch; ++ch) {
#pragma unroll
        for (int i = 0; i < 8; ++i) { const unsigned row = 4u * i + (unsigned)(lane >> 4); const unsigned rc = (row & 15u) ^ ((row >> 4) << 3);
            *(LAS u32x4*)(img + 256u * row + 16u * (((unsigned)lane & 15u) ^ rc)) = gr[i]; }
        long qf[8];
#pragma unroll
        for (int s = 0; s < 8; ++s) qf[s] = *(const long*)(qlp + 32 * s);
        asm volatile("" ::: "memory");
        DSA_GATHER(ch + 1);
        asm volatile("" ::: "memory");
#pragma unroll
        for (int s = 0; s < 8; ++s) qf[s] = qreal ? qf[s] : 0l;
        unsigned io = 0u; asm volatile("" : "+v"(io));
        LAS unsigned char* im = img + io;
        f32x4 S[2];
        S[0] = (f32x4){0.f, 0.f, 0.f, 0.f}; S[1] = S[0];
#pragma unroll
        for (int s4 = 0; s4 < 8; s4 += 4) {
            long af_[4][2];
#pragma unroll
            for (int s = 0; s < 4; ++s)
#pragma unroll
                for (int mb = 0; mb < 2; ++mb) af_[s][mb] = *(const LAS long*)(im + (rdb[mb] ^ (32u * (s4 + s))));
            __builtin_amdgcn_sched_barrier(0);
#pragma unroll
            for (int s = 0; s < 4; ++s)
#pragma unroll
                for (int mb = 0; mb < 2; ++mb) S[mb] = __builtin_amdgcn_mfma_f32_16x16x32_fp8_fp8(af_[s][mb], qf[s4 + s], S[mb], 0, 0, 0);
        }
        float cm = -INFINITY;
#pragma unroll
        for (int mb = 0; mb < 2; ++mb)
#pragma unroll
            for (int i = 0; i < 4; ++i) { const int slot = 32 * ch + 16 * mb + 4 * g + i; const int kidx = list[lpos(slot & 255)];
                int rel = kidx - qpos; rel = rel < -91 ? -91 : (rel > 63 ? 63 : rel);
                float v = S[mb][i] * 0.0625f + LUTA[(rel + 91) * 8 + hcol]; v = slot < nsel ? v : -INFINITY; S[mb][i] = v; cm = fmaxf(cm, v); }
        cm = fmaxf(cm, __shfl_xor(cm, 16)); cm = fmaxf(cm, __shfl_xor(cm, 32));
        const float mn = fmaxf(m, cm), alpha = __builtin_amdgcn_exp2f(m - mn); m = mn;
        float ps = 0.f;
#pragma unroll
        for (int mb = 0; mb < 2; ++mb)
#pragma unroll
            for (int i = 0; i < 4; ++i) { S[mb][i] = __builtin_amdgcn_exp2f(S[mb][i] - mn); ps += S[mb][i]; }
        l = l * alpha + ps;
        if (__any(alpha != 1.f)) {
#pragma unroll
            for (int rb = 0; rb < 16; ++rb) O[rb] = O[rb] * alpha;
        }
        int w0 = __builtin_amdgcn_cvt_pk_fp8_f32(S[0][0], S[0][1], 0, false); w0 = __builtin_amdgcn_cvt_pk_fp8_f32(S[0][2], S[0][3], w0, true);
        int w1 = __builtin_amdgcn_cvt_pk_fp8_f32(S[1][0], S[1][1], 0, false); w1 = __builtin_amdgcn_cvt_pk_fp8_f32(S[1][2], S[1][3], w1, true);
        const long pb = (long)(((unsigned long long)(unsigned)w1 << 32) | (unsigned long long)(unsigned)w0);
#pragma unroll
        for (int rb4 = 0; rb4 < 16; rb4 += 4) {
            long tf_[4];
#pragma unroll
            for (int r_ = 0; r_ < 4; ++r_) { const v2i32_t tv = __builtin_amdgcn_ds_read_tr8_b64_v2i32((LAS v2i32_t*)(im + (trb ^ (16u * (rb4 + r_))))); tf_[r_] = __builtin_bit_cast(long, tv); }
            __builtin_amdgcn_sched_barrier(0);
#pragma unroll
            for (int r_ = 0; r_ < 4; ++r_) O[rb4 + r_] = __builtin_amdgcn_mfma_f32_16x16x32_fp8_fp8(tf_[r_], pb, O[rb4 + r_], 0, 0, 0);
        }
    }
    l += __shfl_xor(l, 16); l += __shfl_xor(l, 32);
    const float il = 1.f / l;
    if (l15 < 8) {
#pragma unroll
        for (int rb = 0; rb < 16; ++rb) { u32x2 w; w.x = pg8::cvt_pk_bf16(O[rb][0] * il, O[rb][1] * il); w.y = pg8::cvt_pk_bf16(O[rb][2] * il, O[rb][3] * il);
            *(u32x2*)(OLAT + ((size_t)t * 8 + l15) * 256 + 16 * rb + 4 * g) = w; }
    }
    }
}
#undef DSA_GATHER
__device__ __forceinline__ int lds_take(LAS unsigned* ctr, int lane) {
    int u = 0; if (lane == 0) u = (int)__hip_atomic_fetch_add(ctr, 1u, __ATOMIC_RELAXED, __HIP_MEMORY_SCOPE_WORKGROUP);
    return __builtin_amdgcn_readfirstlane(u);
}
__device__ __forceinline__ int dsa_query_of(int u, int G) {
    const int k = u >> 3, r = u & 7;
    int cl, bb, grp;
    if (G == 256) { const int idx = ((int)blockIdx.x >> 1) + 128 * k; cl = 1 + (idx >> 4); grp = idx & 15; bb = (int)blockIdx.x & 1; }
    else { const int P = (int)blockIdx.x + k * G; cl = 1 + (P >> 5); bb = (P >> 4) & 1; grp = P & 15; }
    const int c = (r < 4) ? 65 - cl : cl;
    return (c << 8) | (bb << 6) | (4 * grp + (r & 3));
}
__device__ __forceinline__ int dsa_token_of(int qi) { return ((qi >> 6) & 1) * SEQ + ((qi >> 8) - 1) * 64 + (qi & 63); }
__device__ __forceinline__ void phase_dsa(const Params& p, LAS unsigned char* lds, int wave, int lane, int probe) {
    LAS float* LUTA = (LAS float*)(lds + DSA_LUT); LAS unsigned* ctr = (LAS unsigned*)(lds + DSA_LUT + 155 * 8 * 4);
    const int G = (int)gridDim.x, l15 = lane & 15, g = lane >> 4;
    __syncthreads();
    for (int i = threadIdx.x; i < 155 * 8; i += 512) LUTA[i] = p.rel_bias[t5_bucket((i >> 3) - 91) * 16 + (i & 7)] * LOG2E;
    if (threadIdx.x == 0) ctr[0] = 0u;
    const int npi = (1024 - (int)blockIdx.x + G - 1) / G;
    const int nun = npi * 8;
    __syncthreads();
    for (;;) {
        const int u = lds_take(ctr, lane); if (u >= nun) break;
        dsa_unit(p, lds, dsa_query_of(u, G), wave, lane, probe);
    }
}

#define XB_TMO      128
#define XB_XCNT(j)  (256  + 64 * (j))
#define XB_XSUB(j)  (1280 + 64 * (j))
#define XB_XGEN(j)  (2304 + 64 * (j))
#define XB_TOP      3328
#define XB_TOPGEN   3392
#define XCD_BAR_WORDS 3456
#define XB_SPIN_CAP (1u << 24)
__device__ __forceinline__ unsigned xb_ld(unsigned* p)              { return __hip_atomic_load(p, __ATOMIC_RELAXED, __HIP_MEMORY_SCOPE_AGENT); }
__device__ __forceinline__ unsigned xb_add(unsigned* p, unsigned v) { return __hip_atomic_fetch_add(p, v, __ATOMIC_RELAXED, __HIP_MEMORY_SCOPE_AGENT); }
__device__ __forceinline__ unsigned xb_xcc_id() { return (unsigned)__builtin_amdgcn_s_getreg((3 << 11) | 20) & 0xFu; }
#define XB_SPIN(cond, bar) do { unsigned _sp = 0; while (cond) { __builtin_amdgcn_s_sleep(1); \
    if ((++_sp & 255u) == 0u) { if (xb_ld(&(bar)[XB_TMO])) break; if (_sp > XB_SPIN_CAP) { atomicAdd(&(bar)[XB_TMO], 1u); break; } } } } while (0)
struct XcdBarrier { unsigned* bar; unsigned x; volatile LAS unsigned* st; };
__device__ __forceinline__ XcdBarrier xcd_barrier_post(unsigned* bar, volatile LAS unsigned* st) {
    XcdBarrier b; b.bar = bar; b.x = xb_xcc_id(); b.st = st;
    if (threadIdx.x == 0) (void)xb_add(&bar[XB_XCNT(b.x)], 1u);
    return b;
}
__device__ __forceinline__ void xcd_barrier_complete(unsigned* bar, unsigned x, unsigned& nloc, unsigned& nx) {
    const unsigned G = gridDim.x * gridDim.y * gridDim.z;
    unsigned sum, cnt, mine, sp = 0u;
    for (;;) {
        sum = 0u; cnt = 0u; mine = 0u;
#pragma unroll
        for (unsigned j = 0; j < 16; ++j) { const unsigned c = xb_ld(&bar[XB_XCNT(j)]); sum += c; cnt += (c > 0u) ? 1u : 0u; mine = (j == x) ? c : mine; }
        if (sum == G) break;
        __builtin_amdgcn_s_sleep(1);
        if ((++sp & 255u) == 0u) { if (xb_ld(&bar[XB_TMO])) break; if (sp > XB_SPIN_CAP) { atomicAdd(&bar[XB_TMO], 1u); break; } }
    }
    nloc = mine > 0u ? mine : 1u; nx = cnt > 0u ? cnt : 1u;
}
__device__ __forceinline__ void xcd_barrier(const XcdBarrier& b) {
    asm volatile("s_waitcnt vmcnt(0)" ::: "memory");
    __syncthreads();
    if (threadIdx.x == 0) {
        unsigned* bar = b.bar;
        __builtin_amdgcn_s_waitcnt(0);
        unsigned nloc = b.st[0], nx = b.st[1];
        if (nloc == 0u) { xcd_barrier_complete(bar, b.x, nloc, nx); b.st[0] = nloc; b.st[1] = nx; }
        const unsigned old = xb_add(&bar[XB_XSUB(b.x)], 1u);
        const unsigned gen = old / nloc;
        if (old + 1u == (gen + 1u) * nloc) {
            __builtin_amdgcn_fence(__ATOMIC_RELEASE, "agent");
            asm volatile("s_waitcnt vmcnt(0)" ::: "memory");
            const unsigned og = xb_add(&bar[XB_TOP], 1u);
            const unsigned tg = og / nx;
            if (og + 1u == (tg + 1u) * nx) xb_add(&bar[XB_TOPGEN], 1u);
            else XB_SPIN(xb_ld(&bar[XB_TOPGEN]) == tg, bar);
            __builtin_amdgcn_fence(__ATOMIC_ACQUIRE, "agent");
            xb_add(&bar[XB_XGEN(b.x)], 1u);
            asm volatile("s_waitcnt vmcnt(0)" ::: "memory");
        } else {
            XB_SPIN(xb_ld(&bar[XB_XGEN(b.x)]) == gen, bar);
            __builtin_amdgcn_fence(__ATOMIC_ACQUIRE, "agent");
            asm volatile("s_waitcnt vmcnt(0)" ::: "memory");
        }
    }
    __syncthreads();
}

constexpr int LDS_BYTES = 147456, MISC_OFF = 147456 - 256;
constexpr int NPHASE = 8;
#ifndef ONE_LAUNCH
#define ONE_LAUNCH 1
#endif

struct KArgs { Params p; int ph_lo, ph_hi, probe, pad; };
__global__ void __launch_bounds__(512, 2) k_fwd(KArgs a) {
    extern __shared__ __attribute__((aligned(16))) unsigned char lds_raw[];
    LAS unsigned char* lds = (LAS unsigned char*)lds_raw;
    const Params& p = a.p;
    const int tid = threadIdx.x, lane = tid & 63, wave = __builtin_amdgcn_readfirstlane(tid >> 6);
    const int gw = blockIdx.x * 8 + wave, ngw = gridDim.x * 8;
    volatile LAS unsigned* misc = (volatile LAS unsigned*)(lds + MISC_OFF);
    if (tid < 64) misc[tid] = 0u;
    __syncthreads();
    XcdBarrier bar; bar.bar = WSP(unsigned, WS_CTL) + 4096; bar.x = 0; bar.st = misc;
    if (ONE_LAUNCH) bar = xcd_barrier_post(WSP(unsigned, WS_CTL) + 4096, misc);
#define IN(k) (a.ph_lo <= 0 && 0 < a.ph_hi)
#define SEAM(k) do { xcd_barrier(bar); } while (0)
#define RUNPH(k, ...) do { if (IN(k)) { constexpr int nrep_ = (PROBE_REP == (k)) ? 2 : 1; _Pragma("unroll") for (int rep = 0; rep < nrep_; ++rep) { if (rep) xcd_barrier(bar); __VA_ARGS__ } } } while (0)
    RUNPH(0, const int lane_ = opaque_tid() & 63; phase0(p, lds, gw, ngw, wave, lane_, 0, (gridDim.x == 256) ? p.jobs[13].item0 : p.nitems););
    SEAM(0);
    RUNPH(1,
        SchedInproj S{DM, (int)gridDim.x, (int)blockIdx.x, (const char*)WSP(bf16_t, WS_U), (const char*)WSP(bf16_t, WS_WIN)};
        EpiInproj E{WSP(bf16_t, WS_QA), WSP(bf16_t, WS_ZA), WSP(bf16_t, WS_IQ), WSP(bf16_t, WS_QB), WSP(bf16_t, WS_ZB), WSP(bf16_t, WS_GA), WSP(bf16_t, WS_GB), WSP(bf16_t, WS_KB), WSP(bf16_t, WS_VB),
                    WSP(float, WS_CKVRAW), WSP(bf16_t, WS_IK), WSP(float, WS_IW), 0.125f * LOG2E, p.ikn_w, p.ikn_b, 0.015625f};
        pg8::gemm_phase<EpiInproj, SchedInproj>(lds, S, E);
        { SchedGate S8{DM, (int)gridDim.x, (int)blockIdx.x, (const char*)WSP(unsigned char, WS_U8), (const char*)WSP(unsigned char, WS_W8)};
          EpiGate E8{WSP(bf16_t, WS_GA), WSP(bf16_t, WS_GB)};
          pg8::gemm_phase<EpiGate, SchedGate, true, true, true>(lds, S8, E8); }
        if (gridDim.x == 256 && blockIdx.x >= 202) { const int lane_ = opaque_tid() & 63; phase0(p, lds, ((int)blockIdx.x - 202) * 8 + wave, 54 * 8, wave, lane_, p.jobs[13].item0, p.nitems); });
    SEAM(1);
    RUNPH(33, const int lane_ = opaque_tid() & 63; phase_ckvnorm(p, gw, ngw, lane_););
    RUNPH(32, phase_qlat(p, lds););
    RUNPH(30, phase_diff(p, lds););
    RUNPH(31, phase_scores(p, lds););
    SEAM(3);
    RUNPH(4, const int lane_ = opaque_tid() & 63; phase_dsa(p, lds, wave, lane_, a.probe););
    SEAM(4);
    RUNPH(8, phase_oproj(p, lds););
    SEAM(8);
    RUNPH(5,
        SchedMix S{1024, (int)gridDim.x, (int)blockIdx.x, (const char*)WSP(bf16_t, WS_OZA), (const char*)WSP(bf16_t, WS_WOA), (const char*)WSP(bf16_t, WS_OZB), (const char*)WSP(bf16_t, WS_WOB)};
        EpiMix E{WSP(const bf16_t, WS_GA), WSP(const bf16_t, WS_GB), WSP(bf16_t, WS_MIX)};
        pg8::gemm_phase<EpiMix, SchedMix>(lds, S, E););
    SEAM(5);
    if (gridDim.x == 256) {
        RUNPH(6,
            SchedOut S{DM, (int)gridDim.x, (int)blockIdx.x, (const char*)WSP(bf16_t, WS_MIX), (const char*)WSP(bf16_t, WS_WOUT)};
            EpiOutFused E{p.x, p.post_w, p.out, WSP(float, WS_SSQ), WSP(unsigned, WS_CTL) + 8192, lds};
            pg8::gemm_phase<EpiOutFused, SchedOut>(lds, S, E););
    } else {
        RUNPH(6,
            SchedOut S{DM, (int)gridDim.x, (int)blockIdx.x, (const char*)WSP(bf16_t, WS_MIX), (const char*)WSP(bf16_t, WS_WOUT)};
            EpiOut E{WSP(bf16_t, WS_OUTPRE), WSP(float, WS_SSQ)};
            pg8::gemm_phase<EpiOut, SchedOut>(lds, S, E););
        SEAM(6);
        RUNPH(7, const int lane_ = opaque_tid() & 63; phase7(p, gw, ngw, lane_););
    }
#undef RUNPH
#undef IN
#undef SEAM
}

static void add_job(Params& p, const float* src, bf16_t* dst, int K, int N, int col0, int ncols, int row0, int fp8 = 0) {
    TJob& j = p.jobs[p.njobs++]; j.fp8 = fp8; j.pad_ = 0; j.src = src; j.dst = dst; j.K = K; j.N = N; j.col0 = col0; j.nblk = (ncols + 31) / 32; j.row0 = row0; j.item0 = p.nitems; p.nitems += (K / 64) * j.nblk;
}
extern "C" void kernel_launch(void* const* d_in, const int* in_sizes, int n_in, void* d_out, int out_size, void* d_ws, size_t ws_size, hipStream_t stream) {
    if (n_in != 16 || ws_size < WS_END) { fprintf(stderr, "kernel_launch: unexpected arguments (n_in %d, ws %zu)\n", n_in, ws_size); return; }
    static int grid = 0;
    if (!grid) {
        int dev = 0, cus = 0, per_cu = 0;
        (void)hipGetDevice(&dev); (void)hipDeviceGetAttribute(&cus, hipDeviceAttributeMultiprocessorCount, dev);
        (void)hipFuncSetAttribute((const void*)k_fwd, hipFuncAttributeMaxDynamicSharedMemorySize, LDS_BYTES);
        (void)hipOccupancyMaxActiveBlocksPerMultiprocessor(&per_cu, (const void*)k_fwd, 512, LDS_BYTES);
        (void)hipGetLastError();
        grid = cus > 0 ? cus : 256;
        if (per_cu < 1) fprintf(stderr, "kernel_launch: occupancy query reports %d blocks per CU\n", per_cu);
    }
    KArgs a; memset(&a, 0, sizeof(a));
    Params& p = a.p;
    const float** in = (const float**)d_in;
    p.x = in[0]; p.meta = in[1]; p.rel_bias = in[2]; p.pre_w = in[3]; p.w_in = in[4]; p.kv_norm_w = in[5]; p.w_uk = in[6]; p.w_uv = in[7]; p.ikn_w = in[8]; p.ikn_b = in[9];
    p.lam_p = in[10]; p.subln_w = in[11]; p.w_o_a = in[12]; p.w_o_b = in[13]; p.w_out = in[14]; p.post_w = in[15];
    p.out = (float*)d_out; p.ws = (unsigned char*)d_ws;
    bf16_t* WIN = (bf16_t*)(p.ws + WS_WIN);
    const int NIN = 11600;
    add_job(p, p.w_in, WIN, DM, NIN, 0, 1024, 0);
    add_job(p, p.w_in, WIN, DM, NIN, 1280, 1024, 1024);
    add_job(p, p.w_in, WIN, DM, NIN, 2304, 1024, 2048);
    add_job(p, p.w_in, WIN, DM, NIN, 3408, 1024, 3072);
    add_job(p, p.w_in, WIN, DM, NIN, 6480, 1024, 4096);
    add_job(p, p.w_in, (bf16_t*)(p.ws + WS_W8), DM, NIN, 7504, 2048, 0, 1);
    add_job(p, p.w_in, (bf16_t*)(p.ws + WS_W8), DM, NIN, 9552, 2048, 2048, 1);
    add_job(p, p.w_in, WIN, DM, NIN, 4432, 1024, 9216);
    add_job(p, p.w_in, WIN, DM, NIN, 5456, 1024, 10240);
    add_job(p, p.w_in, WIN, DM, NIN, 1024, 256, 11264);
    add_job(p, p.w_in, WIN, DM, NIN, 3328, 32, 11520);
    add_job(p, p.w_in, WIN, DM, NIN, 3392, 32, 11520 + 32);
    add_job(p, p.w_in, WIN, DM, NIN, 3360, 32, 11520 + 128);
    add_job(p, p.w_o_a, (bf16_t*)(p.ws + WS_WOA), 1024, DM, 0, DM, 0);
    add_job(p, p.w_o_b, (bf16_t*)(p.ws + WS_WOB), 1024, DM, 0, DM, 0);
    add_job(p, p.w_out, (bf16_t*)(p.ws + WS_WOUT), DM, DM, 0, DM, 0);
    add_job(p, p.w_uv, (bf16_t*)(p.ws + WS_WUVT), 256, 1024, 0, 1024, 0);
    (void)hipMemsetAsync((char*)d_ws + WS_CTL, 0, CTL_BYTES, stream);
#if ONE_LAUNCH
    a.ph_lo = 0; a.ph_hi = NPHASE; a.probe = PROBE_REP;
    hipLaunchKernelGGL(k_fwd, dim3(grid), dim3(512), LDS_BYTES, stream, a);
#else
    for (int ph = 0; ph < NPHASE; ++ph) { a.ph_lo = ph; a.ph_hi = ph + 1; hipLaunchKernelGGL(k_fwd, dim3(grid), dim3(512), LDS_BYTES, stream, a); }
#endif
}
```

```cpp
#include <hip/hip_runtime.h>
#include <cstdio>
#include <cstdint>
#include <cstring>

#ifndef PROBE_REP
#define PROBE_REP (-1)
#endif
#define LAS __attribute__((address_space(3)))
#define GAS __attribute__((address_space(1)))
typedef unsigned short bf16_t;
typedef short bf16x8 __attribute__((ext_vector_type(8)));
typedef float f32x4 __attribute__((ext_vector_type(4)));
typedef unsigned u32x4 __attribute__((ext_vector_type(4)));
typedef unsigned u32x2 __attribute__((ext_vector_type(2)));
typedef int v8i32 __attribute__((ext_vector_type(8)));
typedef int v4i32 __attribute__((ext_vector_type(4)));

constexpr int DM = 2048, NB = 2, SEQ = 4096, NMETA = 16, TK = SEQ + NMETA  , MTOK = NB * SEQ  , MKEY = NB * TK  ;
constexpr int UROWS = 8448;
constexpr int NPAD = 11776;
constexpr float EPS = 1e-6f;
constexpr float LOG2E = 1.4426950408889634f;
constexpr size_t SC_PER_B = 8585216;

constexpr size_t MiB = 1u << 20;
constexpr size_t WS_CTL = 0, CTL_BYTES = 1 * MiB;
constexpr size_t WS_U = 1 * MiB;
constexpr size_t WS_WIN = 34 * MiB;
constexpr size_t WS_SC = 1 * MiB;
constexpr size_t WS_MIX = 1 * MiB;
constexpr size_t WS_WOA = 80 * MiB, WS_WOB = 84 * MiB, WS_WOUT = 88 * MiB, WS_WUK = 96 * MiB, WS_WUVT = 96 * MiB + 512 * 1024;
constexpr size_t WS_QA = 97 * MiB, WS_IQ = 113 * MiB, WS_QB = 129 * MiB, WS_ZA = 145 * MiB, WS_ZB = 161 * MiB, WS_GA = 177 * MiB, WS_GB = 209 * MiB;
constexpr size_t WS_OLAT = 241 * MiB;
constexpr size_t WS_OZA = 129 * MiB;
constexpr size_t WS_KB = 241 * MiB, WS_VB = 258 * MiB, WS_CKVRAW = 275 * MiB, WS_IKRAW = 284 * MiB, WS_IW = 287 * MiB, WS_CKV = 288 * MiB, WS_IK = 293 * MiB;
constexpr size_t WS_QLAT = 295 * MiB;
constexpr size_t WS_OUTPRE = 295 * MiB;
constexpr size_t WS_OZB = 327 * MiB, WS_SSQ = 343 * MiB, WS_U8 = 344 * MiB, WS_END = 360 * MiB;
constexpr size_t WS_W8 = WS_WIN + (size_t)5120 * 2048 * 2;

__device__ __forceinline__ int opaque_tid() { int t = threadIdx.x; asm volatile("" : "+v"(t)); return t; }
__device__ __forceinline__ float bf2f(unsigned short u) { return __uint_as_float(((unsigned)u) << 16); }
__device__ __forceinline__ unsigned f2bf(float f) { unsigned u = __float_as_uint(f); return (u + 0x7fffu + ((u >> 16) & 1u)) >> 16; }
__device__ __forceinline__ unsigned pk2(float lo, float hi) { return f2bf(lo) | (f2bf(hi) << 16); }
__device__ __forceinline__ float bflo(unsigned w) { return __uint_as_float(w << 16); }
__device__ __forceinline__ float bfhi(unsigned w) { return __uint_as_float(w & 0xffff0000u); }
__device__ __forceinline__ float wave_sum(float v) {
#pragma unroll
    for (int o = 1; o < 64; o <<= 1) v += __shfl_xor(v, o);
    return v;
}
__device__ __forceinline__ float silu_f(float x) { return x * __builtin_amdgcn_rcpf(1.f + __expf(-x)); }
__device__ __forceinline__ int t5_bucket(int rel) {
    const int n = rel < 0 ? -rel : rel; int f;
    if (n < 8) f = n; else if (n < 12) f = 8; else if (n < 16) f = 9; else if (n < 23) f = 10; else if (n < 32) f = 11; else if (n < 46) f = 12; else if (n < 64) f = 13; else if (n < 91) f = 14; else f = 15;
    return (rel > 0 ? 16 : 0) + f;
}
__device__ __forceinline__ size_t sc_off(int b, int j) {
    const int c = 1 + (j >> 6);
    return (size_t)b * SC_PER_B + (size_t)1024 * (c - 1) + (size_t)2048 * (c - 1) * c + (size_t)(j & 63) * (16 + 64 * c);
}

namespace pg8 {
constexpr int BM = 256, BK = 64, HALF = 128, HTB = HALF * BK * 2, STAGE_BYTES = 8 * HTB, NXCD = 8, WGM = 8;
__host__ __device__ __forceinline__ int lds_byte(int r, int c) { const int st = (r >> 4) * 2 + (c >> 5), rr = r & 15, cc = c & 31, ob = rr * 64 + cc * 2; return st * 1024 + (ob ^ (((ob >> 9) & 1) << 5)); }
__host__ __device__ __forceinline__ void stage_rc(int b, int& R, int& C) { const int st = b / 1024, sb = b % 1024, swz = sb ^ (((sb >> 9) & 1) << 5); R = (st >> 1) * 16 + swz / 64; C = (st & 1) * 32 + (swz % 64) / 2; }
__host__ __device__ __forceinline__ int perm32(int rho) { const int n = rho >> 4, i = rho & 15; return 8 * (i >> 2) + 4 * n + (i & 3); }

struct Unit { int pm, pn, sub; };
__device__ __forceinline__ unsigned cvt_pk_bf16(float lo, float hi) { unsigned r; asm volatile("v_cvt_pk_bf16_f32 %0, %1, %2" : "=v"(r) : "v"(lo), "v"(hi)); return r; }

__device__ __forceinline__ void tile_of(int L, int nM, int nN, int& pm, int& pn) {
    const int nwg = nM * nN; int wgid = L; { const int q = nwg / NXCD, r = nwg % NXCD, xcd = wgid % NXCD, off = wgid / NXCD; wgid = (xcd < r ? xcd * (q + 1) : r * (q + 1) + (xcd - r) * q) + off; }
    const int nig = WGM * nN, gid = wgid / nig, fm = gid * WGM, gsz = (nM - fm) < WGM ? (nM - fm) : WGM;
    pm = fm + ((wgid % nig) % gsz); pn = (wgid % nig) / gsz;
}

template <class Epi, class Sched, bool ALIGN_EPI = true, bool SP2 = true, bool FP8 = false>
__device__ __forceinline__ void gemm_phase(LAS unsigned char* lds, const Sched& S, const Epi& E) {
    const int tid = opaque_tid(), wid = __builtin_amdgcn_readfirstlane(tid >> 6), lane = tid & 63, wr = wid >> 2, wc = wid & 3, fr = lane & 15, fq = lane >> 4;
    const int K = FP8 ? S.K / 2 : S.K, nt = K / BK;
    unsigned voffA[2], voffB[2];
#pragma unroll
    for (int i = 0; i < 2; ++i) { int R, C; stage_rc(tid * 16 + i * 8192, R, C); const int Rb = Epi::PERM ? ((R & ~31) + perm32(R & 31)) : R;
        voffA[i] = (unsigned)(R * K + C) * 2u; voffB[i] = (unsigned)(Rb * K + C) * 2u; }
    const size_t kstep = (size_t)(BK * 2);
    const size_t hstep = (size_t)HALF * K * 2;
    const unsigned ldsw = (unsigned)wid * 1024u, lds0 = (unsigned)(size_t)lds;
    const int aoff = lds_byte(wr * 64 + fr, fq * 8), boff = lds_byte(wc * 32 + fr, fq * 8);
#define PG8_SA(b, h) (((b) * 2 + (h)) * HTB)
#define PG8_SB(b, h) ((4 + (b) * 2 + (h)) * HTB)
#define PG8_STAGE(bufoff, gbase, voff) do { _Pragma("unroll") for (int _i = 0; _i < 2; ++_i) { \
        if constexpr (FP8) { unsigned keep_; asm volatile("s_mov_b32 %0, m0\n\ts_mov_b32 m0, %3\n\ts_nop 0\n\tglobal_load_lds_dwordx4 %1, %2\n\ts_mov_b32 m0, %0" \
                : "=&s"(keep_) : "v"((voff)[_i]), "s"((const char*)(gbase)), "s"(lds0 + (unsigned)(bufoff) + ldsw + (unsigned)(_i * 8192)) : "memory"); } \
        else __builtin_amdgcn_global_load_lds((const unsigned*)((const char*)(gbase) + (voff)[_i]), (LAS unsigned*)(lds + (bufoff) + ldsw + _i * 8192), 16, 0, 0); } } while (0)
#define PG8_LD8(dst, addr) do { const v4i32 lo_ = *(const LAS v4i32*)(addr), hi_ = *(const LAS v4i32*)((addr) + 1024); dst = __builtin_shufflevector(lo_, hi_, 0, 1, 2, 3, 4, 5, 6, 7); } while (0)
#define PG8_LDA(dst, b, h) do { if constexpr (FP8) { _Pragma("unroll") for (int m = 0; m < 4; ++m) PG8_LD8(dst##8[m], lds + PG8_SA(b, h) + aoff + m * 2048); } else { \
        _Pragma("unroll") for (int m = 0; m < 4; ++m) _Pragma("unroll") for (int k = 0; k < 2; ++k) dst[m][k] = *(const LAS bf16x8*)(lds + PG8_SA(b, h) + aoff + m * 2048 + k * 1024); } } while (0)
#define PG8_LDB(dst, b, h) do { if constexpr (FP8) { _Pragma("unroll") for (int n = 0; n < 2; ++n) PG8_LD8(dst##8[n], lds + PG8_SB(b, h) + boff + n * 2048); } else { \
        _Pragma("unroll") for (int n = 0; n < 2; ++n) _Pragma("unroll") for (int k = 0; k < 2; ++k) dst[n][k] = *(const LAS bf16x8*)(lds + PG8_SB(b, h) + boff + n * 2048 + k * 1024); } } while (0)
#define PG8_MMA(ai, bj, At, Bt) do { __builtin_amdgcn_s_setprio(1); _Pragma("unroll") for (int m = 0; m < 4; ++m) _Pragma("unroll") for (int n = 0; n < 2; ++n) _Pragma("unroll") for (int k = 0; k < 2; ++k) \
        acc[ai][bj][m][n] = __builtin_amdgcn_mfma_f32_16x16x32_bf16(Bt[n][k], At[m][k], acc[ai][bj][m][n], 0, 0, 0); __builtin_amdgcn_s_setprio(0); } while (0)
#define PG8_MMA8(ai, bj, At, Bt) do { __builtin_amdgcn_s_setprio(1); _Pragma("unroll") for (int m = 0; m < 4; ++m) _Pragma("unroll") for (int n = 0; n < 2; ++n) \
        acc[ai][bj][m][n] = __builtin_amdgcn_mfma_scale_f32_16x16x128_f8f6f4(Bt##8[n], At##8[m], acc[ai][bj][m][n], 0, 0, 0, 0x7f7f7f7f, 0, 0x7f7f7f7f); __builtin_amdgcn_s_setprio(0); } while (0)
#define PG8_MM(ai, bj, At, Bt) do { if constexpr (FP8) PG8_MMA8(ai, bj, At, Bt); else PG8_MMA(ai, bj, At, Bt); } while (0)
#define PG8_WAIT_V(n) asm volatile("s_waitcnt vmcnt(" #n ")" ::: "memory")
#define PG8_WAIT_L(n) asm volatile("s_waitcnt lgkmcnt(" #n ")" ::: "memory")
#define PG8_BAR __builtin_amdgcn_s_barrier()
#define PG8_SCHED __builtin_amdgcn_sched_barrier(0)
    Unit cur, nxt; int ui = 0;
    if (!S.next(0, cur)) return;
    f32x4 acc[2][2][4][2];
#pragma unroll
    for (int a = 0; a < 2; ++a)
#pragma unroll
        for (int b = 0; b < 2; ++b)
#pragma unroll
            for (int m = 0; m < 4; ++m)
#pragma unroll
                for (int n = 0; n < 2; ++n) acc[a][b][m][n] = (f32x4){0.f, 0.f, 0.f, 0.f};
    bf16x8 At[4][2], B0[2][2], B1[2][2];
    v8i32 At8[4], B08[2], B18[2];
    const char* cA = S.a_ptr(cur); const char* cB = S.b_ptr(cur);
    if constexpr (SP2) {
        PG8_STAGE(PG8_SB(0, 0), cB, voffB); PG8_STAGE(PG8_SB(0, 1), cB + hstep, voffB); PG8_STAGE(PG8_SA(0, 0), cA, voffA); PG8_STAGE(PG8_SA(0, 1), cA + hstep, voffA);
        if (wr == 1) PG8_BAR;
        PG8_WAIT_V(2); PG8_BAR;
        PG8_STAGE(PG8_SB(1, 0), cB + kstep, voffB); PG8_STAGE(PG8_SA(1, 0), cA + kstep, voffA); PG8_STAGE(PG8_SB(1, 1), cB + hstep + kstep, voffB);
        PG8_WAIT_V(6); PG8_BAR;
    } else {
        PG8_STAGE(PG8_SB(0, 0), cB, voffB); PG8_STAGE(PG8_SA(0, 0), cA, voffA); PG8_STAGE(PG8_SB(0, 1), cB + hstep, voffB); PG8_STAGE(PG8_SA(0, 1), cA + hstep, voffA);
        if (wr == 1) PG8_BAR;
        PG8_WAIT_V(4); PG8_BAR;
        PG8_STAGE(PG8_SB(1, 0), cB + kstep, voffB); PG8_STAGE(PG8_SA(1, 0), cA + kstep, voffA); PG8_STAGE(PG8_SB(1, 1), cB + hstep + kstep, voffB);
        PG8_WAIT_V(6); PG8_BAR;
    }
    for (;;) {
        const bool has_next = S.next(ui + 1, nxt);
        const char* nA = has_next ? S.a_ptr(nxt) : cA; const char* nB = has_next ? S.b_ptr(nxt) : cB;
        for (int t = 0; t < nt; t += 2) {
            const bool last = (t == nt - 2);
            const char* a1 = cA + (size_t)(t + 1) * kstep;
            const char* a2 = last ? nA : cA + (size_t)(t + 2) * kstep; const char* b2 = last ? nB : cB + (size_t)(t + 2) * kstep;
            const char* a3 = a2 + kstep; const char* b3 = b2 + kstep;
            if constexpr (SP2) {
            PG8_LDB(B0, 0, 0); PG8_LDB(B1, 0, 1); PG8_SCHED; PG8_LDA(At, 0, 0); PG8_STAGE(PG8_SA(1, 1), a1 + hstep, voffA);
            PG8_WAIT_V(8); PG8_WAIT_L(0); PG8_BAR; PG8_MM(0, 0, At, B0); PG8_MM(0, 1, At, B1); PG8_BAR; PG8_SCHED;
            PG8_LDA(At, 0, 1); PG8_STAGE(PG8_SB(0, 0), b2, voffB); PG8_STAGE(PG8_SB(0, 1), b2 + hstep, voffB); PG8_STAGE(PG8_SA(0, 0), a2, voffA);
            PG8_WAIT_V(8); PG8_WAIT_L(0); PG8_BAR; PG8_MM(1, 0, At, B0); PG8_MM(1, 1, At, B1); PG8_BAR; PG8_SCHED;
            PG8_LDB(B0, 1, 0); PG8_LDB(B1, 1, 1); PG8_SCHED; PG8_LDA(At, 1, 0); PG8_STAGE(PG8_SA(0, 1), a2 + hstep, voffA);
            PG8_WAIT_V(8); PG8_WAIT_L(0); PG8_BAR; PG8_MM(0, 0, At, B0); PG8_MM(0, 1, At, B1); PG8_BAR; PG8_SCHED;
            PG8_LDA(At, 1, 1); PG8_STAGE(PG8_SB(1, 0), b3, voffB); PG8_STAGE(PG8_SB(1, 1), b3 + hstep, voffB); PG8_STAGE(PG8_SA(1, 0), a3, voffA);
            PG8_WAIT_V(8); PG8_WAIT_L(0); PG8_BAR; PG8_MM(1, 0, At, B0); PG8_MM(1, 1, At, B1); PG8_BAR; PG8_SCHED;
            } else {
            PG8_LDB(B0, 0, 0); PG8_SCHED; PG8_LDA(At, 0, 0); PG8_STAGE(PG8_SA(1, 1), a1 + hstep, voffA);
            PG8_WAIT_L(8); PG8_BAR; PG8_WAIT_L(0); PG8_MM(0, 0, At, B0); PG8_BAR; PG8_SCHED;
            PG8_LDB(B1, 0, 1); PG8_STAGE(PG8_SB(0, 0), b2, voffB);
            PG8_BAR; PG8_WAIT_L(0); PG8_MM(0, 1, At, B1); PG8_BAR;
            PG8_LDA(At, 0, 1); PG8_STAGE(PG8_SA(0, 0), a2, voffA);
            PG8_BAR; PG8_WAIT_L(0); PG8_MM(1, 0, At, B0); PG8_BAR; PG8_SCHED;
            PG8_STAGE(PG8_SB(0, 1), b2 + hstep, voffB);
            PG8_WAIT_V(6); PG8_BAR; PG8_MM(1, 1, At, B1); PG8_BAR;
            PG8_LDB(B0, 1, 0); PG8_SCHED; PG8_LDA(At, 1, 0); PG8_STAGE(PG8_SA(0, 1), a2 + hstep, voffA);
            PG8_WAIT_L(8); PG8_BAR; PG8_WAIT_L(0); PG8_MM(0, 0, At, B0); PG8_BAR; PG8_SCHED;
            PG8_LDB(B1, 1, 1); PG8_STAGE(PG8_SB(1, 0), b3, voffB);
            PG8_BAR; PG8_WAIT_L(0); PG8_MM(0, 1, At, B1); PG8_BAR;
            PG8_LDA(At, 1, 1); PG8_STAGE(PG8_SA(1, 0), a3, voffA);
            PG8_BAR; PG8_WAIT_L(0); PG8_MM(1, 0, At, B0); PG8_BAR; PG8_SCHED;
            PG8_STAGE(PG8_SB(1, 1), b3 + hstep, voffB);
            PG8_WAIT_V(6); PG8_BAR; PG8_MM(1, 1, At, B1); PG8_BAR;
            }
        }
        if constexpr (ALIGN_EPI) { if (wr == 0) PG8_BAR; }
        E(acc, cur, wr, wc, fr, fq);
        if (!has_next) break;
        if (!E.keep_acc(cur)) {
#pragma unroll
        for (int a = 0; a < 2; ++a)
#pragma unroll
            for (int b = 0; b < 2; ++b)
#pragma unroll
                for (int m = 0; m < 4; ++m)
#pragma unroll
                    for (int n = 0; n < 2; ++n) acc[a][b][m][n] = (f32x4){0.f, 0.f, 0.f, 0.f};
        }
        cur = nxt; cA = nA; cB = nB; ++ui;
        if constexpr (ALIGN_EPI) { if (wr == 1) PG8_BAR; }
    }
    PG8_WAIT_V(0);
    if constexpr (!ALIGN_EPI) { if (wr == 0) PG8_BAR; }
    PG8_BAR;
#undef PG8_SA
#undef PG8_SB
#undef PG8_STAGE
#undef PG8_LDA
#undef PG8_LDB
#undef PG8_MMA
#undef PG8_MMA8
#undef PG8_LD8
#undef PG8_MM
#undef PG8_WAIT_V
#undef PG8_WAIT_L
#undef PG8_BAR
#undef PG8_SCHED
}
}

struct SchedInproj {
    int K, G, c; const char* A; const char* B;
    __device__ __forceinline__ bool next(int i, pg8::Unit& u) const {
        const int L = i * G + c; u.sub = 0;
        if (L < 704) { int pn; pg8::tile_of(L, 32, 22, u.pm, pn); u.pn = pn < 4 ? pn : pn < 12 ? pn + 4 : pn + 24; return true; }
        if (L < 714) { u.pm = 32; u.pn = 36 + (L - 704); return true; }
        return false;
    }
    __device__ __forceinline__ const char* a_ptr(const pg8::Unit& u) const { return A + (size_t)u.pm * 256 * K * 2; }
    __device__ __forceinline__ const char* b_ptr(const pg8::Unit& u) const { return B + (size_t)u.pn * 256 * K * 2; }
};
struct SchedGate {
    int K, G, c; const char* A; const char* B;
    __device__ __forceinline__ bool next(int i, pg8::Unit& u) const {
        const int L = i * G + c; if (L >= 768) return false;
        int pn; pg8::tile_of(L, 32, 24, u.pm, pn); u.sub = pn; u.pn = pn < 16 ? 20 + pn : pn < 20 ? pn - 12 : pn - 4; return true;
    }
    __device__ __forceinline__ const char* a_ptr(const pg8::Unit& u) const { return A + (size_t)u.pm * 256 * K; }
    __device__ __forceinline__ const char* b_ptr(const pg8::Unit& u) const { return B + (size_t)u.sub * 256 * K; }
};
struct EpiInproj {
    static constexpr bool PERM = true;
    bf16_t *QA, *ZA, *IQ, *QB, *ZB, *GA, *GB, *KB, *VB; float *CKVRAW; bf16_t* IKN; float* IW; float qb_scale; const float *ikn_w, *ikn_b; float gscale;
    __device__ __forceinline__ bool keep_acc(const pg8::Unit&) const { return false; }
    __device__ __forceinline__ void operator()(f32x4 (&acc)[2][2][4][2], const pg8::Unit& u, int wr, int wc, int fr, int fq) const {
        const int pn = u.pn;
        if (pn < 44) {
            bf16_t* base; int ldc = 1024, ct, act = 0; bool kside = false;
            if (pn < 4) { base = QA; ct = pn; } else if (pn < 8) { base = ZA; ct = pn - 4; act = 1; } else if (pn < 12) { base = IQ; ct = pn - 8; }
            else if (pn < 16) { base = QB; ct = pn - 12; act = 2; } else if (pn < 20) { base = ZB; ct = pn - 16; act = 1; }
            else if (pn < 28) { base = GA; ct = pn - 20; ldc = 2048; act = 3; } else if (pn < 36) { base = GB; ct = pn - 28; ldc = 2048; act = 3; }
            else if (pn < 40) { base = KB; ct = pn - 36; kside = true; } else { base = VB; ct = pn - 40; kside = true; }
            const float sc = (act == 2) ? qb_scale : (act == 3) ? gscale : 1.f;
#pragma unroll
            for (int ai = 0; ai < 2; ++ai)
#pragma unroll
                for (int m = 0; m < 4; ++m) {
                    const int r = u.pm * 256 + ai * 128 + wr * 64 + m * 16 + fr;
                    long drow = r, drow2 = -1; bool ok = true;
                    if (kside) { if (r < MTOK) drow = (long)(r >> 12) * TK + NMETA + (r & 4095); else { const int i = r - MTOK; ok = i < NMETA; drow = i; drow2 = TK + i; } }
#pragma unroll
                    for (int bj = 0; bj < 2; ++bj) {
                        f32x4 v0 = acc[ai][bj][m][0], v1 = acc[ai][bj][m][1];
                        if (act == 1) {
#pragma unroll
                            for (int e = 0; e < 4; ++e) { v0[e] = silu_f(v0[e]); v1[e] = silu_f(v1[e]); }
                        }
                        v0 = v0 * sc; v1 = v1 * sc;
                        u32x4 w; w.x = pg8::cvt_pk_bf16(v0[0], v0[1]); w.y = pg8::cvt_pk_bf16(v0[2], v0[3]); w.z = pg8::cvt_pk_bf16(v1[0], v1[1]); w.w = pg8::cvt_pk_bf16(v1[2], v1[3]);
                        const int col = ct * 256 + bj * 128 + wc * 32 + 8 * fq;
                        if (ok) { *(u32x4*)(base + (size_t)drow * ldc + col) = w; if (drow2 >= 0) *(u32x4*)(base + (size_t)drow2 * ldc + col) = w; }
                    }
                }
        } else {
#pragma unroll
            for (int ai = 0; ai < 2; ++ai)
#pragma unroll
                for (int m = 0; m < 4; ++m) {
                    const int r = u.pm * 256 + ai * 128 + wr * 64 + m * 16 + fr;
                    long drow, drow2 = -1; bool ok = true;
                    if (r < MTOK) drow = (long)(r >> 12) * TK + NMETA + (r & 4095); else { const int i = r - MTOK; ok = i < NMETA; drow = i; drow2 = TK + i; }
                    if (pn == 44) {
#pragma unroll
                        for (int bj = 0; bj < 2; ++bj) {
                            const f32x4 v0 = acc[ai][bj][m][0], v1 = acc[ai][bj][m][1];
                            const int col = bj * 128 + wc * 32 + 8 * fq;
                            if (ok) { float* p = CKVRAW + (size_t)drow * 256 + col; *(f32x4*)p = v0; *(f32x4*)(p + 4) = v1;
                                      if (drow2 >= 0) { float* p2 = CKVRAW + (size_t)drow2 * 256 + col; *(f32x4*)p2 = v0; *(f32x4*)(p2 + 4) = v1; } }
                        }
                    } else if (wc == 0) {
                        const f32x4 a0 = acc[ai][0][m][0], a1 = acc[ai][0][m][1], b0 = acc[ai][1][m][0], b1 = acc[ai][1][m][1];
                        float s = ((a0[0] + a0[1]) + (a0[2] + a0[3])) + ((a1[0] + a1[1]) + (a1[2] + a1[3])) + ((b0[0] + b0[1]) + (b0[2] + b0[3])) + ((b1[0] + b1[1]) + (b1[2] + b1[3]));
                        s += __shfl_xor(s, 16); s += __shfl_xor(s, 32);
                        const float mu = s * (1.f / 64.f);
                        const f32x4 da0 = a0 - mu, da1 = a1 - mu, db0 = b0 - mu, db1 = b1 - mu;
                        float q = ((da0[0] * da0[0] + da0[1] * da0[1]) + (da0[2] * da0[2] + da0[3] * da0[3])) + ((da1[0] * da1[0] + da1[1] * da1[1]) + (da1[2] * da1[2] + da1[3] * da1[3]))
                                + ((db0[0] * db0[0] + db0[1] * db0[1]) + (db0[2] * db0[2] + db0[3] * db0[3])) + ((db1[0] * db1[0] + db1[1] * db1[1]) + (db1[2] * db1[2] + db1[3] * db1[3]));
                        q += __shfl_xor(q, 16); q += __shfl_xor(q, 32);
                        const float rs = rsqrtf(q * (1.f / 64.f) + EPS);
                        const f32x4 wa0 = *(const f32x4*)(ikn_w + 8 * fq), wa1 = *(const f32x4*)(ikn_w + 8 * fq + 4), wb0 = *(const f32x4*)(ikn_w + 32 + 8 * fq), wb1 = *(const f32x4*)(ikn_w + 36 + 8 * fq);
                        const f32x4 ba0 = *(const f32x4*)(ikn_b + 8 * fq), ba1 = *(const f32x4*)(ikn_b + 8 * fq + 4), bb0 = *(const f32x4*)(ikn_b + 32 + 8 * fq), bb1 = *(const f32x4*)(ikn_b + 36 + 8 * fq);
                        const f32x4 ya0 = da0 * rs * wa0 + ba0, ya1 = da1 * rs * wa1 + ba1, yb0 = db0 * rs * wb0 + bb0, yb1 = db1 * rs * wb1 + bb1;
                        u32x4 pa, pb;
                        pa.x = pg8::cvt_pk_bf16(ya0[0], ya0[1]); pa.y = pg8::cvt_pk_bf16(ya0[2], ya0[3]); pa.z = pg8::cvt_pk_bf16(ya1[0], ya1[1]); pa.w = pg8::cvt_pk_bf16(ya1[2], ya1[3]);
                        pb.x = pg8::cvt_pk_bf16(yb0[0], yb0[1]); pb.y = pg8::cvt_pk_bf16(yb0[2], yb0[3]); pb.z = pg8::cvt_pk_bf16(yb1[0], yb1[1]); pb.w = pg8::cvt_pk_bf16(yb1[2], yb1[3]);
                        if (ok) { *(u32x4*)(IKN + (size_t)drow * 64 + 8 * fq) = pa; *(u32x4*)(IKN + (size_t)drow * 64 + 32 + 8 * fq) = pb;
                                  if (drow2 >= 0) { *(u32x4*)(IKN + (size_t)drow2 * 64 + 8 * fq) = pa; *(u32x4*)(IKN + (size_t)drow2 * 64 + 32 + 8 * fq) = pb; } }
                    } else if (wc == 1) {
                        const f32x4 v0 = acc[ai][0][m][0], v1 = acc[ai][0][m][1];
                        if (fq < 2 && r < MTOK) { float* p = IW + (size_t)r * 16 + 8 * fq; *(f32x4*)p = v0 * 0.03125f; *(f32x4*)(p + 4) = v1 * 0.03125f; }
                    }
                }
        }
    }
};
struct EpiGate {
    static constexpr bool PERM = true;
    bf16_t *GA, *GB, *ZA, *ZB;
    __device__ __forceinline__ bool keep_acc(const pg8::Unit&) const { return false; }
    __device__ __forceinline__ void operator()(f32x4 (&acc)[2][2][4][2], const pg8::Unit& u, int wr, int wc, int fr, int fq) const {
        const int pn = u.pn; const bool zt = pn < 20; const int ldc = zt ? 1024 : DM;
        bf16_t* base = (pn < 8 ? ZA + (pn - 4) * 256 : pn < 20 ? ZB + (pn - 16) * 256 : pn < 28 ? GA + (pn - 20) * 256 : GB + (pn - 28) * 256) + (size_t)(u.pm * 256 + wr * 64 + fr) * ldc + wc * 32 + 8 * fq;
#pragma unroll
        for (int ai = 0; ai < 2; ++ai)
#pragma unroll
            for (int m = 0; m < 4; ++m)
#pragma unroll
                for (int bj = 0; bj < 2; ++bj) {
                    f32x4 v0 = acc[ai][bj][m][0] * 0.015625f, v1 = acc[ai][bj][m][1] * 0.015625f;
                    if (zt) {
#pragma unroll
                        for (int e = 0; e < 4; ++e) { v0[e] = silu_f(v0[e]); v1[e] = silu_f(v1[e]); }
                    }
                    u32x4 w; w.x = pg8::cvt_pk_bf16(v0[0], v0[1]); w.y = pg8::cvt_pk_bf16(v0[2], v0[3]); w.z = pg8::cvt_pk_bf16(v1[0], v1[1]); w.w = pg8::cvt_pk_bf16(v1[2], v1[3]);
                    *(u32x4*)(base + (size_t)(ai * 128 + m * 16) * ldc + bj * 128) = w;
                }
    }
};
struct SchedMix {
    int K, G, c; const char *A0, *B0, *A1, *B1;
    __device__ __forceinline__ bool next(int i, pg8::Unit& u) const {
        const int L = (i >> 1) * G + c; if (L >= 256) return false;
        pg8::tile_of(L, 32, 8, u.pm, u.pn); u.sub = i & 1; return true;
    }
    __device__ __forceinline__ const char* a_ptr(const pg8::Unit& u) const { return (u.sub ? A1 : A0) + (size_t)u.pm * 256 * K * 2; }
    __device__ __forceinline__ const char* b_ptr(const pg8::Unit& u) const { return (u.sub ? B1 : B0) + (size_t)u.pn * 256 * K * 2; }
};
struct EpiMix {
    static constexpr bool PERM = true;
    const bf16_t *GA, *GB; bf16_t* MIX;
    __device__ __forceinline__ bool keep_acc(const pg8::Unit& u) const { return u.sub == 0; }
    static __device__ __forceinline__ float sg_e(float a) { return __expf(-fminf(fmaxf(a, -30.f), 30.f)); }
    __device__ __forceinline__ void operator()(f32x4 (&acc)[2][2][4][2], const pg8::Unit& u, int wr, int wc, int fr, int fq) const {
        const size_t base = (size_t)(u.pm * 256 + wr * 64 + fr) * DM + u.pn * 256 + wc * 32 + 8 * fq;
        if (u.sub == 0) {
#pragma unroll
            for (int ai = 0; ai < 2; ++ai) {
                u32x4 ga[4][2], gb[4][2];
#pragma unroll
                for (int m = 0; m < 4; ++m)
#pragma unroll
                    for (int bj = 0; bj < 2; ++bj) { const size_t o = base + (size_t)(ai * 128 + m * 16) * DM + bj * 128; ga[m][bj] = *(const u32x4*)(GA + o); gb[m][bj] = *(const u32x4*)(GB + o); }
#pragma unroll
                for (int m = 0; m < 4; ++m)
#pragma unroll
                    for (int bj = 0; bj < 2; ++bj)
#pragma unroll
                        for (int e = 0; e < 4; ++e) {
                            const unsigned wa = ga[m][bj][e], wb = gb[m][bj][e];
                            const float f0 = (1.f + sg_e(bflo(wb))) * __builtin_amdgcn_rcpf(1.f + sg_e(bflo(wa))), f1 = (1.f + sg_e(bfhi(wb))) * __builtin_amdgcn_rcpf(1.f + sg_e(bfhi(wa)));
                            const int n = e >> 1, j = (e & 1) * 2;
                            acc[ai][bj][m][n][j] *= f0; acc[ai][bj][m][n][j + 1] *= f1;
                        }
            }
        } else {
            u32x4 gb[2][4][2];
#pragma unroll
            for (int m = 0; m < 4; ++m)
#pragma unroll
                for (int bj = 0; bj < 2; ++bj) gb[0][m][bj] = *(const u32x4*)(GB + base + (size_t)(m * 16) * DM + bj * 128);
#pragma unroll
            for (int ai = 0; ai < 2; ++ai) {
                if (ai == 0) {
#pragma unroll
                    for (int m = 0; m < 4; ++m)
#pragma unroll
                        for (int bj = 0; bj < 2; ++bj) gb[1][m][bj] = *(const u32x4*)(GB + base + (size_t)(128 + m * 16) * DM + bj * 128);
                }
#pragma unroll
                for (int m = 0; m < 4; ++m)
#pragma unroll
                    for (int bj = 0; bj < 2; ++bj) {
                        float v[8];
#pragma unroll
                        for (int e = 0; e < 4; ++e) {
                            const unsigned wb = gb[ai][m][bj][e]; const int n = e >> 1, j = (e & 1) * 2;
                            v[2 * e] = acc[ai][bj][m][n][j] * __builtin_amdgcn_rcpf(1.f + sg_e(bflo(wb))); v[2 * e + 1] = acc[ai][bj][m][n][j + 1] * __builtin_amdgcn_rcpf(1.f + sg_e(bfhi(wb)));
                        }
                        u32x4 w; w.x = pg8::cvt_pk_bf16(v[0], v[1]); w.y = pg8::cvt_pk_bf16(v[2], v[3]); w.z = pg8::cvt_pk_bf16(v[4], v[5]); w.w = pg8::cvt_pk_bf16(v[6], v[7]);
                        *(u32x4*)(MIX + base + (size_t)(ai * 128 + m * 16) * DM + bj * 128) = w;
                    }
            }
        }
    }
};
struct SchedOut {
    int K, G, c; const char *A, *B;
    __device__ __forceinline__ bool next(int i, pg8::Unit& u) const { const int L = i * G + c; if (L >= 256) return false; pg8::tile_of(L, 32, 8, u.pm, u.pn); u.sub = 0; return true; }
    __device__ __forceinline__ const char* a_ptr(const pg8::Unit& u) const { return A + (size_t)u.pm * 256 * K * 2; }
    __device__ __forceinline__ const char* b_ptr(const pg8::Unit& u) const { return B + (size_t)u.pn * 256 * K * 2; }
};
struct EpiOut {
    static constexpr bool PERM = true;
    bf16_t* OUTPRE; float* SSQ;
    __device__ __forceinline__ bool keep_acc(const pg8::Unit&) const { return false; }
    __device__ __forceinline__ void operator()(f32x4 (&acc)[2][2][4][2], const pg8::Unit& u, int wr, int wc, int fr, int fq) const {
#pragma unroll
        for (int ai = 0; ai < 2; ++ai)
#pragma unroll
            for (int m = 0; m < 4; ++m) {
                const int r = u.pm * 256 + ai * 128 + wr * 64 + m * 16 + fr; float ss = 0.f;
#pragma unroll
                for (int bj = 0; bj < 2; ++bj) {
                    const f32x4 v0 = acc[ai][bj][m][0], v1 = acc[ai][bj][m][1];
                    ss += (v0[0] * v0[0] + v0[1] * v0[1]) + (v0[2] * v0[2] + v0[3] * v0[3]) + (v1[0] * v1[0] + v1[1] * v1[1]) + (v1[2] * v1[2] + v1[3] * v1[3]);
                    u32x4 w; w.x = pg8::cvt_pk_bf16(v0[0], v0[1]); w.y = pg8::cvt_pk_bf16(v0[2], v0[3]); w.z = pg8::cvt_pk_bf16(v1[0], v1[1]); w.w = pg8::cvt_pk_bf16(v1[2], v1[3]);
                    *(u32x4*)(OUTPRE + (size_t)r * DM + u.pn * 256 + bj * 128 + wc * 32 + 8 * fq) = w;
                }
                ss += __shfl_xor(ss, 16); ss += __shfl_xor(ss, 32);
                if (fq == 0) SSQ[(size_t)r * 32 + u.pn * 4 + wc] = ss;
            }
    }
};

struct EpiOutFused {
    static constexpr bool PERM = false;
    const float* x; const float* post_w; float* out; float* SSQ; unsigned* cnt; LAS unsigned char* lds;
    __device__ __forceinline__ bool keep_acc(const pg8::Unit&) const { return false; }
    __device__ __forceinline__ void operator()(f32x4 (&acc)[2][2][4][2], const pg8::Unit& u, int wr, int wc, int fr, int fq) const {
        const int tid = opaque_tid(), wid = __builtin_amdgcn_readfirstlane(tid >> 6), lane = tid & 63;
        LAS float* S = (LAS float*)(lds + 131072);
#pragma unroll
        for (int ai = 0; ai < 2; ++ai)
#pragma unroll
            for (int m = 0; m < 4; ++m) {
                float ss = 0.f;
#pragma unroll
                for (int bj = 0; bj < 2; ++bj)
#pragma unroll
                    for (int n = 0; n < 2; ++n) { const f32x4 v = acc[ai][bj][m][n]; ss += (v[0] * v[0] + v[1] * v[1]) + (v[2] * v[2] + v[3] * v[3]); }
                ss += __shfl_xor(ss, 16); ss += __shfl_xor(ss, 32);
                if (fq == 0) __hip_atomic_store(SSQ + (size_t)(u.pm * 256 + ai * 128 + wr * 64 + m * 16 + fr) * 32 + u.pn * 4 + wc, ss, __ATOMIC_RELAXED, __HIP_MEMORY_SCOPE_AGENT);
            }
        asm volatile("s_waitcnt vmcnt(0)" ::: "memory");
        if (lane == 0) __hip_atomic_fetch_add(cnt + 64 * u.pm, 1u, __ATOMIC_RELAXED, __HIP_MEMORY_SCOPE_AGENT);
        if (wid == 0) {
            for (unsigned it = 0; it < (1u << 22); ++it) {
                if ((unsigned)__builtin_amdgcn_readfirstlane(__hip_atomic_load(cnt + 64 * u.pm, __ATOMIC_RELAXED, __HIP_MEMORY_SCOPE_AGENT)) >= 64u) break;
                __builtin_amdgcn_s_sleep(2);
            }
            __builtin_amdgcn_fence(__ATOMIC_ACQUIRE, "agent");
        }
        asm volatile("s_waitcnt vmcnt(0) lgkmcnt(0)" ::: "memory"); __builtin_amdgcn_s_barrier(); asm volatile("" ::: "memory");
        if (tid < 256) {
            const unsigned long long* slot = (const unsigned long long*)(SSQ + (size_t)(u.pm * 256 + tid) * 32); float s = 0.f;
#pragma unroll
            for (int t = 0; t < 16; ++t) { const unsigned long long w = __hip_atomic_load(slot + t, __ATOMIC_RELAXED, __HIP_MEMORY_SCOPE_AGENT); s += __uint_as_float((unsigned)w) + __uint_as_float((unsigned)(w >> 32)); }
            S[tid] = rsqrtf(s * (1.f / DM) + EPS);
        }
        asm volatile("s_waitcnt lgkmcnt(0)" ::: "memory"); __builtin_amdgcn_s_barrier(); asm volatile("" ::: "memory");
        const f32x4 g = *(const f32x4*)(post_w + u.pn * 256 + 4 * lane);
        const int lr0 = 4 * wid;
        const size_t gbase = (size_t)(u.pm * 256 + (lr0 >> 4) * 64 + (lr0 & 15)) * DM + u.pn * 256 + 4 * lane;
        const unsigned woff = (unsigned)((wr * 16 + fr) * 1040 + (wc * 32 + 4 * fq) * 4), roff = (unsigned)(lr0 * 1040 + lane * 16);
        f32x4 xv[4], xn[4];
#pragma unroll
        for (int q = 0; q < 4; ++q) xv[q] = __builtin_nontemporal_load((const f32x4*)(x + gbase + (size_t)q * DM));
#pragma unroll
        for (int s = 0; s < 8; ++s) {
            const int ai = s >> 2, m = s & 3; LAS unsigned char* T = lds + (s & 1) * 33280;
            const float rs = S[ai * 128 + wr * 64 + m * 16 + fr];
#pragma unroll
            for (int bj = 0; bj < 2; ++bj)
#pragma unroll
                for (int n = 0; n < 2; ++n) *(LAS f32x4*)(T + woff + bj * 512 + n * 64) = acc[ai][bj][m][n] * rs;
            if (s < 7) {
                const size_t o2 = (size_t)(((s + 1) >> 2) * 128 + ((s + 1) & 3) * 16) * DM;
#pragma unroll
                for (int q = 0; q < 4; ++q) xn[q] = __builtin_nontemporal_load((const f32x4*)(x + gbase + o2 + (size_t)q * DM));
            }
            asm volatile("s_waitcnt lgkmcnt(0)" ::: "memory"); __builtin_amdgcn_s_barrier(); asm volatile("" ::: "memory");
            const size_t o1 = (size_t)(ai * 128 + m * 16) * DM;
#pragma unroll
            for (int q = 0; q < 4; ++q) { const f32x4 v = *(const LAS f32x4*)(T + roff + q * 1040); __builtin_nontemporal_store(xv[q] + v * g, (f32x4*)(out + gbase + o1 + (size_t)q * DM)); }
#pragma unroll
            for (int q = 0; q < 4; ++q) xv[q] = xn[q];
        }
    }
};

struct TJob { const float* src; bf16_t* dst; int K, N, col0, nblk, row0, item0, fp8, pad_; };
struct Params {
    const float *x, *meta, *rel_bias, *pre_w, *w_in, *kv_norm_w, *w_uk, *w_uv, *ikn_w, *ikn_b, *lam_p, *subln_w, *w_o_a, *w_o_b, *w_out, *post_w;
    float* out; unsigned char* ws;
    TJob jobs[17]; int njobs, nitems;
};
#define WSP(T, off) ((T*)(p.ws + (off)))

__device__ __forceinline__ void p0_transpose_item(const TJob& jb, LAS float* scr, int item, int lane) {
    const int kb = item / jb.nblk, nb = item % jb.nblk, k0 = 64 * kb, n0 = jb.col0 + 32 * nb;
#pragma unroll 8
    for (int i = 0; i < 32; ++i) { const int kk = 2 * i + (lane >> 5); scr[kk * 33 + (lane & 31)] = __builtin_nontemporal_load(jb.src + (size_t)(k0 + kk) * jb.N + n0 + (lane & 31)); }
    asm volatile("s_waitcnt lgkmcnt(0)" ::: "memory");
    const int c = lane & 7;
#pragma unroll
    for (int j = 0; j < 4; ++j) { const int n = (lane >> 3) + 8 * j; const LAS float* s = scr + (8 * c) * 33 + n;
        u32x4 o; o.x = pk2(s[0 * 33], s[1 * 33]); o.y = pk2(s[2 * 33], s[3 * 33]); o.z = pk2(s[4 * 33], s[5 * 33]); o.w = pk2(s[6 * 33], s[7 * 33]);
        if (!jb.fp8) *(u32x4*)(jb.dst + (size_t)(jb.row0 + 32 * nb + n) * jb.K + k0 + 8 * c) = o;
        else { int w0 = __builtin_amdgcn_cvt_pk_fp8_f32(s[0 * 33] * 64.f, s[1 * 33] * 64.f, 0, false); w0 = __builtin_amdgcn_cvt_pk_fp8_f32(s[2 * 33] * 64.f, s[3 * 33] * 64.f, w0, true);
               int w1 = __builtin_amdgcn_cvt_pk_fp8_f32(s[4 * 33] * 64.f, s[5 * 33] * 64.f, 0, false); w1 = __builtin_amdgcn_cvt_pk_fp8_f32(s[6 * 33] * 64.f, s[7 * 33] * 64.f, w1, true);
               u32x2 o8; o8.x = (unsigned)w0; o8.y = (unsigned)w1; *(u32x2*)((unsigned char*)jb.dst + (size_t)(jb.row0 + 32 * nb + n) * jb.K + k0 + 8 * c) = o8; } }
    asm volatile("s_waitcnt lgkmcnt(0)" ::: "memory");
}
__device__ __forceinline__ void p0_norm_row(const float* xrow, const float* g, bf16_t* orow, unsigned char* o8row, int lane) {
    const f32x4* xr = (const f32x4*)xrow + lane; const f32x4* gr = (const f32x4*)g + lane;
    f32x4 v[8]; float s = 0.f;
#pragma unroll
    for (int j = 0; j < 8; ++j) { v[j] = __builtin_nontemporal_load(xr + 64 * j); s += (v[j].x * v[j].x + v[j].y * v[j].y) + (v[j].z * v[j].z + v[j].w * v[j].w); }
    const float rstd = rsqrtf(wave_sum(s) * (1.f / DM) + EPS);
    u32x2* o8 = (u32x2*)orow + lane;
#pragma unroll
    for (int j = 0; j < 8; ++j) { const f32x4 gg = gr[64 * j]; const float y0 = v[j].x * rstd * gg.x, y1 = v[j].y * rstd * gg.y, y2 = v[j].z * rstd * gg.z, y3 = v[j].w * rstd * gg.w;
        u32x2 w; w.x = pk2(y0, y1); w.y = pk2(y2, y3); o8[64 * j] = w;
        if (o8row) { int q = __builtin_amdgcn_cvt_pk_fp8_f32(y0, y1, 0, false); q = __builtin_amdgcn_cvt_pk_fp8_f32(y2, y3, q, true); ((unsigned*)o8row)[64 * j + lane] = (unsigned)q; } }
}
__device__ __forceinline__ void phase0(const Params& p, LAS unsigned char* lds, int gw, int ngw, int wave, int lane, int item_lo, int item_hi) {
    LAS float* scr = (LAS float*)(lds + wave * 16384);
    for (int it = gw + item_lo; it < item_hi; it += ngw) {
        int jn = 0;
#pragma unroll
        for (int q = 1; q < 17; ++q) if (q < p.njobs && it >= p.jobs[q].item0) jn = q;
        p0_transpose_item(p.jobs[jn], scr, it - p.jobs[jn].item0, lane);
    }
    if (item_lo != 0) return;
    bf16_t* U = WSP(bf16_t, WS_U);
    for (int m = gw; m < UROWS; m += ngw) {
        if (m < MTOK) p0_norm_row(p.x + (size_t)m * DM, p.pre_w, U + (size_t)m * DM, WSP(unsigned char, WS_U8) + (size_t)m * DM, lane);
        else if (m < MTOK + NMETA) p0_norm_row(p.meta + (size_t)(m - MTOK) * DM, p.pre_w, U + (size_t)m * DM, nullptr, lane);
        else { u32x4* o = (u32x4*)(U + (size_t)m * DM) + lane;
#pragma unroll
            for (int j = 0; j < 4; ++j) o[64 * j] = (u32x4){0u, 0u, 0u, 0u}; }
    }
    bf16_t* WUK = WSP(bf16_t, WS_WUK);
    for (int i = gw * 64 + lane; i < 262144 / 4; i += ngw * 64) { const f32x4 v = ((const f32x4*)p.w_uk)[i]; u32x2 w; w.x = pk2(v.x, v.y); w.y = pk2(v.z, v.w); ((u32x2*)WUK)[i] = w; }
}

__device__ __forceinline__ void phase_ckvnorm(const Params& p, int gw, int ngw, int lane) {
    const float* CKVRAW = WSP(const float, WS_CKVRAW); bf16_t* CKV = WSP(bf16_t, WS_CKV);
    for (int r = gw; r < MKEY; r += ngw) {
        const f32x4 v = ((const f32x4*)(CKVRAW + (size_t)r * 256))[lane];
        const float ss = wave_sum((v.x * v.x + v.y * v.y) + (v.z * v.z + v.w * v.w));
        const float rstd = rsqrtf(ss * (1.f / 256.f) + EPS);
        const f32x4 g = ((const f32x4*)p.kv_norm_w)[lane];
        int w = __builtin_amdgcn_cvt_pk_fp8_f32(v.x * rstd * g.x, v.y * rstd * g.y, 0, false); w = __builtin_amdgcn_cvt_pk_fp8_f32(v.z * rstd * g.z, v.w * rstd * g.w, w, true);
        ((unsigned*)((unsigned char*)CKV + (size_t)r * 256))[lane] = (unsigned)w;
    }
}

__device__ __forceinline__ void phase7(const Params& p, int gw, int ngw, int lane) {
    const bf16_t* OUTPRE = WSP(const bf16_t, WS_OUTPRE); const float* SSQ = WSP(const float, WS_SSQ);
    for (int r = gw; r < MTOK; r += ngw) {
        float s = (lane < 32) ? SSQ[(size_t)r * 32 + lane] : 0.f; s = wave_sum(s);
        const float rstd = rsqrtf(s * (1.f / DM) + EPS);
        const u32x4* o = (const u32x4*)(OUTPRE + (size_t)r * DM); const f32x4* xr = (const f32x4*)(p.x + (size_t)r * DM); const f32x4* g = (const f32x4*)p.post_w; f32x4* out = (f32x4*)(p.out + (size_t)r * DM);
#pragma unroll
        for (int j = 0; j < 4; ++j) {
            const int ch = 64 * j + lane;
            const u32x4 w = o[ch]; const f32x4 x0 = __builtin_nontemporal_load(xr + 2 * ch), x1 = __builtin_nontemporal_load(xr + 2 * ch + 1), g0 = g[2 * ch], g1 = g[2 * ch + 1];
            f32x4 y0, y1;
            y0.x = x0.x + bflo(w.x) * rstd * g0.x; y0.y = x0.y + bfhi(w.x) * rstd * g0.y; y0.z = x0.z + bflo(w.y) * rstd * g0.z; y0.w = x0.w + bfhi(w.y) * rstd * g0.w;
            y1.x = x1.x + bflo(w.z) * rstd * g1.x; y1.y = x1.y + bfhi(w.z) * rstd * g1.y; y1.z = x1.z + bflo(w.w) * rstd * g1.z; y1.w = x1.w + bfhi(w.w) * rstd * g1.w;
            out[2 * ch] = y0; out[2 * ch + 1] = y1;
        }
    }
}

typedef short v4i16_t __attribute__((ext_vector_type(4)));
typedef float f32x2_t __attribute__((ext_vector_type(2))); typedef __bf16 bf16x2_t __attribute__((ext_vector_type(2)));
__device__ __forceinline__ unsigned cvtpk_s(float lo, float hi) { const f32x2_t v = {lo, hi}; const bf16x2_t b = __builtin_convertvector(v, bf16x2_t); return __builtin_bit_cast(unsigned, b); }
__device__ __forceinline__ unsigned off_b(unsigned row, unsigned ch) { const unsigned f = ((row >> 3) & 1u) | ((((row >> 2) ^ (row >> 3)) & 1u) << 1) | (((row >> 1) & 1u) << 2) | ((row & 1u) << 3); return 256u * row + 16u * (ch ^ f); }
__device__ __forceinline__ bf16x8 tr_frag(LAS unsigned char* img, unsigned a0, unsigned a1) {
    const v4i16_t lo = __builtin_amdgcn_ds_read_tr16_b64_v4i16((LAS v4i16_t*)(img + a0));
    const v4i16_t hi = __builtin_amdgcn_ds_read_tr16_b64_v4i16((LAS v4i16_t*)(img + a1));
    return (bf16x8){lo[0], lo[1], lo[2], lo[3], hi[0], hi[1], hi[2], hi[3]};
}
__device__ __forceinline__ void glds16(const void* gsrc, unsigned lds_dst) {
    unsigned keep;
    asm volatile("s_mov_b32 %0, m0\n\ts_mov_b32 m0, %2\n\ts_nop 0\n\tglobal_load_lds_dwordx4 %1, off\n\ts_mov_b32 m0, %0" : "=&s"(keep) : "v"(gsrc), "s"(lds_dst) : "memory");
}
constexpr int DB_K = 0, DB_V = 49152, DB_LUT = 98304, DB_Q = 99328;
constexpr float DIFF_THR = 24.0f;
__device__ __forceinline__ void diff_unit(const Params& p, LAS unsigned char* lds, int b, int h, int qb, float lam) {
    const bf16_t* QB = WSP(const bf16_t, WS_QB); const bf16_t* KB = WSP(const bf16_t, WS_KB); const bf16_t* VB = WSP(const bf16_t, WS_VB); const bf16_t* ZB = WSP(const bf16_t, WS_ZB); bf16_t* OZB = WSP(bf16_t, WS_OZB);
    const int tid = opaque_tid(), lane = tid & 63, wave = __builtin_amdgcn_readfirstlane(tid >> 6), l15 = lane & 15, g = lane >> 4;
    const int jw = 128 * qb + 16 * wave, jq = jw + l15, cw = 2 * qb + 1 + (wave >> 2), ntiles = 2 * qb + 3;
    LAS float* LUT = (LAS float*)(lds + DB_LUT);
    __syncthreads();
    if (tid < 155) LUT[tid] = p.rel_bias[t5_bucket(tid - 91) * 16 + 8 + h] * LOG2E;
    LAS unsigned char* Qimg = lds + DB_Q + wave * 4096;
    { const bf16_t* qp = QB + (size_t)(b * SEQ + jq) * 1024 + h * 128 + 8 * g;
#pragma unroll
      for (int s = 0; s < 4; ++s) *(LAS bf16x8*)(Qimg + off_b((unsigned)l15, 4u * s + (unsigned)g)) = *(const bf16x8*)(qp + 32 * s); }
    size_t dsrc[2];
#pragma unroll
    for (int i = 0; i < 2; ++i) { const unsigned row = 8u * wave + 4u * i + (unsigned)(lane >> 4); const unsigned f = (off_b(row & 15u, 0u) >> 4) & 15u;
        dsrc[i] = (size_t)row * 1024 + h * 128 + (((unsigned)(lane & 15)) ^ f) * 8; }
    const unsigned ddst = 2048u * wave;
    const unsigned lds0 = (unsigned)(size_t)lds;
#define DF_ROW0(tt) ((size_t)b * TK + ((tt) == 0 ? 0 : 16 + 64 * ((tt) - 1)))
#define DF_DMAK(tt, slot) do { const bf16_t* g_ = KB + DF_ROW0(tt) * 1024; _Pragma("unroll") for (int i_ = 0; i_ < 2; ++i_) \
        glds16(g_ + dsrc[i_], (unsigned)__builtin_amdgcn_readfirstlane((int)(lds0 + DB_K + (slot) * 16384 + ddst + 1024 * i_))); } while (0)
#define DF_DMAV(tt, slot) do { const bf16_t* g_ = VB + DF_ROW0(tt) * 1024; _Pragma("unroll") for (int i_ = 0; i_ < 2; ++i_) \
        glds16(g_ + dsrc[i_], (unsigned)__builtin_amdgcn_readfirstlane((int)(lds0 + DB_V + (slot) * 16384 + ddst + 1024 * i_))); } while (0)
#define DF_WAITBAR(n) do { if ((n) >= 4) asm volatile("s_waitcnt vmcnt(4) lgkmcnt(0)" ::: "memory"); else if ((n) >= 2) asm volatile("s_waitcnt vmcnt(2) lgkmcnt(0)" ::: "memory"); \
        else asm volatile("s_waitcnt vmcnt(0) lgkmcnt(0)" ::: "memory"); __builtin_amdgcn_s_barrier(); asm volatile("" ::: "memory"); } while (0)
    const unsigned q4 = (unsigned)l15 >> 2, pp = (unsigned)l15 & 3u;
    unsigned kbase[2][2], vbase[8];
#pragma unroll
    for (int mp = 0; mp < 2; ++mp)
#pragma unroll
        for (int s = 0; s < 2; ++s) kbase[mp][s] = off_b((unsigned)l15, 8u * mp + 4u * s + (unsigned)g);
#pragma unroll
    for (int c = 0; c < 8; ++c) vbase[c] = off_b(4u * g + q4, 2u * c + (pp >> 1)) + 8u * (pp & 1u);

    float m1 = 0.f, m2 = 0.f;
    f32x4 O1[8], O2[8], OL1 = (f32x4){0.f, 0.f, 0.f, 0.f}, OL2 = (f32x4){0.f, 0.f, 0.f, 0.f};
    const short one_ = (l15 == 0) ? (short)0x3F80 : (short)0;
    const bf16x8 onesf = (bf16x8){one_, one_, one_, one_, one_, one_, one_, one_};
#pragma unroll
    for (int c = 0; c < 8; ++c) { O1[c] = (f32x4){0.f, 0.f, 0.f, 0.f}; O2[c] = (f32x4){0.f, 0.f, 0.f, 0.f}; }
    f32x4 S1[4], S2[4];
    bf16x8 pa1[2], pa2[2];
    float es1 = 1.f, es2 = 1.f; bool pending = false;
    f32x4 cn1 = (f32x4){0.f, 0.f, 0.f, 0.f}, cn2 = cn1, cf1 = cn1, cf2 = cn1;

#define DF_QK(tt, kbo_) do { LAS unsigned char* Kb_ = lds + DB_K + (kbo_); \
        const int dmin_ = ((tt) == 0) ? (jw + 1) : (jw - 64 * (tt) + 1); const bool near_ = dmin_ < 91; \
        const f32x4 ci1_ = near_ ? cn1 : cf1, ci2_ = near_ ? cn2 : cf2;        \
        _Pragma("unroll") for (int s = 0; s < 2; ++s) { const bf16x8 q1_ = *(const LAS bf16x8*)(Qimg + kbase[0][s]), q2_ = *(const LAS bf16x8*)(Qimg + kbase[1][s]); \
          bf16x8 ka1_[4], ka2_[4]; \
          _Pragma("unroll") for (int mb = 0; mb < 4; ++mb) { ka1_[mb] = *(const LAS bf16x8*)(Kb_ + kbase[0][s] + 4096 * mb); ka2_[mb] = *(const LAS bf16x8*)(Kb_ + kbase[1][s] + 4096 * mb); } \
          __builtin_amdgcn_sched_barrier(0); \
          _Pragma("unroll") for (int mb = 0; mb < 4; ++mb) { \
            S1[mb] = __builtin_amdgcn_mfma_f32_16x16x32_bf16(ka1_[mb], q1_, s == 0 ? ci1_ : S1[mb], 0, 0, 0); S2[mb] = __builtin_amdgcn_mfma_f32_16x16x32_bf16(ka2_[mb], q2_, s == 0 ? ci2_ : S2[mb], 0, 0, 0); } } \
        if (near_) { _Pragma("unroll") for (int mb = 0; mb < 4; ++mb) _Pragma("unroll") for (int i = 0; i < 4; ++i) { \
            const int kr_ = 16 * mb + 4 * g + i; const int kpos_ = ((tt) == 0) ? kr_ : 16 + 64 * ((tt) - 1) + kr_; \
            int rel_ = kpos_ - (NMETA + jq); rel_ = rel_ < -91 ? -91 : (rel_ > 63 ? 63 : rel_); const float bias_ = LUT[rel_ + 91]; S1[mb][i] += bias_; S2[mb][i] += bias_; } } \
        if ((tt) == 0) { _Pragma("unroll") for (int mb = 1; mb < 4; ++mb) { S1[mb] = (f32x4){-INFINITY, -INFINITY, -INFINITY, -INFINITY}; S2[mb] = S1[mb]; } } } while (0)
#define DF_LMAX(t1_, t2_) do { t1_ = fmaxf(fmaxf(S1[0][0], S1[0][1]), S1[0][2]); t2_ = fmaxf(fmaxf(S2[0][0], S2[0][1]), S2[0][2]); \
        t1_ = fmaxf(fmaxf(t1_, S1[0][3]), S1[1][0]); t2_ = fmaxf(fmaxf(t2_, S2[0][3]), S2[1][0]); \
        t1_ = fmaxf(fmaxf(t1_, S1[1][1]), S1[1][2]); t2_ = fmaxf(fmaxf(t2_, S2[1][1]), S2[1][2]); \
        t1_ = fmaxf(fmaxf(t1_, S1[1][3]), S1[2][0]); t2_ = fmaxf(fmaxf(t2_, S2[1][3]), S2[2][0]); \
        t1_ = fmaxf(fmaxf(t1_, S1[2][1]), S1[2][2]); t2_ = fmaxf(fmaxf(t2_, S2[2][1]), S2[2][2]); \
        t1_ = fmaxf(fmaxf(t1_, S1[2][3]), S1[3][0]); t2_ = fmaxf(fmaxf(t2_, S2[2][3]), S2[3][0]); \
        t1_ = fmaxf(fmaxf(t1_, S1[3][1]), S1[3][2]); t2_ = fmaxf(fmaxf(t2_, S2[3][1]), S2[3][2]); \
        t1_ = fmaxf(t1_, S1[3][3]); t2_ = fmaxf(t2_, S2[3][3]); } while (0)
#define DF_RESCALE(t1_, t2_, forced_) do { float r1_ = t1_, r2_ = t2_; r1_ = fmaxf(r1_, __shfl_xor(r1_, 16)); r1_ = fmaxf(r1_, __shfl_xor(r1_, 32)); r2_ = fmaxf(r2_, __shfl_xor(r2_, 16)); r2_ = fmaxf(r2_, __shfl_xor(r2_, 32)); \
        const float d1_ = (forced_) ? r1_ : fmaxf(r1_, 0.f), d2_ = (forced_) ? r2_ : fmaxf(r2_, 0.f); m1 += d1_; m2 += d2_; \
        es1 = __builtin_amdgcn_exp2f(-d1_); es2 = __builtin_amdgcn_exp2f(-d2_); \
        _Pragma("unroll") for (int mb = 0; mb < 4; ++mb) { S1[mb] = S1[mb] - d1_; S2[mb] = S2[mb] - d2_; } \
        cn1 = (f32x4){-m1, -m1, -m1, -m1}; cn2 = (f32x4){-m2, -m2, -m2, -m2}; { const float f1_ = bias_far - m1, f2_ = bias_far - m2; cf1 = (f32x4){f1_, f1_, f1_, f1_}; cf2 = (f32x4){f2_, f2_, f2_, f2_}; } } while (0)
#define DF_SCALE_O() do { _Pragma("unroll") for (int i = 0; i < 4; ++i) { const float x1_ = __shfl(es1, 4 * g + i), x2_ = __shfl(es2, 4 * g + i); OL1[i] *= x1_; OL2[i] *= x2_; \
            _Pragma("unroll") for (int c = 0; c < 8; ++c) { O1[c][i] *= x1_; O2[c][i] *= x2_; } } } while (0)
#define DF_EXP() do { _Pragma("unroll") for (int mb = 0; mb < 4; ++mb) _Pragma("unroll") for (int i = 0; i < 4; ++i) { S1[mb][i] = __builtin_amdgcn_exp2f(S1[mb][i]); S2[mb][i] = __builtin_amdgcn_exp2f(S2[mb][i]); } \
        _Pragma("unroll") for (int ks = 0; ks < 2; ++ks) { u32x4 w1_, w2_; \
            w1_.x = cvtpk_s(S1[2 * ks][0], S1[2 * ks][1]); w1_.y = cvtpk_s(S1[2 * ks][2], S1[2 * ks][3]); w1_.z = cvtpk_s(S1[2 * ks + 1][0], S1[2 * ks + 1][1]); w1_.w = cvtpk_s(S1[2 * ks + 1][2], S1[2 * ks + 1][3]); \
            w2_.x = cvtpk_s(S2[2 * ks][0], S2[2 * ks][1]); w2_.y = cvtpk_s(S2[2 * ks][2], S2[2 * ks][3]); w2_.z = cvtpk_s(S2[2 * ks + 1][0], S2[2 * ks + 1][1]); w2_.w = cvtpk_s(S2[2 * ks + 1][2], S2[2 * ks + 1][3]); \
            pa1[ks] = __builtin_bit_cast(bf16x8, w1_); pa2[ks] = __builtin_bit_cast(bf16x8, w2_); } } while (0)
#define DF_PV(vbo_, pq1_, pq2_) do { LAS unsigned char* Vb_ = lds + DB_V + (vbo_); \
        _Pragma("unroll") for (int ks = 0; ks < 2; ++ks) { OL1 = __builtin_amdgcn_mfma_f32_16x16x32_bf16(pq1_[ks], onesf, OL1, 0, 0, 0); OL2 = __builtin_amdgcn_mfma_f32_16x16x32_bf16(pq2_[ks], onesf, OL2, 0, 0, 0); } \
        _Pragma("unroll") for (int c2 = 0; c2 < 8; c2 += 2) { bf16x8 vf_[2][2]; \
            _Pragma("unroll") for (int cc = 0; cc < 2; ++cc) _Pragma("unroll") for (int ks = 0; ks < 2; ++ks) vf_[cc][ks] = tr_frag(Vb_ + vbase[c2 + cc], 8192u * ks, 8192u * ks + 4096u); \
            _Pragma("unroll") for (int cc = 0; cc < 2; ++cc) _Pragma("unroll") for (int ks = 0; ks < 2; ++ks) { \
                O1[c2 + cc] = __builtin_amdgcn_mfma_f32_16x16x32_bf16(pq1_[ks], vf_[cc][ks], O1[c2 + cc], 0, 0, 0); O2[c2 + cc] = __builtin_amdgcn_mfma_f32_16x16x32_bf16(pq2_[ks], vf_[cc][ks], O2[c2 + cc], 0, 0, 0); } } } while (0)

    DF_DMAK(0, 0); DF_DMAV(0, 0); DF_DMAK(1, 1); DF_DMAV(1, 1); DF_DMAK(2, 2);
    asm volatile("s_waitcnt vmcnt(0) lgkmcnt(0)" ::: "memory"); __builtin_amdgcn_s_barrier(); asm volatile("" ::: "memory");
    const float bias_far = LUT[0];
    cf1 = (f32x4){bias_far, bias_far, bias_far, bias_far}; cf2 = cf1;
    { DF_QK(0, 0u); float t1, t2; DF_LMAX(t1, t2); DF_RESCALE(t1, t2, true); DF_EXP(); }
    asm volatile("s_waitcnt lgkmcnt(0)" ::: "memory"); __builtin_amdgcn_s_barrier(); asm volatile("" ::: "memory");
    int sk = 1, sv = 0;
    for (int t = 0; t < ntiles; ++t) {
        if (__builtin_expect(pending, 0)) { DF_SCALE_O(); pending = false; }
        int nnew = 0;
        { const int s3 = (sk == 0) ? 2 : sk - 1;
          if (t + 3 < ntiles) { DF_DMAK(t + 3, s3); nnew += 2; }
          const int s2 = (sv == 0) ? 2 : sv - 1;
          if (t + 2 < ntiles) { DF_DMAV(t + 2, s2); nnew += 2; } }
        unsigned kbo = (unsigned)sk * 16384u, vbo = (unsigned)sv * 16384u; asm volatile("" : "+v"(kbo), "+v"(vbo));
        if (t + 1 <= cw) {
            DF_QK(t + 1, kbo);
            float t1, t2; DF_LMAX(t1, t2);
            if (__builtin_expect(__any((t1 > DIFF_THR) || (t2 > DIFF_THR)), 0)) { DF_RESCALE(t1, t2, false); pending = true; }
            DF_PV(vbo, pa1, pa2);
            DF_EXP();
        } else if (t <= cw) {
            DF_PV(vbo, pa1, pa2);
        }
        DF_WAITBAR(nnew);
        sk = (sk == 2) ? 0 : sk + 1; sv = (sv == 2) ? 0 : sv + 1;
    }
    asm volatile("s_waitcnt vmcnt(0)" ::: "memory");
#undef DF_ROW0
#undef DF_DMAK
#undef DF_DMAV
#undef DF_WAITBAR
#undef DF_QK
#undef DF_LMAX
#undef DF_RESCALE
#undef DF_SCALE_O
#undef DF_EXP
#undef DF_PV
#pragma unroll
    for (int i = 0; i < 4; ++i) {
        const float r1 = 1.f / __shfl(OL1[i], 16 * g), r2 = lam / __shfl(OL2[i], 16 * g);
        float o[8]; float ss = 0.f;
#pragma unroll
        for (int c = 0; c < 8; ++c) { o[c] = O1[c][i] * r1 - O2[c][i] * r2; ss += o[c] * o[c]; }
        ss += __shfl_xor(ss, 1); ss += __shfl_xor(ss, 2); ss += __shfl_xor(ss, 4); ss += __shfl_xor(ss, 8);
        const float rs = rsqrtf(ss * (1.f / 128.f) + EPS) * 0.8f;
        const size_t t = (size_t)b * SEQ + jw + 4 * g + i;
#pragma unroll
        for (int c = 0; c < 8; ++c) { const int d = 16 * c + l15; const float y = o[c] * rs * p.subln_w[d] * bf2f(ZB[t * 1024 + h * 128 + d]); OZB[t * 1024 + h * 128 + d] = (bf16_t)f2bf(y); }
    }
}
__device__ __forceinline__ void phase_diff(const Params& p, LAS unsigned char* lds) {
    const int lane = threadIdx.x & 63;
    float a = (lane < 64) ? p.lam_p[lane] * p.lam_p[64 + lane] : 0.f, bb = p.lam_p[128 + lane] * p.lam_p[192 + lane];
    a = wave_sum(a); bb = wave_sum(bb);
    const float lam = expf(a) - expf(bb) + 0.2f;
    for (int u = blockIdx.x; u < 512; u += gridDim.x) {
        const int v = u & 255;
        int bh = v >> 4, s = v & 15;
        if (gridDim.x == 256) { bh = (v & 7) + 8 * (v >> 7); s = (v >> 3) & 15; }
        const int qb = (u < 256) ? s : 31 - s;
        diff_unit(p, lds, bh >> 3, bh & 7, qb, lam);
    }
}

typedef float f32x16 __attribute__((ext_vector_type(16)));
__device__ __forceinline__ void scores_wg_unit(const Params& p, LAS unsigned char* lds, int c, int b, int half, int kh) {
    const bf16_t* IQ = WSP(const bf16_t, WS_IQ); const float* IW = WSP(const float, WS_IW); float* SC = WSP(float, WS_SC);
    const int tid = opaque_tid(), lane = tid & 63, wave = __builtin_amdgcn_readfirstlane(tid >> 6);
    const int j0 = (c - 1) * 64 + 32 * half + 4 * wave, m0 = b * SEQ + j0, n = 16 + 64 * c, nkb = 2 * c + 1, nkh = (nkb + 1) >> 1;
    const int kbA = kh ? nkh : 0, kbB = kh ? nkb : nkh, ntile = (kbB - kbA + 1) >> 1;
    const int r32 = lane & 31, hi = lane >> 5, tok = r32 >> 4, hh = r32 & 15;
    bf16x8 af[2][4]; float wv[2][16];
#pragma unroll
    for (int pr = 0; pr < 2; ++pr) {
#pragma unroll
        for (int s = 0; s < 4; ++s) af[pr][s] = *(const bf16x8*)(IQ + (size_t)(m0 + 2 * pr + tok) * 1024 + hh * 64 + 16 * s + 8 * hi);
#pragma unroll
        for (int r = 0; r < 16; ++r) wv[pr][r] = IW[(size_t)(m0 + 2 * pr + (r >> 3)) * 16 + (r & 3) + 8 * ((r >> 2) & 1) + 4 * hi];
    }
    float* rowbase = SC + sc_off(b, j0);
    const bf16_t* ikb = WSP(const bf16_t, WS_IK) + (size_t)b * TK * 64;
    const int pkey = tid >> 3, pch = tid & 7;
    const unsigned pdst = (unsigned)pkey * 128u + 16u * (unsigned)(pch ^ (((pkey >> 1) & 1) | (((pkey >> 3) & 1) << 1) | (((pkey >> 4) & 1) << 2)));
    unsigned boff[4];
#pragma unroll
    for (int s = 0; s < 4; ++s) boff[s] = (unsigned)r32 * 128u + 16u * (unsigned)((2 * s + hi) ^ (((r32 >> 1) & 1) | (((r32 >> 3) & 1) << 1) | (((r32 >> 4) & 1) << 2)));
    u32x4 kreg[4];
#define SCW_LOAD(T_) do { _Pragma("unroll") for (int i_ = 0; i_ < 4; ++i_) { int key_ = 32 * (kbA + 8 * (T_)) + 64 * i_ + pkey; key_ = key_ < n ? key_ : n - 1; kreg[i_] = *(const u32x4*)(ikb + (size_t)key_ * 64 + pch * 8); } } while (0)
#define SCW_WRITE(off_) do { _Pragma("unroll") for (int i_ = 0; i_ < 4; ++i_) *(LAS u32x4*)(lds + (off_) + i_ * 8192 + pdst) = kreg[i_]; } while (0)
#define SCW_CHAIN(acc_, pr_, bf_) do { _Pragma("unroll") for (int r_ = 0; r_ < 16; ++r_) acc_[r_] = 0.f; \
        _Pragma("unroll") for (int s_ = 0; s_ < 4; ++s_) acc_ = __builtin_amdgcn_mfma_f32_32x32x16_bf16(af[pr_][s_], bf_[s_], acc_, 0, 0, 0); } while (0)
#define SCW_SUM(acc_, pr_, kb_, en_) do { f32x2_t s0_ = {0.f, 0.f}, s1_ = {0.f, 0.f}; \
        _Pragma("unroll") for (int r_ = 0; r_ < 8; r_ += 2) { \
            const f32x2_t x0_ = {__builtin_amdgcn_fmed3f(acc_[r_], 0.f, pinf), __builtin_amdgcn_fmed3f(acc_[r_ + 1], 0.f, pinf)}; \
            const f32x2_t x1_ = {__builtin_amdgcn_fmed3f(acc_[8 + r_], 0.f, pinf), __builtin_amdgcn_fmed3f(acc_[9 + r_], 0.f, pinf)}; \
            s0_ = __builtin_elementwise_fma((f32x2_t){wv[pr_][r_], wv[pr_][r_ + 1]}, x0_, s0_); s1_ = __builtin_elementwise_fma((f32x2_t){wv[pr_][8 + r_], wv[pr_][9 + r_]}, x1_, s1_); } \
        const float p0_ = s0_.x + s0_.y, p1_ = s1_.x + s1_.y; \
        const auto sw_ = __builtin_amdgcn_permlane32_swap(__float_as_uint(p0_), __float_as_uint(p1_), false, false); \
        const float tot_ = __uint_as_float(sw_[0]) + __uint_as_float(sw_[1]); const int key_ = 32 * (kb_) + r32; \
        if ((en_) && (kb_) < kbB && key_ < n) rowbase[(size_t)(2 * (pr_) + hi) * n + key_] = tot_; } while (0)
#define SCW_MIX() do { _Pragma("unroll") for (int g_ = 0; g_ < 4; ++g_) { __builtin_amdgcn_sched_group_barrier(0x008, 1, 0); __builtin_amdgcn_sched_group_barrier(0x002, 6, 0); } } while (0)
    __syncthreads();
    SCW_LOAD(0); SCW_WRITE(0u);
    __syncthreads();
    f32x16 accA, accB;
    float pinf = __builtin_inff(); asm volatile("" : "+v"(pinf));
#pragma unroll
    for (int r = 0; r < 16; ++r) accB[r] = 0.f;
    const int nsup = (ntile + 3) >> 2;
    for (int T = 0; T < nsup; ++T) {
        if (T + 1 < nsup) SCW_LOAD(T + 1);
        const int tend = (4 * T + 4 < ntile) ? 4 * T + 4 : ntile;
        for (int t = 4 * T; t < tend; ++t) {
            unsigned bo = (unsigned)(T & 1) * 32768u + (unsigned)(t & 3) * 8192u; asm volatile("" : "+v"(bo));
            const int kb0 = kbA + 2 * t;
            bf16x8 bf0[4], bf1[4];
#pragma unroll
            for (int s = 0; s < 4; ++s) bf0[s] = *(const LAS bf16x8*)(lds + bo + boff[s]);
#pragma unroll
            for (int s = 0; s < 4; ++s) bf1[s] = *(const LAS bf16x8*)(lds + bo + boff[s] + 4096);
            SCW_CHAIN(accA, 0, bf0); SCW_SUM(accB, 1, kb0 - 1, t > 0); SCW_MIX();
            SCW_CHAIN(accB, 1, bf0); SCW_SUM(accA, 0, kb0, true); SCW_MIX();
            SCW_CHAIN(accA, 0, bf1); SCW_SUM(accB, 1, kb0, true); SCW_MIX();
            SCW_CHAIN(accB, 1, bf1); SCW_SUM(accA, 0, kb0 + 1, true); SCW_MIX();
        }
        if (T + 1 < nsup) SCW_WRITE((unsigned)((T + 1) & 1) * 32768u);
        __syncthreads();
    }
    SCW_SUM(accB, 1, kbA + 2 * ntile - 1, true);
#undef SCW_CHAIN
#undef SCW_SUM
#undef SCW_MIX
#undef SCW_LOAD
#undef SCW_WRITE
}
__device__ __forceinline__ void phase_scores(const Params& p, LAS unsigned char* lds) {
    for (int P = (int)blockIdx.x; P < 256; P += (int)gridDim.x) {
        const int cl = 1 + (P >> 3), sub = P & 7;
        scores_wg_unit(p, lds, 65 - cl, sub >> 2, (sub >> 1) & 1, sub & 1);
        scores_wg_unit(p, lds, cl, sub >> 2, (sub >> 1) & 1, sub & 1);
    }
}
__device__ __forceinline__ void phase_qlat(const Params& p, LAS unsigned char* lds) {
    const bf16_t* QA = WSP(const bf16_t, WS_QA); const bf16_t* WUK = WSP(const bf16_t, WS_WUK); bf16_t* QLAT = WSP(bf16_t, WS_QLAT);
    const int tid = opaque_tid(), lane = tid & 63, w = __builtin_amdgcn_readfirstlane(tid >> 6), l15 = lane & 15, g = lane >> 4;
    const float sc = 0.08838834764831845f * LOG2E * 16.f;
    const int G = (int)gridDim.x;
    int hcur = -1;
    const unsigned kb0 = off_b((unsigned)l15, (unsigned)g);
    for (int u0 = (int)blockIdx.x; u0 < 4096; u0 += 8 * G) {
        const int h = u0 & 7;
        if (h != hcur || (G & 7)) { hcur = h; __syncthreads();
#pragma unroll
            for (int i = 0; i < 8; ++i) { const int idx = tid + 512 * i, row = idx >> 4, ch = idx & 15;
                *(LAS u32x4*)(lds + off_b((unsigned)row, (unsigned)ch)) = *(const u32x4*)(WUK + ((size_t)row * 8 + h) * 128 + ch * 8); }
            __syncthreads(); }
        const int u = u0 + w * G;
        if (u < 4096 && (u & 7) == h) {
            const int m0 = (u >> 3) * 16;
            bf16x8 bq[4];
#pragma unroll
            for (int s = 0; s < 4; ++s) bq[s] = *(const bf16x8*)(QA + (size_t)(m0 + l15) * 1024 + h * 128 + 32 * s + 8 * g);
#pragma unroll 4
            for (int nb = 0; nb < 16; ++nb) {
                bf16x8 af[4];
#pragma unroll
                for (int s = 0; s < 4; ++s) af[s] = *(const LAS bf16x8*)(lds + 4096 * nb + (kb0 ^ (64u * s)));
                f32x4 acc = (f32x4){0.f, 0.f, 0.f, 0.f};
#pragma unroll
                for (int s = 0; s < 4; ++s) acc = __builtin_amdgcn_mfma_f32_16x16x32_bf16(af[s], bq[s], acc, 0, 0, 0);
                int wv = __builtin_amdgcn_cvt_pk_fp8_f32(acc[0] * sc, acc[1] * sc, 0, false); wv = __builtin_amdgcn_cvt_pk_fp8_f32(acc[2] * sc, acc[3] * sc, wv, true);
                *(unsigned*)((unsigned char*)QLAT + ((size_t)(m0 + l15) * 8 + h) * 256 + 16 * nb + 4 * g) = (unsigned)wv;
            }
        }
    }
}
__device__ __forceinline__ void phase_oproj(const Params& p, LAS unsigned char* lds) {
    const bf16_t* OLAT = WSP(const bf16_t, WS_OLAT); const bf16_t* WUVT = WSP(const bf16_t, WS_WUVT); const bf16_t* ZA = WSP(const bf16_t, WS_ZA); bf16_t* OZA = WSP(bf16_t, WS_OZA);
    const int tid = opaque_tid(), lane = tid & 63, w = __builtin_amdgcn_readfirstlane(tid >> 6), l15 = lane & 15, g = lane >> 4;
    const int G = (int)gridDim.x;
    int hcur = -1;
    const unsigned kb0 = off_b((unsigned)l15, (unsigned)g);
    for (int u0 = (int)blockIdx.x; u0 < 4096; u0 += 8 * G) {
        const int h = u0 & 7;
        if (h != hcur || (G & 7)) { hcur = h; __syncthreads();
#pragma unroll
            for (int i = 0; i < 8; ++i) { const int idx = tid + 512 * i, row = idx >> 5, c32 = idx & 31;
                *(LAS u32x4*)(lds + (c32 >> 4) * 32768 + off_b((unsigned)row, (unsigned)(c32 & 15))) = *(const u32x4*)(WUVT + (size_t)(h * 128 + row) * 256 + c32 * 8); }
            __syncthreads(); }
        const int u = u0 + w * G;
        if (u < 4096 && (u & 7) == h) {
            const int m0 = (u >> 3) * 16;
            bf16x8 bq[8];
#pragma unroll
            for (int s = 0; s < 8; ++s) bq[s] = *(const bf16x8*)(OLAT + ((size_t)(m0 + l15) * 8 + h) * 256 + 32 * s + 8 * g);
#pragma unroll 2
            for (int nb = 0; nb < 8; ++nb) {
                bf16x8 af[8];
#pragma unroll
                for (int s = 0; s < 8; ++s) af[s] = *(const LAS bf16x8*)(lds + (s >> 2) * 32768 + 4096 * nb + (kb0 ^ (64u * (s & 3))));
                f32x4 acc = (f32x4){0.f, 0.f, 0.f, 0.f};
#pragma unroll
                for (int s = 0; s < 8; ++s) acc = __builtin_amdgcn_mfma_f32_16x16x32_bf16(af[s], bq[s], acc, 0, 0, 0);
                const size_t o = (size_t)(m0 + l15) * 1024 + h * 128 + 16 * nb + 4 * g;
                const u32x2 z = *(const u32x2*)(ZA + o);
                u32x2 wv; wv.x = pg8::cvt_pk_bf16(acc[0] * bflo(z.x), acc[1] * bfhi(z.x)); wv.y = pg8::cvt_pk_bf16(acc[2] * bflo(z.y), acc[3] * bfhi(z.y));
                *(u32x2*)(OZA + o) = wv;
            }
        }
    }
}
typedef int v2i32_t __attribute__((ext_vector_type(2)));
constexpr int DSA_WAVE_LDS = 17408, DSA_LUT = 8 * DSA_WAVE_LDS;
__device__ __forceinline__ int lpos(int s) { return (s & ~31) | ((s & 3) << 3) | ((s & 31) >> 2); }
__device__ __forceinline__ unsigned ord_key(float f) { const unsigned u = __float_as_uint(f); return (u & 0x80000000u) ? ~u : (u | 0x80000000u); }
template <int KN>
__device__ __forceinline__ void dsa_select(const float* row, int n, int nsel, LAS int* list, int lane) {
    const __amdgpu_buffer_rsrc_t rs = __builtin_amdgcn_make_buffer_rsrc((void*)row, 0, n * 4, 0x00020000);
    unsigned key[KN];
#pragma unroll
    for (int k = 0; k < KN; ++k) key[k] = (unsigned)__builtin_amdgcn_raw_buffer_load_b32(rs, lane * 4, 256 * k, 2);
    { int idx0 = lane;
#pragma unroll
      for (int k = 0; k < KN; ++k) { const unsigned u = key[k]; const unsigned o = (u & 0x80000000u) ? ~u : (u | 0x80000000u); key[k] = (idx0 < n) ? o : 0u; idx0 += 64; asm volatile("" : "+v"(idx0)); } }
    unsigned thr = 0u;
    if (n > 256) {
        for (int bit = 31; bit >= 0; --bit) {
            const unsigned cand = thr | (1u << bit);
            int c = 0;
#pragma unroll
            for (int k = 0; k < KN; ++k) c += (key[k] >= cand) ? 1 : 0;
            int cnt = 0;
#pragma unroll
            for (int b7 = 0; b7 < 7; ++b7) cnt += __popcll(__ballot((c >> b7) & 1)) << b7;
            if (cnt >= 256) thr = cand;
            if (cnt == 256) break;
        }
    }
    int pos = 0; int idx = lane;
#pragma unroll
    for (int k = 0; k < KN; ++k) { const bool mine = key[k] > thr; const unsigned long long msk = __ballot(mine);
        const int my = __builtin_amdgcn_mbcnt_hi((unsigned)(msk >> 32), __builtin_amdgcn_mbcnt_lo((unsigned)msk, 0u));
        if (mine) list[lpos(pos + my)] = idx; pos += __popcll(msk); idx += 64; asm volatile("" : "+v"(idx)); }
    if (pos < nsel) {
        idx = lane;
#pragma unroll
        for (int k = 0; k < KN; ++k) { const bool mine = (key[k] == thr) && (idx < n); const unsigned long long msk = __ballot(mine);
            const int my = __builtin_amdgcn_mbcnt_hi((unsigned)(msk >> 32), __builtin_amdgcn_mbcnt_lo((unsigned)msk, 0u));
            if (mine && pos + my < nsel) list[lpos(pos + my)] = idx; pos += __popcll(msk); idx += 64; asm volatile("" : "+v"(idx)); }
    }
}
__device__ __forceinline__ void dsa_unit(const Params& p, LAS unsigned char* lds, int qi, int wave, int lane, int probe) {
    const float* SC = WSP(const float, WS_SC); bf16_t* OLAT = WSP(bf16_t, WS_OLAT);
    const int c = qi >> 8, b = (qi >> 6) & 1, j = (c - 1) * 64 + (qi & 63), t = b * SEQ + j, n = 16 + 64 * c, nsel = n < 256 ? n : 256, qpos = NMETA + j;
    LAS unsigned char* img = lds + wave * DSA_WAVE_LDS; LAS int* list = (LAS int*)(img + 16384); const LAS float* LUTA = (const LAS float*)(lds + DSA_LUT);
    const int l15 = lane & 15, g = lane >> 4;
    const float* row = SC + sc_off(b, j);
#pragma unroll
    for (int rs_ = (PROBE_REP == 41) ? 2 : 1; rs_ > 0; --rs_) {
    if (n <= 64 * 17) dsa_select<17>(row, n, nsel, list, lane);
    else if (n <= 64 * 33) dsa_select<33>(row, n, nsel, list, lane);
    else if (n <= 64 * 49) dsa_select<49>(row, n, nsel, list, lane);
    else dsa_select<65>(row, n, nsel, list, lane);
    }
#pragma unroll
    for (int ra_ = (PROBE_REP == 42) ? 2 : 1; ra_ > 0; --ra_) {
    const unsigned char* CKV8 = WSP(const unsigned char, WS_CKV); const unsigned char* qlp = WSP(const unsigned char, WS_QLAT) + ((size_t)t * 8 + (l15 & 7)) * 256 + 8 * g;
    const bool qreal = l15 < 8;
    unsigned rdb[2];
    rdb[0] = 256u * (unsigned)l15 + 8u * ((unsigned)g ^ (2u * (unsigned)l15));
    rdb[1] = 256u * (unsigned)(l15 + 16) + 8u * ((unsigned)g ^ (2u * ((unsigned)l15 ^ 8u)));
    const unsigned tq = (unsigned)l15 >> 1, tp = (unsigned)l15 & 1u;
    const unsigned trow = (tq < 4u) ? 4u * g + tq : 16u + 4u * g + (tq - 4u);
    const unsigned trb = 256u * trow + 8u * (tp ^ (2u * ((trow & 15u) ^ ((trow >> 4) << 3))));
    float m = -INFINITY, l = 0.f;
    f32x4 O[16];
#pragma unroll
    for (int rb = 0; rb < 16; ++rb) O[rb] = (f32x4){0.f, 0.f, 0.f, 0.f};
    const int nch = (nsel + 31) >> 5;
    const int hcol = l15 & 7;
    u32x4 gr[8];
    const unsigned gwr = 256u * (unsigned)(lane >> 4) + 16u * (unsigned)(lane & 15);
#define DSA_GATHER(chn) do { int ki_[8]; { const LAS int* lp_ = list + 32 * (chn) + 8 * (lane >> 4); \
        _Pragma("unroll") for (int v_ = 0; v_ < 2; ++v_) { const u32x4 t_ = *(const LAS u32x4*)(lp_ + 4 * v_); ki_[4 * v_] = (int)t_.x; ki_[4 * v_ + 1] = (int)t_.y; ki_[4 * v_ + 2] = (int)t_.z; ki_[4 * v_ + 3] = (int)t_.w; } } \
        _Pragma("unroll") for (int i = 0; i < 8; ++i) { const int slot = 32 * (chn) + 4 * i + (lane >> 4); const int kidx = slot < nsel ? ki_[i] : 0; \
        gr[i] = *(const u32x4*)(CKV8 + ((size_t)b * TK + kidx) * 256 + (lane & 15) * 16); } } while (0)
    DSA_GATHER(0);
    for (int ch = 0; ch < nch; ++ch) {
#pragma unroll
        for (int i = 0; i < 8; ++i) { const unsigned row = 4u * i + (unsigned)(lane >> 4); const unsigned rc = (row & 15u) ^ ((row >> 4) << 3);
            *(LAS u32x4*)(img + 256u * row + 16u * (((unsigned)lane & 15u) ^ rc)) = gr[i]; }
        long qf[8];
#pragma unroll
        for (int s = 0; s < 8; ++s) qf[s] = *(const long*)(qlp + 32 * s);
        asm volatile("" ::: "memory");
        DSA_GATHER(ch + 1);
        asm volatile("" ::: "memory");
#pragma unroll
        for (int s = 0; s < 8; ++s) qf[s] = qreal ? qf[s] : 0l;
        unsigned io = 0u; asm volatile("" : "+v"(io));
        LAS unsigned char* im = img + io;
        f32x4 S[2];
        S[0] = (f32x4){0.f, 0.f, 0.f, 0.f}; S[1] = S[0];
#pragma unroll
        for (int s4 = 0; s4 < 8; s4 += 4) {
            long af_[4][2];
#pragma unroll
            for (int s = 0; s < 4; ++s)
#pragma unroll
                for (int mb = 0; mb < 2; ++mb) af_[s][mb] = *(const LAS long*)(im + (rdb[mb] ^ (32u * (s4 + s))));
            __builtin_amdgcn_sched_barrier(0);
#pragma unroll
            for (int s = 0; s < 4; ++s)
#pragma unroll
                for (int mb = 0; mb < 2; ++mb) S[mb] = __builtin_amdgcn_mfma_f32_16x16x32_fp8_fp8(af_[s][mb], qf[s4 + s], S[mb], 0, 0, 0);
        }
        float cm = -INFINITY;
#pragma unroll
        for (int mb = 0; mb < 2; ++mb)
#pragma unroll
            for (int i = 0; i < 4; ++i) { const int slot = 32 * ch + 16 * mb + 4 * g + i; const int kidx = list[lpos(slot & 255)];
                int rel = kidx - qpos; rel = rel < -91 ? -91 : (rel > 63 ? 63 : rel);
                float v = S[mb][i] * 0.0625f + LUTA[(rel + 91) * 8 + hcol]; v = slot < nsel ? v : -INFINITY; S[mb][i] = v; cm = fmaxf(cm, v); }
        cm = fmaxf(cm, __shfl_xor(cm, 16)); cm = fmaxf(cm, __shfl_xor(cm, 32));
        const float mn = fmaxf(m, cm), alpha = __builtin_amdgcn_exp2f(m - mn); m = mn;
        float ps = 0.f;
#pragma unroll
        for (int mb = 0; mb < 2; ++mb)
#pragma unroll
            for (int i = 0; i < 4; ++i) { S[mb][i] = __builtin_amdgcn_exp2f(S[mb][i] - mn); ps += S[mb][i]; }
        l = l * alpha + ps;
        if (__any(alpha != 1.f)) {
#pragma unroll
            for (int rb = 0; rb < 16; ++rb) O[rb] = O[rb] * alpha;
        }
        int w0 = __builtin_amdgcn_cvt_pk_fp8_f32(S[0][0], S[0][1], 0, false); w0 = __builtin_amdgcn_cvt_pk_fp8_f32(S[0][2], S[0][3], w0, true);
        int w1 = __builtin_amdgcn_cvt_pk_fp8_f32(S[1][0], S[1][1], 0, false); w1 = __builtin_amdgcn_cvt_pk_fp8_f32(S[1][2], S[1][3], w1, true);
        const long pb = (long)(((unsigned long long)(unsigned)w1 << 32) | (unsigned long long)(unsigned)w0);
#pragma unroll
        for (int rb4 = 0; rb4 < 16; rb4 += 4) {
            long tf_[4];
#pragma unroll
            for (int r_ = 0; r_ < 4; ++r_) { const v2i32_t tv = __builtin_amdgcn_ds_read_tr8_b64_v2i32((LAS v2i32_t*)(im + (trb ^ (16u * (rb4 + r_))))); tf_[r_] = __builtin_bit_cast(long, tv); }
            __builtin_amdgcn_sched_barrier(0);
#pragma unroll
            for (int r_ = 0; r_ < 4; ++r_) O[rb4 + r_] = __builtin_amdgcn_mfma_f32_16x16x32_fp8_fp8(tf_[r_], pb, O[rb4 + r_], 0, 0, 0);
        }
    }
    l += __shfl_xor(l, 16); l += __shfl_xor(l, 32);
    const float il = 1.f / l;
    if (l15 < 8) {
#pragma unroll
        for (int rb = 0; rb < 16; ++rb) { u32x2 w; w.x = pg8::cvt_pk_bf16(O[rb][0] * il, O[rb][1] * il); w.y = pg8::cvt_pk_bf16(O[rb][2] * il, O[rb][3] * il);
            *(u32x2*)(OLAT + ((size_t)t * 8 + l15) * 256 + 16 * rb + 4 * g) = w; }
    }
    }
}
#undef DSA_GATHER
__device__ __forceinline__ int lds_take(LAS unsigned* ctr, int lane) {
    int u = 0; if (lane == 0) u = (int)__hip_atomic_fetch_add(ctr, 1u, __ATOMIC_RELAXED, __HIP_MEMORY_SCOPE_WORKGROUP);
    return __builtin_amdgcn_readfirstlane(u);
}
__device__ __forceinline__ int dsa_query_of(int u, int G) {
    const int k = u >> 3, r = u & 7;
    int cl, bb, grp;
    if (G == 256) { const int idx = ((int)blockIdx.x >> 1) + 128 * k; cl = 1 + (idx >> 4); grp = idx & 15; bb = (int)blockIdx.x & 1; }
    else { const int P = (int)blockIdx.x + k * G; cl = 1 + (P >> 5); bb = (P >> 4) & 1; grp = P & 15; }
    const int c = (r < 4) ? 65 - cl : cl;
    return (c << 8) | (bb << 6) | (4 * grp + (r & 3));
}
__device__ __forceinline__ int dsa_token_of(int qi) { return ((qi >> 6) & 1) * SEQ + ((qi >> 8) - 1) * 64 + (qi & 63); }
__device__ __forceinline__ void phase_dsa(const Params& p, LAS unsigned char* lds, int wave, int lane, int probe) {
    LAS float* LUTA = (LAS float*)(lds + DSA_LUT); LAS unsigned* ctr = (LAS unsigned*)(lds + DSA_LUT + 155 * 8 * 4);
    const int G = (int)gridDim.x, l15 = lane & 15, g = lane >> 4;
    __syncthreads();
    for (int i = threadIdx.x; i < 155 * 8; i += 512) LUTA[i] = p.rel_bias[t5_bucket((i >> 3) - 91) * 16 + (i & 7)] * LOG2E;
    if (threadIdx.x == 0) ctr[0] = 0u;
    const int npi = (1024 - (int)blockIdx.x + G - 1) / G;
    const int nun = npi * 8;
    __syncthreads();
    for (;;) {
        const int u = lds_take(ctr, lane); if (u >= nun) break;
        dsa_unit(p, lds, dsa_query_of(u, G), wave, lane, probe);
    }
}

#define XB_TMO      128
#define XB_XCNT(j)  (256  + 64 * (j))
#define XB_XSUB(j)  (1280 + 64 * (j))
#define XB_XGEN(j)  (2304 + 64 * (j))
#define XB_TOP      3328
#define XB_TOPGEN   3392
#define XCD_BAR_WORDS 3456
#define XB_SPIN_CAP (1u << 24)
__device__ __forceinline__ unsigned xb_ld(unsigned* p)              { return __hip_atomic_load(p, __ATOMIC_RELAXED, __HIP_MEMORY_SCOPE_AGENT); }
__device__ __forceinline__ unsigned xb_add(unsigned* p, unsigned v) { return __hip_atomic_fetch_add(p, v, __ATOMIC_RELAXED, __HIP_MEMORY_SCOPE_AGENT); }
__device__ __forceinline__ unsigned xb_xcc_id() { return (unsigned)__builtin_amdgcn_s_getreg((3 << 11) | 20) & 0xFu; }
#define XB_SPIN(cond, bar) do { unsigned _sp = 0; while (cond) { __builtin_amdgcn_s_sleep(1); \
    if ((++_sp & 255u) == 0u) { if (xb_ld(&(bar)[XB_TMO])) break; if (_sp > XB_SPIN_CAP) { atomicAdd(&(bar)[XB_TMO], 1u); break; } } } } while (0)
struct XcdBarrier { unsigned* bar; unsigned x; volatile LAS unsigned* st; };
__device__ __forceinline__ XcdBarrier xcd_barrier_post(unsigned* bar, volatile LAS unsigned* st) {
    XcdBarrier b; b.bar = bar; b.x = xb_xcc_id(); b.st = st;
    if (threadIdx.x == 0) (void)xb_add(&bar[XB_XCNT(b.x)], 1u);
    return b;
}
__device__ __forceinline__ void xcd_barrier_complete(unsigned* bar, unsigned x, unsigned& nloc, unsigned& nx) {
    const unsigned G = gridDim.x * gridDim.y * gridDim.z;
    unsigned sum, cnt, mine, sp = 0u;
    for (;;) {
        sum = 0u; cnt = 0u; mine = 0u;
#pragma unroll
        for (unsigned j = 0; j < 16; ++j) { const unsigned c = xb_ld(&bar[XB_XCNT(j)]); sum += c; cnt += (c > 0u) ? 1u : 0u; mine = (j == x) ? c : mine; }
        if (sum == G) break;
        __builtin_amdgcn_s_sleep(1);
        if ((++sp & 255u) == 0u) { if (xb_ld(&bar[XB_TMO])) break; if (sp > XB_SPIN_CAP) { atomicAdd(&bar[XB_TMO], 1u); break; } }
    }
    nloc = mine > 0u ? mine : 1u; nx = cnt > 0u ? cnt : 1u;
}
__device__ __forceinline__ void xcd_barrier(const XcdBarrier& b) {
    asm volatile("s_waitcnt vmcnt(0)" ::: "memory");
    __syncthreads();
    if (threadIdx.x == 0) {
        unsigned* bar = b.bar;
        __builtin_amdgcn_s_waitcnt(0);
        unsigned nloc = b.st[0], nx = b.st[1];
        if (nloc == 0u) { xcd_barrier_complete(bar, b.x, nloc, nx); b.st[0] = nloc; b.st[1] = nx; }
        const unsigned old = xb_add(&bar[XB_XSUB(b.x)], 1u);
        const unsigned gen = old / nloc;
        if (old + 1u == (gen + 1u) * nloc) {
            __builtin_amdgcn_fence(__ATOMIC_RELEASE, "agent");
            asm volatile("s_waitcnt vmcnt(0)" ::: "memory");
            const unsigned og = xb_add(&bar[XB_TOP], 1u);
            const unsigned tg = og / nx;
            if (og + 1u == (tg + 1u) * nx) xb_add(&bar[XB_TOPGEN], 1u);
            else XB_SPIN(xb_ld(&bar[XB_TOPGEN]) == tg, bar);
            __builtin_amdgcn_fence(__ATOMIC_ACQUIRE, "agent");
            xb_add(&bar[XB_XGEN(b.x)], 1u);
            asm volatile("s_waitcnt vmcnt(0)" ::: "memory");
        } else {
            XB_SPIN(xb_ld(&bar[XB_XGEN(b.x)]) == gen, bar);
            __builtin_amdgcn_fence(__ATOMIC_ACQUIRE, "agent");
            asm volatile("s_waitcnt vmcnt(0)" ::: "memory");
        }
    }
    __syncthreads();
}

constexpr int LDS_BYTES = 147456, MISC_OFF = 147456 - 256;
constexpr int NPHASE = 8;
#ifndef ONE_LAUNCH
#define ONE_LAUNCH 1
#endif

struct KArgs { Params p; int ph_lo, ph_hi, probe, pad; };
__global__ void __launch_bounds__(512, 2) k_fwd(KArgs a) {
    extern __shared__ __attribute__((aligned(16))) unsigned char lds_raw[];
    LAS unsigned char* lds = (LAS unsigned char*)lds_raw;
    const Params& p = a.p;
    const int tid = threadIdx.x, lane = tid & 63, wave = __builtin_amdgcn_readfirstlane(tid >> 6);
    const int gw = blockIdx.x * 8 + wave, ngw = gridDim.x * 8;
    volatile LAS unsigned* misc = (volatile LAS unsigned*)(lds + MISC_OFF);
    if (tid < 64) misc[tid] = 0u;
    __syncthreads();
    XcdBarrier bar; bar.bar = WSP(unsigned, WS_CTL) + 4096; bar.x = 0; bar.st = misc;
    if (ONE_LAUNCH) bar = xcd_barrier_post(WSP(unsigned, WS_CTL) + 4096, misc);
#define IN(k) (a.ph_lo <= 0 && 0 < a.ph_hi)
#define SEAM(k) do { xcd_barrier(bar); } while (0)
#define RUNPH(k, ...) do { if (IN(k)) { constexpr int nrep_ = (PROBE_REP == (k)) ? 2 : 1; _Pragma("unroll") for (int rep = 0; rep < nrep_; ++rep) { if (rep) xcd_barrier(bar); __VA_ARGS__ } } } while (0)
    RUNPH(0, const int lane_ = opaque_tid() & 63; phase0(p, lds, gw, ngw, wave, lane_, 0, (gridDim.x == 256) ? p.jobs[13].item0 : p.nitems););
    SEAM(0);
    RUNPH(1,
        SchedInproj S{DM, (int)gridDim.x, (int)blockIdx.x, (const char*)WSP(bf16_t, WS_U), (const char*)WSP(bf16_t, WS_WIN)};
        EpiInproj E{WSP(bf16_t, WS_QA), WSP(bf16_t, WS_ZA), WSP(bf16_t, WS_IQ), WSP(bf16_t, WS_QB), WSP(bf16_t, WS_ZB), WSP(bf16_t, WS_GA), WSP(bf16_t, WS_GB), WSP(bf16_t, WS_KB), WSP(bf16_t, WS_VB),
                    WSP(float, WS_CKVRAW), WSP(bf16_t, WS_IK), WSP(float, WS_IW), 0.125f * LOG2E, p.ikn_w, p.ikn_b, 0.015625f};
        pg8::gemm_phase<EpiInproj, SchedInproj>(lds, S, E);
        { SchedGate S8{DM, (int)gridDim.x, (int)blockIdx.x, (const char*)WSP(unsigned char, WS_U8), (const char*)WSP(unsigned char, WS_W8)};
          EpiGate E8{WSP(bf16_t, WS_GA), WSP(bf16_t, WS_GB), WSP(bf16_t, WS_ZA), WSP(bf16_t, WS_ZB)};
          pg8::gemm_phase<EpiGate, SchedGate, true, true, true>(lds, S8, E8); }
        if (gridDim.x == 256 && blockIdx.x >= 202) { const int lane_ = opaque_tid() & 63; phase0(p, lds, ((int)blockIdx.x - 202) * 8 + wave, 54 * 8, wave, lane_, p.jobs[13].item0, p.nitems); });
    SEAM(1);
    RUNPH(33, const int lane_ = opaque_tid() & 63; phase_ckvnorm(p, gw, ngw, lane_););
    RUNPH(32, phase_qlat(p, lds););
    RUNPH(30, phase_diff(p, lds););
    RUNPH(31, phase_scores(p, lds););
    SEAM(3);
    RUNPH(4, const int lane_ = opaque_tid() & 63; phase_dsa(p, lds, wave, lane_, a.probe););
    SEAM(4);
    RUNPH(8, phase_oproj(p, lds););
    SEAM(8);
    RUNPH(5,
        SchedMix S{1024, (int)gridDim.x, (int)blockIdx.x, (const char*)WSP(bf16_t, WS_OZA), (const char*)WSP(bf16_t, WS_WOA), (const char*)WSP(bf16_t, WS_OZB), (const char*)WSP(bf16_t, WS_WOB)};
        EpiMix E{WSP(const bf16_t, WS_GA), WSP(const bf16_t, WS_GB), WSP(bf16_t, WS_MIX)};
        pg8::gemm_phase<EpiMix, SchedMix>(lds, S, E););
    SEAM(5);
    if (gridDim.x == 256) {
        RUNPH(6,
            SchedOut S{DM, (int)gridDim.x, (int)blockIdx.x, (const char*)WSP(bf16_t, WS_MIX), (const char*)WSP(bf16_t, WS_WOUT)};
            EpiOutFused E{p.x, p.post_w, p.out, WSP(float, WS_SSQ), WSP(unsigned, WS_CTL) + 8192, lds};
            pg8::gemm_phase<EpiOutFused, SchedOut>(lds, S, E););
    } else {
        RUNPH(6,
            SchedOut S{DM, (int)gridDim.x, (int)blockIdx.x, (const char*)WSP(bf16_t, WS_MIX), (const char*)WSP(bf16_t, WS_WOUT)};
            EpiOut E{WSP(bf16_t, WS_OUTPRE), WSP(float, WS_SSQ)};
            pg8::gemm_phase<EpiOut, SchedOut>(lds, S, E););
        SEAM(6);
        RUNPH(7, const int lane_ = opaque_tid() & 63; phase7(p, gw, ngw, lane_););
    }
#undef RUNPH
#undef IN
#undef SEAM
}

static void add_job(Params& p, const float* src, bf16_t* dst, int K, int N, int col0, int ncols, int row0, int fp8 = 0) {
    TJob& j = p.jobs[p.njobs++]; j.fp8 = fp8; j.pad_ = 0; j.src = src; j.dst = dst; j.K = K; j.N = N; j.col0 = col0; j.nblk = (ncols + 31) / 32; j.row0 = row0; j.item0 = p.nitems; p.nitems += (K / 64) * j.nblk;
}
extern "C" void kernel_launch(void* const* d_in, const int* in_sizes, int n_in, void* d_out, int out_size, void* d_ws, size_t ws_size, hipStream_t stream) {
    if (n_in != 16 || ws_size < WS_END) { fprintf(stderr, "kernel_launch: unexpected arguments (n_in %d, ws %zu)\n", n_in, ws_size); return; }
    static int grid = 0;
    if (!grid) {
        int dev = 0, cus = 0, per_cu = 0;
        (void)hipGetDevice(&dev); (void)hipDeviceGetAttribute(&cus, hipDeviceAttributeMultiprocessorCount, dev);
        (void)hipFuncSetAttribute((const void*)k_fwd, hipFuncAttributeMaxDynamicSharedMemorySize, LDS_BYTES);
        (void)hipOccupancyMaxActiveBlocksPerMultiprocessor(&per_cu, (const void*)k_fwd, 512, LDS_BYTES);
        (void)hipGetLastError();
        grid = cus > 0 ? cus : 256;
        if (per_cu < 1) fprintf(stderr, "kernel_launch: occupancy query reports %d blocks per CU\n", per_cu);
    }
    KArgs a; memset(&a, 0, sizeof(a));
    Params& p = a.p;
    const float** in = (const float**)d_in;
    p.x = in[0]; p.meta = in[1]; p.rel_bias = in[2]; p.pre_w = in[3]; p.w_in = in[4]; p.kv_norm_w = in[5]; p.w_uk = in[6]; p.w_uv = in[7]; p.ikn_w = in[8]; p.ikn_b = in[9];
    p.lam_p = in[10]; p.subln_w = in[11]; p.w_o_a = in[12]; p.w_o_b = in[13]; p.w_out = in[14]; p.post_w = in[15];
    p.out = (float*)d_out; p.ws = (unsigned char*)d_ws;
    bf16_t* WIN = (bf16_t*)(p.ws + WS_WIN);
    const int NIN = 11600;
    add_job(p, p.w_in, WIN, DM, NIN, 0, 1024, 0);
    add_job(p, p.w_in, (bf16_t*)(p.ws + WS_W8), DM, NIN, 1280, 1024, 4096, 1);
    add_job(p, p.w_in, WIN, DM, NIN, 2304, 1024, 2048);
    add_job(p, p.w_in, WIN, DM, NIN, 3408, 1024, 3072);
    add_job(p, p.w_in, (bf16_t*)(p.ws + WS_W8), DM, NIN, 6480, 1024, 5120, 1);
    add_job(p, p.w_in, (bf16_t*)(p.ws + WS_W8), DM, NIN, 7504, 2048, 0, 1);
    add_job(p, p.w_in, (bf16_t*)(p.ws + WS_W8), DM, NIN, 9552, 2048, 2048, 1);
    add_job(p, p.w_in, WIN, DM, NIN, 4432, 1024, 9216);
    add_job(p, p.w_in, WIN, DM, NIN, 5456, 1024, 10240);
    add_job(p, p.w_in, WIN, DM, NIN, 1024, 256, 11264);
    add_job(p, p.w_in, WIN, DM, NIN, 3328, 32, 11520);
    add_job(p, p.w_in, WIN, DM, NIN, 3392, 32, 11520 + 32);
    add_job(p, p.w_in, WIN, DM, NIN, 3360, 32, 11520 + 128);
    add_job(p, p.w_o_a, (bf16_t*)(p.ws + WS_WOA), 1024, DM, 0, DM, 0);
    add_job(p, p.w_o_b, (bf16_t*)(p.ws + WS_WOB), 1024, DM, 0, DM, 0);
    add_job(p, p.w_out, (bf16_t*)(p.ws + WS_WOUT), DM, DM, 0, DM, 0);
    add_job(p, p.w_uv, (bf16_t*)(p.ws + WS_WUVT), 256, 1024, 0, 1024, 0);
    (void)hipMemsetAsync((char*)d_ws + WS_CTL, 0, CTL_BYTES, stream);
#if ONE_LAUNCH
    a.ph_lo = 0; a.ph_hi = NPHASE; a.probe = PROBE_REP;
    hipLaunchKernelGGL(k_fwd, dim3(grid), dim3(512), LDS_BYTES, stream, a);
#else
    for (int ph = 0; ph < NPHASE; ++ph) { a.ph_lo = ph; a.ph_hi = ph + 1; hipLaunchKernelGGL(k_fwd, dim3(grid), dim3(512), LDS_BYTES, stream, a); }
#endif
}
```

```cpp
#include <hip/hip_runtime.h>
#include <cstdio>
#include <cstdint>
#include <cstring>

#ifndef PROBE_REP
#define PROBE_REP (-1)
#endif
#define LAS __attribute__((address_space(3)))
#define GAS __attribute__((address_space(1)))
typedef unsigned short bf16_t;
typedef short bf16x8 __attribute__((ext_vector_type(8)));
typedef float f32x4 __attribute__((ext_vector_type(4)));
typedef unsigned u32x4 __attribute__((ext_vector_type(4)));
typedef unsigned u32x2 __attribute__((ext_vector_type(2)));
typedef int v8i32 __attribute__((ext_vector_type(8)));
typedef int v4i32 __attribute__((ext_vector_type(4)));

constexpr int DM = 2048, NB = 2, SEQ = 4096, NMETA = 16, TK = SEQ + NMETA  , MTOK = NB * SEQ  , MKEY = NB * TK  ;
constexpr int UROWS = 8448;
constexpr int NPAD = 11776;
constexpr float EPS = 1e-6f;
constexpr float LOG2E = 1.4426950408889634f;
constexpr size_t SC_PER_B = 8585216;

constexpr size_t MiB = 1u << 20;
constexpr size_t WS_CTL = 0, CTL_BYTES = 1 * MiB;
constexpr size_t WS_U = 1 * MiB;
constexpr size_t WS_WIN = 34 * MiB;
constexpr size_t WS_SC = 1 * MiB;
constexpr size_t WS_MIX = 1 * MiB;
constexpr size_t WS_WOA = 80 * MiB, WS_WOB = 84 * MiB, WS_WOUT = 88 * MiB, WS_WUK = 96 * MiB, WS_WUVT = 96 * MiB + 512 * 1024;
constexpr size_t WS_QA = 97 * MiB, WS_IQ = 113 * MiB, WS_QB = 129 * MiB, WS_ZA = 145 * MiB, WS_ZB = 161 * MiB, WS_GA = 177 * MiB, WS_GB = 209 * MiB;
constexpr size_t WS_OLAT = 241 * MiB;
constexpr size_t WS_OZA = 129 * MiB;
constexpr size_t WS_KB = 241 * MiB, WS_VB = 258 * MiB, WS_CKVRAW = 275 * MiB, WS_IKRAW = 284 * MiB, WS_IW = 287 * MiB, WS_CKV = 288 * MiB, WS_IK = 293 * MiB;
constexpr size_t WS_QLAT = 295 * MiB;
constexpr size_t WS_OUTPRE = 295 * MiB;
constexpr size_t WS_OZB = 327 * MiB, WS_SSQ = 343 * MiB, WS_U8 = 344 * MiB, WS_END = 360 * MiB;
constexpr size_t WS_W8 = WS_WIN + (size_t)5120 * 2048 * 2;

__device__ __forceinline__ int opaque_tid() { int t = threadIdx.x; asm volatile("" : "+v"(t)); return t; }
__device__ __forceinline__ float bf2f(unsigned short u) { return __uint_as_float(((unsigned)u) << 16); }
__device__ __forceinline__ unsigned f2bf(float f) { unsigned u = __float_as_uint(f); return (u + 0x7fffu + ((u >> 16) & 1u)) >> 16; }
__device__ __forceinline__ unsigned pk2(float lo, float hi) { return f2bf(lo) | (f2bf(hi) << 16); }
__device__ __forceinline__ float bflo(unsigned w) { return __uint_as_float(w << 16); }
__device__ __forceinline__ float bfhi(unsigned w) { return __uint_as_float(w & 0xffff0000u); }
__device__ __forceinline__ float wave_sum(float v) {
#pragma unroll
    for (int o = 1; o < 64; o <<= 1) v += __shfl_xor(v, o);
    return v;
}
__device__ __forceinline__ float silu_f(float x) { return x * __builtin_amdgcn_rcpf(1.f + __expf(-x)); }
__device__ __forceinline__ int t5_bucket(int rel) {
    const int n = rel < 0 ? -rel : rel; int f;
    if (n < 8) f = n; else if (n < 12) f = 8; else if (n < 16) f = 9; else if (n < 23) f = 10; else if (n < 32) f = 11; else if (n < 46) f = 12; else if (n < 64) f = 13; else if (n < 91) f = 14; else f = 15;
    return (rel > 0 ? 16 : 0) + f;
}
__device__ __forceinline__ size_t sc_off(int b, int j) {
    const int c = 1 + (j >> 6);
    return (size_t)b * SC_PER_B + (size_t)1024 * (c - 1) + (size_t)2048 * (c - 1) * c + (size_t)(j & 63) * (16 + 64 * c);
}

namespace pg8 {
constexpr int BM = 256, BK = 64, HALF = 128, HTB = HALF * BK * 2, STAGE_BYTES = 8 * HTB, NXCD = 8, WGM = 8;
__host__ __device__ __forceinline__ int lds_byte(int r, int c) { const int st = (r >> 4) * 2 + (c >> 5), rr = r & 15, cc = c & 31, ob = rr * 64 + cc * 2; return st * 1024 + (ob ^ (((ob >> 9) & 1) << 5)); }
__host__ __device__ __forceinline__ void stage_rc(int b, int& R, int& C) { const int st = b / 1024, sb = b % 1024, swz = sb ^ (((sb >> 9) & 1) << 5); R = (st >> 1) * 16 + swz / 64; C = (st & 1) * 32 + (swz % 64) / 2; }
__host__ __device__ __forceinline__ int perm32(int rho) { const int n = rho >> 4, i = rho & 15; return 8 * (i >> 2) + 4 * n + (i & 3); }

struct Unit { int pm, pn, sub; };
__device__ __forceinline__ unsigned cvt_pk_bf16(float lo, float hi) { unsigned r; asm volatile("v_cvt_pk_bf16_f32 %0, %1, %2" : "=v"(r) : "v"(lo), "v"(hi)); return r; }

__device__ __forceinline__ void tile_of(int L, int nM, int nN, int& pm, int& pn) {
    const int nwg = nM * nN; int wgid = L; { const int q = nwg / NXCD, r = nwg % NXCD, xcd = wgid % NXCD, off = wgid / NXCD; wgid = (xcd < r ? xcd * (q + 1) : r * (q + 1) + (xcd - r) * q) + off; }
    const int nig = WGM * nN, gid = wgid / nig, fm = gid * WGM, gsz = (nM - fm) < WGM ? (nM - fm) : WGM;
    pm = fm + ((wgid % nig) % gsz); pn = (wgid % nig) / gsz;
}

template <class Epi, class Sched, bool ALIGN_EPI = true, bool SP2 = true, bool FP8 = false>
__device__ __forceinline__ void gemm_phase(LAS unsigned char* lds, const Sched& S, const Epi& E) {
    const int tid = opaque_tid(), wid = __builtin_amdgcn_readfirstlane(tid >> 6), lane = tid & 63, wr = wid >> 2, wc = wid & 3, fr = lane & 15, fq = lane >> 4;
    const int K = FP8 ? S.K / 2 : S.K, nt = K / BK;
    unsigned voffA[2], voffB[2];
#pragma unroll
    for (int i = 0; i < 2; ++i) { int R, C; stage_rc(tid * 16 + i * 8192, R, C); const int Rb = Epi::PERM ? ((R & ~31) + perm32(R & 31)) : R;
        voffA[i] = (unsigned)(R * K + C) * 2u; voffB[i] = (unsigned)(Rb * K + C) * 2u; }
    const size_t kstep = (size_t)(BK * 2);
    const size_t hstep = (size_t)HALF * K * 2;
    const unsigned ldsw = (unsigned)wid * 1024u, lds0 = (unsigned)(size_t)lds;
    const int aoff = lds_byte(wr * 64 + fr, fq * 8), boff = lds_byte(wc * 32 + fr, fq * 8);
#define PG8_SA(b, h) (((b) * 2 + (h)) * HTB)
#define PG8_SB(b, h) ((4 + (b) * 2 + (h)) * HTB)
#define PG8_STAGE(bufoff, gbase, voff) do { _Pragma("unroll") for (int _i = 0; _i < 2; ++_i) { \
        if constexpr (FP8) { unsigned keep_; asm volatile("s_mov_b32 %0, m0\n\ts_mov_b32 m0, %3\n\ts_nop 0\n\tglobal_load_lds_dwordx4 %1, %2\n\ts_mov_b32 m0, %0" \
                : "=&s"(keep_) : "v"((voff)[_i]), "s"((const char*)(gbase)), "s"(lds0 + (unsigned)(bufoff) + ldsw + (unsigned)(_i * 8192)) : "memory"); } \
        else __builtin_amdgcn_global_load_lds((const unsigned*)((const char*)(gbase) + (voff)[_i]), (LAS unsigned*)(lds + (bufoff) + ldsw + _i * 8192), 16, 0, 0); } } while (0)
#define PG8_LD8(dst, addr) do { const v4i32 lo_ = *(const LAS v4i32*)(addr), hi_ = *(const LAS v4i32*)((addr) + 1024); dst = __builtin_shufflevector(lo_, hi_, 0, 1, 2, 3, 4, 5, 6, 7); } while (0)
#define PG8_LDA(dst, b, h) do { if constexpr (FP8) { _Pragma("unroll") for (int m = 0; m < 4; ++m) PG8_LD8(dst##8[m], lds + PG8_SA(b, h) + aoff + m * 2048); } else { \
        _Pragma("unroll") for (int m = 0; m < 4; ++m) _Pragma("unroll") for (int k = 0; k < 2; ++k) dst[m][k] = *(const LAS bf16x8*)(lds + PG8_SA(b, h) + aoff + m * 2048 + k * 1024); } } while (0)
#define PG8_LDB(dst, b, h) do { if constexpr (FP8) { _Pragma("unroll") for (int n = 0; n < 2; ++n) PG8_LD8(dst##8[n], lds + PG8_SB(b, h) + boff + n * 2048); } else { \
        _Pragma("unroll") for (int n = 0; n < 2; ++n) _Pragma("unroll") for (int k = 0; k < 2; ++k) dst[n][k] = *(const LAS bf16x8*)(lds + PG8_SB(b, h) + boff + n * 2048 + k * 1024); } } while (0)
#define PG8_MMA(ai, bj, At, Bt) do { __builtin_amdgcn_s_setprio(1); _Pragma("unroll") for (int m = 0; m < 4; ++m) _Pragma("unroll") for (int n = 0; n < 2; ++n) _Pragma("unroll") for (int k = 0; k < 2; ++k) \
        acc[ai][bj][m][n] = __builtin_amdgcn_mfma_f32_16x16x32_bf16(Bt[n][k], At[m][k], acc[ai][bj][m][n], 0, 0, 0); __builtin_amdgcn_s_setprio(0); } while (0)
#define PG8_MMA8(ai, bj, At, Bt) do { __builtin_amdgcn_s_setprio(1); _Pragma("unroll") for (int m = 0; m < 4; ++m) _Pragma("unroll") for (int n = 0; n < 2; ++n) \
        acc[ai][bj][m][n] = __builtin_amdgcn_mfma_scale_f32_16x16x128_f8f6f4(Bt##8[n], At##8[m], acc[ai][bj][m][n], 0, 0, 0, 0x7f7f7f7f, 0, 0x7f7f7f7f); __builtin_amdgcn_s_setprio(0); } while (0)
#define PG8_MM(ai, bj, At, Bt) do { if constexpr (FP8) PG8_MMA8(ai, bj, At, Bt); else PG8_MMA(ai, bj, At, Bt); } while (0)
#define PG8_WAIT_V(n) asm volatile("s_waitcnt vmcnt(" #n ")" ::: "memory")
#define PG8_WAIT_L(n) asm volatile("s_waitcnt lgkmcnt(" #n ")" ::: "memory")
#define PG8_BAR __builtin_amdgcn_s_barrier()
#define PG8_SCHED __builtin_amdgcn_sched_barrier(0)
    Unit cur, nxt; int ui = 0;
    if (!S.next(0, cur)) return;
    f32x4 acc[2][2][4][2];
#pragma unroll
    for (int a = 0; a < 2; ++a)
#pragma unroll
        for (int b = 0; b < 2; ++b)
#pragma unroll
            for (int m = 0; m < 4; ++m)
#pragma unroll
                for (int n = 0; n < 2; ++n) acc[a][b][m][n] = (f32x4){0.f, 0.f, 0.f, 0.f};
    bf16x8 At[4][2], B0[2][2], B1[2][2];
    v8i32 At8[4], B08[2], B18[2];
    const char* cA = S.a_ptr(cur); const char* cB = S.b_ptr(cur);
    if constexpr (SP2) {
        PG8_STAGE(PG8_SB(0, 0), cB, voffB); PG8_STAGE(PG8_SB(0, 1), cB + hstep, voffB); PG8_STAGE(PG8_SA(0, 0), cA, voffA); PG8_STAGE(PG8_SA(0, 1), cA + hstep, voffA);
        if (wr == 1) PG8_BAR;
        PG8_WAIT_V(2); PG8_BAR;
        PG8_STAGE(PG8_SB(1, 0), cB + kstep, voffB); PG8_STAGE(PG8_SA(1, 0), cA + kstep, voffA); PG8_STAGE(PG8_SB(1, 1), cB + hstep + kstep, voffB);
        PG8_WAIT_V(6); PG8_BAR;
    } else {
        PG8_STAGE(PG8_SB(0, 0), cB, voffB); PG8_STAGE(PG8_SA(0, 0), cA, voffA); PG8_STAGE(PG8_SB(0, 1), cB + hstep, voffB); PG8_STAGE(PG8_SA(0, 1), cA + hstep, voffA);
        if (wr == 1) PG8_BAR;
        PG8_WAIT_V(4); PG8_BAR;
        PG8_STAGE(PG8_SB(1, 0), cB + kstep, voffB); PG8_STAGE(PG8_SA(1, 0), cA + kstep, voffA); PG8_STAGE(PG8_SB(1, 1), cB + hstep + kstep, voffB);
        PG8_WAIT_V(6); PG8_BAR;
    }
    for (;;) {
        const bool has_next = S.next(ui + 1, nxt);
        const char* nA = has_next ? S.a_ptr(nxt) : cA; const char* nB = has_next ? S.b_ptr(nxt) : cB;
        for (int t = 0; t < nt; t += 2) {
            const bool last = (t == nt - 2);
            const char* a1 = cA + (size_t)(t + 1) * kstep;
            const char* a2 = last ? nA : cA + (size_t)(t + 2) * kstep; const char* b2 = last ? nB : cB + (size_t)(t + 2) * kstep;
            const char* a3 = a2 + kstep; const char* b3 = b2 + kstep;
            if constexpr (SP2) {
            PG8_LDB(B0, 0, 0); PG8_LDB(B1, 0, 1); PG8_SCHED; PG8_LDA(At, 0, 0); PG8_STAGE(PG8_SA(1, 1), a1 + hstep, voffA);
            PG8_WAIT_V(8); PG8_WAIT_L(0); PG8_BAR; PG8_MM(0, 0, At, B0); PG8_MM(0, 1, At, B1); PG8_BAR; PG8_SCHED;
            PG8_LDA(At, 0, 1); PG8_STAGE(PG8_SB(0, 0), b2, voffB); PG8_STAGE(PG8_SB(0, 1), b2 + hstep, voffB); PG8_STAGE(PG8_SA(0, 0), a2, voffA);
            PG8_WAIT_V(8); PG8_WAIT_L(0); PG8_BAR; PG8_MM(1, 0, At, B0); PG8_MM(1, 1, At, B1); PG8_BAR; PG8_SCHED;
            PG8_LDB(B0, 1, 0); PG8_LDB(B1, 1, 1); PG8_SCHED; PG8_LDA(At, 1, 0); PG8_STAGE(PG8_SA(0, 1), a2 + hstep, voffA);
            PG8_WAIT_V(8); PG8_WAIT_L(0); PG8_BAR; PG8_MM(0, 0, At, B0); PG8_MM(0, 1, At, B1); PG8_BAR; PG8_SCHED;
            PG8_LDA(At, 1, 1); PG8_STAGE(PG8_SB(1, 0), b3, voffB); PG8_STAGE(PG8_SB(1, 1), b3 + hstep, voffB); PG8_STAGE(PG8_SA(1, 0), a3, voffA);
            PG8_WAIT_V(8); PG8_WAIT_L(0); PG8_BAR; PG8_MM(1, 0, At, B0); PG8_MM(1, 1, At, B1); PG8_BAR; PG8_SCHED;
            } else {
            PG8_LDB(B0, 0, 0); PG8_SCHED; PG8_LDA(At, 0, 0); PG8_STAGE(PG8_SA(1, 1), a1 + hstep, voffA);
            PG8_WAIT_L(8); PG8_BAR; PG8_WAIT_L(0); PG8_MM(0, 0, At, B0); PG8_BAR; PG8_SCHED;
            PG8_LDB(B1, 0, 1); PG8_STAGE(PG8_SB(0, 0), b2, voffB);
            PG8_BAR; PG8_WAIT_L(0); PG8_MM(0, 1, At, B1); PG8_BAR;
            PG8_LDA(At, 0, 1); PG8_STAGE(PG8_SA(0, 0), a2, voffA);
            PG8_BAR; PG8_WAIT_L(0); PG8_MM(1, 0, At, B0); PG8_BAR; PG8_SCHED;
            PG8_STAGE(PG8_SB(0, 1), b2 + hstep, voffB);
            PG8_WAIT_V(6); PG8_BAR; PG8_MM(1, 1, At, B1); PG8_BAR;
            PG8_LDB(B0, 1, 0); PG8_SCHED; PG8_LDA(At, 1, 0); PG8_STAGE(PG8_SA(0, 1), a2 + hstep, voffA);
            PG8_WAIT_L(8); PG8_BAR; PG8_WAIT_L(0); PG8_MM(0, 0, At, B0); PG8_BAR; PG8_SCHED;
            PG8_LDB(B1, 1, 1); PG8_STAGE(PG8_SB(1, 0), b3, voffB);
            PG8_BAR; PG8_WAIT_L(0); PG8_MM(0, 1, At, B1); PG8_BAR;
            PG8_LDA(At, 1, 1); PG8_STAGE(PG8_SA(1, 0), a3, voffA);
            PG8_BAR; PG8_WAIT_L(0); PG8_MM(1, 0, At, B0); PG8_BAR; PG8_SCHED;
            PG8_STAGE(PG8_SB(1, 1), b3 + hstep, voffB);
            PG8_WAIT_V(6); PG8_BAR; PG8_MM(1, 1, At, B1); PG8_BAR;
            }
        }
        if constexpr (ALIGN_EPI) { if (wr == 0) PG8_BAR; }
        E(acc, cur, wr, wc, fr, fq);
        if (!has_next) break;
        if (!E.keep_acc(cur)) {
#pragma unroll
        for (int a = 0; a < 2; ++a)
#pragma unroll
            for (int b = 0; b < 2; ++b)
#pragma unroll
                for (int m = 0; m < 4; ++m)
#pragma unroll
                    for (int n = 0; n < 2; ++n) acc[a][b][m][n] = (f32x4){0.f, 0.f, 0.f, 0.f};
        }
        cur = nxt; cA = nA; cB = nB; ++ui;
        if constexpr (ALIGN_EPI) { if (wr == 1) PG8_BAR; }
    }
    PG8_WAIT_V(0);
    if constexpr (!ALIGN_EPI) { if (wr == 0) PG8_BAR; }
    PG8_BAR;
#undef PG8_SA
#undef PG8_SB
#undef PG8_STAGE
#undef PG8_LDA
#undef PG8_LDB
#undef PG8_MMA
#undef PG8_MMA8
#undef PG8_LD8
#undef PG8_MM
#undef PG8_WAIT_V
#undef PG8_WAIT_L
#undef PG8_BAR
#undef PG8_SCHED
}
}

struct SchedInproj {
    int K, G, c; const char* A; const char* B;
    __device__ __forceinline__ bool next(int i, pg8::Unit& u) const {
        const int L = i * G + c; u.sub = 0;
        if (L < 704) { int pn; pg8::tile_of(L, 32, 22, u.pm, pn); u.pn = pn < 4 ? pn : pn < 12 ? pn + 4 : pn + 24; return true; }
        if (L < 714) { u.pm = 32; u.pn = 36 + (L - 704); return true; }
        return false;
    }
    __device__ __forceinline__ const char* a_ptr(const pg8::Unit& u) const { return A + (size_t)u.pm * 256 * K * 2; }
    __device__ __forceinline__ const char* b_ptr(const pg8::Unit& u) const { return B + (size_t)u.pn * 256 * K * 2; }
};
struct SchedGate {
    int K, G, c; const char* A; const char* B;
    __device__ __forceinline__ bool next(int i, pg8::Unit& u) const {
        const int L = i * G + c; if (L >= 768) return false;
        int pn; pg8::tile_of(L, 32, 24, u.pm, pn); u.sub = pn; u.pn = pn < 16 ? 20 + pn : pn < 20 ? pn - 12 : pn - 4; return true;
    }
    __device__ __forceinline__ const char* a_ptr(const pg8::Unit& u) const { return A + (size_t)u.pm * 256 * K; }
    __device__ __forceinline__ const char* b_ptr(const pg8::Unit& u) const { return B + (size_t)u.sub * 256 * K; }
};
struct EpiInproj {
    static constexpr bool PERM = true;
    bf16_t *QA, *ZA, *IQ, *QB, *ZB, *GA, *GB, *KB, *VB; float *CKVRAW; bf16_t* IKN; float* IW; float qb_scale; const float *ikn_w, *ikn_b; float gscale;
    __device__ __forceinline__ bool keep_acc(const pg8::Unit&) const { return false; }
    __device__ __forceinline__ void operator()(f32x4 (&acc)[2][2][4][2], const pg8::Unit& u, int wr, int wc, int fr, int fq) const {
        const int pn = u.pn;
        if (pn < 44) {
            bf16_t* base; int ldc = 1024, ct, act = 0; bool kside = false;
            if (pn < 4) { base = QA; ct = pn; } else if (pn < 8) { base = ZA; ct = pn - 4; act = 1; } else if (pn < 12) { base = IQ; ct = pn - 8; }
            else if (pn < 16) { base = QB; ct = pn - 12; act = 2; } else if (pn < 20) { base = ZB; ct = pn - 16; act = 1; }
            else if (pn < 28) { base = GA; ct = pn - 20; ldc = 2048; act = 3; } else if (pn < 36) { base = GB; ct = pn - 28; ldc = 2048; act = 3; }
            else if (pn < 40) { base = KB; ct = pn - 36; kside = true; } else { base = VB; ct = pn - 40; kside = true; }
            const float sc = (act == 2) ? qb_scale : (act == 3) ? gscale : 1.f;
#pragma unroll
            for (int ai = 0; ai < 2; ++ai)
#pragma unroll
                for (int m = 0; m < 4; ++m) {
                    const int r = u.pm * 256 + ai * 128 + wr * 64 + m * 16 + fr;
                    long drow = r, drow2 = -1; bool ok = true;
                    if (kside) { if (r < MTOK) drow = (long)(r >> 12) * TK + NMETA + (r & 4095); else { const int i = r - MTOK; ok = i < NMETA; drow = i; drow2 = TK + i; } }
#pragma unroll
                    for (int bj = 0; bj < 2; ++bj) {
                        f32x4 v0 = acc[ai][bj][m][0], v1 = acc[ai][bj][m][1];
                        if (act == 1) {
#pragma unroll
                            for (int e = 0; e < 4; ++e) { v0[e] = silu_f(v0[e]); v1[e] = silu_f(v1[e]); }
                        }
                        v0 = v0 * sc; v1 = v1 * sc;
                        u32x4 w; w.x = pg8::cvt_pk_bf16(v0[0], v0[1]); w.y = pg8::cvt_pk_bf16(v0[2], v0[3]); w.z = pg8::cvt_pk_bf16(v1[0], v1[1]); w.w = pg8::cvt_pk_bf16(v1[2], v1[3]);
                        const int col = ct * 256 + bj * 128 + wc * 32 + 8 * fq;
                        if (ok) { *(u32x4*)(base + (size_t)drow * ldc + col) = w; if (drow2 >= 0) *(u32x4*)(base + (size_t)drow2 * ldc + col) = w; }
                    }
                }
        } else {
#pragma unroll
            for (int ai = 0; ai < 2; ++ai)
#pragma unroll
                for (int m = 0; m < 4; ++m) {
                    const int r = u.pm * 256 + ai * 128 + wr * 64 + m * 16 + fr;
                    long drow, drow2 = -1; bool ok = true;
                    if (r < MTOK) drow = (long)(r >> 12) * TK + NMETA + (r & 4095); else { const int i = r - MTOK; ok = i < NMETA; drow = i; drow2 = TK + i; }
                    if (pn == 44) {
#pragma unroll
                        for (int bj = 0; bj < 2; ++bj) {
                            const f32x4 v0 = acc[ai][bj][m][0], v1 = acc[ai][bj][m][1];
                            const int col = bj * 128 + wc * 32 + 8 * fq;
                            if (ok) { float* p = CKVRAW + (size_t)drow * 256 + col; *(f32x4*)p = v0; *(f32x4*)(p + 4) = v1;
                                      if (drow2 >= 0) { float* p2 = CKVRAW + (size_t)drow2 * 256 + col; *(f32x4*)p2 = v0; *(f32x4*)(p2 + 4) = v1; } }
                        }
                    } else if (wc == 0) {
                        const f32x4 a0 = acc[ai][0][m][0], a1 = acc[ai][0][m][1], b0 = acc[ai][1][m][0], b1 = acc[ai][1][m][1];
                        float s = ((a0[0] + a0[1]) + (a0[2] + a0[3])) + ((a1[0] + a1[1]) + (a1[2] + a1[3])) + ((b0[0] + b0[1]) + (b0[2] + b0[3])) + ((b1[0] + b1[1]) + (b1[2] + b1[3]));
                        s += __shfl_xor(s, 16); s += __shfl_xor(s, 32);
                        const float mu = s * (1.f / 64.f);
                        const f32x4 da0 = a0 - mu, da1 = a1 - mu, db0 = b0 - mu, db1 = b1 - mu;
                        float q = ((da0[0] * da0[0] + da0[1] * da0[1]) + (da0[2] * da0[2] + da0[3] * da0[3])) + ((da1[0] * da1[0] + da1[1] * da1[1]) + (da1[2] * da1[2] + da1[3] * da1[3]))
                                + ((db0[0] * db0[0] + db0[1] * db0[1]) + (db0[2] * db0[2] + db0[3] * db0[3])) + ((db1[0] * db1[0] + db1[1] * db1[1]) + (db1[2] * db1[2] + db1[3] * db1[3]));
                        q += __shfl_xor(q, 16); q += __shfl_xor(q, 32);
                        const float rs = rsqrtf(q * (1.f / 64.f) + EPS);
                        const f32x4 wa0 = *(const f32x4*)(ikn_w + 8 * fq), wa1 = *(const f32x4*)(ikn_w + 8 * fq + 4), wb0 = *(const f32x4*)(ikn_w + 32 + 8 * fq), wb1 = *(const f32x4*)(ikn_w + 36 + 8 * fq);
                        const f32x4 ba0 = *(const f32x4*)(ikn_b + 8 * fq), ba1 = *(const f32x4*)(ikn_b + 8 * fq + 4), bb0 = *(const f32x4*)(ikn_b + 32 + 8 * fq), bb1 = *(const f32x4*)(ikn_b + 36 + 8 * fq);
                        const f32x4 ya0 = da0 * rs * wa0 + ba0, ya1 = da1 * rs * wa1 + ba1, yb0 = db0 * rs * wb0 + bb0, yb1 = db1 * rs * wb1 + bb1;
                        u32x4 pa, pb;
                        pa.x = pg8::cvt_pk_bf16(ya0[0], ya0[1]); pa.y = pg8::cvt_pk_bf16(ya0[2], ya0[3]); pa.z = pg8::cvt_pk_bf16(ya1[0], ya1[1]); pa.w = pg8::cvt_pk_bf16(ya1[2], ya1[3]);
                        pb.x = pg8::cvt_pk_bf16(yb0[0], yb0[1]); pb.y = pg8::cvt_pk_bf16(yb0[2], yb0[3]); pb.z = pg8::cvt_pk_bf16(yb1[0], yb1[1]); pb.w = pg8::cvt_pk_bf16(yb1[2], yb1[3]);
                        if (ok) { *(u32x4*)(IKN + (size_t)drow * 64 + 8 * fq) = pa; *(u32x4*)(IKN + (size_t)drow * 64 + 32 + 8 * fq) = pb;
                                  if (drow2 >= 0) { *(u32x4*)(IKN + (size_t)drow2 * 64 + 8 * fq) = pa; *(u32x4*)(IKN + (size_t)drow2 * 64 + 32 + 8 * fq) = pb; } }
                    } else if (wc == 1) {
                        const f32x4 v0 = acc[ai][0][m][0], v1 = acc[ai][0][m][1];
                        if (fq < 2 && r < MTOK) { float* p = IW + (size_t)r * 16 + 8 * fq; *(f32x4*)p = v0 * 0.03125f; *(f32x4*)(p + 4) = v1 * 0.03125f; }
                    }
                }
        }
    }
};
struct EpiGate {
    static constexpr bool PERM = true;
    bf16_t *GA, *GB, *ZA, *ZB;
    __device__ __forceinline__ bool keep_acc(const pg8::Unit&) const { return false; }
    __device__ __forceinline__ void operator()(f32x4 (&acc)[2][2][4][2], const pg8::Unit& u, int wr, int wc, int fr, int fq) const {
        const int pn = u.pn; const bool zt = pn < 20; const int ldc = zt ? 1024 : DM;
        bf16_t* base = (pn < 8 ? ZA + (pn - 4) * 256 : pn < 20 ? ZB + (pn - 16) * 256 : pn < 28 ? GA + (pn - 20) * 256 : GB + (pn - 28) * 256) + (size_t)(u.pm * 256 + wr * 64 + fr) * ldc + wc * 32 + 8 * fq;
#pragma unroll
        for (int ai = 0; ai < 2; ++ai)
#pragma unroll
            for (int m = 0; m < 4; ++m)
#pragma unroll
                for (int bj = 0; bj < 2; ++bj) {
                    f32x4 v0 = acc[ai][bj][m][0] * 0.015625f, v1 = acc[ai][bj][m][1] * 0.015625f;
                    if (zt) {
#pragma unroll
                        for (int e = 0; e < 4; ++e) { v0[e] = silu_f(v0[e]); v1[e] = silu_f(v1[e]); }
                    }
                    u32x4 w; w.x = pg8::cvt_pk_bf16(v0[0], v0[1]); w.y = pg8::cvt_pk_bf16(v0[2], v0[3]); w.z = pg8::cvt_pk_bf16(v1[0], v1[1]); w.w = pg8::cvt_pk_bf16(v1[2], v1[3]);
                    *(u32x4*)(base + (size_t)(ai * 128 + m * 16) * ldc + bj * 128) = w;
                }
    }
};
struct SchedMix {
    int K, G, c; const char *A0, *B0, *A1, *B1;
    __device__ __forceinline__ bool next(int i, pg8::Unit& u) const {
        const int L = (i >> 1) * G + c; if (L >= 256) return false;
        pg8::tile_of(L, 32, 8, u.pm, u.pn); u.sub = i & 1; return true;
    }
    __device__ __forceinline__ const char* a_ptr(const pg8::Unit& u) const { return (u.sub ? A1 : A0) + (size_t)u.pm * 256 * K * 2; }
    __device__ __forceinline__ const char* b_ptr(const pg8::Unit& u) const { return (u.sub ? B1 : B0) + (size_t)u.pn * 256 * K * 2; }
};
struct EpiMix {
    static constexpr bool PERM = true;
    const bf16_t *GA, *GB; bf16_t* MIX;
    __device__ __forceinline__ bool keep_acc(const pg8::Unit& u) const { return u.sub == 0; }
    static __device__ __forceinline__ float sg_e(float a) { return __expf(-fminf(fmaxf(a, -30.f), 30.f)); }
    __device__ __forceinline__ void operator()(f32x4 (&acc)[2][2][4][2], const pg8::Unit& u, int wr, int wc, int fr, int fq) const {
        const size_t base = (size_t)(u.pm * 256 + wr * 64 + fr) * DM + u.pn * 256 + wc * 32 + 8 * fq;
        if (u.sub == 0) {
#pragma unroll
            for (int ai = 0; ai < 2; ++ai) {
                u32x4 ga[4][2], gb[4][2];
#pragma unroll
                for (int m = 0; m < 4; ++m)
#pragma unroll
                    for (int bj = 0; bj < 2; ++bj) { const size_t o = base + (size_t)(ai * 128 + m * 16) * DM + bj * 128; ga[m][bj] = *(const u32x4*)(GA + o); gb[m][bj] = *(const u32x4*)(GB + o); }
#pragma unroll
                for (int m = 0; m < 4; ++m)
#pragma unroll
                    for (int bj = 0; bj < 2; ++bj)
#pragma unroll
                        for (int e = 0; e < 4; ++e) {
                            const unsigned wa = ga[m][bj][e], wb = gb[m][bj][e];
                            const float f0 = (1.f + sg_e(bflo(wb))) * __builtin_amdgcn_rcpf(1.f + sg_e(bflo(wa))), f1 = (1.f + sg_e(bfhi(wb))) * __builtin_amdgcn_rcpf(1.f + sg_e(bfhi(wa)));
                            const int n = e >> 1, j = (e & 1) * 2;
                            acc[ai][bj][m][n][j] *= f0; acc[ai][bj][m][n][j + 1] *= f1;
                        }
            }
        } else {
            u32x4 gb[2][4][2];
#pragma unroll
            for (int m = 0; m < 4; ++m)
#pragma unroll
                for (int bj = 0; bj < 2; ++bj) gb[0][m][bj] = *(const u32x4*)(GB + base + (size_t)(m * 16) * DM + bj * 128);
#pragma unroll
            for (int ai = 0; ai < 2; ++ai) {
                if (ai == 0) {
#pragma unroll
                    for (int m = 0; m < 4; ++m)
#pragma unroll
                        for (int bj = 0; bj < 2; ++bj) gb[1][m][bj] = *(const u32x4*)(GB + base + (size_t)(128 + m * 16) * DM + bj * 128);
                }
#pragma unroll
                for (int m = 0; m < 4; ++m)
#pragma unroll
                    for (int bj = 0; bj < 2; ++bj) {
                        float v[8];
#pragma unroll
                        for (int e = 0; e < 4; ++e) {
                            const unsigned wb = gb[ai][m][bj][e]; const int n = e >> 1, j = (e & 1) * 2;
                            v[2 * e] = acc[ai][bj][m][n][j] * __builtin_amdgcn_rcpf(1.f + sg_e(bflo(wb))); v[2 * e + 1] = acc[ai][bj][m][n][j + 1] * __builtin_amdgcn_rcpf(1.f + sg_e(bfhi(wb)));
                        }
                        u32x4 w; w.x = pg8::cvt_pk_bf16(v[0], v[1]); w.y = pg8::cvt_pk_bf16(v[2], v[3]); w.z = pg8::cvt_pk_bf16(v[4], v[5]); w.w = pg8::cvt_pk_bf16(v[6], v[7]);
                        *(u32x4*)(MIX + base + (size_t)(ai * 128 + m * 16) * DM + bj * 128) = w;
                    }
            }
        }
    }
};
struct SchedOut {
    int K, G, c; const char *A, *B;
    __device__ __forceinline__ bool next(int i, pg8::Unit& u) const { const int L = i * G + c; if (L >= 256) return false; pg8::tile_of(L, 32, 8, u.pm, u.pn); u.sub = 0; return true; }
    __device__ __forceinline__ const char* a_ptr(const pg8::Unit& u) const { return A + (size_t)u.pm * 256 * K * 2; }
    __device__ __forceinline__ const char* b_ptr(const pg8::Unit& u) const { return B + (size_t)u.pn * 256 * K * 2; }
};
struct EpiOut {
    static constexpr bool PERM = true;
    bf16_t* OUTPRE; float* SSQ;
    __device__ __forceinline__ bool keep_acc(const pg8::Unit&) const { return false; }
    __device__ __forceinline__ void operator()(f32x4 (&acc)[2][2][4][2], const pg8::Unit& u, int wr, int wc, int fr, int fq) const {
#pragma unroll
        for (int ai = 0; ai < 2; ++ai)
#pragma unroll
            for (int m = 0; m < 4; ++m) {
                const int r = u.pm * 256 + ai * 128 + wr * 64 + m * 16 + fr; float ss = 0.f;
#pragma unroll
                for (int bj = 0; bj < 2; ++bj) {
                    const f32x4 v0 = acc[ai][bj][m][0], v1 = acc[ai][bj][m][1];
                    ss += (v0[0] * v0[0] + v0[1] * v0[1]) + (v0[2] * v0[2] + v0[3] * v0[3]) + (v1[0] * v1[0] + v1[1] * v1[1]) + (v1[2] * v1[2] + v1[3] * v1[3]);
                    u32x4 w; w.x = pg8::cvt_pk_bf16(v0[0], v0[1]); w.y = pg8::cvt_pk_bf16(v0[2], v0[3]); w.z = pg8::cvt_pk_bf16(v1[0], v1[1]); w.w = pg8::cvt_pk_bf16(v1[2], v1[3]);
                    *(u32x4*)(OUTPRE + (size_t)r * DM + u.pn * 256 + bj * 128 + wc * 32 + 8 * fq) = w;
                }
                ss += __shfl_xor(ss, 16); ss += __shfl_xor(ss, 32);
                if (fq == 0) SSQ[(size_t)r * 32 + u.pn * 4 + wc] = ss;
            }
    }
};

struct EpiOutFused {
    static constexpr bool PERM = false;
    const float* x; const float* post_w; float* out; float* SSQ; unsigned* cnt; LAS unsigned char* lds;
    __device__ __forceinline__ bool keep_acc(const pg8::Unit&) const { return false; }
    __device__ __forceinline__ void operator()(f32x4 (&acc)[2][2][4][2], const pg8::Unit& u, int wr, int wc, int fr, int fq) const {
        const int tid = opaque_tid(), wid = __builtin_amdgcn_readfirstlane(tid >> 6), lane = tid & 63;
        LAS float* S = (LAS float*)(lds + 131072);
#pragma unroll
        for (int ai = 0; ai < 2; ++ai)
#pragma unroll
            for (int m = 0; m < 4; ++m) {
                float ss = 0.f;
#pragma unroll
                for (int bj = 0; bj < 2; ++bj)
#pragma unroll
                    for (int n = 0; n < 2; ++n) { const f32x4 v = acc[ai][bj][m][n]; ss += (v[0] * v[0] + v[1] * v[1]) + (v[2] * v[2] + v[3] * v[3]); }
                ss += __shfl_xor(ss, 16); ss += __shfl_xor(ss, 32);
                if (fq == 0) __hip_atomic_store(SSQ + (size_t)(u.pm * 256 + ai * 128 + wr * 64 + m * 16 + fr) * 32 + u.pn * 4 + wc, ss, __ATOMIC_RELAXED, __HIP_MEMORY_SCOPE_AGENT);
            }
        asm volatile("s_waitcnt vmcnt(0)" ::: "memory");
        if (lane == 0) __hip_atomic_fetch_add(cnt + 64 * u.pm, 1u, __ATOMIC_RELAXED, __HIP_MEMORY_SCOPE_AGENT);
        if (wid == 0) {
            for (unsigned it = 0; it < (1u << 22); ++it) {
                if ((unsigned)__builtin_amdgcn_readfirstlane(__hip_atomic_load(cnt + 64 * u.pm, __ATOMIC_RELAXED, __HIP_MEMORY_SCOPE_AGENT)) >= 64u) break;
                __builtin_amdgcn_s_sleep(2);
            }
            __builtin_amdgcn_fence(__ATOMIC_ACQUIRE, "agent");
        }
        asm volatile("s_waitcnt vmcnt(0) lgkmcnt(0)" ::: "memory"); __builtin_amdgcn_s_barrier(); asm volatile("" ::: "memory");
        if (tid < 256) {
            const unsigned long long* slot = (const unsigned long long*)(SSQ + (size_t)(u.pm * 256 + tid) * 32); float s = 0.f;
#pragma unroll
            for (int t = 0; t < 16; ++t) { const unsigned long long w = __hip_atomic_load(slot + t, __ATOMIC_RELAXED, __HIP_MEMORY_SCOPE_AGENT); s += __uint_as_float((unsigned)w) + __uint_as_float((unsigned)(w >> 32)); }
            S[tid] = rsqrtf(s * (1.f / DM) + EPS);
        }
        asm volatile("s_waitcnt lgkmcnt(0)" ::: "memory"); __builtin_amdgcn_s_barrier(); asm volatile("" ::: "memory");
        const f32x4 g = *(const f32x4*)(post_w + u.pn * 256 + 4 * lane);
        const int lr0 = 4 * wid;
        const size_t gbase = (size_t)(u.pm * 256 + (lr0 >> 4) * 64 + (lr0 & 15)) * DM + u.pn * 256 + 4 * lane;
        const unsigned woff = (unsigned)((wr * 16 + fr) * 1040 + (wc * 32 + 4 * fq) * 4), roff = (unsigned)(lr0 * 1040 + lane * 16);
        f32x4 xv[4], xn[4];
#pragma unroll
        for (int q = 0; q < 4; ++q) xv[q] = __builtin_nontemporal_load((const f32x4*)(x + gbase + (size_t)q * DM));
#pragma unroll
        for (int s = 0; s < 8; ++s) {
            const int ai = s >> 2, m = s & 3; LAS unsigned char* T = lds + (s & 1) * 33280;
            const float rs = S[ai * 128 + wr * 64 + m * 16 + fr];
#pragma unroll
            for (int bj = 0; bj < 2; ++bj)
#pragma unroll
                for (int n = 0; n < 2; ++n) *(LAS f32x4*)(T + woff + bj * 512 + n * 64) = acc[ai][bj][m][n] * rs;
            if (s < 7) {
                const size_t o2 = (size_t)(((s + 1) >> 2) * 128 + ((s + 1) & 3) * 16) * DM;
#pragma unroll
                for (int q = 0; q < 4; ++q) xn[q] = __builtin_nontemporal_load((const f32x4*)(x + gbase + o2 + (size_t)q * DM));
            }
            asm volatile("s_waitcnt lgkmcnt(0)" ::: "memory"); __builtin_amdgcn_s_barrier(); asm volatile("" ::: "memory");
            const size_t o1 = (size_t)(ai * 128 + m * 16) * DM;
#pragma unroll
            for (int q = 0; q < 4; ++q) { const f32x4 v = *(const LAS f32x4*)(T + roff + q * 1040); __builtin_nontemporal_store(xv[q] + v * g, (f32x4*)(out + gbase + o1 + (size_t)q * DM)); }
#pragma unroll
            for (int q = 0; q < 4; ++q) xv[q] = xn[q];
        }
    }
};

struct TJob { const float* src; bf16_t* dst; int K, N, col0, nblk, row0, item0, fp8, pad_; };
struct Params {
    const float *x, *meta, *rel_bias, *pre_w, *w_in, *kv_norm_w, *w_uk, *w_uv, *ikn_w, *ikn_b, *lam_p, *subln_w, *w_o_a, *w_o_b, *w_out, *post_w;
    float* out; unsigned char* ws;
    TJob jobs[17]; int njobs, nitems;
};
#define WSP(T, off) ((T*)(p.ws + (off)))

__device__ __forceinline__ void p0_transpose_item(const TJob& jb, LAS float* scr, int item, int lane) {
    const int kb = item / jb.nblk, nb = item % jb.nblk, k0 = 64 * kb, n0 = jb.col0 + 32 * nb;
#pragma unroll 8
    for (int i = 0; i < 32; ++i) { const int kk = 2 * i + (lane >> 5); scr[kk * 33 + (lane & 31)] = __builtin_nontemporal_load(jb.src + (size_t)(k0 + kk) * jb.N + n0 + (lane & 31)); }
    asm volatile("s_waitcnt lgkmcnt(0)" ::: "memory");
    const int c = lane & 7;
#pragma unroll
    for (int j = 0; j < 4; ++j) { const int n = (lane >> 3) + 8 * j; const LAS float* s = scr + (8 * c) * 33 + n;
        u32x4 o; o.x = pk2(s[0 * 33], s[1 * 33]); o.y = pk2(s[2 * 33], s[3 * 33]); o.z = pk2(s[4 * 33], s[5 * 33]); o.w = pk2(s[6 * 33], s[7 * 33]);
        if (!jb.fp8) *(u32x4*)(jb.dst + (size_t)(jb.row0 + 32 * nb + n) * jb.K + k0 + 8 * c) = o;
        else { int w0 = __builtin_amdgcn_cvt_pk_fp8_f32(s[0 * 33] * 64.f, s[1 * 33] * 64.f, 0, false); w0 = __builtin_amdgcn_cvt_pk_fp8_f32(s[2 * 33] * 64.f, s[3 * 33] * 64.f, w0, true);
               int w1 = __builtin_amdgcn_cvt_pk_fp8_f32(s[4 * 33] * 64.f, s[5 * 33] * 64.f, 0, false); w1 = __builtin_amdgcn_cvt_pk_fp8_f32(s[6 * 33] * 64.f, s[7 * 33] * 64.f, w1, true);
               u32x2 o8; o8.x = (unsigned)w0; o8.y = (unsigned)w1; *(u32x2*)((unsigned char*)jb.dst + (size_t)(jb.row0 + 32 * nb + n) * jb.K + k0 + 8 * c) = o8; } }
    asm volatile("s_waitcnt lgkmcnt(0)" ::: "memory");
}
__device__ __forceinline__ void p0_norm_row(const float* xrow, const float* g, bf16_t* orow, unsigned char* o8row, int lane) {
    const f32x4* xr = (const f32x4*)xrow + lane; const f32x4* gr = (const f32x4*)g + lane;
    f32x4 v[8]; float s = 0.f;
#pragma unroll
    for (int j = 0; j < 8; ++j) { v[j] = __builtin_nontemporal_load(xr + 64 * j); s += (v[j].x * v[j].x + v[j].y * v[j].y) + (v[j].z * v[j].z + v[j].w * v[j].w); }
    const float rstd = rsqrtf(wave_sum(s) * (1.f / DM) + EPS);
    u32x2* o8 = (u32x2*)orow + lane;
#pragma unroll
    for (int j = 0; j < 8; ++j) { const f32x4 gg = gr[64 * j]; const float y0 = v[j].x * rstd * gg.x, y1 = v[j].y * rstd * gg.y, y2 = v[j].z * rstd * gg.z, y3 = v[j].w * rstd * gg.w;
        u32x2 w; w.x = pk2(y0, y1); w.y = pk2(y2, y3); o8[64 * j] = w;
        if (o8row) { int q = __builtin_amdgcn_cvt_pk_fp8_f32(y0, y1, 0, false); q = __builtin_amdgcn_cvt_pk_fp8_f32(y2, y3, q, true); ((unsigned*)o8row)[64 * j + lane] = (unsigned)q; } }
}
__device__ __forceinline__ void phase0(const Params& p, LAS unsigned char* lds, int gw, int ngw, int wave, int lane, int item_lo, int item_hi) {
    LAS float* scr = (LAS float*)(lds + wave * 16384);
    for (int it = gw + item_lo; it < item_hi; it += ngw) {
        int jn = 0;
#pragma unroll
        for (int q = 1; q < 17; ++q) if (q < p.njobs && it >= p.jobs[q].item0) jn = q;
        p0_transpose_item(p.jobs[jn], scr, it - p.jobs[jn].item0, lane);
    }
    if (item_lo != 0) return;
    bf16_t* U = WSP(bf16_t, WS_U);
    for (int m = gw; m < UROWS; m += ngw) {
        if (m < MTOK) p0_norm_row(p.x + (size_t)m * DM, p.pre_w, U + (size_t)m * DM, WSP(unsigned char, WS_U8) + (size_t)m * DM, lane);
        else if (m < MTOK + NMETA) p0_norm_row(p.meta + (size_t)(m - MTOK) * DM, p.pre_w, U + (size_t)m * DM, nullptr, lane);
        else { u32x4* o = (u32x4*)(U + (size_t)m * DM) + lane;
#pragma unroll
            for (int j = 0; j < 4; ++j) o[64 * j] = (u32x4){0u, 0u, 0u, 0u}; }
    }
    bf16_t* WUK = WSP(bf16_t, WS_WUK);
    for (int i = gw * 64 + lane; i < 262144 / 4; i += ngw * 64) { const f32x4 v = ((const f32x4*)p.w_uk)[i]; u32x2 w; w.x = pk2(v.x, v.y); w.y = pk2(v.z, v.w); ((u32x2*)WUK)[i] = w; }
}

__device__ __forceinline__ void phase_ckvnorm(const Params& p, int gw, int ngw, int lane) {
    const float* CKVRAW = WSP(const float, WS_CKVRAW); bf16_t* CKV = WSP(bf16_t, WS_CKV);
    for (int r = gw; r < MKEY; r += ngw) {
        const f32x4 v = ((const f32x4*)(CKVRAW + (size_t)r * 256))[lane];
        const float ss = wave_sum((v.x * v.x + v.y * v.y) + (v.z * v.z + v.w * v.w));
        const float rstd = rsqrtf(ss * (1.f / 256.f) + EPS);
        const f32x4 g = ((const f32x4*)p.kv_norm_w)[lane];
        int w = __builtin_amdgcn_cvt_pk_fp8_f32(v.x * rstd * g.x, v.y * rstd * g.y, 0, false); w = __builtin_amdgcn_cvt_pk_fp8_f32(v.z * rstd * g.z, v.w * rstd * g.w, w, true);
        ((unsigned*)((unsigned char*)CKV + (size_t)r * 256))[lane] = (unsigned)w;
    }
}

__device__ __forceinline__ void phase7(const Params& p, int gw, int ngw, int lane) {
    const bf16_t* OUTPRE = WSP(const bf16_t, WS_OUTPRE); const float* SSQ = WSP(const float, WS_SSQ);
    for (int r = gw; r < MTOK; r += ngw) {
        float s = (lane < 32) ? SSQ[(size_t)r * 32 + lane] : 0.f; s = wave_sum(s);
        const float rstd = rsqrtf(s * (1.f / DM) + EPS);
        const u32x4* o = (const u32x4*)(OUTPRE + (size_t)r * DM); const f32x4* xr = (const f32x4*)(p.x + (size_t)r * DM); const f32x4* g = (const f32x4*)p.post_w; f32x4* out = (f32x4*)(p.out + (size_t)r * DM);
#pragma unroll
        for (int j = 0; j < 4; ++j) {
            const int ch = 64 * j + lane;
            const u32x4 w = o[ch]; const f32x4 x0 = __builtin_nontemporal_load(xr + 2 * ch), x1 = __builtin_nontemporal_load(xr + 2 * ch + 1), g0 = g[2 * ch], g1 = g[2 * ch + 1];
            f32x4 y0, y1;
            y0.x = x0.x + bflo(w.x) * rstd * g0.x; y0.y = x0.y + bfhi(w.x) * rstd * g0.y; y0.z = x0.z + bflo(w.y) * rstd * g0.z; y0.w = x0.w + bfhi(w.y) * rstd * g0.w;
            y1.x = x1.x + bflo(w.z) * rstd * g1.x; y1.y = x1.y + bfhi(w.z) * rstd * g1.y; y1.z = x1.z + bflo(w.w) * rstd * g1.z; y1.w = x1.w + bfhi(w.w) * rstd * g1.w;
            out[2 * ch] = y0; out[2 * ch + 1] = y1;
        }
    }
}

typedef short v4i16_t __attribute__((ext_vector_type(4)));
typedef float f32x2_t __attribute__((ext_vector_type(2))); typedef __bf16 bf16x2_t __attribute__((ext_vector_type(2)));
__device__ __forceinline__ unsigned cvtpk_s(float lo, float hi) { const f32x2_t v = {lo, hi}; const bf16x2_t b = __builtin_convertvector(v, bf16x2_t); return __builtin_bit_cast(unsigned, b); }
__device__ __forceinline__ unsigned off_b(unsigned row, unsigned ch) { const unsigned f = ((row >> 3) & 1u) | ((((row >> 2) ^ (row >> 3)) & 1u) << 1) | (((row >> 1) & 1u) << 2) | ((row & 1u) << 3); return 256u * row + 16u * (ch ^ f); }
__device__ __forceinline__ bf16x8 tr_frag(LAS unsigned char* img, unsigned a0, unsigned a1) {
    const v4i16_t lo = __builtin_amdgcn_ds_read_tr16_b64_v4i16((LAS v4i16_t*)(img + a0));
    const v4i16_t hi = __builtin_amdgcn_ds_read_tr16_b64_v4i16((LAS v4i16_t*)(img + a1));
    return (bf16x8){lo[0], lo[1], lo[2], lo[3], hi[0], hi[1], hi[2], hi[3]};
}
__device__ __forceinline__ void glds16(const void* gsrc, unsigned lds_dst) {
    unsigned keep;
    asm volatile("s_mov_b32 %0, m0\n\ts_mov_b32 m0, %2\n\ts_nop 0\n\tglobal_load_lds_dwordx4 %1, off\n\ts_mov_b32 m0, %0" : "=&s"(keep) : "v"(gsrc), "s"(lds_dst) : "memory");
}
constexpr int DB_K = 0, DB_V = 49152, DB_LUT = 98304, DB_Q = 99328;
constexpr float DIFF_THR = 24.0f;
__device__ __forceinline__ void diff_unit(const Params& p, LAS unsigned char* lds, int b, int h, int qb, float lam) {
    const bf16_t* QB = WSP(const bf16_t, WS_QB); const bf16_t* KB = WSP(const bf16_t, WS_KB); const bf16_t* VB = WSP(const bf16_t, WS_VB); const bf16_t* ZB = WSP(const bf16_t, WS_ZB); bf16_t* OZB = WSP(bf16_t, WS_OZB);
    const int tid = opaque_tid(), lane = tid & 63, wave = __builtin_amdgcn_readfirstlane(tid >> 6), l15 = lane & 15, g = lane >> 4;
    const int jw = 128 * qb + 16 * wave, jq = jw + l15, cw = 2 * qb + 1 + (wave >> 2), ntiles = 2 * qb + 3;
    LAS float* LUT = (LAS float*)(lds + DB_LUT);
    __syncthreads();
    if (tid < 155) LUT[tid] = p.rel_bias[t5_bucket(tid - 91) * 16 + 8 + h] * LOG2E;
    LAS unsigned char* Qimg = lds + DB_Q + wave * 4096;
    { const bf16_t* qp = QB + (size_t)(b * SEQ + jq) * 1024 + h * 128 + 8 * g;
#pragma unroll
      for (int s = 0; s < 4; ++s) *(LAS bf16x8*)(Qimg + off_b((unsigned)l15, 4u * s + (unsigned)g)) = *(const bf16x8*)(qp + 32 * s); }
    size_t dsrc[2];
#pragma unroll
    for (int i = 0; i < 2; ++i) { const unsigned row = 8u * wave + 4u * i + (unsigned)(lane >> 4); const unsigned f = (off_b(row & 15u, 0u) >> 4) & 15u;
        dsrc[i] = (size_t)row * 1024 + h * 128 + (((unsigned)(lane & 15)) ^ f) * 8; }
    const unsigned ddst = 2048u * wave;
    const unsigned lds0 = (unsigned)(size_t)lds;
#define DF_ROW0(tt) ((size_t)b * TK + ((tt) == 0 ? 0 : 16 + 64 * ((tt) - 1)))
#define DF_DMAK(tt, slot) do { const bf16_t* g_ = KB + DF_ROW0(tt) * 1024; _Pragma("unroll") for (int i_ = 0; i_ < 2; ++i_) \
        glds16(g_ + dsrc[i_], (unsigned)__builtin_amdgcn_readfirstlane((int)(lds0 + DB_K + (slot) * 16384 + ddst + 1024 * i_))); } while (0)
#define DF_DMAV(tt, slot) do { const bf16_t* g_ = VB + DF_ROW0(tt) * 1024; _Pragma("unroll") for (int i_ = 0; i_ < 2; ++i_) \
        glds16(g_ + dsrc[i_], (unsigned)__builtin_amdgcn_readfirstlane((int)(lds0 + DB_V + (slot) * 16384 + ddst + 1024 * i_))); } while (0)
#define DF_WAITBAR(n) do { if ((n) >= 4) asm volatile("s_waitcnt vmcnt(4) lgkmcnt(0)" ::: "memory"); else if ((n) >= 2) asm volatile("s_waitcnt vmcnt(2) lgkmcnt(0)" ::: "memory"); \
        else asm volatile("s_waitcnt vmcnt(0) lgkmcnt(0)" ::: "memory"); __builtin_amdgcn_s_barrier(); asm volatile("" ::: "memory"); } while (0)
    const unsigned q4 = (unsigned)l15 >> 2, pp = (unsigned)l15 & 3u;
    unsigned kbase[2][2], vbase[8];
#pragma unroll
    for (int mp = 0; mp < 2; ++mp)
#pragma unroll
        for (int s = 0; s < 2; ++s) kbase[mp][s] = off_b((unsigned)l15, 8u * mp + 4u * s + (unsigned)g);
#pragma unroll
    for (int c = 0; c < 8; ++c) vbase[c] = off_b(4u * g + q4, 2u * c + (pp >> 1)) + 8u * (pp & 1u);

    float m1 = 0.f, m2 = 0.f;
    f32x4 O1[8], O2[8], OL1 = (f32x4){0.f, 0.f, 0.f, 0.f}, OL2 = (f32x4){0.f, 0.f, 0.f, 0.f};
    const short one_ = (l15 == 0) ? (short)0x3F80 : (short)0;
    const bf16x8 onesf = (bf16x8){one_, one_, one_, one_, one_, one_, one_, one_};
#pragma unroll
    for (int c = 0; c < 8; ++c) { O1[c] = (f32x4){0.f, 0.f, 0.f, 0.f}; O2[c] = (f32x4){0.f, 0.f, 0.f, 0.f}; }
    f32x4 S1[4], S2[4];
    bf16x8 pa1[2], pa2[2];
    float es1 = 1.f, es2 = 1.f; bool pending = false;
    f32x4 cn1 = (f32x4){0.f, 0.f, 0.f, 0.f}, cn2 = cn1, cf1 = cn1, cf2 = cn1;

#define DF_QK(tt, kbo_) do { LAS unsigned char* Kb_ = lds + DB_K + (kbo_); \
        const int dmin_ = ((tt) == 0) ? (jw + 1) : (jw - 64 * (tt) + 1); const bool near_ = dmin_ < 91; \
        const f32x4 ci1_ = near_ ? cn1 : cf1, ci2_ = near_ ? cn2 : cf2;        \
        _Pragma("unroll") for (int s = 0; s < 2; ++s) { const bf16x8 q1_ = *(const LAS bf16x8*)(Qimg + kbase[0][s]), q2_ = *(const LAS bf16x8*)(Qimg + kbase[1][s]); \
          bf16x8 ka1_[4], ka2_[4]; \
          _Pragma("unroll") for (int mb = 0; mb < 4; ++mb) { ka1_[mb] = *(const LAS bf16x8*)(Kb_ + kbase[0][s] + 4096 * mb); ka2_[mb] = *(const LAS bf16x8*)(Kb_ + kbase[1][s] + 4096 * mb); } \
          __builtin_amdgcn_sched_barrier(0); \
          _Pragma("unroll") for (int mb = 0; mb < 4; ++mb) { \
            S1[mb] = __builtin_amdgcn_mfma_f32_16x16x32_bf16(ka1_[mb], q1_, s == 0 ? ci1_ : S1[mb], 0, 0, 0); S2[mb] = __builtin_amdgcn_mfma_f32_16x16x32_bf16(ka2_[mb], q2_, s == 0 ? ci2_ : S2[mb], 0, 0, 0); } } \
        if (near_) { _Pragma("unroll") for (int mb = 0; mb < 4; ++mb) _Pragma("unroll") for (int i = 0; i < 4; ++i) { \
            const int kr_ = 16 * mb + 4 * g + i; const int kpos_ = ((tt) == 0) ? kr_ : 16 + 64 * ((tt) - 1) + kr_; \
            int rel_ = kpos_ - (NMETA + jq); rel_ = rel_ < -91 ? -91 : (rel_ > 63 ? 63 : rel_); const float bias_ = LUT[rel_ + 91]; S1[mb][i] += bias_; S2[mb][i] += bias_; } } \
        if ((tt) == 0) { _Pragma("unroll") for (int mb = 1; mb < 4; ++mb) { S1[mb] = (f32x4){-INFINITY, -INFINITY, -INFINITY, -INFINITY}; S2[mb] = S1[mb]; } } } while (0)
#define DF_LMAX(t1_, t2_) do { t1_ = fmaxf(fmaxf(S1[0][0], S1[0][1]), S1[0][2]); t2_ = fmaxf(fmaxf(S2[0][0], S2[0][1]), S2[0][2]); \
        t1_ = fmaxf(fmaxf(t1_, S1[0][3]), S1[1][0]); t2_ = fmaxf(fmaxf(t2_, S2[0][3]), S2[1][0]); \
        t1_ = fmaxf(fmaxf(t1_, S1[1][1]), S1[1][2]); t2_ = fmaxf(fmaxf(t2_, S2[1][1]), S2[1][2]); \
        t1_ = fmaxf(fmaxf(t1_, S1[1][3]), S1[2][0]); t2_ = fmaxf(fmaxf(t2_, S2[1][3]), S2[2][0]); \
        t1_ = fmaxf(fmaxf(t1_, S1[2][1]), S1[2][2]); t2_ = fmaxf(fmaxf(t2_, S2[2][1]), S2[2][2]); \
        t1_ = fmaxf(fmaxf(t1_, S1[2][3]), S1[3][0]); t2_ = fmaxf(fmaxf(t2_, S2[2][3]), S2[3][0]); \
        t1_ = fmaxf(fmaxf(t1_, S1[3][1]), S1[3][2]); t2_ = fmaxf(fmaxf(t2_, S2[3][1]), S2[3][2]); \
        t1_ = fmaxf(t1_, S1[3][3]); t2_ = fmaxf(t2_, S2[3][3]); } while (0)
#define DF_RESCALE(t1_, t2_, forced_) do { float r1_ = t1_, r2_ = t2_; r1_ = fmaxf(r1_, __shfl_xor(r1_, 16)); r1_ = fmaxf(r1_, __shfl_xor(r1_, 32)); r2_ = fmaxf(r2_, __shfl_xor(r2_, 16)); r2_ = fmaxf(r2_, __shfl_xor(r2_, 32)); \
        const float d1_ = (forced_) ? r1_ : fmaxf(r1_, 0.f), d2_ = (forced_) ? r2_ : fmaxf(r2_, 0.f); m1 += d1_; m2 += d2_; \
        es1 = __builtin_amdgcn_exp2f(-d1_); es2 = __builtin_amdgcn_exp2f(-d2_); \
        _Pragma("unroll") for (int mb = 0; mb < 4; ++mb) { S1[mb] = S1[mb] - d1_; S2[mb] = S2[mb] - d2_; } \
        cn1 = (f32x4){-m1, -m1, -m1, -m1}; cn2 = (f32x4){-m2, -m2, -m2, -m2}; { const float f1_ = bias_far - m1, f2_ = bias_far - m2; cf1 = (f32x4){f1_, f1_, f1_, f1_}; cf2 = (f32x4){f2_, f2_, f2_, f2_}; } } while (0)
#define DF_SCALE_O() do { _Pragma("unroll") for (int i = 0; i < 4; ++i) { const float x1_ = __shfl(es1, 4 * g + i), x2_ = __shfl(es2, 4 * g + i); OL1[i] *= x1_; OL2[i] *= x2_; \
            _Pragma("unroll") for (int c = 0; c < 8; ++c) { O1[c][i] *= x1_; O2[c][i] *= x2_; } } } while (0)
#define DF_EXP() do { _Pragma("unroll") for (int mb = 0; mb < 4; ++mb) _Pragma("unroll") for (int i = 0; i < 4; ++i) { S1[mb][i] = __builtin_amdgcn_exp2f(S1[mb][i]); S2[mb][i] = __builtin_amdgcn_exp2f(S2[mb][i]); } \
        _Pragma("unroll") for (int ks = 0; ks < 2; ++ks) { u32x4 w1_, w2_; \
            w1_.x = cvtpk_s(S1[2 * ks][0], S1[2 * ks][1]); w1_.y = cvtpk_s(S1[2 * ks][2], S1[2 * ks][3]); w1_.z = cvtpk_s(S1[2 * ks + 1][0], S1[2 * ks + 1][1]); w1_.w = cvtpk_s(S1[2 * ks + 1][2], S1[2 * ks + 1][3]); \
            w2_.x = cvtpk_s(S2[2 * ks][0], S2[2 * ks][1]); w2_.y = cvtpk_s(S2[2 * ks][2], S2[2 * ks][3]); w2_.z = cvtpk_s(S2[2 * ks + 1][0], S2[2 * ks + 1][1]); w2_.w = cvtpk_s(S2[2 * ks + 1][2], S2[2 * ks + 1][3]); \
            pa1[ks] = __builtin_bit_cast(bf16x8, w1_); pa2[ks] = __builtin_bit_cast(bf16x8, w2_); } } while (0)
#define DF_PV(vbo_, pq1_, pq2_) do { LAS unsigned char* Vb_ = lds + DB_V + (vbo_); \
        _Pragma("unroll") for (int ks = 0; ks < 2; ++ks) { OL1 = __builtin_amdgcn_mfma_f32_16x16x32_bf16(pq1_[ks], onesf, OL1, 0, 0, 0); OL2 = __builtin_amdgcn_mfma_f32_16x16x32_bf16(pq2_[ks], onesf, OL2, 0, 0, 0); } \
        _Pragma("unroll") for (int c2 = 0; c2 < 8; c2 += 2) { bf16x8 vf_[2][2]; \
            _Pragma("unroll") for (int cc = 0; cc < 2; ++cc) _Pragma("unroll") for (int ks = 0; ks < 2; ++ks) vf_[cc][ks] = tr_frag(Vb_ + vbase[c2 + cc], 8192u * ks, 8192u * ks + 4096u); \
            _Pragma("unroll") for (int cc = 0; cc < 2; ++cc) _Pragma("unroll") for (int ks = 0; ks < 2; ++ks) { \
                O1[c2 + cc] = __builtin_amdgcn_mfma_f32_16x16x32_bf16(pq1_[ks], vf_[cc][ks], O1[c2 + cc], 0, 0, 0); O2[c2 + cc] = __builtin_amdgcn_mfma_f32_16x16x32_bf16(pq2_[ks], vf_[cc][ks], O2[c2 + cc], 0, 0, 0); } } } while (0)

    DF_DMAK(0, 0); DF_DMAV(0, 0); DF_DMAK(1, 1); DF_DMAV(1, 1); DF_DMAK(2, 2);
    asm volatile("s_waitcnt vmcnt(0) lgkmcnt(0)" ::: "memory"); __builtin_amdgcn_s_barrier(); asm volatile("" ::: "memory");
    const float bias_far = LUT[0];
    cf1 = (f32x4){bias_far, bias_far, bias_far, bias_far}; cf2 = cf1;
    { DF_QK(0, 0u); float t1, t2; DF_LMAX(t1, t2); DF_RESCALE(t1, t2, true); DF_EXP(); }
    asm volatile("s_waitcnt lgkmcnt(0)" ::: "memory"); __builtin_amdgcn_s_barrier(); asm volatile("" ::: "memory");
    int sk = 1, sv = 0;
    for (int t = 0; t < ntiles; ++t) {
        if (__builtin_expect(pending, 0)) { DF_SCALE_O(); pending = false; }
        int nnew = 0;
        { const int s3 = (sk == 0) ? 2 : sk - 1;
          if (t + 3 < ntiles) { DF_DMAK(t + 3, s3); nnew += 2; }
          const int s2 = (sv == 0) ? 2 : sv - 1;
          if (t + 2 < ntiles) { DF_DMAV(t + 2, s2); nnew += 2; } }
        unsigned kbo = (unsigned)sk * 16384u, vbo = (unsigned)sv * 16384u; asm volatile("" : "+v"(kbo), "+v"(vbo));
        if (t + 1 <= cw) {
            DF_QK(t + 1, kbo);
            float t1, t2; DF_LMAX(t1, t2);
            if (__builtin_expect(__any((t1 > DIFF_THR) || (t2 > DIFF_THR)), 0)) { DF_RESCALE(t1, t2, false); pending = true; }
            DF_PV(vbo, pa1, pa2);
            DF_EXP();
        } else if (t <= cw) {
            DF_PV(vbo, pa1, pa2);
        }
        DF_WAITBAR(nnew);
        sk = (sk == 2) ? 0 : sk + 1; sv = (sv == 2) ? 0 : sv + 1;
    }
    asm volatile("s_waitcnt vmcnt(0)" ::: "memory");
#undef DF_ROW0
#undef DF_DMAK
#undef DF_DMAV
#undef DF_WAITBAR
#undef DF_QK
#undef DF_LMAX
#undef DF_RESCALE
#undef DF_SCALE_O
#undef DF_EXP
#undef DF_PV
#pragma unroll
    for (int i = 0; i < 4; ++i) {
        const float r1 = 1.f / __shfl(OL1[i], 16 * g), r2 = lam / __shfl(OL2[i], 16 * g);
        float o[8]; float ss = 0.f;
#pragma unroll
        for (int c = 0; c < 8; ++c) { o[c] = O1[c][i] * r1 - O2[c][i] * r2; ss += o[c] * o[c]; }
        ss += __shfl_xor(ss, 1); ss += __shfl_xor(ss, 2); ss += __shfl_xor(ss, 4); ss += __shfl_xor(ss, 8);
        const float rs = rsqrtf(ss * (1.f / 128.f) + EPS) * 0.8f;
        const size_t t = (size_t)b * SEQ + jw + 4 * g + i;
#pragma unroll
        for (int c = 0; c < 8; ++c) { const int d = 16 * c + l15; const float y = o[c] * rs * p.subln_w[d] * bf2f(ZB[t * 1024 + h * 128 + d]); OZB[t * 1024 + h * 128 + d] = (bf16_t)f2bf(y); }
    }
}
__device__ __forceinline__ void phase_diff(const Params& p, LAS unsigned char* lds) {
    const int lane = threadIdx.x & 63;
    float a = (lane < 64) ? p.lam_p[lane] * p.lam_p[64 + lane] : 0.f, bb = p.lam_p[128 + lane] * p.lam_p[192 + lane];
    a = wave_sum(a); bb = wave_sum(bb);
    const float lam = expf(a) - expf(bb) + 0.2f;
    for (int u = blockIdx.x; u < 512; u += gridDim.x) {
        const int v = u & 255;
        int bh = v >> 4, s = v & 15;
        if (gridDim.x == 256) { bh = (v & 7) + 8 * (v >> 7); s = (v >> 3) & 15; }
        const int qb = (u < 256) ? s : 31 - s;
        diff_unit(p, lds, bh >> 3, bh & 7, qb, lam);
    }
}

typedef float f32x16 __attribute__((ext_vector_type(16)));
__device__ __forceinline__ void scores_wg_unit(const Params& p, LAS unsigned char* lds, int c, int b, int half, int kh) {
    const bf16_t* IQ = WSP(const bf16_t, WS_IQ); const float* IW = WSP(const float, WS_IW); float* SC = WSP(float, WS_SC);
    const int tid = opaque_tid(), lane = tid & 63, wave = __builtin_amdgcn_readfirstlane(tid >> 6);
    const int j0 = (c - 1) * 64 + 32 * half + 4 * wave, m0 = b * SEQ + j0, n = 16 + 64 * c, nkb = 2 * c + 1, nkh = (nkb + 1) >> 1;
    const int kbA = kh ? nkh : 0, kbB = kh ? nkb : nkh, ntile = (kbB - kbA + 1) >> 1;
    const int r32 = lane & 31, hi = lane >> 5, tok = r32 >> 4, hh = r32 & 15;
    bf16x8 af[2][4]; float wv[2][16];
#pragma unroll
    for (int pr = 0; pr < 2; ++pr) {
#pragma unroll
        for (int s = 0; s < 4; ++s) af[pr][s] = *(const bf16x8*)(IQ + (size_t)(m0 + 2 * pr + tok) * 1024 + hh * 64 + 16 * s + 8 * hi);
#pragma unroll
        for (int r = 0; r < 16; ++r) wv[pr][r] = IW[(size_t)(m0 + 2 * pr + (r >> 3)) * 16 + (r & 3) + 8 * ((r >> 2) & 1) + 4 * hi];
    }
    float* rowbase = SC + sc_off(b, j0);
    const bf16_t* ikb = WSP(const bf16_t, WS_IK) + (size_t)b * TK * 64;
    const int pkey = tid >> 3, pch = tid & 7;
    const unsigned pdst = (unsigned)pkey * 128u + 16u * (unsigned)(pch ^ (((pkey >> 1) & 1) | (((pkey >> 3) & 1) << 1) | (((pkey >> 4) & 1) << 2)));
    unsigned boff[4];
#pragma unroll
    for (int s = 0; s < 4; ++s) boff[s] = (unsigned)r32 * 128u + 16u * (unsigned)((2 * s + hi) ^ (((r32 >> 1) & 1) | (((r32 >> 3) & 1) << 1) | (((r32 >> 4) & 1) << 2)));
    u32x4 kreg[4];
#define SCW_LOAD(T_) do { _Pragma("unroll") for (int i_ = 0; i_ < 4; ++i_) { int key_ = 32 * (kbA + 8 * (T_)) + 64 * i_ + pkey; key_ = key_ < n ? key_ : n - 1; kreg[i_] = *(const u32x4*)(ikb + (size_t)key_ * 64 + pch * 8); } } while (0)
#define SCW_WRITE(off_) do { _Pragma("unroll") for (int i_ = 0; i_ < 4; ++i_) *(LAS u32x4*)(lds + (off_) + i_ * 8192 + pdst) = kreg[i_]; } while (0)
#define SCW_CHAIN(acc_, pr_, bf_) do { _Pragma("unroll") for (int r_ = 0; r_ < 16; ++r_) acc_[r_] = 0.f; \
        _Pragma("unroll") for (int s_ = 0; s_ < 4; ++s_) acc_ = __builtin_amdgcn_mfma_f32_32x32x16_bf16(af[pr_][s_], bf_[s_], acc_, 0, 0, 0); } while (0)
#define SCW_SUM(acc_, pr_, kb_, en_) do { f32x2_t s0_ = {0.f, 0.f}, s1_ = {0.f, 0.f}; \
        _Pragma("unroll") for (int r_ = 0; r_ < 8; r_ += 2) { \
            const f32x2_t x0_ = {__builtin_amdgcn_fmed3f(acc_[r_], 0.f, pinf), __builtin_amdgcn_fmed3f(acc_[r_ + 1], 0.f, pinf)}; \
            const f32x2_t x1_ = {__builtin_amdgcn_fmed3f(acc_[8 + r_], 0.f, pinf), __builtin_amdgcn_fmed3f(acc_[9 + r_], 0.f, pinf)}; \
            s0_ = __builtin_elementwise_fma((f32x2_t){wv[pr_][r_], wv[pr_][r_ + 1]}, x0_, s0_); s1_ = __builtin_elementwise_fma((f32x2_t){wv[pr_][8 + r_], wv[pr_][9 + r_]}, x1_, s1_); } \
        const float p0_ = s0_.x + s0_.y, p1_ = s1_.x + s1_.y; \
        const auto sw_ = __builtin_amdgcn_permlane32_swap(__float_as_uint(p0_), __float_as_uint(p1_), false, false); \
        const float tot_ = __uint_as_float(sw_[0]) + __uint_as_float(sw_[1]); const int key_ = 32 * (kb_) + r32; \
        if ((en_) && (kb_) < kbB && key_ < n) rowbase[(size_t)(2 * (pr_) + hi) * n + key_] = tot_; } while (0)
#define SCW_MIX() do { _Pragma("unroll") for (int g_ = 0; g_ < 4; ++g_) { __builtin_amdgcn_sched_group_barrier(0x008, 1, 0); __builtin_amdgcn_sched_group_barrier(0x002, 6, 0); } } while (0)
    __syncthreads();
    SCW_LOAD(0); SCW_WRITE(0u);
    __syncthreads();
    f32x16 accA, accB;
    float pinf = __builtin_inff(); asm volatile("" : "+v"(pinf));
#pragma unroll
    for (int r = 0; r < 16; ++r) accB[r] = 0.f;
    const int nsup = (ntile + 3) >> 2;
    for (int T = 0; T < nsup; ++T) {
        if (T + 1 < nsup) SCW_LOAD(T + 1);
        const int tend = (4 * T + 4 < ntile) ? 4 * T + 4 : ntile;
        for (int t = 4 * T; t < tend; ++t) {
            unsigned bo = (unsigned)(T & 1) * 32768u + (unsigned)(t & 3) * 8192u; asm volatile("" : "+v"(bo));
            const int kb0 = kbA + 2 * t;
            bf16x8 bf0[4], bf1[4];
#pragma unroll
            for (int s = 0; s < 4; ++s) bf0[s] = *(const LAS bf16x8*)(lds + bo + boff[s]);
#pragma unroll
            for (int s = 0; s < 4; ++s) bf1[s] = *(const LAS bf16x8*)(lds + bo + boff[s] + 4096);
            SCW_CHAIN(accA, 0, bf0); SCW_SUM(accB, 1, kb0 - 1, t > 0); SCW_MIX();
            SCW_CHAIN(accB, 1, bf0); SCW_SUM(accA, 0, kb0, true); SCW_MIX();
            SCW_CHAIN(accA, 0, bf1); SCW_SUM(accB, 1, kb0, true); SCW_MIX();
            SCW_CHAIN(accB, 1, bf1); SCW_SUM(accA, 0, kb0 + 1, true); SCW_MIX();
        }
        if (T + 1 < nsup) SCW_WRITE((unsigned)((T + 1) & 1) * 32768u);
        __syncthreads();
    }
    SCW_SUM(accB, 1, kbA + 2 * ntile - 1, true);
#undef SCW_CHAIN
#undef SCW_SUM
#undef SCW_MIX
#undef SCW_LOAD
#undef SCW_WRITE
}
__device__ __forceinline__ void phase_scores(const Params& p, LAS unsigned char* lds) {
    for (int P = (int)blockIdx.x; P < 256; P += (int)gridDim.x) {
        const int cl = 1 + (P >> 3), sub = P & 7;
        scores_wg_unit(p, lds, 65 - cl, sub >> 2, (sub >> 1) & 1, sub & 1);
        scores_wg_unit(p, lds, cl, sub >> 2, (sub >> 1) & 1, sub & 1);
    }
}
__device__ __forceinline__ void phase_qlat(const Params& p, LAS unsigned char* lds) {
    const bf16_t* QA = WSP(const bf16_t, WS_QA); const bf16_t* WUK = WSP(const bf16_t, WS_WUK); bf16_t* QLAT = WSP(bf16_t, WS_QLAT);
    const int tid = opaque_tid(), lane = tid & 63, w = __builtin_amdgcn_readfirstlane(tid >> 6), l15 = lane & 15, g = lane >> 4;
    const float sc = 0.08838834764831845f * LOG2E * 16.f;
    const int G = (int)gridDim.x;
    int hcur = -1;
    const unsigned kb0 = off_b((unsigned)l15, (unsigned)g);
    for (int u0 = (int)blockIdx.x; u0 < 4096; u0 += 8 * G) {
        const int h = u0 & 7;
        if (h != hcur || (G & 7)) { hcur = h; __syncthreads();
#pragma unroll
            for (int i = 0; i < 8; ++i) { const int idx = tid + 512 * i, row = idx >> 4, ch = idx & 15;
                *(LAS u32x4*)(lds + off_b((unsigned)row, (unsigned)ch)) = *(const u32x4*)(WUK + ((size_t)row * 8 + h) * 128 + ch * 8); }
            __syncthreads(); }
        const int u = u0 + w * G;
        if (u < 4096 && (u & 7) == h) {
            const int m0 = (u >> 3) * 16;
            bf16x8 bq[4];
#pragma unroll
            for (int s = 0; s < 4; ++s) bq[s] = *(const bf16x8*)(QA + (size_t)(m0 + l15) * 1024 + h * 128 + 32 * s + 8 * g);
#pragma unroll 4
            for (int nb = 0; nb < 16; ++nb) {
                bf16x8 af[4];
#pragma unroll
                for (int s = 0; s < 4; ++s) af[s] = *(const LAS bf16x8*)(lds + 4096 * nb + (kb0 ^ (64u * s)));
                f32x4 acc = (f32x4){0.f, 0.f, 0.f, 0.f};
#pragma unroll
                for (int s = 0; s < 4; ++s) acc = __builtin_amdgcn_mfma_f32_16x16x32_bf16(af[s], bq[s], acc, 0, 0, 0);
                int wv = __builtin_amdgcn_cvt_pk_fp8_f32(acc[0] * sc, acc[1] * sc, 0, false); wv = __builtin_amdgcn_cvt_pk_fp8_f32(acc[2] * sc, acc[3] * sc, wv, true);
                *(unsigned*)((unsigned char*)QLAT + ((size_t)(m0 + l15) * 8 + h) * 256 + 16 * nb + 4 * g) = (unsigned)wv;
            }
        }
    }
}
__device__ __forceinline__ void phase_oproj(const Params& p, LAS unsigned char* lds) {
    const bf16_t* OLAT = WSP(const bf16_t, WS_OLAT); const bf16_t* WUVT = WSP(const bf16_t, WS_WUVT); const bf16_t* ZA = WSP(const bf16_t, WS_ZA); bf16_t* OZA = WSP(bf16_t, WS_OZA);
    const int tid = opaque_tid(), lane = tid & 63, w = __builtin_amdgcn_readfirstlane(tid >> 6), l15 = lane & 15, g = lane >> 4;
    const int G = (int)gridDim.x;
    int hcur = -1;
    const unsigned kb0 = off_b((unsigned)l15, (unsigned)g);
    for (int u0 = (int)blockIdx.x; u0 < 4096; u0 += 8 * G) {
        const int h = u0 & 7;
        if (h != hcur || (G & 7)) { hcur = h; __syncthreads();
#pragma unroll
            for (int i = 0; i < 8; ++i) { const int idx = tid + 512 * i, row = idx >> 5, c32 = idx & 31;
                *(LAS u32x4*)(lds + (c32 >> 4) * 32768 + off_b((unsigned)row, (unsigned)(c32 & 15))) = *(const u32x4*)(WUVT + (size_t)(h * 128 + row) * 256 + c32 * 8); }
            __syncthreads(); }
        const int u = u0 + w * G;
        if (u < 4096 && (u & 7) == h) {
            const int m0 = (u >> 3) * 16;
            bf16x8 bq[8];
#pragma unroll
            for (int s = 0; s < 8; ++s) bq[s] = *(const bf16x8*)(OLAT + ((size_t)(m0 + l15) * 8 + h) * 256 + 32 * s + 8 * g);
#pragma unroll 2
            for (int nb = 0; nb < 8; ++nb) {
                bf16x8 af[8];
#pragma unroll
                for (int s = 0; s < 8; ++s) af[s] = *(const LAS bf16x8*)(lds + (s >> 2) * 32768 + 4096 * nb + (kb0 ^ (64u * (s & 3))));
                f32x4 acc = (f32x4){0.f, 0.f, 0.f, 0.f};
#pragma unroll
                for (int s = 0; s < 8; ++s) acc = __builtin_amdgcn_mfma_f32_16x16x32_bf16(af[s], bq[s], acc, 0, 0, 0);
                const size_t o = (size_t)(m0 + l15) * 1024 + h * 128 + 16 * nb + 4 * g;
                const u32x2 z = *(const u32x2*)(ZA + o);
                u32x2 wv; wv.x = pg8::cvt_pk_bf16(acc[0] * bflo(z.x), acc[1] * bfhi(z.x)); wv.y = pg8::cvt_pk_bf16(acc[2] * bflo(z.y), acc[3] * bfhi(z.y));
                *(u32x2*)(OZA + o) = wv;
            }
        }
    }
}
typedef int v2i32_t __attribute__((ext_vector_type(2)));
constexpr int DSA_WAVE_LDS = 17408, DSA_LUT = 8 * DSA_WAVE_LDS;
__device__ __forceinline__ int lpos(int s) { return (s & ~31) | ((s & 3) << 3) | ((s & 31) >> 2); }
__device__ __forceinline__ unsigned ord_key(float f) { const unsigned u = __float_as_uint(f); return (u & 0x80000000u) ? ~u : (u | 0x80000000u); }
template <int KN>
__device__ __forceinline__ void dsa_select(const float* row, int n, int nsel, LAS int* list, int lane) {
    const __amdgpu_buffer_rsrc_t rs = __builtin_amdgcn_make_buffer_rsrc((void*)row, 0, n * 4, 0x00020000);
    unsigned key[KN];
#pragma unroll
    for (int k = 0; k < KN; ++k) key[k] = (unsigned)__builtin_amdgcn_raw_buffer_load_b32(rs, lane * 4, 256 * k, 2);
    { int idx0 = lane;
#pragma unroll
      for (int k = 0; k < KN; ++k) { const unsigned u = key[k]; const unsigned o = (u & 0x80000000u) ? ~u : (u | 0x80000000u); key[k] = (idx0 < n) ? o : 0u; idx0 += 64; asm volatile("" : "+v"(idx0)); } }
    unsigned thr = 0u;
    if (n > 256) {
        for (int bit = 31; bit >= 0; --bit) {
            const unsigned cand = thr | (1u << bit);
            int c = 0;
#pragma unroll
            for (int k = 0; k < KN; ++k) c += (key[k] >= cand) ? 1 : 0;
            int cnt = 0;
#pragma unroll
            for (int b7 = 0; b7 < 7; ++b7) cnt += __popcll(__ballot((c >> b7) & 1)) << b7;
            if (cnt >= 256) thr = cand;
            if (cnt == 256) break;
        }
    }
    int pos = 0; int idx = lane;
#pragma unroll
    for (int k = 0; k < KN; ++k) { const bool mine = key[k] > thr; const unsigned long long msk = __ballot(mine);
        const int my = __builtin_amdgcn_mbcnt_hi((unsigned)(msk >> 32), __builtin_amdgcn_mbcnt_lo((unsigned)msk, 0u));
        if (mine) list[lpos(pos + my)] = idx; pos += __popcll(msk); idx += 64; asm volatile("" : "+v"(idx)); }
    if (pos < nsel) {
        idx = lane;
#pragma unroll
        for (int k = 0; k < KN; ++k) { const bool mine = (key[k] == thr) && (idx < n); const unsigned long long msk = __ballot(mine);
            const int my = __builtin_amdgcn_mbcnt_hi((unsigned)(msk >> 32), __builtin_amdgcn_mbcnt_lo((unsigned)msk, 0u));
            if (mine && pos + my < nsel) list[lpos(pos + my)] = idx; pos += __popcll(msk); idx += 64; asm volatile("" : "+v"(idx)); }
    }
}
__device__ __forceinline__ void dsa_unit(const Params& p, LAS unsigned char* lds, int qi, int wave, int lane, int probe) {
    const float* SC = WSP(const float, WS_SC); bf16_t* OLAT = WSP(bf16_t, WS_OLAT);
    const int c = qi >> 8, b = (qi >> 6) & 1, j = (c - 1) * 64 + (qi & 63), t = b * SEQ + j, n = 16 + 64 * c, nsel = n < 256 ? n : 256, qpos = NMETA + j;
    LAS unsigned char* img = lds + wave * DSA_WAVE_LDS; LAS int* list = (LAS int*)(img + 16384); const LAS float* LUTA = (const LAS float*)(lds + DSA_LUT);
    const int l15 = lane & 15, g = lane >> 4;
    const float* row = SC + sc_off(b, j);
#pragma unroll
    for (int rs_ = (PROBE_REP == 41) ? 2 : 1; rs_ > 0; --rs_) {
    if (n <= 64 * 17) dsa_select<17>(row, n, nsel, list, lane);
    else if (n <= 64 * 33) dsa_select<33>(row, n, nsel, list, lane);
    else if (n <= 64 * 49) dsa_select<49>(row, n, nsel, list, lane);
    else dsa_select<65>(row, n, nsel, list, lane);
    }
#pragma unroll
    for (int ra_ = (PROBE_REP == 42) ? 2 : 1; ra_ > 0; --ra_) {
    const unsigned char* CKV8 = WSP(const unsigned char, WS_CKV); const unsigned char* qlp = WSP(const unsigned char, WS_QLAT) + ((size_t)t * 8 + (l15 & 7)) * 256 + 8 * g;
    const bool qreal = l15 < 8;
    unsigned rdb[2];
    rdb[0] = 256u * (unsigned)l15 + 8u * ((unsigned)g ^ (2u * (unsigned)l15));
    rdb[1] = 256u * (unsigned)(l15 + 16) + 8u * ((unsigned)g ^ (2u * ((unsigned)l15 ^ 8u)));
    const unsigned tq = (unsigned)l15 >> 1, tp = (unsigned)l15 & 1u;
    const unsigned trow = (tq < 4u) ? 4u * g + tq : 16u + 4u * g + (tq - 4u);
    const unsigned trb = 256u * trow + 8u * (tp ^ (2u * ((trow & 15u) ^ ((trow >> 4) << 3))));
    float m = -INFINITY, l = 0.f;
    f32x4 O[16];
#pragma unroll
    for (int rb = 0; rb < 16; ++rb) O[rb] = (f32x4){0.f, 0.f, 0.f, 0.f};
    const int nch = (nsel + 31) >> 5;
    const int hcol = l15 & 7;
    u32x4 gr[8];
    const unsigned gwr = 256u * (unsigned)(lane >> 4) + 16u * (unsigned)(lane & 15);
#define DSA_GATHER(chn) do { int ki_[8]; { const int ce_ = ((chn) < nch) ? (chn) : 0; const LAS int* lp_ = list + 32 * ce_ + 8 * (lane >> 4);     \
        _Pragma("unroll") for (int v_ = 0; v_ < 2; ++v_) { const u32x4 t_ = *(const LAS u32x4*)(lp_ + 4 * v_); ki_[4 * v_] = (int)t_.x; ki_[4 * v_ + 1] = (int)t_.y; ki_[4 * v_ + 2] = (int)t_.z; ki_[4 * v_ + 3] = (int)t_.w; } } \
        _Pragma("unroll") for (int i = 0; i < 8; ++i) gr[i] = *(const u32x4*)(ckb + (((unsigned)ki_[i] << 8) | gl16)); } while (0)
    const unsigned char* ckb = CKV8 + (size_t)b * TK * 256; const unsigned gl16 = ((unsigned)lane & 15u) << 4;
    if (nsel < 32 * nch) { for (int i = nsel + lane; i < 32 * nch; i += 64) list[lpos(i)] = 0; }
    long qf[8];
#pragma unroll
    for (int s = 0; s < 8; ++s) qf[s] = *(const long*)(qlp + 32 * s);
#pragma unroll
    for (int s = 0; s < 8; ++s) qf[s] = qreal ? qf[s] : 0l;
    DSA_GATHER(0);
    for (int ch = 0; ch < nch; ++ch) {
#pragma unroll
        for (int i = 0; i < 8; ++i) { const unsigned row = 4u * i + (unsigned)(lane >> 4); const unsigned rc = (row & 15u) ^ ((row >> 4) << 3);
            *(LAS u32x4*)(img + 256u * row + 16u * (((unsigned)lane & 15u) ^ rc)) = gr[i]; }
        asm volatile("" ::: "memory");
        DSA_GATHER(ch + 1);
        asm volatile("" ::: "memory");
        LAS unsigned char* im = img;
        f32x4 S[2];
        S[0] = (f32x4){0.f, 0.f, 0.f, 0.f}; S[1] = S[0];
#pragma unroll
        for (int s4 = 0; s4 < 8; s4 += 4) {
            long af_[4][2];
#pragma unroll
            for (int s = 0; s < 4; ++s)
#pragma unroll
                for (int mb = 0; mb < 2; ++mb) af_[s][mb] = *(const LAS long*)(im + (rdb[mb] ^ (32u * (s4 + s))));
            __builtin_amdgcn_sched_barrier(0);
#pragma unroll
            for (int s = 0; s < 4; ++s)
#pragma unroll
                for (int mb = 0; mb < 2; ++mb) S[mb] = __builtin_amdgcn_mfma_f32_16x16x32_fp8_fp8(af_[s][mb], qf[s4 + s], S[mb], 0, 0, 0);
        }
        float cm = -INFINITY;
#pragma unroll
        for (int mb = 0; mb < 2; ++mb)
#pragma unroll
            for (int i = 0; i < 4; ++i) { const int slot = 32 * ch + 16 * mb + 4 * g + i; const int kidx = list[lpos(slot & 255)];
                int rel = kidx - qpos; rel = rel < -91 ? -91 : (rel > 63 ? 63 : rel);
                float v = S[mb][i] * 0.0625f + LUTA[(rel + 91) * 8 + hcol]; v = slot < nsel ? v : -INFINITY; S[mb][i] = v; cm = fmaxf(cm, v); }
        cm = fmaxf(cm, __shfl_xor(cm, 16)); cm = fmaxf(cm, __shfl_xor(cm, 32));
        const float mn = fmaxf(m, cm), alpha = __builtin_amdgcn_exp2f(m - mn); m = mn;
        float ps = 0.f;
#pragma unroll
        for (int mb = 0; mb < 2; ++mb)
#pragma unroll
            for (int i = 0; i < 4; ++i) { S[mb][i] = __builtin_amdgcn_exp2f(S[mb][i] - mn); ps += S[mb][i]; }
        l = l * alpha + ps;
        if (__any(alpha != 1.f)) {
#pragma unroll
            for (int rb = 0; rb < 16; ++rb) O[rb] = O[rb] * alpha;
        }
        int w0 = __builtin_amdgcn_cvt_pk_fp8_f32(S[0][0], S[0][1], 0, false); w0 = __builtin_amdgcn_cvt_pk_fp8_f32(S[0][2], S[0][3], w0, true);
        int w1 = __builtin_amdgcn_cvt_pk_fp8_f32(S[1][0], S[1][1], 0, false); w1 = __builtin_amdgcn_cvt_pk_fp8_f32(S[1][2], S[1][3], w1, true);
        const long pb = (long)(((unsigned long long)(unsigned)w1 << 32) | (unsigned long long)(unsigned)w0);
#pragma unroll
        for (int rb4 = 0; rb4 < 16; rb4 += 4) {
            long tf_[4];
#pragma unroll
            for (int r_ = 0; r_ < 4; ++r_) { const v2i32_t tv = __builtin_amdgcn_ds_read_tr8_b64_v2i32((LAS v2i32_t*)(im + (trb ^ (16u * (rb4 + r_))))); tf_[r_] = __builtin_bit_cast(long, tv); }
            __builtin_amdgcn_sched_barrier(0);
#pragma unroll
            for (int r_ = 0; r_ < 4; ++r_) O[rb4 + r_] = __builtin_amdgcn_mfma_f32_16x16x32_fp8_fp8(tf_[r_], pb, O[rb4 + r_], 0, 0, 0);
        }
    }
    l += __shfl_xor(l, 16); l += __shfl_xor(l, 32);
    const float il = 1.f / l;
    if (l15 < 8) {
#pragma unroll
        for (int rb = 0; rb < 16; ++rb) { u32x2 w; w.x = pg8::cvt_pk_bf16(O[rb][0] * il, O[rb][1] * il); w.y = pg8::cvt_pk_bf16(O[rb][2] * il, O[rb][3] * il);
            *(u32x2*)(OLAT + ((size_t)t * 8 + l15) * 256 + 16 * rb + 4 * g) = w; }
    }
    }
}
#undef DSA_GATHER
__device__ __forceinline__ int lds_take(LAS unsigned* ctr, int lane) {
    int u = 0; if (lane == 0) u = (int)__hip_atomic_fetch_add(ctr, 1u, __ATOMIC_RELAXED, __HIP_MEMORY_SCOPE_WORKGROUP);
    return __builtin_amdgcn_readfirstlane(u);
}
__device__ __forceinline__ int dsa_query_of(int u, int G) {
    const int k = u >> 3, r = u & 7;
    int cl, bb, grp;
    if (G == 256) { const int idx = ((int)blockIdx.x >> 1) + 128 * k; cl = 1 + (idx >> 4); grp = idx & 15; bb = (int)blockIdx.x & 1; }
    else { const int P = (int)blockIdx.x + k * G; cl = 1 + (P >> 5); bb = (P >> 4) & 1; grp = P & 15; }
    const int c = (r < 4) ? 65 - cl : cl;
    return (c << 8) | (bb << 6) | (4 * grp + (r & 3));
}
__device__ __forceinline__ int dsa_token_of(int qi) { return ((qi >> 6) & 1) * SEQ + ((qi >> 8) - 1) * 64 + (qi & 63); }
__device__ __forceinline__ void phase_dsa(const Params& p, LAS unsigned char* lds, int wave, int lane, int probe) {
    LAS float* LUTA = (LAS float*)(lds + DSA_LUT); LAS unsigned* ctr = (LAS unsigned*)(lds + DSA_LUT + 155 * 8 * 4);
    const int G = (int)gridDim.x, l15 = lane & 15, g = lane >> 4;
    __syncthreads();
    for (int i = threadIdx.x; i < 155 * 8; i += 512) LUTA[i] = p.rel_bias[t5_bucket((i >> 3) - 91) * 16 + (i & 7)] * LOG2E;
    if (threadIdx.x == 0) ctr[0] = 0u;
    const int npi = (1024 - (int)blockIdx.x + G - 1) / G;
    const int nun = npi * 8;
    __syncthreads();
    for (;;) {
        const int u = lds_take(ctr, lane); if (u >= nun) break;
        dsa_unit(p, lds, dsa_query_of(u, G), wave, lane, probe);
    }
}

#define XB_TMO      128
#define XB_XCNT(j)  (256  + 64 * (j))
#define XB_XSUB(j)  (1280 + 64 * (j))
#define XB_XGEN(j)  (2304 + 64 * (j))
#define XB_TOP      3328
#define XB_TOPGEN   3392
#define XCD_BAR_WORDS 3456
#define XB_SPIN_CAP (1u << 24)
__device__ __forceinline__ unsigned xb_ld(unsigned* p)              { return __hip_atomic_load(p, __ATOMIC_RELAXED, __HIP_MEMORY_SCOPE_AGENT); }
__device__ __forceinline__ unsigned xb_add(unsigned* p, unsigned v) { return __hip_atomic_fetch_add(p, v, __ATOMIC_RELAXED, __HIP_MEMORY_SCOPE_AGENT); }
__device__ __forceinline__ unsigned xb_xcc_id() { return (unsigned)__builtin_amdgcn_s_getreg((3 << 11) | 20) & 0xFu; }
#define XB_SPIN(cond, bar) do { unsigned _sp = 0; while (cond) { __builtin_amdgcn_s_sleep(1); \
    if ((++_sp & 255u) == 0u) { if (xb_ld(&(bar)[XB_TMO])) break; if (_sp > XB_SPIN_CAP) { atomicAdd(&(bar)[XB_TMO], 1u); break; } } } } while (0)
struct XcdBarrier { unsigned* bar; unsigned x; volatile LAS unsigned* st; };
__device__ __forceinline__ XcdBarrier xcd_barrier_post(unsigned* bar, volatile LAS unsigned* st) {
    XcdBarrier b; b.bar = bar; b.x = xb_xcc_id(); b.st = st;
    if (threadIdx.x == 0) (void)xb_add(&bar[XB_XCNT(b.x)], 1u);
    return b;
}
__device__ __forceinline__ void xcd_barrier_complete(unsigned* bar, unsigned x, unsigned& nloc, unsigned& nx) {
    const unsigned G = gridDim.x * gridDim.y * gridDim.z;
    unsigned sum, cnt, mine, sp = 0u;
    for (;;) {
        sum = 0u; cnt = 0u; mine = 0u;
#pragma unroll
        for (unsigned j = 0; j < 16; ++j) { const unsigned c = xb_ld(&bar[XB_XCNT(j)]); sum += c; cnt += (c > 0u) ? 1u : 0u; mine = (j == x) ? c : mine; }
        if (sum == G) break;
        __builtin_amdgcn_s_sleep(1);
        if ((++sp & 255u) == 0u) { if (xb_ld(&bar[XB_TMO])) break; if (sp > XB_SPIN_CAP) { atomicAdd(&bar[XB_TMO], 1u); break; } }
    }
    nloc = mine > 0u ? mine : 1u; nx = cnt > 0u ? cnt : 1u;
}
__device__ __forceinline__ void xcd_barrier(const XcdBarrier& b) {
    asm volatile("s_waitcnt vmcnt(0)" ::: "memory");
    __syncthreads();
    if (threadIdx.x == 0) {
        unsigned* bar = b.bar;
        __builtin_amdgcn_s_waitcnt(0);
        unsigned nloc = b.st[0], nx = b.st[1];
        if (nloc == 0u) { xcd_barrier_complete(bar, b.x, nloc, nx); b.st[0] = nloc; b.st[1] = nx; }
        const unsigned old = xb_add(&bar[XB_XSUB(b.x)], 1u);
        const unsigned gen = old / nloc;
        if (old + 1u == (gen + 1u) * nloc) {
            __builtin_amdgcn_fence(__ATOMIC_RELEASE, "agent");
            asm volatile("s_waitcnt vmcnt(0)" ::: "memory");
            const unsigned og = xb_add(&bar[XB_TOP], 1u);
            const unsigned tg = og / nx;
            if (og + 1u == (tg + 1u) * nx) xb_add(&bar[XB_TOPGEN], 1u);
            else XB_SPIN(xb_ld(&bar[XB_TOPGEN]) == tg, bar);
            __builtin_amdgcn_fence(__ATOMIC_ACQUIRE, "agent");
            xb_add(&bar[XB_XGEN(b.x)], 1u);
            asm volatile("s_waitcnt vmcnt(0)" ::: "memory");
        } else {
            XB_SPIN(xb_ld(&bar[XB_XGEN(b.x)]) == gen, bar);
            __builtin_amdgcn_fence(__ATOMIC_ACQUIRE, "agent");
            asm volatile("s_waitcnt vmcnt(0)" ::: "memory");
        }
    }
    __syncthreads();
}

constexpr int LDS_BYTES = 147456, MISC_OFF = 147456 - 256;
constexpr int NPHASE = 8;
#ifndef ONE_LAUNCH
#define ONE_LAUNCH 1
#endif

struct KArgs { Params p; int ph_lo, ph_hi, probe, pad; };
__global__ void __launch_bounds__(512, 2) k_fwd(KArgs a) {
    extern __shared__ __attribute__((aligned(16))) unsigned char lds_raw[];
    LAS unsigned char* lds = (LAS unsigned char*)lds_raw;
    const Params& p = a.p;
    const int tid = threadIdx.x, lane = tid & 63, wave = __builtin_amdgcn_readfirstlane(tid >> 6);
    const int gw = blockIdx.x * 8 + wave, ngw = gridDim.x * 8;
    volatile LAS unsigned* misc = (volatile LAS unsigned*)(lds + MISC_OFF);
    if (tid < 64) misc[tid] = 0u;
    __syncthreads();
    XcdBarrier bar; bar.bar = WSP(unsigned, WS_CTL) + 4096; bar.x = 0; bar.st = misc;
    if (ONE_LAUNCH) bar = xcd_barrier_post(WSP(unsigned, WS_CTL) + 4096, misc);
#define IN(k) (a.ph_lo <= 0 && 0 < a.ph_hi)
#define SEAM(k) do { xcd_barrier(bar); } while (0)
#define RUNPH(k, ...) do { if (IN(k)) { constexpr int nrep_ = (PROBE_REP == (k)) ? 2 : 1; _Pragma("unroll") for (int rep = 0; rep < nrep_; ++rep) { if (rep) xcd_barrier(bar); __VA_ARGS__ } } } while (0)
    RUNPH(0, const int lane_ = opaque_tid() & 63; phase0(p, lds, gw, ngw, wave, lane_, 0, (gridDim.x == 256) ? p.jobs[13].item0 : p.nitems););
    SEAM(0);
    RUNPH(1,
        SchedInproj S{DM, (int)gridDim.x, (int)blockIdx.x, (const char*)WSP(bf16_t, WS_U), (const char*)WSP(bf16_t, WS_WIN)};
        EpiInproj E{WSP(bf16_t, WS_QA), WSP(bf16_t, WS_ZA), WSP(bf16_t, WS_IQ), WSP(bf16_t, WS_QB), WSP(bf16_t, WS_ZB), WSP(bf16_t, WS_GA), WSP(bf16_t, WS_GB), WSP(bf16_t, WS_KB), WSP(bf16_t, WS_VB),
                    WSP(float, WS_CKVRAW), WSP(bf16_t, WS_IK), WSP(float, WS_IW), 0.125f * LOG2E, p.ikn_w, p.ikn_b, 0.015625f};
        pg8::gemm_phase<EpiInproj, SchedInproj>(lds, S, E);
        { SchedGate S8{DM, (int)gridDim.x, (int)blockIdx.x, (const char*)WSP(unsigned char, WS_U8), (const char*)WSP(unsigned char, WS_W8)};
          EpiGate E8{WSP(bf16_t, WS_GA), WSP(bf16_t, WS_GB), WSP(bf16_t, WS_ZA), WSP(bf16_t, WS_ZB)};
          pg8::gemm_phase<EpiGate, SchedGate, true, true, true>(lds, S8, E8); }
        if (gridDim.x == 256 && blockIdx.x >= 202) { const int lane_ = opaque_tid() & 63; phase0(p, lds, ((int)blockIdx.x - 202) * 8 + wave, 54 * 8, wave, lane_, p.jobs[13].item0, p.nitems); });
    SEAM(1);
    RUNPH(33, const int lane_ = opaque_tid() & 63; phase_ckvnorm(p, gw, ngw, lane_););
    RUNPH(32, phase_qlat(p, lds););
    RUNPH(30, phase_diff(p, lds););
    RUNPH(31, phase_scores(p, lds););
    SEAM(3);
    RUNPH(4, const int lane_ = opaque_tid() & 63; phase_dsa(p, lds, wave, lane_, a.probe););
    SEAM(4);
    RUNPH(8, phase_oproj(p, lds););
    SEAM(8);
    RUNPH(5,
        SchedMix S{1024, (int)gridDim.x, (int)blockIdx.x, (const char*)WSP(bf16_t, WS_OZA), (const char*)WSP(bf16_t, WS_WOA), (const char*)WSP(bf16_t, WS_OZB), (const char*)WSP(bf16_t, WS_WOB)};
        EpiMix E{WSP(const bf16_t, WS_GA), WSP(const bf16_t, WS_GB), WSP(bf16_t, WS_MIX)};
        pg8::gemm_phase<EpiMix, SchedMix>(lds, S, E););
    SEAM(5);
    if (gridDim.x == 256) {
        RUNPH(6,
            SchedOut S{DM, (int)gridDim.x, (int)blockIdx.x, (const char*)WSP(bf16_t, WS_MIX), (const char*)WSP(bf16_t, WS_WOUT)};
            EpiOutFused E{p.x, p.post_w, p.out, WSP(float, WS_SSQ), WSP(unsigned, WS_CTL) + 8192, lds};
            pg8::gemm_phase<EpiOutFused, SchedOut>(lds, S, E););
    } else {
        RUNPH(6,
            SchedOut S{DM, (int)gridDim.x, (int)blockIdx.x, (const char*)WSP(bf16_t, WS_MIX), (const char*)WSP(bf16_t, WS_WOUT)};
            EpiOut E{WSP(bf16_t, WS_OUTPRE), WSP(float, WS_SSQ)};
            pg8::gemm_phase<EpiOut, SchedOut>(lds, S, E););
        SEAM(6);
        RUNPH(7, const int lane_ = opaque_tid() & 63; phase7(p, gw, ngw, lane_););
    }
#undef RUNPH
#undef IN
#undef SEAM
}

static void add_job(Params& p, const float* src, bf16_t* dst, int K, int N, int col0, int ncols, int row0, int fp8 = 0) {
    TJob& j = p.jobs[p.njobs++]; j.fp8 = fp8; j.pad_ = 0; j.src = src; j.dst = dst; j.K = K; j.N = N; j.col0 = col0; j.nblk = (ncols + 31) / 32; j.row0 = row0; j.item0 = p.nitems; p.nitems += (K / 64) * j.nblk;
}
extern "C" void kernel_launch(void* const* d_in, const int* in_sizes, int n_in, void* d_out, int out_size, void* d_ws, size_t ws_size, hipStream_t stream) {
    if (n_in != 16 || ws_size < WS_END) { fprintf(stderr, "kernel_launch: unexpected arguments (n_in %d, ws %zu)\n", n_in, ws_size); return; }
    static int grid = 0;
    if (!grid) {
        int dev = 0, cus = 0, per_cu = 0;
        (void)hipGetDevice(&dev); (void)hipDeviceGetAttribute(&cus, hipDeviceAttributeMultiprocessorCount, dev);
        (void)hipFuncSetAttribute((const void*)k_fwd, hipFuncAttributeMaxDynamicSharedMemorySize, LDS_BYTES);
        (void)hipOccupancyMaxActiveBlocksPerMultiprocessor(&per_cu, (const void*)k_fwd, 512, LDS_BYTES);
        (void)hipGetLastError();
        grid = cus > 0 ? cus : 256;
        if (per_cu < 1) fprintf(stderr, "kernel_launch: occupancy query reports %d blocks per CU\n", per_cu);
    }
    KArgs a; memset(&a, 0, sizeof(a));
    Params& p = a.p;
    const float** in = (const float**)d_in;
    p.x = in[0]; p.meta = in[1]; p.rel_bias = in[2]; p.pre_w = in[3]; p.w_in = in[4]; p.kv_norm_w = in[5]; p.w_uk = in[6]; p.w_uv = in[7]; p.ikn_w = in[8]; p.ikn_b = in[9];
    p.lam_p = in[10]; p.subln_w = in[11]; p.w_o_a = in[12]; p.w_o_b = in[13]; p.w_out = in[14]; p.post_w = in[15];
    p.out = (float*)d_out; p.ws = (unsigned char*)d_ws;
    bf16_t* WIN = (bf16_t*)(p.ws + WS_WIN);
    const int NIN = 11600;
    add_job(p, p.w_in, WIN, DM, NIN, 0, 1024, 0);
    add_job(p, p.w_in, (bf16_t*)(p.ws + WS_W8), DM, NIN, 1280, 1024, 4096, 1);
    add_job(p, p.w_in, WIN, DM, NIN, 2304, 1024, 2048);
    add_job(p, p.w_in, WIN, DM, NIN, 3408, 1024, 3072);
    add_job(p, p.w_in, (bf16_t*)(p.ws + WS_W8), DM, NIN, 6480, 1024, 5120, 1);
    add_job(p, p.w_in, (bf16_t*)(p.ws + WS_W8), DM, NIN, 7504, 2048, 0, 1);
    add_job(p, p.w_in, (bf16_t*)(p.ws + WS_W8), DM, NIN, 9552, 2048, 2048, 1);
    add_job(p, p.w_in, WIN, DM, NIN, 4432, 1024, 9216);
    add_job(p, p.w_in, WIN, DM, NIN, 5456, 1024, 10240);
    add_job(p, p.w_in, WIN, DM, NIN, 1024, 256, 11264);
    add_job(p, p.w_in, WIN, DM, NIN, 3328, 32, 11520);
    add_job(p, p.w_in, WIN, DM, NIN, 3392, 32, 11520 + 32);
    add_job(p, p.w_in, WIN, DM, NIN, 3360, 32, 11520 + 128);
    add_job(p, p.w_o_a, (bf16_t*)(p.ws + WS_WOA), 1024, DM, 0, DM, 0);
    add_job(p, p.w_o_b, (bf16_t*)(p.ws + WS_WOB), 1024, DM, 0, DM, 0);
    add_job(p, p.w_out, (bf16_t*)(p.ws + WS_WOUT), DM, DM, 0, DM, 0);
    add_job(p, p.w_uv, (bf16_t*)(p.ws + WS_WUVT), 256, 1024, 0, 1024, 0);
    (void)hipMemsetAsync((char*)d_ws + WS_CTL, 0, CTL_BYTES, stream);
#if ONE_LAUNCH
    a.ph_lo = 0; a.ph_hi = NPHASE; a.probe = PROBE_REP;
    hipLaunchKernelGGL(k_fwd, dim3(grid), dim3(512), LDS_BYTES, stream, a);
#else
    for (int ph = 0; ph < NPHASE; ++ph) { a.ph_lo = ph; a.ph_hi = ph + 1; hipLaunchKernelGGL(k_fwd, dim3(grid), dim3(512), LDS_BYTES, stream, a); }
#endif
}
```

```cpp
#include <hip/hip_runtime.h>
#include <cstdio>
#include <cstdint>
#include <cstring>

#ifndef PROBE_REP
#define PROBE_REP (-1)
#endif
#define LAS __attribute__((address_space(3)))
#define GAS __attribute__((address_space(1)))
typedef unsigned short bf16_t;
typedef short bf16x8 __attribute__((ext_vector_type(8)));
typedef float f32x4 __attribute__((ext_vector_type(4)));
typedef unsigned u32x4 __attribute__((ext_vector_type(4)));
typedef unsigned u32x2 __attribute__((ext_vector_type(2)));
typedef int v8i32 __attribute__((ext_vector_type(8)));
typedef int v4i32 __attribute__((ext_vector_type(4)));

constexpr int DM = 2048, NB = 2, SEQ = 4096, NMETA = 16, TK = SEQ + NMETA  , MTOK = NB * SEQ  , MKEY = NB * TK  ;
constexpr int UROWS = 8448;
constexpr int NPAD = 11776;
constexpr float EPS = 1e-6f;
constexpr float LOG2E = 1.4426950408889634f;
constexpr size_t SC_PER_B = 8585216;

constexpr size_t MiB = 1u << 20;
constexpr size_t WS_CTL = 0, CTL_BYTES = 1 * MiB;
constexpr size_t WS_U = 1 * MiB;
constexpr size_t WS_WIN = 34 * MiB;
constexpr size_t WS_SC = 1 * MiB;
constexpr size_t WS_MIX = 1 * MiB;
constexpr size_t WS_WOA = 80 * MiB, WS_WOB = 84 * MiB, WS_WOUT = 88 * MiB, WS_WUK = 96 * MiB, WS_WUVT = 96 * MiB + 512 * 1024;
constexpr size_t WS_QA = 97 * MiB, WS_IQ = 113 * MiB, WS_QB = 129 * MiB, WS_ZA = 145 * MiB, WS_ZB = 161 * MiB, WS_GA = 177 * MiB, WS_GB = 209 * MiB;
constexpr size_t WS_OLAT = 241 * MiB;
constexpr size_t WS_OZA = 129 * MiB;
constexpr size_t WS_KB = 241 * MiB, WS_VB = 258 * MiB, WS_CKVRAW = 275 * MiB, WS_IKRAW = 284 * MiB, WS_IW = 287 * MiB, WS_CKV = 288 * MiB, WS_IK = 293 * MiB;
constexpr size_t WS_QLAT = 295 * MiB;
constexpr size_t WS_OUTPRE = 295 * MiB;
constexpr size_t WS_OZB = 327 * MiB, WS_SSQ = 343 * MiB, WS_U8 = 344 * MiB, WS_END = 360 * MiB;
constexpr size_t WS_W8 = WS_WIN + (size_t)5120 * 2048 * 2;

__device__ __forceinline__ int opaque_tid() { int t = threadIdx.x; asm volatile("" : "+v"(t)); return t; }
__device__ __forceinline__ float bf2f(unsigned short u) { return __uint_as_float(((unsigned)u) << 16); }
__device__ __forceinline__ unsigned f2bf(float f) { unsigned u = __float_as_uint(f); return (u + 0x7fffu + ((u >> 16) & 1u)) >> 16; }
__device__ __forceinline__ unsigned pk2(float lo, float hi) { return f2bf(lo) | (f2bf(hi) << 16); }
__device__ __forceinline__ float bflo(unsigned w) { return __uint_as_float(w << 16); }
__device__ __forceinline__ float bfhi(unsigned w) { return __uint_as_float(w & 0xffff0000u); }
__device__ __forceinline__ float wave_sum(float v) {
#pragma unroll
    for (int o = 1; o < 64; o <<= 1) v += __shfl_xor(v, o);
    return v;
}
__device__ __forceinline__ float silu_f(float x) { return x * __builtin_amdgcn_rcpf(1.f + __expf(-x)); }
__device__ __forceinline__ int t5_bucket(int rel) {
    const int n = rel < 0 ? -rel : rel; int f;
    if (n < 8) f = n; else if (n < 12) f = 8; else if (n < 16) f = 9; else if (n < 23) f = 10; else if (n < 32) f = 11; else if (n < 46) f = 12; else if (n < 64) f = 13; else if (n < 91) f = 14; else f = 15;
    return (rel > 0 ? 16 : 0) + f;
}
__device__ __forceinline__ size_t sc_off(int b, int j) {
    const int c = 1 + (j >> 6);
    return (size_t)b * SC_PER_B + (size_t)1024 * (c - 1) + (size_t)2048 * (c - 1) * c + (size_t)(j & 63) * (16 + 64 * c);
}

namespace pg8 {
constexpr int BM = 256, BK = 64, HALF = 128, HTB = HALF * BK * 2, STAGE_BYTES = 8 * HTB, NXCD = 8, WGM = 8;
__host__ __device__ __forceinline__ int lds_byte(int r, int c) { const int st = (r >> 4) * 2 + (c >> 5), rr = r & 15, cc = c & 31, ob = rr * 64 + cc * 2; return st * 1024 + (ob ^ (((ob >> 9) & 1) << 5)); }
__host__ __device__ __forceinline__ void stage_rc(int b, int& R, int& C) { const int st = b / 1024, sb = b % 1024, swz = sb ^ (((sb >> 9) & 1) << 5); R = (st >> 1) * 16 + swz / 64; C = (st & 1) * 32 + (swz % 64) / 2; }
__host__ __device__ __forceinline__ int perm32(int rho) { const int n = rho >> 4, i = rho & 15; return 8 * (i >> 2) + 4 * n + (i & 3); }

struct Unit { int pm, pn, sub; };
__device__ __forceinline__ unsigned cvt_pk_bf16(float lo, float hi) { unsigned r; asm volatile("v_cvt_pk_bf16_f32 %0, %1, %2" : "=v"(r) : "v"(lo), "v"(hi)); return r; }

__device__ __forceinline__ void tile_of(int L, int nM, int nN, int& pm, int& pn) {
    const int nwg = nM * nN; int wgid = L; { const int q = nwg / NXCD, r = nwg % NXCD, xcd = wgid % NXCD, off = wgid / NXCD; wgid = (xcd < r ? xcd * (q + 1) : r * (q + 1) + (xcd - r) * q) + off; }
    const int nig = WGM * nN, gid = wgid / nig, fm = gid * WGM, gsz = (nM - fm) < WGM ? (nM - fm) : WGM;
    pm = fm + ((wgid % nig) % gsz); pn = (wgid % nig) / gsz;
}

template <class Epi, class Sched, bool ALIGN_EPI = true, bool SP2 = true, bool FP8 = false>
__device__ __forceinline__ void gemm_phase(LAS unsigned char* lds, const Sched& S, const Epi& E) {
    const int tid = opaque_tid(), wid = __builtin_amdgcn_readfirstlane(tid >> 6), lane = tid & 63, wr = wid >> 2, wc = wid & 3, fr = lane & 15, fq = lane >> 4;
    const int K = FP8 ? S.K / 2 : S.K, nt = K / BK;
    unsigned voffA[2], voffB[2];
#pragma unroll
    for (int i = 0; i < 2; ++i) { int R, C; stage_rc(tid * 16 + i * 8192, R, C); const int Rb = Epi::PERM ? ((R & ~31) + perm32(R & 31)) : R;
        voffA[i] = (unsigned)(R * K + C) * 2u; voffB[i] = (unsigned)(Rb * K + C) * 2u; }
    const size_t kstep = (size_t)(BK * 2);
    const size_t hstep = (size_t)HALF * K * 2;
    const unsigned ldsw = (unsigned)wid * 1024u, lds0 = (unsigned)(size_t)lds;
    const int aoff = lds_byte(wr * 64 + fr, fq * 8), boff = lds_byte(wc * 32 + fr, fq * 8);
#define PG8_SA(b, h) (((b) * 2 + (h)) * HTB)
#define PG8_SB(b, h) ((4 + (b) * 2 + (h)) * HTB)
#define PG8_STAGE(bufoff, gbase, voff) do { _Pragma("unroll") for (int _i = 0; _i < 2; ++_i) { \
        if constexpr (FP8) { unsigned keep_; asm volatile("s_mov_b32 %0, m0\n\ts_mov_b32 m0, %3\n\ts_nop 0\n\tglobal_load_lds_dwordx4 %1, %2\n\ts_mov_b32 m0, %0" \
                : "=&s"(keep_) : "v"((voff)[_i]), "s"((const char*)(gbase)), "s"(lds0 + (unsigned)(bufoff) + ldsw + (unsigned)(_i * 8192)) : "memory"); } \
        else __builtin_amdgcn_global_load_lds((const unsigned*)((const char*)(gbase) + (voff)[_i]), (LAS unsigned*)(lds + (bufoff) + ldsw + _i * 8192), 16, 0, 0); } } while (0)
#define PG8_LD8(dst, addr) do { const v4i32 lo_ = *(const LAS v4i32*)(addr), hi_ = *(const LAS v4i32*)((addr) + 1024); dst = __builtin_shufflevector(lo_, hi_, 0, 1, 2, 3, 4, 5, 6, 7); } while (0)
#define PG8_LDA(dst, b, h) do { if constexpr (FP8) { _Pragma("unroll") for (int m = 0; m < 4; ++m) PG8_LD8(dst##8[m], lds + PG8_SA(b, h) + aoff + m * 2048); } else { \
        _Pragma("unroll") for (int m = 0; m < 4; ++m) _Pragma("unroll") for (int k = 0; k < 2; ++k) dst[m][k] = *(const LAS bf16x8*)(lds + PG8_SA(b, h) + aoff + m * 2048 + k * 1024); } } while (0)
#define PG8_LDB(dst, b, h) do { if constexpr (FP8) { _Pragma("unroll") for (int n = 0; n < 2; ++n) PG8_LD8(dst##8[n], lds + PG8_SB(b, h) + boff + n * 2048); } else { \
        _Pragma("unroll") for (int n = 0; n < 2; ++n) _Pragma("unroll") for (int k = 0; k < 2; ++k) dst[n][k] = *(const LAS bf16x8*)(lds + PG8_SB(b, h) + boff + n * 2048 + k * 1024); } } while (0)
#define PG8_MMA(ai, bj, At, Bt) do { __builtin_amdgcn_s_setprio(1); _Pragma("unroll") for (int m = 0; m < 4; ++m) _Pragma("unroll") for (int n = 0; n < 2; ++n) _Pragma("unroll") for (int k = 0; k < 2; ++k) \
        acc[ai][bj][m][n] = __builtin_amdgcn_mfma_f32_16x16x32_bf16(Bt[n][k], At[m][k], acc[ai][bj][m][n], 0, 0, 0); __builtin_amdgcn_s_setprio(0); } while (0)
#define PG8_MMA8(ai, bj, At, Bt) do { __builtin_amdgcn_s_setprio(1); _Pragma("unroll") for (int m = 0; m < 4; ++m) _Pragma("unroll") for (int n = 0; n < 2; ++n) \
        acc[ai][bj][m][n] = __builtin_amdgcn_mfma_scale_f32_16x16x128_f8f6f4(Bt##8[n], At##8[m], acc[ai][bj][m][n], 0, 0, 0, 0x7f7f7f7f, 0, 0x7f7f7f7f); __builtin_amdgcn_s_setprio(0); } while (0)
#define PG8_MM(ai, bj, At, Bt) do { if constexpr (FP8) PG8_MMA8(ai, bj, At, Bt); else PG8_MMA(ai, bj, At, Bt); } while (0)
#define PG8_WAIT_V(n) asm volatile("s_waitcnt vmcnt(" #n ")" ::: "memory")
#define PG8_WAIT_L(n) asm volatile("s_waitcnt lgkmcnt(" #n ")" ::: "memory")
#define PG8_BAR __builtin_amdgcn_s_barrier()
#define PG8_SCHED __builtin_amdgcn_sched_barrier(0)
    Unit cur, nxt; int ui = 0;
    if (!S.next(0, cur)) return;
    f32x4 acc[2][2][4][2];
#pragma unroll
    for (int a = 0; a < 2; ++a)
#pragma unroll
        for (int b = 0; b < 2; ++b)
#pragma unroll
            for (int m = 0; m < 4; ++m)
#pragma unroll
                for (int n = 0; n < 2; ++n) acc[a][b][m][n] = (f32x4){0.f, 0.f, 0.f, 0.f};
    bf16x8 At[4][2], B0[2][2], B1[2][2];
    v8i32 At8[4], B08[2], B18[2];
    const char* cA = S.a_ptr(cur); const char* cB = S.b_ptr(cur);
    if constexpr (SP2) {
        PG8_STAGE(PG8_SB(0, 0), cB, voffB); PG8_STAGE(PG8_SB(0, 1), cB + hstep, voffB); PG8_STAGE(PG8_SA(0, 0), cA, voffA); PG8_STAGE(PG8_SA(0, 1), cA + hstep, voffA);
        if (wr == 1) PG8_BAR;
        PG8_WAIT_V(2); PG8_BAR;
        PG8_STAGE(PG8_SB(1, 0), cB + kstep, voffB); PG8_STAGE(PG8_SA(1, 0), cA + kstep, voffA); PG8_STAGE(PG8_SB(1, 1), cB + hstep + kstep, voffB);
        PG8_WAIT_V(6); PG8_BAR;
    } else {
        PG8_STAGE(PG8_SB(0, 0), cB, voffB); PG8_STAGE(PG8_SA(0, 0), cA, voffA); PG8_STAGE(PG8_SB(0, 1), cB + hstep, voffB); PG8_STAGE(PG8_SA(0, 1), cA + hstep, voffA);
        if (wr == 1) PG8_BAR;
        PG8_WAIT_V(4); PG8_BAR;
        PG8_STAGE(PG8_SB(1, 0), cB + kstep, voffB); PG8_STAGE(PG8_SA(1, 0), cA + kstep, voffA); PG8_STAGE(PG8_SB(1, 1), cB + hstep + kstep, voffB);
        PG8_WAIT_V(6); PG8_BAR;
    }
    for (;;) {
        const bool has_next = S.next(ui + 1, nxt);
        const char* nA = has_next ? S.a_ptr(nxt) : cA; const char* nB = has_next ? S.b_ptr(nxt) : cB;
        for (int t = 0; t < nt; t += 2) {
            const bool last = (t == nt - 2);
            const char* a1 = cA + (size_t)(t + 1) * kstep;
            const char* a2 = last ? nA : cA + (size_t)(t + 2) * kstep; const char* b2 = last ? nB : cB + (size_t)(t + 2) * kstep;
            const char* a3 = a2 + kstep; const char* b3 = b2 + kstep;
            if constexpr (SP2) {
            PG8_LDB(B0, 0, 0); PG8_LDB(B1, 0, 1); PG8_SCHED; PG8_LDA(At, 0, 0); PG8_STAGE(PG8_SA(1, 1), a1 + hstep, voffA);
            PG8_WAIT_V(8); PG8_WAIT_L(0); PG8_BAR; PG8_MM(0, 0, At, B0); PG8_MM(0, 1, At, B1); PG8_BAR; PG8_SCHED;
            PG8_LDA(At, 0, 1); PG8_STAGE(PG8_SB(0, 0), b2, voffB); PG8_STAGE(PG8_SB(0, 1), b2 + hstep, voffB); PG8_STAGE(PG8_SA(0, 0), a2, voffA);
            PG8_WAIT_V(8); PG8_WAIT_L(0); PG8_BAR; PG8_MM(1, 0, At, B0); PG8_MM(1, 1, At, B1); PG8_BAR; PG8_SCHED;
            PG8_LDB(B0, 1, 0); PG8_LDB(B1, 1, 1); PG8_SCHED; PG8_LDA(At, 1, 0); PG8_STAGE(PG8_SA(0, 1), a2 + hstep, voffA);
            PG8_WAIT_V(8); PG8_WAIT_L(0); PG8_BAR; PG8_MM(0, 0, At, B0); PG8_MM(0, 1, At, B1); PG8_BAR; PG8_SCHED;
            PG8_LDA(At, 1, 1); PG8_STAGE(PG8_SB(1, 0), b3, voffB); PG8_STAGE(PG8_SB(1, 1), b3 + hstep, voffB); PG8_STAGE(PG8_SA(1, 0), a3, voffA);
            PG8_WAIT_V(8); PG8_WAIT_L(0); PG8_BAR; PG8_MM(1, 0, At, B0); PG8_MM(1, 1, At, B1); PG8_BAR; PG8_SCHED;
            } else {
            PG8_LDB(B0, 0, 0); PG8_SCHED; PG8_LDA(At, 0, 0); PG8_STAGE(PG8_SA(1, 1), a1 + hstep, voffA);
            PG8_WAIT_L(8); PG8_BAR; PG8_WAIT_L(0); PG8_MM(0, 0, At, B0); PG8_BAR; PG8_SCHED;
            PG8_LDB(B1, 0, 1); PG8_STAGE(PG8_SB(0, 0), b2, voffB);
            PG8_BAR; PG8_WAIT_L(0); PG8_MM(0, 1, At, B1); PG8_BAR;
            PG8_LDA(At, 0, 1); PG8_STAGE(PG8_SA(0, 0), a2, voffA);
            PG8_BAR; PG8_WAIT_L(0); PG8_MM(1, 0, At, B0); PG8_BAR; PG8_SCHED;
            PG8_STAGE(PG8_SB(0, 1), b2 + hstep, voffB);
            PG8_WAIT_V(6); PG8_BAR; PG8_MM(1, 1, At, B1); PG8_BAR;
            PG8_LDB(B0, 1, 0); PG8_SCHED; PG8_LDA(At, 1, 0); PG8_STAGE(PG8_SA(0, 1), a2 + hstep, voffA);
            PG8_WAIT_L(8); PG8_BAR; PG8_WAIT_L(0); PG8_MM(0, 0, At, B0); PG8_BAR; PG8_SCHED;
            PG8_LDB(B1, 1, 1); PG8_STAGE(PG8_SB(1, 0), b3, voffB);
            PG8_BAR; PG8_WAIT_L(0); PG8_MM(0, 1, At, B1); PG8_BAR;
            PG8_LDA(At, 1, 1); PG8_STAGE(PG8_SA(1, 0), a3, voffA);
            PG8_BAR; PG8_WAIT_L(0); PG8_MM(1, 0, At, B0); PG8_BAR; PG8_SCHED;
            PG8_STAGE(PG8_SB(1, 1), b3 + hstep, voffB);
            PG8_WAIT_V(6); PG8_BAR; PG8_MM(1, 1, At, B1); PG8_BAR;
            }
        }
        if constexpr (ALIGN_EPI) { if (wr == 0) PG8_BAR; }
        E(acc, cur, wr, wc, fr, fq);
        if (!has_next) break;
        if (!E.keep_acc(cur)) {
#pragma unroll
        for (int a = 0; a < 2; ++a)
#pragma unroll
            for (int b = 0; b < 2; ++b)
#pragma unroll
                for (int m = 0; m < 4; ++m)
#pragma unroll
                    for (int n = 0; n < 2; ++n) acc[a][b][m][n] = (f32x4){0.f, 0.f, 0.f, 0.f};
        }
        cur = nxt; cA = nA; cB = nB; ++ui;
        if constexpr (ALIGN_EPI) { if (wr == 1) PG8_BAR; }
    }
    PG8_WAIT_V(0);
    if constexpr (!ALIGN_EPI) { if (wr == 0) PG8_BAR; }
    PG8_BAR;
#undef PG8_SA
#undef PG8_SB
#undef PG8_STAGE
#undef PG8_LDA
#undef PG8_LDB
#undef PG8_MMA
#undef PG8_MMA8
#undef PG8_LD8
#undef PG8_MM
#undef PG8_WAIT_V
#undef PG8_WAIT_L
#undef PG8_BAR
#undef PG8_SCHED
}
}

struct SchedInproj {
    int K, G, c; const char* A; const char* B;
    __device__ __forceinline__ bool next(int i, pg8::Unit& u) const {
        const int L = i * G + c; u.sub = 0;
        if (L < 704) { int pn; pg8::tile_of(L, 32, 22, u.pm, pn); u.pn = pn < 4 ? pn : pn < 12 ? pn + 4 : pn + 24; return true; }
        if (L < 714) { u.pm = 32; u.pn = 36 + (L - 704); return true; }
        return false;
    }
    __device__ __forceinline__ const char* a_ptr(const pg8::Unit& u) const { return A + (size_t)u.pm * 256 * K * 2; }
    __device__ __forceinline__ const char* b_ptr(const pg8::Unit& u) const { return B + (size_t)u.pn * 256 * K * 2; }
};
struct SchedGate {
    int K, G, c; const char* A; const char* B;
    __device__ __forceinline__ bool next(int i, pg8::Unit& u) const {
        const int L = i * G + c; if (L >= 768) return false;
        int pn; pg8::tile_of(L, 32, 24, u.pm, pn); u.sub = pn; u.pn = pn < 16 ? 20 + pn : pn < 20 ? pn - 12 : pn - 4; return true;
    }
    __device__ __forceinline__ const char* a_ptr(const pg8::Unit& u) const { return A + (size_t)u.pm * 256 * K; }
    __device__ __forceinline__ const char* b_ptr(const pg8::Unit& u) const { return B + (size_t)u.sub * 256 * K; }
};
struct EpiInproj {
    static constexpr bool PERM = true;
    bf16_t *QA, *ZA, *IQ, *QB, *ZB, *GA, *GB, *KB, *VB; float *CKVRAW; bf16_t* IKN; float* IW; float qb_scale; const float *ikn_w, *ikn_b; float gscale;
    __device__ __forceinline__ bool keep_acc(const pg8::Unit&) const { return false; }
    __device__ __forceinline__ void operator()(f32x4 (&acc)[2][2][4][2], const pg8::Unit& u, int wr, int wc, int fr, int fq) const {
        const int pn = u.pn;
        if (pn < 44) {
            bf16_t* base; int ldc = 1024, ct, act = 0; bool kside = false;
            if (pn < 4) { base = QA; ct = pn; } else if (pn < 8) { base = ZA; ct = pn - 4; act = 1; } else if (pn < 12) { base = IQ; ct = pn - 8; }
            else if (pn < 16) { base = QB; ct = pn - 12; act = 2; } else if (pn < 20) { base = ZB; ct = pn - 16; act = 1; }
            else if (pn < 28) { base = GA; ct = pn - 20; ldc = 2048; act = 3; } else if (pn < 36) { base = GB; ct = pn - 28; ldc = 2048; act = 3; }
            else if (pn < 40) { base = KB; ct = pn - 36; kside = true; } else { base = VB; ct = pn - 40; kside = true; }
            const float sc = (act == 2) ? qb_scale : (act == 3) ? gscale : 1.f;
#pragma unroll
            for (int ai = 0; ai < 2; ++ai)
#pragma unroll
                for (int m = 0; m < 4; ++m) {
                    const int r = u.pm * 256 + ai * 128 + wr * 64 + m * 16 + fr;
                    long drow = r, drow2 = -1; bool ok = true;
                    if (kside) { if (r < MTOK) drow = (long)(r >> 12) * TK + NMETA + (r & 4095); else { const int i = r - MTOK; ok = i < NMETA; drow = i; drow2 = TK + i; } }
#pragma unroll
                    for (int bj = 0; bj < 2; ++bj) {
                        f32x4 v0 = acc[ai][bj][m][0], v1 = acc[ai][bj][m][1];
                        if (act == 1) {
#pragma unroll
                            for (int e = 0; e < 4; ++e) { v0[e] = silu_f(v0[e]); v1[e] = silu_f(v1[e]); }
                        }
                        v0 = v0 * sc; v1 = v1 * sc;
                        u32x4 w; w.x = pg8::cvt_pk_bf16(v0[0], v0[1]); w.y = pg8::cvt_pk_bf16(v0[2], v0[3]); w.z = pg8::cvt_pk_bf16(v1[0], v1[1]); w.w = pg8::cvt_pk_bf16(v1[2], v1[3]);
                        const int col = ct * 256 + bj * 128 + wc * 32 + 8 * fq;
                        if (ok) { *(u32x4*)(base + (size_t)drow * ldc + col) = w; if (drow2 >= 0) *(u32x4*)(base + (size_t)drow2 * ldc + col) = w; }
                    }
                }
        } else {
#pragma unroll
            for (int ai = 0; ai < 2; ++ai)
#pragma unroll
                for (int m = 0; m < 4; ++m) {
                    const int r = u.pm * 256 + ai * 128 + wr * 64 + m * 16 + fr;
                    long drow, drow2 = -1; bool ok = true;
                    if (r < MTOK) drow = (long)(r >> 12) * TK + NMETA + (r & 4095); else { const int i = r - MTOK; ok = i < NMETA; drow = i; drow2 = TK + i; }
                    if (pn == 44) {
#pragma unroll
                        for (int bj = 0; bj < 2; ++bj) {
                            const f32x4 v0 = acc[ai][bj][m][0], v1 = acc[ai][bj][m][1];
                            const int col = bj * 128 + wc * 32 + 8 * fq;
                            if (ok) { float* p = CKVRAW + (size_t)drow * 256 + col; *(f32x4*)p = v0; *(f32x4*)(p + 4) = v1;
                                      if (drow2 >= 0) { float* p2 = CKVRAW + (size_t)drow2 * 256 + col; *(f32x4*)p2 = v0; *(f32x4*)(p2 + 4) = v1; } }
                        }
                    } else if (wc == 0) {
                        const f32x4 a0 = acc[ai][0][m][0], a1 = acc[ai][0][m][1], b0 = acc[ai][1][m][0], b1 = acc[ai][1][m][1];
                        float s = ((a0[0] + a0[1]) + (a0[2] + a0[3])) + ((a1[0] + a1[1]) + (a1[2] + a1[3])) + ((b0[0] + b0[1]) + (b0[2] + b0[3])) + ((b1[0] + b1[1]) + (b1[2] + b1[3]));
                        s += __shfl_xor(s, 16); s += __shfl_xor(s, 32);
                        const float mu = s * (1.f / 64.f);
                        const f32x4 da0 = a0 - mu, da1 = a1 - mu, db0 = b0 - mu, db1 = b1 - mu;
                        float q = ((da0[0] * da0[0] + da0[1] * da0[1]) + (da0[2] * da0[2] + da0[3] * da0[3])) + ((da1[0] * da1[0] + da1[1] * da1[1]) + (da1[2] * da1[2] + da1[3] * da1[3]))
                                + ((db0[0] * db0[0] + db0[1] * db0[1]) + (db0[2] * db0[2] + db0[3] * db0[3])) + ((db1[0] * db1[0] + db1[1] * db1[1]) + (db1[2] * db1[2] + db1[3] * db1[3]));
                        q += __shfl_xor(q, 16); q += __shfl_xor(q, 32);
                        const float rs = rsqrtf(q * (1.f / 64.f) + EPS);
                        const f32x4 wa0 = *(const f32x4*)(ikn_w + 8 * fq), wa1 = *(const f32x4*)(ikn_w + 8 * fq + 4), wb0 = *(const f32x4*)(ikn_w + 32 + 8 * fq), wb1 = *(const f32x4*)(ikn_w + 36 + 8 * fq);
                        const f32x4 ba0 = *(const f32x4*)(ikn_b + 8 * fq), ba1 = *(const f32x4*)(ikn_b + 8 * fq + 4), bb0 = *(const f32x4*)(ikn_b + 32 + 8 * fq), bb1 = *(const f32x4*)(ikn_b + 36 + 8 * fq);
                        const f32x4 ya0 = da0 * rs * wa0 + ba0, ya1 = da1 * rs * wa1 + ba1, yb0 = db0 * rs * wb0 + bb0, yb1 = db1 * rs * wb1 + bb1;
                        u32x4 pa, pb;
                        pa.x = pg8::cvt_pk_bf16(ya0[0], ya0[1]); pa.y = pg8::cvt_pk_bf16(ya0[2], ya0[3]); pa.z = pg8::cvt_pk_bf16(ya1[0], ya1[1]); pa.w = pg8::cvt_pk_bf16(ya1[2], ya1[3]);
                        pb.x = pg8::cvt_pk_bf16(yb0[0], yb0[1]); pb.y = pg8::cvt_pk_bf16(yb0[2], yb0[3]); pb.z = pg8::cvt_pk_bf16(yb1[0], yb1[1]); pb.w = pg8::cvt_pk_bf16(yb1[2], yb1[3]);
                        if (ok) { *(u32x4*)(IKN + (size_t)drow * 64 + 8 * fq) = pa; *(u32x4*)(IKN + (size_t)drow * 64 + 32 + 8 * fq) = pb;
                                  if (drow2 >= 0) { *(u32x4*)(IKN + (size_t)drow2 * 64 + 8 * fq) = pa; *(u32x4*)(IKN + (size_t)drow2 * 64 + 32 + 8 * fq) = pb; } }
                    } else if (wc == 1) {
                        const f32x4 v0 = acc[ai][0][m][0], v1 = acc[ai][0][m][1];
                        if (fq < 2 && r < MTOK) { float* p = IW + (size_t)r * 16 + 8 * fq; *(f32x4*)p = v0 * 0.03125f; *(f32x4*)(p + 4) = v1 * 0.03125f; }
                    }
                }
        }
    }
};
struct EpiGate {
    static constexpr bool PERM = true;
    bf16_t *GA, *GB, *ZA, *ZB;
    __device__ __forceinline__ bool keep_acc(const pg8::Unit&) const { return false; }
    __device__ __forceinline__ void operator()(f32x4 (&acc)[2][2][4][2], const pg8::Unit& u, int wr, int wc, int fr, int fq) const {
        const int pn = u.pn; const bool zt = pn < 20; const int ldc = zt ? 1024 : DM;
        bf16_t* base = (pn < 8 ? ZA + (pn - 4) * 256 : pn < 20 ? ZB + (pn - 16) * 256 : pn < 28 ? GA + (pn - 20) * 256 : GB + (pn - 28) * 256) + (size_t)(u.pm * 256 + wr * 64 + fr) * ldc + wc * 32 + 8 * fq;
#pragma unroll
        for (int ai = 0; ai < 2; ++ai)
#pragma unroll
            for (int m = 0; m < 4; ++m)
#pragma unroll
                for (int bj = 0; bj < 2; ++bj) {
                    f32x4 v0 = acc[ai][bj][m][0] * 0.015625f, v1 = acc[ai][bj][m][1] * 0.015625f;
                    if (zt) {
#pragma unroll
                        for (int e = 0; e < 4; ++e) { v0[e] = silu_f(v0[e]); v1[e] = silu_f(v1[e]); }
                    }
                    u32x4 w; w.x = pg8::cvt_pk_bf16(v0[0], v0[1]); w.y = pg8::cvt_pk_bf16(v0[2], v0[3]); w.z = pg8::cvt_pk_bf16(v1[0], v1[1]); w.w = pg8::cvt_pk_bf16(v1[2], v1[3]);
                    *(u32x4*)(base + (size_t)(ai * 128 + m * 16) * ldc + bj * 128) = w;
                }
    }
};
struct SchedMix {
    int K, G, c; const char *A0, *B0, *A1, *B1;
    __device__ __forceinline__ bool next(int i, pg8::Unit& u) const {
        const int L = (i >> 1) * G + c; if (L >= 256) return false;
        pg8::tile_of(L, 32, 8, u.pm, u.pn); u.sub = i & 1; return true;
    }
    __device__ __forceinline__ const char* a_ptr(const pg8::Unit& u) const { return (u.sub ? A1 : A0) + (size_t)u.pm * 256 * K * 2; }
    __device__ __forceinline__ const char* b_ptr(const pg8::Unit& u) const { return (u.sub ? B1 : B0) + (size_t)u.pn * 256 * K * 2; }
};
struct EpiMix {
    static constexpr bool PERM = true;
    const bf16_t *GA, *GB; bf16_t* MIX;
    __device__ __forceinline__ bool keep_acc(const pg8::Unit& u) const { return u.sub == 0; }
    static __device__ __forceinline__ float sg_e(float a) { return __expf(-fminf(fmaxf(a, -30.f), 30.f)); }
    __device__ __forceinline__ void operator()(f32x4 (&acc)[2][2][4][2], const pg8::Unit& u, int wr, int wc, int fr, int fq) const {
        const size_t base = (size_t)(u.pm * 256 + wr * 64 + fr) * DM + u.pn * 256 + wc * 32 + 8 * fq;
        if (u.sub == 0) {
#pragma unroll
            for (int ai = 0; ai < 2; ++ai) {
                u32x4 ga[4][2], gb[4][2];
#pragma unroll
                for (int m = 0; m < 4; ++m)
#pragma unroll
                    for (int bj = 0; bj < 2; ++bj) { const size_t o = base + (size_t)(ai * 128 + m * 16) * DM + bj * 128; ga[m][bj] = *(const u32x4*)(GA + o); gb[m][bj] = *(const u32x4*)(GB + o); }
#pragma unroll
                for (int m = 0; m < 4; ++m)
#pragma unroll
                    for (int bj = 0; bj < 2; ++bj)
#pragma unroll
                        for (int e = 0; e < 4; ++e) {
                            const unsigned wa = ga[m][bj][e], wb = gb[m][bj][e];
                            const float f0 = (1.f + sg_e(bflo(wb))) * __builtin_amdgcn_rcpf(1.f + sg_e(bflo(wa))), f1 = (1.f + sg_e(bfhi(wb))) * __builtin_amdgcn_rcpf(1.f + sg_e(bfhi(wa)));
                            const int n = e >> 1, j = (e & 1) * 2;
                            acc[ai][bj][m][n][j] *= f0; acc[ai][bj][m][n][j + 1] *= f1;
                        }
            }
        } else {
            u32x4 gb[2][4][2];
#pragma unroll
            for (int m = 0; m < 4; ++m)
#pragma unroll
                for (int bj = 0; bj < 2; ++bj) gb[0][m][bj] = *(const u32x4*)(GB + base + (size_t)(m * 16) * DM + bj * 128);
#pragma unroll
            for (int ai = 0; ai < 2; ++ai) {
                if (ai == 0) {
#pragma unroll
                    for (int m = 0; m < 4; ++m)
#pragma unroll
                        for (int bj = 0; bj < 2; ++bj) gb[1][m][bj] = *(const u32x4*)(GB + base + (size_t)(128 + m * 16) * DM + bj * 128);
                }
#pragma unroll
                for (int m = 0; m < 4; ++m)
#pragma unroll
                    for (int bj = 0; bj < 2; ++bj) {
                        float v[8];
#pragma unroll
                        for (int e = 0; e < 4; ++e) {
                            const unsigned wb = gb[ai][m][bj][e]; const int n = e >> 1, j = (e & 1) * 2;
                            v[2 * e] = acc[ai][bj][m][n][j] * __builtin_amdgcn_rcpf(1.f + sg_e(bflo(wb))); v[2 * e + 1] = acc[ai][bj][m][n][j + 1] * __builtin_amdgcn_rcpf(1.f + sg_e(bfhi(wb)));
                        }
                        u32x4 w; w.x = pg8::cvt_pk_bf16(v[0], v[1]); w.y = pg8::cvt_pk_bf16(v[2], v[3]); w.z = pg8::cvt_pk_bf16(v[4], v[5]); w.w = pg8::cvt_pk_bf16(v[6], v[7]);
                        *(u32x4*)(MIX + base + (size_t)(ai * 128 + m * 16) * DM + bj * 128) = w;
                    }
            }
        }
    }
};
struct SchedOut {
    int K, G, c; const char *A, *B;
    __device__ __forceinline__ bool next(int i, pg8::Unit& u) const { const int L = i * G + c; if (L >= 256) return false; pg8::tile_of(L, 32, 8, u.pm, u.pn); u.sub = 0; return true; }
    __device__ __forceinline__ const char* a_ptr(const pg8::Unit& u) const { return A + (size_t)u.pm * 256 * K * 2; }
    __device__ __forceinline__ const char* b_ptr(const pg8::Unit& u) const { return B + (size_t)u.pn * 256 * K * 2; }
};
struct EpiOut {
    static constexpr bool PERM = true;
    bf16_t* OUTPRE; float* SSQ;
    __device__ __forceinline__ bool keep_acc(const pg8::Unit&) const { return false; }
    __device__ __forceinline__ void operator()(f32x4 (&acc)[2][2][4][2], const pg8::Unit& u, int wr, int wc, int fr, int fq) const {
#pragma unroll
        for (int ai = 0; ai < 2; ++ai)
#pragma unroll
            for (int m = 0; m < 4; ++m) {
                const int r = u.pm * 256 + ai * 128 + wr * 64 + m * 16 + fr; float ss = 0.f;
#pragma unroll
                for (int bj = 0; bj < 2; ++bj) {
                    const f32x4 v0 = acc[ai][bj][m][0], v1 = acc[ai][bj][m][1];
                    ss += (v0[0] * v0[0] + v0[1] * v0[1]) + (v0[2] * v0[2] + v0[3] * v0[3]) + (v1[0] * v1[0] + v1[1] * v1[1]) + (v1[2] * v1[2] + v1[3] * v1[3]);
                    u32x4 w; w.x = pg8::cvt_pk_bf16(v0[0], v0[1]); w.y = pg8::cvt_pk_bf16(v0[2], v0[3]); w.z = pg8::cvt_pk_bf16(v1[0], v1[1]); w.w = pg8::cvt_pk_bf16(v1[2], v1[3]);
                    *(u32x4*)(OUTPRE + (size_t)r * DM + u.pn * 256 + bj * 128 + wc * 32 + 8 * fq) = w;
                }
                ss += __shfl_xor(ss, 16); ss += __shfl_xor(ss, 32);
                if (fq == 0) SSQ[(size_t)r * 32 + u.pn * 4 + wc] = ss;
            }
    }
};

struct EpiOutFused {
    static constexpr bool PERM = false;
    const float* x; const float* post_w; float* out; float* SSQ; unsigned* cnt; LAS unsigned char* lds;
    __device__ __forceinline__ bool keep_acc(const pg8::Unit&) const { return false; }
    __device__ __forceinline__ void operator()(f32x4 (&acc)[2][2][4][2], const pg8::Unit& u, int wr, int wc, int fr, int fq) const {
        const int tid = opaque_tid(), wid = __builtin_amdgcn_readfirstlane(tid >> 6), lane = tid & 63;
        LAS float* S = (LAS float*)(lds + 131072);
#pragma unroll
        for (int ai = 0; ai < 2; ++ai)
#pragma unroll
            for (int m = 0; m < 4; ++m) {
                float ss = 0.f;
#pragma unroll
                for (int bj = 0; bj < 2; ++bj)
#pragma unroll
                    for (int n = 0; n < 2; ++n) { const f32x4 v = acc[ai][bj][m][n]; ss += (v[0] * v[0] + v[1] * v[1]) + (v[2] * v[2] + v[3] * v[3]); }
                ss += __shfl_xor(ss, 16); ss += __shfl_xor(ss, 32);
                if (fq == 0) __hip_atomic_store(SSQ + (size_t)(u.pm * 256 + ai * 128 + wr * 64 + m * 16 + fr) * 32 + u.pn * 4 + wc, ss, __ATOMIC_RELAXED, __HIP_MEMORY_SCOPE_AGENT);
            }
        asm volatile("s_waitcnt vmcnt(0)" ::: "memory");
        if (lane == 0) __hip_atomic_fetch_add(cnt + 64 * u.pm, 1u, __ATOMIC_RELAXED, __HIP_MEMORY_SCOPE_AGENT);
        if (wid == 0) {
            for (unsigned it = 0; it < (1u << 22); ++it) {
                if ((unsigned)__builtin_amdgcn_readfirstlane(__hip_atomic_load(cnt + 64 * u.pm, __ATOMIC_RELAXED, __HIP_MEMORY_SCOPE_AGENT)) >= 64u) break;
                __builtin_amdgcn_s_sleep(2);
            }
            __builtin_amdgcn_fence(__ATOMIC_ACQUIRE, "agent");
        }
        asm volatile("s_waitcnt vmcnt(0) lgkmcnt(0)" ::: "memory"); __builtin_amdgcn_s_barrier(); asm volatile("" ::: "memory");
        if (tid < 256) {
            const unsigned long long* slot = (const unsigned long long*)(SSQ + (size_t)(u.pm * 256 + tid) * 32); float s = 0.f;
#pragma unroll
            for (int t = 0; t < 16; ++t) { const unsigned long long w = __hip_atomic_load(slot + t, __ATOMIC_RELAXED, __HIP_MEMORY_SCOPE_AGENT); s += __uint_as_float((unsigned)w) + __uint_as_float((unsigned)(w >> 32)); }
            S[tid] = rsqrtf(s * (1.f / DM) + EPS);
        }
        asm volatile("s_waitcnt lgkmcnt(0)" ::: "memory"); __builtin_amdgcn_s_barrier(); asm volatile("" ::: "memory");
        const f32x4 g = *(const f32x4*)(post_w + u.pn * 256 + 4 * lane);
        const int lr0 = 4 * wid;
        const size_t gbase = (size_t)(u.pm * 256 + (lr0 >> 4) * 64 + (lr0 & 15)) * DM + u.pn * 256 + 4 * lane;
        const unsigned woff = (unsigned)((wr * 16 + fr) * 1040 + (wc * 32 + 4 * fq) * 4), roff = (unsigned)(lr0 * 1040 + lane * 16);
        f32x4 xv[4], xn[4];
#pragma unroll
        for (int q = 0; q < 4; ++q) xv[q] = __builtin_nontemporal_load((const f32x4*)(x + gbase + (size_t)q * DM));
#pragma unroll
        for (int s = 0; s < 8; ++s) {
            const int ai = s >> 2, m = s & 3; LAS unsigned char* T = lds + (s & 1) * 33280;
            const float rs = S[ai * 128 + wr * 64 + m * 16 + fr];
#pragma unroll
            for (int bj = 0; bj < 2; ++bj)
#pragma unroll
                for (int n = 0; n < 2; ++n) *(LAS f32x4*)(T + woff + bj * 512 + n * 64) = acc[ai][bj][m][n] * rs;
            if (s < 7) {
                const size_t o2 = (size_t)(((s + 1) >> 2) * 128 + ((s + 1) & 3) * 16) * DM;
#pragma unroll
                for (int q = 0; q < 4; ++q) xn[q] = __builtin_nontemporal_load((const f32x4*)(x + gbase + o2 + (size_t)q * DM));
            }
            asm volatile("s_waitcnt lgkmcnt(0)" ::: "memory"); __builtin_amdgcn_s_barrier(); asm volatile("" ::: "memory");
            const size_t o1 = (size_t)(ai * 128 + m * 16) * DM;
#pragma unroll
            for (int q = 0; q < 4; ++q) { const f32x4 v = *(const LAS f32x4*)(T + roff + q * 1040); __builtin_nontemporal_store(xv[q] + v * g, (f32x4*)(out + gbase + o1 + (size_t)q * DM)); }
#pragma unroll
            for (int q = 0; q < 4; ++q) xv[q] = xn[q];
        }
    }
};

struct TJob { const float* src; bf16_t* dst; int K, N, col0, nblk, row0, item0, fp8, pad_; };
struct Params {
    const float *x, *meta, *rel_bias, *pre_w, *w_in, *kv_norm_w, *w_uk, *w_uv, *ikn_w, *ikn_b, *lam_p, *subln_w, *w_o_a, *w_o_b, *w_out, *post_w;
    float* out; unsigned char* ws;
    TJob jobs[17]; int njobs, nitems;
};
#define WSP(T, off) ((T*)(p.ws + (off)))

__device__ __forceinline__ void p0_transpose_item(const TJob& jb, LAS float* scr, int item, int lane) {
    const int kb = item / jb.nblk, nb = item % jb.nblk, k0 = 64 * kb, n0 = jb.col0 + 32 * nb;
#pragma unroll 8
    for (int i = 0; i < 32; ++i) { const int kk = 2 * i + (lane >> 5); scr[kk * 33 + (lane & 31)] = __builtin_nontemporal_load(jb.src + (size_t)(k0 + kk) * jb.N + n0 + (lane & 31)); }
    asm volatile("s_waitcnt lgkmcnt(0)" ::: "memory");
    const int c = lane & 7;
#pragma unroll
    for (int j = 0; j < 4; ++j) { const int n = (lane >> 3) + 8 * j; const LAS float* s = scr + (8 * c) * 33 + n;
        u32x4 o; o.x = pk2(s[0 * 33], s[1 * 33]); o.y = pk2(s[2 * 33], s[3 * 33]); o.z = pk2(s[4 * 33], s[5 * 33]); o.w = pk2(s[6 * 33], s[7 * 33]);
        if (!jb.fp8) *(u32x4*)(jb.dst + (size_t)(jb.row0 + 32 * nb + n) * jb.K + k0 + 8 * c) = o;
        else { int w0 = __builtin_amdgcn_cvt_pk_fp8_f32(s[0 * 33] * 64.f, s[1 * 33] * 64.f, 0, false); w0 = __builtin_amdgcn_cvt_pk_fp8_f32(s[2 * 33] * 64.f, s[3 * 33] * 64.f, w0, true);
               int w1 = __builtin_amdgcn_cvt_pk_fp8_f32(s[4 * 33] * 64.f, s[5 * 33] * 64.f, 0, false); w1 = __builtin_amdgcn_cvt_pk_fp8_f32(s[6 * 33] * 64.f, s[7 * 33] * 64.f, w1, true);
               u32x2 o8; o8.x = (unsigned)w0; o8.y = (unsigned)w1; *(u32x2*)((unsigned char*)jb.dst + (size_t)(jb.row0 + 32 * nb + n) * jb.K + k0 + 8 * c) = o8; } }
    asm volatile("s_waitcnt lgkmcnt(0)" ::: "memory");
}
__device__ __forceinline__ void p0_norm_row(const float* xrow, const float* g, bf16_t* orow, unsigned char* o8row, int lane) {
    const f32x4* xr = (const f32x4*)xrow + lane; const f32x4* gr = (const f32x4*)g + lane;
    f32x4 v[8]; float s = 0.f;
#pragma unroll
    for (int j = 0; j < 8; ++j) { v[j] = __builtin_nontemporal_load(xr + 64 * j); s += (v[j].x * v[j].x + v[j].y * v[j].y) + (v[j].z * v[j].z + v[j].w * v[j].w); }
    const float rstd = rsqrtf(wave_sum(s) * (1.f / DM) + EPS);
    u32x2* o8 = (u32x2*)orow + lane;
#pragma unroll
    for (int j = 0; j < 8; ++j) { const f32x4 gg = gr[64 * j]; const float y0 = v[j].x * rstd * gg.x, y1 = v[j].y * rstd * gg.y, y2 = v[j].z * rstd * gg.z, y3 = v[j].w * rstd * gg.w;
        u32x2 w; w.x = pk2(y0, y1); w.y = pk2(y2, y3); o8[64 * j] = w;
        if (o8row) { int q = __builtin_amdgcn_cvt_pk_fp8_f32(y0, y1, 0, false); q = __builtin_amdgcn_cvt_pk_fp8_f32(y2, y3, q, true); ((unsigned*)o8row)[64 * j + lane] = (unsigned)q; } }
}
__device__ __forceinline__ void phase0(const Params& p, LAS unsigned char* lds, int gw, int ngw, int wave, int lane, int item_lo, int item_hi) {
    LAS float* scr = (LAS float*)(lds + wave * 16384);
    for (int it = gw + item_lo; it < item_hi; it += ngw) {
        int jn = 0;
#pragma unroll
        for (int q = 1; q < 17; ++q) if (q < p.njobs && it >= p.jobs[q].item0) jn = q;
        p0_transpose_item(p.jobs[jn], scr, it - p.jobs[jn].item0, lane);
    }
    if (item_lo != 0) return;
    bf16_t* U = WSP(bf16_t, WS_U);
    for (int m = gw; m < UROWS; m += ngw) {
        if (m < MTOK) p0_norm_row(p.x + (size_t)m * DM, p.pre_w, U + (size_t)m * DM, WSP(unsigned char, WS_U8) + (size_t)m * DM, lane);
        else if (m < MTOK + NMETA) p0_norm_row(p.meta + (size_t)(m - MTOK) * DM, p.pre_w, U + (size_t)m * DM, nullptr, lane);
        else { u32x4* o = (u32x4*)(U + (size_t)m * DM) + lane;
#pragma unroll
            for (int j = 0; j < 4; ++j) o[64 * j] = (u32x4){0u, 0u, 0u, 0u}; }
    }
    bf16_t* WUK = WSP(bf16_t, WS_WUK);
    for (int i = gw * 64 + lane; i < 262144 / 4; i += ngw * 64) { const f32x4 v = ((const f32x4*)p.w_uk)[i]; u32x2 w; w.x = pk2(v.x, v.y); w.y = pk2(v.z, v.w); ((u32x2*)WUK)[i] = w; }
}

__device__ __forceinline__ void phase_ckvnorm(const Params& p, int gw, int ngw, int lane) {
    const float* CKVRAW = WSP(const float, WS_CKVRAW); bf16_t* CKV = WSP(bf16_t, WS_CKV);
    for (int r = gw; r < MKEY; r += ngw) {
        const f32x4 v = ((const f32x4*)(CKVRAW + (size_t)r * 256))[lane];
        const float ss = wave_sum((v.x * v.x + v.y * v.y) + (v.z * v.z + v.w * v.w));
        const float rstd = rsqrtf(ss * (1.f / 256.f) + EPS);
        const f32x4 g = ((const f32x4*)p.kv_norm_w)[lane];
        int w = __builtin_amdgcn_cvt_pk_fp8_f32(v.x * rstd * g.x, v.y * rstd * g.y, 0, false); w = __builtin_amdgcn_cvt_pk_fp8_f32(v.z * rstd * g.z, v.w * rstd * g.w, w, true);
        ((unsigned*)((unsigned char*)CKV + (size_t)r * 256))[lane] = (unsigned)w;
    }
}

__device__ __forceinline__ void phase7(const Params& p, int gw, int ngw, int lane) {
    const bf16_t* OUTPRE = WSP(const bf16_t, WS_OUTPRE); const float* SSQ = WSP(const float, WS_SSQ);
    for (int r = gw; r < MTOK; r += ngw) {
        float s = (lane < 32) ? SSQ[(size_t)r * 32 + lane] : 0.f; s = wave_sum(s);
        const float rstd = rsqrtf(s * (1.f / DM) + EPS);
        const u32x4* o = (const u32x4*)(OUTPRE + (size_t)r * DM); const f32x4* xr = (const f32x4*)(p.x + (size_t)r * DM); const f32x4* g = (const f32x4*)p.post_w; f32x4* out = (f32x4*)(p.out + (size_t)r * DM);
#pragma unroll
        for (int j = 0; j < 4; ++j) {
            const int ch = 64 * j + lane;
            const u32x4 w = o[ch]; const f32x4 x0 = __builtin_nontemporal_load(xr + 2 * ch), x1 = __builtin_nontemporal_load(xr + 2 * ch + 1), g0 = g[2 * ch], g1 = g[2 * ch + 1];
            f32x4 y0, y1;
            y0.x = x0.x + bflo(w.x) * rstd * g0.x; y0.y = x0.y + bfhi(w.x) * rstd * g0.y; y0.z = x0.z + bflo(w.y) * rstd * g0.z; y0.w = x0.w + bfhi(w.y) * rstd * g0.w;
            y1.x = x1.x + bflo(w.z) * rstd * g1.x; y1.y = x1.y + bfhi(w.z) * rstd * g1.y; y1.z = x1.z + bflo(w.w) * rstd * g1.z; y1.w = x1.w + bfhi(w.w) * rstd * g1.w;
            out[2 * ch] = y0; out[2 * ch + 1] = y1;
        }
    }
}

typedef short v4i16_t __attribute__((ext_vector_type(4)));
typedef float f32x2_t __attribute__((ext_vector_type(2))); typedef __bf16 bf16x2_t __attribute__((ext_vector_type(2)));
__device__ __forceinline__ unsigned cvtpk_s(float lo, float hi) { const f32x2_t v = {lo, hi}; const bf16x2_t b = __builtin_convertvector(v, bf16x2_t); return __builtin_bit_cast(unsigned, b); }
__device__ __forceinline__ unsigned off_b(unsigned row, unsigned ch) { const unsigned f = ((row >> 3) & 1u) | ((((row >> 2) ^ (row >> 3)) & 1u) << 1) | (((row >> 1) & 1u) << 2) | ((row & 1u) << 3); return 256u * row + 16u * (ch ^ f); }
__device__ __forceinline__ bf16x8 tr_frag(LAS unsigned char* img, unsigned a0, unsigned a1) {
    const v4i16_t lo = __builtin_amdgcn_ds_read_tr16_b64_v4i16((LAS v4i16_t*)(img + a0));
    const v4i16_t hi = __builtin_amdgcn_ds_read_tr16_b64_v4i16((LAS v4i16_t*)(img + a1));
    return (bf16x8){lo[0], lo[1], lo[2], lo[3], hi[0], hi[1], hi[2], hi[3]};
}
__device__ __forceinline__ void glds16(const void* gsrc, unsigned lds_dst) {
    unsigned keep;
    asm volatile("s_mov_b32 %0, m0\n\ts_mov_b32 m0, %2\n\ts_nop 0\n\tglobal_load_lds_dwordx4 %1, off\n\ts_mov_b32 m0, %0" : "=&s"(keep) : "v"(gsrc), "s"(lds_dst) : "memory");
}
constexpr int DB_K = 0, DB_V = 49152, DB_LUT = 98304, DB_Q = 99328;
constexpr float DIFF_THR = 24.0f;
__device__ __forceinline__ void diff_unit(const Params& p, LAS unsigned char* lds, int b, int h, int qb, float lam) {
    const bf16_t* QB = WSP(const bf16_t, WS_QB); const bf16_t* KB = WSP(const bf16_t, WS_KB); const bf16_t* VB = WSP(const bf16_t, WS_VB); const bf16_t* ZB = WSP(const bf16_t, WS_ZB); bf16_t* OZB = WSP(bf16_t, WS_OZB);
    const int tid = opaque_tid(), lane = tid & 63, wave = __builtin_amdgcn_readfirstlane(tid >> 6), l15 = lane & 15, g = lane >> 4;
    const int jw = 128 * qb + 16 * wave, jq = jw + l15, cw = 2 * qb + 1 + (wave >> 2), ntiles = 2 * qb + 3;
    LAS float* LUT = (LAS float*)(lds + DB_LUT);
    __syncthreads();
    if (tid < 155) LUT[tid] = p.rel_bias[t5_bucket(tid - 91) * 16 + 8 + h] * LOG2E;
    LAS unsigned char* Qimg = lds + DB_Q + wave * 4096;
    { const bf16_t* qp = QB + (size_t)(b * SEQ + jq) * 1024 + h * 128 + 8 * g;
#pragma unroll
      for (int s = 0; s < 4; ++s) *(LAS bf16x8*)(Qimg + off_b((unsigned)l15, 4u * s + (unsigned)g)) = *(const bf16x8*)(qp + 32 * s); }
    size_t dsrc[2];
#pragma unroll
    for (int i = 0; i < 2; ++i) { const unsigned row = 8u * wave + 4u * i + (unsigned)(lane >> 4); const unsigned f = (off_b(row & 15u, 0u) >> 4) & 15u;
        dsrc[i] = (size_t)row * 1024 + h * 128 + (((unsigned)(lane & 15)) ^ f) * 8; }
    const unsigned ddst = 2048u * wave;
    const unsigned lds0 = (unsigned)(size_t)lds;
#define DF_ROW0(tt) ((size_t)b * TK + ((tt) == 0 ? 0 : 16 + 64 * ((tt) - 1)))
#define DF_DMAK(tt, slot) do { const bf16_t* g_ = KB + DF_ROW0(tt) * 1024; _Pragma("unroll") for (int i_ = 0; i_ < 2; ++i_) \
        glds16(g_ + dsrc[i_], (unsigned)__builtin_amdgcn_readfirstlane((int)(lds0 + DB_K + (slot) * 16384 + ddst + 1024 * i_))); } while (0)
#define DF_DMAV(tt, slot) do { const bf16_t* g_ = VB + DF_ROW0(tt) * 1024; _Pragma("unroll") for (int i_ = 0; i_ < 2; ++i_) \
        glds16(g_ + dsrc[i_], (unsigned)__builtin_amdgcn_readfirstlane((int)(lds0 + DB_V + (slot) * 16384 + ddst + 1024 * i_))); } while (0)
#define DF_WAITBAR(n) do { if ((n) >= 4) asm volatile("s_waitcnt vmcnt(4) lgkmcnt(0)" ::: "memory"); else if ((n) >= 2) asm volatile("s_waitcnt vmcnt(2) lgkmcnt(0)" ::: "memory"); \
        else asm volatile("s_waitcnt vmcnt(0) lgkmcnt(0)" ::: "memory"); __builtin_amdgcn_s_barrier(); asm volatile("" ::: "memory"); } while (0)
    const unsigned q4 = (unsigned)l15 >> 2, pp = (unsigned)l15 & 3u;
    unsigned kbase[2][2], vbase[8];
#pragma unroll
    for (int mp = 0; mp < 2; ++mp)
#pragma unroll
        for (int s = 0; s < 2; ++s) kbase[mp][s] = off_b((unsigned)l15, 8u * mp + 4u * s + (unsigned)g);
#pragma unroll
    for (int c = 0; c < 8; ++c) vbase[c] = off_b(4u * g + q4, 2u * c + (pp >> 1)) + 8u * (pp & 1u);

    float m1 = 0.f, m2 = 0.f;
    f32x4 O1[8], O2[8], OL1 = (f32x4){0.f, 0.f, 0.f, 0.f}, OL2 = (f32x4){0.f, 0.f, 0.f, 0.f};
    const short one_ = (l15 == 0) ? (short)0x3F80 : (short)0;
    const bf16x8 onesf = (bf16x8){one_, one_, one_, one_, one_, one_, one_, one_};
#pragma unroll
    for (int c = 0; c < 8; ++c) { O1[c] = (f32x4){0.f, 0.f, 0.f, 0.f}; O2[c] = (f32x4){0.f, 0.f, 0.f, 0.f}; }
    f32x4 S1[4], S2[4];
    bf16x8 pa1[2], pa2[2];
    float es1 = 1.f, es2 = 1.f; bool pending = false;
    f32x4 cn1 = (f32x4){0.f, 0.f, 0.f, 0.f}, cn2 = cn1, cf1 = cn1, cf2 = cn1;

#define DF_QK(tt, kbo_) do { LAS unsigned char* Kb_ = lds + DB_K + (kbo_); \
        const int dmin_ = ((tt) == 0) ? (jw + 1) : (jw - 64 * (tt) + 1); const bool near_ = dmin_ < 91; \
        const f32x4 ci1_ = near_ ? cn1 : cf1, ci2_ = near_ ? cn2 : cf2;        \
        _Pragma("unroll") for (int s = 0; s < 2; ++s) { const bf16x8 q1_ = *(const LAS bf16x8*)(Qimg + kbase[0][s]), q2_ = *(const LAS bf16x8*)(Qimg + kbase[1][s]); \
          bf16x8 ka1_[4], ka2_[4]; \
          _Pragma("unroll") for (int mb = 0; mb < 4; ++mb) { ka1_[mb] = *(const LAS bf16x8*)(Kb_ + kbase[0][s] + 4096 * mb); ka2_[mb] = *(const LAS bf16x8*)(Kb_ + kbase[1][s] + 4096 * mb); } \
          __builtin_amdgcn_sched_barrier(0); \
          _Pragma("unroll") for (int mb = 0; mb < 4; ++mb) { \
            S1[mb] = __builtin_amdgcn_mfma_f32_16x16x32_bf16(ka1_[mb], q1_, s == 0 ? ci1_ : S1[mb], 0, 0, 0); S2[mb] = __builtin_amdgcn_mfma_f32_16x16x32_bf16(ka2_[mb], q2_, s == 0 ? ci2_ : S2[mb], 0, 0, 0); } } \
        if (near_) { _Pragma("unroll") for (int mb = 0; mb < 4; ++mb) _Pragma("unroll") for (int i = 0; i < 4; ++i) { \
            const int kr_ = 16 * mb + 4 * g + i; const int kpos_ = ((tt) == 0) ? kr_ : 16 + 64 * ((tt) - 1) + kr_; \
            int rel_ = kpos_ - (NMETA + jq); rel_ = rel_ < -91 ? -91 : (rel_ > 63 ? 63 : rel_); const float bias_ = LUT[rel_ + 91]; S1[mb][i] += bias_; S2[mb][i] += bias_; } } \
        if ((tt) == 0) { _Pragma("unroll") for (int mb = 1; mb < 4; ++mb) { S1[mb] = (f32x4){-INFINITY, -INFINITY, -INFINITY, -INFINITY}; S2[mb] = S1[mb]; } } } while (0)
#define DF_LMAX(t1_, t2_) do { t1_ = fmaxf(fmaxf(S1[0][0], S1[0][1]), S1[0][2]); t2_ = fmaxf(fmaxf(S2[0][0], S2[0][1]), S2[0][2]); \
        t1_ = fmaxf(fmaxf(t1_, S1[0][3]), S1[1][0]); t2_ = fmaxf(fmaxf(t2_, S2[0][3]), S2[1][0]); \
        t1_ = fmaxf(fmaxf(t1_, S1[1][1]), S1[1][2]); t2_ = fmaxf(fmaxf(t2_, S2[1][1]), S2[1][2]); \
        t1_ = fmaxf(fmaxf(t1_, S1[1][3]), S1[2][0]); t2_ = fmaxf(fmaxf(t2_, S2[1][3]), S2[2][0]); \
        t1_ = fmaxf(fmaxf(t1_, S1[2][1]), S1[2][2]); t2_ = fmaxf(fmaxf(t2_, S2[2][1]), S2[2][2]); \
        t1_ = fmaxf(fmaxf(t1_, S1[2][3]), S1[3][0]); t2_ = fmaxf(fmaxf(t2_, S2[2][3]), S2[3][0]); \
        t1_ = fmaxf(fmaxf(t1_, S1[3][1]), S1[3][2]); t2_ = fmaxf(fmaxf(t2_, S2[3][1]), S2[3][2]); \
        t1_ = fmaxf(t1_, S1[3][3]); t2_ = fmaxf(t2_, S2[3][3]); } while (0)
#define DF_RESCALE(t1_, t2_, forced_) do { float r1_ = t1_, r2_ = t2_; r1_ = fmaxf(r1_, __shfl_xor(r1_, 16)); r1_ = fmaxf(r1_, __shfl_xor(r1_, 32)); r2_ = fmaxf(r2_, __shfl_xor(r2_, 16)); r2_ = fmaxf(r2_, __shfl_xor(r2_, 32)); \
        const float d1_ = (forced_) ? r1_ : fmaxf(r1_, 0.f), d2_ = (forced_) ? r2_ : fmaxf(r2_, 0.f); m1 += d1_; m2 += d2_; \
        es1 = __builtin_amdgcn_exp2f(-d1_); es2 = __builtin_amdgcn_exp2f(-d2_); \
        _Pragma("unroll") for (int mb = 0; mb < 4; ++mb) { S1[mb] = S1[mb] - d1_; S2[mb] = S2[mb] - d2_; } \
        cn1 = (f32x4){-m1, -m1, -m1, -m1}; cn2 = (f32x4){-m2, -m2, -m2, -m2}; { const float f1_ = bias_far - m1, f2_ = bias_far - m2; cf1 = (f32x4){f1_, f1_, f1_, f1_}; cf2 = (f32x4){f2_, f2_, f2_, f2_}; } } while (0)
#define DF_SCALE_O() do { _Pragma("unroll") for (int i = 0; i < 4; ++i) { const float x1_ = __shfl(es1, 4 * g + i), x2_ = __shfl(es2, 4 * g + i); OL1[i] *= x1_; OL2[i] *= x2_; \
            _Pragma("unroll") for (int c = 0; c < 8; ++c) { O1[c][i] *= x1_; O2[c][i] *= x2_; } } } while (0)
#define DF_EXP() do { _Pragma("unroll") for (int mb = 0; mb < 4; ++mb) _Pragma("unroll") for (int i = 0; i < 4; ++i) { S1[mb][i] = __builtin_amdgcn_exp2f(S1[mb][i]); S2[mb][i] = __builtin_amdgcn_exp2f(S2[mb][i]); } \
        _Pragma("unroll") for (int ks = 0; ks < 2; ++ks) { u32x4 w1_, w2_; \
            w1_.x = cvtpk_s(S1[2 * ks][0], S1[2 * ks][1]); w1_.y = cvtpk_s(S1[2 * ks][2], S1[2 * ks][3]); w1_.z = cvtpk_s(S1[2 * ks + 1][0], S1[2 * ks + 1][1]); w1_.w = cvtpk_s(S1[2 * ks + 1][2], S1[2 * ks + 1][3]); \
            w2_.x = cvtpk_s(S2[2 * ks][0], S2[2 * ks][1]); w2_.y = cvtpk_s(S2[2 * ks][2], S2[2 * ks][3]); w2_.z = cvtpk_s(S2[2 * ks + 1][0], S2[2 * ks + 1][1]); w2_.w = cvtpk_s(S2[2 * ks + 1][2], S2[2 * ks + 1][3]); \
            pa1[ks] = __builtin_bit_cast(bf16x8, w1_); pa2[ks] = __builtin_bit_cast(bf16x8, w2_); } } while (0)
#define DF_PV(vbo_, pq1_, pq2_) do { LAS unsigned char* Vb_ = lds + DB_V + (vbo_); \
        _Pragma("unroll") for (int ks = 0; ks < 2; ++ks) { OL1 = __builtin_amdgcn_mfma_f32_16x16x32_bf16(pq1_[ks], onesf, OL1, 0, 0, 0); OL2 = __builtin_amdgcn_mfma_f32_16x16x32_bf16(pq2_[ks], onesf, OL2, 0, 0, 0); } \
        _Pragma("unroll") for (int c2 = 0; c2 < 8; c2 += 2) { bf16x8 vf_[2][2]; \
            _Pragma("unroll") for (int cc = 0; cc < 2; ++cc) _Pragma("unroll") for (int ks = 0; ks < 2; ++ks) vf_[cc][ks] = tr_frag(Vb_ + vbase[c2 + cc], 8192u * ks, 8192u * ks + 4096u); \
            _Pragma("unroll") for (int cc = 0; cc < 2; ++cc) _Pragma("unroll") for (int ks = 0; ks < 2; ++ks) { \
                O1[c2 + cc] = __builtin_amdgcn_mfma_f32_16x16x32_bf16(pq1_[ks], vf_[cc][ks], O1[c2 + cc], 0, 0, 0); O2[c2 + cc] = __builtin_amdgcn_mfma_f32_16x16x32_bf16(pq2_[ks], vf_[cc][ks], O2[c2 + cc], 0, 0, 0); } } } while (0)

    DF_DMAK(0, 0); DF_DMAV(0, 0); DF_DMAK(1, 1); DF_DMAV(1, 1); DF_DMAK(2, 2);
    asm volatile("s_waitcnt vmcnt(0) lgkmcnt(0)" ::: "memory"); __builtin_amdgcn_s_barrier(); asm volatile("" ::: "memory");
    const float bias_far = LUT[0];
    cf1 = (f32x4){bias_far, bias_far, bias_far, bias_far}; cf2 = cf1;
    { DF_QK(0, 0u); float t1, t2; DF_LMAX(t1, t2); DF_RESCALE(t1, t2, true); DF_EXP(); }
    asm volatile("s_waitcnt lgkmcnt(0)" ::: "memory"); __builtin_amdgcn_s_barrier(); asm volatile("" ::: "memory");
    int sk = 1, sv = 0;
    for (int t = 0; t < ntiles; ++t) {
        if (__builtin_expect(pending, 0)) { DF_SCALE_O(); pending = false; }
        int nnew = 0;
        { const int s3 = (sk == 0) ? 2 : sk - 1;
          if (t + 3 < ntiles) { DF_DMAK(t + 3, s3); nnew += 2; }
          const int s2 = (sv == 0) ? 2 : sv - 1;
          if (t + 2 < ntiles) { DF_DMAV(t + 2, s2); nnew += 2; } }
        unsigned kbo = (unsigned)sk * 16384u, vbo = (unsigned)sv * 16384u; asm volatile("" : "+v"(kbo), "+v"(vbo));
        if (t + 1 <= cw) {
            DF_QK(t + 1, kbo);
            float t1, t2; DF_LMAX(t1, t2);
            if (__builtin_expect(__any((t1 > DIFF_THR) || (t2 > DIFF_THR)), 0)) { DF_RESCALE(t1, t2, false); pending = true; }
            DF_PV(vbo, pa1, pa2);
            DF_EXP();
        } else if (t <= cw) {
            DF_PV(vbo, pa1, pa2);
        }
        DF_WAITBAR(nnew);
        sk = (sk == 2) ? 0 : sk + 1; sv = (sv == 2) ? 0 : sv + 1;
    }
    asm volatile("s_waitcnt vmcnt(0)" ::: "memory");
#undef DF_ROW0
#undef DF_DMAK
#undef DF_DMAV
#undef DF_WAITBAR
#undef DF_QK
#undef DF_LMAX
#undef DF_RESCALE
#undef DF_SCALE_O
#undef DF_EXP
#undef DF_PV
#pragma unroll
    for (int i = 0; i < 4; ++i) {
        const float r1 = 1.f / __shfl(OL1[i], 16 * g), r2 = lam / __shfl(OL2[i], 16 * g);
        float o[8]; float ss = 0.f;
#pragma unroll
        for (int c = 0; c < 8; ++c) { o[c] = O1[c][i] * r1 - O2[c][i] * r2; ss += o[c] * o[c]; }
        ss += __shfl_xor(ss, 1); ss += __shfl_xor(ss, 2); ss += __shfl_xor(ss, 4); ss += __shfl_xor(ss, 8);
        const float rs = rsqrtf(ss * (1.f / 128.f) + EPS) * 0.8f;
        const size_t t = (size_t)b * SEQ + jw + 4 * g + i;
#pragma unroll
        for (int c = 0; c < 8; ++c) { const int d = 16 * c + l15; const float y = o[c] * rs * p.subln_w[d] * bf2f(ZB[t * 1024 + h * 128 + d]); OZB[t * 1024 + h * 128 + d] = (bf16_t)f2bf(y); }
    }
}
__device__ __forceinline__ void phase_diff(const Params& p, LAS unsigned char* lds) {
    const int lane = threadIdx.x & 63;
    float a = (lane < 64) ? p.lam_p[lane] * p.lam_p[64 + lane] : 0.f, bb = p.lam_p[128 + lane] * p.lam_p[192 + lane];
    a = wave_sum(a); bb = wave_sum(bb);
    const float lam = expf(a) - expf(bb) + 0.2f;
    for (int u = blockIdx.x; u < 512; u += gridDim.x) {
        const int v = u & 255;
        int bh = v >> 4, s = v & 15;
        if (gridDim.x == 256) { bh = (v & 7) + 8 * (v >> 7); s = (v >> 3) & 15; }
        const int qb = (u < 256) ? s : 31 - s;
        diff_unit(p, lds, bh >> 3, bh & 7, qb, lam);
    }
}

typedef float f32x16 __attribute__((ext_vector_type(16)));
__device__ __forceinline__ void scores_wg_unit(const Params& p, LAS unsigned char* lds, int c, int b, int half, int kh) {
    const bf16_t* IQ = WSP(const bf16_t, WS_IQ); const float* IW = WSP(const float, WS_IW); float* SC = WSP(float, WS_SC);
    const int tid = opaque_tid(), lane = tid & 63, wave = __builtin_amdgcn_readfirstlane(tid >> 6);
    const int j0 = (c - 1) * 64 + 32 * half + 4 * wave, m0 = b * SEQ + j0, n = 16 + 64 * c, nkb = 2 * c + 1, nkh = (nkb + 1) >> 1;
    const int kbA = kh ? nkh : 0, kbB = kh ? nkb : nkh, ntile = (kbB - kbA + 1) >> 1;
    const int r32 = lane & 31, hi = lane >> 5, tok = r32 >> 4, hh = r32 & 15;
    bf16x8 af[2][4]; float wv[2][16];
#pragma unroll
    for (int pr = 0; pr < 2; ++pr) {
#pragma unroll
        for (int s = 0; s < 4; ++s) af[pr][s] = *(const bf16x8*)(IQ + (size_t)(m0 + 2 * pr + tok) * 1024 + hh * 64 + 16 * s + 8 * hi);
#pragma unroll
        for (int r = 0; r < 16; ++r) wv[pr][r] = IW[(size_t)(m0 + 2 * pr + (r >> 3)) * 16 + (r & 3) + 8 * ((r >> 2) & 1) + 4 * hi];
    }
    float* rowbase = SC + sc_off(b, j0);
    const unsigned rofs[2] = {(unsigned)(hi * n + r32), (unsigned)((2 + hi) * n + r32)};
    const bf16_t* ikb = WSP(const bf16_t, WS_IK) + (size_t)b * TK * 64;
    const int pkey = tid >> 3, pch = tid & 7;
    const unsigned pdst = (unsigned)pkey * 128u + 16u * (unsigned)(pch ^ (((pkey >> 1) & 1) | (((pkey >> 3) & 1) << 1) | (((pkey >> 4) & 1) << 2)));
    unsigned boff[4];
#pragma unroll
    for (int s = 0; s < 4; ++s) boff[s] = (unsigned)r32 * 128u + 16u * (unsigned)((2 * s + hi) ^ (((r32 >> 1) & 1) | (((r32 >> 3) & 1) << 1) | (((r32 >> 4) & 1) << 2)));
    u32x4 kreg[4];
#define SCW_LOAD(T_) do { _Pragma("unroll") for (int i_ = 0; i_ < 4; ++i_) { int key_ = 32 * (kbA + 8 * (T_)) + 64 * i_ + pkey; key_ = key_ < n ? key_ : n - 1; kreg[i_] = *(const u32x4*)(ikb + (size_t)key_ * 64 + pch * 8); } } while (0)
#define SCW_WRITE(off_) do { _Pragma("unroll") for (int i_ = 0; i_ < 4; ++i_) *(LAS u32x4*)(lds + (off_) + i_ * 8192 + pdst) = kreg[i_]; } while (0)
#define SCW_PART(acc_, pr_, j_, s0_, s1_) do { \
        const f32x2_t x0_ = {__builtin_amdgcn_fmed3f(acc_[2 * (j_)], 0.f, pinf), __builtin_amdgcn_fmed3f(acc_[2 * (j_) + 1], 0.f, pinf)}; \
        const f32x2_t x1_ = {__builtin_amdgcn_fmed3f(acc_[8 + 2 * (j_)], 0.f, pinf), __builtin_amdgcn_fmed3f(acc_[9 + 2 * (j_)], 0.f, pinf)}; \
        s0_ = __builtin_elementwise_fma(wv2[pr_][j_], x0_, s0_); s1_ = __builtin_elementwise_fma(wv2[pr_][4 + (j_)], x1_, s1_); } while (0)
#define SCW_FIN(s0_, s1_, tot_) do { const float p0_ = s0_.x + s0_.y, p1_ = s1_.x + s1_.y; \
        const auto sw_ = __builtin_amdgcn_permlane32_swap(__float_as_uint(p0_), __float_as_uint(p1_), false, false); \
        tot_ = __uint_as_float(sw_[0]) + __uint_as_float(sw_[1]); } while (0)
#define SCW_STAGE(x0_, x1_, bf_, y0_, y1_, t0_, t1_) do { f32x2_t sa0_ = {0.f, 0.f}, sa1_ = sa0_, sb0_ = sa0_, sb1_ = sa0_; \
        _Pragma("unroll") for (int r_ = 0; r_ < 16; ++r_) { x0_[r_] = 0.f; x1_[r_] = 0.f; } \
        _Pragma("unroll") for (int s_ = 0; s_ < 4; ++s_) { \
            x0_ = __builtin_amdgcn_mfma_f32_32x32x16_bf16(af[0][s_], bf_[s_], x0_, 0, 0, 0); SCW_PART(y0_, 0, s_, sa0_, sa1_); \
            x1_ = __builtin_amdgcn_mfma_f32_32x32x16_bf16(af[1][s_], bf_[s_], x1_, 0, 0, 0); SCW_PART(y1_, 1, s_, sb0_, sb1_); \
            __builtin_amdgcn_sched_barrier(0); } \
        SCW_FIN(sa0_, sa1_, t0_); SCW_FIN(sb0_, sb1_, t1_); } while (0)
#define SCW_STORE(t0_, t1_, kb_, en_) do { const int key_ = 32 * (kb_) + r32; \
        if ((en_) && (kb_) < kbB && key_ < n) { rowbase[rofs[0] + 32u * (unsigned)(kb_)] = t0_; rowbase[rofs[1] + 32u * (unsigned)(kb_)] = t1_; } } while (0)
#define SCW_MIX() do { _Pragma("unroll") for (int g_ = 0; g_ < 8; ++g_) { __builtin_amdgcn_sched_group_barrier(0x008, 1, 0); __builtin_amdgcn_sched_group_barrier(0x002, 7, 0); } } while (0)
    __syncthreads();
    SCW_LOAD(0); SCW_WRITE(0u);
    __syncthreads();
    f32x16 a0, a1, b0, b1;
    float pinf = __builtin_inff(); asm volatile("" : "+v"(pinf));
    f32x2_t wv2[2][8];
#pragma unroll
    for (int pr = 0; pr < 2; ++pr)
#pragma unroll
        for (int r = 0; r < 8; ++r) wv2[pr][r] = (f32x2_t){wv[pr][2 * r], wv[pr][2 * r + 1]};
#pragma unroll
    for (int r = 0; r < 16; ++r) { b0[r] = 0.f; b1[r] = 0.f; }
    const int nsup = (ntile + 3) >> 2;
    for (int T = 0; T < nsup; ++T) {
        if (T + 1 < nsup) SCW_LOAD(T + 1);
        const int tend = (4 * T + 4 < ntile) ? 4 * T + 4 : ntile;
        for (int t = 4 * T; t < tend; ++t) {
            unsigned bo = (unsigned)(T & 1) * 32768u + (unsigned)(t & 3) * 8192u; asm volatile("" : "+v"(bo));
            const int kb0 = kbA + 2 * t;
            bf16x8 bf0[4], bf1[4];
#pragma unroll
            for (int s = 0; s < 4; ++s) bf0[s] = *(const LAS bf16x8*)(lds + bo + boff[s]);
#pragma unroll
            for (int s = 0; s < 4; ++s) bf1[s] = *(const LAS bf16x8*)(lds + bo + boff[s] + 4096);
            float t0, t1;
            SCW_STAGE(a0, a1, bf0, b0, b1, t0, t1); SCW_STORE(t0, t1, kb0 - 1, t > 0);
            SCW_STAGE(b0, b1, bf1, a0, a1, t0, t1); SCW_STORE(t0, t1, kb0, true);
        }
        if (T + 1 < nsup) SCW_WRITE((unsigned)((T + 1) & 1) * 32768u);
        __syncthreads();
    }
    { float t0, t1; f32x2_t sa0 = {0.f, 0.f}, sa1 = sa0, sb0 = sa0, sb1 = sa0;
#pragma unroll
      for (int j = 0; j < 4; ++j) { SCW_PART(b0, 0, j, sa0, sa1); SCW_PART(b1, 1, j, sb0, sb1); }
      SCW_FIN(sa0, sa1, t0); SCW_FIN(sb0, sb1, t1); SCW_STORE(t0, t1, kbA + 2 * ntile - 1, true); }
#undef SCW_PART
#undef SCW_FIN
#undef SCW_STAGE
#undef SCW_STORE
#undef SCW_LOAD
#undef SCW_WRITE
}
__device__ __forceinline__ void phase_scores(const Params& p, LAS unsigned char* lds) {
    for (int P = (int)blockIdx.x; P < 256; P += (int)gridDim.x) {
        const int cl = 1 + (P >> 3), sub = P & 7;
        scores_wg_unit(p, lds, 65 - cl, sub >> 2, (sub >> 1) & 1, sub & 1);
        scores_wg_unit(p, lds, cl, sub >> 2, (sub >> 1) & 1, sub & 1);
    }
}
__device__ __forceinline__ void phase_qlat(const Params& p, LAS unsigned char* lds) {
    const bf16_t* QA = WSP(const bf16_t, WS_QA); const bf16_t* WUK = WSP(const bf16_t, WS_WUK); bf16_t* QLAT = WSP(bf16_t, WS_QLAT);
    const int tid = opaque_tid(), lane = tid & 63, w = __builtin_amdgcn_readfirstlane(tid >> 6), l15 = lane & 15, g = lane >> 4;
    const float sc = 0.08838834764831845f * LOG2E * 16.f;
    const int G = (int)gridDim.x;
    int hcur = -1;
    const unsigned kb0 = off_b((unsigned)l15, (unsigned)g);
    for (int u0 = (int)blockIdx.x; u0 < 4096; u0 += 8 * G) {
        const int h = u0 & 7;
        if (h != hcur || (G & 7)) { hcur = h; __syncthreads();
#pragma unroll
            for (int i = 0; i < 8; ++i) { const int idx = tid + 512 * i, row = idx >> 4, ch = idx & 15;
                *(LAS u32x4*)(lds + off_b((unsigned)row, (unsigned)ch)) = *(const u32x4*)(WUK + ((size_t)row * 8 + h) * 128 + ch * 8); }
            __syncthreads(); }
        const int u = u0 + w * G;
        if (u < 4096 && (u & 7) == h) {
            const int m0 = (u >> 3) * 16;
            bf16x8 bq[4];
#pragma unroll
            for (int s = 0; s < 4; ++s) bq[s] = *(const bf16x8*)(QA + (size_t)(m0 + l15) * 1024 + h * 128 + 32 * s + 8 * g);
#pragma unroll 4
            for (int nb = 0; nb < 16; ++nb) {
                bf16x8 af[4];
#pragma unroll
                for (int s = 0; s < 4; ++s) af[s] = *(const LAS bf16x8*)(lds + 4096 * nb + (kb0 ^ (64u * s)));
                f32x4 acc = (f32x4){0.f, 0.f, 0.f, 0.f};
#pragma unroll
                for (int s = 0; s < 4; ++s) acc = __builtin_amdgcn_mfma_f32_16x16x32_bf16(af[s], bq[s], acc, 0, 0, 0);
                int wv = __builtin_amdgcn_cvt_pk_fp8_f32(acc[0] * sc, acc[1] * sc, 0, false); wv = __builtin_amdgcn_cvt_pk_fp8_f32(acc[2] * sc, acc[3] * sc, wv, true);
                *(unsigned*)((unsigned char*)QLAT + ((size_t)(m0 + l15) * 8 + h) * 256 + 16 * nb + 4 * g) = (unsigned)wv;
            }
        }
    }
}
__device__ __forceinline__ void phase_oproj(const Params& p, LAS unsigned char* lds) {
    const bf16_t* OLAT = WSP(const bf16_t, WS_OLAT); const bf16_t* WUVT = WSP(const bf16_t, WS_WUVT); const bf16_t* ZA = WSP(const bf16_t, WS_ZA); bf16_t* OZA = WSP(bf16_t, WS_OZA);
    const int tid = opaque_tid(), lane = tid & 63, w = __builtin_amdgcn_readfirstlane(tid >> 6), l15 = lane & 15, g = lane >> 4;
    const int G = (int)gridDim.x;
    int hcur = -1;
    const unsigned kb0 = off_b((unsigned)l15, (unsigned)g);
    for (int u0 = (int)blockIdx.x; u0 < 4096; u0 += 8 * G) {
        const int h = u0 & 7;
        if (h != hcur || (G & 7)) { hcur = h; __syncthreads();
#pragma unroll
            for (int i = 0; i < 8; ++i) { const int idx = tid + 512 * i, row = idx >> 5, c32 = idx & 31;
                *(LAS u32x4*)(lds + (c32 >> 4) * 32768 + off_b((unsigned)row, (unsigned)(c32 & 15))) = *(const u32x4*)(WUVT + (size_t)(h * 128 + row) * 256 + c32 * 8); }
            __syncthreads(); }
        const int u = u0 + w * G;
        if (u < 4096 && (u & 7) == h) {
            const int m0 = (u >> 3) * 16;
            bf16x8 bq[8];
#pragma unroll
            for (int s = 0; s < 8; ++s) bq[s] = *(const bf16x8*)(OLAT + ((size_t)(m0 + l15) * 8 + h) * 256 + 32 * s + 8 * g);
#pragma unroll 2
            for (int nb = 0; nb < 8; ++nb) {
                bf16x8 af[8];
#pragma unroll
                for (int s = 0; s < 8; ++s) af[s] = *(const LAS bf16x8*)(lds + (s >> 2) * 32768 + 4096 * nb + (kb0 ^ (64u * (s & 3))));
                f32x4 acc = (f32x4){0.f, 0.f, 0.f, 0.f};
#pragma unroll
                for (int s = 0; s < 8; ++s) acc = __builtin_amdgcn_mfma_f32_16x16x32_bf16(af[s], bq[s], acc, 0, 0, 0);
                const size_t o = (size_t)(m0 + l15) * 1024 + h * 128 + 16 * nb + 4 * g;
                const u32x2 z = *(const u32x2*)(ZA + o);
                u32x2 wv; wv.x = pg8::cvt_pk_bf16(acc[0] * bflo(z.x), acc[1] * bfhi(z.x)); wv.y = pg8::cvt_pk_bf16(acc[2] * bflo(z.y), acc[3] * bfhi(z.y));
                *(u32x2*)(OZA + o) = wv;
            }
        }
    }
}
typedef int v2i32_t __attribute__((ext_vector_type(2)));
constexpr int DSA_WAVE_LDS = 17408, DSA_LUT = 8 * DSA_WAVE_LDS;
__device__ __forceinline__ int lpos(int s) { return (s & ~31) | ((s & 3) << 3) | ((s & 31) >> 2); }
__device__ __forceinline__ unsigned ord_key(float f) { const unsigned u = __float_as_uint(f); return (u & 0x80000000u) ? ~u : (u | 0x80000000u); }
template <int KN>
__device__ __forceinline__ void dsa_select(const float* row, int n, int nsel, LAS int* list, int lane) {
    const __amdgpu_buffer_rsrc_t rs = __builtin_amdgcn_make_buffer_rsrc((void*)row, 0, n * 4, 0x00020000);
    unsigned key[KN];
#pragma unroll
    for (int k = 0; k < KN; ++k) key[k] = (unsigned)__builtin_amdgcn_raw_buffer_load_b32(rs, lane * 4, 256 * k, 2);
    { int idx0 = lane;
#pragma unroll
      for (int k = 0; k < KN; ++k) { const unsigned u = key[k]; const unsigned o = (u & 0x80000000u) ? ~u : (u | 0x80000000u); key[k] = (idx0 < n) ? o : 0u; idx0 += 64; asm volatile("" : "+v"(idx0)); } }
    unsigned thr = 0u;
    if (n > 256) {
        for (int bit = 31; bit >= 0; --bit) {
            const unsigned cand = thr | (1u << bit);
            int c = 0;
#pragma unroll
            for (int k = 0; k < KN; ++k) c += (key[k] >= cand) ? 1 : 0;
            int cnt = 0;
#pragma unroll
            for (int b7 = 0; b7 < 7; ++b7) cnt += __popcll(__ballot((c >> b7) & 1)) << b7;
            if (cnt >= 256) thr = cand;
            if (cnt == 256) break;
        }
    }
    int pos = 0; int idx = lane;
#pragma unroll
    for (int k = 0; k < KN; ++k) { const bool mine = key[k] > thr; const unsigned long long msk = __ballot(mine);
        const int my = __builtin_amdgcn_mbcnt_hi((unsigned)(msk >> 32), __builtin_amdgcn_mbcnt_lo((unsigned)msk, 0u));
        if (mine) list[lpos(pos + my)] = idx; pos += __popcll(msk); idx += 64; asm volatile("" : "+v"(idx)); }
    if (pos < nsel) {
        idx = lane;
#pragma unroll
        for (int k = 0; k < KN; ++k) { const bool mine = (key[k] == thr) && (idx < n); const unsigned long long msk = __ballot(mine);
            const int my = __builtin_amdgcn_mbcnt_hi((unsigned)(msk >> 32), __builtin_amdgcn_mbcnt_lo((unsigned)msk, 0u));
            if (mine && pos + my < nsel) list[lpos(pos + my)] = idx; pos += __popcll(msk); idx += 64; asm volatile("" : "+v"(idx)); }
    }
}
__device__ __forceinline__ void dsa_unit(const Params& p, LAS unsigned char* lds, int qi, int wave, int lane, int probe) {
    const float* SC = WSP(const float, WS_SC); bf16_t* OLAT = WSP(bf16_t, WS_OLAT);
    const int c = qi >> 8, b = (qi >> 6) & 1, j = (c - 1) * 64 + (qi & 63), t = b * SEQ + j, n = 16 + 64 * c, nsel = n < 256 ? n : 256, qpos = NMETA + j;
    LAS unsigned char* img = lds + wave * DSA_WAVE_LDS; LAS int* list = (LAS int*)(img + 16384); const LAS float* LUTA = (const LAS float*)(lds + DSA_LUT);
    const int l15 = lane & 15, g = lane >> 4;
    const float* row = SC + sc_off(b, j);
#pragma unroll
    for (int rs_ = (PROBE_REP == 41) ? 2 : 1; rs_ > 0; --rs_) {
    if (n <= 64 * 17) dsa_select<17>(row, n, nsel, list, lane);
    else if (n <= 64 * 33) dsa_select<33>(row, n, nsel, list, lane);
    else if (n <= 64 * 49) dsa_select<49>(row, n, nsel, list, lane);
    else dsa_select<65>(row, n, nsel, list, lane);
    }
#pragma unroll
    for (int ra_ = (PROBE_REP == 42) ? 2 : 1; ra_ > 0; --ra_) {
    const unsigned char* CKV8 = WSP(const unsigned char, WS_CKV); const unsigned char* qlp = WSP(const unsigned char, WS_QLAT) + ((size_t)t * 8 + (l15 & 7)) * 256 + 8 * g;
    const bool qreal = l15 < 8;
    unsigned rdb[2];
    rdb[0] = 256u * (unsigned)l15 + 8u * ((unsigned)g ^ (2u * (unsigned)l15));
    rdb[1] = 256u * (unsigned)(l15 + 16) + 8u * ((unsigned)g ^ (2u * ((unsigned)l15 ^ 8u)));
    const unsigned tq = (unsigned)l15 >> 1, tp = (unsigned)l15 & 1u;
    const unsigned trow = (tq < 4u) ? 4u * g + tq : 16u + 4u * g + (tq - 4u);
    const unsigned trb = 256u * trow + 8u * (tp ^ (2u * ((trow & 15u) ^ ((trow >> 4) << 3))));
    float m = -INFINITY, l = 0.f;
    f32x4 O[16];
#pragma unroll
    for (int rb = 0; rb < 16; ++rb) O[rb] = (f32x4){0.f, 0.f, 0.f, 0.f};
    const int nch = (nsel + 31) >> 5;
    const int hcol = l15 & 7;
    u32x4 gr[8];
    const unsigned gwr = 256u * (unsigned)(lane >> 4) + 16u * (unsigned)(lane & 15);
#define DSA_GATHER(chn) do { int ki_[8]; { const int ce_ = ((chn) < nch) ? (chn) : 0; const LAS int* lp_ = list + 32 * ce_ + 8 * (lane >> 4);     \
        _Pragma("unroll") for (int v_ = 0; v_ < 2; ++v_) { const u32x4 t_ = *(const LAS u32x4*)(lp_ + 4 * v_); ki_[4 * v_] = (int)t_.x; ki_[4 * v_ + 1] = (int)t_.y; ki_[4 * v_ + 2] = (int)t_.z; ki_[4 * v_ + 3] = (int)t_.w; } } \
        _Pragma("unroll") for (int i = 0; i < 8; ++i) gr[i] = *(const u32x4*)(ckb + (((unsigned)ki_[i] << 8) | gl16)); } while (0)
    const unsigned char* ckb = CKV8 + (size_t)b * TK * 256; const unsigned gl16 = ((unsigned)lane & 15u) << 4;
    if (nsel < 32 * nch) { for (int i = nsel + lane; i < 32 * nch; i += 64) list[lpos(i)] = 0; }
    long qf[8];
#pragma unroll
    for (int s = 0; s < 8; ++s) qf[s] = *(const long*)(qlp + 32 * s);
#pragma unroll
    for (int s = 0; s < 8; ++s) qf[s] = qreal ? qf[s] : 0l;
    DSA_GATHER(0);
    for (int ch = 0; ch < nch; ++ch) {
#pragma unroll
        for (int i = 0; i < 8; ++i) { const unsigned row = 4u * i + (unsigned)(lane >> 4); const unsigned rc = (row & 15u) ^ ((row >> 4) << 3);
            *(LAS u32x4*)(img + 256u * row + 16u * (((unsigned)lane & 15u) ^ rc)) = gr[i]; }
        asm volatile("" ::: "memory");
        DSA_GATHER(ch + 1);
        asm volatile("" ::: "memory");
        LAS unsigned char* im = img;
        f32x4 S[2];
        S[0] = (f32x4){0.f, 0.f, 0.f, 0.f}; S[1] = S[0];
#pragma unroll
        for (int s4 = 0; s4 < 8; s4 += 4) {
            long af_[4][2];
#pragma unroll
            for (int s = 0; s < 4; ++s)
#pragma unroll
                for (int mb = 0; mb < 2; ++mb) af_[s][mb] = *(const LAS long*)(im + (rdb[mb] ^ (32u * (s4 + s))));
            __builtin_amdgcn_sched_barrier(0);
#pragma unroll
            for (int s = 0; s < 4; ++s)
#pragma unroll
                for (int mb = 0; mb < 2; ++mb) S[mb] = __builtin_amdgcn_mfma_f32_16x16x32_fp8_fp8(af_[s][mb], qf[s4 + s], S[mb], 0, 0, 0);
        }
        float cm = -INFINITY;
#pragma unroll
        for (int mb = 0; mb < 2; ++mb)
#pragma unroll
            for (int i = 0; i < 4; ++i) { const int slot = 32 * ch + 16 * mb + 4 * g + i; const int kidx = list[lpos(slot & 255)];
                int rel = kidx - qpos; rel = rel < -91 ? -91 : (rel > 63 ? 63 : rel);
                float v = S[mb][i] * 0.0625f + LUTA[(rel + 91) * 8 + hcol]; v = slot < nsel ? v : -INFINITY; S[mb][i] = v; cm = fmaxf(cm, v); }
        cm = fmaxf(cm, __shfl_xor(cm, 16)); cm = fmaxf(cm, __shfl_xor(cm, 32));
        const float mn = fmaxf(m, cm), alpha = __builtin_amdgcn_exp2f(m - mn); m = mn;
        float ps = 0.f;
#pragma unroll
        for (int mb = 0; mb < 2; ++mb)
#pragma unroll
            for (int i = 0; i < 4; ++i) { S[mb][i] = __builtin_amdgcn_exp2f(S[mb][i] - mn); ps += S[mb][i]; }
        l = l * alpha + ps;
        if (__any(alpha != 1.f)) {
#pragma unroll
            for (int rb = 0; rb < 16; ++rb) O[rb] = O[rb] * alpha;
        }
        int w0 = __builtin_amdgcn_cvt_pk_fp8_f32(S[0][0], S[0][1], 0, false); w0 = __builtin_amdgcn_cvt_pk_fp8_f32(S[0][2], S[0][3], w0, true);
        int w1 = __builtin_amdgcn_cvt_pk_fp8_f32(S[1][0], S[1][1], 0, false); w1 = __builtin_amdgcn_cvt_pk_fp8_f32(S[1][2], S[1][3], w1, true);
        const long pb = (long)(((unsigned long long)(unsigned)w1 << 32) | (unsigned long long)(unsigned)w0);
#pragma unroll
        for (int rb4 = 0; rb4 < 16; rb4 += 4) {
            long tf_[4];
#pragma unroll
            for (int r_ = 0; r_ < 4; ++r_) { const v2i32_t tv = __builtin_amdgcn_ds_read_tr8_b64_v2i32((LAS v2i32_t*)(im + (trb ^ (16u * (rb4 + r_))))); tf_[r_] = __builtin_bit_cast(long, tv); }
            __builtin_amdgcn_sched_barrier(0);
#pragma unroll
            for (int r_ = 0; r_ < 4; ++r_) O[rb4 + r_] = __builtin_amdgcn_mfma_f32_16x16x32_fp8_fp8(tf_[r_], pb, O[rb4 + r_], 0, 0, 0);
        }
    }
    l += __shfl_xor(l, 16); l += __shfl_xor(l, 32);
    const float il = 1.f / l;
    if (l15 < 8) {
#pragma unroll
        for (int rb = 0; rb < 16; ++rb) { u32x2 w; w.x = pg8::cvt_pk_bf16(O[rb][0] * il, O[rb][1] * il); w.y = pg8::cvt_pk_bf16(O[rb][2] * il, O[rb][3] * il);
            *(u32x2*)(OLAT + ((size_t)t * 8 + l15) * 256 + 16 * rb + 4 * g) = w; }
    }
    }
}
#undef DSA_GATHER
__device__ __forceinline__ int lds_take(LAS unsigned* ctr, int lane) {
    int u = 0; if (lane == 0) u = (int)__hip_atomic_fetch_add(ctr, 1u, __ATOMIC_RELAXED, __HIP_MEMORY_SCOPE_WORKGROUP);
    return __builtin_amdgcn_readfirstlane(u);
}
__device__ __forceinline__ int dsa_query_of(int u, int G) {
    const int k = u >> 3, r = u & 7;
    int cl, bb, grp;
    if (G == 256) { const int idx = ((int)blockIdx.x >> 1) + 128 * k; cl = 1 + (idx >> 4); grp = idx & 15; bb = (int)blockIdx.x & 1; }
    else { const int P = (int)blockIdx.x + k * G; cl = 1 + (P >> 5); bb = (P >> 4) & 1; grp = P & 15; }
    const int c = (r < 4) ? 65 - cl : cl;
    return (c << 8) | (bb << 6) | (4 * grp + (r & 3));
}
__device__ __forceinline__ int dsa_token_of(int qi) { return ((qi >> 6) & 1) * SEQ + ((qi >> 8) - 1) * 64 + (qi & 63); }
__device__ __forceinline__ void phase_dsa(const Params& p, LAS unsigned char* lds, int wave, int lane, int probe) {
    LAS float* LUTA = (LAS float*)(lds + DSA_LUT); LAS unsigned* ctr = (LAS unsigned*)(lds + DSA_LUT + 155 * 8 * 4);
    const int G = (int)gridDim.x, l15 = lane & 15, g = lane >> 4;
    __syncthreads();
    for (int i = threadIdx.x; i < 155 * 8; i += 512) LUTA[i] = p.rel_bias[t5_bucket((i >> 3) - 91) * 16 + (i & 7)] * LOG2E;
    if (threadIdx.x == 0) ctr[0] = 0u;
    const int npi = (1024 - (int)blockIdx.x + G - 1) / G;
    const int nun = npi * 8;
    __syncthreads();
    for (;;) {
        const int u = lds_take(ctr, lane); if (u >= nun) break;
        dsa_unit(p, lds, dsa_query_of(u, G), wave, lane, probe);
    }
}

#define XB_TMO      128
#define XB_XCNT(j)  (256  + 64 * (j))
#define XB_XSUB(j)  (1280 + 64 * (j))
#define XB_XGEN(j)  (2304 + 64 * (j))
#define XB_TOP      3328
#define XB_TOPGEN   3392
#define XCD_BAR_WORDS 3456
#define XB_SPIN_CAP (1u << 24)
__device__ __forceinline__ unsigned xb_ld(unsigned* p)              { return __hip_atomic_load(p, __ATOMIC_RELAXED, __HIP_MEMORY_SCOPE_AGENT); }
__device__ __forceinline__ unsigned xb_add(unsigned* p, unsigned v) { return __hip_atomic_fetch_add(p, v, __ATOMIC_RELAXED, __HIP_MEMORY_SCOPE_AGENT); }
__device__ __forceinline__ unsigned xb_xcc_id() { return (unsigned)__builtin_amdgcn_s_getreg((3 << 11) | 20) & 0xFu; }
#define XB_SPIN(cond, bar) do { unsigned _sp = 0; while (cond) { __builtin_amdgcn_s_sleep(1); \
    if ((++_sp & 255u) == 0u) { if (xb_ld(&(bar)[XB_TMO])) break; if (_sp > XB_SPIN_CAP) { atomicAdd(&(bar)[XB_TMO], 1u); break; } } } } while (0)
struct XcdBarrier { unsigned* bar; unsigned x; volatile LAS unsigned* st; };
__device__ __forceinline__ XcdBarrier xcd_barrier_post(unsigned* bar, volatile LAS unsigned* st) {
    XcdBarrier b; b.bar = bar; b.x = xb_xcc_id(); b.st = st;
    if (threadIdx.x == 0) (void)xb_add(&bar[XB_XCNT(b.x)], 1u);
    return b;
}
__device__ __forceinline__ void xcd_barrier_complete(unsigned* bar, unsigned x, unsigned& nloc, unsigned& nx) {
    const unsigned G = gridDim.x * gridDim.y * gridDim.z;
    unsigned sum, cnt, mine, sp = 0u;
    for (;;) {
        sum = 0u; cnt = 0u; mine = 0u;
#pragma unroll
        for (unsigned j = 0; j < 16; ++j) { const unsigned c = xb_ld(&bar[XB_XCNT(j)]); sum += c; cnt += (c > 0u) ? 1u : 0u; mine = (j == x) ? c : mine; }
        if (sum == G) break;
        __builtin_amdgcn_s_sleep(1);
        if ((++sp & 255u) == 0u) { if (xb_ld(&bar[XB_TMO])) break; if (sp > XB_SPIN_CAP) { atomicAdd(&bar[XB_TMO], 1u); break; } }
    }
    nloc = mine > 0u ? mine : 1u; nx = cnt > 0u ? cnt : 1u;
}
__device__ __forceinline__ void xcd_barrier(const XcdBarrier& b) {
    asm volatile("s_waitcnt vmcnt(0)" ::: "memory");
    __syncthreads();
    if (threadIdx.x == 0) {
        unsigned* bar = b.bar;
        __builtin_amdgcn_s_waitcnt(0);
        unsigned nloc = b.st[0], nx = b.st[1];
        if (nloc == 0u) { xcd_barrier_complete(bar, b.x, nloc, nx); b.st[0] = nloc; b.st[1] = nx; }
        const unsigned old = xb_add(&bar[XB_XSUB(b.x)], 1u);
        const unsigned gen = old / nloc;
        if (old + 1u == (gen + 1u) * nloc) {
            __builtin_amdgcn_fence(__ATOMIC_RELEASE, "agent");
            asm volatile("s_waitcnt vmcnt(0)" ::: "memory");
            const unsigned og = xb_add(&bar[XB_TOP], 1u);
            const unsigned tg = og / nx;
            if (og + 1u == (tg + 1u) * nx) xb_add(&bar[XB_TOPGEN], 1u);
            else XB_SPIN(xb_ld(&bar[XB_TOPGEN]) == tg, bar);
            __builtin_amdgcn_fence(__ATOMIC_ACQUIRE, "agent");
            xb_add(&bar[XB_XGEN(b.x)], 1u);
            asm volatile("s_waitcnt vmcnt(0)" ::: "memory");
        } else {
            XB_SPIN(xb_ld(&bar[XB_XGEN(b.x)]) == gen, bar);
            __builtin_amdgcn_fence(__ATOMIC_ACQUIRE, "agent");
            asm volatile("s_waitcnt vmcnt(0)" ::: "memory");
        }
    }
    __syncthreads();
}

constexpr int LDS_BYTES = 147456, MISC_OFF = 147456 - 256;
constexpr int NPHASE = 8;
#ifndef ONE_LAUNCH
#define ONE_LAUNCH 1
#endif

struct KArgs { Params p; int ph_lo, ph_hi, probe, pad; };
__global__ void __launch_bounds__(512, 2) k_fwd(KArgs a) {
    extern __shared__ __attribute__((aligned(16))) unsigned char lds_raw[];
    LAS unsigned char* lds = (LAS unsigned char*)lds_raw;
    const Params& p = a.p;
    const int tid = threadIdx.x, lane = tid & 63, wave = __builtin_amdgcn_readfirstlane(tid >> 6);
    const int gw = blockIdx.x * 8 + wave, ngw = gridDim.x * 8;
    volatile LAS unsigned* misc = (volatile LAS unsigned*)(lds + MISC_OFF);
    if (tid < 64) misc[tid] = 0u;
    __syncthreads();
    XcdBarrier bar; bar.bar = WSP(unsigned, WS_CTL) + 4096; bar.x = 0; bar.st = misc;
    if (ONE_LAUNCH) bar = xcd_barrier_post(WSP(unsigned, WS_CTL) + 4096, misc);
#define IN(k) (a.ph_lo <= 0 && 0 < a.ph_hi)
#define SEAM(k) do { xcd_barrier(bar); } while (0)
#define RUNPH(k, ...) do { if (IN(k)) { constexpr int nrep_ = (PROBE_REP == (k)) ? 2 : 1; _Pragma("unroll") for (int rep = 0; rep < nrep_; ++rep) { if (rep) xcd_barrier(bar); __VA_ARGS__ } } } while (0)
    RUNPH(0, const int lane_ = opaque_tid() & 63; phase0(p, lds, gw, ngw, wave, lane_, 0, (gridDim.x == 256) ? p.jobs[13].item0 : p.nitems););
    SEAM(0);
    RUNPH(1,
        SchedInproj S{DM, (int)gridDim.x, (int)blockIdx.x, (const char*)WSP(bf16_t, WS_U), (const char*)WSP(bf16_t, WS_WIN)};
        EpiInproj E{WSP(bf16_t, WS_QA), WSP(bf16_t, WS_ZA), WSP(bf16_t, WS_IQ), WSP(bf16_t, WS_QB), WSP(bf16_t, WS_ZB), WSP(bf16_t, WS_GA), WSP(bf16_t, WS_GB), WSP(bf16_t, WS_KB), WSP(bf16_t, WS_VB),
                    WSP(float, WS_CKVRAW), WSP(bf16_t, WS_IK), WSP(float, WS_IW), 0.125f * LOG2E, p.ikn_w, p.ikn_b, 0.015625f};
        pg8::gemm_phase<EpiInproj, SchedInproj>(lds, S, E);
        { SchedGate S8{DM, (int)gridDim.x, (int)blockIdx.x, (const char*)WSP(unsigned char, WS_U8), (const char*)WSP(unsigned char, WS_W8)};
          EpiGate E8{WSP(bf16_t, WS_GA), WSP(bf16_t, WS_GB), WSP(bf16_t, WS_ZA), WSP(bf16_t, WS_ZB)};
          pg8::gemm_phase<EpiGate, SchedGate, true, true, true>(lds, S8, E8); }
        if (gridDim.x == 256 && blockIdx.x >= 202) { const int lane_ = opaque_tid() & 63; phase0(p, lds, ((int)blockIdx.x - 202) * 8 + wave, 54 * 8, wave, lane_, p.jobs[13].item0, p.nitems); });
    SEAM(1);
    RUNPH(33, const int lane_ = opaque_tid() & 63; phase_ckvnorm(p, gw, ngw, lane_););
    RUNPH(32, phase_qlat(p, lds););
    RUNPH(30, phase_diff(p, lds););
    RUNPH(31, phase_scores(p, lds););
    SEAM(3);
    RUNPH(4, const int lane_ = opaque_tid() & 63; phase_dsa(p, lds, wave, lane_, a.probe););
    SEAM(4);
    RUNPH(8, phase_oproj(p, lds););
    SEAM(8);
    RUNPH(5,
        SchedMix S{1024, (int)gridDim.x, (int)blockIdx.x, (const char*)WSP(bf16_t, WS_OZA), (const char*)WSP(bf16_t, WS_WOA), (const char*)WSP(bf16_t, WS_OZB), (const char*)WSP(bf16_t, WS_WOB)};
        EpiMix E{WSP(const bf16_t, WS_GA), WSP(const bf16_t, WS_GB), WSP(bf16_t, WS_MIX)};
        pg8::gemm_phase<EpiMix, SchedMix>(lds, S, E););
    SEAM(5);
    if (gridDim.x == 256) {
        RUNPH(6,
            SchedOut S{DM, (int)gridDim.x, (int)blockIdx.x, (const char*)WSP(bf16_t, WS_MIX), (const char*)WSP(bf16_t, WS_WOUT)};
            EpiOutFused E{p.x, p.post_w, p.out, WSP(float, WS_SSQ), WSP(unsigned, WS_CTL) + 8192, lds};
            pg8::gemm_phase<EpiOutFused, SchedOut>(lds, S, E););
    } else {
        RUNPH(6,
            SchedOut S{DM, (int)gridDim.x, (int)blockIdx.x, (const char*)WSP(bf16_t, WS_MIX), (const char*)WSP(bf16_t, WS_WOUT)};
            EpiOut E{WSP(bf16_t, WS_OUTPRE), WSP(float, WS_SSQ)};
            pg8::gemm_phase<EpiOut, SchedOut>(lds, S, E););
        SEAM(6);
        RUNPH(7, const int lane_ = opaque_tid() & 63; phase7(p, gw, ngw, lane_););
    }
#undef RUNPH
#undef IN
#undef SEAM
}

static void add_job(Params& p, const float* src, bf16_t* dst, int K, int N, int col0, int ncols, int row0, int fp8 = 0) {
    TJob& j = p.jobs[p.njobs++]; j.fp8 = fp8; j.pad_ = 0; j.src = src; j.dst = dst; j.K = K; j.N = N; j.col0 = col0; j.nblk = (ncols + 31) / 32; j.row0 = row0; j.item0 = p.nitems; p.nitems += (K / 64) * j.nblk;
}
extern "C" void kernel_launch(void* const* d_in, const int* in_sizes, int n_in, void* d_out, int out_size, void* d_ws, size_t ws_size, hipStream_t stream) {
    if (n_in != 16 || ws_size < WS_END) { fprintf(stderr, "kernel_launch: unexpected arguments (n_in %d, ws %zu)\n", n_in, ws_size); return; }
    static int grid = 0;
    if (!grid) {
        int dev = 0, cus = 0, per_cu = 0;
        (void)hipGetDevice(&dev); (void)hipDeviceGetAttribute(&cus, hipDeviceAttributeMultiprocessorCount, dev);
        (void)hipFuncSetAttribute((const void*)k_fwd, hipFuncAttributeMaxDynamicSharedMemorySize, LDS_BYTES);
        (void)hipOccupancyMaxActiveBlocksPerMultiprocessor(&per_cu, (const void*)k_fwd, 512, LDS_BYTES);
        (void)hipGetLastError();
        grid = cus > 0 ? cus : 256;
        if (per_cu < 1) fprintf(stderr, "kernel_launch: occupancy query reports %d blocks per CU\n", per_cu);
    }
    KArgs a; memset(&a, 0, sizeof(a));
    Params& p = a.p;
    const float** in = (const float**)d_in;
    p.x = in[0]; p.meta = in[1]; p.rel_bias = in[2]; p.pre_w = in[3]; p.w_in = in[4]; p.kv_norm_w = in[5]; p.w_uk = in[6]; p.w_uv = in[7]; p.ikn_w = in[8]; p.ikn_b = in[9];
    p.lam_p = in[10]; p.subln_w = in[11]; p.w_o_a = in[12]; p.w_o_b = in[13]; p.w_out = in[14]; p.post_w = in[15];
    p.out = (float*)d_out; p.ws = (unsigned char*)d_ws;
    bf16_t* WIN = (bf16_t*)(p.ws + WS_WIN);
    const int NIN = 11600;
    add_job(p, p.w_in, WIN, DM, NIN, 0, 1024, 0);
    add_job(p, p.w_in, (bf16_t*)(p.ws + WS_W8), DM, NIN, 1280, 1024, 4096, 1);
    add_job(p, p.w_in, WIN, DM, NIN, 2304, 1024, 2048);
    add_job(p, p.w_in, WIN, DM, NIN, 3408, 1024, 3072);
    add_job(p, p.w_in, (bf16_t*)(p.ws + WS_W8), DM, NIN, 6480, 1024, 5120, 1);
    add_job(p, p.w_in, (bf16_t*)(p.ws + WS_W8), DM, NIN, 7504, 2048, 0, 1);
    add_job(p, p.w_in, (bf16_t*)(p.ws + WS_W8), DM, NIN, 9552, 2048, 2048, 1);
    add_job(p, p.w_in, WIN, DM, NIN, 4432, 1024, 9216);
    add_job(p, p.w_in, WIN, DM, NIN, 5456, 1024, 10240);
    add_job(p, p.w_in, WIN, DM, NIN, 1024, 256, 11264);
    add_job(p, p.w_in, WIN, DM, NIN, 3328, 32, 11520);
    add_job(p, p.w_in, WIN, DM, NIN, 3392, 32, 11520 + 32);
    add_job(p, p.w_in, WIN, DM, NIN, 3360, 32, 11520 + 128);
    add_job(p, p.w_o_a, (bf16_t*)(p.ws + WS_WOA), 1024, DM, 0, DM, 0);
    add_job(p, p.w_o_b, (bf16_t*)(p.ws + WS_WOB), 1024, DM, 0, DM, 0);
    add_job(p, p.w_out, (bf16_t*)(p.ws + WS_WOUT), DM, DM, 0, DM, 0);
    add_job(p, p.w_uv, (bf16_t*)(p.ws + WS_WUVT), 256, 1024, 0, 1024, 0);
    (void)hipMemsetAsync((char*)d_ws + WS_CTL, 0, CTL_BYTES, stream);
#if ONE_LAUNCH
    a.ph_lo = 0; a.ph_hi = NPHASE; a.probe = PROBE_REP;
    hipLaunchKernelGGL(k_fwd, dim3(grid), dim3(512), LDS_BYTES, stream, a);
#else
    for (int ph = 0; ph < NPHASE; ++ph) { a.ph_lo = ph; a.ph_hi = ph + 1; hipLaunchKernelGGL(k_fwd, dim3(grid), dim3(512), LDS_BYTES, stream, a); }
#endif
}
```

```cpp
#include <hip/hip_runtime.h>
#include <cstdio>
#include <cstdint>
#include <cstring>

#ifndef PROBE_REP
#define PROBE_REP (-1)
#endif
#define LAS __attribute__((address_space(3)))
#define GAS __attribute__((address_space(1)))
typedef unsigned short bf16_t;
typedef short bf16x8 __attribute__((ext_vector_type(8)));
typedef float f32x4 __attribute__((ext_vector_type(4)));
typedef unsigned u32x4 __attribute__((ext_vector_type(4)));
typedef unsigned u32x2 __attribute__((ext_vector_type(2)));
typedef int v8i32 __attribute__((ext_vector_type(8)));
typedef int v4i32 __attribute__((ext_vector_type(4)));

constexpr int DM = 2048, NB = 2, SEQ = 4096, NMETA = 16, TK = SEQ + NMETA  , MTOK = NB * SEQ  , MKEY = NB * TK  ;
constexpr int UROWS = 8448;
constexpr int NPAD = 11776;
constexpr float EPS = 1e-6f;
constexpr float LOG2E = 1.4426950408889634f;
constexpr size_t SC_PER_B = 8585216;

constexpr size_t MiB = 1u << 20;
constexpr size_t WS_CTL = 0, CTL_BYTES = 1 * MiB;
constexpr size_t WS_U = 1 * MiB;
constexpr size_t WS_WIN = 34 * MiB;
constexpr size_t WS_SC = 1 * MiB;
constexpr size_t WS_MIX = 1 * MiB;
constexpr size_t WS_WOA = 80 * MiB, WS_WOB = 84 * MiB, WS_WOUT = 88 * MiB, WS_WUK = 96 * MiB, WS_WUVT = 96 * MiB + 512 * 1024;
constexpr size_t WS_QA = 97 * MiB, WS_IQ = 113 * MiB, WS_QB = 129 * MiB, WS_ZA = 145 * MiB, WS_ZB = 161 * MiB, WS_GA = 177 * MiB, WS_GB = 209 * MiB;
constexpr size_t WS_OLAT = 241 * MiB;
constexpr size_t WS_OZA = 129 * MiB;
constexpr size_t WS_KB = 241 * MiB, WS_VB = 258 * MiB, WS_CKVRAW = 275 * MiB, WS_IKRAW = 284 * MiB, WS_IW = 287 * MiB, WS_CKV = 288 * MiB, WS_IK = 293 * MiB;
constexpr size_t WS_QLAT = 295 * MiB;
constexpr size_t WS_OUTPRE = 295 * MiB;
constexpr size_t WS_OZB = 327 * MiB, WS_SSQ = 343 * MiB, WS_U8 = 344 * MiB, WS_END = 361 * MiB;
constexpr size_t WS_W8 = WS_WIN + (size_t)5120 * 2048 * 2;

__device__ __forceinline__ int opaque_tid() { int t = threadIdx.x; asm volatile("" : "+v"(t)); return t; }
__device__ __forceinline__ float bf2f(unsigned short u) { return __uint_as_float(((unsigned)u) << 16); }
__device__ __forceinline__ unsigned f2bf(float f) { unsigned u = __float_as_uint(f); return (u + 0x7fffu + ((u >> 16) & 1u)) >> 16; }
__device__ __forceinline__ unsigned pk2(float lo, float hi) { return f2bf(lo) | (f2bf(hi) << 16); }
__device__ __forceinline__ float bflo(unsigned w) { return __uint_as_float(w << 16); }
__device__ __forceinline__ float bfhi(unsigned w) { return __uint_as_float(w & 0xffff0000u); }
__device__ __forceinline__ float xsum_rows(float v) {
    const auto a = __builtin_amdgcn_permlane16_swap(__float_as_uint(v), __float_as_uint(v), false, false); v = __uint_as_float(a[0]) + __uint_as_float(a[1]);
    const auto b = __builtin_amdgcn_permlane32_swap(__float_as_uint(v), __float_as_uint(v), false, false); return __uint_as_float(b[0]) + __uint_as_float(b[1]);
}
__device__ __forceinline__ float wave_sum(float v) {
    v += __int_as_float(__builtin_amdgcn_update_dpp(0, __float_as_int(v), 0x121, 0xF, 0xF, false));
    v += __int_as_float(__builtin_amdgcn_update_dpp(0, __float_as_int(v), 0x122, 0xF, 0xF, false));
    v += __int_as_float(__builtin_amdgcn_update_dpp(0, __float_as_int(v), 0x124, 0xF, 0xF, false));
    v += __int_as_float(__builtin_amdgcn_update_dpp(0, __float_as_int(v), 0x128, 0xF, 0xF, false));
    return xsum_rows(v);
}
__device__ __forceinline__ float silu_f(float x) { return x * __builtin_amdgcn_rcpf(1.f + __expf(-x)); }
__device__ __forceinline__ int t5_bucket(int rel) {
    const int n = rel < 0 ? -rel : rel; int f;
    if (n < 8) f = n; else if (n < 12) f = 8; else if (n < 16) f = 9; else if (n < 23) f = 10; else if (n < 32) f = 11; else if (n < 46) f = 12; else if (n < 64) f = 13; else if (n < 91) f = 14; else f = 15;
    return (rel > 0 ? 16 : 0) + f;
}
__device__ __forceinline__ size_t sc_off(int b, int j) {
    const int c = 1 + (j >> 6);
    return (size_t)b * SC_PER_B + (size_t)1024 * (c - 1) + (size_t)2048 * (c - 1) * c + (size_t)(j & 63) * (16 + 64 * c);
}

namespace pg8 {
constexpr int BM = 256, BK = 64, HALF = 128, HTB = HALF * BK * 2, STAGE_BYTES = 8 * HTB, NXCD = 8, WGM = 8;
__host__ __device__ __forceinline__ int lds_byte(int r, int c) { const int st = (r >> 4) * 2 + (c >> 5), rr = r & 15, cc = c & 31, ob = rr * 64 + cc * 2; return st * 1024 + (ob ^ (((ob >> 9) & 1) << 5)); }
__host__ __device__ __forceinline__ void stage_rc(int b, int& R, int& C) { const int st = b / 1024, sb = b % 1024, swz = sb ^ (((sb >> 9) & 1) << 5); R = (st >> 1) * 16 + swz / 64; C = (st & 1) * 32 + (swz % 64) / 2; }
__host__ __device__ __forceinline__ int perm32(int rho) { const int n = rho >> 4, i = rho & 15; return 8 * (i >> 2) + 4 * n + (i & 3); }

struct Unit { int pm, pn, sub; };
__device__ __forceinline__ unsigned cvt_pk_bf16(float lo, float hi) { unsigned r; asm volatile("v_cvt_pk_bf16_f32 %0, %1, %2" : "=v"(r) : "v"(lo), "v"(hi)); return r; }

__device__ __forceinline__ void tile_of(int L, int nM, int nN, int& pm, int& pn) {
    const int nwg = nM * nN; int wgid = L; { const int q = nwg / NXCD, r = nwg % NXCD, xcd = wgid % NXCD, off = wgid / NXCD; wgid = (xcd < r ? xcd * (q + 1) : r * (q + 1) + (xcd - r) * q) + off; }
    const int nig = WGM * nN, gid = wgid / nig, fm = gid * WGM, gsz = (nM - fm) < WGM ? (nM - fm) : WGM;
    pm = fm + ((wgid % nig) % gsz); pn = (wgid % nig) / gsz;
}

template <class Epi, class Sched, bool ALIGN_EPI = true, bool SP2 = true, bool FP8 = false, bool REMAP = false>
__device__ __forceinline__ void gemm_phase(LAS unsigned char* lds, const Sched& S, const Epi& E) {
    const int tid = opaque_tid(), wid = __builtin_amdgcn_readfirstlane(tid >> 6), lane = tid & 63, wr = wid >> 2, wc = wid & 3, fr = lane & 15, fq = lane >> 4;
    const int K = FP8 ? S.K / 2 : S.K, nt = K / BK;
    unsigned voffA[2], voffB[2];
#pragma unroll
    for (int i = 0; i < 2; ++i) { int R, C; stage_rc(tid * 16 + i * 8192, R, C); const int p32 = perm32(R & 31); const int Rb = REMAP ? (64 * (R >> 5) + 16 * (p32 >> 3) + (p32 & 7)) : Epi::PERM ? ((R & ~31) + p32) : R;
        voffA[i] = (unsigned)(R * K + C) * 2u; voffB[i] = (unsigned)(Rb * K + C) * 2u; }
    const size_t kstep = (size_t)(BK * 2);
    const size_t hstep = (size_t)HALF * K * 2, hstepB = REMAP ? (size_t)8 * K * 2 : hstep;
    const unsigned ldsw = (unsigned)wid * 1024u, lds0 = (unsigned)(size_t)lds;
    const int aoff = lds_byte(wr * 64 + fr, fq * 8), boff = lds_byte(wc * 32 + fr, fq * 8);
#define PG8_SA(b, h) (((b) * 2 + (h)) * HTB)
#define PG8_SB(b, h) ((4 + (b) * 2 + (h)) * HTB)
#define PG8_STAGE(bufoff, gbase, voff) do { _Pragma("unroll") for (int _i = 0; _i < 2; ++_i) { \
        if constexpr (FP8) { unsigned keep_; asm volatile("s_mov_b32 %0, m0\n\ts_mov_b32 m0, %3\n\ts_nop 0\n\tglobal_load_lds_dwordx4 %1, %2\n\ts_mov_b32 m0, %0" \
                : "=&s"(keep_) : "v"((voff)[_i]), "s"((const char*)(gbase)), "s"(lds0 + (unsigned)(bufoff) + ldsw + (unsigned)(_i * 8192)) : "memory"); } \
        else __builtin_amdgcn_global_load_lds((const unsigned*)((const char*)(gbase) + (voff)[_i]), (LAS unsigned*)(lds + (bufoff) + ldsw + _i * 8192), 16, 0, 0); } } while (0)
#define PG8_LD8(dst, addr) do { const v4i32 lo_ = *(const LAS v4i32*)(addr), hi_ = *(const LAS v4i32*)((addr) + 1024); dst = __builtin_shufflevector(lo_, hi_, 0, 1, 2, 3, 4, 5, 6, 7); } while (0)
#define PG8_LDA(dst, b, h) do { if constexpr (FP8) { _Pragma("unroll") for (int m = 0; m < 4; ++m) PG8_LD8(dst##8[m], lds + PG8_SA(b, h) + aoff + m * 2048); } else { \
        _Pragma("unroll") for (int m = 0; m < 4; ++m) _Pragma("unroll") for (int k = 0; k < 2; ++k) dst[m][k] = *(const LAS bf16x8*)(lds + PG8_SA(b, h) + aoff + m * 2048 + k * 1024); } } while (0)
#define PG8_LDB(dst, b, h) do { if constexpr (FP8) { _Pragma("unroll") for (int n = 0; n < 2; ++n) PG8_LD8(dst##8[n], lds + PG8_SB(b, h) + boff + n * 2048); } else { \
        _Pragma("unroll") for (int n = 0; n < 2; ++n) _Pragma("unroll") for (int k = 0; k < 2; ++k) dst[n][k] = *(const LAS bf16x8*)(lds + PG8_SB(b, h) + boff + n * 2048 + k * 1024); } } while (0)
#define PG8_MMA(ai, bj, At, Bt) do { __builtin_amdgcn_s_setprio(1); _Pragma("unroll") for (int m = 0; m < 4; ++m) _Pragma("unroll") for (int n = 0; n < 2; ++n) _Pragma("unroll") for (int k = 0; k < 2; ++k) \
        acc[ai][bj][m][n] = __builtin_amdgcn_mfma_f32_16x16x32_bf16(Bt[n][k], At[m][k], acc[ai][bj][m][n], 0, 0, 0); __builtin_amdgcn_s_setprio(0); } while (0)
#define PG8_MMA8(ai, bj, At, Bt) do { __builtin_amdgcn_s_setprio(1); _Pragma("unroll") for (int m = 0; m < 4; ++m) _Pragma("unroll") for (int n = 0; n < 2; ++n) \
        acc[ai][bj][m][n] = __builtin_amdgcn_mfma_scale_f32_16x16x128_f8f6f4(Bt##8[n], At##8[m], acc[ai][bj][m][n], 0, 0, 0, 0x7f7f7f7f, 0, 0x7f7f7f7f); __builtin_amdgcn_s_setprio(0); } while (0)
#define PG8_MM(ai, bj, At, Bt) do { if constexpr (FP8) PG8_MMA8(ai, bj, At, Bt); else PG8_MMA(ai, bj, At, Bt); } while (0)
#define PG8_WAIT_V(n) asm volatile("s_waitcnt vmcnt(" #n ")" ::: "memory")
#define PG8_WAIT_L(n) asm volatile("s_waitcnt lgkmcnt(" #n ")" ::: "memory")
#define PG8_BAR __builtin_amdgcn_s_barrier()
#define PG8_SCHED __builtin_amdgcn_sched_barrier(0)
    Unit cur, nxt; int ui = 0;
    if (!S.next(0, cur)) return;
    f32x4 acc[2][2][4][2];
#pragma unroll
    for (int a = 0; a < 2; ++a)
#pragma unroll
        for (int b = 0; b < 2; ++b)
#pragma unroll
            for (int m = 0; m < 4; ++m)
#pragma unroll
                for (int n = 0; n < 2; ++n) acc[a][b][m][n] = (f32x4){0.f, 0.f, 0.f, 0.f};
    bf16x8 At[4][2], B0[2][2], B1[2][2];
    v8i32 At8[4], B08[2], B18[2];
    const char* cA = S.a_ptr(cur); const char* cB = S.b_ptr(cur);
    if constexpr (SP2) {
        PG8_STAGE(PG8_SB(0, 0), cB, voffB); PG8_STAGE(PG8_SB(0, 1), cB + hstepB, voffB); PG8_STAGE(PG8_SA(0, 0), cA, voffA); PG8_STAGE(PG8_SA(0, 1), cA + hstep, voffA);
        if (wr == 1) PG8_BAR;
        PG8_WAIT_V(2); PG8_BAR;
        PG8_STAGE(PG8_SB(1, 0), cB + kstep, voffB); PG8_STAGE(PG8_SA(1, 0), cA + kstep, voffA); PG8_STAGE(PG8_SB(1, 1), cB + hstepB + kstep, voffB);
        PG8_WAIT_V(6); PG8_BAR;
    } else {
        PG8_STAGE(PG8_SB(0, 0), cB, voffB); PG8_STAGE(PG8_SA(0, 0), cA, voffA); PG8_STAGE(PG8_SB(0, 1), cB + hstepB, voffB); PG8_STAGE(PG8_SA(0, 1), cA + hstep, voffA);
        if (wr == 1) PG8_BAR;
        PG8_WAIT_V(4); PG8_BAR;
        PG8_STAGE(PG8_SB(1, 0), cB + kstep, voffB); PG8_STAGE(PG8_SA(1, 0), cA + kstep, voffA); PG8_STAGE(PG8_SB(1, 1), cB + hstepB + kstep, voffB);
        PG8_WAIT_V(6); PG8_BAR;
    }
    for (;;) {
        const bool has_next = S.next(ui + 1, nxt);
        const char* nA = has_next ? S.a_ptr(nxt) : cA; const char* nB = has_next ? S.b_ptr(nxt) : cB;
        for (int t = 0; t < nt; t += 2) {
            const bool last = (t == nt - 2);
            const char* a1 = cA + (size_t)(t + 1) * kstep;
            const char* a2 = last ? nA : cA + (size_t)(t + 2) * kstep; const char* b2 = last ? nB : cB + (size_t)(t + 2) * kstep;
            const char* a3 = a2 + kstep; const char* b3 = b2 + kstep;
            if constexpr (SP2) {
            PG8_LDB(B0, 0, 0); PG8_LDB(B1, 0, 1); PG8_SCHED; PG8_LDA(At, 0, 0); PG8_STAGE(PG8_SA(1, 1), a1 + hstep, voffA);
            PG8_WAIT_V(8); PG8_WAIT_L(0); PG8_BAR; PG8_MM(0, 0, At, B0); PG8_MM(0, 1, At, B1); PG8_BAR; PG8_SCHED;
            PG8_LDA(At, 0, 1); PG8_STAGE(PG8_SB(0, 0), b2, voffB); PG8_STAGE(PG8_SB(0, 1), b2 + hstepB, voffB); PG8_STAGE(PG8_SA(0, 0), a2, voffA);
            PG8_WAIT_V(8); PG8_WAIT_L(0); PG8_BAR; PG8_MM(1, 0, At, B0); PG8_MM(1, 1, At, B1); PG8_BAR; PG8_SCHED;
            PG8_LDB(B0, 1, 0); PG8_LDB(B1, 1, 1); PG8_SCHED; PG8_LDA(At, 1, 0); PG8_STAGE(PG8_SA(0, 1), a2 + hstep, voffA);
            PG8_WAIT_V(8); PG8_WAIT_L(0); PG8_BAR; PG8_MM(0, 0, At, B0); PG8_MM(0, 1, At, B1); PG8_BAR; PG8_SCHED;
            PG8_LDA(At, 1, 1); PG8_STAGE(PG8_SB(1, 0), b3, voffB); PG8_STAGE(PG8_SB(1, 1), b3 + hstepB, voffB); PG8_STAGE(PG8_SA(1, 0), a3, voffA);
            PG8_WAIT_V(8); PG8_WAIT_L(0); PG8_BAR; PG8_MM(1, 0, At, B0); PG8_MM(1, 1, At, B1); PG8_BAR; PG8_SCHED;
            } else {
            PG8_LDB(B0, 0, 0); PG8_SCHED; PG8_LDA(At, 0, 0); PG8_STAGE(PG8_SA(1, 1), a1 + hstep, voffA);
            PG8_WAIT_L(8); PG8_BAR; PG8_WAIT_L(0); PG8_MM(0, 0, At, B0); PG8_BAR; PG8_SCHED;
            PG8_LDB(B1, 0, 1); PG8_STAGE(PG8_SB(0, 0), b2, voffB);
            PG8_BAR; PG8_WAIT_L(0); PG8_MM(0, 1, At, B1); PG8_BAR;
            PG8_LDA(At, 0, 1); PG8_STAGE(PG8_SA(0, 0), a2, voffA);
            PG8_BAR; PG8_WAIT_L(0); PG8_MM(1, 0, At, B0); PG8_BAR; PG8_SCHED;
            PG8_STAGE(PG8_SB(0, 1), b2 + hstepB, voffB);
            PG8_WAIT_V(6); PG8_BAR; PG8_MM(1, 1, At, B1); PG8_BAR;
            PG8_LDB(B0, 1, 0); PG8_SCHED; PG8_LDA(At, 1, 0); PG8_STAGE(PG8_SA(0, 1), a2 + hstep, voffA);
            PG8_WAIT_L(8); PG8_BAR; PG8_WAIT_L(0); PG8_MM(0, 0, At, B0); PG8_BAR; PG8_SCHED;
            PG8_LDB(B1, 1, 1); PG8_STAGE(PG8_SB(1, 0), b3, voffB);
            PG8_BAR; PG8_WAIT_L(0); PG8_MM(0, 1, At, B1); PG8_BAR;
            PG8_LDA(At, 1, 1); PG8_STAGE(PG8_SA(1, 0), a3, voffA);
            PG8_BAR; PG8_WAIT_L(0); PG8_MM(1, 0, At, B0); PG8_BAR; PG8_SCHED;
            PG8_STAGE(PG8_SB(1, 1), b3 + hstepB, voffB);
            PG8_WAIT_V(6); PG8_BAR; PG8_MM(1, 1, At, B1); PG8_BAR;
            }
        }
        if constexpr (ALIGN_EPI) { if (wr == 0) PG8_BAR; }
        E(acc, cur, wr, wc, fr, fq);
        if (!has_next) break;
        if (!E.keep_acc(cur)) {
#pragma unroll
        for (int a = 0; a < 2; ++a)
#pragma unroll
            for (int b = 0; b < 2; ++b)
#pragma unroll
                for (int m = 0; m < 4; ++m)
#pragma unroll
                    for (int n = 0; n < 2; ++n) acc[a][b][m][n] = (f32x4){0.f, 0.f, 0.f, 0.f};
        }
        cur = nxt; cA = nA; cB = nB; ++ui;
        if constexpr (ALIGN_EPI) { if (wr == 1) PG8_BAR; }
    }
    PG8_WAIT_V(0);
    if constexpr (!ALIGN_EPI) { if (wr == 0) PG8_BAR; }
    PG8_BAR;
#undef PG8_SA
#undef PG8_SB
#undef PG8_STAGE
#undef PG8_LDA
#undef PG8_LDB
#undef PG8_MMA
#undef PG8_MMA8
#undef PG8_LD8
#undef PG8_MM
#undef PG8_WAIT_V
#undef PG8_WAIT_L
#undef PG8_BAR
#undef PG8_SCHED
}
}

struct SchedInproj {
    int K, G, c; const char* A; const char* B;
    __device__ __forceinline__ bool next(int i, pg8::Unit& u) const {
        const int L = i * G + c; u.sub = 0;
        if (L < 448) { int pn; pg8::tile_of(L, 32, 14, u.pm, pn); u.pn = pn < 8 ? pn + 8 : pn < 12 ? pn + 28 : pn + 32; return true; }
        if (L < 454) { const int q = L - 448; u.pm = 32; u.pn = q < 4 ? 36 + q : 40 + q; return true; }
        return false;
    }
    __device__ __forceinline__ const char* a_ptr(const pg8::Unit& u) const { return A + (size_t)u.pm * 256 * K * 2; }
    __device__ __forceinline__ const char* b_ptr(const pg8::Unit& u) const { return B + (size_t)u.pn * 256 * K * 2; }
};
struct SchedGate {
    int K, G, c; const char* A; const char* B;
    __device__ __forceinline__ bool next(int i, pg8::Unit& u) const {
        int pn; const int L = i * G + c;
        if (L < 1024) pg8::tile_of(L, 32, 32, u.pm, pn);
        else { const int Lm = (G == 256) ? i * G + (G - 1 - c) : L;
               if (Lm < 1024 || Lm >= 1028) return false; u.pm = 32; pn = 28 + (Lm - 1024); }
        u.sub = pn; u.pn = pn < 16 ? 20 + pn : pn < 20 ? pn - 12 : pn < 24 ? pn - 4 : pn < 28 ? pn - 24 : pn + 12; return true;
    }
    __device__ __forceinline__ const char* a_ptr(const pg8::Unit& u) const { return A + (size_t)u.pm * 256 * K; }
    __device__ __forceinline__ const char* b_ptr(const pg8::Unit& u) const { return B + (size_t)u.sub * 256 * K; }
};
struct EpiInproj {
    static constexpr bool PERM = true;
    bf16_t *QA, *ZA, *IQ, *QB, *ZB, *GA, *GB, *KB, *VB; float *CKVRAW; bf16_t* IKN; float* IW; float qb_scale; const float *ikn_w, *ikn_b; float gscale;
    __device__ __forceinline__ bool keep_acc(const pg8::Unit&) const { return false; }
    __device__ __forceinline__ void operator()(f32x4 (&acc)[2][2][4][2], const pg8::Unit& u, int wr, int wc, int fr, int fq) const {
        const int pn = u.pn;
        if (pn < 44) {
            bf16_t* base; int ldc = 1024, ct, act = 0; bool kside = false;
            if (pn < 4) { base = QA; ct = pn; } else if (pn < 8) { base = ZA; ct = pn - 4; act = 1; } else if (pn < 12) { base = IQ; ct = pn - 8; }
            else if (pn < 16) { base = QB; ct = pn - 12; act = 2; } else if (pn < 20) { base = ZB; ct = pn - 16; act = 1; }
            else if (pn < 28) { base = GA; ct = pn - 20; ldc = 2048; act = 3; } else if (pn < 36) { base = GB; ct = pn - 28; ldc = 2048; act = 3; }
            else if (pn < 40) { base = KB; ct = pn - 36; kside = true; } else { base = VB; ct = pn - 40; kside = true; }
            const float sc = (act == 2) ? qb_scale : (act == 3) ? gscale : 1.f;
#pragma unroll
            for (int ai = 0; ai < 2; ++ai)
#pragma unroll
                for (int m = 0; m < 4; ++m) {
                    const int r = u.pm * 256 + ai * 128 + wr * 64 + m * 16 + fr;
                    long drow = r, drow2 = -1; bool ok = true;
                    if (kside) { if (r < MTOK) drow = (long)(r >> 12) * TK + NMETA + (r & 4095); else { const int i = r - MTOK; ok = i < NMETA; drow = i; drow2 = TK + i; } }
#pragma unroll
                    for (int bj = 0; bj < 2; ++bj) {
                        f32x4 v0 = acc[ai][bj][m][0], v1 = acc[ai][bj][m][1];
                        if (act == 1) {
#pragma unroll
                            for (int e = 0; e < 4; ++e) { v0[e] = silu_f(v0[e]); v1[e] = silu_f(v1[e]); }
                        }
                        v0 = v0 * sc; v1 = v1 * sc;
                        u32x4 w; w.x = pg8::cvt_pk_bf16(v0[0], v0[1]); w.y = pg8::cvt_pk_bf16(v0[2], v0[3]); w.z = pg8::cvt_pk_bf16(v1[0], v1[1]); w.w = pg8::cvt_pk_bf16(v1[2], v1[3]);
                        const int col = ct * 256 + bj * 128 + wc * 32 + 8 * fq;
                        if (ok) { *(u32x4*)(base + (size_t)drow * ldc + col) = w; if (drow2 >= 0) *(u32x4*)(base + (size_t)drow2 * ldc + col) = w; }
                    }
                }
        } else {
#pragma unroll
            for (int ai = 0; ai < 2; ++ai)
#pragma unroll
                for (int m = 0; m < 4; ++m) {
                    const int r = u.pm * 256 + ai * 128 + wr * 64 + m * 16 + fr;
                    long drow, drow2 = -1; bool ok = true;
                    if (r < MTOK) drow = (long)(r >> 12) * TK + NMETA + (r & 4095); else { const int i = r - MTOK; ok = i < NMETA; drow = i; drow2 = TK + i; }
                    if (pn == 44) {
#pragma unroll
                        for (int bj = 0; bj < 2; ++bj) {
                            const f32x4 v0 = acc[ai][bj][m][0], v1 = acc[ai][bj][m][1];
                            const int col = bj * 128 + wc * 32 + 8 * fq;
                            if (ok) { float* p = CKVRAW + (size_t)drow * 256 + col; *(f32x4*)p = v0; *(f32x4*)(p + 4) = v1;
                                      if (drow2 >= 0) { float* p2 = CKVRAW + (size_t)drow2 * 256 + col; *(f32x4*)p2 = v0; *(f32x4*)(p2 + 4) = v1; } }
                        }
                    } else if (wc == 0) {
                        const f32x4 a0 = acc[ai][0][m][0], a1 = acc[ai][0][m][1], b0 = acc[ai][1][m][0], b1 = acc[ai][1][m][1];
                        float s = ((a0[0] + a0[1]) + (a0[2] + a0[3])) + ((a1[0] + a1[1]) + (a1[2] + a1[3])) + ((b0[0] + b0[1]) + (b0[2] + b0[3])) + ((b1[0] + b1[1]) + (b1[2] + b1[3]));
                        s = xsum_rows(s);
                        const float mu = s * (1.f / 64.f);
                        const f32x4 da0 = a0 - mu, da1 = a1 - mu, db0 = b0 - mu, db1 = b1 - mu;
                        float q = ((da0[0] * da0[0] + da0[1] * da0[1]) + (da0[2] * da0[2] + da0[3] * da0[3])) + ((da1[0] * da1[0] + da1[1] * da1[1]) + (da1[2] * da1[2] + da1[3] * da1[3]))
                                + ((db0[0] * db0[0] + db0[1] * db0[1]) + (db0[2] * db0[2] + db0[3] * db0[3])) + ((db1[0] * db1[0] + db1[1] * db1[1]) + (db1[2] * db1[2] + db1[3] * db1[3]));
                        q = xsum_rows(q);
                        const float rs = rsqrtf(q * (1.f / 64.f) + EPS);
                        const f32x4 wa0 = *(const f32x4*)(ikn_w + 8 * fq), wa1 = *(const f32x4*)(ikn_w + 8 * fq + 4), wb0 = *(const f32x4*)(ikn_w + 32 + 8 * fq), wb1 = *(const f32x4*)(ikn_w + 36 + 8 * fq);
                        const f32x4 ba0 = *(const f32x4*)(ikn_b + 8 * fq), ba1 = *(const f32x4*)(ikn_b + 8 * fq + 4), bb0 = *(const f32x4*)(ikn_b + 32 + 8 * fq), bb1 = *(const f32x4*)(ikn_b + 36 + 8 * fq);
                        const f32x4 ya0 = da0 * rs * wa0 + ba0, ya1 = da1 * rs * wa1 + ba1, yb0 = db0 * rs * wb0 + bb0, yb1 = db1 * rs * wb1 + bb1;
                        u32x4 pa, pb;
                        pa.x = pg8::cvt_pk_bf16(ya0[0], ya0[1]); pa.y = pg8::cvt_pk_bf16(ya0[2], ya0[3]); pa.z = pg8::cvt_pk_bf16(ya1[0], ya1[1]); pa.w = pg8::cvt_pk_bf16(ya1[2], ya1[3]);
                        pb.x = pg8::cvt_pk_bf16(yb0[0], yb0[1]); pb.y = pg8::cvt_pk_bf16(yb0[2], yb0[3]); pb.z = pg8::cvt_pk_bf16(yb1[0], yb1[1]); pb.w = pg8::cvt_pk_bf16(yb1[2], yb1[3]);
                        if (ok) { *(u32x4*)(IKN + (size_t)drow * 64 + 8 * fq) = pa; *(u32x4*)(IKN + (size_t)drow * 64 + 32 + 8 * fq) = pb;
                                  if (drow2 >= 0) { *(u32x4*)(IKN + (size_t)drow2 * 64 + 8 * fq) = pa; *(u32x4*)(IKN + (size_t)drow2 * 64 + 32 + 8 * fq) = pb; } }
                    } else if (wc == 1) {
                        const f32x4 v0 = acc[ai][0][m][0], v1 = acc[ai][0][m][1];
                        if (fq < 2 && r < MTOK) { float* p = IW + (size_t)r * 16 + 8 * fq; *(f32x4*)p = v0 * 0.03125f; *(f32x4*)(p + 4) = v1 * 0.03125f; }
                    }
                }
        }
    }
};
struct EpiGate {
    static constexpr bool PERM = true;
    bf16_t *GA, *GB, *ZA, *ZB, *QA, *VB;
    __device__ __forceinline__ bool keep_acc(const pg8::Unit&) const { return false; }
    __device__ __forceinline__ void operator()(f32x4 (&acc)[2][2][4][2], const pg8::Unit& u, int wr, int wc, int fr, int fq) const {
        { const int ln = (int)__builtin_amdgcn_mbcnt_hi(~0u, __builtin_amdgcn_mbcnt_lo(~0u, 0u)); fr = ln & 15; fq = ln >> 4; }
        const int pn = u.pn; const bool zt = pn >= 4 && pn < 20, vb = pn >= 40; const unsigned ldc = (pn >= 20 && pn < 40) ? DM : 1024;
        bf16_t* base = (pn < 4 ? QA + pn * 256 : pn < 8 ? ZA + (pn - 4) * 256 : pn < 20 ? ZB + (pn - 16) * 256 : pn < 28 ? GA + (pn - 20) * 256 : pn < 36 ? GB + (pn - 28) * 256 : VB + (pn - 40) * 256) + wc * 64 + 16 * fq;
#pragma unroll
        for (int ai = 0; ai < 2; ++ai)
#pragma unroll
            for (int m = 0; m < 4; ++m) {
                const int r = u.pm * 256 + ai * 128 + wr * 64 + m * 16 + fr;
                if (pn >= 20 && pn < 36) {
                    unsigned char* gp = (unsigned char*)(pn < 28 ? GA : GB) + (size_t)r * DM + ((pn - 20) & 7) * 256 + wc * 64 + 16 * fq;
                    const float lo = pn < 28 ? 0.f : 1.f; u32x4 w;
#pragma unroll
                    for (int bj = 0; bj < 2; ++bj)
#pragma unroll
                        for (int n = 0; n < 2; ++n) { unsigned d = 0u;
#pragma unroll
                            for (int j = 0; j < 4; ++j) { const float sg = 255.f * __builtin_amdgcn_rcpf(1.f + __builtin_amdgcn_exp2f(__builtin_amdgcn_fmed3f(acc[ai][bj][m][n][j] * (-0.015625f * LOG2E), -43.28f, 43.28f)));
                                d = __builtin_amdgcn_cvt_pk_u8_f32(fmaxf(sg, lo), j, d); }
                            w[2 * bj + n] = d; }
                    *(u32x4*)gp = w;
                    continue;
                }
                unsigned ro = (unsigned)r * ldc; int dup = -1; bool ok = true;
                if (vb) { if (r < MTOK) ro = (unsigned)((r >> 12) * TK + NMETA + (r & 4095)) * 1024u; else { const int i = r - MTOK; ok = i < NMETA; ro = (unsigned)i * 1024u; dup = (TK + i) * 1024; } }
#pragma unroll
                for (int bj = 0; bj < 2; ++bj) {
                    f32x4 v0 = acc[ai][bj][m][0] * 0.015625f, v1 = acc[ai][bj][m][1] * 0.015625f;
                    if (zt) {
#pragma unroll
                        for (int e = 0; e < 4; ++e) { v0[e] = silu_f(v0[e]); v1[e] = silu_f(v1[e]); }
                    }
                    u32x4 w; w.x = pg8::cvt_pk_bf16(v0[0], v0[1]); w.y = pg8::cvt_pk_bf16(v0[2], v0[3]); w.z = pg8::cvt_pk_bf16(v1[0], v1[1]); w.w = pg8::cvt_pk_bf16(v1[2], v1[3]);
                    if (ok) { *(u32x4*)(base + ro + bj * 8) = w; if (dup >= 0) *(u32x4*)(base + (unsigned)dup + bj * 8) = w; }
                }
            }
    }
};
struct SchedMix {
    int K, G, c; const char *A0, *B0, *A1, *B1;
    __device__ __forceinline__ bool next(int i, pg8::Unit& u) const {
        const int L = (i >> 1) * G + c; if (L >= 256) return false;
        pg8::tile_of(L, 32, 8, u.pm, u.pn); u.sub = i & 1; return true;
    }
    __device__ __forceinline__ const char* a_ptr(const pg8::Unit& u) const { return (u.sub ? A1 : A0) + (size_t)u.pm * 256 * K * 2; }
    __device__ __forceinline__ const char* b_ptr(const pg8::Unit& u) const { return (u.sub ? B1 : B0) + (size_t)u.pn * 256 * K * 2; }
};
struct EpiMix {
    static constexpr bool PERM = true;
    const unsigned char *GA, *GB; bf16_t* MIX;
    __device__ __forceinline__ bool keep_acc(const pg8::Unit& u) const { return u.sub == 0; }
    __device__ __forceinline__ void operator()(f32x4 (&acc)[2][2][4][2], const pg8::Unit& u, int wr, int wc, int fr, int fq) const {
        const size_t base = (size_t)(u.pm * 256 + wr * 64 + fr) * DM + u.pn * 256 + wc * 64 + 16 * fq;
        if (u.sub == 0) {
            u32x4 ga[2][4], gb[2][4];
#pragma unroll
            for (int ai = 0; ai < 2; ++ai)
#pragma unroll
                for (int m = 0; m < 4; ++m) { const size_t o = base + (size_t)(ai * 128 + m * 16) * DM; ga[ai][m] = *(const u32x4*)(GA + o); gb[ai][m] = *(const u32x4*)(GB + o); }
#pragma unroll
            for (int ai = 0; ai < 2; ++ai)
#pragma unroll
                for (int m = 0; m < 4; ++m)
#pragma unroll
                    for (int bj = 0; bj < 2; ++bj)
#pragma unroll
                        for (int n = 0; n < 2; ++n)
#pragma unroll
                            for (int j = 0; j < 4; ++j) { const float a8 = (float)((ga[ai][m][2 * bj + n] >> (8 * j)) & 0xffu), b8 = (float)((gb[ai][m][2 * bj + n] >> (8 * j)) & 0xffu);
                                acc[ai][bj][m][n][j] *= a8 * __builtin_amdgcn_rcpf(b8); }
        } else {
            u32x4 gb[2][4];
#pragma unroll
            for (int ai = 0; ai < 2; ++ai)
#pragma unroll
                for (int m = 0; m < 4; ++m) gb[ai][m] = *(const u32x4*)(GB + base + (size_t)(ai * 128 + m * 16) * DM);
#pragma unroll
            for (int ai = 0; ai < 2; ++ai)
#pragma unroll
                for (int m = 0; m < 4; ++m)
#pragma unroll
                    for (int bj = 0; bj < 2; ++bj) {
                        float v[8];
#pragma unroll
                        for (int n = 0; n < 2; ++n)
#pragma unroll
                            for (int j = 0; j < 4; ++j) v[4 * n + j] = acc[ai][bj][m][n][j] * ((float)((gb[ai][m][2 * bj + n] >> (8 * j)) & 0xffu) * 0.00392156862745098f);
                        u32x4 w; w.x = pg8::cvt_pk_bf16(v[0], v[1]); w.y = pg8::cvt_pk_bf16(v[2], v[3]); w.z = pg8::cvt_pk_bf16(v[4], v[5]); w.w = pg8::cvt_pk_bf16(v[6], v[7]);
                        *(u32x4*)(MIX + base + (size_t)(ai * 128 + m * 16) * DM + bj * 8) = w;
                    }
        }
    }
};
struct SchedOut {
    int K, G, c; const char *A, *B;
    __device__ __forceinline__ bool next(int i, pg8::Unit& u) const { const int L = i * G + c; if (L >= 256) return false; pg8::tile_of(L, 32, 8, u.pm, u.pn); u.sub = 0; return true; }
    __device__ __forceinline__ const char* a_ptr(const pg8::Unit& u) const { return A + (size_t)u.pm * 256 * K * 2; }
    __device__ __forceinline__ const char* b_ptr(const pg8::Unit& u) const { return B + (size_t)u.pn * 256 * K * 2; }
};
struct EpiOut {
    static constexpr bool PERM = true;
    bf16_t* OUTPRE; float* SSQ;
    __device__ __forceinline__ bool keep_acc(const pg8::Unit&) const { return false; }
    __device__ __forceinline__ void operator()(f32x4 (&acc)[2][2][4][2], const pg8::Unit& u, int wr, int wc, int fr, int fq) const {
#pragma unroll
        for (int ai = 0; ai < 2; ++ai)
#pragma unroll
            for (int m = 0; m < 4; ++m) {
                const int r = u.pm * 256 + ai * 128 + wr * 64 + m * 16 + fr; float ss = 0.f;
#pragma unroll
                for (int bj = 0; bj < 2; ++bj) {
                    const f32x4 v0 = acc[ai][bj][m][0], v1 = acc[ai][bj][m][1];
                    ss += (v0[0] * v0[0] + v0[1] * v0[1]) + (v0[2] * v0[2] + v0[3] * v0[3]) + (v1[0] * v1[0] + v1[1] * v1[1]) + (v1[2] * v1[2] + v1[3] * v1[3]);
                    u32x4 w; w.x = pg8::cvt_pk_bf16(v0[0], v0[1]); w.y = pg8::cvt_pk_bf16(v0[2], v0[3]); w.z = pg8::cvt_pk_bf16(v1[0], v1[1]); w.w = pg8::cvt_pk_bf16(v1[2], v1[3]);
                    *(u32x4*)(OUTPRE + (size_t)r * DM + u.pn * 256 + bj * 128 + wc * 32 + 8 * fq) = w;
                }
                ss = xsum_rows(ss);
                if (fq == 0) SSQ[(size_t)r * 32 + u.pn * 4 + wc] = ss;
            }
    }
};

struct EpiOutFused {
    static constexpr bool PERM = false;
    const float* x; const float* post_w; float* out; float* SSQ; unsigned* cnt; LAS unsigned char* lds;
    __device__ __forceinline__ bool keep_acc(const pg8::Unit&) const { return false; }
    __device__ __forceinline__ void operator()(f32x4 (&acc)[2][2][4][2], const pg8::Unit& u, int wr, int wc, int fr, int fq) const {
        const int tid = opaque_tid(), wid = __builtin_amdgcn_readfirstlane(tid >> 6), lane = tid & 63;
        LAS float* S = (LAS float*)(lds + 131072);
#pragma unroll
        for (int ai = 0; ai < 2; ++ai)
#pragma unroll
            for (int m = 0; m < 4; ++m) {
                float ss = 0.f;
#pragma unroll
                for (int bj = 0; bj < 2; ++bj)
#pragma unroll
                    for (int n = 0; n < 2; ++n) { const f32x4 v = acc[ai][bj][m][n]; ss += (v[0] * v[0] + v[1] * v[1]) + (v[2] * v[2] + v[3] * v[3]); }
                ss = xsum_rows(ss);
                if (fq == 0) __hip_atomic_store(SSQ + (size_t)(u.pm * 256 + ai * 128 + wr * 64 + m * 16 + fr) * 32 + u.pn * 4 + wc, ss, __ATOMIC_RELAXED, __HIP_MEMORY_SCOPE_AGENT);
            }
        asm volatile("s_waitcnt vmcnt(0)" ::: "memory");
        if (lane == 0) __hip_atomic_fetch_add(cnt + 64 * u.pm, 1u, __ATOMIC_RELAXED, __HIP_MEMORY_SCOPE_AGENT);
        const f32x4 g = *(const f32x4*)(post_w + u.pn * 256 + 4 * lane);
        const int lr0 = 4 * wid;
        const size_t gbase = (size_t)(u.pm * 256 + (lr0 >> 4) * 64 + (lr0 & 15)) * DM + u.pn * 256 + 4 * lane;
        f32x4 xv[4], xn[4];
#pragma unroll
        for (int q = 0; q < 4; ++q) xv[q] = __builtin_nontemporal_load((const f32x4*)(x + gbase + (size_t)q * DM));
        if (wid == 0) {
            for (unsigned it = 0; it < (1u << 22); ++it) {
                if ((unsigned)__builtin_amdgcn_readfirstlane(__hip_atomic_load(cnt + 64 * u.pm, __ATOMIC_RELAXED, __HIP_MEMORY_SCOPE_AGENT)) >= 64u) break;
                __builtin_amdgcn_s_sleep(2);
            }
            __builtin_amdgcn_fence(__ATOMIC_ACQUIRE, "agent");
        }
        asm volatile("s_waitcnt vmcnt(0) lgkmcnt(0)" ::: "memory"); __builtin_amdgcn_s_barrier(); asm volatile("" ::: "memory");
        if (tid < 256) {
            const unsigned long long* slot = (const unsigned long long*)(SSQ + (size_t)(u.pm * 256 + tid) * 32); float s = 0.f;
#pragma unroll
            for (int t = 0; t < 16; ++t) { const unsigned long long w = __hip_atomic_load(slot + t, __ATOMIC_RELAXED, __HIP_MEMORY_SCOPE_AGENT); s += __uint_as_float((unsigned)w) + __uint_as_float((unsigned)(w >> 32)); }
            S[tid] = rsqrtf(s * (1.f / DM) + EPS);
        }
        asm volatile("s_waitcnt lgkmcnt(0)" ::: "memory"); __builtin_amdgcn_s_barrier(); asm volatile("" ::: "memory");
        const unsigned woff = (unsigned)((wr * 16 + fr) * 1040 + (wc * 32 + 4 * fq) * 4), roff = (unsigned)(lr0 * 1040 + lane * 16);
#pragma unroll
        for (int s = 0; s < 8; ++s) {
            const int ai = s >> 2, m = s & 3; LAS unsigned char* T = lds + (s & 1) * 33280;
            const float rs = S[ai * 128 + wr * 64 + m * 16 + fr];
#pragma unroll
            for (int bj = 0; bj < 2; ++bj)
#pragma unroll
                for (int n = 0; n < 2; ++n) *(LAS f32x4*)(T + woff + bj * 512 + n * 64) = acc[ai][bj][m][n] * rs;
            if (s < 7) {
                const size_t o2 = (size_t)(((s + 1) >> 2) * 128 + ((s + 1) & 3) * 16) * DM;
#pragma unroll
                for (int q = 0; q < 4; ++q) xn[q] = __builtin_nontemporal_load((const f32x4*)(x + gbase + o2 + (size_t)q * DM));
            }
            asm volatile("s_waitcnt lgkmcnt(0)" ::: "memory"); __builtin_amdgcn_s_barrier(); asm volatile("" ::: "memory");
            const size_t o1 = (size_t)(ai * 128 + m * 16) * DM;
#pragma unroll
            for (int q = 0; q < 4; ++q) { const f32x4 v = *(const LAS f32x4*)(T + roff + q * 1040); *(f32x4*)(out + gbase + o1 + (size_t)q * DM) = xv[q] + v * g; }
#pragma unroll
            for (int q = 0; q < 4; ++q) xv[q] = xn[q];
        }
    }
};

struct TJob { const float* src; bf16_t* dst; int K, N, col0, nblk, row0, item0, fp8, pad_; };
struct Params {
    const float *x, *meta, *rel_bias, *pre_w, *w_in, *kv_norm_w, *w_uk, *w_uv, *ikn_w, *ikn_b, *lam_p, *subln_w, *w_o_a, *w_o_b, *w_out, *post_w;
    float* out; unsigned char* ws;
    TJob jobs[17]; int njobs, nitems;
};
#define WSP(T, off) ((T*)(p.ws + (off)))

__device__ __forceinline__ void p0_item_load(const TJob& jb, int item, int lane, float (&nv)[32]) {
    const int kb = item / jb.nblk, nb = item % jb.nblk, k0 = 64 * kb, n0 = jb.col0 + 32 * nb;
    const float* sp = jb.src + (size_t)(k0 + (lane >> 5)) * jb.N + n0 + (lane & 31);
#pragma unroll
    for (int i = 0; i < 32; ++i) nv[i] = __builtin_nontemporal_load(sp + (size_t)(2 * i) * jb.N);
}
__device__ __forceinline__ void p0_item_finish(const TJob& jb, LAS float* scr, int item, int lane, const float (&nv)[32]) {
    const int kb = item / jb.nblk, nb = item % jb.nblk, k0 = 64 * kb;
#pragma unroll
    for (int i = 0; i < 32; ++i) { const int kk = 2 * i + (lane >> 5); scr[kk * 33 + (lane & 31)] = nv[i]; }
    asm volatile("s_waitcnt lgkmcnt(0)" ::: "memory");
    const int c = lane & 7;
#pragma unroll
    for (int j = 0; j < 4; ++j) { const int n = (lane >> 3) + 8 * j; const LAS float* s = scr + (8 * c) * 33 + n;
        u32x4 o; o.x = pk2(s[0 * 33], s[1 * 33]); o.y = pk2(s[2 * 33], s[3 * 33]); o.z = pk2(s[4 * 33], s[5 * 33]); o.w = pk2(s[6 * 33], s[7 * 33]);
        if (!jb.fp8) *(u32x4*)(jb.dst + (size_t)(jb.row0 + 32 * nb + n) * jb.K + k0 + 8 * c) = o;
        else { int w0 = __builtin_amdgcn_cvt_pk_fp8_f32(s[0 * 33] * 64.f, s[1 * 33] * 64.f, 0, false); w0 = __builtin_amdgcn_cvt_pk_fp8_f32(s[2 * 33] * 64.f, s[3 * 33] * 64.f, w0, true);
               int w1 = __builtin_amdgcn_cvt_pk_fp8_f32(s[4 * 33] * 64.f, s[5 * 33] * 64.f, 0, false); w1 = __builtin_amdgcn_cvt_pk_fp8_f32(s[6 * 33] * 64.f, s[7 * 33] * 64.f, w1, true);
               u32x2 o8; o8.x = (unsigned)w0; o8.y = (unsigned)w1; *(u32x2*)((unsigned char*)jb.dst + (size_t)(jb.row0 + 32 * nb + n) * jb.K + k0 + 8 * c) = o8; } }
    asm volatile("s_waitcnt lgkmcnt(0)" ::: "memory");
}
__device__ __forceinline__ int p0_job_of(const Params& p, int it) {
    int jn = 0;
#pragma unroll
    for (int q = 1; q < 17; ++q) if (q < p.njobs && it >= p.jobs[q].item0) jn = q;
    return jn;
}
__device__ __forceinline__ void p0_norm_finish(const f32x4 (&v)[8], const float* g, bf16_t* orow, unsigned char* o8row, int lane) {
    const f32x4* gr = (const f32x4*)g + lane; float s = 0.f;
#pragma unroll
    for (int j = 0; j < 8; ++j) s += (v[j].x * v[j].x + v[j].y * v[j].y) + (v[j].z * v[j].z + v[j].w * v[j].w);
    const float rstd = rsqrtf(wave_sum(s) * (1.f / DM) + EPS);
    const bool odd = (lane & 1) != 0;
    u32x2* o8 = (u32x2*)orow + (odd ? 64 + lane - 1 : lane);
    u32x2 wj[2];
#pragma unroll
    for (int j = 0; j < 8; ++j) { const f32x4 gg = gr[64 * j]; const float y0 = v[j].x * rstd * gg.x, y1 = v[j].y * rstd * gg.y, y2 = v[j].z * rstd * gg.z, y3 = v[j].w * rstd * gg.w;
        wj[j & 1].x = pk2(y0, y1); wj[j & 1].y = pk2(y2, y3);
        int q = __builtin_amdgcn_cvt_pk_fp8_f32(y0, y1, 0, false); q = __builtin_amdgcn_cvt_pk_fp8_f32(y2, y3, q, true); ((unsigned*)o8row)[64 * j + lane] = (unsigned)q;
        if (j & 1) {
            const unsigned sx = odd ? wj[0].x : wj[1].x, sy = odd ? wj[0].y : wj[1].y;
            const unsigned rx = (unsigned)__builtin_amdgcn_mov_dpp((int)sx, 0xB1, 0xF, 0xF, true), ry = (unsigned)__builtin_amdgcn_mov_dpp((int)sy, 0xB1, 0xF, 0xF, true);
            u32x4 dat; dat.x = odd ? rx : wj[0].x; dat.y = odd ? ry : wj[0].y; dat.z = odd ? wj[1].x : rx; dat.w = odd ? wj[1].y : ry;
            *(u32x4*)(o8 + 64 * (j - 1)) = dat; } }
}
__device__ __forceinline__ const float* p0_row_src(const Params& p, int m) { return m < MTOK ? p.x + (size_t)m * DM : (m < MTOK + NMETA ? p.meta + (size_t)(m - MTOK) * DM : (const float*)nullptr); }
__device__ __forceinline__ void phase0(const Params& p, LAS unsigned char* lds, int gw, int ngw, int wave, int lane, int item_lo, int item_hi) {
    LAS float* scr = (LAS float*)(lds + wave * 16384);
    { int it = gw + item_lo;
      if (it < item_hi) {
          float nv[32]; int jn = p0_job_of(p, it); p0_item_load(p.jobs[jn], it - p.jobs[jn].item0, lane, nv);
          for (;;) {
              const int itn = it + ngw; const bool more = itn < item_hi; float nn[32]; int jnn = 0;
              if (more) { jnn = p0_job_of(p, itn); p0_item_load(p.jobs[jnn], itn - p.jobs[jnn].item0, lane, nn); }
              p0_item_finish(p.jobs[jn], scr, it - p.jobs[jn].item0, lane, nv);
              if (!more) break;
#pragma unroll
              for (int i = 0; i < 32; ++i) nv[i] = nn[i];
              it = itn; jn = jnn;
          }
      } }
    if (item_lo != 0) return;
    bf16_t* U = WSP(bf16_t, WS_U); unsigned char* U8 = WSP(unsigned char, WS_U8);
    { int m = gw;
      if (m < UROWS) {
          f32x4 v[8]; const float* sp = p0_row_src(p, m);
          if (sp) {
#pragma unroll
              for (int j = 0; j < 8; ++j) v[j] = __builtin_nontemporal_load((const f32x4*)sp + lane + 64 * j); }
          for (;;) {
              const int mn = m + ngw; const bool more = mn < UROWS; const float* spn = more ? p0_row_src(p, mn) : (const float*)nullptr; f32x4 vn[8];
              if (spn) {
#pragma unroll
                  for (int j = 0; j < 8; ++j) vn[j] = __builtin_nontemporal_load((const f32x4*)spn + lane + 64 * j); }
              if (sp) p0_norm_finish(v, p.pre_w, U + (size_t)m * DM, U8 + (size_t)m * DM, lane);
              else { u32x4* o = (u32x4*)(U + (size_t)m * DM) + lane; u32x4* o8 = (u32x4*)(U8 + (size_t)m * DM) + lane;
#pragma unroll
                  for (int j = 0; j < 4; ++j) o[64 * j] = (u32x4){0u, 0u, 0u, 0u};
#pragma unroll
                  for (int j = 0; j < 2; ++j) o8[64 * j] = (u32x4){0u, 0u, 0u, 0u}; }
              if (!more) break;
              if (spn) {
#pragma unroll
                  for (int j = 0; j < 8; ++j) v[j] = vn[j]; }
              m = mn; sp = spn;
          }
      } }
    bf16_t* WUK = WSP(bf16_t, WS_WUK);
    for (int i = gw * 64 + lane; i < 262144 / 4; i += ngw * 64) { const f32x4 v = ((const f32x4*)p.w_uk)[i]; u32x2 w; w.x = pk2(v.x, v.y); w.y = pk2(v.z, v.w); ((u32x2*)WUK)[i] = w; }
}

__device__ __forceinline__ void phase_ckvnorm(const Params& p, int gw, int ngw, int lane) {
    const float* CKVRAW = WSP(const float, WS_CKVRAW); bf16_t* CKV = WSP(bf16_t, WS_CKV);
    for (int r = gw; r < MKEY; r += ngw) {
        const f32x4 v = ((const f32x4*)(CKVRAW + (size_t)r * 256))[lane];
        const float ss = wave_sum((v.x * v.x + v.y * v.y) + (v.z * v.z + v.w * v.w));
        const float rstd = rsqrtf(ss * (1.f / 256.f) + EPS);
        const f32x4 g = ((const f32x4*)p.kv_norm_w)[lane];
        int w = __builtin_amdgcn_cvt_pk_fp8_f32(v.x * rstd * g.x, v.y * rstd * g.y, 0, false); w = __builtin_amdgcn_cvt_pk_fp8_f32(v.z * rstd * g.z, v.w * rstd * g.w, w, true);
        ((unsigned*)((unsigned char*)CKV + (size_t)r * 256))[lane] = (unsigned)w;
    }
}

__device__ __forceinline__ void phase7(const Params& p, int gw, int ngw, int lane) {
    const bf16_t* OUTPRE = WSP(const bf16_t, WS_OUTPRE); const float* SSQ = WSP(const float, WS_SSQ);
    for (int r = gw; r < MTOK; r += ngw) {
        float s = (lane < 32) ? SSQ[(size_t)r * 32 + lane] : 0.f; s = wave_sum(s);
        const float rstd = rsqrtf(s * (1.f / DM) + EPS);
        const u32x4* o = (const u32x4*)(OUTPRE + (size_t)r * DM); const f32x4* xr = (const f32x4*)(p.x + (size_t)r * DM); const f32x4* g = (const f32x4*)p.post_w; f32x4* out = (f32x4*)(p.out + (size_t)r * DM);
#pragma unroll
        for (int j = 0; j < 4; ++j) {
            const int ch = 64 * j + lane;
            const u32x4 w = o[ch]; const f32x4 x0 = __builtin_nontemporal_load(xr + 2 * ch), x1 = __builtin_nontemporal_load(xr + 2 * ch + 1), g0 = g[2 * ch], g1 = g[2 * ch + 1];
            f32x4 y0, y1;
            y0.x = x0.x + bflo(w.x) * rstd * g0.x; y0.y = x0.y + bfhi(w.x) * rstd * g0.y; y0.z = x0.z + bflo(w.y) * rstd * g0.z; y0.w = x0.w + bfhi(w.y) * rstd * g0.w;
            y1.x = x1.x + bflo(w.z) * rstd * g1.x; y1.y = x1.y + bfhi(w.z) * rstd * g1.y; y1.z = x1.z + bflo(w.w) * rstd * g1.z; y1.w = x1.w + bfhi(w.w) * rstd * g1.w;
            out[2 * ch] = y0; out[2 * ch + 1] = y1;
        }
    }
}

typedef short v4i16_t __attribute__((ext_vector_type(4)));
typedef float f32x2_t __attribute__((ext_vector_type(2))); typedef __bf16 bf16x2_t __attribute__((ext_vector_type(2)));
__device__ __forceinline__ unsigned cvtpk_s(float lo, float hi) { const f32x2_t v = {lo, hi}; const bf16x2_t b = __builtin_convertvector(v, bf16x2_t); return __builtin_bit_cast(unsigned, b); }
__device__ __forceinline__ unsigned off_b(unsigned row, unsigned ch) { const unsigned f = ((row >> 3) & 1u) | ((((row >> 2) ^ (row >> 3)) & 1u) << 1) | (((row >> 1) & 1u) << 2) | ((row & 1u) << 3); return 256u * row + 16u * (ch ^ f); }
__device__ __forceinline__ bf16x8 tr_frag(LAS unsigned char* img, unsigned a0, unsigned a1) {
    const v4i16_t lo = __builtin_amdgcn_ds_read_tr16_b64_v4i16((LAS v4i16_t*)(img + a0));
    const v4i16_t hi = __builtin_amdgcn_ds_read_tr16_b64_v4i16((LAS v4i16_t*)(img + a1));
    return (bf16x8){lo[0], lo[1], lo[2], lo[3], hi[0], hi[1], hi[2], hi[3]};
}
__device__ __forceinline__ void glds16(const void* gsrc, unsigned lds_dst) {
    unsigned keep;
    asm volatile("s_mov_b32 %0, m0\n\ts_mov_b32 m0, %2\n\ts_nop 0\n\tglobal_load_lds_dwordx4 %1, off\n\ts_mov_b32 m0, %0" : "=&s"(keep) : "v"(gsrc), "s"(lds_dst) : "memory");
}
constexpr int DB_K = 0, DB_V = 49152, DB_LUT = 98304, DB_Q = 99328;
constexpr float DIFF_THR = 24.0f;
__device__ __forceinline__ void diff_unit(const Params& p, LAS unsigned char* lds, int b, int h, int qb, float lam) {
    const bf16_t* QB = WSP(const bf16_t, WS_QB); const bf16_t* KB = WSP(const bf16_t, WS_KB); const bf16_t* VB = WSP(const bf16_t, WS_VB); const bf16_t* ZB = WSP(const bf16_t, WS_ZB); bf16_t* OZB = WSP(bf16_t, WS_OZB);
    const int tid = opaque_tid(), lane = tid & 63, wave = __builtin_amdgcn_readfirstlane(tid >> 6), l15 = lane & 15, g = lane >> 4;
    const int jw = 128 * qb + 16 * wave, jq = jw + l15, cw = 2 * qb + 1 + (wave >> 2), ntiles = 2 * qb + 3;
    LAS float* LUT = (LAS float*)(lds + DB_LUT);
    __syncthreads();
    if (tid < 155) LUT[tid] = p.rel_bias[t5_bucket(tid - 91) * 16 + 8 + h] * LOG2E;
    LAS unsigned char* Qimg = lds + DB_Q + wave * 4096;
    { const bf16_t* qp = QB + (size_t)(b * SEQ + jq) * 1024 + h * 128 + 8 * g;
#pragma unroll
      for (int s = 0; s < 4; ++s) *(LAS bf16x8*)(Qimg + off_b((unsigned)l15, 4u * s + (unsigned)g)) = *(const bf16x8*)(qp + 32 * s); }
    size_t dsrc[2];
#pragma unroll
    for (int i = 0; i < 2; ++i) { const unsigned row = 8u * wave + 4u * i + (unsigned)(lane >> 4); const unsigned f = (off_b(row & 15u, 0u) >> 4) & 15u;
        dsrc[i] = (size_t)row * 1024 + h * 128 + (((unsigned)(lane & 15)) ^ f) * 8; }
    const unsigned ddst = 2048u * wave;
    const unsigned lds0 = (unsigned)(size_t)lds;
#define DF_ROW0(tt) ((size_t)b * TK + ((tt) == 0 ? 0 : 16 + 64 * ((tt) - 1)))
#define DF_DMAK(tt, slot) do { const bf16_t* g_ = KB + DF_ROW0(tt) * 1024; _Pragma("unroll") for (int i_ = 0; i_ < 2; ++i_) \
        glds16(g_ + dsrc[i_], (unsigned)__builtin_amdgcn_readfirstlane((int)(lds0 + DB_K + (slot) * 16384 + ddst + 1024 * i_))); } while (0)
#define DF_DMAV(tt, slot) do { const bf16_t* g_ = VB + DF_ROW0(tt) * 1024; _Pragma("unroll") for (int i_ = 0; i_ < 2; ++i_) \
        glds16(g_ + dsrc[i_], (unsigned)__builtin_amdgcn_readfirstlane((int)(lds0 + DB_V + (slot) * 16384 + ddst + 1024 * i_))); } while (0)
#define DF_WAITBAR(n) do { if ((n) >= 4) asm volatile("s_waitcnt vmcnt(4) lgkmcnt(0)" ::: "memory"); else if ((n) >= 2) asm volatile("s_waitcnt vmcnt(2) lgkmcnt(0)" ::: "memory"); \
        else asm volatile("s_waitcnt vmcnt(0) lgkmcnt(0)" ::: "memory"); __builtin_amdgcn_s_barrier(); asm volatile("" ::: "memory"); } while (0)
    const unsigned q4 = (unsigned)l15 >> 2, pp = (unsigned)l15 & 3u;
    unsigned kbase[2][2], vbase[8];
#pragma unroll
    for (int mp = 0; mp < 2; ++mp)
#pragma unroll
        for (int s = 0; s < 2; ++s) kbase[mp][s] = off_b((unsigned)l15, 8u * mp + 4u * s + (unsigned)g);
#pragma unroll
    for (int c = 0; c < 8; ++c) vbase[c] = off_b(4u * g + q4, 2u * c + (pp >> 1)) + 8u * (pp & 1u);

    float m1 = 0.f, m2 = 0.f;
    f32x4 O1[8], O2[8], OL1 = (f32x4){0.f, 0.f, 0.f, 0.f}, OL2 = (f32x4){0.f, 0.f, 0.f, 0.f};
    const short one_ = (l15 == 0) ? (short)0x3F80 : (short)0;
    const bf16x8 onesf = (bf16x8){one_, one_, one_, one_, one_, one_, one_, one_};
#pragma unroll
    for (int c = 0; c < 8; ++c) { O1[c] = (f32x4){0.f, 0.f, 0.f, 0.f}; O2[c] = (f32x4){0.f, 0.f, 0.f, 0.f}; }
    f32x4 S1[4], S2[4];
    bf16x8 pa1[2], pa2[2];
    float es1 = 1.f, es2 = 1.f; bool pending = false;
    f32x4 cn1 = (f32x4){0.f, 0.f, 0.f, 0.f}, cn2 = cn1, cf1 = cn1, cf2 = cn1;

#define DF_QK(tt, kbo_) do { LAS unsigned char* Kb_ = lds + DB_K + (kbo_); \
        const int dmin_ = ((tt) == 0) ? (jw + 1) : (jw - 64 * (tt) + 1); const bool near_ = dmin_ < 91; \
        const f32x4 ci1_ = near_ ? cn1 : cf1, ci2_ = near_ ? cn2 : cf2;        \
        _Pragma("unroll") for (int s = 0; s < 2; ++s) { const bf16x8 q1_ = *(const LAS bf16x8*)(Qimg + kbase[0][s]), q2_ = *(const LAS bf16x8*)(Qimg + kbase[1][s]); \
          bf16x8 ka1_[4], ka2_[4]; \
          _Pragma("unroll") for (int mb = 0; mb < 4; ++mb) { ka1_[mb] = *(const LAS bf16x8*)(Kb_ + kbase[0][s] + 4096 * mb); ka2_[mb] = *(const LAS bf16x8*)(Kb_ + kbase[1][s] + 4096 * mb); } \
          __builtin_amdgcn_sched_barrier(0); \
          _Pragma("unroll") for (int mb = 0; mb < 4; ++mb) { \
            S1[mb] = __builtin_amdgcn_mfma_f32_16x16x32_bf16(ka1_[mb], q1_, s == 0 ? ci1_ : S1[mb], 0, 0, 0); S2[mb] = __builtin_amdgcn_mfma_f32_16x16x32_bf16(ka2_[mb], q2_, s == 0 ? ci2_ : S2[mb], 0, 0, 0); } } \
        if (near_) { _Pragma("unroll") for (int mb = 0; mb < 4; ++mb) _Pragma("unroll") for (int i = 0; i < 4; ++i) { \
            const int kr_ = 16 * mb + 4 * g + i; const int kpos_ = ((tt) == 0) ? kr_ : 16 + 64 * ((tt) - 1) + kr_; \
            int rel_ = kpos_ - (NMETA + jq); rel_ = rel_ < -91 ? -91 : (rel_ > 63 ? 63 : rel_); const float bias_ = LUT[rel_ + 91]; S1[mb][i] += bias_; S2[mb][i] += bias_; } } \
        if ((tt) == 0) { _Pragma("unroll") for (int mb = 1; mb < 4; ++mb) { S1[mb] = (f32x4){-INFINITY, -INFINITY, -INFINITY, -INFINITY}; S2[mb] = S1[mb]; } } } while (0)
#define DF_LMAX(t1_, t2_) do { t1_ = fmaxf(fmaxf(S1[0][0], S1[0][1]), S1[0][2]); t2_ = fmaxf(fmaxf(S2[0][0], S2[0][1]), S2[0][2]); \
        t1_ = fmaxf(fmaxf(t1_, S1[0][3]), S1[1][0]); t2_ = fmaxf(fmaxf(t2_, S2[0][3]), S2[1][0]); \
        t1_ = fmaxf(fmaxf(t1_, S1[1][1]), S1[1][2]); t2_ = fmaxf(fmaxf(t2_, S2[1][1]), S2[1][2]); \
        t1_ = fmaxf(fmaxf(t1_, S1[1][3]), S1[2][0]); t2_ = fmaxf(fmaxf(t2_, S2[1][3]), S2[2][0]); \
        t1_ = fmaxf(fmaxf(t1_, S1[2][1]), S1[2][2]); t2_ = fmaxf(fmaxf(t2_, S2[2][1]), S2[2][2]); \
        t1_ = fmaxf(fmaxf(t1_, S1[2][3]), S1[3][0]); t2_ = fmaxf(fmaxf(t2_, S2[2][3]), S2[3][0]); \
        t1_ = fmaxf(fmaxf(t1_, S1[3][1]), S1[3][2]); t2_ = fmaxf(fmaxf(t2_, S2[3][1]), S2[3][2]); \
        t1_ = fmaxf(t1_, S1[3][3]); t2_ = fmaxf(t2_, S2[3][3]); } while (0)
#define DF_RESCALE(t1_, t2_, forced_) do { float r1_ = t1_, r2_ = t2_; r1_ = fmaxf(r1_, __shfl_xor(r1_, 16)); r1_ = fmaxf(r1_, __shfl_xor(r1_, 32)); r2_ = fmaxf(r2_, __shfl_xor(r2_, 16)); r2_ = fmaxf(r2_, __shfl_xor(r2_, 32)); \
        const float d1_ = (forced_) ? r1_ : fmaxf(r1_, 0.f), d2_ = (forced_) ? r2_ : fmaxf(r2_, 0.f); m1 += d1_; m2 += d2_; \
        es1 = __builtin_amdgcn_exp2f(-d1_); es2 = __builtin_amdgcn_exp2f(-d2_); \
        _Pragma("unroll") for (int mb = 0; mb < 4; ++mb) { S1[mb] = S1[mb] - d1_; S2[mb] = S2[mb] - d2_; } \
        cn1 = (f32x4){-m1, -m1, -m1, -m1}; cn2 = (f32x4){-m2, -m2, -m2, -m2}; { const float f1_ = bias_far - m1, f2_ = bias_far - m2; cf1 = (f32x4){f1_, f1_, f1_, f1_}; cf2 = (f32x4){f2_, f2_, f2_, f2_}; } } while (0)
#define DF_SCALE_O() do { _Pragma("unroll") for (int i = 0; i < 4; ++i) { const float x1_ = __shfl(es1, 4 * g + i), x2_ = __shfl(es2, 4 * g + i); OL1[i] *= x1_; OL2[i] *= x2_; \
            _Pragma("unroll") for (int c = 0; c < 8; ++c) { O1[c][i] *= x1_; O2[c][i] *= x2_; } } } while (0)
#define DF_EXP() do { _Pragma("unroll") for (int mb = 0; mb < 4; ++mb) _Pragma("unroll") for (int i = 0; i < 4; ++i) { S1[mb][i] = __builtin_amdgcn_exp2f(S1[mb][i]); S2[mb][i] = __builtin_amdgcn_exp2f(S2[mb][i]); } \
        _Pragma("unroll") for (int ks = 0; ks < 2; ++ks) { u32x4 w1_, w2_; \
            w1_.x = cvtpk_s(S1[2 * ks][0], S1[2 * ks][1]); w1_.y = cvtpk_s(S1[2 * ks][2], S1[2 * ks][3]); w1_.z = cvtpk_s(S1[2 * ks + 1][0], S1[2 * ks + 1][1]); w1_.w = cvtpk_s(S1[2 * ks + 1][2], S1[2 * ks + 1][3]); \
            w2_.x = cvtpk_s(S2[2 * ks][0], S2[2 * ks][1]); w2_.y = cvtpk_s(S2[2 * ks][2], S2[2 * ks][3]); w2_.z = cvtpk_s(S2[2 * ks + 1][0], S2[2 * ks + 1][1]); w2_.w = cvtpk_s(S2[2 * ks + 1][2], S2[2 * ks + 1][3]); \
            pa1[ks] = __builtin_bit_cast(bf16x8, w1_); pa2[ks] = __builtin_bit_cast(bf16x8, w2_); } } while (0)
#define DF_PV(vbo_, pq1_, pq2_) do { LAS unsigned char* Vb_ = lds + DB_V + (vbo_); \
        _Pragma("unroll") for (int ks = 0; ks < 2; ++ks) { OL1 = __builtin_amdgcn_mfma_f32_16x16x32_bf16(pq1_[ks], onesf, OL1, 0, 0, 0); OL2 = __builtin_amdgcn_mfma_f32_16x16x32_bf16(pq2_[ks], onesf, OL2, 0, 0, 0); } \
        _Pragma("unroll") for (int c2 = 0; c2 < 8; c2 += 2) { bf16x8 vf_[2][2]; \
            _Pragma("unroll") for (int cc = 0; cc < 2; ++cc) _Pragma("unroll") for (int ks = 0; ks < 2; ++ks) vf_[cc][ks] = tr_frag(Vb_ + vbase[c2 + cc], 8192u * ks, 8192u * ks + 4096u); \
            _Pragma("unroll") for (int cc = 0; cc < 2; ++cc) _Pragma("unroll") for (int ks = 0; ks < 2; ++ks) { \
                O1[c2 + cc] = __builtin_amdgcn_mfma_f32_16x16x32_bf16(pq1_[ks], vf_[cc][ks], O1[c2 + cc], 0, 0, 0); O2[c2 + cc] = __builtin_amdgcn_mfma_f32_16x16x32_bf16(pq2_[ks], vf_[cc][ks], O2[c2 + cc], 0, 0, 0); } } } while (0)

    DF_DMAK(0, 0); DF_DMAV(0, 0); DF_DMAK(1, 1); DF_DMAV(1, 1); DF_DMAK(2, 2);
    asm volatile("s_waitcnt vmcnt(0) lgkmcnt(0)" ::: "memory"); __builtin_amdgcn_s_barrier(); asm volatile("" ::: "memory");
    const float bias_far = LUT[0];
    cf1 = (f32x4){bias_far, bias_far, bias_far, bias_far}; cf2 = cf1;
    { DF_QK(0, 0u); float t1, t2; DF_LMAX(t1, t2); DF_RESCALE(t1, t2, true); DF_EXP(); }
    asm volatile("s_waitcnt lgkmcnt(0)" ::: "memory"); __builtin_amdgcn_s_barrier(); asm volatile("" ::: "memory");
    int sk = 1, sv = 0;
    for (int t = 0; t < ntiles; ++t) {
        if (__builtin_expect(pending, 0)) { DF_SCALE_O(); pending = false; }
        int nnew = 0;
        { const int s3 = (sk == 0) ? 2 : sk - 1;
          if (t + 3 < ntiles) { DF_DMAK(t + 3, s3); nnew += 2; }
          const int s2 = (sv == 0) ? 2 : sv - 1;
          if (t + 2 < ntiles) { DF_DMAV(t + 2, s2); nnew += 2; } }
        unsigned kbo = (unsigned)sk * 16384u, vbo = (unsigned)sv * 16384u; asm volatile("" : "+v"(kbo), "+v"(vbo));
        if (t + 1 <= cw) {
            DF_QK(t + 1, kbo);
            float t1, t2; DF_LMAX(t1, t2);
            if (__builtin_expect(__any((t1 > DIFF_THR) || (t2 > DIFF_THR)), 0)) { DF_RESCALE(t1, t2, false); pending = true; }
            DF_PV(vbo, pa1, pa2);
            DF_EXP();
        } else if (t <= cw) {
            DF_PV(vbo, pa1, pa2);
        }
        DF_WAITBAR(nnew);
        sk = (sk == 2) ? 0 : sk + 1; sv = (sv == 2) ? 0 : sv + 1;
    }
    asm volatile("s_waitcnt vmcnt(0)" ::: "memory");
#undef DF_ROW0
#undef DF_DMAK
#undef DF_DMAV
#undef DF_WAITBAR
#undef DF_QK
#undef DF_LMAX
#undef DF_RESCALE
#undef DF_SCALE_O
#undef DF_EXP
#undef DF_PV
#pragma unroll
    for (int i = 0; i < 4; ++i) {
        const float r1 = 1.f / __shfl(OL1[i], 16 * g), r2 = lam / __shfl(OL2[i], 16 * g);
        float o[8]; float ss = 0.f;
#pragma unroll
        for (int c = 0; c < 8; ++c) { o[c] = O1[c][i] * r1 - O2[c][i] * r2; ss += o[c] * o[c]; }
        ss += __int_as_float(__builtin_amdgcn_update_dpp(0, __float_as_int(ss), 0x121, 0xF, 0xF, false)); ss += __int_as_float(__builtin_amdgcn_update_dpp(0, __float_as_int(ss), 0x122, 0xF, 0xF, false));
        ss += __int_as_float(__builtin_amdgcn_update_dpp(0, __float_as_int(ss), 0x124, 0xF, 0xF, false)); ss += __int_as_float(__builtin_amdgcn_update_dpp(0, __float_as_int(ss), 0x128, 0xF, 0xF, false));
        const float rs = rsqrtf(ss * (1.f / 128.f) + EPS) * 0.8f;
#pragma unroll
        for (int c = 0; c < 8; ++c) *(LAS unsigned short*)(Qimg + (4 * g + i) * 256 + (16 * c + l15) * 2) = (unsigned short)f2bf(o[c] * rs);
    }
    asm volatile("s_waitcnt lgkmcnt(0)" ::: "memory");
    { const f32x4 w0 = *(const f32x4*)(p.subln_w + 8 * l15), w1 = *(const f32x4*)(p.subln_w + 8 * l15 + 4);
#pragma unroll
      for (int k = 0; k < 4; ++k) { const int row = g + 4 * k; const size_t ofs = ((size_t)b * SEQ + jw + row) * 1024 + h * 128 + 8 * l15;
          const u32x4 v = *(const LAS u32x4*)(Qimg + row * 256 + l15 * 16), z = *(const u32x4*)(ZB + ofs);
          u32x4 y;
          y.x = pk2(bflo(v.x) * w0.x * bflo(z.x), bfhi(v.x) * w0.y * bfhi(z.x)); y.y = pk2(bflo(v.y) * w0.z * bflo(z.y), bfhi(v.y) * w0.w * bfhi(z.y));
          y.z = pk2(bflo(v.z) * w1.x * bflo(z.z), bfhi(v.z) * w1.y * bfhi(z.z)); y.w = pk2(bflo(v.w) * w1.z * bflo(z.w), bfhi(v.w) * w1.w * bfhi(z.w));
          *(u32x4*)(OZB + ofs) = y; } }
}
__device__ __forceinline__ void phase_diff(const Params& p, LAS unsigned char* lds) {
    const int lane = threadIdx.x & 63;
    float a = (lane < 64) ? p.lam_p[lane] * p.lam_p[64 + lane] : 0.f, bb = p.lam_p[128 + lane] * p.lam_p[192 + lane];
    a = wave_sum(a); bb = wave_sum(bb);
    const float lam = expf(a) - expf(bb) + 0.2f;
    for (int u = blockIdx.x; u < 512; u += gridDim.x) {
        const int v = u & 255;
        int bh = v >> 4, s = v & 15;
        if (gridDim.x == 256) { bh = (v & 7) + 8 * (v >> 7); s = (v >> 3) & 15; }
        const int qb = (u < 256) ? s : 31 - s;
        diff_unit(p, lds, bh >> 3, bh & 7, qb, lam);
    }
}

typedef float f32x16 __attribute__((ext_vector_type(16)));
__device__ __forceinline__ void scores_wg_unit(const Params& p, LAS unsigned char* lds, int c, int b, int half, int kh) {
    const bf16_t* IQ = WSP(const bf16_t, WS_IQ); const float* IW = WSP(const float, WS_IW); unsigned short* SC = WSP(unsigned short, WS_SC);
    const int tid = opaque_tid(), lane = tid & 63, wave = __builtin_amdgcn_readfirstlane(tid >> 6);
    const int j0 = (c - 1) * 64 + 32 * half + 4 * wave, m0 = b * SEQ + j0, n = 16 + 64 * c, nkb = 2 * c + 1, nkh = (nkb + 1) >> 1;
    const int kbA = kh ? nkh : 0, kbB = kh ? nkb : nkh, ntile = (kbB - kbA + 1) >> 1;
    const int r32 = lane & 31, hi = lane >> 5, tok = r32 >> 4, hh = r32 & 15;
    bf16x8 af[2][4]; float wv[2][16];
#pragma unroll
    for (int pr = 0; pr < 2; ++pr) {
#pragma unroll
        for (int s = 0; s < 4; ++s) af[pr][s] = *(const bf16x8*)(IQ + (size_t)(m0 + 2 * pr + tok) * 1024 + hh * 64 + 16 * s + 8 * hi);
#pragma unroll
        for (int r = 0; r < 16; ++r) wv[pr][r] = IW[(size_t)(m0 + 2 * pr + (r >> 3)) * 16 + (r & 3) + 8 * ((r >> 2) & 1) + 4 * hi];
    }
    unsigned short* rowbase = SC + sc_off(b, j0);
    LAS unsigned char* sbuf = lds + 65536 + wave * 4096;
    const bf16_t* ikb = WSP(const bf16_t, WS_IK) + (size_t)b * TK * 64;
    const int pkey = tid >> 3, pch = tid & 7;
    const unsigned pdst = (unsigned)pkey * 128u + 16u * (unsigned)(pch ^ (((pkey >> 1) & 1) | (((pkey >> 3) & 1) << 1) | (((pkey >> 4) & 1) << 2)));
    unsigned boff[4];
#pragma unroll
    for (int s = 0; s < 4; ++s) boff[s] = (unsigned)r32 * 128u + 16u * (unsigned)((2 * s + hi) ^ (((r32 >> 1) & 1) | (((r32 >> 3) & 1) << 1) | (((r32 >> 4) & 1) << 2)));
    u32x4 kreg[4];
#define SCW_LOAD(T_) do { _Pragma("unroll") for (int i_ = 0; i_ < 4; ++i_) { int key_ = 32 * (kbA + 8 * (T_)) + 64 * i_ + pkey; key_ = key_ < n ? key_ : n - 1; kreg[i_] = *(const u32x4*)(ikb + (size_t)key_ * 64 + pch * 8); } } while (0)
#define SCW_WRITE(off_) do { _Pragma("unroll") for (int i_ = 0; i_ < 4; ++i_) *(LAS u32x4*)(lds + (off_) + i_ * 8192 + pdst) = kreg[i_]; } while (0)
#define SCW_PART(acc_, pr_, j_, s0_, s1_) do { \
        const f32x2_t x0_ = {__builtin_amdgcn_fmed3f(acc_[2 * (j_)], 0.f, pinf), __builtin_amdgcn_fmed3f(acc_[2 * (j_) + 1], 0.f, pinf)}; \
        const f32x2_t x1_ = {__builtin_amdgcn_fmed3f(acc_[8 + 2 * (j_)], 0.f, pinf), __builtin_amdgcn_fmed3f(acc_[9 + 2 * (j_)], 0.f, pinf)}; \
        s0_ = __builtin_elementwise_fma(wv2[pr_][j_], x0_, s0_); s1_ = __builtin_elementwise_fma(wv2[pr_][4 + (j_)], x1_, s1_); } while (0)
#define SCW_FIN(s0_, s1_, tot_) do { const float p0_ = s0_.x + s0_.y, p1_ = s1_.x + s1_.y; \
        const auto sw_ = __builtin_amdgcn_permlane32_swap(__float_as_uint(p0_), __float_as_uint(p1_), false, false); \
        tot_ = __uint_as_float(sw_[0]) + __uint_as_float(sw_[1]); } while (0)
#define SCW_STAGE(x0_, x1_, bf_, y0_, y1_, t0_, t1_) do { f32x2_t sa0_ = {0.f, 0.f}, sa1_ = sa0_, sb0_ = sa0_, sb1_ = sa0_; \
        _Pragma("unroll") for (int r_ = 0; r_ < 16; ++r_) { x0_[r_] = 0.f; x1_[r_] = 0.f; } \
        _Pragma("unroll") for (int s_ = 0; s_ < 4; ++s_) { \
            x0_ = __builtin_amdgcn_mfma_f32_32x32x16_bf16(af[0][s_], bf_[s_], x0_, 0, 0, 0); SCW_PART(y0_, 0, s_, sa0_, sa1_); \
            x1_ = __builtin_amdgcn_mfma_f32_32x32x16_bf16(af[1][s_], bf_[s_], x1_, 0, 0, 0); SCW_PART(y1_, 1, s_, sb0_, sb1_); \
            __builtin_amdgcn_sched_barrier(0); } \
        SCW_FIN(sa0_, sa1_, t0_); SCW_FIN(sb0_, sb1_, t1_); } while (0)
#define SCW_STORE(t0_, t1_, kb_, en_) do { if (en_) { const unsigned o_ = ((unsigned)((kb_) - kbA) & 15u) * 64u + (unsigned)r32 * 2u; \
        *(LAS unsigned short*)(sbuf + hi * 1024 + o_) = (unsigned short)__builtin_bit_cast(unsigned, __builtin_amdgcn_cvt_pkrtz(t0_, 0.f)); \
        *(LAS unsigned short*)(sbuf + (2 + hi) * 1024 + o_) = (unsigned short)__builtin_bit_cast(unsigned, __builtin_amdgcn_cvt_pkrtz(t1_, 0.f)); } } while (0)
#define SCW_FLUSH(T_) do { asm volatile("s_waitcnt lgkmcnt(0)" ::: "memory"); \
        _Pragma("unroll") for (int i_ = 0; i_ < 2; ++i_) { const int p_ = lane + 64 * i_, tk_ = p_ >> 5, c0_ = p_ & 31; const int key0_ = 32 * (kbA + 8 * (T_)) + 8 * c0_; \
            if (key0_ < n && key0_ < 32 * kbB) *(u32x4*)(rowbase + (size_t)tk_ * n + key0_) = *(const LAS u32x4*)(sbuf + tk_ * 1024 + ((T_) & 1) * 512 + c0_ * 16); } } while (0)
#define SCW_MIX() do { _Pragma("unroll") for (int g_ = 0; g_ < 8; ++g_) { __builtin_amdgcn_sched_group_barrier(0x008, 1, 0); __builtin_amdgcn_sched_group_barrier(0x002, 7, 0); } } while (0)
    __syncthreads();
    SCW_LOAD(0); SCW_WRITE(0u);
    __syncthreads();
    f32x16 a0, a1, b0, b1;
    float pinf = __builtin_inff(); asm volatile("" : "+v"(pinf));
    f32x2_t wv2[2][8];
#pragma unroll
    for (int pr = 0; pr < 2; ++pr)
#pragma unroll
        for (int r = 0; r < 8; ++r) wv2[pr][r] = (f32x2_t){wv[pr][2 * r], wv[pr][2 * r + 1]};
#pragma unroll
    for (int r = 0; r < 16; ++r) { b0[r] = 0.f; b1[r] = 0.f; }
    const int nsup = (ntile + 3) >> 2;
    for (int T = 0; T < nsup; ++T) {
        if (T + 1 < nsup) SCW_LOAD(T + 1);
        const int tend = (4 * T + 4 < ntile) ? 4 * T + 4 : ntile;
        for (int t = 4 * T; t < tend; ++t) {
            unsigned bo = (unsigned)(T & 1) * 32768u + (unsigned)(t & 3) * 8192u; asm volatile("" : "+v"(bo));
            const int kb0 = kbA + 2 * t;
            bf16x8 bf0[4], bf1[4];
#pragma unroll
            for (int s = 0; s < 4; ++s) bf0[s] = *(const LAS bf16x8*)(lds + bo + boff[s]);
#pragma unroll
            for (int s = 0; s < 4; ++s) bf1[s] = *(const LAS bf16x8*)(lds + bo + boff[s] + 4096);
            float t0, t1;
            SCW_STAGE(a0, a1, bf0, b0, b1, t0, t1); SCW_STORE(t0, t1, kb0 - 1, t > 0);
            SCW_STAGE(b0, b1, bf1, a0, a1, t0, t1); SCW_STORE(t0, t1, kb0, true);
        }
        if (T > 0) SCW_FLUSH(T - 1);
        if (T + 1 < nsup) SCW_WRITE((unsigned)((T + 1) & 1) * 32768u);
        __syncthreads();
    }
    { float t0, t1; f32x2_t sa0 = {0.f, 0.f}, sa1 = sa0, sb0 = sa0, sb1 = sa0;
#pragma unroll
      for (int j = 0; j < 4; ++j) { SCW_PART(b0, 0, j, sa0, sa1); SCW_PART(b1, 1, j, sb0, sb1); }
      SCW_FIN(sa0, sa1, t0); SCW_FIN(sb0, sb1, t1); SCW_STORE(t0, t1, kbA + 2 * ntile - 1, true); }
    SCW_FLUSH(nsup - 1);
#undef SCW_FLUSH
#undef SCW_PART
#undef SCW_FIN
#undef SCW_STAGE
#undef SCW_STORE
#undef SCW_LOAD
#undef SCW_WRITE
}
__device__ __forceinline__ void phase_scores(const Params& p, LAS unsigned char* lds) {
    for (int P = (int)blockIdx.x; P < 256; P += (int)gridDim.x) {
        const int cl = 1 + (P >> 3), sub = P & 7;
        scores_wg_unit(p, lds, 65 - cl, sub >> 2, (sub >> 1) & 1, sub & 1);
        scores_wg_unit(p, lds, cl, sub >> 2, (sub >> 1) & 1, sub & 1);
    }
}
__device__ __forceinline__ void phase_qlat(const Params& p, LAS unsigned char* lds) {
    const bf16_t* QA = WSP(const bf16_t, WS_QA); const bf16_t* WUK = WSP(const bf16_t, WS_WUK); bf16_t* QLAT = WSP(bf16_t, WS_QLAT);
    const int tid = opaque_tid(), lane = tid & 63, w = __builtin_amdgcn_readfirstlane(tid >> 6), l15 = lane & 15, g = lane >> 4;
    const float sc = 0.08838834764831845f * LOG2E * 16.f;
    const int G = (int)gridDim.x;
    int hcur = -1;
    const unsigned kb0 = off_b((unsigned)l15, (unsigned)g);
    bf16x8 bq[4], bqn[4]; bool act = false;
    { const int u0 = (int)blockIdx.x, u = u0 + w * G;
      if (u0 < 4096 && u < 4096 && (u & 7) == (u0 & 7)) { act = true; const int m0 = (u >> 3) * 16, h = u0 & 7;
#pragma unroll
          for (int s = 0; s < 4; ++s) bq[s] = __builtin_nontemporal_load((const bf16x8*)(QA + (size_t)(m0 + l15) * 1024 + h * 128 + 32 * s + 8 * g)); } }
    for (int u0 = (int)blockIdx.x; u0 < 4096; u0 += 8 * G) {
        const int h = u0 & 7;
        if (h != hcur || (G & 7)) { hcur = h; __syncthreads();
#pragma unroll
            for (int i = 0; i < 8; ++i) { const int idx = tid + 512 * i, row = idx >> 4, ch = idx & 15, nbr = row >> 4, ir = row & 15;
                const int rsrc = 64 * (nbr >> 2) + 16 * (ir >> 2) + 4 * (nbr & 3) + (ir & 3);
                *(LAS u32x4*)(lds + off_b((unsigned)row, (unsigned)ch)) = *(const u32x4*)(WUK + ((size_t)rsrc * 8 + h) * 128 + ch * 8); }
            __syncthreads(); }
        const int u = u0 + w * G;
        bool actn = false;
        { const int u0n = u0 + 8 * G, un = u0n + w * G;
          if (u0n < 4096 && un < 4096 && (un & 7) == (u0n & 7)) { actn = true; const int m0n = (un >> 3) * 16, hn = u0n & 7;
#pragma unroll
              for (int s = 0; s < 4; ++s) bqn[s] = __builtin_nontemporal_load((const bf16x8*)(QA + (size_t)(m0n + l15) * 1024 + hn * 128 + 32 * s + 8 * g)); } }
        if (act) {
            const int m0 = (u >> 3) * 16;
#pragma unroll 2
            for (int k4 = 0; k4 < 4; ++k4) {
                u32x4 wq;
#pragma unroll
                for (int nbl = 0; nbl < 4; ++nbl) { const int nb = 4 * k4 + nbl;
                    bf16x8 af[4];
#pragma unroll
                    for (int s = 0; s < 4; ++s) af[s] = *(const LAS bf16x8*)(lds + 4096 * nb + (kb0 ^ (64u * s)));
                    f32x4 acc = (f32x4){0.f, 0.f, 0.f, 0.f};
#pragma unroll
                    for (int s = 0; s < 4; ++s) acc = __builtin_amdgcn_mfma_f32_16x16x32_bf16(af[s], bq[s], acc, 0, 0, 0);
                    int wv = __builtin_amdgcn_cvt_pk_fp8_f32(acc[0] * sc, acc[1] * sc, 0, false); wv = __builtin_amdgcn_cvt_pk_fp8_f32(acc[2] * sc, acc[3] * sc, wv, true);
                    wq[nbl] = (unsigned)wv; }
                *(u32x4*)((unsigned char*)QLAT + ((size_t)(m0 + l15) * 8 + h) * 256 + 64 * k4 + 16 * g) = wq;
            }
        }
        act = actn;
#pragma unroll
        for (int s = 0; s < 4; ++s) bq[s] = bqn[s];
    }
}
__device__ __forceinline__ void phase_oproj(const Params& p, LAS unsigned char* lds) {
    const bf16_t* OLAT = WSP(const bf16_t, WS_OLAT); const bf16_t* WUVT = WSP(const bf16_t, WS_WUVT); const bf16_t* ZA = WSP(const bf16_t, WS_ZA); bf16_t* OZA = WSP(bf16_t, WS_OZA);
    const int tid = opaque_tid(), lane = tid & 63, w = __builtin_amdgcn_readfirstlane(tid >> 6), l15 = lane & 15, g = lane >> 4;
    const int G = (int)gridDim.x;
    int hcur = -1;
    const unsigned kb0 = off_b((unsigned)l15, (unsigned)g);
    bf16x8 bq[8], bqn[8]; u32x4 zz[4], zzn[4];
    bool act = false;
    { const int u0 = (int)blockIdx.x, u = u0 + w * G;
      if (u0 < 4096 && u < 4096 && (u & 7) == (u0 & 7)) { act = true; const int m0 = (u >> 3) * 16, h = u0 & 7;
#pragma unroll
          for (int s = 0; s < 8; ++s) bq[s] = __builtin_nontemporal_load((const bf16x8*)(OLAT + ((size_t)(m0 + l15) * 8 + h) * 256 + 32 * s + 8 * g));
#pragma unroll
          for (int k2 = 0; k2 < 4; ++k2) zz[k2] = __builtin_nontemporal_load((const u32x4*)(ZA + (size_t)(m0 + l15) * 1024 + h * 128 + 32 * k2 + 8 * g)); } }
    for (int u0 = (int)blockIdx.x; u0 < 4096; u0 += 8 * G) {
        const int h = u0 & 7;
        if (h != hcur || (G & 7)) { hcur = h; __syncthreads();
#pragma unroll
            for (int i = 0; i < 8; ++i) { const int idx = tid + 512 * i, row = idx >> 5, c32 = idx & 31, nbr = row >> 4, ir = row & 15;
                const int dsrc = 32 * (nbr >> 1) + 8 * (ir >> 2) + 4 * (nbr & 1) + (ir & 3);
                *(LAS u32x4*)(lds + (c32 >> 4) * 32768 + off_b((unsigned)row, (unsigned)(c32 & 15))) = *(const u32x4*)(WUVT + (size_t)(h * 128 + dsrc) * 256 + c32 * 8); }
            __syncthreads(); }
        const int u = u0 + w * G;
        bool actn = false;
        { const int u0n = u0 + 8 * G, un = u0n + w * G;
          if (u0n < 4096 && un < 4096 && (un & 7) == (u0n & 7)) { actn = true; const int m0n = (un >> 3) * 16, hn = u0n & 7;
#pragma unroll
              for (int s = 0; s < 8; ++s) bqn[s] = __builtin_nontemporal_load((const bf16x8*)(OLAT + ((size_t)(m0n + l15) * 8 + hn) * 256 + 32 * s + 8 * g));
#pragma unroll
              for (int k2 = 0; k2 < 4; ++k2) zzn[k2] = __builtin_nontemporal_load((const u32x4*)(ZA + (size_t)(m0n + l15) * 1024 + hn * 128 + 32 * k2 + 8 * g)); } }
        if (act) {
            const int m0 = (u >> 3) * 16;
#pragma unroll
            for (int k2 = 0; k2 < 4; ++k2) {
                const size_t o = (size_t)(m0 + l15) * 1024 + h * 128 + 32 * k2 + 8 * g;
                const u32x4 z = zz[k2];
                u32x4 wv;
#pragma unroll
                for (int nbl = 0; nbl < 2; ++nbl) { const int nb = 2 * k2 + nbl;
                    bf16x8 af[8];
#pragma unroll
                    for (int s = 0; s < 8; ++s) af[s] = *(const LAS bf16x8*)(lds + (s >> 2) * 32768 + 4096 * nb + (kb0 ^ (64u * (s & 3))));
                    f32x4 acc = (f32x4){0.f, 0.f, 0.f, 0.f};
#pragma unroll
                    for (int s = 0; s < 8; ++s) acc = __builtin_amdgcn_mfma_f32_16x16x32_bf16(af[s], bq[s], acc, 0, 0, 0);
                    wv[2 * nbl] = pg8::cvt_pk_bf16(acc[0] * bflo(z[2 * nbl]), acc[1] * bfhi(z[2 * nbl])); wv[2 * nbl + 1] = pg8::cvt_pk_bf16(acc[2] * bflo(z[2 * nbl + 1]), acc[3] * bfhi(z[2 * nbl + 1])); }
                *(u32x4*)(OZA + o) = wv;
            }
        }
        act = actn;
#pragma unroll
        for (int s = 0; s < 8; ++s) bq[s] = bqn[s];
#pragma unroll
        for (int k2 = 0; k2 < 4; ++k2) zz[k2] = zzn[k2];
    }
}
typedef int v2i32_t __attribute__((ext_vector_type(2)));
constexpr int DSA_WAVE_LDS = 17408, DSA_LUT = 8 * DSA_WAVE_LDS;
__device__ __forceinline__ int lpos(int s) { return (s & ~31) | ((s & 3) << 3) | ((s & 31) >> 2); }
__device__ __forceinline__ unsigned ord_key(float f) { const unsigned u = __float_as_uint(f); return (u & 0x80000000u) ? ~u : (u | 0x80000000u); }
template <int N> struct DsaPar { static constexpr unsigned value = N; };
typedef unsigned short u16x2 __attribute__((ext_vector_type(2)));
template <int KW>
__device__ __forceinline__ void dsa_select(const unsigned short* row, int n, int nsel, LAS int* list, int lane) {
    const __amdgpu_buffer_rsrc_t rs = __builtin_amdgcn_make_buffer_rsrc((void*)row, 0, n * 2, 0x00020000);
    unsigned key[KW];
#pragma unroll
    for (int k = 0; k < KW; ++k) key[k] = (unsigned)__builtin_amdgcn_raw_buffer_load_b32(rs, lane * 4, 256 * k, 2);
    { int w0 = lane; const int nw = n >> 1;
#pragma unroll
      for (int k = 0; k < KW; ++k) { const unsigned u = key[k];
          const unsigned neg = (unsigned)__builtin_bit_cast(unsigned, (__builtin_bit_cast(short __attribute__((ext_vector_type(2))), u) >> (short)15));
          const unsigned o = u ^ (neg | 0x80008000u);
          key[k] = (w0 < nw) ? o : 0u; w0 += 64; asm volatile("" : "+v"(w0)); } }
    unsigned thr = 0u; bool exact = (n <= 256);
    unsigned one2 = 0x00010001u; asm volatile("" : "+v"(one2));
    if (n > 256) {
        for (int bit = 15; bit >= 0; --bit) {
            const unsigned cand = thr | (1u << bit);
            const unsigned cm1 = (cand - 1u) * 0x00010001u;
            unsigned acc0 = 0u, acc1 = 0u;
#pragma unroll
            for (int k = 0; k < KW; ++k) { unsigned s;
                asm("v_pk_sub_u16 %0, %1, %2 clamp" : "=v"(s) : "v"(key[k]), "v"(cm1));
                asm("v_pk_min_u16 %0, %1, %2" : "=v"(s) : "v"(s), "v"(one2));
                if (k & 1) asm("v_pk_add_u16 %0, %1, %2" : "=v"(acc1) : "v"(acc1), "v"(s)); else asm("v_pk_add_u16 %0, %1, %2" : "=v"(acc0) : "v"(acc0), "v"(s)); }
            const unsigned acc = acc0 + acc1;
            const int c = (int)(acc & 0xffffu) + (int)(acc >> 16);
            int v_ = c;
            v_ += __builtin_amdgcn_update_dpp(0, v_, 0x111, 0xF, 0xF, true); v_ += __builtin_amdgcn_update_dpp(0, v_, 0x112, 0xF, 0xF, true);
            v_ += __builtin_amdgcn_update_dpp(0, v_, 0x114, 0xF, 0xF, true); v_ += __builtin_amdgcn_update_dpp(0, v_, 0x118, 0xF, 0xF, true);
            v_ += __builtin_amdgcn_update_dpp(0, v_, 0x142, 0xA, 0xF, false); v_ += __builtin_amdgcn_update_dpp(0, v_, 0x143, 0xC, 0xF, false);
            const int cnt = __builtin_amdgcn_readlane(v_, 63);
            if (cnt >= 256) thr = cand;
            if (cnt == 256) { exact = true; break; }
        }
    }
    if (exact) {
        const unsigned t1 = thr ? thr : 1u, cm1 = (t1 - 1u) * 0x00010001u;
        unsigned acc0 = 0u, acc1 = 0u;
#pragma unroll
        for (int k = 0; k < KW; ++k) { unsigned s;
            asm("v_pk_sub_u16 %0, %1, %2 clamp" : "=v"(s) : "v"(key[k]), "v"(cm1));
            asm("v_pk_min_u16 %0, %1, %2" : "=v"(s) : "v"(s), "v"(one2));
            if (k & 1) asm("v_pk_add_u16 %0, %1, %2" : "=v"(acc1) : "v"(acc1), "v"(s)); else asm("v_pk_add_u16 %0, %1, %2" : "=v"(acc0) : "v"(acc0), "v"(s)); }
        const unsigned acc = acc0 + acc1; const int c = (int)(acc & 0xffffu) + (int)(acc >> 16);
        int v_ = c;
        v_ += __builtin_amdgcn_update_dpp(0, v_, 0x111, 0xF, 0xF, true); v_ += __builtin_amdgcn_update_dpp(0, v_, 0x112, 0xF, 0xF, true);
        v_ += __builtin_amdgcn_update_dpp(0, v_, 0x114, 0xF, 0xF, true); v_ += __builtin_amdgcn_update_dpp(0, v_, 0x118, 0xF, 0xF, true);
        v_ += __builtin_amdgcn_update_dpp(0, v_, 0x142, 0xA, 0xF, false); v_ += __builtin_amdgcn_update_dpp(0, v_, 0x143, 0xC, 0xF, false);
        int slot = v_ - c; int idx = 2 * lane;
#pragma unroll
        for (int k = 0; k < KW; ++k) { const unsigned lo = key[k] & 0xffffu, hi = key[k] >> 16;
            if (lo >= t1) { list[lpos(slot)] = idx; ++slot; }
            if (hi >= t1) { list[lpos(slot)] = idx + 1; ++slot; }
            idx += 128; asm volatile("" : "+v"(idx)); }
        return;
    }
    int pos = 0; int idx = 2 * lane;
#pragma unroll
    for (int k = 0; k < KW; ++k) { const unsigned lo = key[k] & 0xffffu, hi = key[k] >> 16; const bool m0 = lo > thr, m1 = hi > thr;
        const unsigned long long k0 = __ballot(m0), k1 = __ballot(m1);
        const int my = __builtin_amdgcn_mbcnt_hi((unsigned)(k0 >> 32), __builtin_amdgcn_mbcnt_lo((unsigned)k0, 0u)) + __builtin_amdgcn_mbcnt_hi((unsigned)(k1 >> 32), __builtin_amdgcn_mbcnt_lo((unsigned)k1, 0u));
        if (m0) list[lpos(pos + my)] = idx;
        if (m1) list[lpos(pos + my + (m0 ? 1 : 0))] = idx + 1;
        pos += __popcll(k0) + __popcll(k1); idx += 128; asm volatile("" : "+v"(idx)); }
    if (pos < nsel) {
        idx = 2 * lane;
#pragma unroll
        for (int k = 0; k < KW; ++k) { const unsigned lo = key[k] & 0xffffu, hi = key[k] >> 16; const bool m0 = (lo == thr) && (idx < n), m1 = (hi == thr) && (idx < n);
            const unsigned long long k0 = __ballot(m0), k1 = __ballot(m1);
            const int my = __builtin_amdgcn_mbcnt_hi((unsigned)(k0 >> 32), __builtin_amdgcn_mbcnt_lo((unsigned)k0, 0u)) + __builtin_amdgcn_mbcnt_hi((unsigned)(k1 >> 32), __builtin_amdgcn_mbcnt_lo((unsigned)k1, 0u));
            if (m0 && pos + my < nsel) list[lpos(pos + my)] = idx;
            if (m1 && pos + my + (m0 ? 1 : 0) < nsel) list[lpos(pos + my + (m0 ? 1 : 0))] = idx + 1;
            pos += __popcll(k0) + __popcll(k1); idx += 128; asm volatile("" : "+v"(idx)); }
    }
}
__device__ __forceinline__ void dsa_unit(const Params& p, LAS unsigned char* lds, int qi, int wave, int lane, int probe) {
    const unsigned short* SC = WSP(const unsigned short, WS_SC); bf16_t* OLAT = WSP(bf16_t, WS_OLAT);
    const int c = qi >> 8, b = (qi >> 6) & 1, j = (c - 1) * 64 + (qi & 63), t = b * SEQ + j, n = 16 + 64 * c, nsel = n < 256 ? n : 256, qpos = NMETA + j;
    LAS unsigned char* img = lds + wave * DSA_WAVE_LDS; LAS int* list = (LAS int*)(img + 16384); const LAS float* LUTA = (const LAS float*)(lds + DSA_LUT);
    const int l15 = lane & 15, g = lane >> 4;
    const unsigned short* row = SC + sc_off(b, j);
#pragma unroll
    for (int rs_ = (PROBE_REP == 41) ? 2 : 1; rs_ > 0; --rs_) {
    if (n <= 64 * 17) dsa_select<9>(row, n, nsel, list, lane);
    else if (n <= 64 * 33) dsa_select<17>(row, n, nsel, list, lane);
    else if (n <= 64 * 49) dsa_select<25>(row, n, nsel, list, lane);
    else dsa_select<33>(row, n, nsel, list, lane);
    }
#pragma unroll
    for (int ra_ = (PROBE_REP == 42) ? 2 : 1; ra_ > 0; --ra_) {
    const unsigned char* CKV8 = WSP(const unsigned char, WS_CKV); const unsigned char* qlp = WSP(const unsigned char, WS_QLAT) + ((size_t)t * 8 + (l15 & 7)) * 256 + 8 * g;
    const bool qreal = l15 < 8;
    unsigned rdb[2];
    rdb[0] = 256u * (unsigned)l15 + 8u * ((unsigned)g ^ (2u * (unsigned)l15));
    rdb[1] = 256u * (unsigned)(l15 + 16) + 8u * ((unsigned)g ^ (2u * ((unsigned)l15 ^ 8u)));
    const unsigned tq = (unsigned)l15 >> 1, tp = (unsigned)l15 & 1u;
    const unsigned trow = (tq < 4u) ? 4u * g + tq : 16u + 4u * g + (tq - 4u);
    const unsigned trb = 256u * trow + 8u * (tp ^ (2u * ((trow & 15u) ^ ((trow >> 4) << 3))));
    float m = -INFINITY, l = 0.f;
    f32x4 O[16];
#pragma unroll
    for (int rb = 0; rb < 16; ++rb) O[rb] = (f32x4){0.f, 0.f, 0.f, 0.f};
    const int nch = (nsel + 31) >> 5;
    const int hcol = l15 & 7;
    const unsigned char* ckb = CKV8 + (size_t)b * TK * 256;
    unsigned gsx[8];
#pragma unroll
    for (int i = 0; i < 8; ++i) { const unsigned row = 4u * i + (unsigned)(lane >> 4); const unsigned rc = (row & 15u) ^ ((row >> 4) << 3); gsx[i] = (((unsigned)lane & 15u) ^ rc) << 4; }
    const unsigned imgaddr = (unsigned)(size_t)img;
#define DSA_GATHER(chn, imo_) do { int ki_[8]; { const int ce_ = ((chn) < nch) ? (chn) : 0; const LAS int* lp_ = list + 32 * ce_ + 8 * (lane >> 4);     \
        _Pragma("unroll") for (int v_ = 0; v_ < 2; ++v_) { const u32x4 t_ = *(const LAS u32x4*)(lp_ + 4 * v_); ki_[4 * v_] = (int)t_.x; ki_[4 * v_ + 1] = (int)t_.y; ki_[4 * v_ + 2] = (int)t_.z; ki_[4 * v_ + 3] = (int)t_.w; } } \
        _Pragma("unroll") for (int i = 0; i < 8; ++i) { unsigned keep_; const unsigned ldsa_ = (unsigned)__builtin_amdgcn_readfirstlane((int)(imgaddr + (imo_) + 1024u * i)); \
            asm volatile("s_mov_b32 %0, m0\n\ts_mov_b32 m0, %3\n\ts_nop 0\n\tglobal_load_lds_dwordx4 %1, %2\n\ts_mov_b32 m0, %0" : "=&s"(keep_) : "v"(((unsigned)ki_[i] << 8) | gsx[i]), "s"(ckb), "s"(ldsa_) : "memory"); } } while (0)
    if (nsel < 32 * nch) { for (int i = nsel + lane; i < 32 * nch; i += 64) list[lpos(i)] = 0; }
    long qf[8];
#pragma unroll
    for (int s = 0; s < 8; ++s) qf[s] = *(const long*)(qlp + 32 * s);
#pragma unroll
    for (int s = 0; s < 8; ++s) { qf[s] = qreal ? qf[s] : 0l; asm volatile("" : "+v"(qf[s])); }
    asm volatile("s_waitcnt lgkmcnt(0)" ::: "memory");
    DSA_GATHER(0, 0u); DSA_GATHER(1, 8192u);
    auto chunk_step = [&](const int ch, auto par) __attribute__((always_inline)) {
        asm volatile("s_waitcnt vmcnt(8)" ::: "memory");
        constexpr unsigned io = decltype(par)::value * 8192u;
        LAS unsigned char* im = img + io;
        f32x4 S[2];
        S[0] = (f32x4){0.f, 0.f, 0.f, 0.f}; S[1] = S[0];
#pragma unroll
        for (int s4 = 0; s4 < 8; s4 += 4) {
            v2i32_t af_[4][2];
#pragma unroll
            for (int s = 0; s < 4; ++s)
#pragma unroll
                for (int mb = 0; mb < 2; ++mb) af_[s][mb] = *(const LAS v2i32_t*)(im + (rdb[mb] ^ (32u * (s4 + s))));
            __builtin_amdgcn_sched_barrier(0);
            const v8i32 qq = {(int)(unsigned)qf[s4], (int)(unsigned)((unsigned long)qf[s4] >> 32), (int)(unsigned)qf[s4 + 1], (int)(unsigned)((unsigned long)qf[s4 + 1] >> 32),
                              (int)(unsigned)qf[s4 + 2], (int)(unsigned)((unsigned long)qf[s4 + 2] >> 32), (int)(unsigned)qf[s4 + 3], (int)(unsigned)((unsigned long)qf[s4 + 3] >> 32)};
#pragma unroll
            for (int mb = 0; mb < 2; ++mb) { const v8i32 aa = {af_[0][mb].x, af_[0][mb].y, af_[1][mb].x, af_[1][mb].y, af_[2][mb].x, af_[2][mb].y, af_[3][mb].x, af_[3][mb].y};
                S[mb] = __builtin_amdgcn_mfma_scale_f32_16x16x128_f8f6f4(aa, qq, S[mb], 0, 0, 0, 0x7f7f7f7f, 0, 0x7f7f7f7f); }
        }
        float cm = -INFINITY;
#pragma unroll
        for (int mb = 0; mb < 2; ++mb)
#pragma unroll
            for (int i = 0; i < 4; ++i) { const int slot = 32 * ch + 16 * mb + 4 * g + i; const int kidx = list[lpos(slot & 255)];
                int rel = kidx - qpos; rel = rel < -91 ? -91 : (rel > 63 ? 63 : rel);
                float v = S[mb][i] * 0.0625f + LUTA[(rel + 91) * 8 + hcol]; v = slot < nsel ? v : -INFINITY; S[mb][i] = v; cm = fmaxf(cm, v); }
        { const auto s16 = __builtin_amdgcn_permlane16_swap(__float_as_uint(cm), __float_as_uint(cm), false, false);
          cm = fmaxf(__uint_as_float(s16[0]), __uint_as_float(s16[1]));
          const auto s32 = __builtin_amdgcn_permlane32_swap(__float_as_uint(cm), __float_as_uint(cm), false, false);
          cm = fmaxf(__uint_as_float(s32[0]), __uint_as_float(s32[1])); }
        const float mn = fmaxf(m, cm), alpha = __builtin_amdgcn_exp2f(m - mn); m = mn;
        float ps = 0.f;
#pragma unroll
        for (int mb = 0; mb < 2; ++mb)
#pragma unroll
            for (int i = 0; i < 4; ++i) { S[mb][i] = __builtin_amdgcn_exp2f(S[mb][i] - mn); ps += S[mb][i]; }
        l = l * alpha + ps;
        if (__any(alpha != 1.f)) {
#pragma unroll
            for (int rb = 0; rb < 16; ++rb) O[rb] = O[rb] * alpha;
        }
        int w0 = __builtin_amdgcn_cvt_pk_fp8_f32(S[0][0], S[0][1], 0, false); w0 = __builtin_amdgcn_cvt_pk_fp8_f32(S[0][2], S[0][3], w0, true);
        int w1 = __builtin_amdgcn_cvt_pk_fp8_f32(S[1][0], S[1][1], 0, false); w1 = __builtin_amdgcn_cvt_pk_fp8_f32(S[1][2], S[1][3], w1, true);
        const long pb = (long)(((unsigned long long)(unsigned)w1 << 32) | (unsigned long long)(unsigned)w0);
#pragma unroll
        for (int rb4 = 0; rb4 < 16; rb4 += 4) {
            long tf_[4];
#pragma unroll
            for (int r_ = 0; r_ < 4; ++r_) { const v2i32_t tv = __builtin_amdgcn_ds_read_tr8_b64_v2i32((LAS v2i32_t*)(im + (trb ^ (16u * (rb4 + r_))))); tf_[r_] = __builtin_bit_cast(long, tv); }
            __builtin_amdgcn_sched_barrier(0);
#pragma unroll
            for (int r_ = 0; r_ < 4; ++r_) O[rb4 + r_] = __builtin_amdgcn_mfma_f32_16x16x32_fp8_fp8(tf_[r_], pb, O[rb4 + r_], 0, 0, 0);
        }
        asm volatile("s_waitcnt lgkmcnt(0)" ::: "memory");
        DSA_GATHER(ch + 2, io);
    };
    for (int ch = 0; ch < nch; ch += 2) { chunk_step(ch, DsaPar<0>{}); if (ch + 1 < nch) chunk_step(ch + 1, DsaPar<1>{}); }
    asm volatile("s_waitcnt vmcnt(0)" ::: "memory");
    l = xsum_rows(l);
    const float il = 1.f / l;
    {
        const bool godd = (g & 1) != 0;
        bf16_t* orow = OLAT + ((size_t)t * 8 + l15) * 256 + (godd ? 16 + 4 * (g - 1) : 4 * g);
#pragma unroll
        for (int rb = 0; rb < 16; rb += 2) {
            u32x2 wa, wb;
            wa.x = pg8::cvt_pk_bf16(O[rb][0] * il, O[rb][1] * il); wa.y = pg8::cvt_pk_bf16(O[rb][2] * il, O[rb][3] * il);
            wb.x = pg8::cvt_pk_bf16(O[rb + 1][0] * il, O[rb + 1][1] * il); wb.y = pg8::cvt_pk_bf16(O[rb + 1][2] * il, O[rb + 1][3] * il);
            const auto s0 = __builtin_amdgcn_permlane16_swap(wa.x, wb.x, false, false), s1 = __builtin_amdgcn_permlane16_swap(wa.y, wb.y, false, false);
            u32x4 dat;
            dat.x = godd ? s0[0] : wa.x; dat.y = godd ? s1[0] : wa.y; dat.z = godd ? wb.x : s0[1]; dat.w = godd ? wb.y : s1[1];
            if (l15 < 8) *(u32x4*)(orow + 16 * rb) = dat;
        }
    }
    }
}
#undef DSA_GATHER
__device__ __forceinline__ int lds_take(LAS unsigned* ctr, int lane) {
    int u = 0; if (lane == 0) u = (int)__hip_atomic_fetch_add(ctr, 1u, __ATOMIC_RELAXED, __HIP_MEMORY_SCOPE_WORKGROUP);
    return __builtin_amdgcn_readfirstlane(u);
}
__device__ __forceinline__ int dsa_query_of(int u, int G) {
    const int k = u >> 3, r = u & 7;
    int cl, bb, grp;
    if (G == 256) { const int idx = ((int)blockIdx.x >> 1) + 128 * k; cl = 1 + (idx >> 4); grp = idx & 15; bb = (int)blockIdx.x & 1; }
    else { const int P = (int)blockIdx.x + k * G; cl = 1 + (P >> 5); bb = (P >> 4) & 1; grp = P & 15; }
    const int c = (r < 4) ? 65 - cl : cl;
    return (c << 8) | (bb << 6) | (4 * grp + (r & 3));
}
__device__ __forceinline__ int dsa_token_of(int qi) { return ((qi >> 6) & 1) * SEQ + ((qi >> 8) - 1) * 64 + (qi & 63); }
__device__ __forceinline__ void phase_dsa(const Params& p, LAS unsigned char* lds, int wave, int lane, int probe) {
    LAS float* LUTA = (LAS float*)(lds + DSA_LUT); LAS unsigned* ctr = (LAS unsigned*)(lds + DSA_LUT + 155 * 8 * 4);
    const int G = (int)gridDim.x, l15 = lane & 15, g = lane >> 4;
    __syncthreads();
    for (int i = threadIdx.x; i < 155 * 8; i += 512) LUTA[i] = p.rel_bias[t5_bucket((i >> 3) - 91) * 16 + (i & 7)] * LOG2E;
    if (threadIdx.x == 0) ctr[0] = 0u;
    const int npi = (1024 - (int)blockIdx.x + G - 1) / G;
    const int nun = npi * 8;
    __syncthreads();
    for (;;) {
        const int u = lds_take(ctr, lane); if (u >= nun) break;
        dsa_unit(p, lds, dsa_query_of(u, G), wave, lane, probe);
    }
}

#define XB_TMO      128
#define XB_XCNT(j)  (256  + 64 * (j))
#define XB_XSUB(j)  (1280 + 64 * (j))
#define XB_XGEN(j)  (2304 + 64 * (j))
#define XB_TOP      3328
#define XB_TOPGEN   3392
#define XCD_BAR_WORDS 3456
#define XB_SPIN_CAP (1u << 24)
__device__ __forceinline__ unsigned xb_ld(unsigned* p)              { return __hip_atomic_load(p, __ATOMIC_RELAXED, __HIP_MEMORY_SCOPE_AGENT); }
__device__ __forceinline__ unsigned xb_add(unsigned* p, unsigned v) { return __hip_atomic_fetch_add(p, v, __ATOMIC_RELAXED, __HIP_MEMORY_SCOPE_AGENT); }
__device__ __forceinline__ unsigned xb_xcc_id() { return (unsigned)__builtin_amdgcn_s_getreg((3 << 11) | 20) & 0xFu; }
#define XB_SPIN(cond, bar) do { unsigned _sp = 0; while (cond) { __builtin_amdgcn_s_sleep(1); \
    if ((++_sp & 255u) == 0u) { if (xb_ld(&(bar)[XB_TMO])) break; if (_sp > XB_SPIN_CAP) { atomicAdd(&(bar)[XB_TMO], 1u); break; } } } } while (0)
struct XcdBarrier { unsigned* bar; unsigned x; volatile LAS unsigned* st; };
__device__ __forceinline__ XcdBarrier xcd_barrier_post(unsigned* bar, volatile LAS unsigned* st) {
    XcdBarrier b; b.bar = bar; b.x = xb_xcc_id(); b.st = st;
    if (threadIdx.x == 0) (void)xb_add(&bar[XB_XCNT(b.x)], 1u);
    return b;
}
__device__ __forceinline__ void xcd_barrier_complete(unsigned* bar, unsigned x, unsigned& nloc, unsigned& nx) {
    const unsigned G = gridDim.x * gridDim.y * gridDim.z;
    unsigned sum, cnt, mine, sp = 0u;
    for (;;) {
        sum = 0u; cnt = 0u; mine = 0u;
#pragma unroll
        for (unsigned j = 0; j < 16; ++j) { const unsigned c = xb_ld(&bar[XB_XCNT(j)]); sum += c; cnt += (c > 0u) ? 1u : 0u; mine = (j == x) ? c : mine; }
        if (sum == G) break;
        __builtin_amdgcn_s_sleep(1);
        if ((++sp & 255u) == 0u) { if (xb_ld(&bar[XB_TMO])) break; if (sp > XB_SPIN_CAP) { atomicAdd(&bar[XB_TMO], 1u); break; } }
    }
    nloc = mine > 0u ? mine : 1u; nx = cnt > 0u ? cnt : 1u;
}
__device__ __forceinline__ void xcd_barrier(const XcdBarrier& b) {
    asm volatile("s_waitcnt vmcnt(0)" ::: "memory");
    __syncthreads();
    if (threadIdx.x == 0) {
        unsigned* bar = b.bar;
        __builtin_amdgcn_s_waitcnt(0);
        unsigned nloc = b.st[0], nx = b.st[1];
        if (nloc == 0u) { xcd_barrier_complete(bar, b.x, nloc, nx); b.st[0] = nloc; b.st[1] = nx; }
        const unsigned old = xb_add(&bar[XB_XSUB(b.x)], 1u);
        const unsigned gen = old / nloc;
        if (old + 1u == (gen + 1u) * nloc) {
            __builtin_amdgcn_fence(__ATOMIC_RELEASE, "agent");
            asm volatile("s_waitcnt vmcnt(0)" ::: "memory");
            const unsigned og = xb_add(&bar[XB_TOP], 1u);
            const unsigned tg = og / nx;
            if (og + 1u == (tg + 1u) * nx) xb_add(&bar[XB_TOPGEN], 1u);
            else XB_SPIN(xb_ld(&bar[XB_TOPGEN]) == tg, bar);
            __builtin_amdgcn_fence(__ATOMIC_ACQUIRE, "agent");
            xb_add(&bar[XB_XGEN(b.x)], 1u);
            asm volatile("s_waitcnt vmcnt(0)" ::: "memory");
        } else {
            XB_SPIN(xb_ld(&bar[XB_XGEN(b.x)]) == gen, bar);
            __builtin_amdgcn_fence(__ATOMIC_ACQUIRE, "agent");
            asm volatile("s_waitcnt vmcnt(0)" ::: "memory");
        }
    }
    __syncthreads();
}

constexpr int LDS_BYTES = 147456, MISC_OFF = 147456 - 256;
constexpr int NPHASE = 8;
#ifndef ONE_LAUNCH
#define ONE_LAUNCH 1
#endif

struct KArgs { Params p; int ph_lo, ph_hi, probe, pad; };
__global__ void __launch_bounds__(512, 2) k_fwd(KArgs a) {
    extern __shared__ __attribute__((aligned(16))) unsigned char lds_raw[];
    LAS unsigned char* lds = (LAS unsigned char*)lds_raw;
    const Params& p = a.p;
    const int tid = threadIdx.x, lane = tid & 63, wave = __builtin_amdgcn_readfirstlane(tid >> 6);
    const int gw = blockIdx.x * 8 + wave, ngw = gridDim.x * 8;
    volatile LAS unsigned* misc = (volatile LAS unsigned*)(lds + MISC_OFF);
    if (tid < 64) misc[tid] = 0u;
    __syncthreads();
    XcdBarrier bar; bar.bar = WSP(unsigned, WS_CTL) + 4096; bar.x = 0; bar.st = misc;
    if (ONE_LAUNCH) bar = xcd_barrier_post(WSP(unsigned, WS_CTL) + 4096, misc);
#define IN(k) (a.ph_lo <= 0 && 0 < a.ph_hi)
#define SEAM(k) do { xcd_barrier(bar); } while (0)
#define RUNPH(k, ...) do { if (IN(k)) { constexpr int nrep_ = (PROBE_REP == (k)) ? 2 : 1; _Pragma("unroll") for (int rep = 0; rep < nrep_; ++rep) { if (rep) xcd_barrier(bar); __VA_ARGS__ } } } while (0)
    RUNPH(0, const int lane_ = opaque_tid() & 63; phase0(p, lds, gw, ngw, wave, lane_, 0, (gridDim.x == 256) ? p.jobs[13].item0 : p.nitems););
    SEAM(0);
    RUNPH(1,
        SchedInproj S{DM, (int)gridDim.x, (int)blockIdx.x, (const char*)WSP(bf16_t, WS_U), (const char*)WSP(bf16_t, WS_WIN)};
        EpiInproj E{WSP(bf16_t, WS_QA), WSP(bf16_t, WS_ZA), WSP(bf16_t, WS_IQ), WSP(bf16_t, WS_QB), WSP(bf16_t, WS_ZB), WSP(bf16_t, WS_GA), WSP(bf16_t, WS_GB), WSP(bf16_t, WS_KB), WSP(bf16_t, WS_VB),
                    WSP(float, WS_CKVRAW), WSP(bf16_t, WS_IK), WSP(float, WS_IW), 0.125f * LOG2E, p.ikn_w, p.ikn_b, 0.015625f};
        pg8::gemm_phase<EpiInproj, SchedInproj>(lds, S, E);
        { SchedGate S8{DM, (int)gridDim.x, (int)blockIdx.x, (const char*)WSP(unsigned char, WS_U8), (const char*)WSP(unsigned char, WS_W8)};
          EpiGate E8{WSP(bf16_t, WS_GA), WSP(bf16_t, WS_GB), WSP(bf16_t, WS_ZA), WSP(bf16_t, WS_ZB), WSP(bf16_t, WS_QA), WSP(bf16_t, WS_VB)};
          pg8::gemm_phase<EpiGate, SchedGate, true, true, true, true>(lds, S8, E8); }
        if (gridDim.x == 256 && blockIdx.x >= 198 && blockIdx.x < 252) { const int lane_ = opaque_tid() & 63; phase0(p, lds, ((int)blockIdx.x - 198) * 8 + wave, 54 * 8, wave, lane_, p.jobs[13].item0, p.nitems); });
    SEAM(1);
    RUNPH(33, const int lane_ = opaque_tid() & 63; phase_ckvnorm(p, gw, ngw, lane_););
    RUNPH(32, phase_qlat(p, lds););
    RUNPH(30, phase_diff(p, lds););
    RUNPH(31, phase_scores(p, lds););
    SEAM(3);
    RUNPH(4, const int lane_ = opaque_tid() & 63; phase_dsa(p, lds, wave, lane_, a.probe););
    SEAM(4);
    RUNPH(8, phase_oproj(p, lds););
    SEAM(8);
    RUNPH(5,
        SchedMix S{1024, (int)gridDim.x, (int)blockIdx.x, (const char*)WSP(bf16_t, WS_OZA), (const char*)WSP(bf16_t, WS_WOA), (const char*)WSP(bf16_t, WS_OZB), (const char*)WSP(bf16_t, WS_WOB)};
        EpiMix E{WSP(const unsigned char, WS_GA), WSP(const unsigned char, WS_GB), WSP(bf16_t, WS_MIX)};
        pg8::gemm_phase<EpiMix, SchedMix, true, true, false, true>(lds, S, E););
    SEAM(5);
    if (gridDim.x == 256) {
        RUNPH(6,
            SchedOut S{DM, (int)gridDim.x, (int)blockIdx.x, (const char*)WSP(bf16_t, WS_MIX), (const char*)WSP(bf16_t, WS_WOUT)};
            EpiOutFused E{p.x, p.post_w, p.out, WSP(float, WS_SSQ), WSP(unsigned, WS_CTL) + 8192, lds};
            pg8::gemm_phase<EpiOutFused, SchedOut>(lds, S, E););
    } else {
        RUNPH(6,
            SchedOut S{DM, (int)gridDim.x, (int)blockIdx.x, (const char*)WSP(bf16_t, WS_MIX), (const char*)WSP(bf16_t, WS_WOUT)};
            EpiOut E{WSP(bf16_t, WS_OUTPRE), WSP(float, WS_SSQ)};
            pg8::gemm_phase<EpiOut, SchedOut>(lds, S, E););
        SEAM(6);
        RUNPH(7, const int lane_ = opaque_tid() & 63; phase7(p, gw, ngw, lane_););
    }
#undef RUNPH
#undef IN
#undef SEAM
}

static void add_job(Params& p, const float* src, bf16_t* dst, int K, int N, int col0, int ncols, int row0, int fp8 = 0) {
    TJob& j = p.jobs[p.njobs++]; j.fp8 = fp8; j.pad_ = 0; j.src = src; j.dst = dst; j.K = K; j.N = N; j.col0 = col0; j.nblk = (ncols + 31) / 32; j.row0 = row0; j.item0 = p.nitems; p.nitems += (K / 64) * j.nblk;
}
extern "C" void kernel_launch(void* const* d_in, const int* in_sizes, int n_in, void* d_out, int out_size, void* d_ws, size_t ws_size, hipStream_t stream) {
    if (n_in != 16 || ws_size < WS_END) { fprintf(stderr, "kernel_launch: unexpected arguments (n_in %d, ws %zu)\n", n_in, ws_size); return; }
    static int grid = 0;
    if (!grid) {
        int dev = 0, cus = 0, per_cu = 0;
        (void)hipGetDevice(&dev); (void)hipDeviceGetAttribute(&cus, hipDeviceAttributeMultiprocessorCount, dev);
        (void)hipFuncSetAttribute((const void*)k_fwd, hipFuncAttributeMaxDynamicSharedMemorySize, LDS_BYTES);
        (void)hipOccupancyMaxActiveBlocksPerMultiprocessor(&per_cu, (const void*)k_fwd, 512, LDS_BYTES);
        (void)hipGetLastError();
        grid = cus > 0 ? cus : 256;
        if (per_cu < 1) fprintf(stderr, "kernel_launch: occupancy query reports %d blocks per CU\n", per_cu);
    }
    KArgs a; memset(&a, 0, sizeof(a));
    Params& p = a.p;
    const float** in = (const float**)d_in;
    p.x = in[0]; p.meta = in[1]; p.rel_bias = in[2]; p.pre_w = in[3]; p.w_in = in[4]; p.kv_norm_w = in[5]; p.w_uk = in[6]; p.w_uv = in[7]; p.ikn_w = in[8]; p.ikn_b = in[9];
    p.lam_p = in[10]; p.subln_w = in[11]; p.w_o_a = in[12]; p.w_o_b = in[13]; p.w_out = in[14]; p.post_w = in[15];
    p.out = (float*)d_out; p.ws = (unsigned char*)d_ws;
    bf16_t* WIN = (bf16_t*)(p.ws + WS_WIN);
    const int NIN = 11600;
    add_job(p, p.w_in, (bf16_t*)(p.ws + WS_W8), DM, NIN, 0, 1024, 6144, 1);
    add_job(p, p.w_in, (bf16_t*)(p.ws + WS_W8), DM, NIN, 1280, 1024, 4096, 1);
    add_job(p, p.w_in, WIN, DM, NIN, 2304, 1024, 2048);
    add_job(p, p.w_in, WIN, DM, NIN, 3408, 1024, 3072);
    add_job(p, p.w_in, (bf16_t*)(p.ws + WS_W8), DM, NIN, 6480, 1024, 5120, 1);
    add_job(p, p.w_in, (bf16_t*)(p.ws + WS_W8), DM, NIN, 7504, 2048, 0, 1);
    add_job(p, p.w_in, (bf16_t*)(p.ws + WS_W8), DM, NIN, 9552, 2048, 2048, 1);
    add_job(p, p.w_in, WIN, DM, NIN, 4432, 1024, 9216);
    add_job(p, p.w_in, (bf16_t*)(p.ws + WS_W8), DM, NIN, 5456, 1024, 7168, 1);
    add_job(p, p.w_in, WIN, DM, NIN, 1024, 256, 11264);
    add_job(p, p.w_in, WIN, DM, NIN, 3328, 32, 11520);
    add_job(p, p.w_in, WIN, DM, NIN, 3392, 32, 11520 + 32);
    add_job(p, p.w_in, WIN, DM, NIN, 3360, 32, 11520 + 128);
    add_job(p, p.w_o_a, (bf16_t*)(p.ws + WS_WOA), 1024, DM, 0, DM, 0);
    add_job(p, p.w_o_b, (bf16_t*)(p.ws + WS_WOB), 1024, DM, 0, DM, 0);
    add_job(p, p.w_out, (bf16_t*)(p.ws + WS_WOUT), DM, DM, 0, DM, 0);
    add_job(p, p.w_uv, (bf16_t*)(p.ws + WS_WUVT), 256, 1024, 0, 1024, 0);
    (void)hipMemsetAsync((char*)d_ws + WS_CTL, 0, CTL_BYTES, stream);
#if ONE_LAUNCH
    a.ph_lo = 0; a.ph_hi = NPHASE; a.probe = PROBE_REP;
    hipLaunchKernelGGL(k_fwd, dim3(grid), dim3(512), LDS_BYTES, stream, a);
#else
    for (int ph = 0; ph < NPHASE; ++ph) { a.ph_lo = ph; a.ph_hi = ph + 1; hipLaunchKernelGGL(k_fwd, dim3(grid), dim3(512), LDS_BYTES, stream, a); }
#endif
}
```
